# Optimizing an MI355X kernel written in HIP

```python
import jax, jax.numpy as jnp
from jax import lax
import numpy as np

D_MODEL = 2048
BATCH = 16
SEQ = 256
DEPTH = 2
DEC_BATCH = 8
DEC_SEQ = 1024
PAST_LEN = 512

GRID_W = 64
QBLOCK = 128
ROPE_BASE = 10000.0
RMS_EPS = 1e-6
LN_EPS = 1e-5
NEG_INF = -1e30

N_EVEN = (DEPTH + 1) // 2
N_ODD = DEPTH // 2

MLA_HEADS = 8
Q_LORA = 512
KV_LORA = 256
QK_NOPE = 128
QK_ROPE = 64
V_HEAD = 128
MLA_OUT = MLA_HEADS * V_HEAD
POOL_WINDOWS = (2, 4, 8, 16)
POOL_GROUPS = len(POOL_WINDOWS)
POOL_CH = D_MODEL // 2
POOL_GC = POOL_CH // POOL_GROUPS
EVEN_IN = Q_LORA + KV_LORA + QK_ROPE + POOL_CH
EVEN_MIX = MLA_OUT + POOL_CH
SWA_HEADS = 32
SWA_KV = 4
SWA_HD = 64
SWA_GROUP = SWA_HEADS // SWA_KV
WINDOW = 128
ODD_MIX = SWA_HEADS * SWA_HD
ODD_IN = ODD_MIX + 2 * SWA_KV * SWA_HD
N_EXPERTS = 16
EXPERT_FF = 2048
CAP_FACTOR = 2
DN_ALPHA = (2 * DEPTH) ** 0.25
DN_BETA = (8 * DEPTH) ** -0.25

kernel_name = 'hybrid_diffusion_mla_pool_swa_ecmoe_step'

f32 = jnp.float32


def rms_norm(x, g):
    xf = x.astype(f32)
    y = xf * lax.rsqrt(jnp.mean(xf * xf, -1, keepdims=True) + RMS_EPS)
    return (y * g.astype(f32)).astype(x.dtype)


def layer_norm(x, g, b):
    xf = x.astype(f32)
    xc = xf - jnp.mean(xf, -1, keepdims=True)
    var = jnp.mean(xc * xc, -1, keepdims=True)
    return (xc * lax.rsqrt(var + LN_EPS) * g.astype(f32) + b.astype(f32)).astype(x.dtype)


def axial_rope_angles(n_tokens, rot_dim):
    rows = n_tokens // GRID_W
    row = jnp.repeat(jnp.arange(rows, dtype=f32), GRID_W)
    col = jnp.tile(jnp.arange(GRID_W, dtype=f32), rows)
    n_freq = rot_dim // 4
    inv = ROPE_BASE ** (-jnp.arange(n_freq, dtype=f32) / n_freq)
    ang = jnp.concatenate([row[:, None] * inv, col[:, None] * inv], -1)
    return jnp.cos(ang), jnp.sin(ang)


def apply_rope(x, cos, sin):
    shape = (1, x.shape[1]) + (1,) * (x.ndim - 3) + (cos.shape[-1],)
    c, s = cos.reshape(shape), sin.reshape(shape)
    xf = x.astype(f32)
    x1, x2 = xf[..., 0::2], xf[..., 1::2]
    out = jnp.stack([x1 * c - x2 * s, x1 * s + x2 * c], -1).reshape(x.shape)
    return out.astype(x.dtype)


def dense_attention(q, k, v, sink=None):
    b, sq, hk, g, dk = q.shape
    scale = dk ** -0.5
    nb = sq // QBLOCK
    qb = jnp.moveaxis(q.reshape(b, nb, QBLOCK, hk, g, dk), 1, 0)

    def block(qi):
        s = jnp.einsum('bqhgd,bkhd->bhgqk', qi, k, preferred_element_type=f32) * scale
        if sink is None:
            p = jax.nn.softmax(s, -1)
        else:
            s_sink = jnp.broadcast_to(sink.astype(f32)[None, :, :, None, None], s.shape[:-1] + (1,))
            p = jax.nn.softmax(jnp.concatenate([s, s_sink], -1), -1)[..., :-1]
        return jnp.einsum('bhgqk,bkhe->bqhge', p.astype(v.dtype), v)

    out = lax.map(block, qb)
    return jnp.moveaxis(out, 0, 1).reshape(b, sq, hk, g, v.shape[-1])


def window_attention(q, k, v, k_ctx, v_ctx, sink):
    b, s_len, hk, g, d = q.shape
    nb = s_len // QBLOCK
    n_ctx = k_ctx.shape[1]
    scale = d ** -0.5
    pad = ((0, 0), (QBLOCK, QBLOCK), (0, 0), (0, 0))

    def band(t):
        tb = jnp.pad(t, pad).reshape(b, nb + 2, QBLOCK, hk, t.shape[-1])
        return jnp.moveaxis(jnp.concatenate([tb[:, :-2], tb[:, 1:-1], tb[:, 2:]], 2), 1, 0)

    kb, vb = band(k), band(v)
    qb = jnp.moveaxis(q.reshape(b, nb, QBLOCK, hk, g, d), 1, 0)
    k_off = jnp.arange(3 * QBLOCK) - QBLOCK
    rel = k_off[None, :] - jnp.arange(QBLOCK)[:, None]
    in_window = jnp.abs(rel) <= WINDOW
    sink_f = sink.astype(f32)

    def block(args):
        i, qi, ki, vi = args
        kpos = i * QBLOCK + k_off
        valid = in_window & ((kpos >= 0) & (kpos < s_len))[None, :]
        s_loc = jnp.einsum('bqhgd,bkhd->bhgqk', qi, ki, preferred_element_type=f32) * scale
        s_loc = jnp.where(valid, s_loc, NEG_INF)
        s_ctx = jnp.einsum('bqhgd,bkhd->bhgqk', qi, k_ctx, preferred_element_type=f32) * scale
        s_sink = jnp.broadcast_to(sink_f[None, :, :, None, None], s_loc.shape[:-1] + (1,))
        p = jax.nn.softmax(jnp.concatenate([s_loc, s_ctx, s_sink], -1), -1)
        p_loc = p[..., :3 * QBLOCK].astype(vi.dtype)
        p_ctx = p[..., 3 * QBLOCK:3 * QBLOCK + n_ctx].astype(v_ctx.dtype)
        return (jnp.einsum('bhgqk,bkhe->bqhge', p_loc, vi)
                + jnp.einsum('bhgqk,bkhe->bqhge', p_ctx, v_ctx))

    out = lax.map(block, (jnp.arange(nb), qb, kb, vb))
    return jnp.moveaxis(out, 0, 1).reshape(b, s_len, hk, g, d)


def pool_mixer(u, w_pool, pool_scale):
    b, s_len, _ = u.shape
    uf = u.astype(f32).reshape(b, s_len, POOL_GROUPS, POOL_GC)
    cs = jnp.pad(jnp.cumsum(uf, axis=1), ((0, 0), (1, 0), (0, 0), (0, 0)))
    t = jnp.arange(s_len)
    outs = []
    for gi, w in enumerate(POOL_WINDOWS):
        lo = jnp.clip(t - w // 2, 0, s_len)
        hi = jnp.clip(t + w // 2, 0, s_len)
        cnt = (hi - lo).astype(f32)[None, :, None]
        csg = cs[:, :, gi]
        outs.append((csg[:, hi] - csg[:, lo]) / cnt - uf[:, :, gi])
    pooled = jnp.stack(outs, 2).astype(u.dtype)
    mixed = jnp.einsum('bsgc,gce->bsge', pooled, w_pool)
    return mixed.reshape(b, s_len, POOL_CH) * pool_scale


def mla_keys(c_kv, k_pe, w_ukv):
    b, s_len, _ = c_kv.shape
    kv = (c_kv @ w_ukv).reshape(b, s_len, MLA_HEADS, QK_NOPE + V_HEAD)
    k_pe_h = jnp.broadcast_to(k_pe[:, :, None, :], (b, s_len, MLA_HEADS, QK_ROPE))
    return jnp.concatenate([kv[..., :QK_NOPE], k_pe_h], -1), kv[..., QK_NOPE:]


def even_mixer(h, e, P, ctx):
    b, s_len, _ = h.shape
    proj = h @ P['w_in_even'][e]
    c_q, c_kv, k_pe, u_pool = jnp.split(proj, [Q_LORA, Q_LORA + KV_LORA, Q_LORA + KV_LORA + QK_ROPE], axis=-1)
    c_q = rms_norm(c_q, P['q_norm'][e])
    c_kv = rms_norm(c_kv, P['kv_norm'][e])
    q = (c_q @ P['w_uq'][e]).reshape(b, s_len, MLA_HEADS, QK_NOPE + QK_ROPE)
    w_ukv = P['w_ukv'][e]
    if ctx is None:
        k, v = mla_keys(c_kv, k_pe, w_ukv)
        new = (c_kv, k_pe)
    else:
        cos, sin = axial_rope_angles(s_len, QK_ROPE)
        q = jnp.concatenate([q[..., :QK_NOPE], apply_rope(q[..., QK_NOPE:], cos, sin)], -1)
        k_pe_rot = apply_rope(k_pe[:, :, None, :], cos, sin)[:, :, 0, :]
        k_lat, v_lat = mla_keys(c_kv, k_pe_rot, w_ukv)
        k_ctx, v_ctx = mla_keys(ctx[0], ctx[1], w_ukv)
        k = jnp.concatenate([k_lat, k_ctx], 1)
        v = jnp.concatenate([v_lat, v_ctx], 1)
        new = None
    attn = dense_attention(q[:, :, :, None, :], k, v)
    pooled = pool_mixer(u_pool, P['w_pool'][e], P['pool_scale'][e])
    mix = jnp.concatenate([attn.reshape(b, s_len, MLA_OUT), pooled], -1) @ P['w_out_even'][e]
    return mix, new


def odd_mixer(h, o, P, ctx):
    b, s_len, _ = h.shape
    proj = h @ P['w_in_odd'][o]
    q, k, v = jnp.split(proj, [ODD_MIX, ODD_MIX + SWA_KV * SWA_HD], axis=-1)
    q = q.reshape(b, s_len, SWA_KV, SWA_GROUP, SWA_HD)
    k = k.reshape(b, s_len, SWA_KV, SWA_HD)
    v = v.reshape(b, s_len, SWA_KV, SWA_HD)
    sink = P['sink'][o].reshape(SWA_KV, SWA_GROUP)
    if ctx is None:
        attn = dense_attention(q, k, v, sink)
        new = (k, v)
    else:
        cos, sin = axial_rope_angles(s_len, SWA_HD)
        attn = window_attention(apply_rope(q, cos, sin), apply_rope(k, cos, sin), v, ctx[0], ctx[1], sink)
        new = None
    return attn.reshape(b, s_len, ODD_MIX) @ P['w_out_odd'][o], new


def ec_moe(x, w_router, w_gate, w_up, w_down):
    b, n, _ = x.shape
    cap = max(1, CAP_FACTOR * n // N_EXPERTS)
    aff = jax.nn.softmax(jnp.einsum('bnd,de->bne', x, w_router, preferred_element_type=f32), -1)
    top_v, top_i = lax.top_k(jnp.swapaxes(aff, 1, 2), cap)
    b_idx = jnp.arange(b)[:, None, None]
    xs = x[b_idx, top_i]
    hid = jax.nn.silu(jnp.einsum('becd,edf->becf', xs, w_gate)) * jnp.einsum('becd,edf->becf', xs, w_up)
    y = jnp.einsum('becf,efd->becd', hid, w_down) * top_v[..., None].astype(x.dtype)
    return jnp.zeros_like(x).at[b_idx, top_i].add(y.astype(x.dtype))


def modulation(cond, w_ada, b_ada):
    m = (jax.nn.silu(cond) @ w_ada + b_ada)[:, None, :]
    return jnp.split(m, 6, axis=-1)


def run_trunk(x, cond, P, ctx_caches):
    ckv_l, kpe_l, k_l, v_l = [], [], [], []
    for l in range(DEPTH):
        sh1, sc1, g1, sh2, sc2, g2 = modulation(cond, P['w_ada'][l], P['b_ada'][l])
        h = x * (1 + sc1) + sh1
        if l % 2 == 0:
            e = l // 2
            ctx = None if ctx_caches is None else (ctx_caches[0][:, e], ctx_caches[1][:, e])
            mix, new = even_mixer(h, e, P, ctx)
            if new is not None:
                ckv_l.append(new[0])
                kpe_l.append(new[1])
        else:
            o = l // 2
            ctx = None if ctx_caches is None else (ctx_caches[2][:, o], ctx_caches[3][:, o])
            mix, new = odd_mixer(h, o, P, ctx)
            if new is not None:
                k_l.append(new[0])
                v_l.append(new[1])
        x = layer_norm(DN_ALPHA * x + g1 * mix, P['ln1_g'][l], P['ln1_b'][l])
        h = x * (1 + sc2) + sh2
        ffn = ec_moe(h, P['w_router'][l], P['w_gate'][l], P['w_up'][l], P['w_down'][l])
        x = layer_norm(DN_ALPHA * x + g2 * ffn, P['ln2_g'][l], P['ln2_b'][l])
    return x, (ckv_l, kpe_l, k_l, v_l)


def setup_inputs(seed: int = 0) -> dict:
    key = jax.random.key(seed)
    ks = iter(jax.random.split(key, 40))

    def nrm(shape, scale=1.0):
        return jax.random.normal(next(ks), shape, jnp.float32) * scale

    d = D_MODEL
    return {
        'x_prompt': nrm((BATCH, SEQ, d)),
        'x_sample': nrm((DEC_BATCH, DEC_SEQ, d)),
        'cache_mla_ckv': nrm((DEC_BATCH, N_EVEN, PAST_LEN, KV_LORA)),
        'cache_mla_kpe': nrm((DEC_BATCH, N_EVEN, PAST_LEN, QK_ROPE)),
        'cache_swa_k': nrm((DEC_BATCH, N_ODD, PAST_LEN, SWA_KV, SWA_HD)),
        'cache_swa_v': nrm((DEC_BATCH, N_ODD, PAST_LEN, SWA_KV, SWA_HD)),
        'c': nrm((DEC_BATCH, d)),
        'c_ctx': nrm((d,)),
        'w_ada': nrm((DEPTH, d, 6 * d), 0.5 * d ** -0.5),
        'b_ada': nrm((DEPTH, 6 * d), 0.02),
        'w_in_even': nrm((N_EVEN, d, EVEN_IN), d ** -0.5),
        'q_norm': 1.0 + nrm((N_EVEN, Q_LORA), 0.02),
        'kv_norm': 1.0 + nrm((N_EVEN, KV_LORA), 0.02),
        'w_uq': nrm((N_EVEN, Q_LORA, MLA_HEADS * (QK_NOPE + QK_ROPE)), Q_LORA ** -0.5),
        'w_ukv': nrm((N_EVEN, KV_LORA, MLA_HEADS * (QK_NOPE + V_HEAD)), KV_LORA ** -0.5),
        'w_pool': nrm((N_EVEN, POOL_GROUPS, POOL_GC, POOL_GC), POOL_GC ** -0.5),
        'pool_scale': 1.0 + nrm((N_EVEN, POOL_CH), 0.1),
        'w_out_even': nrm((N_EVEN, EVEN_MIX, d), DN_BETA * EVEN_MIX ** -0.5),
        'w_in_odd': nrm((N_ODD, d, ODD_IN), d ** -0.5),
        'sink': nrm((N_ODD, SWA_HEADS)),
        'w_out_odd': nrm((N_ODD, ODD_MIX, d), DN_BETA * ODD_MIX ** -0.5),
        'ln1_g': 1.0 + nrm((DEPTH, d), 0.02),
        'ln1_b': nrm((DEPTH, d), 0.02),
        'w_router': nrm((DEPTH, d, N_EXPERTS), d ** -0.5),
        'w_gate': nrm((DEPTH, N_EXPERTS, d, EXPERT_FF), d ** -0.5),
        'w_up': nrm((DEPTH, N_EXPERTS, d, EXPERT_FF), d ** -0.5),
        'w_down': nrm((DEPTH, N_EXPERTS, EXPERT_FF, d), DN_BETA * EXPERT_FF ** -0.5),
        'ln2_g': 1.0 + nrm((DEPTH, d), 0.02),
        'ln2_b': nrm((DEPTH, d), 0.02),
    }


def reference(x_prompt, x_sample, cache_mla_ckv, cache_mla_kpe, cache_swa_k, cache_swa_v, c, c_ctx,
              w_ada, b_ada, w_in_even, q_norm, kv_norm, w_uq, w_ukv, w_pool, pool_scale, w_out_even,
              w_in_odd, sink, w_out_odd, ln1_g, ln1_b, w_router, w_gate, w_up, w_down, ln2_g, ln2_b):
    P = {
        'w_ada': w_ada, 'b_ada': b_ada,
        'w_in_even': w_in_even, 'q_norm': q_norm, 'kv_norm': kv_norm, 'w_uq': w_uq, 'w_ukv': w_ukv,
        'w_pool': w_pool, 'pool_scale': pool_scale, 'w_out_even': w_out_even,
        'w_in_odd': w_in_odd, 'sink': sink, 'w_out_odd': w_out_odd,
        'ln1_g': ln1_g, 'ln1_b': ln1_b, 'ln2_g': ln2_g, 'ln2_b': ln2_b,
        'w_router': w_router, 'w_gate': w_gate, 'w_up': w_up, 'w_down': w_down,
    }
    y_prompt, (ckv_l, kpe_l, k_l, v_l) = run_trunk(x_prompt, c_ctx[None, :], P, None)
    new_mla_ckv = jnp.stack(ckv_l, axis=1)
    new_mla_kpe = jnp.stack(kpe_l, axis=1)
    new_swa_k = jnp.stack(k_l, axis=1)
    new_swa_v = jnp.stack(v_l, axis=1)
    y_sample, _ = run_trunk(x_sample, c, P, (cache_mla_ckv, cache_mla_kpe, cache_swa_k, cache_swa_v))
    return (y_prompt, y_sample, new_mla_ckv, new_mla_kpe, new_swa_k, new_swa_v)
```

```cpp
#include <hip/hip_runtime.h>
#include <cstdio>
#include <cstdint>
#include <utility>

constexpr int D = 2048, T_CTX = 4096, T = 12288, TC = 4096, TX = 16384;
constexpr int MODW = 12288, NCOND = 9;
constexpr int NSLOT = 1536, NXS = 16 * NSLOT;
constexpr float DN_ALPHA = 1.41421356237309515f;
constexpr float LOG2E = 1.44269504088896341f;
constexpr float QS_MLA = 0.07216878364870322f * LOG2E;
constexpr float QS_SWA = 0.125f * LOG2E;
constexpr int NTHREADS = 512, NWAVES = 8;

constexpr size_t O_Y = 0, O_CKV = 25165824, O_KPE = 26214400, O_SK = 26476544, O_SV = 27525120, O_END = 28573696;

constexpr size_t al256(size_t x) { return (x + 255) & ~(size_t)255; }
constexpr size_t WS_CTL = 0, CTL_BYTES = 1u << 20;
constexpr size_t WS_MOD = WS_CTL + CTL_BYTES;
constexpr size_t WS_ROPE = WS_MOD + al256((size_t)2 * 9 * 12288 * 4);
constexpr size_t WS_WINE = WS_ROPE + al256((size_t)2 * 1024 * 32 * 4);
constexpr size_t WS_W2 = WS_WINE + (size_t)2048 * 2048 * 2;
constexpr size_t WS_WOUTE = WS_W2 + (size_t)4608 * 512 * 2;
constexpr size_t WS_WINO = WS_WOUTE + (size_t)2048 * 2048 * 2;
constexpr size_t WS_WOUTO = WS_WINO + (size_t)2560 * 2048 * 2;
constexpr size_t WS_WGU = WS_WOUTO + (size_t)2048 * 2048 * 2;
constexpr size_t WS_WDN = WS_WGU + (size_t)32 * 4096 * 2048 * 2;
constexpr size_t WS_H = WS_WDN + (size_t)32 * 2048 * 2048 * 2;
constexpr size_t WS_PJ = WS_H + (size_t)T * 2048 * 2;
constexpr size_t WS_ACT2 = WS_PJ + (size_t)T * 1792 * 4;
constexpr size_t WS_KPE = WS_ACT2 + (size_t)TX * 1792 * 2;
constexpr size_t WS_Q = WS_KPE + (size_t)TX * 64 * 2;
constexpr size_t WS_KN = WS_Q + (size_t)T * 2048 * 2;
constexpr size_t WS_VT = WS_KN + (size_t)TX * 1024 * 2;
constexpr size_t WS_VTO = WS_VT + (size_t)1024 * TX * 2;
constexpr size_t WS_KO = WS_VTO + (size_t)256 * TX * 2;
constexpr size_t WS_MIX = WS_KO + (size_t)TX * 256 * 2;
constexpr size_t WS_Y = WS_MIX + (size_t)T * 2048 * 2;
constexpr size_t WS_X1 = WS_Y + (size_t)T * 2048 * 4;
constexpr size_t WS_XL = WS_X1 + (size_t)T * 2048 * 4;
constexpr size_t WS_AFF = WS_XL + (size_t)T * 2048 * 4;
constexpr size_t WS_INV = WS_AFF + (size_t)T * 16 * 4;
constexpr size_t WS_XS = WS_INV + (size_t)T * 16 * 4;
constexpr size_t WS_HID = WS_XS + (size_t)NXS * 2048 * 2;
constexpr size_t WS_YE = WS_HID + (size_t)NXS * 2048 * 2;
constexpr size_t WS_DBG = WS_YE + (size_t)NXS * 2048 * 2;
constexpr size_t WS_END = WS_DBG + (1u << 20);

typedef unsigned short bf16_t;
typedef float f32x4 __attribute__((ext_vector_type(4)));
typedef unsigned u32x4 __attribute__((ext_vector_type(4)));
typedef unsigned u32x2 __attribute__((ext_vector_type(2)));
#define LAS __attribute__((address_space(3)))
#define DI __device__ __forceinline__

struct Params {
    const float* in[29];
    float* out;
    unsigned char* ws;
    int ph_lo, ph_hi;
};

DI unsigned f2bf(float f) { unsigned u = __float_as_uint(f); return (u + 0x7fffu + ((u >> 16) & 1u)) >> 16; }
DI unsigned pk2(float lo, float hi) { return f2bf(lo) | (f2bf(hi) << 16); }
DI float bf2f(unsigned b) { return __uint_as_float(b << 16); }
DI float bflo(unsigned w) { return __uint_as_float(w << 16); }
DI float bfhi(unsigned w) { return __uint_as_float(w & 0xffff0000u); }
DI float wave_sum(float v) {
#pragma unroll
    for (int o = 1; o < 64; o <<= 1) v += __shfl_xor(v, o);
    return v;
}
DI float wave_max(float v) {
#pragma unroll
    for (int o = 1; o < 64; o <<= 1) v = fmaxf(v, __shfl_xor(v, o));
    return v;
}
DI int cond_of_row(int r) { return r < T_CTX ? 0 : 1 + ((r - T_CTX) >> 10); }
DI const float* xrow_in(const Params& p, int r) { return r < T_CTX ? p.in[0] + (size_t)r * D : p.in[1] + (size_t)(r - T_CTX) * D; }

DI float* ws_mod(const Params& p) { return (float*)(p.ws + WS_MOD); }
DI float* ws_cos(const Params& p) { return (float*)(p.ws + WS_ROPE); }
DI float* ws_sin(const Params& p) { return (float*)(p.ws + WS_ROPE) + 1024 * 32; }
template <class X> DI X* wsp(const Params& p, size_t off) { return (X*)(p.ws + off); }
DI const float* modp(const Params& p, int l, int ci, int j) { return ws_mod(p) + ((size_t)(l * 9 + ci) * MODW + (size_t)j * D); }


DI void ph_mod(const Params& p, unsigned char* lds_raw) {
    float* s_lds = (float*)lds_raw;
    float* red = s_lds + 9 * 2048;
    const int tid = threadIdx.x, lane = tid & 63, wave = tid >> 6;
    const float* c = p.in[6]; const float* c_ctx = p.in[7]; const float* w_ada = p.in[8]; const float* b_ada = p.in[9];
    for (int i = tid; i < 9 * 2048; i += NTHREADS) { const int ci = i >> 11, k = i & 2047; const float v = ci == 0 ? c_ctx[k] : c[(ci - 1) * 2048 + k]; s_lds[i] = v / (1.f + expf(-v)); }
    __syncthreads();
    float* MOD = ws_mod(p);
    for (int it = blockIdx.x; it < 384; it += gridDim.x) {
        const int l = it / 192, c0 = (it % 192) * 64;
        const int kq = tid >> 4, cl = tid & 15;
        const float* w = w_ada + (size_t)l * 2048 * MODW + c0 + 4 * cl;
        float acc[9][4];
#pragma unroll
        for (int ci = 0; ci < 9; ++ci)
#pragma unroll
            for (int j = 0; j < 4; ++j) acc[ci][j] = 0.f;
#pragma unroll 8
        for (int kk = 0; kk < 64; ++kk) {
            const int k = kq * 64 + kk;
            const f32x4 wv = *(const f32x4*)(w + (size_t)k * MODW);
#pragma unroll
            for (int ci = 0; ci < 9; ++ci) { const float s = s_lds[ci * 2048 + k];
#pragma unroll
                for (int j = 0; j < 4; ++j) acc[ci][j] += s * wv[j]; }
        }
#pragma unroll
        for (int ci = 0; ci < 9; ++ci)
#pragma unroll
            for (int j = 0; j < 4; ++j) { float v = acc[ci][j]; v += __shfl_xor(v, 16); v += __shfl_xor(v, 32); acc[ci][j] = v; }
        if (lane < 16) {
#pragma unroll
            for (int ci = 0; ci < 9; ++ci)
#pragma unroll
                for (int j = 0; j < 4; ++j) red[(wave * 9 + ci) * 64 + 4 * cl + j] = acc[ci][j];
        }
        __syncthreads();
        for (int o = tid; o < 576; o += NTHREADS) { const int ci = o >> 6, cc = o & 63; float s = 0.f;
#pragma unroll
            for (int w8 = 0; w8 < 8; ++w8) s += red[(w8 * 9 + ci) * 64 + cc];
            MOD[(size_t)(l * 9 + ci) * MODW + c0 + cc] = s + b_ada[l * MODW + c0 + cc]; }
        __syncthreads();
    }
}

constexpr int CV_INE = 928, CV_UQ = 192, CV_UKV = 128, CV_POOL = 64, CV_OUT = 1024, CV_INO = 1280, CV_MOE = 98304;
constexpr int CV_TOTAL = CV_INE + CV_UQ + CV_UKV + CV_POOL + CV_OUT + CV_INO + CV_OUT + CV_MOE;
DI void cvt_item(const Params& p, int item, int lane) {
    const float* src; bf16_t* dst; int K, N, ldd, nb, kb, map = 0, a = 0;
    if (item < CV_INE) { src = p.in[10]; dst = wsp<bf16_t>(p, WS_WINE); K = 2048; N = 1856; ldd = 2048; nb = item % 29; kb = item / 29; map = 1; }
    else if ((item -= CV_INE) < CV_UQ) { src = p.in[13]; dst = wsp<bf16_t>(p, WS_W2); K = 512; N = 1536; ldd = 512; nb = item % 24; kb = item / 24; }
    else if ((item -= CV_UQ) < CV_UKV) { src = p.in[14]; dst = wsp<bf16_t>(p, WS_W2); K = 256; N = 2048; ldd = 512; nb = item % 32; kb = item / 32; map = 2; }
    else if ((item -= CV_UKV) < CV_POOL) { const int g = item >> 4, r = item & 15; src = p.in[15] + (size_t)g * 65536; dst = wsp<bf16_t>(p, WS_W2); K = 256; N = 256; ldd = 512; nb = r & 3; kb = r >> 2; a = 3584 + g * 256; }
    else if ((item -= CV_POOL) < CV_OUT) { src = p.in[17]; dst = wsp<bf16_t>(p, WS_WOUTE); K = 2048; N = 2048; ldd = 2048; nb = item & 31; kb = item >> 5; }
    else if ((item -= CV_OUT) < CV_INO) { src = p.in[18]; dst = wsp<bf16_t>(p, WS_WINO); K = 2048; N = 2560; ldd = 2048; nb = item % 40; kb = item / 40; }
    else if ((item -= CV_INO) < CV_OUT) { src = p.in[20]; dst = wsp<bf16_t>(p, WS_WOUTO); K = 2048; N = 2048; ldd = 2048; nb = item & 31; kb = item >> 5; }
    else { item -= CV_OUT; const int mat = item >> 10, w = item & 1023, le = mat / 3, kind = mat % 3; K = 2048; N = 2048; ldd = 2048; nb = w & 31; kb = w >> 5;
        src = p.in[24 + kind] + (size_t)le * 2048 * 2048;
        if (kind == 2) dst = wsp<bf16_t>(p, WS_WDN) + (size_t)le * 2048 * 2048; else { dst = wsp<bf16_t>(p, WS_WGU) + (size_t)le * 4096 * 2048; map = 3; a = kind * 128; } }
    const int n = nb * 64 + lane;
    const float* s = src + (size_t)(kb * 64) * N + n;
    float v[64];
#pragma unroll
    for (int k = 0; k < 64; ++k) v[k] = s[(size_t)k * N];
    int drow;
    if (map == 0) drow = n + a;
    else if (map == 1) drow = n < 768 ? n : (n < 832 ? 1792 + (n - 768) : 768 + (n - 832));
    else if (map == 2) { const int h = n >> 8, j = n & 255; drow = j < 128 ? 1536 + h * 128 + j : 2560 + h * 128 + (j - 128); }
    else drow = (n >> 7) * 256 + (n & 127) + a;
    u32x4* d = (u32x4*)(dst + (size_t)drow * ldd + kb * 64);
#pragma unroll
    for (int c8 = 0; c8 < 8; ++c8) { u32x4 o; o.x = pk2(v[8 * c8], v[8 * c8 + 1]); o.y = pk2(v[8 * c8 + 2], v[8 * c8 + 3]); o.z = pk2(v[8 * c8 + 4], v[8 * c8 + 5]); o.w = pk2(v[8 * c8 + 6], v[8 * c8 + 7]); d[c8] = o; }
}
DI void ph_convert(const Params& p, int item_lo, int item_hi) {
    const int lane = threadIdx.x & 63, gw = blockIdx.x * NWAVES + (threadIdx.x >> 6), NGW = gridDim.x * NWAVES;
    for (int it = item_lo + gw; it < item_hi; it += NGW) cvt_item(p, it, lane);
}

DI void ph_misc(const Params& p) {
    const size_t gt = (size_t)blockIdx.x * NTHREADS + threadIdx.x, NGT = (size_t)gridDim.x * NTHREADS;
    float* cosT = ws_cos(p); float* sinT = ws_sin(p);
    for (size_t i = gt; i < 1024 * 32; i += NGT) { const int s = (int)(i >> 5), f = (int)(i & 31);
        const float inv = powf(10000.f, -(float)(f & 15) / 16.f); const float pos = f < 16 ? (float)(s >> 6) : (float)(s & 63); const float ang = pos * inv;
        cosT[i] = cosf(ang); sinT[i] = sinf(ang); }
    bf16_t* ACT2 = wsp<bf16_t>(p, WS_ACT2); bf16_t* KPE = wsp<bf16_t>(p, WS_KPE); bf16_t* KO = wsp<bf16_t>(p, WS_KO); bf16_t* VTO = wsp<bf16_t>(p, WS_VTO);
    const float* cckv = p.in[2]; const float* ckpe = p.in[3]; const float* csk = p.in[4]; const float* csv = p.in[5];
    for (size_t i = gt; i < (size_t)TC * 256 / 4; i += NGT) { const size_t e = i * 4; const int j = (int)(e >> 8), cc = (int)(e & 255); const f32x4 v = *(const f32x4*)(cckv + e);
        u32x2 o; o.x = pk2(v[0], v[1]); o.y = pk2(v[2], v[3]); *(u32x2*)(ACT2 + (size_t)(T + j) * 1792 + 512 + cc) = o;
        const f32x4 k = *(const f32x4*)(csk + e); u32x2 o2; o2.x = pk2(k[0], k[1]); o2.y = pk2(k[2], k[3]); *(u32x2*)(KO + (size_t)(T + j) * 256 + cc) = o2; }
    for (size_t i = gt; i < (size_t)TC * 64 / 4; i += NGT) { const size_t e = i * 4; const f32x4 v = *(const f32x4*)(ckpe + e); u32x2 o; o.x = pk2(v[0], v[1]); o.y = pk2(v[2], v[3]); *(u32x2*)(KPE + (size_t)T * 64 + e) = o; }
    for (size_t i = gt; i < (size_t)256 * (TC / 8); i += NGT) { const int f = (int)(i / (TC / 8)), j8 = (int)(i % (TC / 8)) * 8; float v[8];
#pragma unroll
        for (int q = 0; q < 8; ++q) v[q] = csv[(size_t)(j8 + q) * 256 + f];
        u32x4 o; o.x = pk2(v[0], v[1]); o.y = pk2(v[2], v[3]); o.z = pk2(v[4], v[5]); o.w = pk2(v[6], v[7]); *(u32x4*)(VTO + (size_t)f * TX + T + j8) = o; }
}

DI void ph_h0(const Params& p) {
    const int lane = threadIdx.x & 63, gw = blockIdx.x * NWAVES + (threadIdx.x >> 6), NGW = gridDim.x * NWAVES;
    bf16_t* H = wsp<bf16_t>(p, WS_H);
    for (int r = gw; r < T; r += NGW) {
        const int ci = cond_of_row(r); const float* x = xrow_in(p, r); const float* sh = modp(p, 0, ci, 0); const float* sc = modp(p, 0, ci, 1);
#pragma unroll
        for (int j = 0; j < 8; ++j) { const int c0 = lane * 4 + 256 * j; const f32x4 v = *(const f32x4*)(x + c0), a = *(const f32x4*)(sc + c0), b = *(const f32x4*)(sh + c0);
            const f32x4 h = v * (1.f + a) + b; u32x2 o; o.x = pk2(h[0], h[1]); o.y = pk2(h[2], h[3]); *(u32x2*)(H + (size_t)r * D + c0) = o; }
    }
}

DI void ph_e1(const Params& p) {
    const int lane = threadIdx.x & 63, gw = blockIdx.x * NWAVES + (threadIdx.x >> 6), NGW = gridDim.x * NWAVES;
    const float* PJ = wsp<float>(p, WS_PJ); bf16_t* ACT2 = wsp<bf16_t>(p, WS_ACT2);
    const float* qn = p.in[11]; const float* kvn = p.in[12];
    for (int r = gw; r < T; r += NGW) {
        const float* pr = PJ + (size_t)r * 1792; bf16_t* ar = ACT2 + (size_t)r * 1792;
        {
            f32x4 v[2]; float ss = 0.f;
#pragma unroll
            for (int j = 0; j < 2; ++j) { v[j] = *(const f32x4*)(pr + lane * 4 + 256 * j); ss += (v[j][0] * v[j][0] + v[j][1] * v[j][1]) + (v[j][2] * v[j][2] + v[j][3] * v[j][3]); }
            const float rs = rsqrtf(wave_sum(ss) * (1.f / 512.f) + 1e-6f);
#pragma unroll
            for (int j = 0; j < 2; ++j) { const int c0 = lane * 4 + 256 * j; const f32x4 g = *(const f32x4*)(qn + c0); const f32x4 y = v[j] * rs * g; u32x2 o; o.x = pk2(y[0], y[1]); o.y = pk2(y[2], y[3]); *(u32x2*)(ar + c0) = o; }
        }
        {
            const int c0 = lane * 4; const f32x4 v = *(const f32x4*)(pr + 512 + c0); float ss = (v[0] * v[0] + v[1] * v[1]) + (v[2] * v[2] + v[3] * v[3]);
            const float rs = rsqrtf(wave_sum(ss) * (1.f / 256.f) + 1e-6f); const f32x4 g = *(const f32x4*)(kvn + c0); const f32x4 y = v * rs * g;
            u32x2 o; o.x = pk2(y[0], y[1]); o.y = pk2(y[2], y[3]); *(u32x2*)(ar + 512 + c0) = o;
            if (r < T_CTX) *(f32x4*)(p.out + O_CKV + (size_t)r * 256 + c0) = y;
        }
        {
            int s, S, rb; if (r < T_CTX) { s = r & 255; S = 256; rb = r - s; } else { s = (r - T_CTX) & 1023; S = 1024; rb = r - s; }
#pragma unroll
            for (int g = 0; g < 4; ++g) { const int half = 1 << g; const int lo = max(s - half, 0), hi = min(s + half, S); const int c0 = 768 + g * 256 + lane * 4;
                f32x4 sum = {0.f, 0.f, 0.f, 0.f};
                for (int t = lo; t < hi; ++t) sum += *(const f32x4*)(PJ + (size_t)(rb + t) * 1792 + c0);
                const f32x4 u = *(const f32x4*)(pr + c0); const f32x4 y = sum / (float)(hi - lo) - u;
                u32x2 o; o.x = pk2(y[0], y[1]); o.y = pk2(y[2], y[3]); *(u32x2*)(ar + c0) = o; }
        }
    }
}

DI void ph_ln1(const Params& p, int l, unsigned char* lds_raw) {
    const int tid = threadIdx.x, lane = tid & 63, gw = blockIdx.x * NWAVES + (tid >> 6), NGW = gridDim.x * NWAVES;
    float* wT = (float*)lds_raw;
    const float* wr = p.in[23] + (size_t)l * 2048 * 16;
    for (int i = tid; i < 2048 * 16; i += NTHREADS) { const int d = i >> 4, e = i & 15; wT[e * 2048 + d] = wr[i]; }
    __syncthreads();
    const float* Y = wsp<float>(p, WS_Y); float* X1 = wsp<float>(p, WS_X1); bf16_t* H = wsp<bf16_t>(p, WS_H); float* AFF = wsp<float>(p, WS_AFF);
    const float* lg = p.in[21] + l * D; const float* lb = p.in[22] + l * D;
    for (int r = gw; r < T; r += NGW) {
        const int ci = cond_of_row(r); const float* sh = modp(p, l, ci, 3); const float* sc = modp(p, l, ci, 4);
        f32x4 v[8]; float s = 0.f;
#pragma unroll
        for (int j = 0; j < 8; ++j) { v[j] = *(const f32x4*)(Y + (size_t)r * D + lane * 4 + 256 * j); s += (v[j][0] + v[j][1]) + (v[j][2] + v[j][3]); }
        const float mean = wave_sum(s) * (1.f / D); float s2 = 0.f;
#pragma unroll
        for (int j = 0; j < 8; ++j) { v[j] = v[j] - mean; s2 += (v[j][0] * v[j][0] + v[j][1] * v[j][1]) + (v[j][2] * v[j][2] + v[j][3] * v[j][3]); }
        const float rstd = rsqrtf(wave_sum(s2) * (1.f / D) + 1e-5f);
#pragma unroll
        for (int j = 0; j < 8; ++j) { const int c0 = lane * 4 + 256 * j; const f32x4 x1 = v[j] * rstd * *(const f32x4*)(lg + c0) + *(const f32x4*)(lb + c0);
            *(f32x4*)(X1 + (size_t)r * D + c0) = x1;
            const f32x4 h = x1 * (1.f + *(const f32x4*)(sc + c0)) + *(const f32x4*)(sh + c0); v[j] = h;
            u32x2 o; o.x = pk2(h[0], h[1]); o.y = pk2(h[2], h[3]); *(u32x2*)(H + (size_t)r * D + c0) = o; }
        float mine = -1e30f;
#pragma unroll 2
        for (int e = 0; e < 16; ++e) { float a = 0.f;
#pragma unroll
            for (int j = 0; j < 8; ++j) { const f32x4 w = *(const f32x4*)(wT + e * 2048 + lane * 4 + 256 * j); a += (v[j][0] * w[0] + v[j][1] * w[1]) + (v[j][2] * w[2] + v[j][3] * w[3]); }
            a = wave_sum(a); mine = (lane == e) ? a : mine; }
        const float m = wave_max(mine);
        const float ex = lane < 16 ? expf(mine - m) : 0.f;
        const float den = wave_sum(ex);
        mine = ex;
        if (lane < 16) AFF[(size_t)r * 16 + lane] = mine / den;
    }
}

DI void ph_topk(const Params& p, unsigned char* lds_raw) {
    const int tid = threadIdx.x, lane = tid & 63, wave = tid >> 6;
    float* vals = (float*)lds_raw;
    int* sel = (int*)(vals + 1024);
    const float* AFF = wsp<float>(p, WS_AFF); int* INV = wsp<int>(p, WS_INV); const bf16_t* H = wsp<bf16_t>(p, WS_H); bf16_t* XS = wsp<bf16_t>(p, WS_XS);
    for (int it = blockIdx.x; it < 384; it += gridDim.x) {
        int n, cap, r0, e, sb;
        if (it < 256) { const int b = it >> 4; e = it & 15; n = 256; cap = 32; r0 = b * 256; sb = b * 32; }
        else { const int q = it - 256, b = q >> 4; e = q & 15; n = 1024; cap = 128; r0 = T_CTX + b * 1024; sb = 512 + b * 128; }
        for (int i = tid; i < n; i += NTHREADS) vals[i] = AFF[(size_t)(r0 + i) * 16 + e];
        __syncthreads();
        for (int i = tid; i < n; i += NTHREADS) { const float vi = vals[i]; int cnt = 0;
            for (int j = 0; j < n; ++j) { const float vj = vals[j]; cnt += (vj > vi || (vj == vi && j < i)) ? 1 : 0; }
            if (cnt < cap) { sel[cnt] = i; INV[(size_t)(r0 + i) * 16 + e] = sb + cnt; } else INV[(size_t)(r0 + i) * 16 + e] = -1; }
        __syncthreads();
        for (int k = wave; k < cap; k += NWAVES) { const int r = r0 + sel[k]; const u32x4* src = (const u32x4*)(H + (size_t)r * D); u32x4* dst = (u32x4*)(XS + (size_t)(e * NSLOT + sb + k) * D);
#pragma unroll
            for (int j = 0; j < 4; ++j) dst[lane + 64 * j] = src[lane + 64 * j]; }
        __syncthreads();
    }
}

DI void ph_ln2(const Params& p, int l) {
    const int lane = threadIdx.x & 63, gw = blockIdx.x * NWAVES + (threadIdx.x >> 6), NGW = gridDim.x * NWAVES;
    const float* X1 = wsp<float>(p, WS_X1); const float* AFF = wsp<float>(p, WS_AFF); const int* INV = wsp<int>(p, WS_INV); const bf16_t* YE = wsp<bf16_t>(p, WS_YE);
    float* XL = wsp<float>(p, WS_XL); bf16_t* H = wsp<bf16_t>(p, WS_H);
    const float* lg = p.in[27] + l * D; const float* lb = p.in[28] + l * D;
    for (int r = gw; r < T; r += NGW) {
        const int ci = cond_of_row(r); const float* g2 = modp(p, l, ci, 5);
        f32x4 f[8];
#pragma unroll
        for (int j = 0; j < 8; ++j) f[j] = (f32x4){0.f, 0.f, 0.f, 0.f};
        for (int e = 0; e < 16; ++e) { const int slot = INV[(size_t)r * 16 + e]; if (slot < 0) continue; const float w = AFF[(size_t)r * 16 + e];
            const bf16_t* y = YE + (size_t)(e * NSLOT + slot) * D;
#pragma unroll
            for (int j = 0; j < 8; ++j) { const u32x2 q = *(const u32x2*)(y + lane * 4 + 256 * j); f[j][0] += w * bflo(q.x); f[j][1] += w * bfhi(q.x); f[j][2] += w * bflo(q.y); f[j][3] += w * bfhi(q.y); } }
        float s = 0.f;
#pragma unroll
        for (int j = 0; j < 8; ++j) { const int c0 = lane * 4 + 256 * j; f[j] = DN_ALPHA * *(const f32x4*)(X1 + (size_t)r * D + c0) + *(const f32x4*)(g2 + c0) * f[j]; s += (f[j][0] + f[j][1]) + (f[j][2] + f[j][3]); }
        const float mean = wave_sum(s) * (1.f / D); float s2 = 0.f;
#pragma unroll
        for (int j = 0; j < 8; ++j) { f[j] = f[j] - mean; s2 += (f[j][0] * f[j][0] + f[j][1] * f[j][1]) + (f[j][2] * f[j][2] + f[j][3] * f[j][3]); }
        const float rstd = rsqrtf(wave_sum(s2) * (1.f / D) + 1e-5f);
        const float* sh = modp(p, 1, ci, 0); const float* sc = modp(p, 1, ci, 1);
#pragma unroll
        for (int j = 0; j < 8; ++j) { const int c0 = lane * 4 + 256 * j; const f32x4 x = f[j] * rstd * *(const f32x4*)(lg + c0) + *(const f32x4*)(lb + c0);
            if (l == 0) { *(f32x4*)(XL + (size_t)r * D + c0) = x; const f32x4 h = x * (1.f + *(const f32x4*)(sc + c0)) + *(const f32x4*)(sh + c0);
                u32x2 o; o.x = pk2(h[0], h[1]); o.y = pk2(h[2], h[3]); *(u32x2*)(H + (size_t)r * D + c0) = o; }
            else *(f32x4*)(p.out + O_Y + (size_t)r * D + c0) = x; }
    }
}

struct Unit { const char* A; const char* B; unsigned lda, ldb; int nt; int pm, pn; int mode; int aux; };
DI int vcu_of(int bx, int G) { return (G % 8 == 0) ? (bx % 8) * (G / 8) + bx / 8 : bx; }

DI void rope8(const Params& p, int s, int pi0, float* v) {
    const f32x4 c = *(const f32x4*)(ws_cos(p) + s * 32 + pi0), sn = *(const f32x4*)(ws_sin(p) + s * 32 + pi0);
#pragma unroll
    for (int i = 0; i < 4; ++i) { const float x1 = v[2 * i], x2 = v[2 * i + 1]; v[2 * i] = x1 * c[i] - x2 * sn[i]; v[2 * i + 1] = x1 * sn[i] + x2 * c[i]; }
}
DI void st_bf16x8(bf16_t* dst, const float* v) { u32x4 w; w.x = pk2(v[0], v[1]); w.y = pk2(v[2], v[3]); w.z = pk2(v[4], v[5]); w.w = pk2(v[6], v[7]); *(u32x4*)dst = w; }
DI void st_f32x8(float* dst, const float* v) { *(f32x4*)dst = (f32x4){v[0], v[1], v[2], v[3]}; *(f32x4*)(dst + 4) = (f32x4){v[4], v[5], v[6], v[7]}; }

struct SchedInEven { const Params* p; int G, c;
    DI bool next(int i, Unit& u) const { const int L = i * G + c; if (L >= 48 * 8) return false; u.pm = L >> 3; u.pn = L & 7;
        u.A = (const char*)wsp<bf16_t>(*p, WS_H) + (size_t)u.pm * 256 * 4096; u.B = (const char*)wsp<bf16_t>(*p, WS_WINE) + (size_t)u.pn * 256 * 4096; u.lda = 4096; u.ldb = 4096; u.nt = 32; u.mode = 0; u.aux = 0; return true; } };
struct EpiInEven { static constexpr bool PAIR = false; const Params* p;
    DI void store(const Unit& u, int row, int col, float* v) const {
        const int r = u.pm * 256 + row, gc = u.pn * 256 + col;
        if (gc < 1792) { st_f32x8(wsp<float>(*p, WS_PJ) + (size_t)r * 1792 + gc, v); return; }
        if (gc >= 1856) return;
        const int j0 = gc - 1792;
        if (r < T_CTX) st_f32x8(p->out + O_KPE + (size_t)r * 64 + j0, v); else rope8(*p, (r - T_CTX) & 1023, j0 >> 1, v);
        st_bf16x8(wsp<bf16_t>(*p, WS_KPE) + (size_t)r * 64 + j0, v);
    } };

constexpr int E2_Q = 48 * 6, E2_K = 64 * 4, E2_V = 4 * 64, E2_P = 48 * 4, E2_TOTAL = E2_Q + E2_K + E2_V + E2_P;
struct SchedE2 { const Params* p; int G, c;
    DI bool next(int i, Unit& u) const { int L = i * G + c; if (L >= E2_TOTAL) return false;
        const char* ACT2 = (const char*)wsp<bf16_t>(*p, WS_ACT2); const char* W2 = (const char*)wsp<bf16_t>(*p, WS_W2); u.aux = 0;
        if (L < E2_Q) { u.mode = 0; u.pm = L / 6; u.pn = L % 6; u.A = ACT2 + (size_t)u.pm * 256 * 3584; u.lda = 3584; u.B = W2 + (size_t)u.pn * 256 * 1024; u.ldb = 1024; u.nt = 8; return true; }
        L -= E2_Q;
        if (L < E2_K) { u.mode = 1; u.pm = L >> 2; u.pn = L & 3; u.A = ACT2 + (size_t)u.pm * 256 * 3584 + 512 * 2; u.lda = 3584; u.B = W2 + (size_t)(1536 + u.pn * 256) * 1024; u.ldb = 1024; u.nt = 4; return true; }
        L -= E2_K;
        if (L < E2_V) { u.mode = 2; u.pm = L >> 6; u.pn = L & 63; u.A = W2 + (size_t)(2560 + u.pm * 256) * 1024; u.lda = 1024; u.B = ACT2 + (size_t)u.pn * 256 * 3584 + 512 * 2; u.ldb = 3584; u.nt = 4; return true; }
        L -= E2_V;
        u.mode = 3; u.pm = L >> 2; u.aux = L & 3; u.pn = 0; u.A = ACT2 + (size_t)u.pm * 256 * 3584 + (768 + u.aux * 256) * 2; u.lda = 3584; u.B = W2 + (size_t)(3584 + u.aux * 256) * 1024; u.ldb = 1024; u.nt = 4; return true; } };
struct EpiE2 { static constexpr bool PAIR = false; const Params* p;
    DI void store(const Unit& u, int row, int col, float* v) const {
        const int r = u.pm * 256 + row, gc = u.pn * 256 + col;
        if (u.mode == 0) { const int dd = gc % 192; if (dd >= 128 && r >= T_CTX) rope8(*p, (r - T_CTX) & 1023, (dd - 128) >> 1, v);
#pragma unroll
            for (int i = 0; i < 8; ++i) v[i] *= QS_MLA;
            st_bf16x8(wsp<bf16_t>(*p, WS_Q) + (size_t)r * 1536 + gc, v); }
        else if (u.mode == 1) st_bf16x8(wsp<bf16_t>(*p, WS_KN) + (size_t)r * 1024 + gc, v);
        else if (u.mode == 2) st_bf16x8(wsp<bf16_t>(*p, WS_VT) + (size_t)r * TX + gc, v);
        else { const float* ps = p->in[16] + u.aux * 256 + col;
#pragma unroll
            for (int i = 0; i < 8; ++i) v[i] *= ps[i];
            st_bf16x8(wsp<bf16_t>(*p, WS_MIX) + (size_t)r * 2048 + 1024 + u.aux * 256 + col, v); }
    } };

struct SchedOut { const Params* p; int G, c, l;
    DI bool next(int i, Unit& u) const { const int L = i * G + c; if (L >= 48 * 8) return false; u.pm = L >> 3; u.pn = L & 7;
        u.A = (const char*)wsp<bf16_t>(*p, WS_MIX) + (size_t)u.pm * 256 * 4096; u.B = (const char*)wsp<bf16_t>(*p, l == 0 ? WS_WOUTE : WS_WOUTO) + (size_t)u.pn * 256 * 4096; u.lda = 4096; u.ldb = 4096; u.nt = 32; u.mode = 0; u.aux = 0; return true; } };
struct EpiOut { static constexpr bool PAIR = false; const Params* p; int l;
    DI void store(const Unit& u, int row, int col, float* v) const {
        const int r = u.pm * 256 + row, gc = u.pn * 256 + col;
        const float* x = (l == 0 ? xrow_in(*p, r) : wsp<float>(*p, WS_XL) + (size_t)r * D) + gc; const float* g1 = modp(*p, l, cond_of_row(r), 2) + gc;
        const f32x4 x0 = *(const f32x4*)x, x1 = *(const f32x4*)(x + 4), g0 = *(const f32x4*)g1, g4 = *(const f32x4*)(g1 + 4);
#pragma unroll
        for (int i = 0; i < 4; ++i) { v[i] = DN_ALPHA * x0[i] + g0[i] * v[i]; v[4 + i] = DN_ALPHA * x1[i] + g4[i] * v[4 + i]; }
        st_f32x8(wsp<float>(*p, WS_Y) + (size_t)r * D + gc, v);
    } };

struct SchedGU { const Params* p; int G, c, l;
    DI bool next(int i, Unit& u) const { const int L = i * G + c; if (L >= 16 * 96) return false; const int e = L / 96, rem = L % 96; u.pn = rem / 6; u.pm = e * 6 + rem % 6; u.aux = e;
        u.A = (const char*)wsp<bf16_t>(*p, WS_XS) + (size_t)u.pm * 256 * 4096; u.B = (const char*)wsp<bf16_t>(*p, WS_WGU) + ((size_t)(l * 16 + e) * 4096 + (size_t)u.pn * 256) * 4096; u.lda = 4096; u.ldb = 4096; u.nt = 32; u.mode = 0; return true; } };
struct EpiGU { static constexpr bool PAIR = true; const Params* p;
    DI void store2(const Unit& u, int row, int col, const float* g, const float* up) const {
        float h[8];
#pragma unroll
        for (int i = 0; i < 8; ++i) h[i] = g[i] / (1.f + __expf(-g[i])) * up[i];
        st_bf16x8(wsp<bf16_t>(*p, WS_HID) + (size_t)(u.pm * 256 + row) * D + u.pn * 128 + col, h);
    } };

struct SchedDown { const Params* p; int G, c, l;
    DI bool next(int i, Unit& u) const { const int L = i * G + c; if (L >= 16 * 48) return false; const int e = L / 48, rem = L % 48; u.pn = rem / 6; u.pm = e * 6 + rem % 6; u.aux = e;
        u.A = (const char*)wsp<bf16_t>(*p, WS_HID) + (size_t)u.pm * 256 * 4096; u.B = (const char*)wsp<bf16_t>(*p, WS_WDN) + ((size_t)(l * 16 + e) * 2048 + (size_t)u.pn * 256) * 4096; u.lda = 4096; u.ldb = 4096; u.nt = 32; u.mode = 0; return true; } };
struct EpiDown { static constexpr bool PAIR = false; const Params* p;
    DI void store(const Unit& u, int row, int col, float* v) const { st_bf16x8(wsp<bf16_t>(*p, WS_YE) + (size_t)(u.pm * 256 + row) * D + u.pn * 256 + col, v); } };

constexpr int IO_QK = 48 * 9, IO_V = 16, IO_VT = 48, IO_TOTAL = IO_QK + IO_V + IO_VT;
struct SchedInOdd { const Params* p; int G, c;
    DI bool next(int i, Unit& u) const { int L = i * G + c; if (L >= IO_TOTAL) return false;
        const char* Hb = (const char*)wsp<bf16_t>(*p, WS_H); const char* W = (const char*)wsp<bf16_t>(*p, WS_WINO); u.aux = 0; u.nt = 32; u.lda = 4096; u.ldb = 4096;
        if (L < IO_QK) { u.mode = 0; u.pm = L / 9; u.pn = L % 9; u.A = Hb + (size_t)u.pm * 256 * 4096; u.B = W + (size_t)u.pn * 256 * 4096; return true; }
        L -= IO_QK;
        if (L < IO_V) { u.mode = 1; u.pm = L; u.pn = 9; u.A = Hb + (size_t)u.pm * 256 * 4096; u.B = W + (size_t)9 * 256 * 4096; return true; }
        L -= IO_V;
        u.mode = 2; u.pm = 0; u.pn = L; u.A = W + (size_t)9 * 256 * 4096; u.B = Hb + (size_t)u.pn * 256 * 4096; return true; } };
struct EpiInOdd { static constexpr bool PAIR = false; const Params* p;
    DI void store(const Unit& u, int row, int col, float* v) const {
        const int r = u.pm * 256 + row, gc = u.pn * 256 + col;
        if (u.mode == 0) {
            if (gc < 2048) { if (r >= T_CTX) rope8(*p, (r - T_CTX) & 1023, (gc & 63) >> 1, v);
#pragma unroll
                for (int i = 0; i < 8; ++i) v[i] *= QS_SWA;
                st_bf16x8(wsp<bf16_t>(*p, WS_Q) + (size_t)r * 2048 + gc, v); }
            else { const int kc = gc - 2048; if (r < T_CTX) st_f32x8(p->out + O_SK + (size_t)r * 256 + kc, v); else rope8(*p, (r - T_CTX) & 1023, (kc & 63) >> 1, v);
                st_bf16x8(wsp<bf16_t>(*p, WS_KO) + (size_t)r * 256 + kc, v); } }
        else if (u.mode == 1) st_f32x8(p->out + O_SV + (size_t)r * 256 + col, v);
        else st_bf16x8(wsp<bf16_t>(*p, WS_VTO) + (size_t)row * TX + gc, v);
    } };

template <class Sched, class Epi>
DI void naive_gemm(const Sched& S, const Epi& E, unsigned char* lds_raw) {
    float* As = (float*)lds_raw;
    float* Bs = As + 16 * 260;
    const int tid = threadIdx.x, ty = tid >> 4, tx = tid & 15;
    Unit u;
    for (int i = 0; S.next(i, u); ++i) {
        float acc[2][8][8];
#pragma unroll
        for (int h = 0; h < 2; ++h)
#pragma unroll
            for (int a = 0; a < 8; ++a)
#pragma unroll
                for (int b = 0; b < 8; ++b) acc[h][a][b] = 0.f;
        const int K = u.nt * 64;
        for (int k0 = 0; k0 < K; k0 += 16) {
            {
                const int row = tid >> 1, kh = (tid & 1) * 8;
                const u32x4 a = *(const u32x4*)(u.A + (size_t)row * u.lda + (size_t)(k0 + kh) * 2);
                const u32x4 b = *(const u32x4*)(u.B + (size_t)row * u.ldb + (size_t)(k0 + kh) * 2);
                As[(kh + 0) * 260 + row] = bflo(a.x); As[(kh + 1) * 260 + row] = bfhi(a.x); As[(kh + 2) * 260 + row] = bflo(a.y); As[(kh + 3) * 260 + row] = bfhi(a.y);
                As[(kh + 4) * 260 + row] = bflo(a.z); As[(kh + 5) * 260 + row] = bfhi(a.z); As[(kh + 6) * 260 + row] = bflo(a.w); As[(kh + 7) * 260 + row] = bfhi(a.w);
                Bs[(kh + 0) * 260 + row] = bflo(b.x); Bs[(kh + 1) * 260 + row] = bfhi(b.x); Bs[(kh + 2) * 260 + row] = bflo(b.y); Bs[(kh + 3) * 260 + row] = bfhi(b.y);
                Bs[(kh + 4) * 260 + row] = bflo(b.z); Bs[(kh + 5) * 260 + row] = bfhi(b.z); Bs[(kh + 6) * 260 + row] = bflo(b.w); Bs[(kh + 7) * 260 + row] = bfhi(b.w);
            }
            __syncthreads();
#pragma unroll 1
            for (int k = 0; k < 16; ++k) {
                float a[8], b[2][8];
#pragma unroll
                for (int q = 0; q < 8; ++q) { a[q] = As[k * 260 + ty * 8 + q]; b[0][q] = Bs[k * 260 + tx * 8 + q]; b[1][q] = Bs[k * 260 + 128 + tx * 8 + q]; }
#pragma unroll
                for (int h = 0; h < 2; ++h)
#pragma unroll
                    for (int x = 0; x < 8; ++x)
#pragma unroll
                        for (int y = 0; y < 8; ++y) acc[h][x][y] += a[x] * b[h][y];
            }
            __syncthreads();
        }
#pragma unroll
        for (int x = 0; x < 8; ++x) {
            if constexpr (Epi::PAIR) E.store2(u, ty * 8 + x, tx * 8, acc[0][x], acc[1][x]);
            else { E.store(u, ty * 8 + x, tx * 8, acc[0][x]); E.store(u, ty * 8 + x, 128 + tx * 8, acc[1][x]); }
        }
    }
}

template <bool SWA>
DI void naive_attn(const Params& p, unsigned char* lds_raw) {
    constexpr int DK = SWA ? 64 : 192, DV = SWA ? 64 : 128, NH = SWA ? 32 : 8, LDQ = SWA ? 2048 : 1536;
    const int tid = threadIdx.x, lane = tid & 63, wave = tid >> 6, gw = blockIdx.x * NWAVES + wave, NGW = gridDim.x * NWAVES;
    float* sc = (float*)lds_raw + wave * 1792;
    float* qs = sc + 1536;
    const bf16_t* Q = wsp<bf16_t>(p, WS_Q); const bf16_t* KN = wsp<bf16_t>(p, SWA ? WS_KO : WS_KN); const bf16_t* KPE = wsp<bf16_t>(p, WS_KPE);
    const bf16_t* VT = wsp<bf16_t>(p, SWA ? WS_VTO : WS_VT); bf16_t* MIX = wsp<bf16_t>(p, WS_MIX);
    for (int it = gw; it < T * NH; it += NGW) {
        const int r = it / NH, h = it % NH;
        for (int d = lane; d < DK; d += 64) qs[d] = bf2f(Q[(size_t)r * LDQ + h * DK + d]);
        int seg0[2], segn[2], nseg; int qpos = 0;
        if (r < T_CTX) { seg0[0] = r & ~255; segn[0] = 256; nseg = 1; }
        else { const int b = (r - T_CTX) >> 10, s = (r - T_CTX) & 1023, base = T_CTX + b * 1024; qpos = s;
            if (SWA) { const int lo = max(s - 128, 0), hi = min(s + 128, 1023); seg0[0] = base + lo; segn[0] = hi - lo + 1; } else { seg0[0] = base; segn[0] = 1024; }
            seg0[1] = T + b * 512; segn[1] = 512; nseg = 2; }
        const int kvh = SWA ? (h >> 3) : h;
        float m = SWA ? p.in[19][h] * LOG2E : -1e30f; int idx0 = 0;
        for (int sgi = 0; sgi < nseg; ++sgi) {
            for (int j = lane; j < segn[sgi]; j += 64) { const int key = seg0[sgi] + j; float dot = 0.f;
                if (SWA) { const bf16_t* kr = KN + (size_t)key * 256 + kvh * 64;
                    for (int d = 0; d < 64; d += 8) { const u32x4 w = *(const u32x4*)(kr + d); dot += qs[d] * bflo(w.x) + qs[d + 1] * bfhi(w.x) + qs[d + 2] * bflo(w.y) + qs[d + 3] * bfhi(w.y) + qs[d + 4] * bflo(w.z) + qs[d + 5] * bfhi(w.z) + qs[d + 6] * bflo(w.w) + qs[d + 7] * bfhi(w.w); } }
                else { const bf16_t* kr = KN + (size_t)key * 1024 + h * 128;
                    for (int d = 0; d < 128; d += 8) { const u32x4 w = *(const u32x4*)(kr + d); dot += qs[d] * bflo(w.x) + qs[d + 1] * bfhi(w.x) + qs[d + 2] * bflo(w.y) + qs[d + 3] * bfhi(w.y) + qs[d + 4] * bflo(w.z) + qs[d + 5] * bfhi(w.z) + qs[d + 6] * bflo(w.w) + qs[d + 7] * bfhi(w.w); }
                    const bf16_t* kp = KPE + (size_t)key * 64;
                    for (int d = 0; d < 64; d += 8) { const u32x4 w = *(const u32x4*)(kp + d); const float* q8 = qs + 128 + d; dot += q8[0] * bflo(w.x) + q8[1] * bfhi(w.x) + q8[2] * bflo(w.y) + q8[3] * bfhi(w.y) + q8[4] * bflo(w.z) + q8[5] * bfhi(w.z) + q8[6] * bflo(w.w) + q8[7] * bfhi(w.w); } }
                sc[idx0 + j] = dot; m = fmaxf(m, dot); }
            idx0 += segn[sgi]; }
        (void)qpos;
        m = wave_max(m);
        float l = 0.f;
        for (int j = lane; j < idx0; j += 64) { const float e = exp2f(sc[j] - m); sc[j] = e; l += e; }
        l = wave_sum(l); if (SWA) l += exp2f(p.in[19][h] * LOG2E - m);
        float o[2] = {0.f, 0.f}; idx0 = 0;
        for (int sgi = 0; sgi < nseg; ++sgi) {
#pragma unroll
            for (int f = 0; f < DV / 64; ++f) { const bf16_t* vr = VT + (size_t)(kvh * DV + lane + 64 * f) * TX + seg0[sgi]; float a = 0.f;
                for (int j = 0; j < segn[sgi]; ++j) a += sc[idx0 + j] * bf2f(vr[j]);
                o[f] += a; }
            idx0 += segn[sgi]; }
        const float inv = 1.f / l;
#pragma unroll
        for (int f = 0; f < DV / 64; ++f) MIX[(size_t)r * 2048 + h * DV + lane + 64 * f] = (bf16_t)f2bf(o[f] * inv);
    }
}

constexpr int LDS_BYTES = 147456;
constexpr int NPH = 20;
template <int PH> __global__ void __launch_bounds__(NTHREADS) k_ph(Params p) {
    extern __shared__ __attribute__((aligned(16))) unsigned char lds[];
    const int G = gridDim.x, c = vcu_of(blockIdx.x, G);
    if constexpr (PH == 0) { ph_mod(p, lds); ph_misc(p); ph_convert(p, 0, CV_TOTAL); }
    else if constexpr (PH == 1) ph_h0(p);
    else if constexpr (PH == 2) { SchedInEven S{&p, G, c}; EpiInEven E{&p}; naive_gemm(S, E, lds); }
    else if constexpr (PH == 3) ph_e1(p);
    else if constexpr (PH == 4) { SchedE2 S{&p, G, c}; EpiE2 E{&p}; naive_gemm(S, E, lds); }
    else if constexpr (PH == 5) naive_attn<false>(p, lds);
    else if constexpr (PH == 6 || PH == 14) { constexpr int l = PH == 6 ? 0 : 1; SchedOut S{&p, G, c, l}; EpiOut E{&p, l}; naive_gemm(S, E, lds); }
    else if constexpr (PH == 7 || PH == 15) ph_ln1(p, PH == 7 ? 0 : 1, lds);
    else if constexpr (PH == 8 || PH == 16) ph_topk(p, lds);
    else if constexpr (PH == 9 || PH == 17) { SchedGU S{&p, G, c, PH == 9 ? 0 : 1}; EpiGU E{&p}; naive_gemm(S, E, lds); }
    else if constexpr (PH == 10 || PH == 18) { SchedDown S{&p, G, c, PH == 10 ? 0 : 1}; EpiDown E{&p}; naive_gemm(S, E, lds); }
    else if constexpr (PH == 11 || PH == 19) ph_ln2(p, PH == 11 ? 0 : 1);
    else if constexpr (PH == 12) { SchedInOdd S{&p, G, c}; EpiInOdd E{&p}; naive_gemm(S, E, lds); }
    else if constexpr (PH == 13) naive_attn<true>(p, lds);
}
typedef void (*kfn_t)(Params);
template <int... I> static void fill_tab(kfn_t* t, std::integer_sequence<int, I...>) { ((t[I] = k_ph<I>), ...); }

extern "C" void kernel_launch(void* const* d_in, const int* in_sizes, int n_in, void* d_out, int out_size, void* d_ws, size_t ws_size, hipStream_t stream) {
    static int grid = 0; static kfn_t tab[NPH];
    if (grid == 0) {
        if (n_in != 29 || out_size != (int)O_END || ws_size < WS_END) { fprintf(stderr, "kernel_launch: unexpected shapes (n_in %d out %d ws %zu need %zu)\n", n_in, out_size, ws_size, (size_t)WS_END); grid = -1; return; }
        fill_tab(tab, std::make_integer_sequence<int, NPH>{});
        int dev = 0, cus = 0; hipGetDevice(&dev); hipDeviceGetAttribute(&cus, hipDeviceAttributeMultiprocessorCount, dev);
        for (int i = 0; i < NPH; ++i) if (hipFuncSetAttribute((const void*)tab[i], hipFuncAttributeMaxDynamicSharedMemorySize, LDS_BYTES) != hipSuccess) { fprintf(stderr, "hipFuncSetAttribute failed\n"); grid = -1; return; }
        grid = cus > 0 ? cus : 256;
    }
    if (grid < 0) return;
    Params p{};
    for (int i = 0; i < 29; ++i) p.in[i] = (const float*)d_in[i];
    p.out = (float*)d_out; p.ws = (unsigned char*)d_ws; p.ph_lo = 0; p.ph_hi = NPH;
    hipMemsetAsync((char*)d_ws + WS_CTL, 0, CTL_BYTES, stream);
    for (int i = 0; i < NPH; ++i) hipLaunchKernelGGL(tab[i], dim3(grid), dim3(NTHREADS), LDS_BYTES, stream, p);
}
```

```cpp
#include <hip/hip_runtime.h>
#include <cstdio>
#include <cstdint>

constexpr int D = 2048, T_CTX = 4096, T = 12288, TC = 4096, TX = 16384;
constexpr int MODW = 12288, NCOND = 9;
constexpr int NSLOT = 1536, NXS = 16 * NSLOT;
constexpr float DN_ALPHA = 1.41421356237309515f;
constexpr float LOG2E = 1.44269504088896341f;
constexpr float QS_MLA = 0.07216878364870322f * LOG2E;
constexpr float QS_SWA = 0.125f * LOG2E;
constexpr int NTHREADS = 512, NWAVES = 8;

constexpr size_t O_Y = 0, O_CKV = 25165824, O_KPE = 26214400, O_SK = 26476544, O_SV = 27525120, O_END = 28573696;

constexpr size_t al256(size_t x) { return (x + 255) & ~(size_t)255; }
constexpr size_t WS_CTL = 0, CTL_BYTES = 1u << 20;
constexpr size_t WS_MOD = WS_CTL + CTL_BYTES;
constexpr size_t WS_ROPE = WS_MOD + al256((size_t)2 * 9 * 12288 * 4);
constexpr size_t WS_WINE = WS_ROPE + al256((size_t)2 * 1024 * 32 * 4);
constexpr size_t WS_W2 = WS_WINE + (size_t)2048 * 2048 * 2;
constexpr size_t WS_WOUTE = WS_W2 + (size_t)4608 * 512 * 2;
constexpr size_t WS_WINO = WS_WOUTE + (size_t)2048 * 2048 * 2;
constexpr size_t WS_WOUTO = WS_WINO + (size_t)2560 * 2048 * 2;
constexpr size_t WS_WGU = WS_WOUTO + (size_t)2048 * 2048 * 2;
constexpr size_t WS_WDN = WS_WGU + (size_t)32 * 4096 * 2048 * 2;
constexpr size_t WS_H = WS_WDN + (size_t)32 * 2048 * 2048 * 2;
constexpr size_t WS_PJ = WS_H + (size_t)T * 2048 * 2;
constexpr size_t WS_ACT2 = WS_PJ + (size_t)T * 1792 * 4;
constexpr size_t WS_KPE = WS_ACT2 + (size_t)TX * 1792 * 2;
constexpr size_t WS_Q = WS_KPE + (size_t)TX * 64 * 2;
constexpr size_t WS_KN = WS_Q + (size_t)T * 2048 * 2;
constexpr size_t WS_VT = WS_KN + (size_t)TX * 1024 * 2;
constexpr size_t WS_VTO = WS_VT + (size_t)1024 * TX * 2;
constexpr size_t WS_KO = WS_VTO + (size_t)256 * TX * 2;
constexpr size_t WS_MIX = WS_KO + (size_t)TX * 256 * 2;
constexpr size_t WS_Y = WS_MIX + (size_t)T * 2048 * 2;
constexpr size_t WS_X1 = WS_Y + (size_t)T * 2048 * 4;
constexpr size_t WS_XL = WS_X1 + (size_t)T * 2048 * 4;
constexpr size_t WS_AFF = WS_XL + (size_t)T * 2048 * 4;
constexpr size_t WS_INV = WS_AFF + (size_t)T * 16 * 4;
constexpr size_t WS_XS = WS_INV + (size_t)T * 16 * 4;
constexpr size_t WS_HID = WS_XS + (size_t)NXS * 2048 * 2;
constexpr size_t WS_YE = WS_HID + (size_t)NXS * 2048 * 2;
constexpr size_t WS_DBG = WS_YE + (size_t)NXS * 2048 * 2;
constexpr size_t WS_END = WS_DBG + (1u << 20);

typedef unsigned short bf16_t;
typedef float f32x4 __attribute__((ext_vector_type(4)));
typedef unsigned u32x4 __attribute__((ext_vector_type(4)));
typedef unsigned u32x2 __attribute__((ext_vector_type(2)));
#define LAS __attribute__((address_space(3)))
#define DI __device__ __forceinline__

struct Params {
    const float* in[29];
    float* out;
    unsigned char* ws;
    int ph_lo, ph_hi;
};

DI unsigned f2bf(float f) { unsigned u = __float_as_uint(f); return (u + 0x7fffu + ((u >> 16) & 1u)) >> 16; }
DI unsigned pk2(float lo, float hi) { return f2bf(lo) | (f2bf(hi) << 16); }
DI float bf2f(unsigned b) { return __uint_as_float(b << 16); }
DI float bflo(unsigned w) { return __uint_as_float(w << 16); }
DI float bfhi(unsigned w) { return __uint_as_float(w & 0xffff0000u); }
DI float wave_sum(float v) {
#pragma unroll
    for (int o = 1; o < 64; o <<= 1) v += __shfl_xor(v, o);
    return v;
}
DI float wave_max(float v) {
#pragma unroll
    for (int o = 1; o < 64; o <<= 1) v = fmaxf(v, __shfl_xor(v, o));
    return v;
}
DI int cond_of_row(int r) { return r < T_CTX ? 0 : 1 + ((r - T_CTX) >> 10); }
DI const float* xrow_in(const Params& p, int r) { return r < T_CTX ? p.in[0] + (size_t)r * D : p.in[1] + (size_t)(r - T_CTX) * D; }

DI float* ws_mod(const Params& p) { return (float*)(p.ws + WS_MOD); }
DI float* ws_cos(const Params& p) { return (float*)(p.ws + WS_ROPE); }
DI float* ws_sin(const Params& p) { return (float*)(p.ws + WS_ROPE) + 1024 * 32; }
template <class X> DI X* wsp(const Params& p, size_t off) { return (X*)(p.ws + off); }
DI const float* modp(const Params& p, int l, int ci, int j) { return ws_mod(p) + ((size_t)(l * 9 + ci) * MODW + (size_t)j * D); }

#define XB_TMO      128
#define XB_XCNT(j)  (256  + 64 * (j))
#define XB_XSUB(j)  (1280 + 64 * (j))
#define XB_XGEN(j)  (2304 + 64 * (j))
#define XB_TOP      3328
#define XB_TOPGEN   3392
#define XCD_BAR_WORDS 3456
#define XB_SPIN_CAP (1u << 18)

__device__ __forceinline__ unsigned xb_ld(unsigned* p)              { return __hip_atomic_load(p, __ATOMIC_RELAXED, __HIP_MEMORY_SCOPE_AGENT); }
__device__ __forceinline__ unsigned xb_add(unsigned* p, unsigned v) { return __hip_atomic_fetch_add(p, v, __ATOMIC_RELAXED, __HIP_MEMORY_SCOPE_AGENT); }
__device__ __forceinline__ unsigned xb_xcc_id() { return (unsigned)__builtin_amdgcn_s_getreg((3 << 11) | 20) & 0xFu; }
#define XB_SPIN(cond, bar) do { unsigned _sp = 0; while (cond) { __builtin_amdgcn_s_sleep(1); \
    if ((++_sp & 255u) == 0u) { if (xb_ld(&(bar)[XB_TMO])) break; if (_sp > XB_SPIN_CAP) { atomicAdd(&(bar)[XB_TMO], 1u); break; } } } } while (0)

struct XcdBarrier {
    unsigned* bar; unsigned x;
    volatile LAS unsigned* st;
};

__device__ __forceinline__ XcdBarrier xcd_barrier_post(unsigned* bar, volatile LAS unsigned* st) {
    XcdBarrier b; b.bar = bar; b.x = xb_xcc_id(); b.st = st;
    if (threadIdx.x == 0) (void)xb_add(&bar[XB_XCNT(b.x)], 1u);
    return b;
}
__device__ __forceinline__ void xcd_barrier_complete(unsigned* bar, unsigned x, unsigned& nloc, unsigned& nx) {
    const unsigned G = gridDim.x * gridDim.y * gridDim.z;
    unsigned sum, cnt, mine, sp = 0u;
    for (;;) {
        sum = 0u; cnt = 0u; mine = 0u;
#pragma unroll
        for (unsigned j = 0; j < 16; ++j) { const unsigned c = xb_ld(&bar[XB_XCNT(j)]); sum += c; cnt += (c > 0u) ? 1u : 0u; mine = (j == x) ? c : mine; }
        if (sum == G) break;
        __builtin_amdgcn_s_sleep(1);
        if ((++sp & 255u) == 0u) { if (xb_ld(&bar[XB_TMO])) break; if (sp > XB_SPIN_CAP) { atomicAdd(&bar[XB_TMO], 1u); break; } }
    }
    nloc = mine > 0u ? mine : 1u; nx = cnt > 0u ? cnt : 1u;
}

__device__ __forceinline__ void xcd_barrier(const XcdBarrier& b) {
    asm volatile("s_waitcnt vmcnt(0)" ::: "memory");
    __syncthreads();
    if (threadIdx.x == 0) {
        unsigned* bar = b.bar;
        __builtin_amdgcn_s_waitcnt(0);
        unsigned nloc = b.st[0], nx = b.st[1];
        if (nloc == 0u) { xcd_barrier_complete(bar, b.x, nloc, nx); b.st[0] = nloc; b.st[1] = nx; }
        const unsigned old = xb_add(&bar[XB_XSUB(b.x)], 1u);
        const unsigned gen = old / nloc;
        if (old + 1u == (gen + 1u) * nloc) {
            __builtin_amdgcn_fence(__ATOMIC_RELEASE, "agent");
            asm volatile("s_waitcnt vmcnt(0)" ::: "memory");
            const unsigned og = xb_add(&bar[XB_TOP], 1u);
            const unsigned tg = og / nx;
            if (og + 1u == (tg + 1u) * nx) xb_add(&bar[XB_TOPGEN], 1u);
            else XB_SPIN(xb_ld(&bar[XB_TOPGEN]) == tg, bar);
            __builtin_amdgcn_fence(__ATOMIC_ACQUIRE, "agent");
            xb_add(&bar[XB_XGEN(b.x)], 1u);
            asm volatile("s_waitcnt vmcnt(0)" ::: "memory");
        } else {
            XB_SPIN(xb_ld(&bar[XB_XGEN(b.x)]) == gen, bar);
            __builtin_amdgcn_fence(__ATOMIC_ACQUIRE, "agent");
            asm volatile("s_waitcnt vmcnt(0)" ::: "memory");
        }
    }
    __syncthreads();
}
constexpr int CW_BAR = 4096;


DI void ph_mod(const Params& p, unsigned char* lds_raw) {
    float* s_lds = (float*)lds_raw;
    float* red = s_lds + 9 * 2048;
    const int tid = threadIdx.x, lane = tid & 63, wave = tid >> 6;
    const float* c = p.in[6]; const float* c_ctx = p.in[7]; const float* w_ada = p.in[8]; const float* b_ada = p.in[9];
    for (int i = tid; i < 9 * 2048; i += NTHREADS) { const int ci = i >> 11, k = i & 2047; const float v = ci == 0 ? c_ctx[k] : c[(ci - 1) * 2048 + k]; s_lds[i] = v / (1.f + expf(-v)); }
    __syncthreads();
    float* MOD = ws_mod(p);
    for (int it = blockIdx.x; it < 384; it += gridDim.x) {
        const int l = it / 192, c0 = (it % 192) * 64;
        const int kq = tid >> 4, cl = tid & 15;
        const float* w = w_ada + (size_t)l * 2048 * MODW + c0 + 4 * cl;
        float acc[9][4];
#pragma unroll
        for (int ci = 0; ci < 9; ++ci)
#pragma unroll
            for (int j = 0; j < 4; ++j) acc[ci][j] = 0.f;
#pragma unroll 8
        for (int kk = 0; kk < 64; ++kk) {
            const int k = kq * 64 + kk;
            const f32x4 wv = *(const f32x4*)(w + (size_t)k * MODW);
#pragma unroll
            for (int ci = 0; ci < 9; ++ci) { const float s = s_lds[ci * 2048 + k];
#pragma unroll
                for (int j = 0; j < 4; ++j) acc[ci][j] += s * wv[j]; }
        }
#pragma unroll
        for (int ci = 0; ci < 9; ++ci)
#pragma unroll
            for (int j = 0; j < 4; ++j) { float v = acc[ci][j]; v += __shfl_xor(v, 16); v += __shfl_xor(v, 32); acc[ci][j] = v; }
        if (lane < 16) {
#pragma unroll
            for (int ci = 0; ci < 9; ++ci)
#pragma unroll
                for (int j = 0; j < 4; ++j) red[(wave * 9 + ci) * 64 + 4 * cl + j] = acc[ci][j];
        }
        __syncthreads();
        for (int o = tid; o < 576; o += NTHREADS) { const int ci = o >> 6, cc = o & 63; float s = 0.f;
#pragma unroll
            for (int w8 = 0; w8 < 8; ++w8) s += red[(w8 * 9 + ci) * 64 + cc];
            MOD[(size_t)(l * 9 + ci) * MODW + c0 + cc] = s + b_ada[l * MODW + c0 + cc]; }
        __syncthreads();
    }
}

constexpr int CV_INE = 928, CV_UQ = 192, CV_UKV = 128, CV_POOL = 64, CV_OUT = 1024, CV_INO = 1280, CV_MOE = 98304;
constexpr int CV_TOTAL = CV_INE + CV_UQ + CV_UKV + CV_POOL + CV_OUT + CV_INO + CV_OUT + CV_MOE;
DI void cvt_item(const Params& p, int item, int lane) {
    const float* src; bf16_t* dst; int K, N, ldd, nb, kb, map = 0, a = 0;
    if (item < CV_INE) { src = p.in[10]; dst = wsp<bf16_t>(p, WS_WINE); K = 2048; N = 1856; ldd = 2048; nb = item % 29; kb = item / 29; map = 1; }
    else if ((item -= CV_INE) < CV_UQ) { src = p.in[13]; dst = wsp<bf16_t>(p, WS_W2); K = 512; N = 1536; ldd = 512; nb = item % 24; kb = item / 24; }
    else if ((item -= CV_UQ) < CV_UKV) { src = p.in[14]; dst = wsp<bf16_t>(p, WS_W2); K = 256; N = 2048; ldd = 512; nb = item % 32; kb = item / 32; map = 2; }
    else if ((item -= CV_UKV) < CV_POOL) { const int g = item >> 4, r = item & 15; src = p.in[15] + (size_t)g * 65536; dst = wsp<bf16_t>(p, WS_W2); K = 256; N = 256; ldd = 512; nb = r & 3; kb = r >> 2; a = 3584 + g * 256; }
    else if ((item -= CV_POOL) < CV_OUT) { src = p.in[17]; dst = wsp<bf16_t>(p, WS_WOUTE); K = 2048; N = 2048; ldd = 2048; nb = item & 31; kb = item >> 5; }
    else if ((item -= CV_OUT) < CV_INO) { src = p.in[18]; dst = wsp<bf16_t>(p, WS_WINO); K = 2048; N = 2560; ldd = 2048; nb = item % 40; kb = item / 40; }
    else if ((item -= CV_INO) < CV_OUT) { src = p.in[20]; dst = wsp<bf16_t>(p, WS_WOUTO); K = 2048; N = 2048; ldd = 2048; nb = item & 31; kb = item >> 5; }
    else { item -= CV_OUT; const int mat = item >> 10, w = item & 1023, le = mat / 3, kind = mat % 3; K = 2048; N = 2048; ldd = 2048; nb = w & 31; kb = w >> 5;
        src = p.in[24 + kind] + (size_t)le * 2048 * 2048;
        if (kind == 2) dst = wsp<bf16_t>(p, WS_WDN) + (size_t)le * 2048 * 2048; else { dst = wsp<bf16_t>(p, WS_WGU) + (size_t)le * 4096 * 2048; map = 3; a = kind * 128; } }
    const int n = nb * 64 + lane;
    const float* s = src + (size_t)(kb * 64) * N + n;
    float v[64];
#pragma unroll
    for (int k = 0; k < 64; ++k) v[k] = s[(size_t)k * N];
    int drow;
    if (map == 0) drow = n + a;
    else if (map == 1) drow = n < 768 ? n : (n < 832 ? 1792 + (n - 768) : 768 + (n - 832));
    else if (map == 2) { const int h = n >> 8, j = n & 255; drow = j < 128 ? 1536 + h * 128 + j : 2560 + h * 128 + (j - 128); }
    else drow = (n >> 7) * 256 + (n & 127) + a;
    u32x4* d = (u32x4*)(dst + (size_t)drow * ldd + kb * 64);
#pragma unroll
    for (int c8 = 0; c8 < 8; ++c8) { u32x4 o; o.x = pk2(v[8 * c8], v[8 * c8 + 1]); o.y = pk2(v[8 * c8 + 2], v[8 * c8 + 3]); o.z = pk2(v[8 * c8 + 4], v[8 * c8 + 5]); o.w = pk2(v[8 * c8 + 6], v[8 * c8 + 7]); d[c8] = o; }
}
DI void ph_convert(const Params& p, int item_lo, int item_hi) {
    const int lane = threadIdx.x & 63, gw = blockIdx.x * NWAVES + (threadIdx.x >> 6), NGW = gridDim.x * NWAVES;
    for (int it = item_lo + gw; it < item_hi; it += NGW) cvt_item(p, it, lane);
}

DI void ph_misc(const Params& p) {
    const size_t gt = (size_t)blockIdx.x * NTHREADS + threadIdx.x, NGT = (size_t)gridDim.x * NTHREADS;
    float* cosT = ws_cos(p); float* sinT = ws_sin(p);
    for (size_t i = gt; i < 1024 * 32; i += NGT) { const int s = (int)(i >> 5), f = (int)(i & 31);
        const float inv = powf(10000.f, -(float)(f & 15) / 16.f); const float pos = f < 16 ? (float)(s >> 6) : (float)(s & 63); const float ang = pos * inv;
        cosT[i] = cosf(ang); sinT[i] = sinf(ang); }
    bf16_t* ACT2 = wsp<bf16_t>(p, WS_ACT2); bf16_t* KPE = wsp<bf16_t>(p, WS_KPE); bf16_t* KO = wsp<bf16_t>(p, WS_KO); bf16_t* VTO = wsp<bf16_t>(p, WS_VTO);
    const float* cckv = p.in[2]; const float* ckpe = p.in[3]; const float* csk = p.in[4]; const float* csv = p.in[5];
    for (size_t i = gt; i < (size_t)TC * 256 / 4; i += NGT) { const size_t e = i * 4; const int j = (int)(e >> 8), cc = (int)(e & 255); const f32x4 v = *(const f32x4*)(cckv + e);
        u32x2 o; o.x = pk2(v[0], v[1]); o.y = pk2(v[2], v[3]); *(u32x2*)(ACT2 + (size_t)(T + j) * 1792 + 512 + cc) = o;
        const f32x4 k = *(const f32x4*)(csk + e); u32x2 o2; o2.x = pk2(k[0], k[1]); o2.y = pk2(k[2], k[3]); *(u32x2*)(KO + (size_t)(T + j) * 256 + cc) = o2; }
    for (size_t i = gt; i < (size_t)TC * 64 / 4; i += NGT) { const size_t e = i * 4; const f32x4 v = *(const f32x4*)(ckpe + e); u32x2 o; o.x = pk2(v[0], v[1]); o.y = pk2(v[2], v[3]); *(u32x2*)(KPE + (size_t)T * 64 + e) = o; }
    for (size_t i = gt; i < (size_t)256 * (TC / 8); i += NGT) { const int f = (int)(i / (TC / 8)), j8 = (int)(i % (TC / 8)) * 8; float v[8];
#pragma unroll
        for (int q = 0; q < 8; ++q) v[q] = csv[(size_t)(j8 + q) * 256 + f];
        u32x4 o; o.x = pk2(v[0], v[1]); o.y = pk2(v[2], v[3]); o.z = pk2(v[4], v[5]); o.w = pk2(v[6], v[7]); *(u32x4*)(VTO + (size_t)f * TX + T + j8) = o; }
}

DI void ph_h0(const Params& p) {
    const int lane = threadIdx.x & 63, gw = blockIdx.x * NWAVES + (threadIdx.x >> 6), NGW = gridDim.x * NWAVES;
    bf16_t* H = wsp<bf16_t>(p, WS_H);
    for (int r = gw; r < T; r += NGW) {
        const int ci = cond_of_row(r); const float* x = xrow_in(p, r); const float* sh = modp(p, 0, ci, 0); const float* sc = modp(p, 0, ci, 1);
#pragma unroll
        for (int j = 0; j < 8; ++j) { const int c0 = lane * 4 + 256 * j; const f32x4 v = *(const f32x4*)(x + c0), a = *(const f32x4*)(sc + c0), b = *(const f32x4*)(sh + c0);
            const f32x4 h = v * (1.f + a) + b; u32x2 o; o.x = pk2(h[0], h[1]); o.y = pk2(h[2], h[3]); *(u32x2*)(H + (size_t)r * D + c0) = o; }
    }
}

DI void ph_e1(const Params& p) {
    const int lane = threadIdx.x & 63, gw = blockIdx.x * NWAVES + (threadIdx.x >> 6), NGW = gridDim.x * NWAVES;
    const float* PJ = wsp<float>(p, WS_PJ); bf16_t* ACT2 = wsp<bf16_t>(p, WS_ACT2);
    const float* qn = p.in[11]; const float* kvn = p.in[12];
    for (int r = gw; r < T; r += NGW) {
        const float* pr = PJ + (size_t)r * 1792; bf16_t* ar = ACT2 + (size_t)r * 1792;
        {
            f32x4 v[2]; float ss = 0.f;
#pragma unroll
            for (int j = 0; j < 2; ++j) { v[j] = *(const f32x4*)(pr + lane * 4 + 256 * j); ss += (v[j][0] * v[j][0] + v[j][1] * v[j][1]) + (v[j][2] * v[j][2] + v[j][3] * v[j][3]); }
            const float rs = rsqrtf(wave_sum(ss) * (1.f / 512.f) + 1e-6f);
#pragma unroll
            for (int j = 0; j < 2; ++j) { const int c0 = lane * 4 + 256 * j; const f32x4 g = *(const f32x4*)(qn + c0); const f32x4 y = v[j] * rs * g; u32x2 o; o.x = pk2(y[0], y[1]); o.y = pk2(y[2], y[3]); *(u32x2*)(ar + c0) = o; }
        }
        {
            const int c0 = lane * 4; const f32x4 v = *(const f32x4*)(pr + 512 + c0); float ss = (v[0] * v[0] + v[1] * v[1]) + (v[2] * v[2] + v[3] * v[3]);
            const float rs = rsqrtf(wave_sum(ss) * (1.f / 256.f) + 1e-6f); const f32x4 g = *(const f32x4*)(kvn + c0); const f32x4 y = v * rs * g;
            u32x2 o; o.x = pk2(y[0], y[1]); o.y = pk2(y[2], y[3]); *(u32x2*)(ar + 512 + c0) = o;
            if (r < T_CTX) *(f32x4*)(p.out + O_CKV + (size_t)r * 256 + c0) = y;
        }
        {
            int s, S, rb; if (r < T_CTX) { s = r & 255; S = 256; rb = r - s; } else { s = (r - T_CTX) & 1023; S = 1024; rb = r - s; }
#pragma unroll
            for (int g = 0; g < 4; ++g) { const int half = 1 << g; const int lo = max(s - half, 0), hi = min(s + half, S); const int c0 = 768 + g * 256 + lane * 4;
                f32x4 sum = {0.f, 0.f, 0.f, 0.f};
                for (int t = lo; t < hi; ++t) sum += *(const f32x4*)(PJ + (size_t)(rb + t) * 1792 + c0);
                const f32x4 u = *(const f32x4*)(pr + c0); const f32x4 y = sum / (float)(hi - lo) - u;
                u32x2 o; o.x = pk2(y[0], y[1]); o.y = pk2(y[2], y[3]); *(u32x2*)(ar + c0) = o; }
        }
    }
}

DI void ph_ln1(const Params& p, int l, unsigned char* lds_raw) {
    const int tid = threadIdx.x, lane = tid & 63, gw = blockIdx.x * NWAVES + (tid >> 6), NGW = gridDim.x * NWAVES;
    float* wT = (float*)lds_raw;
    const float* wr = p.in[23] + (size_t)l * 2048 * 16;
    for (int i = tid; i < 2048 * 16; i += NTHREADS) { const int d = i >> 4, e = i & 15; wT[e * 2048 + d] = wr[i]; }
    __syncthreads();
    const float* Y = wsp<float>(p, WS_Y); float* X1 = wsp<float>(p, WS_X1); bf16_t* H = wsp<bf16_t>(p, WS_H); float* AFF = wsp<float>(p, WS_AFF);
    const float* lg = p.in[21] + l * D; const float* lb = p.in[22] + l * D;
    for (int r = gw; r < T; r += NGW) {
        const int ci = cond_of_row(r); const float* sh = modp(p, l, ci, 3); const float* sc = modp(p, l, ci, 4);
        f32x4 v[8]; float s = 0.f;
#pragma unroll
        for (int j = 0; j < 8; ++j) { v[j] = *(const f32x4*)(Y + (size_t)r * D + lane * 4 + 256 * j); s += (v[j][0] + v[j][1]) + (v[j][2] + v[j][3]); }
        const float mean = wave_sum(s) * (1.f / D); float s2 = 0.f;
#pragma unroll
        for (int j = 0; j < 8; ++j) { v[j] = v[j] - mean; s2 += (v[j][0] * v[j][0] + v[j][1] * v[j][1]) + (v[j][2] * v[j][2] + v[j][3] * v[j][3]); }
        const float rstd = rsqrtf(wave_sum(s2) * (1.f / D) + 1e-5f);
#pragma unroll
        for (int j = 0; j < 8; ++j) { const int c0 = lane * 4 + 256 * j; const f32x4 x1 = v[j] * rstd * *(const f32x4*)(lg + c0) + *(const f32x4*)(lb + c0);
            *(f32x4*)(X1 + (size_t)r * D + c0) = x1;
            const f32x4 h = x1 * (1.f + *(const f32x4*)(sc + c0)) + *(const f32x4*)(sh + c0); v[j] = h;
            u32x2 o; o.x = pk2(h[0], h[1]); o.y = pk2(h[2], h[3]); *(u32x2*)(H + (size_t)r * D + c0) = o; }
        float mine = -1e30f;
#pragma unroll 2
        for (int e = 0; e < 16; ++e) { float a = 0.f;
#pragma unroll
            for (int j = 0; j < 8; ++j) { const f32x4 w = *(const f32x4*)(wT + e * 2048 + lane * 4 + 256 * j); a += (v[j][0] * w[0] + v[j][1] * w[1]) + (v[j][2] * w[2] + v[j][3] * w[3]); }
            a = wave_sum(a); mine = (lane == e) ? a : mine; }
        const float m = wave_max(mine);
        const float ex = lane < 16 ? expf(mine - m) : 0.f;
        const float den = wave_sum(ex);
        mine = ex;
        if (lane < 16) AFF[(size_t)r * 16 + lane] = mine / den;
    }
}

DI void ph_topk(const Params& p, unsigned char* lds_raw) {
    const int tid = threadIdx.x, lane = tid & 63, wave = tid >> 6;
    float* vals = (float*)lds_raw;
    int* sel = (int*)(vals + 1024);
    const float* AFF = wsp<float>(p, WS_AFF); int* INV = wsp<int>(p, WS_INV); const bf16_t* H = wsp<bf16_t>(p, WS_H); bf16_t* XS = wsp<bf16_t>(p, WS_XS);
    for (int it = blockIdx.x; it < 384; it += gridDim.x) {
        int n, cap, r0, e, sb;
        if (it < 256) { const int b = it >> 4; e = it & 15; n = 256; cap = 32; r0 = b * 256; sb = b * 32; }
        else { const int q = it - 256, b = q >> 4; e = q & 15; n = 1024; cap = 128; r0 = T_CTX + b * 1024; sb = 512 + b * 128; }
        for (int i = tid; i < n; i += NTHREADS) vals[i] = AFF[(size_t)(r0 + i) * 16 + e];
        __syncthreads();
        for (int i = tid; i < n; i += NTHREADS) { const float vi = vals[i]; int cnt = 0;
            for (int j = 0; j < n; ++j) { const float vj = vals[j]; cnt += (vj > vi || (vj == vi && j < i)) ? 1 : 0; }
            if (cnt < cap) { sel[cnt] = i; INV[(size_t)(r0 + i) * 16 + e] = sb + cnt; } else INV[(size_t)(r0 + i) * 16 + e] = -1; }
        __syncthreads();
        for (int k = wave; k < cap; k += NWAVES) { const int r = r0 + sel[k]; const u32x4* src = (const u32x4*)(H + (size_t)r * D); u32x4* dst = (u32x4*)(XS + (size_t)(e * NSLOT + sb + k) * D);
#pragma unroll
            for (int j = 0; j < 4; ++j) dst[lane + 64 * j] = src[lane + 64 * j]; }
        __syncthreads();
    }
}

DI void ph_ln2(const Params& p, int l) {
    const int lane = threadIdx.x & 63, gw = blockIdx.x * NWAVES + (threadIdx.x >> 6), NGW = gridDim.x * NWAVES;
    const float* X1 = wsp<float>(p, WS_X1); const float* AFF = wsp<float>(p, WS_AFF); const int* INV = wsp<int>(p, WS_INV); const bf16_t* YE = wsp<bf16_t>(p, WS_YE);
    float* XL = wsp<float>(p, WS_XL); bf16_t* H = wsp<bf16_t>(p, WS_H);
    const float* lg = p.in[27] + l * D; const float* lb = p.in[28] + l * D;
    for (int r = gw; r < T; r += NGW) {
        const int ci = cond_of_row(r); const float* g2 = modp(p, l, ci, 5);
        f32x4 f[8];
#pragma unroll
        for (int j = 0; j < 8; ++j) f[j] = (f32x4){0.f, 0.f, 0.f, 0.f};
        for (int e = 0; e < 16; ++e) { const int slot = INV[(size_t)r * 16 + e]; if (slot < 0) continue; const float w = AFF[(size_t)r * 16 + e];
            const bf16_t* y = YE + (size_t)(e * NSLOT + slot) * D;
#pragma unroll
            for (int j = 0; j < 8; ++j) { const u32x2 q = *(const u32x2*)(y + lane * 4 + 256 * j); f[j][0] += w * bflo(q.x); f[j][1] += w * bfhi(q.x); f[j][2] += w * bflo(q.y); f[j][3] += w * bfhi(q.y); } }
        float s = 0.f;
#pragma unroll
        for (int j = 0; j < 8; ++j) { const int c0 = lane * 4 + 256 * j; f[j] = DN_ALPHA * *(const f32x4*)(X1 + (size_t)r * D + c0) + *(const f32x4*)(g2 + c0) * f[j]; s += (f[j][0] + f[j][1]) + (f[j][2] + f[j][3]); }
        const float mean = wave_sum(s) * (1.f / D); float s2 = 0.f;
#pragma unroll
        for (int j = 0; j < 8; ++j) { f[j] = f[j] - mean; s2 += (f[j][0] * f[j][0] + f[j][1] * f[j][1]) + (f[j][2] * f[j][2] + f[j][3] * f[j][3]); }
        const float rstd = rsqrtf(wave_sum(s2) * (1.f / D) + 1e-5f);
        const float* sh = modp(p, 1, ci, 0); const float* sc = modp(p, 1, ci, 1);
#pragma unroll
        for (int j = 0; j < 8; ++j) { const int c0 = lane * 4 + 256 * j; const f32x4 x = f[j] * rstd * *(const f32x4*)(lg + c0) + *(const f32x4*)(lb + c0);
            if (l == 0) { *(f32x4*)(XL + (size_t)r * D + c0) = x; const f32x4 h = x * (1.f + *(const f32x4*)(sc + c0)) + *(const f32x4*)(sh + c0);
                u32x2 o; o.x = pk2(h[0], h[1]); o.y = pk2(h[2], h[3]); *(u32x2*)(H + (size_t)r * D + c0) = o; }
            else *(f32x4*)(p.out + O_Y + (size_t)r * D + c0) = x; }
    }
}

struct Unit { const char* A; const char* B; unsigned lda, ldb; int nt; int pm, pn; int mode; int aux; };
DI int vcu_of(int bx, int G) { return (G % 8 == 0) ? (bx % 8) * (G / 8) + bx / 8 : bx; }

DI void rope8(const Params& p, int s, int pi0, float* v) {
    const f32x4 c = *(const f32x4*)(ws_cos(p) + s * 32 + pi0), sn = *(const f32x4*)(ws_sin(p) + s * 32 + pi0);
#pragma unroll
    for (int i = 0; i < 4; ++i) { const float x1 = v[2 * i], x2 = v[2 * i + 1]; v[2 * i] = x1 * c[i] - x2 * sn[i]; v[2 * i + 1] = x1 * sn[i] + x2 * c[i]; }
}
DI void st_bf16x8(bf16_t* dst, const float* v) { u32x4 w; w.x = pk2(v[0], v[1]); w.y = pk2(v[2], v[3]); w.z = pk2(v[4], v[5]); w.w = pk2(v[6], v[7]); *(u32x4*)dst = w; }
DI void st_f32x8(float* dst, const float* v) { *(f32x4*)dst = (f32x4){v[0], v[1], v[2], v[3]}; *(f32x4*)(dst + 4) = (f32x4){v[4], v[5], v[6], v[7]}; }

struct SchedInEven { const Params* p; int G, c;
    DI bool next(int i, Unit& u) const { const int L = i * G + c; if (L >= 48 * 8) return false; u.pm = L >> 3; u.pn = L & 7;
        u.A = (const char*)wsp<bf16_t>(*p, WS_H) + (size_t)u.pm * 256 * 4096; u.B = (const char*)wsp<bf16_t>(*p, WS_WINE) + (size_t)u.pn * 256 * 4096; u.lda = 4096; u.ldb = 4096; u.nt = 32; u.mode = 0; u.aux = 0; return true; } };
struct EpiInEven { static constexpr bool PAIR = false; const Params* p;
    DI void store(const Unit& u, int row, int col, float* v) const {
        const int r = u.pm * 256 + row, gc = u.pn * 256 + col;
        if (gc < 1792) { st_f32x8(wsp<float>(*p, WS_PJ) + (size_t)r * 1792 + gc, v); return; }
        if (gc >= 1856) return;
        const int j0 = gc - 1792;
        if (r < T_CTX) st_f32x8(p->out + O_KPE + (size_t)r * 64 + j0, v); else rope8(*p, (r - T_CTX) & 1023, j0 >> 1, v);
        st_bf16x8(wsp<bf16_t>(*p, WS_KPE) + (size_t)r * 64 + j0, v);
    } };

constexpr int E2_Q = 48 * 6, E2_K = 64 * 4, E2_V = 4 * 64, E2_P = 48 * 4, E2_TOTAL = E2_Q + E2_K + E2_V + E2_P;
struct SchedE2 { const Params* p; int G, c;
    DI bool next(int i, Unit& u) const { int L = i * G + c; if (L >= E2_TOTAL) return false;
        const char* ACT2 = (const char*)wsp<bf16_t>(*p, WS_ACT2); const char* W2 = (const char*)wsp<bf16_t>(*p, WS_W2); u.aux = 0;
        if (L < E2_Q) { u.mode = 0; u.pm = L / 6; u.pn = L % 6; u.A = ACT2 + (size_t)u.pm * 256 * 3584; u.lda = 3584; u.B = W2 + (size_t)u.pn * 256 * 1024; u.ldb = 1024; u.nt = 8; return true; }
        L -= E2_Q;
        if (L < E2_K) { u.mode = 1; u.pm = L >> 2; u.pn = L & 3; u.A = ACT2 + (size_t)u.pm * 256 * 3584 + 512 * 2; u.lda = 3584; u.B = W2 + (size_t)(1536 + u.pn * 256) * 1024; u.ldb = 1024; u.nt = 4; return true; }
        L -= E2_K;
        if (L < E2_V) { u.mode = 2; u.pm = L >> 6; u.pn = L & 63; u.A = W2 + (size_t)(2560 + u.pm * 256) * 1024; u.lda = 1024; u.B = ACT2 + (size_t)u.pn * 256 * 3584 + 512 * 2; u.ldb = 3584; u.nt = 4; return true; }
        L -= E2_V;
        u.mode = 3; u.pm = L >> 2; u.aux = L & 3; u.pn = 0; u.A = ACT2 + (size_t)u.pm * 256 * 3584 + (768 + u.aux * 256) * 2; u.lda = 3584; u.B = W2 + (size_t)(3584 + u.aux * 256) * 1024; u.ldb = 1024; u.nt = 4; return true; } };
struct EpiE2 { static constexpr bool PAIR = false; const Params* p;
    DI void store(const Unit& u, int row, int col, float* v) const {
        const int r = u.pm * 256 + row, gc = u.pn * 256 + col;
        if (u.mode == 0) { const int dd = gc % 192; if (dd >= 128 && r >= T_CTX) rope8(*p, (r - T_CTX) & 1023, (dd - 128) >> 1, v);
#pragma unroll
            for (int i = 0; i < 8; ++i) v[i] *= QS_MLA;
            st_bf16x8(wsp<bf16_t>(*p, WS_Q) + (size_t)r * 1536 + gc, v); }
        else if (u.mode == 1) st_bf16x8(wsp<bf16_t>(*p, WS_KN) + (size_t)r * 1024 + gc, v);
        else if (u.mode == 2) st_bf16x8(wsp<bf16_t>(*p, WS_VT) + (size_t)r * TX + gc, v);
        else { const float* ps = p->in[16] + u.aux * 256 + col;
#pragma unroll
            for (int i = 0; i < 8; ++i) v[i] *= ps[i];
            st_bf16x8(wsp<bf16_t>(*p, WS_MIX) + (size_t)r * 2048 + 1024 + u.aux * 256 + col, v); }
    } };

struct SchedOut { const Params* p; int G, c, l;
    DI bool next(int i, Unit& u) const { const int L = i * G + c; if (L >= 48 * 8) return false; u.pm = L >> 3; u.pn = L & 7;
        u.A = (const char*)wsp<bf16_t>(*p, WS_MIX) + (size_t)u.pm * 256 * 4096; u.B = (const char*)wsp<bf16_t>(*p, l == 0 ? WS_WOUTE : WS_WOUTO) + (size_t)u.pn * 256 * 4096; u.lda = 4096; u.ldb = 4096; u.nt = 32; u.mode = 0; u.aux = 0; return true; } };
struct EpiOut { static constexpr bool PAIR = false; const Params* p; int l;
    DI void store(const Unit& u, int row, int col, float* v) const {
        const int r = u.pm * 256 + row, gc = u.pn * 256 + col;
        const float* x = (l == 0 ? xrow_in(*p, r) : wsp<float>(*p, WS_XL) + (size_t)r * D) + gc; const float* g1 = modp(*p, l, cond_of_row(r), 2) + gc;
        const f32x4 x0 = *(const f32x4*)x, x1 = *(const f32x4*)(x + 4), g0 = *(const f32x4*)g1, g4 = *(const f32x4*)(g1 + 4);
#pragma unroll
        for (int i = 0; i < 4; ++i) { v[i] = DN_ALPHA * x0[i] + g0[i] * v[i]; v[4 + i] = DN_ALPHA * x1[i] + g4[i] * v[4 + i]; }
        st_f32x8(wsp<float>(*p, WS_Y) + (size_t)r * D + gc, v);
    } };

struct SchedGU { const Params* p; int G, c, l;
    DI bool next(int i, Unit& u) const { const int L = i * G + c; if (L >= 16 * 96) return false; const int e = L / 96, rem = L % 96; u.pn = rem / 6; u.pm = e * 6 + rem % 6; u.aux = e;
        u.A = (const char*)wsp<bf16_t>(*p, WS_XS) + (size_t)u.pm * 256 * 4096; u.B = (const char*)wsp<bf16_t>(*p, WS_WGU) + ((size_t)(l * 16 + e) * 4096 + (size_t)u.pn * 256) * 4096; u.lda = 4096; u.ldb = 4096; u.nt = 32; u.mode = 0; return true; } };
struct EpiGU { static constexpr bool PAIR = true; const Params* p;
    DI void store2(const Unit& u, int row, int col, const float* g, const float* up) const {
        float h[8];
#pragma unroll
        for (int i = 0; i < 8; ++i) h[i] = g[i] / (1.f + __expf(-g[i])) * up[i];
        st_bf16x8(wsp<bf16_t>(*p, WS_HID) + (size_t)(u.pm * 256 + row) * D + u.pn * 128 + col, h);
    } };

struct SchedDown { const Params* p; int G, c, l;
    DI bool next(int i, Unit& u) const { const int L = i * G + c; if (L >= 16 * 48) return false; const int e = L / 48, rem = L % 48; u.pn = rem / 6; u.pm = e * 6 + rem % 6; u.aux = e;
        u.A = (const char*)wsp<bf16_t>(*p, WS_HID) + (size_t)u.pm * 256 * 4096; u.B = (const char*)wsp<bf16_t>(*p, WS_WDN) + ((size_t)(l * 16 + e) * 2048 + (size_t)u.pn * 256) * 4096; u.lda = 4096; u.ldb = 4096; u.nt = 32; u.mode = 0; return true; } };
struct EpiDown { static constexpr bool PAIR = false; const Params* p;
    DI void store(const Unit& u, int row, int col, float* v) const { st_bf16x8(wsp<bf16_t>(*p, WS_YE) + (size_t)(u.pm * 256 + row) * D + u.pn * 256 + col, v); } };

constexpr int IO_QK = 48 * 9, IO_V = 16, IO_VT = 48, IO_TOTAL = IO_QK + IO_V + IO_VT;
struct SchedInOdd { const Params* p; int G, c;
    DI bool next(int i, Unit& u) const { int L = i * G + c; if (L >= IO_TOTAL) return false;
        const char* Hb = (const char*)wsp<bf16_t>(*p, WS_H); const char* W = (const char*)wsp<bf16_t>(*p, WS_WINO); u.aux = 0; u.nt = 32; u.lda = 4096; u.ldb = 4096;
        if (L < IO_QK) { u.mode = 0; u.pm = L / 9; u.pn = L % 9; u.A = Hb + (size_t)u.pm * 256 * 4096; u.B = W + (size_t)u.pn * 256 * 4096; return true; }
        L -= IO_QK;
        if (L < IO_V) { u.mode = 1; u.pm = L; u.pn = 9; u.A = Hb + (size_t)u.pm * 256 * 4096; u.B = W + (size_t)9 * 256 * 4096; return true; }
        L -= IO_V;
        u.mode = 2; u.pm = 0; u.pn = L; u.A = W + (size_t)9 * 256 * 4096; u.B = Hb + (size_t)u.pn * 256 * 4096; return true; } };
struct EpiInOdd { static constexpr bool PAIR = false; const Params* p;
    DI void store(const Unit& u, int row, int col, float* v) const {
        const int r = u.pm * 256 + row, gc = u.pn * 256 + col;
        if (u.mode == 0) {
            if (gc < 2048) { if (r >= T_CTX) rope8(*p, (r - T_CTX) & 1023, (gc & 63) >> 1, v);
#pragma unroll
                for (int i = 0; i < 8; ++i) v[i] *= QS_SWA;
                st_bf16x8(wsp<bf16_t>(*p, WS_Q) + (size_t)r * 2048 + gc, v); }
            else { const int kc = gc - 2048; if (r < T_CTX) st_f32x8(p->out + O_SK + (size_t)r * 256 + kc, v); else rope8(*p, (r - T_CTX) & 1023, (kc & 63) >> 1, v);
                st_bf16x8(wsp<bf16_t>(*p, WS_KO) + (size_t)r * 256 + kc, v); } }
        else if (u.mode == 1) st_f32x8(p->out + O_SV + (size_t)r * 256 + col, v);
        else st_bf16x8(wsp<bf16_t>(*p, WS_VTO) + (size_t)row * TX + gc, v);
    } };

template <class Sched, class Epi>
DI void naive_gemm(const Sched& S, const Epi& E, unsigned char* lds_raw) {
    float* As = (float*)lds_raw;
    float* Bs = As + 16 * 260;
    const int tid = threadIdx.x, ty = tid >> 4, tx = tid & 15;
    Unit u;
    for (int i = 0; S.next(i, u); ++i) {
        float acc[2][8][8];
#pragma unroll
        for (int h = 0; h < 2; ++h)
#pragma unroll
            for (int a = 0; a < 8; ++a)
#pragma unroll
                for (int b = 0; b < 8; ++b) acc[h][a][b] = 0.f;
        const int K = u.nt * 64;
        for (int k0 = 0; k0 < K; k0 += 16) {
            {
                const int row = tid >> 1, kh = (tid & 1) * 8;
                const u32x4 a = *(const u32x4*)(u.A + (size_t)row * u.lda + (size_t)(k0 + kh) * 2);
                const u32x4 b = *(const u32x4*)(u.B + (size_t)row * u.ldb + (size_t)(k0 + kh) * 2);
                As[(kh + 0) * 260 + row] = bflo(a.x); As[(kh + 1) * 260 + row] = bfhi(a.x); As[(kh + 2) * 260 + row] = bflo(a.y); As[(kh + 3) * 260 + row] = bfhi(a.y);
                As[(kh + 4) * 260 + row] = bflo(a.z); As[(kh + 5) * 260 + row] = bfhi(a.z); As[(kh + 6) * 260 + row] = bflo(a.w); As[(kh + 7) * 260 + row] = bfhi(a.w);
                Bs[(kh + 0) * 260 + row] = bflo(b.x); Bs[(kh + 1) * 260 + row] = bfhi(b.x); Bs[(kh + 2) * 260 + row] = bflo(b.y); Bs[(kh + 3) * 260 + row] = bfhi(b.y);
                Bs[(kh + 4) * 260 + row] = bflo(b.z); Bs[(kh + 5) * 260 + row] = bfhi(b.z); Bs[(kh + 6) * 260 + row] = bflo(b.w); Bs[(kh + 7) * 260 + row] = bfhi(b.w);
            }
            __syncthreads();
#pragma unroll 1
            for (int k = 0; k < 16; ++k) {
                float a[8], b[2][8];
#pragma unroll
                for (int q = 0; q < 8; ++q) { a[q] = As[k * 260 + ty * 8 + q]; b[0][q] = Bs[k * 260 + tx * 8 + q]; b[1][q] = Bs[k * 260 + 128 + tx * 8 + q]; }
#pragma unroll
                for (int h = 0; h < 2; ++h)
#pragma unroll
                    for (int x = 0; x < 8; ++x)
#pragma unroll
                        for (int y = 0; y < 8; ++y) acc[h][x][y] += a[x] * b[h][y];
            }
            __syncthreads();
        }
#pragma unroll
        for (int x = 0; x < 8; ++x) {
            if constexpr (Epi::PAIR) E.store2(u, ty * 8 + x, tx * 8, acc[0][x], acc[1][x]);
            else { E.store(u, ty * 8 + x, tx * 8, acc[0][x]); E.store(u, ty * 8 + x, 128 + tx * 8, acc[1][x]); }
        }
    }
}

template <bool SWA>
DI void naive_attn(const Params& p, unsigned char* lds_raw) {
    constexpr int DK = SWA ? 64 : 192, DV = SWA ? 64 : 128, NH = SWA ? 32 : 8, LDQ = SWA ? 2048 : 1536;
    const int tid = threadIdx.x, lane = tid & 63, wave = tid >> 6, gw = blockIdx.x * NWAVES + wave, NGW = gridDim.x * NWAVES;
    float* sc = (float*)lds_raw + wave * 1792;
    float* qs = sc + 1536;
    const bf16_t* Q = wsp<bf16_t>(p, WS_Q); const bf16_t* KN = wsp<bf16_t>(p, SWA ? WS_KO : WS_KN); const bf16_t* KPE = wsp<bf16_t>(p, WS_KPE);
    const bf16_t* VT = wsp<bf16_t>(p, SWA ? WS_VTO : WS_VT); bf16_t* MIX = wsp<bf16_t>(p, WS_MIX);
    for (int it = gw; it < T * NH; it += NGW) {
        const int r = it / NH, h = it % NH;
        for (int d = lane; d < DK; d += 64) qs[d] = bf2f(Q[(size_t)r * LDQ + h * DK + d]);
        int seg0[2], segn[2], nseg; int qpos = 0;
        if (r < T_CTX) { seg0[0] = r & ~255; segn[0] = 256; nseg = 1; }
        else { const int b = (r - T_CTX) >> 10, s = (r - T_CTX) & 1023, base = T_CTX + b * 1024; qpos = s;
            if (SWA) { const int lo = max(s - 128, 0), hi = min(s + 128, 1023); seg0[0] = base + lo; segn[0] = hi - lo + 1; } else { seg0[0] = base; segn[0] = 1024; }
            seg0[1] = T + b * 512; segn[1] = 512; nseg = 2; }
        const int kvh = SWA ? (h >> 3) : h;
        float m = SWA ? p.in[19][h] * LOG2E : -1e30f; int idx0 = 0;
        for (int sgi = 0; sgi < nseg; ++sgi) {
            for (int j = lane; j < segn[sgi]; j += 64) { const int key = seg0[sgi] + j; float dot = 0.f;
                if (SWA) { const bf16_t* kr = KN + (size_t)key * 256 + kvh * 64;
                    for (int d = 0; d < 64; d += 8) { const u32x4 w = *(const u32x4*)(kr + d); dot += qs[d] * bflo(w.x) + qs[d + 1] * bfhi(w.x) + qs[d + 2] * bflo(w.y) + qs[d + 3] * bfhi(w.y) + qs[d + 4] * bflo(w.z) + qs[d + 5] * bfhi(w.z) + qs[d + 6] * bflo(w.w) + qs[d + 7] * bfhi(w.w); } }
                else { const bf16_t* kr = KN + (size_t)key * 1024 + h * 128;
                    for (int d = 0; d < 128; d += 8) { const u32x4 w = *(const u32x4*)(kr + d); dot += qs[d] * bflo(w.x) + qs[d + 1] * bfhi(w.x) + qs[d + 2] * bflo(w.y) + qs[d + 3] * bfhi(w.y) + qs[d + 4] * bflo(w.z) + qs[d + 5] * bfhi(w.z) + qs[d + 6] * bflo(w.w) + qs[d + 7] * bfhi(w.w); }
                    const bf16_t* kp = KPE + (size_t)key * 64;
                    for (int d = 0; d < 64; d += 8) { const u32x4 w = *(const u32x4*)(kp + d); const float* q8 = qs + 128 + d; dot += q8[0] * bflo(w.x) + q8[1] * bfhi(w.x) + q8[2] * bflo(w.y) + q8[3] * bfhi(w.y) + q8[4] * bflo(w.z) + q8[5] * bfhi(w.z) + q8[6] * bflo(w.w) + q8[7] * bfhi(w.w); } }
                sc[idx0 + j] = dot; m = fmaxf(m, dot); }
            idx0 += segn[sgi]; }
        (void)qpos;
        m = wave_max(m);
        float l = 0.f;
        for (int j = lane; j < idx0; j += 64) { const float e = exp2f(sc[j] - m); sc[j] = e; l += e; }
        l = wave_sum(l); if (SWA) l += exp2f(p.in[19][h] * LOG2E - m);
        float o[2] = {0.f, 0.f}; idx0 = 0;
        for (int sgi = 0; sgi < nseg; ++sgi) {
#pragma unroll
            for (int f = 0; f < DV / 64; ++f) { const bf16_t* vr = VT + (size_t)(kvh * DV + lane + 64 * f) * TX + seg0[sgi]; float a = 0.f;
                for (int j = 0; j < segn[sgi]; ++j) a += sc[idx0 + j] * bf2f(vr[j]);
                o[f] += a; }
            idx0 += segn[sgi]; }
        const float inv = 1.f / l;
#pragma unroll
        for (int f = 0; f < DV / 64; ++f) MIX[(size_t)r * 2048 + h * DV + lane + 64 * f] = (bf16_t)f2bf(o[f] * inv);
    }
}

constexpr int LDS_BYTES = 147456, MISC_OFF = 146432;
constexpr int NPH = 20;
__global__ void __launch_bounds__(NTHREADS, 2) mega(Params p) {
    extern __shared__ __attribute__((aligned(16))) unsigned char lds[];
    const int G = gridDim.x, c = vcu_of(blockIdx.x, G);
    volatile LAS unsigned* MISC = (volatile LAS unsigned*)((LAS unsigned char*)lds + MISC_OFF);
    if (threadIdx.x < 4) MISC[threadIdx.x] = 0u;
    __syncthreads();
    XcdBarrier bar = xcd_barrier_post((unsigned*)(p.ws + WS_CTL) + CW_BAR, MISC);
    const int lo = p.ph_lo, hi = p.ph_hi;
#define IN(k) (lo <= (k) && (k) < hi)
#define SEAM(k) do { if (IN(k) && IN((k) + 1)) xcd_barrier(bar); } while (0)
    if (IN(0)) { ph_mod(p, lds); ph_misc(p); ph_convert(p, 0, CV_TOTAL); } SEAM(0);
    if (IN(1)) ph_h0(p); SEAM(1);
    if (IN(2)) { SchedInEven S{&p, G, c}; EpiInEven E{&p}; naive_gemm(S, E, lds); } SEAM(2);
    if (IN(3)) ph_e1(p); SEAM(3);
    if (IN(4)) { SchedE2 S{&p, G, c}; EpiE2 E{&p}; naive_gemm(S, E, lds); } SEAM(4);
    if (IN(5)) naive_attn<false>(p, lds); SEAM(5);
    if (IN(6)) { SchedOut S{&p, G, c, 0}; EpiOut E{&p, 0}; naive_gemm(S, E, lds); } SEAM(6);
    if (IN(7)) ph_ln1(p, 0, lds); SEAM(7);
    if (IN(8)) ph_topk(p, lds); SEAM(8);
    if (IN(9)) { SchedGU S{&p, G, c, 0}; EpiGU E{&p}; naive_gemm(S, E, lds); } SEAM(9);
    if (IN(10)) { SchedDown S{&p, G, c, 0}; EpiDown E{&p}; naive_gemm(S, E, lds); } SEAM(10);
    if (IN(11)) ph_ln2(p, 0); SEAM(11);
    if (IN(12)) { SchedInOdd S{&p, G, c}; EpiInOdd E{&p}; naive_gemm(S, E, lds); } SEAM(12);
    if (IN(13)) naive_attn<true>(p, lds); SEAM(13);
    if (IN(14)) { SchedOut S{&p, G, c, 1}; EpiOut E{&p, 1}; naive_gemm(S, E, lds); } SEAM(14);
    if (IN(15)) ph_ln1(p, 1, lds); SEAM(15);
    if (IN(16)) ph_topk(p, lds); SEAM(16);
    if (IN(17)) { SchedGU S{&p, G, c, 1}; EpiGU E{&p}; naive_gemm(S, E, lds); } SEAM(17);
    if (IN(18)) { SchedDown S{&p, G, c, 1}; EpiDown E{&p}; naive_gemm(S, E, lds); } SEAM(18);
    if (IN(19)) ph_ln2(p, 1);
#undef IN
#undef SEAM
}

extern "C" void kernel_launch(void* const* d_in, const int* in_sizes, int n_in, void* d_out, int out_size, void* d_ws, size_t ws_size, hipStream_t stream) {
    static int grid = 0;
    if (grid == 0) {
        if (n_in != 29 || out_size != (int)O_END || ws_size < WS_END) { fprintf(stderr, "kernel_launch: unexpected shapes (n_in %d out %d ws %zu need %zu)\n", n_in, out_size, ws_size, (size_t)WS_END); grid = -1; return; }
        int dev = 0, cus = 0, per_cu = 0;
        if (hipGetDevice(&dev) != hipSuccess || hipDeviceGetAttribute(&cus, hipDeviceAttributeMultiprocessorCount, dev) != hipSuccess) { grid = -1; return; }
        if (hipFuncSetAttribute((const void*)mega, hipFuncAttributeMaxDynamicSharedMemorySize, LDS_BYTES) != hipSuccess) { fprintf(stderr, "hipFuncSetAttribute failed\n"); grid = -1; return; }
        if (hipOccupancyMaxActiveBlocksPerMultiprocessor(&per_cu, (const void*)mega, NTHREADS, LDS_BYTES) != hipSuccess || per_cu < 1) fprintf(stderr, "occupancy query: %d\n", per_cu);
        (void)hipGetLastError();
        grid = cus > 0 ? cus : 256;
    }
    if (grid < 0) return;
    Params p{};
    for (int i = 0; i < 29; ++i) p.in[i] = (const float*)d_in[i];
    p.out = (float*)d_out; p.ws = (unsigned char*)d_ws; p.ph_lo = 0; p.ph_hi = NPH;
    (void)hipMemsetAsync((char*)d_ws + WS_CTL, 0, CTL_BYTES, stream);
    hipLaunchKernelGGL(mega, dim3(grid), dim3(NTHREADS), LDS_BYTES, stream, p);
}
```

```cpp
#include <hip/hip_runtime.h>
#include <cstdio>
#include <cstdint>

constexpr int D = 2048, T_CTX = 4096, T = 12288, TC = 4096, TX = 16384;
constexpr int MODW = 12288, NCOND = 9;
constexpr int NSLOT = 1536, NXS = 16 * NSLOT;
constexpr float DN_ALPHA = 1.41421356237309515f;
constexpr float LOG2E = 1.44269504088896341f;
constexpr float QS_MLA = 0.07216878364870322f * LOG2E;
constexpr float QS_SWA = 0.125f * LOG2E;
constexpr int NTHREADS = 512, NWAVES = 8;

constexpr size_t O_Y = 0, O_CKV = 25165824, O_KPE = 26214400, O_SK = 26476544, O_SV = 27525120, O_END = 28573696;

constexpr size_t al256(size_t x) { return (x + 255) & ~(size_t)255; }
constexpr size_t WS_CTL = 0, CTL_BYTES = 1u << 20;
constexpr size_t WS_MOD = WS_CTL + CTL_BYTES;
constexpr size_t WS_ROPE = WS_MOD + al256((size_t)2 * 9 * 12288 * 4);
constexpr size_t WS_WINE = WS_ROPE + al256((size_t)2 * 1024 * 32 * 4);
constexpr size_t WS_W2 = WS_WINE + (size_t)2048 * 2048 * 2;
constexpr size_t WS_WOUTE = WS_W2 + (size_t)4608 * 1792 * 2;
constexpr size_t WS_WINO = WS_WOUTE + (size_t)2048 * 2048 * 2;
constexpr size_t WS_WOUTO = WS_WINO + (size_t)2560 * 2048 * 2;
constexpr size_t WS_WGU = WS_WOUTO + (size_t)2048 * 2048 * 2;
constexpr size_t WS_WDN = WS_WGU + (size_t)32 * 4096 * 2048 * 2;
constexpr size_t WS_H = WS_WDN + (size_t)32 * 2048 * 2048 * 2;
constexpr size_t WS_PJ = WS_H + (size_t)T * 2048 * 2;
constexpr size_t WS_ACT2 = WS_PJ + (size_t)T * 1792 * 4;
constexpr size_t WS_KPE = WS_ACT2 + (size_t)TX * 1792 * 2;
constexpr size_t WS_Q = WS_KPE + (size_t)TX * 64 * 2;
constexpr size_t WS_KN = WS_Q + (size_t)T * 2048 * 2;
constexpr size_t WS_VT = WS_KN + (size_t)TX * 1024 * 2;
constexpr size_t WS_VTO = WS_VT + (size_t)1024 * TX * 2;
constexpr size_t WS_KO = WS_VTO + (size_t)256 * TX * 2;
constexpr size_t WS_MIX = WS_KO + (size_t)TX * 256 * 2;
constexpr size_t WS_Y = WS_MIX + (size_t)T * 2048 * 2;
constexpr size_t WS_X1 = WS_Y + (size_t)T * 2048 * 4;
constexpr size_t WS_XL = WS_X1 + (size_t)T * 2048 * 4;
constexpr size_t WS_AFF = WS_XL + (size_t)T * 2048 * 4;
constexpr size_t WS_INV = WS_AFF + (size_t)T * 16 * 4;
constexpr size_t WS_XS = WS_INV + (size_t)T * 16 * 4;
constexpr size_t WS_HID = WS_XS + (size_t)NXS * 2048 * 2;
constexpr size_t WS_YE = WS_HID + (size_t)NXS * 2048 * 2;
constexpr size_t WS_DBG = WS_YE + (size_t)NXS * 2048 * 2;
constexpr size_t WS_END = WS_DBG + (1u << 20);

typedef unsigned short bf16_t;
typedef float f32x4 __attribute__((ext_vector_type(4)));
typedef unsigned u32x4 __attribute__((ext_vector_type(4)));
typedef unsigned u32x2 __attribute__((ext_vector_type(2)));
#define LAS __attribute__((address_space(3)))
#define DI __device__ __forceinline__

struct Params {
    const float* in[29];
    float* out;
    unsigned char* ws;
    int ph_lo, ph_hi;
};

DI unsigned f2bf(float f) { unsigned u = __float_as_uint(f); return (u + 0x7fffu + ((u >> 16) & 1u)) >> 16; }
DI unsigned pk2(float lo, float hi) { return f2bf(lo) | (f2bf(hi) << 16); }
DI float bf2f(unsigned b) { return __uint_as_float(b << 16); }
DI float bflo(unsigned w) { return __uint_as_float(w << 16); }
DI float bfhi(unsigned w) { return __uint_as_float(w & 0xffff0000u); }
DI float wave_sum(float v) {
#pragma unroll
    for (int o = 1; o < 64; o <<= 1) v += __shfl_xor(v, o);
    return v;
}
DI float wave_max(float v) {
#pragma unroll
    for (int o = 1; o < 64; o <<= 1) v = fmaxf(v, __shfl_xor(v, o));
    return v;
}
DI int cond_of_row(int r) { return r < T_CTX ? 0 : 1 + ((r - T_CTX) >> 10); }
DI const float* xrow_in(const Params& p, int r) { return r < T_CTX ? p.in[0] + (size_t)r * D : p.in[1] + (size_t)(r - T_CTX) * D; }

DI float* ws_mod(const Params& p) { return (float*)(p.ws + WS_MOD); }
DI float* ws_cos(const Params& p) { return (float*)(p.ws + WS_ROPE); }
DI float* ws_sin(const Params& p) { return (float*)(p.ws + WS_ROPE) + 1024 * 32; }
template <class X> DI X* wsp(const Params& p, size_t off) { return (X*)(p.ws + off); }
DI const float* modp(const Params& p, int l, int ci, int j) { return ws_mod(p) + ((size_t)(l * 9 + ci) * MODW + (size_t)j * D); }

#define XB_TMO      128
#define XB_XCNT(j)  (256  + 64 * (j))
#define XB_XSUB(j)  (1280 + 64 * (j))
#define XB_XGEN(j)  (2304 + 64 * (j))
#define XB_TOP      3328
#define XB_TOPGEN   3392
#define XCD_BAR_WORDS 3456
#define XB_SPIN_CAP (1u << 18)

__device__ __forceinline__ unsigned xb_ld(unsigned* p)              { return __hip_atomic_load(p, __ATOMIC_RELAXED, __HIP_MEMORY_SCOPE_AGENT); }
__device__ __forceinline__ unsigned xb_add(unsigned* p, unsigned v) { return __hip_atomic_fetch_add(p, v, __ATOMIC_RELAXED, __HIP_MEMORY_SCOPE_AGENT); }
__device__ __forceinline__ unsigned xb_xcc_id() { return (unsigned)__builtin_amdgcn_s_getreg((3 << 11) | 20) & 0xFu; }
#define XB_SPIN(cond, bar) do { unsigned _sp = 0; while (cond) { __builtin_amdgcn_s_sleep(1); \
    if ((++_sp & 255u) == 0u) { if (xb_ld(&(bar)[XB_TMO])) break; if (_sp > XB_SPIN_CAP) { atomicAdd(&(bar)[XB_TMO], 1u); break; } } } } while (0)

struct XcdBarrier {
    unsigned* bar; unsigned x;
    volatile LAS unsigned* st;
};

__device__ __forceinline__ XcdBarrier xcd_barrier_post(unsigned* bar, volatile LAS unsigned* st) {
    XcdBarrier b; b.bar = bar; b.x = xb_xcc_id(); b.st = st;
    if (threadIdx.x == 0) (void)xb_add(&bar[XB_XCNT(b.x)], 1u);
    return b;
}
__device__ __forceinline__ void xcd_barrier_complete(unsigned* bar, unsigned x, unsigned& nloc, unsigned& nx) {
    const unsigned G = gridDim.x * gridDim.y * gridDim.z;
    unsigned sum, cnt, mine, sp = 0u;
    for (;;) {
        sum = 0u; cnt = 0u; mine = 0u;
#pragma unroll
        for (unsigned j = 0; j < 16; ++j) { const unsigned c = xb_ld(&bar[XB_XCNT(j)]); sum += c; cnt += (c > 0u) ? 1u : 0u; mine = (j == x) ? c : mine; }
        if (sum == G) break;
        __builtin_amdgcn_s_sleep(1);
        if ((++sp & 255u) == 0u) { if (xb_ld(&bar[XB_TMO])) break; if (sp > XB_SPIN_CAP) { atomicAdd(&bar[XB_TMO], 1u); break; } }
    }
    nloc = mine > 0u ? mine : 1u; nx = cnt > 0u ? cnt : 1u;
}

__device__ __forceinline__ void xcd_barrier(const XcdBarrier& b) {
    asm volatile("s_waitcnt vmcnt(0)" ::: "memory");
    __syncthreads();
    if (threadIdx.x == 0) {
        unsigned* bar = b.bar;
        __builtin_amdgcn_s_waitcnt(0);
        unsigned nloc = b.st[0], nx = b.st[1];
        if (nloc == 0u) { xcd_barrier_complete(bar, b.x, nloc, nx); b.st[0] = nloc; b.st[1] = nx; }
        const unsigned old = xb_add(&bar[XB_XSUB(b.x)], 1u);
        const unsigned gen = old / nloc;
        if (old + 1u == (gen + 1u) * nloc) {
            __builtin_amdgcn_fence(__ATOMIC_RELEASE, "agent");
            asm volatile("s_waitcnt vmcnt(0)" ::: "memory");
            const unsigned og = xb_add(&bar[XB_TOP], 1u);
            const unsigned tg = og / nx;
            if (og + 1u == (tg + 1u) * nx) xb_add(&bar[XB_TOPGEN], 1u);
            else XB_SPIN(xb_ld(&bar[XB_TOPGEN]) == tg, bar);
            __builtin_amdgcn_fence(__ATOMIC_ACQUIRE, "agent");
            xb_add(&bar[XB_XGEN(b.x)], 1u);
            asm volatile("s_waitcnt vmcnt(0)" ::: "memory");
        } else {
            XB_SPIN(xb_ld(&bar[XB_XGEN(b.x)]) == gen, bar);
            __builtin_amdgcn_fence(__ATOMIC_ACQUIRE, "agent");
            asm volatile("s_waitcnt vmcnt(0)" ::: "memory");
        }
    }
    __syncthreads();
}
constexpr int CW_BAR = 4096;


DI void ph_mod(const Params& p, unsigned char* lds_raw) {
    float* s_lds = (float*)lds_raw;
    float* red = s_lds + 9 * 2048;
    const int tid = threadIdx.x, lane = tid & 63, wave = __builtin_amdgcn_readfirstlane(tid >> 6);
    const float* c = p.in[6]; const float* c_ctx = p.in[7]; const float* w_ada = p.in[8]; const float* b_ada = p.in[9];
    for (int i = tid; i < 9 * 2048; i += NTHREADS) { const int ci = i >> 11, k = i & 2047; const float v = ci == 0 ? c_ctx[k] : c[(ci - 1) * 2048 + k]; s_lds[i] = v / (1.f + expf(-v)); }
    __syncthreads();
    float* MOD = ws_mod(p);
    for (int it = blockIdx.x; it < 384; it += gridDim.x) {
        const int l = it / 192, c0 = (it % 192) * 64;
        const int kq = tid >> 4, cl = tid & 15;
        const float* w = w_ada + (size_t)l * 2048 * MODW + c0 + 4 * cl;
        float acc[9][4];
#pragma unroll
        for (int ci = 0; ci < 9; ++ci)
#pragma unroll
            for (int j = 0; j < 4; ++j) acc[ci][j] = 0.f;
#pragma unroll 8
        for (int kk = 0; kk < 64; ++kk) {
            const int k = kq * 64 + kk;
            const f32x4 wv = *(const f32x4*)(w + (size_t)k * MODW);
#pragma unroll
            for (int ci = 0; ci < 9; ++ci) { const float s = s_lds[ci * 2048 + k];
#pragma unroll
                for (int j = 0; j < 4; ++j) acc[ci][j] += s * wv[j]; }
        }
#pragma unroll
        for (int ci = 0; ci < 9; ++ci)
#pragma unroll
            for (int j = 0; j < 4; ++j) { float v = acc[ci][j]; v += __shfl_xor(v, 16); v += __shfl_xor(v, 32); acc[ci][j] = v; }
        if (lane < 16) {
#pragma unroll
            for (int ci = 0; ci < 9; ++ci)
#pragma unroll
                for (int j = 0; j < 4; ++j) red[(wave * 9 + ci) * 64 + 4 * cl + j] = acc[ci][j];
        }
        __syncthreads();
        for (int o = tid; o < 576; o += NTHREADS) { const int ci = o >> 6, cc = o & 63; float s = 0.f;
#pragma unroll
            for (int w8 = 0; w8 < 8; ++w8) s += red[(w8 * 9 + ci) * 64 + cc];
            MOD[(size_t)(l * 9 + ci) * MODW + c0 + cc] = s + b_ada[l * MODW + c0 + cc]; }
        __syncthreads();
    }
}

constexpr int CV_INE = 928, CV_UQ = 192, CV_UKV = 128, CV_POOL = 64, CV_OUT = 1024, CV_INO = 1280, CV_MOE = 98304;
constexpr int CV_TOTAL = CV_INE + CV_UQ + CV_UKV + CV_POOL + CV_OUT + CV_INO + CV_OUT + CV_MOE;
DI void cvt_item(const Params& p, int item, int lane) {
    const float* src; bf16_t* dst; int K, N, ldd, nb, kb, map = 0, a = 0;
    if (item < CV_INE) { src = p.in[10]; dst = wsp<bf16_t>(p, WS_WINE); K = 2048; N = 1856; ldd = 2048; nb = item % 29; kb = item / 29; map = 1; }
    else if ((item -= CV_INE) < CV_UQ) { src = p.in[13]; dst = wsp<bf16_t>(p, WS_W2); K = 512; N = 1536; ldd = 1792; nb = item % 24; kb = item / 24; }
    else if ((item -= CV_UQ) < CV_UKV) { src = p.in[14]; dst = wsp<bf16_t>(p, WS_W2); K = 256; N = 2048; ldd = 1792; nb = item % 32; kb = item / 32; map = 2; }
    else if ((item -= CV_UKV) < CV_POOL) { const int g = item >> 4, r = item & 15; src = p.in[15] + (size_t)g * 65536; dst = wsp<bf16_t>(p, WS_W2); K = 256; N = 256; ldd = 1792; nb = r & 3; kb = r >> 2; a = 3584 + g * 256; }
    else if ((item -= CV_POOL) < CV_OUT) { src = p.in[17]; dst = wsp<bf16_t>(p, WS_WOUTE); K = 2048; N = 2048; ldd = 2048; nb = item & 31; kb = item >> 5; }
    else if ((item -= CV_OUT) < CV_INO) { src = p.in[18]; dst = wsp<bf16_t>(p, WS_WINO); K = 2048; N = 2560; ldd = 2048; nb = item % 40; kb = item / 40; }
    else if ((item -= CV_INO) < CV_OUT) { src = p.in[20]; dst = wsp<bf16_t>(p, WS_WOUTO); K = 2048; N = 2048; ldd = 2048; nb = item & 31; kb = item >> 5; }
    else { item -= CV_OUT; const int mat = item >> 10, w = item & 1023, le = mat / 3, kind = mat % 3; K = 2048; N = 2048; ldd = 2048; nb = w & 31; kb = w >> 5;
        src = p.in[24 + kind] + (size_t)le * 2048 * 2048;
        if (kind == 2) dst = wsp<bf16_t>(p, WS_WDN) + (size_t)le * 2048 * 2048; else { dst = wsp<bf16_t>(p, WS_WGU) + (size_t)le * 4096 * 2048; map = 3; a = kind * 128; } }
    const int n = nb * 64 + lane;
    const float* s = src + (size_t)(kb * 64) * N + n;
    float v[64];
#pragma unroll
    for (int k = 0; k < 64; ++k) v[k] = s[(size_t)k * N];
    int drow;
    if (map == 0) drow = n + a;
    else if (map == 1) drow = n < 768 ? n : (n < 832 ? 1792 + (n - 768) : 768 + (n - 832));
    else if (map == 2) { const int h = n >> 8, j = n & 255; drow = j < 128 ? 1536 + h * 128 + j : 2560 + h * 128 + (j - 128); }
    else drow = (n >> 7) * 256 + (n & 127) + a;
    u32x4* d = (u32x4*)(dst + (size_t)drow * ldd + kb * 64);
#pragma unroll
    for (int c8 = 0; c8 < 8; ++c8) { u32x4 o; o.x = pk2(v[8 * c8], v[8 * c8 + 1]); o.y = pk2(v[8 * c8 + 2], v[8 * c8 + 3]); o.z = pk2(v[8 * c8 + 4], v[8 * c8 + 5]); o.w = pk2(v[8 * c8 + 6], v[8 * c8 + 7]); d[c8] = o; }
}
DI void ph_convert(const Params& p, int item_lo, int item_hi) {
    const int lane = threadIdx.x & 63, gw = blockIdx.x * NWAVES + __builtin_amdgcn_readfirstlane(threadIdx.x >> 6), NGW = gridDim.x * NWAVES;
    for (int it = item_lo + gw; it < item_hi; it += NGW) cvt_item(p, it, lane);
}

DI void ph_misc(const Params& p) {
    const size_t gt = (size_t)blockIdx.x * NTHREADS + threadIdx.x, NGT = (size_t)gridDim.x * NTHREADS;
    float* cosT = ws_cos(p); float* sinT = ws_sin(p);
    for (size_t i = gt; i < 1024 * 32; i += NGT) { const int s = (int)(i >> 5), f = (int)(i & 31);
        const float inv = powf(10000.f, -(float)(f & 15) / 16.f); const float pos = f < 16 ? (float)(s >> 6) : (float)(s & 63); const float ang = pos * inv;
        cosT[i] = cosf(ang); sinT[i] = sinf(ang); }
    bf16_t* ACT2 = wsp<bf16_t>(p, WS_ACT2); bf16_t* KPE = wsp<bf16_t>(p, WS_KPE); bf16_t* KO = wsp<bf16_t>(p, WS_KO); bf16_t* VTO = wsp<bf16_t>(p, WS_VTO);
    const float* cckv = p.in[2]; const float* ckpe = p.in[3]; const float* csk = p.in[4]; const float* csv = p.in[5];
    for (size_t i = gt; i < (size_t)TC * 256 / 4; i += NGT) { const size_t e = i * 4; const int j = (int)(e >> 8), cc = (int)(e & 255); const f32x4 v = *(const f32x4*)(cckv + e);
        u32x2 o; o.x = pk2(v[0], v[1]); o.y = pk2(v[2], v[3]); *(u32x2*)(ACT2 + (size_t)(T + j) * 1792 + 512 + cc) = o;
        const f32x4 k = *(const f32x4*)(csk + e); u32x2 o2; o2.x = pk2(k[0], k[1]); o2.y = pk2(k[2], k[3]); *(u32x2*)(KO + (size_t)(T + j) * 256 + cc) = o2; }
    for (size_t i = gt; i < (size_t)TC * 64 / 4; i += NGT) { const size_t e = i * 4; const f32x4 v = *(const f32x4*)(ckpe + e); u32x2 o; o.x = pk2(v[0], v[1]); o.y = pk2(v[2], v[3]); *(u32x2*)(KPE + (size_t)T * 64 + e) = o; }
    for (size_t i = gt; i < (size_t)256 * (TC / 8); i += NGT) { const int f = (int)(i / (TC / 8)), j8 = (int)(i % (TC / 8)) * 8; float v[8];
#pragma unroll
        for (int q = 0; q < 8; ++q) v[q] = csv[(size_t)(j8 + q) * 256 + f];
        u32x4 o; o.x = pk2(v[0], v[1]); o.y = pk2(v[2], v[3]); o.z = pk2(v[4], v[5]); o.w = pk2(v[6], v[7]); *(u32x4*)(VTO + (size_t)f * TX + T + j8) = o; }
}

DI void ph_h0(const Params& p) {
    const int lane = threadIdx.x & 63, gw = blockIdx.x * NWAVES + __builtin_amdgcn_readfirstlane(threadIdx.x >> 6), NGW = gridDim.x * NWAVES;
    bf16_t* H = wsp<bf16_t>(p, WS_H);
    for (int r = gw; r < T; r += NGW) {
        const int ci = cond_of_row(r); const float* x = xrow_in(p, r); const float* sh = modp(p, 0, ci, 0); const float* sc = modp(p, 0, ci, 1);
#pragma unroll
        for (int j = 0; j < 8; ++j) { const int c0 = lane * 4 + 256 * j; const f32x4 v = *(const f32x4*)(x + c0), a = *(const f32x4*)(sc + c0), b = *(const f32x4*)(sh + c0);
            const f32x4 h = v * (1.f + a) + b; u32x2 o; o.x = pk2(h[0], h[1]); o.y = pk2(h[2], h[3]); *(u32x2*)(H + (size_t)r * D + c0) = o; }
    }
}

DI void ph_e1(const Params& p) {
    const int lane = threadIdx.x & 63, gw = blockIdx.x * NWAVES + __builtin_amdgcn_readfirstlane(threadIdx.x >> 6), NGW = gridDim.x * NWAVES;
    const float* PJ = wsp<float>(p, WS_PJ); bf16_t* ACT2 = wsp<bf16_t>(p, WS_ACT2);
    const float* qn = p.in[11]; const float* kvn = p.in[12];
    for (int r = gw; r < T; r += NGW) {
        const float* pr = PJ + (size_t)r * 1792; bf16_t* ar = ACT2 + (size_t)r * 1792;
        {
            f32x4 v[2]; float ss = 0.f;
#pragma unroll
            for (int j = 0; j < 2; ++j) { v[j] = *(const f32x4*)(pr + lane * 4 + 256 * j); ss += (v[j][0] * v[j][0] + v[j][1] * v[j][1]) + (v[j][2] * v[j][2] + v[j][3] * v[j][3]); }
            const float rs = rsqrtf(wave_sum(ss) * (1.f / 512.f) + 1e-6f);
#pragma unroll
            for (int j = 0; j < 2; ++j) { const int c0 = lane * 4 + 256 * j; const f32x4 g = *(const f32x4*)(qn + c0); const f32x4 y = v[j] * rs * g; u32x2 o; o.x = pk2(y[0], y[1]); o.y = pk2(y[2], y[3]); *(u32x2*)(ar + c0) = o; }
        }
        {
            const int c0 = lane * 4; const f32x4 v = *(const f32x4*)(pr + 512 + c0); float ss = (v[0] * v[0] + v[1] * v[1]) + (v[2] * v[2] + v[3] * v[3]);
            const float rs = rsqrtf(wave_sum(ss) * (1.f / 256.f) + 1e-6f); const f32x4 g = *(const f32x4*)(kvn + c0); const f32x4 y = v * rs * g;
            u32x2 o; o.x = pk2(y[0], y[1]); o.y = pk2(y[2], y[3]); *(u32x2*)(ar + 512 + c0) = o;
            if (r < T_CTX) *(f32x4*)(p.out + O_CKV + (size_t)r * 256 + c0) = y;
        }
        {
            int s, S, rb; if (r < T_CTX) { s = r & 255; S = 256; rb = r - s; } else { s = (r - T_CTX) & 1023; S = 1024; rb = r - s; }
#pragma unroll
            for (int g = 0; g < 4; ++g) { const int half = 1 << g; const int lo = max(s - half, 0), hi = min(s + half, S); const int c0 = 768 + g * 256 + lane * 4;
                f32x4 sum = {0.f, 0.f, 0.f, 0.f};
                for (int t = lo; t < hi; ++t) sum += *(const f32x4*)(PJ + (size_t)(rb + t) * 1792 + c0);
                const f32x4 u = *(const f32x4*)(pr + c0); const f32x4 y = sum / (float)(hi - lo) - u;
                u32x2 o; o.x = pk2(y[0], y[1]); o.y = pk2(y[2], y[3]); *(u32x2*)(ar + c0) = o; }
        }
    }
}

DI void ph_ln1(const Params& p, int l, unsigned char* lds_raw) {
    const int tid = threadIdx.x, lane = tid & 63, gw = blockIdx.x * NWAVES + __builtin_amdgcn_readfirstlane(tid >> 6), NGW = gridDim.x * NWAVES;
    float* wT = (float*)lds_raw;
    const float* wr = p.in[23] + (size_t)l * 2048 * 16;
    for (int i = tid; i < 2048 * 16; i += NTHREADS) { const int d = i >> 4, e = i & 15; wT[e * 2048 + d] = wr[i]; }
    __syncthreads();
    const float* Y = wsp<float>(p, WS_Y); float* X1 = wsp<float>(p, WS_X1); bf16_t* H = wsp<bf16_t>(p, WS_H); float* AFF = wsp<float>(p, WS_AFF);
    const float* lg = p.in[21] + l * D; const float* lb = p.in[22] + l * D;
    for (int r = gw; r < T; r += NGW) {
        const int ci = cond_of_row(r); const float* sh = modp(p, l, ci, 3); const float* sc = modp(p, l, ci, 4);
        f32x4 v[8]; float s = 0.f;
#pragma unroll
        for (int j = 0; j < 8; ++j) { v[j] = *(const f32x4*)(Y + (size_t)r * D + lane * 4 + 256 * j); s += (v[j][0] + v[j][1]) + (v[j][2] + v[j][3]); }
        const float mean = wave_sum(s) * (1.f / D); float s2 = 0.f;
#pragma unroll
        for (int j = 0; j < 8; ++j) { v[j] = v[j] - mean; s2 += (v[j][0] * v[j][0] + v[j][1] * v[j][1]) + (v[j][2] * v[j][2] + v[j][3] * v[j][3]); }
        const float rstd = rsqrtf(wave_sum(s2) * (1.f / D) + 1e-5f);
#pragma unroll
        for (int j = 0; j < 8; ++j) { const int c0 = lane * 4 + 256 * j; const f32x4 x1 = v[j] * rstd * *(const f32x4*)(lg + c0) + *(const f32x4*)(lb + c0);
            *(f32x4*)(X1 + (size_t)r * D + c0) = x1;
            const f32x4 h = x1 * (1.f + *(const f32x4*)(sc + c0)) + *(const f32x4*)(sh + c0); v[j] = h;
            u32x2 o; o.x = pk2(h[0], h[1]); o.y = pk2(h[2], h[3]); *(u32x2*)(H + (size_t)r * D + c0) = o; }
        float mine = -1e30f;
#pragma unroll 2
        for (int e = 0; e < 16; ++e) { float a = 0.f;
#pragma unroll
            for (int j = 0; j < 8; ++j) { const f32x4 w = *(const f32x4*)(wT + e * 2048 + lane * 4 + 256 * j); a += (v[j][0] * w[0] + v[j][1] * w[1]) + (v[j][2] * w[2] + v[j][3] * w[3]); }
            a = wave_sum(a); mine = (lane == e) ? a : mine; }
        const float m = wave_max(mine);
        const float ex = lane < 16 ? expf(mine - m) : 0.f;
        const float den = wave_sum(ex);
        mine = ex;
        if (lane < 16) AFF[(size_t)r * 16 + lane] = mine / den;
    }
}

DI void ph_topk(const Params& p, unsigned char* lds_raw) {
    const int tid = threadIdx.x, lane = tid & 63, wave = __builtin_amdgcn_readfirstlane(tid >> 6);
    float* vals = (float*)lds_raw;
    int* sel = (int*)(vals + 1024);
    const float* AFF = wsp<float>(p, WS_AFF); int* INV = wsp<int>(p, WS_INV); const bf16_t* H = wsp<bf16_t>(p, WS_H); bf16_t* XS = wsp<bf16_t>(p, WS_XS);
    for (int it = blockIdx.x; it < 384; it += gridDim.x) {
        int n, cap, r0, e, sb;
        if (it < 256) { const int b = it >> 4; e = it & 15; n = 256; cap = 32; r0 = b * 256; sb = b * 32; }
        else { const int q = it - 256, b = q >> 4; e = q & 15; n = 1024; cap = 128; r0 = T_CTX + b * 1024; sb = 512 + b * 128; }
        for (int i = tid; i < n; i += NTHREADS) vals[i] = AFF[(size_t)(r0 + i) * 16 + e];
        __syncthreads();
        for (int i = tid; i < n; i += NTHREADS) { const float vi = vals[i]; int cnt = 0;
            for (int j = 0; j < n; ++j) { const float vj = vals[j]; cnt += (vj > vi || (vj == vi && j < i)) ? 1 : 0; }
            if (cnt < cap) { sel[cnt] = i; INV[(size_t)(r0 + i) * 16 + e] = sb + cnt; } else INV[(size_t)(r0 + i) * 16 + e] = -1; }
        __syncthreads();
        for (int k = wave; k < cap; k += NWAVES) { const int r = r0 + sel[k]; const u32x4* src = (const u32x4*)(H + (size_t)r * D); u32x4* dst = (u32x4*)(XS + (size_t)(e * NSLOT + sb + k) * D);
#pragma unroll
            for (int j = 0; j < 4; ++j) dst[lane + 64 * j] = src[lane + 64 * j]; }
        __syncthreads();
    }
}

DI void ph_ln2(const Params& p, int l) {
    const int lane = threadIdx.x & 63, gw = blockIdx.x * NWAVES + __builtin_amdgcn_readfirstlane(threadIdx.x >> 6), NGW = gridDim.x * NWAVES;
    const float* X1 = wsp<float>(p, WS_X1); const float* AFF = wsp<float>(p, WS_AFF); const int* INV = wsp<int>(p, WS_INV); const bf16_t* YE = wsp<bf16_t>(p, WS_YE);
    float* XL = wsp<float>(p, WS_XL); bf16_t* H = wsp<bf16_t>(p, WS_H);
    const float* lg = p.in[27] + l * D; const float* lb = p.in[28] + l * D;
    for (int r = gw; r < T; r += NGW) {
        const int ci = cond_of_row(r); const float* g2 = modp(p, l, ci, 5);
        f32x4 f[8];
#pragma unroll
        for (int j = 0; j < 8; ++j) f[j] = (f32x4){0.f, 0.f, 0.f, 0.f};
        for (int e = 0; e < 16; ++e) { const int slot = INV[(size_t)r * 16 + e]; if (slot < 0) continue; const float w = AFF[(size_t)r * 16 + e];
            const bf16_t* y = YE + (size_t)(e * NSLOT + slot) * D;
#pragma unroll
            for (int j = 0; j < 8; ++j) { const u32x2 q = *(const u32x2*)(y + lane * 4 + 256 * j); f[j][0] += w * bflo(q.x); f[j][1] += w * bfhi(q.x); f[j][2] += w * bflo(q.y); f[j][3] += w * bfhi(q.y); } }
        float s = 0.f;
#pragma unroll
        for (int j = 0; j < 8; ++j) { const int c0 = lane * 4 + 256 * j; f[j] = DN_ALPHA * *(const f32x4*)(X1 + (size_t)r * D + c0) + *(const f32x4*)(g2 + c0) * f[j]; s += (f[j][0] + f[j][1]) + (f[j][2] + f[j][3]); }
        const float mean = wave_sum(s) * (1.f / D); float s2 = 0.f;
#pragma unroll
        for (int j = 0; j < 8; ++j) { f[j] = f[j] - mean; s2 += (f[j][0] * f[j][0] + f[j][1] * f[j][1]) + (f[j][2] * f[j][2] + f[j][3] * f[j][3]); }
        const float rstd = rsqrtf(wave_sum(s2) * (1.f / D) + 1e-5f);
        const float* sh = modp(p, 1, ci, 0); const float* sc = modp(p, 1, ci, 1);
#pragma unroll
        for (int j = 0; j < 8; ++j) { const int c0 = lane * 4 + 256 * j; const f32x4 x = f[j] * rstd * *(const f32x4*)(lg + c0) + *(const f32x4*)(lb + c0);
            if (l == 0) { *(f32x4*)(XL + (size_t)r * D + c0) = x; const f32x4 h = x * (1.f + *(const f32x4*)(sc + c0)) + *(const f32x4*)(sh + c0);
                u32x2 o; o.x = pk2(h[0], h[1]); o.y = pk2(h[2], h[3]); *(u32x2*)(H + (size_t)r * D + c0) = o; }
            else *(f32x4*)(p.out + O_Y + (size_t)r * D + c0) = x; }
    }
}

struct Unit { const char* A; const char* B; unsigned lda, ldb; int nt; int pm, pn; int mode; int aux; };
DI int vcu_of(int bx, int G) { return (G % 8 == 0) ? (bx % 8) * (G / 8) + bx / 8 : bx; }

DI void rope8(const Params& p, int s, int pi0, float* v) {
    const f32x4 c = *(const f32x4*)(ws_cos(p) + s * 32 + pi0), sn = *(const f32x4*)(ws_sin(p) + s * 32 + pi0);
#pragma unroll
    for (int i = 0; i < 4; ++i) { const float x1 = v[2 * i], x2 = v[2 * i + 1]; v[2 * i] = x1 * c[i] - x2 * sn[i]; v[2 * i + 1] = x1 * sn[i] + x2 * c[i]; }
}
DI void st_bf16x8(bf16_t* dst, const float* v) { u32x4 w; w.x = pk2(v[0], v[1]); w.y = pk2(v[2], v[3]); w.z = pk2(v[4], v[5]); w.w = pk2(v[6], v[7]); *(u32x4*)dst = w; }
DI void st_f32x8(float* dst, const float* v) { *(f32x4*)dst = (f32x4){v[0], v[1], v[2], v[3]}; *(f32x4*)(dst + 4) = (f32x4){v[4], v[5], v[6], v[7]}; }

struct SchedInEven { const Params* p; int G, c;
    DI bool next(int i, Unit& u) const { const int L = i * G + c; if (L >= 48 * 8) return false; u.pm = L >> 3; u.pn = L & 7;
        u.A = (const char*)wsp<bf16_t>(*p, WS_H) + (size_t)u.pm * 256 * 4096; u.B = (const char*)wsp<bf16_t>(*p, WS_WINE) + (size_t)u.pn * 256 * 4096; u.lda = 4096; u.ldb = 4096; u.nt = 32; u.mode = 0; u.aux = 0; return true; } };
struct EpiInEven { static constexpr bool PAIR = false; const Params* p;
    DI void store(const Unit& u, int row, int col, float* v) const {
        const int r = u.pm * 256 + row, gc = u.pn * 256 + col;
        if (gc < 1792) { st_f32x8(wsp<float>(*p, WS_PJ) + (size_t)r * 1792 + gc, v); return; }
        if (gc >= 1856) return;
        const int j0 = gc - 1792;
        if (r < T_CTX) st_f32x8(p->out + O_KPE + (size_t)r * 64 + j0, v); else rope8(*p, (r - T_CTX) & 1023, j0 >> 1, v);
        st_bf16x8(wsp<bf16_t>(*p, WS_KPE) + (size_t)r * 64 + j0, v);
    } };

constexpr int E2_Q = 48 * 6, E2_K = 64 * 4, E2_V = 4 * 64, E2_P = 48 * 4, E2_TOTAL = E2_Q + E2_K + E2_V + E2_P;
struct SchedE2 { const Params* p; int G, c;
    DI bool next(int i, Unit& u) const { int L = i * G + c; if (L >= E2_TOTAL) return false;
        const char* ACT2 = (const char*)wsp<bf16_t>(*p, WS_ACT2); const char* W2 = (const char*)wsp<bf16_t>(*p, WS_W2); u.aux = 0;
        if (L < E2_Q) { u.mode = 0; u.pm = L / 6; u.pn = L % 6; u.A = ACT2 + (size_t)u.pm * 256 * 3584; u.lda = 3584; u.B = W2 + (size_t)u.pn * 256 * 3584; u.ldb = 3584; u.nt = 8; return true; }
        L -= E2_Q;
        if (L < E2_K) { u.mode = 1; u.pm = L >> 2; u.pn = L & 3; u.A = ACT2 + (size_t)u.pm * 256 * 3584 + 512 * 2; u.lda = 3584; u.B = W2 + (size_t)(1536 + u.pn * 256) * 3584; u.ldb = 3584; u.nt = 4; return true; }
        L -= E2_K;
        if (L < E2_V) { u.mode = 2; u.pm = L >> 6; u.pn = L & 63; u.A = W2 + (size_t)(2560 + u.pm * 256) * 3584; u.lda = 3584; u.B = ACT2 + (size_t)u.pn * 256 * 3584 + 512 * 2; u.ldb = 3584; u.nt = 4; return true; }
        L -= E2_V;
        u.mode = 3; u.pm = L >> 2; u.aux = L & 3; u.pn = 0; u.A = ACT2 + (size_t)u.pm * 256 * 3584 + (768 + u.aux * 256) * 2; u.lda = 3584; u.B = W2 + (size_t)(3584 + u.aux * 256) * 3584; u.ldb = 3584; u.nt = 4; return true; } };
struct EpiE2 { static constexpr bool PAIR = false; const Params* p;
    DI void store(const Unit& u, int row, int col, float* v) const {
        const int r = u.pm * 256 + row, gc = u.pn * 256 + col;
        if (u.mode == 0) { const int dd = gc % 192; if (dd >= 128 && r >= T_CTX) rope8(*p, (r - T_CTX) & 1023, (dd - 128) >> 1, v);
#pragma unroll
            for (int i = 0; i < 8; ++i) v[i] *= QS_MLA;
            st_bf16x8(wsp<bf16_t>(*p, WS_Q) + (size_t)r * 1536 + gc, v); }
        else if (u.mode == 1) st_bf16x8(wsp<bf16_t>(*p, WS_KN) + (size_t)r * 1024 + gc, v);
        else if (u.mode == 2) st_bf16x8(wsp<bf16_t>(*p, WS_VT) + (size_t)r * TX + gc, v);
        else { const float* ps = p->in[16] + u.aux * 256 + col;
#pragma unroll
            for (int i = 0; i < 8; ++i) v[i] *= ps[i];
            st_bf16x8(wsp<bf16_t>(*p, WS_MIX) + (size_t)r * 2048 + 1024 + u.aux * 256 + col, v); }
    } };

struct SchedOut { const Params* p; int G, c, l;
    DI bool next(int i, Unit& u) const { const int L = i * G + c; if (L >= 48 * 8) return false; u.pm = L >> 3; u.pn = L & 7;
        u.A = (const char*)wsp<bf16_t>(*p, WS_MIX) + (size_t)u.pm * 256 * 4096; u.B = (const char*)wsp<bf16_t>(*p, l == 0 ? WS_WOUTE : WS_WOUTO) + (size_t)u.pn * 256 * 4096; u.lda = 4096; u.ldb = 4096; u.nt = 32; u.mode = 0; u.aux = 0; return true; } };
struct EpiOut { static constexpr bool PAIR = false; const Params* p; int l;
    DI void store(const Unit& u, int row, int col, float* v) const {
        const int r = u.pm * 256 + row, gc = u.pn * 256 + col;
        const float* x = (l == 0 ? xrow_in(*p, r) : wsp<float>(*p, WS_XL) + (size_t)r * D) + gc; const float* g1 = modp(*p, l, cond_of_row(r), 2) + gc;
        const f32x4 x0 = *(const f32x4*)x, x1 = *(const f32x4*)(x + 4), g0 = *(const f32x4*)g1, g4 = *(const f32x4*)(g1 + 4);
#pragma unroll
        for (int i = 0; i < 4; ++i) { v[i] = DN_ALPHA * x0[i] + g0[i] * v[i]; v[4 + i] = DN_ALPHA * x1[i] + g4[i] * v[4 + i]; }
        st_f32x8(wsp<float>(*p, WS_Y) + (size_t)r * D + gc, v);
    } };

struct SchedGU { const Params* p; int G, c, l;
    DI bool next(int i, Unit& u) const { const int L = i * G + c; if (L >= 16 * 96) return false; const int e = L / 96, rem = L % 96; u.pn = rem / 6; u.pm = e * 6 + rem % 6; u.aux = e;
        u.A = (const char*)wsp<bf16_t>(*p, WS_XS) + (size_t)u.pm * 256 * 4096; u.B = (const char*)wsp<bf16_t>(*p, WS_WGU) + ((size_t)(l * 16 + e) * 4096 + (size_t)u.pn * 256) * 4096; u.lda = 4096; u.ldb = 4096; u.nt = 32; u.mode = 0; return true; } };
struct EpiGU { static constexpr bool PAIR = true; const Params* p;
    DI void store2(const Unit& u, int row, int col, const float* g, const float* up) const {
        float h[8];
#pragma unroll
        for (int i = 0; i < 8; ++i) h[i] = g[i] / (1.f + __expf(-g[i])) * up[i];
        st_bf16x8(wsp<bf16_t>(*p, WS_HID) + (size_t)(u.pm * 256 + row) * D + u.pn * 128 + col, h);
    } };

struct SchedDown { const Params* p; int G, c, l;
    DI bool next(int i, Unit& u) const { const int L = i * G + c; if (L >= 16 * 48) return false; const int e = L / 48, rem = L % 48; u.pn = rem / 6; u.pm = e * 6 + rem % 6; u.aux = e;
        u.A = (const char*)wsp<bf16_t>(*p, WS_HID) + (size_t)u.pm * 256 * 4096; u.B = (const char*)wsp<bf16_t>(*p, WS_WDN) + ((size_t)(l * 16 + e) * 2048 + (size_t)u.pn * 256) * 4096; u.lda = 4096; u.ldb = 4096; u.nt = 32; u.mode = 0; return true; } };
struct EpiDown { static constexpr bool PAIR = false; const Params* p;
    DI void store(const Unit& u, int row, int col, float* v) const { st_bf16x8(wsp<bf16_t>(*p, WS_YE) + (size_t)(u.pm * 256 + row) * D + u.pn * 256 + col, v); } };

constexpr int IO_QK = 48 * 9, IO_V = 16, IO_VT = 48, IO_TOTAL = IO_QK + IO_V + IO_VT;
struct SchedInOdd { const Params* p; int G, c;
    DI bool next(int i, Unit& u) const { int L = i * G + c; if (L >= IO_TOTAL) return false;
        const char* Hb = (const char*)wsp<bf16_t>(*p, WS_H); const char* W = (const char*)wsp<bf16_t>(*p, WS_WINO); u.aux = 0; u.nt = 32; u.lda = 4096; u.ldb = 4096;
        if (L < IO_QK) { u.mode = 0; u.pm = L / 9; u.pn = L % 9; u.A = Hb + (size_t)u.pm * 256 * 4096; u.B = W + (size_t)u.pn * 256 * 4096; return true; }
        L -= IO_QK;
        if (L < IO_V) { u.mode = 1; u.pm = L; u.pn = 9; u.A = Hb + (size_t)u.pm * 256 * 4096; u.B = W + (size_t)9 * 256 * 4096; return true; }
        L -= IO_V;
        u.mode = 2; u.pm = 0; u.pn = L; u.A = W + (size_t)9 * 256 * 4096; u.B = Hb + (size_t)u.pn * 256 * 4096; return true; } };
struct EpiInOdd { static constexpr bool PAIR = false; const Params* p;
    DI void store(const Unit& u, int row, int col, float* v) const {
        const int r = u.pm * 256 + row, gc = u.pn * 256 + col;
        if (u.mode == 0) {
            if (gc < 2048) { if (r >= T_CTX) rope8(*p, (r - T_CTX) & 1023, (gc & 63) >> 1, v);
#pragma unroll
                for (int i = 0; i < 8; ++i) v[i] *= QS_SWA;
                st_bf16x8(wsp<bf16_t>(*p, WS_Q) + (size_t)r * 2048 + gc, v); }
            else { const int kc = gc - 2048; if (r < T_CTX) st_f32x8(p->out + O_SK + (size_t)r * 256 + kc, v); else rope8(*p, (r - T_CTX) & 1023, (kc & 63) >> 1, v);
                st_bf16x8(wsp<bf16_t>(*p, WS_KO) + (size_t)r * 256 + kc, v); } }
        else if (u.mode == 1) st_f32x8(p->out + O_SV + (size_t)r * 256 + col, v);
        else st_bf16x8(wsp<bf16_t>(*p, WS_VTO) + (size_t)row * TX + gc, v);
    } };

template <class Sched, class Epi>
DI void naive_gemm(const Sched& S, const Epi& E, unsigned char* lds_raw) {
    float* As = (float*)lds_raw;
    float* Bs = As + 16 * 260;
    const int tid = threadIdx.x, ty = tid >> 4, tx = tid & 15;
    Unit u;
    for (int i = 0; S.next(i, u); ++i) {
        float acc[2][8][8];
#pragma unroll
        for (int h = 0; h < 2; ++h)
#pragma unroll
            for (int a = 0; a < 8; ++a)
#pragma unroll
                for (int b = 0; b < 8; ++b) acc[h][a][b] = 0.f;
        const int K = u.nt * 64;
        for (int k0 = 0; k0 < K; k0 += 16) {
            {
                const int row = tid >> 1, kh = (tid & 1) * 8;
                const u32x4 a = *(const u32x4*)(u.A + (size_t)row * u.lda + (size_t)(k0 + kh) * 2);
                const u32x4 b = *(const u32x4*)(u.B + (size_t)row * u.ldb + (size_t)(k0 + kh) * 2);
                As[(kh + 0) * 260 + row] = bflo(a.x); As[(kh + 1) * 260 + row] = bfhi(a.x); As[(kh + 2) * 260 + row] = bflo(a.y); As[(kh + 3) * 260 + row] = bfhi(a.y);
                As[(kh + 4) * 260 + row] = bflo(a.z); As[(kh + 5) * 260 + row] = bfhi(a.z); As[(kh + 6) * 260 + row] = bflo(a.w); As[(kh + 7) * 260 + row] = bfhi(a.w);
                Bs[(kh + 0) * 260 + row] = bflo(b.x); Bs[(kh + 1) * 260 + row] = bfhi(b.x); Bs[(kh + 2) * 260 + row] = bflo(b.y); Bs[(kh + 3) * 260 + row] = bfhi(b.y);
                Bs[(kh + 4) * 260 + row] = bflo(b.z); Bs[(kh + 5) * 260 + row] = bfhi(b.z); Bs[(kh + 6) * 260 + row] = bflo(b.w); Bs[(kh + 7) * 260 + row] = bfhi(b.w);
            }
            __syncthreads();
#pragma unroll 1
            for (int k = 0; k < 16; ++k) {
                float a[8], b[2][8];
#pragma unroll
                for (int q = 0; q < 8; ++q) { a[q] = As[k * 260 + ty * 8 + q]; b[0][q] = Bs[k * 260 + tx * 8 + q]; b[1][q] = Bs[k * 260 + 128 + tx * 8 + q]; }
#pragma unroll
                for (int h = 0; h < 2; ++h)
#pragma unroll
                    for (int x = 0; x < 8; ++x)
#pragma unroll
                        for (int y = 0; y < 8; ++y) acc[h][x][y] += a[x] * b[h][y];
            }
            __syncthreads();
        }
#pragma unroll
        for (int x = 0; x < 8; ++x) {
            if constexpr (Epi::PAIR) E.store2(u, ty * 8 + x, tx * 8, acc[0][x], acc[1][x]);
            else { E.store(u, ty * 8 + x, tx * 8, acc[0][x]); E.store(u, ty * 8 + x, 128 + tx * 8, acc[1][x]); }
        }
    }
}

template <bool SWA>
DI void naive_attn(const Params& p, unsigned char* lds_raw) {
    constexpr int DK = SWA ? 64 : 192, DV = SWA ? 64 : 128, NH = SWA ? 32 : 8, LDQ = SWA ? 2048 : 1536;
    const int tid = threadIdx.x, lane = tid & 63, wave = __builtin_amdgcn_readfirstlane(tid >> 6), gw = blockIdx.x * NWAVES + wave, NGW = gridDim.x * NWAVES;
    float* sc = (float*)lds_raw + wave * 1792;
    float* qs = sc + 1536;
    const bf16_t* Q = wsp<bf16_t>(p, WS_Q); const bf16_t* KN = wsp<bf16_t>(p, SWA ? WS_KO : WS_KN); const bf16_t* KPE = wsp<bf16_t>(p, WS_KPE);
    const bf16_t* VT = wsp<bf16_t>(p, SWA ? WS_VTO : WS_VT); bf16_t* MIX = wsp<bf16_t>(p, WS_MIX);
    for (int it = gw; it < T * NH; it += NGW) {
        const int r = it / NH, h = it % NH;
        for (int d = lane; d < DK; d += 64) qs[d] = bf2f(Q[(size_t)r * LDQ + h * DK + d]);
        int seg0[2], segn[2], nseg; int qpos = 0;
        if (r < T_CTX) { seg0[0] = r & ~255; segn[0] = 256; nseg = 1; }
        else { const int b = (r - T_CTX) >> 10, s = (r - T_CTX) & 1023, base = T_CTX + b * 1024; qpos = s;
            if (SWA) { const int lo = max(s - 128, 0), hi = min(s + 128, 1023); seg0[0] = base + lo; segn[0] = hi - lo + 1; } else { seg0[0] = base; segn[0] = 1024; }
            seg0[1] = T + b * 512; segn[1] = 512; nseg = 2; }
        const int kvh = SWA ? (h >> 3) : h;
        float m = SWA ? p.in[19][h] * LOG2E : -1e30f; int idx0 = 0;
        for (int sgi = 0; sgi < nseg; ++sgi) {
            for (int j = lane; j < segn[sgi]; j += 64) { const int key = seg0[sgi] + j; float dot = 0.f;
                if (SWA) { const bf16_t* kr = KN + (size_t)key * 256 + kvh * 64;
                    for (int d = 0; d < 64; d += 8) { const u32x4 w = *(const u32x4*)(kr + d); dot += qs[d] * bflo(w.x) + qs[d + 1] * bfhi(w.x) + qs[d + 2] * bflo(w.y) + qs[d + 3] * bfhi(w.y) + qs[d + 4] * bflo(w.z) + qs[d + 5] * bfhi(w.z) + qs[d + 6] * bflo(w.w) + qs[d + 7] * bfhi(w.w); } }
                else { const bf16_t* kr = KN + (size_t)key * 1024 + h * 128;
                    for (int d = 0; d < 128; d += 8) { const u32x4 w = *(const u32x4*)(kr + d); dot += qs[d] * bflo(w.x) + qs[d + 1] * bfhi(w.x) + qs[d + 2] * bflo(w.y) + qs[d + 3] * bfhi(w.y) + qs[d + 4] * bflo(w.z) + qs[d + 5] * bfhi(w.z) + qs[d + 6] * bflo(w.w) + qs[d + 7] * bfhi(w.w); }
                    const bf16_t* kp = KPE + (size_t)key * 64;
                    for (int d = 0; d < 64; d += 8) { const u32x4 w = *(const u32x4*)(kp + d); const float* q8 = qs + 128 + d; dot += q8[0] * bflo(w.x) + q8[1] * bfhi(w.x) + q8[2] * bflo(w.y) + q8[3] * bfhi(w.y) + q8[4] * bflo(w.z) + q8[5] * bfhi(w.z) + q8[6] * bflo(w.w) + q8[7] * bfhi(w.w); } }
                sc[idx0 + j] = dot; m = fmaxf(m, dot); }
            idx0 += segn[sgi]; }
        (void)qpos;
        m = wave_max(m);
        float l = 0.f;
        for (int j = lane; j < idx0; j += 64) { const float e = exp2f(sc[j] - m); sc[j] = e; l += e; }
        l = wave_sum(l); if (SWA) l += exp2f(p.in[19][h] * LOG2E - m);
        float o[2] = {0.f, 0.f}; idx0 = 0;
        for (int sgi = 0; sgi < nseg; ++sgi) {
#pragma unroll
            for (int f = 0; f < DV / 64; ++f) { const bf16_t* vr = VT + (size_t)(kvh * DV + lane + 64 * f) * TX + seg0[sgi]; float a = 0.f;
                for (int j = 0; j < segn[sgi]; ++j) a += sc[idx0 + j] * bf2f(vr[j]);
                o[f] += a; }
            idx0 += segn[sgi]; }
        const float inv = 1.f / l;
#pragma unroll
        for (int f = 0; f < DV / 64; ++f) MIX[(size_t)r * 2048 + h * DV + lane + 64 * f] = (bf16_t)f2bf(o[f] * inv);
    }
}

namespace pg8 {
typedef short bf16x8 __attribute__((ext_vector_type(8)));
constexpr int BM = 256, BK = 64, HALF = 128, HTB = HALF * BK * 2  , STAGE_BYTES = 8 * HTB;
DI int lds_byte(int r, int c) { const int st = (r >> 4) * 2 + (c >> 5), rr = r & 15, cc = c & 31, ob = rr * 64 + cc * 2; return st * 1024 + (ob ^ (((ob >> 9) & 1) << 5)); }
DI void stage_rc(int b, int& R, int& C) { const int st = b / 1024, sb = b % 1024, swz = sb ^ (((sb >> 9) & 1) << 5); R = (st >> 1) * 16 + swz / 64; C = (st & 1) * 32 + (swz % 64) / 2; }
DI int perm32(int rho) { const int n = rho >> 4, i = rho & 15; return 8 * (i >> 2) + 4 * n + (i & 3); }

template <class Epi, class Sched, bool ALIGN_EPI = true>
DI void gemm_phase(LAS unsigned char* lds, const Sched& S, const Epi& E) {
    const int tid = threadIdx.x, wid = __builtin_amdgcn_readfirstlane(tid >> 6), lane = tid & 63, wr = wid >> 2, wc = wid & 3, fr = lane & 15, fq = lane >> 4;
    int RA[2], RB[2], CB[2];
#pragma unroll
    for (int i = 0; i < 2; ++i) { int R, C; stage_rc(tid * 16 + i * 8192, R, C); RA[i] = R; RB[i] = (R & ~31) + perm32(R & 31); CB[i] = C * 2; }
    constexpr size_t kstep = (size_t)(BK * 2);
    const unsigned ldsw = (unsigned)wid * 1024u;
    const int aoff = lds_byte(wr * 64 + fr, fq * 8), boff = lds_byte(wc * 32 + fr, fq * 8);
#define PG8_SA(b, h) (((b) * 2 + (h)) * HTB)
#define PG8_SB(b, h) ((4 + (b) * 2 + (h)) * HTB)
#define PG8_STAGE(bufoff, gbase, v0, v1) do { \
        __builtin_amdgcn_global_load_lds((const unsigned*)((const char*)(gbase) + (v0)), (LAS unsigned*)(lds + (bufoff) + ldsw), 16, 0, 0); \
        __builtin_amdgcn_global_load_lds((const unsigned*)((const char*)(gbase) + (v1)), (LAS unsigned*)(lds + (bufoff) + ldsw + 8192), 16, 0, 0); } while (0)
#define PG8_LDA(dst, b, h) do { _Pragma("unroll") for (int m = 0; m < 4; ++m) _Pragma("unroll") for (int k = 0; k < 2; ++k) dst[m][k] = *(const LAS bf16x8*)(lds + PG8_SA(b, h) + aoff + m * 2048 + k * 1024); } while (0)
#define PG8_LDB(dst, b, h) do { _Pragma("unroll") for (int n = 0; n < 2; ++n) _Pragma("unroll") for (int k = 0; k < 2; ++k) dst[n][k] = *(const LAS bf16x8*)(lds + PG8_SB(b, h) + boff + n * 2048 + k * 1024); } while (0)
#define PG8_MMA(ai, bj, At, Bt) do { __builtin_amdgcn_s_setprio(1); _Pragma("unroll") for (int m = 0; m < 4; ++m) _Pragma("unroll") for (int n = 0; n < 2; ++n) _Pragma("unroll") for (int k = 0; k < 2; ++k) \
        acc[ai][bj][m][n] = __builtin_amdgcn_mfma_f32_16x16x32_bf16(Bt[n][k], At[m][k], acc[ai][bj][m][n], 0, 0, 0); __builtin_amdgcn_s_setprio(0); } while (0)
#define PG8_WAIT_V(n) asm volatile("s_waitcnt vmcnt(" #n ")" ::: "memory")
#define PG8_WAIT_L(n) asm volatile("s_waitcnt lgkmcnt(" #n ")" ::: "memory")
#define PG8_BAR __builtin_amdgcn_s_barrier()
#define PG8_SCHED __builtin_amdgcn_sched_barrier(0)
    Unit cur, nxt; int ui = 0;
    if (!S.next(0, cur)) return;
    f32x4 acc[2][2][4][2];
#pragma unroll
    for (int a = 0; a < 2; ++a)
#pragma unroll
        for (int b = 0; b < 2; ++b)
#pragma unroll
            for (int m = 0; m < 4; ++m)
#pragma unroll
                for (int n = 0; n < 2; ++n) acc[a][b][m][n] = (f32x4){0.f, 0.f, 0.f, 0.f};
    bf16x8 At[4][2], B0[2][2], B1[2][2];
    const char* cA = cur.A; const char* cB = cur.B;
    const unsigned ld = cur.lda;
    const unsigned vA0 = RA[0] * ld + CB[0], vA1 = RA[1] * ld + CB[1], vB0 = RB[0] * ld + CB[0], vB1 = RB[1] * ld + CB[1];
    const size_t hA = (size_t)HALF * ld, hB = hA;
    PG8_STAGE(PG8_SB(0, 0), cB, vB0, vB1); PG8_STAGE(PG8_SB(0, 1), cB + hB, vB0, vB1); PG8_STAGE(PG8_SA(0, 0), cA, vA0, vA1); PG8_STAGE(PG8_SA(0, 1), cA + hA, vA0, vA1);
    if (wr == 1) PG8_BAR;
    PG8_WAIT_V(2); PG8_BAR;
    PG8_STAGE(PG8_SB(1, 0), cB + kstep, vB0, vB1); PG8_STAGE(PG8_SA(1, 0), cA + kstep, vA0, vA1); PG8_STAGE(PG8_SB(1, 1), cB + hB + kstep, vB0, vB1);
    PG8_WAIT_V(6); PG8_BAR;
    for (;;) {
        const bool has_next = S.next(ui + 1, nxt);
        const char* nA = has_next ? nxt.A : cA; const char* nB = has_next ? nxt.B : cB;
        const int nt = cur.nt;
        for (int t = 0; t < nt; t += 2) {
            const bool last = (t == nt - 2);
            const char* a1 = cA + (size_t)(t + 1) * kstep;
            const char* a2 = last ? nA : cA + (size_t)(t + 2) * kstep; const char* b2 = last ? nB : cB + (size_t)(t + 2) * kstep;
            const char* a3 = a2 + kstep; const char* b3 = b2 + kstep;
            PG8_LDB(B0, 0, 0); PG8_LDB(B1, 0, 1); PG8_SCHED; PG8_LDA(At, 0, 0); PG8_STAGE(PG8_SA(1, 1), a1 + hA, vA0, vA1);
            PG8_WAIT_V(8); PG8_WAIT_L(0); PG8_BAR; PG8_MMA(0, 0, At, B0); PG8_MMA(0, 1, At, B1); PG8_BAR; PG8_SCHED;
            PG8_LDA(At, 0, 1); PG8_STAGE(PG8_SB(0, 0), b2, vB0, vB1); PG8_STAGE(PG8_SB(0, 1), b2 + hB, vB0, vB1); PG8_STAGE(PG8_SA(0, 0), a2, vA0, vA1);
            PG8_WAIT_V(8); PG8_WAIT_L(0); PG8_BAR; PG8_MMA(1, 0, At, B0); PG8_MMA(1, 1, At, B1); PG8_BAR; PG8_SCHED;
            PG8_LDB(B0, 1, 0); PG8_LDB(B1, 1, 1); PG8_SCHED; PG8_LDA(At, 1, 0); PG8_STAGE(PG8_SA(0, 1), a2 + hA, vA0, vA1);
            PG8_WAIT_V(8); PG8_WAIT_L(0); PG8_BAR; PG8_MMA(0, 0, At, B0); PG8_MMA(0, 1, At, B1); PG8_BAR; PG8_SCHED;
            PG8_LDA(At, 1, 1); PG8_STAGE(PG8_SB(1, 0), b3, vB0, vB1); PG8_STAGE(PG8_SB(1, 1), b3 + hB, vB0, vB1); PG8_STAGE(PG8_SA(1, 0), a3, vA0, vA1);
            PG8_WAIT_V(8); PG8_WAIT_L(0); PG8_BAR; PG8_MMA(1, 0, At, B0); PG8_MMA(1, 1, At, B1); PG8_BAR; PG8_SCHED;
        }
        if constexpr (ALIGN_EPI) { if (wr == 0) PG8_BAR; }
        {
            int fr_ = fr, fq_ = fq; asm volatile("" : "+v"(fr_), "+v"(fq_));
#pragma unroll
            for (int ai = 0; ai < 2; ++ai)
#pragma unroll
                for (int m = 0; m < 4; ++m) { const int row = ai * HALF + wr * 64 + m * 16 + fr_;
                    if constexpr (Epi::PAIR) { float g[8], up[8];
#pragma unroll
                        for (int j = 0; j < 4; ++j) { g[j] = acc[ai][0][m][0][j]; g[4 + j] = acc[ai][0][m][1][j]; up[j] = acc[ai][1][m][0][j]; up[4 + j] = acc[ai][1][m][1][j]; }
                        E.store2(cur, row, wc * 32 + 8 * fq_, g, up); }
                    else {
#pragma unroll
                        for (int bj = 0; bj < 2; ++bj) { float v[8];
#pragma unroll
                            for (int j = 0; j < 4; ++j) { v[j] = acc[ai][bj][m][0][j]; v[4 + j] = acc[ai][bj][m][1][j]; }
                            E.store(cur, row, bj * HALF + wc * 32 + 8 * fq_, v); } } }
        }
        if (!has_next) break;
#pragma unroll
        for (int a = 0; a < 2; ++a)
#pragma unroll
            for (int b = 0; b < 2; ++b)
#pragma unroll
                for (int m = 0; m < 4; ++m)
#pragma unroll
                    for (int n = 0; n < 2; ++n) acc[a][b][m][n] = (f32x4){0.f, 0.f, 0.f, 0.f};
        cur = nxt; cA = nA; cB = nB; ++ui;
        if constexpr (ALIGN_EPI) { if (wr == 1) PG8_BAR; }
    }
    PG8_WAIT_V(0);
    if constexpr (!ALIGN_EPI) { if (wr == 0) PG8_BAR; }
    PG8_BAR;
#undef PG8_SA
#undef PG8_SB
#undef PG8_STAGE
#undef PG8_LDA
#undef PG8_LDB
#undef PG8_MMA
#undef PG8_WAIT_V
#undef PG8_WAIT_L
#undef PG8_BAR
#undef PG8_SCHED
}
}

constexpr int LDS_BYTES = 147456, MISC_OFF = 146432;
constexpr int NPH = 20;
__global__ void __launch_bounds__(NTHREADS, 2) mega(Params p) {
    extern __shared__ __attribute__((aligned(16))) unsigned char lds[];
    const int G = gridDim.x, c = vcu_of(blockIdx.x, G);
    volatile LAS unsigned* MISC = (volatile LAS unsigned*)((LAS unsigned char*)lds + MISC_OFF);
    if (threadIdx.x < 4) MISC[threadIdx.x] = 0u;
    __syncthreads();
    XcdBarrier bar = xcd_barrier_post((unsigned*)(p.ws + WS_CTL) + CW_BAR, MISC);
    const int lo = p.ph_lo, hi = p.ph_hi;
#define IN(k) (lo <= (k) && (k) < hi)
#define SEAM(k) do { if (IN(k) && IN((k) + 1)) xcd_barrier(bar); } while (0)
    if (IN(0)) { ph_mod(p, lds); ph_misc(p); ph_convert(p, 0, CV_TOTAL); } SEAM(0);
    if (IN(1)) ph_h0(p); SEAM(1);
    if (IN(2)) { SchedInEven S{&p, G, c}; EpiInEven E{&p}; pg8::gemm_phase((LAS unsigned char*)lds, S, E); } SEAM(2);
    if (IN(3)) ph_e1(p); SEAM(3);
    if (IN(4)) { SchedE2 S{&p, G, c}; EpiE2 E{&p}; pg8::gemm_phase((LAS unsigned char*)lds, S, E); } SEAM(4);
    if (IN(5)) naive_attn<false>(p, lds); SEAM(5);
    if (IN(6)) { SchedOut S{&p, G, c, 0}; EpiOut E{&p, 0}; pg8::gemm_phase((LAS unsigned char*)lds, S, E); } SEAM(6);
    if (IN(7)) ph_ln1(p, 0, lds); SEAM(7);
    if (IN(8)) ph_topk(p, lds); SEAM(8);
    if (IN(9)) { SchedGU S{&p, G, c, 0}; EpiGU E{&p}; pg8::gemm_phase((LAS unsigned char*)lds, S, E); } SEAM(9);
    if (IN(10)) { SchedDown S{&p, G, c, 0}; EpiDown E{&p}; pg8::gemm_phase((LAS unsigned char*)lds, S, E); } SEAM(10);
    if (IN(11)) ph_ln2(p, 0); SEAM(11);
    if (IN(12)) { SchedInOdd S{&p, G, c}; EpiInOdd E{&p}; pg8::gemm_phase((LAS unsigned char*)lds, S, E); } SEAM(12);
    if (IN(13)) naive_attn<true>(p, lds); SEAM(13);
    if (IN(14)) { SchedOut S{&p, G, c, 1}; EpiOut E{&p, 1}; pg8::gemm_phase((LAS unsigned char*)lds, S, E); } SEAM(14);
    if (IN(15)) ph_ln1(p, 1, lds); SEAM(15);
    if (IN(16)) ph_topk(p, lds); SEAM(16);
    if (IN(17)) { SchedGU S{&p, G, c, 1}; EpiGU E{&p}; pg8::gemm_phase((LAS unsigned char*)lds, S, E); } SEAM(17);
    if (IN(18)) { SchedDown S{&p, G, c, 1}; EpiDown E{&p}; pg8::gemm_phase((LAS unsigned char*)lds, S, E); } SEAM(18);
    if (IN(19)) ph_ln2(p, 1);
#undef IN
#undef SEAM
}

extern "C" void kernel_launch(void* const* d_in, const int* in_sizes, int n_in, void* d_out, int out_size, void* d_ws, size_t ws_size, hipStream_t stream) {
    static int grid = 0;
    if (grid == 0) {
        if (n_in != 29 || out_size != (int)O_END || ws_size < WS_END) { fprintf(stderr, "kernel_launch: unexpected shapes (n_in %d out %d ws %zu need %zu)\n", n_in, out_size, ws_size, (size_t)WS_END); grid = -1; return; }
        int dev = 0, cus = 0, per_cu = 0;
        if (hipGetDevice(&dev) != hipSuccess || hipDeviceGetAttribute(&cus, hipDeviceAttributeMultiprocessorCount, dev) != hipSuccess) { grid = -1; return; }
        if (hipFuncSetAttribute((const void*)mega, hipFuncAttributeMaxDynamicSharedMemorySize, LDS_BYTES) != hipSuccess) { fprintf(stderr, "hipFuncSetAttribute failed\n"); grid = -1; return; }
        if (hipOccupancyMaxActiveBlocksPerMultiprocessor(&per_cu, (const void*)mega, NTHREADS, LDS_BYTES) != hipSuccess || per_cu < 1) fprintf(stderr, "occupancy query: %d\n", per_cu);
        (void)hipGetLastError();
        grid = cus > 0 ? cus : 256;
    }
    if (grid < 0) return;
    Params p{};
    for (int i = 0; i < 29; ++i) p.in[i] = (const float*)d_in[i];
    p.out = (float*)d_out; p.ws = (unsigned char*)d_ws; p.ph_lo = 0; p.ph_hi = NPH;
    (void)hipMemsetAsync((char*)d_ws + WS_CTL, 0, CTL_BYTES, stream);
    hipLaunchKernelGGL(mega, dim3(grid), dim3(NTHREADS), LDS_BYTES, stream, p);
}
```

```cpp
#include <hip/hip_runtime.h>
#include <cstdio>
#include <cstdint>

constexpr int D = 2048, T_CTX = 4096, T = 12288, TC = 4096, TX = 16384;
constexpr int MODW = 12288, NCOND = 9;
constexpr int NSLOT = 1536, NXS = 16 * NSLOT;
constexpr float DN_ALPHA = 1.41421356237309515f;
constexpr float LOG2E = 1.44269504088896341f;
constexpr float QS_MLA = 0.07216878364870322f * LOG2E;
constexpr float QS_SWA = 0.125f * LOG2E;
constexpr int NTHREADS = 512, NWAVES = 8;

constexpr size_t O_Y = 0, O_CKV = 25165824, O_KPE = 26214400, O_SK = 26476544, O_SV = 27525120, O_END = 28573696;

constexpr size_t al256(size_t x) { return (x + 255) & ~(size_t)255; }
constexpr size_t WS_CTL = 0, CTL_BYTES = 1u << 20;
constexpr size_t WS_MOD = WS_CTL + CTL_BYTES;
constexpr size_t WS_ROPE = WS_MOD + al256((size_t)2 * 9 * 12288 * 4);
constexpr size_t WS_WINE = WS_ROPE + al256((size_t)2 * 1024 * 32 * 4);
constexpr size_t WS_W2 = WS_WINE + (size_t)2048 * 2048 * 2;
constexpr size_t WS_WOUTE = WS_W2 + (size_t)4608 * 1792 * 2;
constexpr size_t WS_WINO = WS_WOUTE + (size_t)2048 * 2048 * 2;
constexpr size_t WS_WOUTO = WS_WINO + (size_t)2560 * 2048 * 2;
constexpr size_t WS_WGU = WS_WOUTO + (size_t)2048 * 2048 * 2;
constexpr size_t WS_WDN = WS_WGU + (size_t)32 * 4096 * 2048 * 2;
constexpr size_t WS_H = WS_WDN + (size_t)32 * 2048 * 2048 * 2;
constexpr size_t WS_PJ = WS_H + (size_t)T * 2048 * 2;
constexpr size_t WS_ACT2 = WS_PJ + (size_t)T * 1792 * 4;
constexpr size_t WS_KPE = WS_ACT2 + (size_t)TX * 1792 * 2;
constexpr size_t WS_Q = WS_KPE + (size_t)TX * 64 * 2;
constexpr size_t WS_KN = WS_Q + (size_t)T * 2048 * 2;
constexpr size_t WS_VT = WS_KN + (size_t)TX * 1024 * 2;
constexpr size_t WS_VTO = WS_VT + (size_t)1024 * TX * 2;
constexpr size_t WS_KO = WS_VTO + (size_t)256 * TX * 2;
constexpr size_t WS_MIX = WS_KO + (size_t)TX * 256 * 2;
constexpr size_t WS_Y = WS_MIX + (size_t)T * 2048 * 2;
constexpr size_t WS_X1 = WS_Y + (size_t)T * 2048 * 4;
constexpr size_t WS_XL = WS_X1 + (size_t)T * 2048 * 4;
constexpr size_t WS_AFF = WS_XL + (size_t)T * 2048 * 4;
constexpr size_t WS_INV = WS_AFF + (size_t)T * 16 * 4;
constexpr size_t WS_XS = WS_INV + (size_t)T * 16 * 4;
constexpr size_t WS_HID = WS_XS + (size_t)NXS * 2048 * 2;
constexpr size_t WS_YE = WS_HID + (size_t)NXS * 2048 * 2;
constexpr size_t WS_DBG = WS_YE + (size_t)NXS * 2048 * 2;
constexpr size_t WS_END = WS_DBG + (1u << 20);

typedef unsigned short bf16_t;
typedef float f32x4 __attribute__((ext_vector_type(4)));
typedef unsigned u32x4 __attribute__((ext_vector_type(4)));
typedef unsigned u32x2 __attribute__((ext_vector_type(2)));
#define LAS __attribute__((address_space(3)))
#define DI __device__ __forceinline__

struct Params {
    const float* in[29];
    float* out;
    unsigned char* ws;
    int ph_lo, ph_hi;
};

DI unsigned f2bf(float f) { unsigned u = __float_as_uint(f); return (u + 0x7fffu + ((u >> 16) & 1u)) >> 16; }
DI unsigned pk2(float lo, float hi) { return f2bf(lo) | (f2bf(hi) << 16); }
DI float bf2f(unsigned b) { return __uint_as_float(b << 16); }
DI float bflo(unsigned w) { return __uint_as_float(w << 16); }
DI float bfhi(unsigned w) { return __uint_as_float(w & 0xffff0000u); }
DI float wave_sum(float v) {
#pragma unroll
    for (int o = 1; o < 64; o <<= 1) v += __shfl_xor(v, o);
    return v;
}
DI float wave_max(float v) {
#pragma unroll
    for (int o = 1; o < 64; o <<= 1) v = fmaxf(v, __shfl_xor(v, o));
    return v;
}
DI int cond_of_row(int r) { return r < T_CTX ? 0 : 1 + ((r - T_CTX) >> 10); }
DI const float* xrow_in(const Params& p, int r) { return r < T_CTX ? p.in[0] + (size_t)r * D : p.in[1] + (size_t)(r - T_CTX) * D; }

DI float* ws_mod(const Params& p) { return (float*)(p.ws + WS_MOD); }
DI float* ws_cos(const Params& p) { return (float*)(p.ws + WS_ROPE); }
DI float* ws_sin(const Params& p) { return (float*)(p.ws + WS_ROPE) + 1024 * 32; }
template <class X> DI X* wsp(const Params& p, size_t off) { return (X*)(p.ws + off); }
DI const float* modp(const Params& p, int l, int ci, int j) { return ws_mod(p) + ((size_t)(l * 9 + ci) * MODW + (size_t)j * D); }

#define XB_TMO      128
#define XB_XCNT(j)  (256  + 64 * (j))
#define XB_XSUB(j)  (1280 + 64 * (j))
#define XB_XGEN(j)  (2304 + 64 * (j))
#define XB_TOP      3328
#define XB_TOPGEN   3392
#define XCD_BAR_WORDS 3456
#define XB_SPIN_CAP (1u << 18)

__device__ __forceinline__ unsigned xb_ld(unsigned* p)              { return __hip_atomic_load(p, __ATOMIC_RELAXED, __HIP_MEMORY_SCOPE_AGENT); }
__device__ __forceinline__ unsigned xb_add(unsigned* p, unsigned v) { return __hip_atomic_fetch_add(p, v, __ATOMIC_RELAXED, __HIP_MEMORY_SCOPE_AGENT); }
__device__ __forceinline__ unsigned xb_xcc_id() { return (unsigned)__builtin_amdgcn_s_getreg((3 << 11) | 20) & 0xFu; }
#define XB_SPIN(cond, bar) do { unsigned _sp = 0; while (cond) { __builtin_amdgcn_s_sleep(1); \
    if ((++_sp & 255u) == 0u) { if (xb_ld(&(bar)[XB_TMO])) break; if (_sp > XB_SPIN_CAP) { atomicAdd(&(bar)[XB_TMO], 1u); break; } } } } while (0)

struct XcdBarrier {
    unsigned* bar; unsigned x;
    volatile LAS unsigned* st;
};

__device__ __forceinline__ XcdBarrier xcd_barrier_post(unsigned* bar, volatile LAS unsigned* st) {
    XcdBarrier b; b.bar = bar; b.x = xb_xcc_id(); b.st = st;
    if (threadIdx.x == 0) (void)xb_add(&bar[XB_XCNT(b.x)], 1u);
    return b;
}
__device__ __forceinline__ void xcd_barrier_complete(unsigned* bar, unsigned x, unsigned& nloc, unsigned& nx) {
    const unsigned G = gridDim.x * gridDim.y * gridDim.z;
    unsigned sum, cnt, mine, sp = 0u;
    for (;;) {
        sum = 0u; cnt = 0u; mine = 0u;
#pragma unroll
        for (unsigned j = 0; j < 16; ++j) { const unsigned c = xb_ld(&bar[XB_XCNT(j)]); sum += c; cnt += (c > 0u) ? 1u : 0u; mine = (j == x) ? c : mine; }
        if (sum == G) break;
        __builtin_amdgcn_s_sleep(1);
        if ((++sp & 255u) == 0u) { if (xb_ld(&bar[XB_TMO])) break; if (sp > XB_SPIN_CAP) { atomicAdd(&bar[XB_TMO], 1u); break; } }
    }
    nloc = mine > 0u ? mine : 1u; nx = cnt > 0u ? cnt : 1u;
}

__device__ __forceinline__ void xcd_barrier(const XcdBarrier& b) {
    asm volatile("s_waitcnt vmcnt(0)" ::: "memory");
    __syncthreads();
    if (threadIdx.x == 0) {
        unsigned* bar = b.bar;
        __builtin_amdgcn_s_waitcnt(0);
        unsigned nloc = b.st[0], nx = b.st[1];
        if (nloc == 0u) { xcd_barrier_complete(bar, b.x, nloc, nx); b.st[0] = nloc; b.st[1] = nx; }
        const unsigned old = xb_add(&bar[XB_XSUB(b.x)], 1u);
        const unsigned gen = old / nloc;
        if (old + 1u == (gen + 1u) * nloc) {
            __builtin_amdgcn_fence(__ATOMIC_RELEASE, "agent");
            asm volatile("s_waitcnt vmcnt(0)" ::: "memory");
            const unsigned og = xb_add(&bar[XB_TOP], 1u);
            const unsigned tg = og / nx;
            if (og + 1u == (tg + 1u) * nx) xb_add(&bar[XB_TOPGEN], 1u);
            else XB_SPIN(xb_ld(&bar[XB_TOPGEN]) == tg, bar);
            __builtin_amdgcn_fence(__ATOMIC_ACQUIRE, "agent");
            xb_add(&bar[XB_XGEN(b.x)], 1u);
            asm volatile("s_waitcnt vmcnt(0)" ::: "memory");
        } else {
            XB_SPIN(xb_ld(&bar[XB_XGEN(b.x)]) == gen, bar);
            __builtin_amdgcn_fence(__ATOMIC_ACQUIRE, "agent");
            asm volatile("s_waitcnt vmcnt(0)" ::: "memory");
        }
    }
    __syncthreads();
}
constexpr int CW_BAR = 4096;


DI void ph_mod(const Params& p, unsigned char* lds_raw) {
    float* s_lds = (float*)lds_raw;
    float* red = s_lds + 9 * 2048;
    const int tid = threadIdx.x, lane = tid & 63, wave = __builtin_amdgcn_readfirstlane(tid >> 6);
    const float* c = p.in[6]; const float* c_ctx = p.in[7]; const float* w_ada = p.in[8]; const float* b_ada = p.in[9];
    for (int i = tid; i < 9 * 2048; i += NTHREADS) { const int ci = i >> 11, k = i & 2047; const float v = ci == 0 ? c_ctx[k] : c[(ci - 1) * 2048 + k]; s_lds[i] = v / (1.f + expf(-v)); }
    __syncthreads();
    float* MOD = ws_mod(p);
    for (int it = blockIdx.x; it < 384; it += gridDim.x) {
        const int l = it / 192, c0 = (it % 192) * 64;
        const int kq = tid >> 4, cl = tid & 15;
        const float* w = w_ada + (size_t)l * 2048 * MODW + c0 + 4 * cl;
        float acc[9][4];
#pragma unroll
        for (int ci = 0; ci < 9; ++ci)
#pragma unroll
            for (int j = 0; j < 4; ++j) acc[ci][j] = 0.f;
#pragma unroll 8
        for (int kk = 0; kk < 64; ++kk) {
            const int k = kq * 64 + kk;
            const f32x4 wv = *(const f32x4*)(w + (size_t)k * MODW);
#pragma unroll
            for (int ci = 0; ci < 9; ++ci) { const float s = s_lds[ci * 2048 + k];
#pragma unroll
                for (int j = 0; j < 4; ++j) acc[ci][j] += s * wv[j]; }
        }
#pragma unroll
        for (int ci = 0; ci < 9; ++ci)
#pragma unroll
            for (int j = 0; j < 4; ++j) { float v = acc[ci][j]; v += __shfl_xor(v, 16); v += __shfl_xor(v, 32); acc[ci][j] = v; }
        if (lane < 16) {
#pragma unroll
            for (int ci = 0; ci < 9; ++ci)
#pragma unroll
                for (int j = 0; j < 4; ++j) red[(wave * 9 + ci) * 64 + 4 * cl + j] = acc[ci][j];
        }
        __syncthreads();
        for (int o = tid; o < 576; o += NTHREADS) { const int ci = o >> 6, cc = o & 63; float s = 0.f;
#pragma unroll
            for (int w8 = 0; w8 < 8; ++w8) s += red[(w8 * 9 + ci) * 64 + cc];
            MOD[(size_t)(l * 9 + ci) * MODW + c0 + cc] = s + b_ada[l * MODW + c0 + cc]; }
        __syncthreads();
    }
}

constexpr int CV_INE = 928, CV_UQ = 192, CV_UKV = 128, CV_POOL = 64, CV_OUT = 1024, CV_INO = 1280, CV_MOE = 98304;
constexpr int CV_TOTAL = CV_INE + CV_UQ + CV_UKV + CV_POOL + CV_OUT + CV_INO + CV_OUT + CV_MOE;
DI void cvt_item(const Params& p, int item, int lane) {
    const float* src; bf16_t* dst; int K, N, ldd, nb, kb, map = 0, a = 0;
    if (item < CV_INE) { src = p.in[10]; dst = wsp<bf16_t>(p, WS_WINE); K = 2048; N = 1856; ldd = 2048; nb = item % 29; kb = item / 29; map = 1; }
    else if ((item -= CV_INE) < CV_UQ) { src = p.in[13]; dst = wsp<bf16_t>(p, WS_W2); K = 512; N = 1536; ldd = 1792; nb = item % 24; kb = item / 24; }
    else if ((item -= CV_UQ) < CV_UKV) { src = p.in[14]; dst = wsp<bf16_t>(p, WS_W2); K = 256; N = 2048; ldd = 1792; nb = item % 32; kb = item / 32; map = 2; }
    else if ((item -= CV_UKV) < CV_POOL) { const int g = item >> 4, r = item & 15; src = p.in[15] + (size_t)g * 65536; dst = wsp<bf16_t>(p, WS_W2); K = 256; N = 256; ldd = 1792; nb = r & 3; kb = r >> 2; a = 3584 + g * 256; }
    else if ((item -= CV_POOL) < CV_OUT) { src = p.in[17]; dst = wsp<bf16_t>(p, WS_WOUTE); K = 2048; N = 2048; ldd = 2048; nb = item & 31; kb = item >> 5; }
    else if ((item -= CV_OUT) < CV_INO) { src = p.in[18]; dst = wsp<bf16_t>(p, WS_WINO); K = 2048; N = 2560; ldd = 2048; nb = item % 40; kb = item / 40; }
    else if ((item -= CV_INO) < CV_OUT) { src = p.in[20]; dst = wsp<bf16_t>(p, WS_WOUTO); K = 2048; N = 2048; ldd = 2048; nb = item & 31; kb = item >> 5; }
    else { item -= CV_OUT; const int mat = item >> 10, w = item & 1023, le = mat / 3, kind = mat % 3; K = 2048; N = 2048; ldd = 2048; nb = w & 31; kb = w >> 5;
        src = p.in[24 + kind] + (size_t)le * 2048 * 2048;
        if (kind == 2) dst = wsp<bf16_t>(p, WS_WDN) + (size_t)le * 2048 * 2048; else { dst = wsp<bf16_t>(p, WS_WGU) + (size_t)le * 4096 * 2048; map = 3; a = kind * 128; } }
    const int n = nb * 64 + lane;
    const float* s = src + (size_t)(kb * 64) * N + n;
    float v[64];
#pragma unroll
    for (int k = 0; k < 64; ++k) v[k] = s[(size_t)k * N];
    int drow;
    if (map == 0) drow = n + a;
    else if (map == 1) drow = n < 768 ? n : (n < 832 ? 1792 + (n - 768) : 768 + (n - 832));
    else if (map == 2) { const int h = n >> 8, j = n & 255; drow = j < 128 ? 1536 + h * 128 + j : 2560 + h * 128 + (j - 128); }
    else drow = (n >> 7) * 256 + (n & 127) + a;
    u32x4* d = (u32x4*)(dst + (size_t)drow * ldd + kb * 64);
#pragma unroll
    for (int c8 = 0; c8 < 8; ++c8) { u32x4 o; o.x = pk2(v[8 * c8], v[8 * c8 + 1]); o.y = pk2(v[8 * c8 + 2], v[8 * c8 + 3]); o.z = pk2(v[8 * c8 + 4], v[8 * c8 + 5]); o.w = pk2(v[8 * c8 + 6], v[8 * c8 + 7]); d[c8] = o; }
}
DI void ph_convert(const Params& p, int item_lo, int item_hi) {
    const int lane = threadIdx.x & 63, gw = blockIdx.x * NWAVES + __builtin_amdgcn_readfirstlane(threadIdx.x >> 6), NGW = gridDim.x * NWAVES;
    for (int it = item_lo + gw; it < item_hi; it += NGW) cvt_item(p, it, lane);
}

DI void ph_misc(const Params& p) {
    const size_t gt = (size_t)blockIdx.x * NTHREADS + threadIdx.x, NGT = (size_t)gridDim.x * NTHREADS;
    float* cosT = ws_cos(p); float* sinT = ws_sin(p);
    for (size_t i = gt; i < 1024 * 32; i += NGT) { const int s = (int)(i >> 5), f = (int)(i & 31);
        const float inv = powf(10000.f, -(float)(f & 15) / 16.f); const float pos = f < 16 ? (float)(s >> 6) : (float)(s & 63); const float ang = pos * inv;
        cosT[i] = cosf(ang); sinT[i] = sinf(ang); }
    bf16_t* ACT2 = wsp<bf16_t>(p, WS_ACT2); bf16_t* KPE = wsp<bf16_t>(p, WS_KPE); bf16_t* KO = wsp<bf16_t>(p, WS_KO); bf16_t* VTO = wsp<bf16_t>(p, WS_VTO);
    const float* cckv = p.in[2]; const float* ckpe = p.in[3]; const float* csk = p.in[4]; const float* csv = p.in[5];
    for (size_t i = gt; i < (size_t)TC * 256 / 4; i += NGT) { const size_t e = i * 4; const int j = (int)(e >> 8), cc = (int)(e & 255); const f32x4 v = *(const f32x4*)(cckv + e);
        u32x2 o; o.x = pk2(v[0], v[1]); o.y = pk2(v[2], v[3]); *(u32x2*)(ACT2 + (size_t)(T + j) * 1792 + 512 + cc) = o;
        const f32x4 k = *(const f32x4*)(csk + e); u32x2 o2; o2.x = pk2(k[0], k[1]); o2.y = pk2(k[2], k[3]); *(u32x2*)(KO + (size_t)(T + j) * 256 + cc) = o2; }
    for (size_t i = gt; i < (size_t)TC * 64 / 4; i += NGT) { const size_t e = i * 4; const f32x4 v = *(const f32x4*)(ckpe + e); u32x2 o; o.x = pk2(v[0], v[1]); o.y = pk2(v[2], v[3]); *(u32x2*)(KPE + (size_t)T * 64 + e) = o; }
    for (size_t i = gt; i < (size_t)256 * (TC / 8); i += NGT) { const int f = (int)(i / (TC / 8)), j8 = (int)(i % (TC / 8)) * 8; float v[8];
#pragma unroll
        for (int q = 0; q < 8; ++q) v[q] = csv[(size_t)(j8 + q) * 256 + f];
        u32x4 o; o.x = pk2(v[0], v[1]); o.y = pk2(v[2], v[3]); o.z = pk2(v[4], v[5]); o.w = pk2(v[6], v[7]); *(u32x4*)(VTO + (size_t)f * TX + T + j8) = o; }
}

DI void ph_h0(const Params& p) {
    const int lane = threadIdx.x & 63, gw = blockIdx.x * NWAVES + __builtin_amdgcn_readfirstlane(threadIdx.x >> 6), NGW = gridDim.x * NWAVES;
    bf16_t* H = wsp<bf16_t>(p, WS_H);
    for (int r = gw; r < T; r += NGW) {
        const int ci = cond_of_row(r); const float* x = xrow_in(p, r); const float* sh = modp(p, 0, ci, 0); const float* sc = modp(p, 0, ci, 1);
#pragma unroll
        for (int j = 0; j < 8; ++j) { const int c0 = lane * 4 + 256 * j; const f32x4 v = *(const f32x4*)(x + c0), a = *(const f32x4*)(sc + c0), b = *(const f32x4*)(sh + c0);
            const f32x4 h = v * (1.f + a) + b; u32x2 o; o.x = pk2(h[0], h[1]); o.y = pk2(h[2], h[3]); *(u32x2*)(H + (size_t)r * D + c0) = o; }
    }
}

DI void ph_e1(const Params& p) {
    const int lane = threadIdx.x & 63, gw = blockIdx.x * NWAVES + __builtin_amdgcn_readfirstlane(threadIdx.x >> 6), NGW = gridDim.x * NWAVES;
    const float* PJ = wsp<float>(p, WS_PJ); bf16_t* ACT2 = wsp<bf16_t>(p, WS_ACT2);
    const float* qn = p.in[11]; const float* kvn = p.in[12];
    for (int r = gw; r < T; r += NGW) {
        const float* pr = PJ + (size_t)r * 1792; bf16_t* ar = ACT2 + (size_t)r * 1792;
        {
            f32x4 v[2]; float ss = 0.f;
#pragma unroll
            for (int j = 0; j < 2; ++j) { v[j] = *(const f32x4*)(pr + lane * 4 + 256 * j); ss += (v[j][0] * v[j][0] + v[j][1] * v[j][1]) + (v[j][2] * v[j][2] + v[j][3] * v[j][3]); }
            const float rs = rsqrtf(wave_sum(ss) * (1.f / 512.f) + 1e-6f);
#pragma unroll
            for (int j = 0; j < 2; ++j) { const int c0 = lane * 4 + 256 * j; const f32x4 g = *(const f32x4*)(qn + c0); const f32x4 y = v[j] * rs * g; u32x2 o; o.x = pk2(y[0], y[1]); o.y = pk2(y[2], y[3]); *(u32x2*)(ar + c0) = o; }
        }
        {
            const int c0 = lane * 4; const f32x4 v = *(const f32x4*)(pr + 512 + c0); float ss = (v[0] * v[0] + v[1] * v[1]) + (v[2] * v[2] + v[3] * v[3]);
            const float rs = rsqrtf(wave_sum(ss) * (1.f / 256.f) + 1e-6f); const f32x4 g = *(const f32x4*)(kvn + c0); const f32x4 y = v * rs * g;
            u32x2 o; o.x = pk2(y[0], y[1]); o.y = pk2(y[2], y[3]); *(u32x2*)(ar + 512 + c0) = o;
            if (r < T_CTX) *(f32x4*)(p.out + O_CKV + (size_t)r * 256 + c0) = y;
        }
        {
            int s, S, rb; if (r < T_CTX) { s = r & 255; S = 256; rb = r - s; } else { s = (r - T_CTX) & 1023; S = 1024; rb = r - s; }
#pragma unroll
            for (int g = 0; g < 4; ++g) { const int half = 1 << g; const int lo = max(s - half, 0), hi = min(s + half, S); const int c0 = 768 + g * 256 + lane * 4;
                f32x4 sum = {0.f, 0.f, 0.f, 0.f};
                for (int t = lo; t < hi; ++t) sum += *(const f32x4*)(PJ + (size_t)(rb + t) * 1792 + c0);
                const f32x4 u = *(const f32x4*)(pr + c0); const f32x4 y = sum / (float)(hi - lo) - u;
                u32x2 o; o.x = pk2(y[0], y[1]); o.y = pk2(y[2], y[3]); *(u32x2*)(ar + c0) = o; }
        }
    }
}

DI void ph_ln1(const Params& p, int l, unsigned char* lds_raw) {
    const int tid = threadIdx.x, lane = tid & 63, gw = blockIdx.x * NWAVES + __builtin_amdgcn_readfirstlane(tid >> 6), NGW = gridDim.x * NWAVES;
    float* wT = (float*)lds_raw;
    const float* wr = p.in[23] + (size_t)l * 2048 * 16;
    for (int i = tid; i < 2048 * 16; i += NTHREADS) { const int d = i >> 4, e = i & 15; wT[e * 2048 + d] = wr[i]; }
    __syncthreads();
    const float* Y = wsp<float>(p, WS_Y); float* X1 = wsp<float>(p, WS_X1); bf16_t* H = wsp<bf16_t>(p, WS_H); float* AFF = wsp<float>(p, WS_AFF);
    const float* lg = p.in[21] + l * D; const float* lb = p.in[22] + l * D;
    for (int r = gw; r < T; r += NGW) {
        const int ci = cond_of_row(r); const float* sh = modp(p, l, ci, 3); const float* sc = modp(p, l, ci, 4);
        f32x4 v[8]; float s = 0.f;
#pragma unroll
        for (int j = 0; j < 8; ++j) { v[j] = *(const f32x4*)(Y + (size_t)r * D + lane * 4 + 256 * j); s += (v[j][0] + v[j][1]) + (v[j][2] + v[j][3]); }
        const float mean = wave_sum(s) * (1.f / D); float s2 = 0.f;
#pragma unroll
        for (int j = 0; j < 8; ++j) { v[j] = v[j] - mean; s2 += (v[j][0] * v[j][0] + v[j][1] * v[j][1]) + (v[j][2] * v[j][2] + v[j][3] * v[j][3]); }
        const float rstd = rsqrtf(wave_sum(s2) * (1.f / D) + 1e-5f);
#pragma unroll
        for (int j = 0; j < 8; ++j) { const int c0 = lane * 4 + 256 * j; const f32x4 x1 = v[j] * rstd * *(const f32x4*)(lg + c0) + *(const f32x4*)(lb + c0);
            *(f32x4*)(X1 + (size_t)r * D + c0) = x1;
            const f32x4 h = x1 * (1.f + *(const f32x4*)(sc + c0)) + *(const f32x4*)(sh + c0); v[j] = h;
            u32x2 o; o.x = pk2(h[0], h[1]); o.y = pk2(h[2], h[3]); *(u32x2*)(H + (size_t)r * D + c0) = o; }
        float mine = -1e30f;
#pragma unroll 2
        for (int e = 0; e < 16; ++e) { float a = 0.f;
#pragma unroll
            for (int j = 0; j < 8; ++j) { const f32x4 w = *(const f32x4*)(wT + e * 2048 + lane * 4 + 256 * j); a += (v[j][0] * w[0] + v[j][1] * w[1]) + (v[j][2] * w[2] + v[j][3] * w[3]); }
            a = wave_sum(a); mine = (lane == e) ? a : mine; }
        const float m = wave_max(mine);
        const float ex = lane < 16 ? expf(mine - m) : 0.f;
        const float den = wave_sum(ex);
        mine = ex;
        if (lane < 16) AFF[(size_t)r * 16 + lane] = mine / den;
    }
}

DI void ph_topk(const Params& p, unsigned char* lds_raw) {
    const int tid = threadIdx.x, lane = tid & 63, wave = __builtin_amdgcn_readfirstlane(tid >> 6);
    float* vals = (float*)lds_raw;
    int* sel = (int*)(vals + 1024);
    const float* AFF = wsp<float>(p, WS_AFF); int* INV = wsp<int>(p, WS_INV); const bf16_t* H = wsp<bf16_t>(p, WS_H); bf16_t* XS = wsp<bf16_t>(p, WS_XS);
    for (int it = blockIdx.x; it < 384; it += gridDim.x) {
        int n, cap, r0, e, sb;
        if (it < 256) { const int b = it >> 4; e = it & 15; n = 256; cap = 32; r0 = b * 256; sb = b * 32; }
        else { const int q = it - 256, b = q >> 4; e = q & 15; n = 1024; cap = 128; r0 = T_CTX + b * 1024; sb = 512 + b * 128; }
        for (int i = tid; i < n; i += NTHREADS) vals[i] = AFF[(size_t)(r0 + i) * 16 + e];
        __syncthreads();
        for (int i = tid; i < n; i += NTHREADS) { const float vi = vals[i]; int cnt = 0;
            for (int j = 0; j < n; ++j) { const float vj = vals[j]; cnt += (vj > vi || (vj == vi && j < i)) ? 1 : 0; }
            if (cnt < cap) { sel[cnt] = i; INV[(size_t)(r0 + i) * 16 + e] = sb + cnt; } else INV[(size_t)(r0 + i) * 16 + e] = -1; }
        __syncthreads();
        for (int k = wave; k < cap; k += NWAVES) { const int r = r0 + sel[k]; const u32x4* src = (const u32x4*)(H + (size_t)r * D); u32x4* dst = (u32x4*)(XS + (size_t)(e * NSLOT + sb + k) * D);
#pragma unroll
            for (int j = 0; j < 4; ++j) dst[lane + 64 * j] = src[lane + 64 * j]; }
        __syncthreads();
    }
}

DI void ph_ln2(const Params& p, int l) {
    const int lane = threadIdx.x & 63, gw = blockIdx.x * NWAVES + __builtin_amdgcn_readfirstlane(threadIdx.x >> 6), NGW = gridDim.x * NWAVES;
    const float* X1 = wsp<float>(p, WS_X1); const float* AFF = wsp<float>(p, WS_AFF); const int* INV = wsp<int>(p, WS_INV); const bf16_t* YE = wsp<bf16_t>(p, WS_YE);
    float* XL = wsp<float>(p, WS_XL); bf16_t* H = wsp<bf16_t>(p, WS_H);
    const float* lg = p.in[27] + l * D; const float* lb = p.in[28] + l * D;
    for (int r = gw; r < T; r += NGW) {
        const int ci = cond_of_row(r); const float* g2 = modp(p, l, ci, 5);
        f32x4 f[8];
#pragma unroll
        for (int j = 0; j < 8; ++j) f[j] = (f32x4){0.f, 0.f, 0.f, 0.f};
        for (int e = 0; e < 16; ++e) { const int slot = INV[(size_t)r * 16 + e]; if (slot < 0) continue; const float w = AFF[(size_t)r * 16 + e];
            const bf16_t* y = YE + (size_t)(e * NSLOT + slot) * D;
#pragma unroll
            for (int j = 0; j < 8; ++j) { const u32x2 q = *(const u32x2*)(y + lane * 4 + 256 * j); f[j][0] += w * bflo(q.x); f[j][1] += w * bfhi(q.x); f[j][2] += w * bflo(q.y); f[j][3] += w * bfhi(q.y); } }
        float s = 0.f;
#pragma unroll
        for (int j = 0; j < 8; ++j) { const int c0 = lane * 4 + 256 * j; f[j] = DN_ALPHA * *(const f32x4*)(X1 + (size_t)r * D + c0) + *(const f32x4*)(g2 + c0) * f[j]; s += (f[j][0] + f[j][1]) + (f[j][2] + f[j][3]); }
        const float mean = wave_sum(s) * (1.f / D); float s2 = 0.f;
#pragma unroll
        for (int j = 0; j < 8; ++j) { f[j] = f[j] - mean; s2 += (f[j][0] * f[j][0] + f[j][1] * f[j][1]) + (f[j][2] * f[j][2] + f[j][3] * f[j][3]); }
        const float rstd = rsqrtf(wave_sum(s2) * (1.f / D) + 1e-5f);
        const float* sh = modp(p, 1, ci, 0); const float* sc = modp(p, 1, ci, 1);
#pragma unroll
        for (int j = 0; j < 8; ++j) { const int c0 = lane * 4 + 256 * j; const f32x4 x = f[j] * rstd * *(const f32x4*)(lg + c0) + *(const f32x4*)(lb + c0);
            if (l == 0) { *(f32x4*)(XL + (size_t)r * D + c0) = x; const f32x4 h = x * (1.f + *(const f32x4*)(sc + c0)) + *(const f32x4*)(sh + c0);
                u32x2 o; o.x = pk2(h[0], h[1]); o.y = pk2(h[2], h[3]); *(u32x2*)(H + (size_t)r * D + c0) = o; }
            else *(f32x4*)(p.out + O_Y + (size_t)r * D + c0) = x; }
    }
}

struct Unit { const char* A; const char* B; unsigned lda, ldb; int nt; int pm, pn; int mode; int aux; };
DI int vcu_of(int bx, int G) { return (G % 8 == 0) ? (bx % 8) * (G / 8) + bx / 8 : bx; }

DI void rope8(const Params& p, int s, int pi0, float* v) {
    const f32x4 c = *(const f32x4*)(ws_cos(p) + s * 32 + pi0), sn = *(const f32x4*)(ws_sin(p) + s * 32 + pi0);
#pragma unroll
    for (int i = 0; i < 4; ++i) { const float x1 = v[2 * i], x2 = v[2 * i + 1]; v[2 * i] = x1 * c[i] - x2 * sn[i]; v[2 * i + 1] = x1 * sn[i] + x2 * c[i]; }
}
DI void st_bf16x8(bf16_t* dst, const float* v) { u32x4 w; w.x = pk2(v[0], v[1]); w.y = pk2(v[2], v[3]); w.z = pk2(v[4], v[5]); w.w = pk2(v[6], v[7]); *(u32x4*)dst = w; }
DI void st_f32x8(float* dst, const float* v) { *(f32x4*)dst = (f32x4){v[0], v[1], v[2], v[3]}; *(f32x4*)(dst + 4) = (f32x4){v[4], v[5], v[6], v[7]}; }

struct SchedInEven { const Params* p; int G, c;
    DI bool next(int i, Unit& u) const { const int L = i * G + c; if (L >= 48 * 8) return false; u.pm = L >> 3; u.pn = L & 7;
        u.A = (const char*)wsp<bf16_t>(*p, WS_H) + (size_t)u.pm * 256 * 4096; u.B = (const char*)wsp<bf16_t>(*p, WS_WINE) + (size_t)u.pn * 256 * 4096; u.lda = 4096; u.ldb = 4096; u.nt = 32; u.mode = 0; u.aux = 0; return true; } };
struct EpiInEven { static constexpr bool PAIR = false; const Params* p;
    DI void store(const Unit& u, int row, int col, float* v) const {
        const int r = u.pm * 256 + row, gc = u.pn * 256 + col;
        if (gc < 1792) { st_f32x8(wsp<float>(*p, WS_PJ) + (size_t)r * 1792 + gc, v); return; }
        if (gc >= 1856) return;
        const int j0 = gc - 1792;
        if (r < T_CTX) st_f32x8(p->out + O_KPE + (size_t)r * 64 + j0, v); else rope8(*p, (r - T_CTX) & 1023, j0 >> 1, v);
        st_bf16x8(wsp<bf16_t>(*p, WS_KPE) + (size_t)r * 64 + j0, v);
    } };

constexpr int E2_Q = 48 * 6, E2_K = 64 * 4, E2_V = 4 * 64, E2_P = 48 * 4, E2_TOTAL = E2_Q + E2_K + E2_V + E2_P;
struct SchedE2 { const Params* p; int G, c;
    DI bool next(int i, Unit& u) const { int L = i * G + c; if (L >= E2_TOTAL) return false;
        const char* ACT2 = (const char*)wsp<bf16_t>(*p, WS_ACT2); const char* W2 = (const char*)wsp<bf16_t>(*p, WS_W2); u.aux = 0;
        if (L < E2_Q) { u.mode = 0; u.pm = L / 6; u.pn = L % 6; u.A = ACT2 + (size_t)u.pm * 256 * 3584; u.lda = 3584; u.B = W2 + (size_t)u.pn * 256 * 3584; u.ldb = 3584; u.nt = 8; return true; }
        L -= E2_Q;
        if (L < E2_K) { u.mode = 1; u.pm = L >> 2; u.pn = L & 3; u.A = ACT2 + (size_t)u.pm * 256 * 3584 + 512 * 2; u.lda = 3584; u.B = W2 + (size_t)(1536 + u.pn * 256) * 3584; u.ldb = 3584; u.nt = 4; return true; }
        L -= E2_K;
        if (L < E2_V) { u.mode = 2; u.pm = L >> 6; u.pn = L & 63; u.A = W2 + (size_t)(2560 + u.pm * 256) * 3584; u.lda = 3584; u.B = ACT2 + (size_t)u.pn * 256 * 3584 + 512 * 2; u.ldb = 3584; u.nt = 4; return true; }
        L -= E2_V;
        u.mode = 3; u.pm = L >> 2; u.aux = L & 3; u.pn = 0; u.A = ACT2 + (size_t)u.pm * 256 * 3584 + (768 + u.aux * 256) * 2; u.lda = 3584; u.B = W2 + (size_t)(3584 + u.aux * 256) * 3584; u.ldb = 3584; u.nt = 4; return true; } };
struct EpiE2 { static constexpr bool PAIR = false; const Params* p;
    DI void store(const Unit& u, int row, int col, float* v) const {
        const int r = u.pm * 256 + row, gc = u.pn * 256 + col;
        if (u.mode == 0) { const int dd = gc % 192; if (dd >= 128 && r >= T_CTX) rope8(*p, (r - T_CTX) & 1023, (dd - 128) >> 1, v);
#pragma unroll
            for (int i = 0; i < 8; ++i) v[i] *= QS_MLA;
            st_bf16x8(wsp<bf16_t>(*p, WS_Q) + (size_t)r * 1536 + gc, v); }
        else if (u.mode == 1) st_bf16x8(wsp<bf16_t>(*p, WS_KN) + (size_t)r * 1024 + gc, v);
        else if (u.mode == 2) st_bf16x8(wsp<bf16_t>(*p, WS_VT) + (size_t)r * TX + gc, v);
        else { const float* ps = p->in[16] + u.aux * 256 + col;
#pragma unroll
            for (int i = 0; i < 8; ++i) v[i] *= ps[i];
            st_bf16x8(wsp<bf16_t>(*p, WS_MIX) + (size_t)r * 2048 + 1024 + u.aux * 256 + col, v); }
    } };

struct SchedOut { const Params* p; int G, c, l;
    DI bool next(int i, Unit& u) const { const int L = i * G + c; if (L >= 48 * 8) return false; u.pm = L >> 3; u.pn = L & 7;
        u.A = (const char*)wsp<bf16_t>(*p, WS_MIX) + (size_t)u.pm * 256 * 4096; u.B = (const char*)wsp<bf16_t>(*p, l == 0 ? WS_WOUTE : WS_WOUTO) + (size_t)u.pn * 256 * 4096; u.lda = 4096; u.ldb = 4096; u.nt = 32; u.mode = 0; u.aux = 0; return true; } };
struct EpiOut { static constexpr bool PAIR = false; const Params* p; int l;
    DI void store(const Unit& u, int row, int col, float* v) const {
        const int r = u.pm * 256 + row, gc = u.pn * 256 + col;
        const float* x = (l == 0 ? xrow_in(*p, r) : wsp<float>(*p, WS_XL) + (size_t)r * D) + gc; const float* g1 = modp(*p, l, cond_of_row(r), 2) + gc;
        const f32x4 x0 = *(const f32x4*)x, x1 = *(const f32x4*)(x + 4), g0 = *(const f32x4*)g1, g4 = *(const f32x4*)(g1 + 4);
#pragma unroll
        for (int i = 0; i < 4; ++i) { v[i] = DN_ALPHA * x0[i] + g0[i] * v[i]; v[4 + i] = DN_ALPHA * x1[i] + g4[i] * v[4 + i]; }
        st_f32x8(wsp<float>(*p, WS_Y) + (size_t)r * D + gc, v);
    } };

struct SchedGU { const Params* p; int G, c, l;
    DI bool next(int i, Unit& u) const { const int L = i * G + c; if (L >= 16 * 96) return false; const int e = L / 96, rem = L % 96; u.pn = rem / 6; u.pm = e * 6 + rem % 6; u.aux = e;
        u.A = (const char*)wsp<bf16_t>(*p, WS_XS) + (size_t)u.pm * 256 * 4096; u.B = (const char*)wsp<bf16_t>(*p, WS_WGU) + ((size_t)(l * 16 + e) * 4096 + (size_t)u.pn * 256) * 4096; u.lda = 4096; u.ldb = 4096; u.nt = 32; u.mode = 0; return true; } };
struct EpiGU { static constexpr bool PAIR = true; const Params* p;
    DI void store2(const Unit& u, int row, int col, const float* g, const float* up) const {
        float h[8];
#pragma unroll
        for (int i = 0; i < 8; ++i) h[i] = g[i] / (1.f + __expf(-g[i])) * up[i];
        st_bf16x8(wsp<bf16_t>(*p, WS_HID) + (size_t)(u.pm * 256 + row) * D + u.pn * 128 + col, h);
    } };

struct SchedDown { const Params* p; int G, c, l;
    DI bool next(int i, Unit& u) const { const int L = i * G + c; if (L >= 16 * 48) return false; const int e = L / 48, rem = L % 48; u.pn = rem / 6; u.pm = e * 6 + rem % 6; u.aux = e;
        u.A = (const char*)wsp<bf16_t>(*p, WS_HID) + (size_t)u.pm * 256 * 4096; u.B = (const char*)wsp<bf16_t>(*p, WS_WDN) + ((size_t)(l * 16 + e) * 2048 + (size_t)u.pn * 256) * 4096; u.lda = 4096; u.ldb = 4096; u.nt = 32; u.mode = 0; return true; } };
struct EpiDown { static constexpr bool PAIR = false; const Params* p;
    DI void store(const Unit& u, int row, int col, float* v) const { st_bf16x8(wsp<bf16_t>(*p, WS_YE) + (size_t)(u.pm * 256 + row) * D + u.pn * 256 + col, v); } };

constexpr int IO_QK = 48 * 9, IO_V = 16, IO_VT = 48, IO_TOTAL = IO_QK + IO_V + IO_VT;
struct SchedInOdd { const Params* p; int G, c;
    DI bool next(int i, Unit& u) const { int L = i * G + c; if (L >= IO_TOTAL) return false;
        const char* Hb = (const char*)wsp<bf16_t>(*p, WS_H); const char* W = (const char*)wsp<bf16_t>(*p, WS_WINO); u.aux = 0; u.nt = 32; u.lda = 4096; u.ldb = 4096;
        if (L < IO_QK) { u.mode = 0; u.pm = L / 9; u.pn = L % 9; u.A = Hb + (size_t)u.pm * 256 * 4096; u.B = W + (size_t)u.pn * 256 * 4096; return true; }
        L -= IO_QK;
        if (L < IO_V) { u.mode = 1; u.pm = L; u.pn = 9; u.A = Hb + (size_t)u.pm * 256 * 4096; u.B = W + (size_t)9 * 256 * 4096; return true; }
        L -= IO_V;
        u.mode = 2; u.pm = 0; u.pn = L; u.A = W + (size_t)9 * 256 * 4096; u.B = Hb + (size_t)u.pn * 256 * 4096; return true; } };
struct EpiInOdd { static constexpr bool PAIR = false; const Params* p;
    DI void store(const Unit& u, int row, int col, float* v) const {
        const int r = u.pm * 256 + row, gc = u.pn * 256 + col;
        if (u.mode == 0) {
            if (gc < 2048) { if (r >= T_CTX) rope8(*p, (r - T_CTX) & 1023, (gc & 63) >> 1, v);
#pragma unroll
                for (int i = 0; i < 8; ++i) v[i] *= QS_SWA;
                st_bf16x8(wsp<bf16_t>(*p, WS_Q) + (size_t)r * 2048 + gc, v); }
            else { const int kc = gc - 2048; if (r < T_CTX) st_f32x8(p->out + O_SK + (size_t)r * 256 + kc, v); else rope8(*p, (r - T_CTX) & 1023, (kc & 63) >> 1, v);
                st_bf16x8(wsp<bf16_t>(*p, WS_KO) + (size_t)r * 256 + kc, v); } }
        else if (u.mode == 1) st_f32x8(p->out + O_SV + (size_t)r * 256 + col, v);
        else st_bf16x8(wsp<bf16_t>(*p, WS_VTO) + (size_t)row * TX + gc, v);
    } };

namespace pg8 {
typedef short bf16x8 __attribute__((ext_vector_type(8)));
constexpr int BM = 256, BK = 64, HALF = 128, HTB = HALF * BK * 2  , STAGE_BYTES = 8 * HTB;
DI int lds_byte(int r, int c) { const int st = (r >> 4) * 2 + (c >> 5), rr = r & 15, cc = c & 31, ob = rr * 64 + cc * 2; return st * 1024 + (ob ^ (((ob >> 9) & 1) << 5)); }
DI void stage_rc(int b, int& R, int& C) { const int st = b / 1024, sb = b % 1024, swz = sb ^ (((sb >> 9) & 1) << 5); R = (st >> 1) * 16 + swz / 64; C = (st & 1) * 32 + (swz % 64) / 2; }
DI int perm32(int rho) { const int n = rho >> 4, i = rho & 15; return 8 * (i >> 2) + 4 * n + (i & 3); }

template <class Epi, class Sched, bool ALIGN_EPI = true>
DI void gemm_phase(LAS unsigned char* lds, const Sched& S, const Epi& E) {
    const int tid = threadIdx.x, wid = __builtin_amdgcn_readfirstlane(tid >> 6), lane = tid & 63, wr = wid >> 2, wc = wid & 3, fr = lane & 15, fq = lane >> 4;
    int RA[2], RB[2], CB[2];
#pragma unroll
    for (int i = 0; i < 2; ++i) { int R, C; stage_rc(tid * 16 + i * 8192, R, C); RA[i] = R; RB[i] = (R & ~31) + perm32(R & 31); CB[i] = C * 2; }
    constexpr size_t kstep = (size_t)(BK * 2);
    const unsigned ldsw = (unsigned)wid * 1024u;
    const int aoff = lds_byte(wr * 64 + fr, fq * 8), boff = lds_byte(wc * 32 + fr, fq * 8);
#define PG8_SA(b, h) (((b) * 2 + (h)) * HTB)
#define PG8_SB(b, h) ((4 + (b) * 2 + (h)) * HTB)
#define PG8_STAGE(bufoff, gbase, v0, v1) do { \
        __builtin_amdgcn_global_load_lds((const unsigned*)((const char*)(gbase) + (v0)), (LAS unsigned*)(lds + (bufoff) + ldsw), 16, 0, 0); \
        __builtin_amdgcn_global_load_lds((const unsigned*)((const char*)(gbase) + (v1)), (LAS unsigned*)(lds + (bufoff) + ldsw + 8192), 16, 0, 0); } while (0)
#define PG8_LDA(dst, b, h) do { _Pragma("unroll") for (int m = 0; m < 4; ++m) _Pragma("unroll") for (int k = 0; k < 2; ++k) dst[m][k] = *(const LAS bf16x8*)(lds + PG8_SA(b, h) + aoff + m * 2048 + k * 1024); } while (0)
#define PG8_LDB(dst, b, h) do { _Pragma("unroll") for (int n = 0; n < 2; ++n) _Pragma("unroll") for (int k = 0; k < 2; ++k) dst[n][k] = *(const LAS bf16x8*)(lds + PG8_SB(b, h) + boff + n * 2048 + k * 1024); } while (0)
#define PG8_MMA(ai, bj, At, Bt) do { __builtin_amdgcn_s_setprio(1); _Pragma("unroll") for (int m = 0; m < 4; ++m) _Pragma("unroll") for (int n = 0; n < 2; ++n) _Pragma("unroll") for (int k = 0; k < 2; ++k) \
        acc[ai][bj][m][n] = __builtin_amdgcn_mfma_f32_16x16x32_bf16(Bt[n][k], At[m][k], acc[ai][bj][m][n], 0, 0, 0); __builtin_amdgcn_s_setprio(0); } while (0)
#define PG8_WAIT_V(n) asm volatile("s_waitcnt vmcnt(" #n ")" ::: "memory")
#define PG8_WAIT_L(n) asm volatile("s_waitcnt lgkmcnt(" #n ")" ::: "memory")
#define PG8_BAR __builtin_amdgcn_s_barrier()
#define PG8_SCHED __builtin_amdgcn_sched_barrier(0)
    Unit cur, nxt; int ui = 0;
    if (!S.next(0, cur)) return;
    f32x4 acc[2][2][4][2];
#pragma unroll
    for (int a = 0; a < 2; ++a)
#pragma unroll
        for (int b = 0; b < 2; ++b)
#pragma unroll
            for (int m = 0; m < 4; ++m)
#pragma unroll
                for (int n = 0; n < 2; ++n) acc[a][b][m][n] = (f32x4){0.f, 0.f, 0.f, 0.f};
    bf16x8 At[4][2], B0[2][2], B1[2][2];
    const char* cA = cur.A; const char* cB = cur.B;
    const unsigned ld = cur.lda;
    const unsigned vA0 = RA[0] * ld + CB[0], vA1 = RA[1] * ld + CB[1], vB0 = RB[0] * ld + CB[0], vB1 = RB[1] * ld + CB[1];
    const size_t hA = (size_t)HALF * ld, hB = hA;
    PG8_STAGE(PG8_SB(0, 0), cB, vB0, vB1); PG8_STAGE(PG8_SB(0, 1), cB + hB, vB0, vB1); PG8_STAGE(PG8_SA(0, 0), cA, vA0, vA1); PG8_STAGE(PG8_SA(0, 1), cA + hA, vA0, vA1);
    if (wr == 1) PG8_BAR;
    PG8_WAIT_V(2); PG8_BAR;
    PG8_STAGE(PG8_SB(1, 0), cB + kstep, vB0, vB1); PG8_STAGE(PG8_SA(1, 0), cA + kstep, vA0, vA1); PG8_STAGE(PG8_SB(1, 1), cB + hB + kstep, vB0, vB1);
    PG8_WAIT_V(6); PG8_BAR;
    for (;;) {
        const bool has_next = S.next(ui + 1, nxt);
        const char* nA = has_next ? nxt.A : cA; const char* nB = has_next ? nxt.B : cB;
        const int nt = cur.nt;
        for (int t = 0; t < nt; t += 2) {
            const bool last = (t == nt - 2);
            const char* a1 = cA + (size_t)(t + 1) * kstep;
            const char* a2 = last ? nA : cA + (size_t)(t + 2) * kstep; const char* b2 = last ? nB : cB + (size_t)(t + 2) * kstep;
            const char* a3 = a2 + kstep; const char* b3 = b2 + kstep;
            PG8_LDB(B0, 0, 0); PG8_LDB(B1, 0, 1); PG8_SCHED; PG8_LDA(At, 0, 0); PG8_STAGE(PG8_SA(1, 1), a1 + hA, vA0, vA1);
            PG8_WAIT_V(8); PG8_WAIT_L(0); PG8_BAR; PG8_MMA(0, 0, At, B0); PG8_MMA(0, 1, At, B1); PG8_BAR; PG8_SCHED;
            PG8_LDA(At, 0, 1); PG8_STAGE(PG8_SB(0, 0), b2, vB0, vB1); PG8_STAGE(PG8_SB(0, 1), b2 + hB, vB0, vB1); PG8_STAGE(PG8_SA(0, 0), a2, vA0, vA1);
            PG8_WAIT_V(8); PG8_WAIT_L(0); PG8_BAR; PG8_MMA(1, 0, At, B0); PG8_MMA(1, 1, At, B1); PG8_BAR; PG8_SCHED;
            PG8_LDB(B0, 1, 0); PG8_LDB(B1, 1, 1); PG8_SCHED; PG8_LDA(At, 1, 0); PG8_STAGE(PG8_SA(0, 1), a2 + hA, vA0, vA1);
            PG8_WAIT_V(8); PG8_WAIT_L(0); PG8_BAR; PG8_MMA(0, 0, At, B0); PG8_MMA(0, 1, At, B1); PG8_BAR; PG8_SCHED;
            PG8_LDA(At, 1, 1); PG8_STAGE(PG8_SB(1, 0), b3, vB0, vB1); PG8_STAGE(PG8_SB(1, 1), b3 + hB, vB0, vB1); PG8_STAGE(PG8_SA(1, 0), a3, vA0, vA1);
            PG8_WAIT_V(8); PG8_WAIT_L(0); PG8_BAR; PG8_MMA(1, 0, At, B0); PG8_MMA(1, 1, At, B1); PG8_BAR; PG8_SCHED;
        }
        if constexpr (ALIGN_EPI) { if (wr == 0) PG8_BAR; }
        {
            int fr_ = fr, fq_ = fq; asm volatile("" : "+v"(fr_), "+v"(fq_));
#pragma unroll
            for (int ai = 0; ai < 2; ++ai)
#pragma unroll
                for (int m = 0; m < 4; ++m) { const int row = ai * HALF + wr * 64 + m * 16 + fr_;
                    if constexpr (Epi::PAIR) { float g[8], up[8];
#pragma unroll
                        for (int j = 0; j < 4; ++j) { g[j] = acc[ai][0][m][0][j]; g[4 + j] = acc[ai][0][m][1][j]; up[j] = acc[ai][1][m][0][j]; up[4 + j] = acc[ai][1][m][1][j]; }
                        E.store2(cur, row, wc * 32 + 8 * fq_, g, up); }
                    else {
#pragma unroll
                        for (int bj = 0; bj < 2; ++bj) { float v[8];
#pragma unroll
                            for (int j = 0; j < 4; ++j) { v[j] = acc[ai][bj][m][0][j]; v[4 + j] = acc[ai][bj][m][1][j]; }
                            E.store(cur, row, bj * HALF + wc * 32 + 8 * fq_, v); } } }
        }
        if (!has_next) break;
#pragma unroll
        for (int a = 0; a < 2; ++a)
#pragma unroll
            for (int b = 0; b < 2; ++b)
#pragma unroll
                for (int m = 0; m < 4; ++m)
#pragma unroll
                    for (int n = 0; n < 2; ++n) acc[a][b][m][n] = (f32x4){0.f, 0.f, 0.f, 0.f};
        cur = nxt; cA = nA; cB = nB; ++ui;
        if constexpr (ALIGN_EPI) { if (wr == 1) PG8_BAR; }
    }
    PG8_WAIT_V(0);
    if constexpr (!ALIGN_EPI) { if (wr == 0) PG8_BAR; }
    PG8_BAR;
#undef PG8_SA
#undef PG8_SB
#undef PG8_STAGE
#undef PG8_LDA
#undef PG8_LDB
#undef PG8_MMA
#undef PG8_WAIT_V
#undef PG8_WAIT_L
#undef PG8_BAR
#undef PG8_SCHED
}
}

namespace att {
typedef short bf16x8 __attribute__((ext_vector_type(8)));
typedef short s16x4 __attribute__((ext_vector_type(4)));
typedef float f32x16 __attribute__((ext_vector_type(16)));
typedef float f32x2_t __attribute__((ext_vector_type(2)));
typedef __bf16 bf16x2_t __attribute__((ext_vector_type(2)));
DI unsigned cvtpk(float lo, float hi) { f32x2_t v = {lo, hi}; bf16x2_t b = __builtin_convertvector(v, bf16x2_t); return __builtin_bit_cast(unsigned, b); }
DI int crow(int r, int h) { return (r & 3) + 8 * (r >> 2) + 4 * h; }

template <bool SWA>
DI void attn_phase(const Params& p, LAS unsigned char* lds, int G, int c) {
    constexpr int DK = SWA ? 64 : 192, DV = SWA ? 64 : 128, KSTR = DK * 2 + 16, VSTR = 136;
    constexpr int KB = 64 * KSTR, VB = DV * VSTR, STG = KB + VB;
    constexpr int CPR = DK / 8, NKC = (64 * CPR) / NTHREADS, NVC = (DV * 8) / NTHREADS, NQ = DK / 16, NDV = DV / 32;
    constexpr int LDQ = SWA ? 2048 : 1536, NUNITS = SWA ? 1536 : 384;
    static_assert(2 * STG <= 131072, "attention LDS");
    const int tid = threadIdx.x, lane = tid & 63, wid = __builtin_amdgcn_readfirstlane(tid >> 6), q = lane & 31, hh = lane >> 5;
    const bf16_t* Q = wsp<bf16_t>(p, WS_Q); const bf16_t* KN = wsp<bf16_t>(p, SWA ? WS_KO : WS_KN); const bf16_t* KPE = wsp<bf16_t>(p, WS_KPE);
    const bf16_t* VT = wsp<bf16_t>(p, SWA ? WS_VTO : WS_VT); bf16_t* MIX = wsp<bf16_t>(p, WS_MIX);
    for (int L = c; L < NUNITS; L += G) {
        int rowbase, hk, nt0, nt1, key0a, key0b = 0, kpos0 = 0, qpos0 = 0; bool masked = false;
        if (!SWA) {
            if (L < 256) { const int b = L >> 5, qt = L & 3; hk = (L >> 2) & 7; rowbase = T_CTX + b * 1024 + qt * 256; key0a = T_CTX + b * 1024; nt0 = 16; key0b = T + b * 512; nt1 = 8; }
            else { const int Lc = L - 256, b = Lc >> 3; hk = Lc & 7; rowbase = b * 256; key0a = b * 256; nt0 = 4; nt1 = 0; }
        } else {
            if (L < 1024) { const int b = L >> 7, t0 = (L & 31) * 32; hk = (L >> 5) & 3; rowbase = T_CTX + b * 1024 + t0;
                const int lo = max(t0 - 128, 0) & ~63, hi = min((t0 + 160 + 63) & ~63, 1024);
                key0a = T_CTX + b * 1024 + lo; nt0 = (hi - lo) >> 6; kpos0 = lo; qpos0 = t0; masked = true; key0b = T + b * 512; nt1 = 8; }
            else { const int Lc = L - 1024, b = Lc >> 5; hk = (Lc >> 3) & 3; rowbase = b * 256 + (Lc & 7) * 32; key0a = b * 256; nt0 = 4; nt1 = 0; }
        }
        const int total = nt0 + nt1;
        const int qrow = SWA ? rowbase + q : rowbase + wid * 32 + q;
        const int qhead = SWA ? hk * 8 + wid : hk;
        bf16x8 qf[NQ];
#pragma unroll
        for (int s = 0; s < NQ; ++s) qf[s] = *(const bf16x8*)(Q + (size_t)qrow * LDQ + qhead * DK + 16 * s + 8 * hh);
        f32x16 o[NDV];
#pragma unroll
        for (int d = 0; d < NDV; ++d)
#pragma unroll
            for (int r = 0; r < 16; ++r) o[d][r] = 0.f;
        float m = SWA ? p.in[19][qhead] * LOG2E : -1e30f, l = (SWA && hh == 0) ? 1.f : 0.f;
        const int qpos = qpos0 + q;
        u32x4 kreg[NKC], vreg[NVC];
#define ATT_LOAD(t_) do { const int tt_ = (t_); const int kb_ = tt_ < nt0 ? key0a + tt_ * 64 : key0b + (tt_ - nt0) * 64; \
            _Pragma("unroll") for (int i = 0; i < NKC; ++i) { const int ch = tid + NTHREADS * i, j = ch / CPR, cc = ch % CPR; \
                const bf16_t* src = SWA ? KN + (size_t)(kb_ + j) * 256 + hk * 64 + cc * 8 : (cc < 16 ? KN + (size_t)(kb_ + j) * 1024 + hk * 128 + cc * 8 : KPE + (size_t)(kb_ + j) * 64 + (cc - 16) * 8); \
                kreg[i] = *(const u32x4*)src; } \
            _Pragma("unroll") for (int i = 0; i < NVC; ++i) { const int ch = tid + NTHREADS * i, dv = ch >> 3, cc = ch & 7; \
                vreg[i] = *(const u32x4*)(VT + (size_t)(hk * DV + dv) * TX + kb_ + cc * 8); } } while (0)
#define ATT_WRITE(buf_) do { LAS unsigned char* Kw = lds + (buf_) * STG; LAS unsigned char* Vw = Kw + KB; \
            _Pragma("unroll") for (int i = 0; i < NKC; ++i) { const int ch = tid + NTHREADS * i, j = ch / CPR, cc = ch % CPR; *(LAS u32x4*)(Kw + j * KSTR + cc * 16) = kreg[i]; } \
            _Pragma("unroll") for (int i = 0; i < NVC; ++i) { const int ch = tid + NTHREADS * i, dv = ch >> 3, cc = ch & 7; \
                *(LAS u32x2*)(Vw + dv * VSTR + cc * 16) = (u32x2){vreg[i].x, vreg[i].y}; *(LAS u32x2*)(Vw + dv * VSTR + cc * 16 + 8) = (u32x2){vreg[i].z, vreg[i].w}; } } while (0)
        ATT_LOAD(0); ATT_WRITE(0);
        __syncthreads();
        for (int t = 0; t < total; ++t) {
            const int buf = t & 1;
            if (t + 1 < total) ATT_LOAD(t + 1);
            const LAS unsigned char* Kl = lds + buf * STG; const LAS unsigned char* Vl = Kl + KB;
            f32x16 s0, s1;
#pragma unroll
            for (int r = 0; r < 16; ++r) { s0[r] = 0.f; s1[r] = 0.f; }
#pragma unroll
            for (int s = 0; s < NQ; ++s) {
                const bf16x8 a0 = *(const LAS bf16x8*)(Kl + q * KSTR + (16 * s + 8 * hh) * 2);
                const bf16x8 a1 = *(const LAS bf16x8*)(Kl + (32 + q) * KSTR + (16 * s + 8 * hh) * 2);
                s0 = __builtin_amdgcn_mfma_f32_32x32x16_bf16(a0, qf[s], s0, 0, 0, 0);
                s1 = __builtin_amdgcn_mfma_f32_32x32x16_bf16(a1, qf[s], s1, 0, 0, 0);
            }
            if (SWA && masked && t < nt0) {
                const int kp = kpos0 + t * 64 - qpos;
#pragma unroll
                for (int r = 0; r < 16; ++r) { const int d0 = kp + crow(r, hh), d1 = d0 + 32;
                    s0[r] = (d0 >= -128 && d0 <= 128) ? s0[r] : -1e30f; s1[r] = (d1 >= -128 && d1 <= 128) ? s1[r] : -1e30f; }
            }
            float tm = fmaxf(s0[0], s1[0]);
#pragma unroll
            for (int r = 1; r < 16; ++r) tm = fmaxf(tm, fmaxf(s0[r], s1[r]));
            tm = fmaxf(tm, __shfl_xor(tm, 32));
            const float mn = fmaxf(m, tm), alpha = __builtin_amdgcn_exp2f(m - mn); m = mn;
            l *= alpha;
#pragma unroll
            for (int d = 0; d < NDV; ++d)
#pragma unroll
                for (int r = 0; r < 16; ++r) o[d][r] *= alpha;
            float ls = 0.f;
#pragma unroll
            for (int r = 0; r < 16; ++r) { s0[r] = __builtin_amdgcn_exp2f(s0[r] - m); s1[r] = __builtin_amdgcn_exp2f(s1[r] - m); ls += s0[r] + s1[r]; }
            l += ls;
            bf16x8 pb[2][2];
#pragma unroll
            for (int s = 0; s < 2; ++s) {
                u32x4 w0, w1;
                w0.x = cvtpk(s0[8 * s + 0], s0[8 * s + 1]); w0.y = cvtpk(s0[8 * s + 2], s0[8 * s + 3]); w0.z = cvtpk(s0[8 * s + 4], s0[8 * s + 5]); w0.w = cvtpk(s0[8 * s + 6], s0[8 * s + 7]);
                w1.x = cvtpk(s1[8 * s + 0], s1[8 * s + 1]); w1.y = cvtpk(s1[8 * s + 2], s1[8 * s + 3]); w1.z = cvtpk(s1[8 * s + 4], s1[8 * s + 5]); w1.w = cvtpk(s1[8 * s + 6], s1[8 * s + 7]);
                pb[0][s] = __builtin_bit_cast(bf16x8, w0); pb[1][s] = __builtin_bit_cast(bf16x8, w1);
            }
#pragma unroll
            for (int d = 0; d < NDV; ++d)
#pragma unroll
                for (int blk = 0; blk < 2; ++blk)
#pragma unroll
                    for (int s = 0; s < 2; ++s) {
                        const LAS unsigned char* vp = Vl + (d * 32 + q) * VSTR + (blk * 32 + 16 * s + 4 * hh) * 2;
                        const s16x4 lo = *(const LAS s16x4*)vp, hi = *(const LAS s16x4*)(vp + 16);
                        const bf16x8 a = {lo[0], lo[1], lo[2], lo[3], hi[0], hi[1], hi[2], hi[3]};
                        o[d] = __builtin_amdgcn_mfma_f32_32x32x16_bf16(a, pb[blk][s], o[d], 0, 0, 0);
                    }
            if (t + 1 < total) ATT_WRITE(buf ^ 1);
            __syncthreads();
        }
#undef ATT_LOAD
#undef ATT_WRITE
        const float inv = 1.f / (l + __shfl_xor(l, 32));
        bf16_t* orow = MIX + (size_t)qrow * 2048 + qhead * DV;
#pragma unroll
        for (int d = 0; d < NDV; ++d)
#pragma unroll
            for (int g = 0; g < 4; ++g) { u32x2 w; w.x = cvtpk(o[d][4 * g] * inv, o[d][4 * g + 1] * inv); w.y = cvtpk(o[d][4 * g + 2] * inv, o[d][4 * g + 3] * inv);
                *(u32x2*)(orow + d * 32 + 8 * g + 4 * hh) = w; }
    }
}
}

constexpr int LDS_BYTES = 147456, MISC_OFF = 146432;
constexpr int NPH = 20;
__global__ void __launch_bounds__(NTHREADS, 2) mega(Params p) {
    extern __shared__ __attribute__((aligned(16))) unsigned char lds[];
    const int G = gridDim.x, c = vcu_of(blockIdx.x, G);
    volatile LAS unsigned* MISC = (volatile LAS unsigned*)((LAS unsigned char*)lds + MISC_OFF);
    if (threadIdx.x < 4) MISC[threadIdx.x] = 0u;
    __syncthreads();
    XcdBarrier bar = xcd_barrier_post((unsigned*)(p.ws + WS_CTL) + CW_BAR, MISC);
    const int lo = p.ph_lo, hi = p.ph_hi;
#define IN(k) (lo <= (k) && (k) < hi)
#define SEAM(k) do { if (IN(k) && IN((k) + 1)) xcd_barrier(bar); } while (0)
    if (IN(0)) { ph_mod(p, lds); ph_misc(p); ph_convert(p, 0, CV_TOTAL); } SEAM(0);
    if (IN(1)) ph_h0(p); SEAM(1);
    if (IN(2)) { SchedInEven S{&p, G, c}; EpiInEven E{&p}; pg8::gemm_phase((LAS unsigned char*)lds, S, E); } SEAM(2);
    if (IN(3)) ph_e1(p); SEAM(3);
    if (IN(4)) { SchedE2 S{&p, G, c}; EpiE2 E{&p}; pg8::gemm_phase((LAS unsigned char*)lds, S, E); } SEAM(4);
    if (IN(5)) att::attn_phase<false>(p, (LAS unsigned char*)lds, G, c); SEAM(5);
    if (IN(6)) { SchedOut S{&p, G, c, 0}; EpiOut E{&p, 0}; pg8::gemm_phase((LAS unsigned char*)lds, S, E); } SEAM(6);
    if (IN(7)) ph_ln1(p, 0, lds); SEAM(7);
    if (IN(8)) ph_topk(p, lds); SEAM(8);
    if (IN(9)) { SchedGU S{&p, G, c, 0}; EpiGU E{&p}; pg8::gemm_phase((LAS unsigned char*)lds, S, E); } SEAM(9);
    if (IN(10)) { SchedDown S{&p, G, c, 0}; EpiDown E{&p}; pg8::gemm_phase((LAS unsigned char*)lds, S, E); } SEAM(10);
    if (IN(11)) ph_ln2(p, 0); SEAM(11);
    if (IN(12)) { SchedInOdd S{&p, G, c}; EpiInOdd E{&p}; pg8::gemm_phase((LAS unsigned char*)lds, S, E); } SEAM(12);
    if (IN(13)) att::attn_phase<true>(p, (LAS unsigned char*)lds, G, c); SEAM(13);
    if (IN(14)) { SchedOut S{&p, G, c, 1}; EpiOut E{&p, 1}; pg8::gemm_phase((LAS unsigned char*)lds, S, E); } SEAM(14);
    if (IN(15)) ph_ln1(p, 1, lds); SEAM(15);
    if (IN(16)) ph_topk(p, lds); SEAM(16);
    if (IN(17)) { SchedGU S{&p, G, c, 1}; EpiGU E{&p}; pg8::gemm_phase((LAS unsigned char*)lds, S, E); } SEAM(17);
    if (IN(18)) { SchedDown S{&p, G, c, 1}; EpiDown E{&p}; pg8::gemm_phase((LAS unsigned char*)lds, S, E); } SEAM(18);
    if (IN(19)) ph_ln2(p, 1);
#undef IN
#undef SEAM
}

extern "C" void kernel_launch(void* const* d_in, const int* in_sizes, int n_in, void* d_out, int out_size, void* d_ws, size_t ws_size, hipStream_t stream) {
    static int grid = 0;
    if (grid == 0) {
        if (n_in != 29 || out_size != (int)O_END || ws_size < WS_END) { fprintf(stderr, "kernel_launch: unexpected shapes (n_in %d out %d ws %zu need %zu)\n", n_in, out_size, ws_size, (size_t)WS_END); grid = -1; return; }
        int dev = 0, cus = 0, per_cu = 0;
        if (hipGetDevice(&dev) != hipSuccess || hipDeviceGetAttribute(&cus, hipDeviceAttributeMultiprocessorCount, dev) != hipSuccess) { grid = -1; return; }
        if (hipFuncSetAttribute((const void*)mega, hipFuncAttributeMaxDynamicSharedMemorySize, LDS_BYTES) != hipSuccess) { fprintf(stderr, "hipFuncSetAttribute failed\n"); grid = -1; return; }
        if (hipOccupancyMaxActiveBlocksPerMultiprocessor(&per_cu, (const void*)mega, NTHREADS, LDS_BYTES) != hipSuccess || per_cu < 1) fprintf(stderr, "occupancy query: %d\n", per_cu);
        (void)hipGetLastError();
        grid = cus > 0 ? cus : 256;
    }
    if (grid < 0) return;
    Params p{};
    for (int i = 0; i < 29; ++i) p.in[i] = (const float*)d_in[i];
    p.out = (float*)d_out; p.ws = (unsigned char*)d_ws; p.ph_lo = 0; p.ph_hi = NPH;
    (void)hipMemsetAsync((char*)d_ws + WS_CTL, 0, CTL_BYTES, stream);
    hipLaunchKernelGGL(mega, dim3(grid), dim3(NTHREADS), LDS_BYTES, stream, p);
}
```

```cpp
#include <hip/hip_runtime.h>
#include <cstdio>
#include <cstdint>

constexpr int D = 2048, T_CTX = 4096, T = 12288, TC = 4096, TX = 16384;
constexpr int MODW = 12288, NCOND = 9;
constexpr int NSLOT = 1536, NXS = 16 * NSLOT;
constexpr float DN_ALPHA = 1.41421356237309515f;
constexpr float LOG2E = 1.44269504088896341f;
constexpr float QS_MLA = 0.07216878364870322f * LOG2E;
constexpr float QS_SWA = 0.125f * LOG2E;
constexpr int NTHREADS = 512, NWAVES = 8;
#ifndef MOE_F8
#define MOE_F8 1
#endif
constexpr float GU_WSCALE = 32.f, DN_WSCALE = 64.f;

constexpr size_t O_Y = 0, O_CKV = 25165824, O_KPE = 26214400, O_SK = 26476544, O_SV = 27525120, O_END = 28573696;

constexpr size_t al256(size_t x) { return (x + 255) & ~(size_t)255; }
constexpr size_t WS_CTL = 0, CTL_BYTES = 1u << 20;
constexpr size_t WS_MOD = WS_CTL + CTL_BYTES;
constexpr size_t WS_ROPE = WS_MOD + al256((size_t)2 * 9 * 12288 * 4);
constexpr size_t WS_WINE = WS_ROPE + al256((size_t)2 * 1024 * 32 * 4);
constexpr size_t WS_W2 = WS_WINE + (size_t)2048 * 2048 * 2;
constexpr size_t WS_WOUTE = WS_W2 + (size_t)4608 * 1792 * 2;
constexpr size_t WS_WINO = WS_WOUTE + (size_t)2048 * 2048 * 2;
constexpr size_t WS_WOUTO = WS_WINO + (size_t)2560 * 2048 * 2;
constexpr size_t WS_WGU = WS_WOUTO + (size_t)2048 * 2048 * 2;
constexpr size_t WS_WDN = WS_WGU + (size_t)32 * 4096 * 2048 * 2;
constexpr size_t WS_H = WS_WDN + (size_t)32 * 2048 * 2048 * 2;
constexpr size_t WS_PJ = WS_H + (size_t)T * 2048 * 2;
constexpr size_t WS_ACT2 = WS_PJ + (size_t)T * 1792 * 4;
constexpr size_t WS_KPE = WS_ACT2 + (size_t)TX * 1792 * 2;
constexpr size_t WS_Q = WS_KPE + (size_t)TX * 64 * 2;
constexpr size_t WS_KN = WS_Q + (size_t)T * 2048 * 2;
constexpr size_t WS_VT = WS_KN + (size_t)TX * 1024 * 2;
constexpr size_t WS_VTO = WS_VT + (size_t)1024 * TX * 2;
constexpr size_t WS_KO = WS_VTO + (size_t)256 * TX * 2;
constexpr size_t WS_MIX = WS_KO + (size_t)TX * 256 * 2;
constexpr size_t WS_Y = WS_MIX + (size_t)T * 2048 * 2;
constexpr size_t WS_X1 = WS_Y + (size_t)T * 2048 * 4;
constexpr size_t WS_XL = WS_X1 + (size_t)T * 2048 * 4;
constexpr size_t WS_AFF = WS_XL + (size_t)T * 2048 * 4;
constexpr size_t WS_INV = WS_AFF + (size_t)T * 16 * 4;
constexpr size_t WS_XS = WS_INV + (size_t)T * 16 * 4;
constexpr size_t WS_HID = WS_XS + (size_t)NXS * 2048 * 2;
constexpr size_t WS_YE = WS_HID + (size_t)NXS * 2048 * 2;
constexpr size_t WS_DBG = WS_YE + (size_t)NXS * 2048 * 2;
constexpr size_t WS_END = WS_DBG + (1u << 20);

typedef unsigned short bf16_t;
typedef float f32x4 __attribute__((ext_vector_type(4)));
typedef unsigned u32x4 __attribute__((ext_vector_type(4)));
typedef unsigned u32x2 __attribute__((ext_vector_type(2)));
#define LAS __attribute__((address_space(3)))
#define DI __device__ __forceinline__

struct Params {
    const float* in[29];
    float* out;
    unsigned char* ws;
    int ph_lo, ph_hi;
};

DI unsigned f2bf(float f) { unsigned u = __float_as_uint(f); return (u + 0x7fffu + ((u >> 16) & 1u)) >> 16; }
DI unsigned pk2(float lo, float hi) { return f2bf(lo) | (f2bf(hi) << 16); }
DI unsigned pk4_fp8(float a, float b, float c, float d) { unsigned w = 0; w = __builtin_amdgcn_cvt_pk_fp8_f32(a, b, w, false); w = __builtin_amdgcn_cvt_pk_fp8_f32(c, d, w, true); return w; }
DI float bf2f(unsigned b) { return __uint_as_float(b << 16); }
DI float bflo(unsigned w) { return __uint_as_float(w << 16); }
DI float bfhi(unsigned w) { return __uint_as_float(w & 0xffff0000u); }
DI float wave_sum(float v) {
#pragma unroll
    for (int o = 1; o < 64; o <<= 1) v += __shfl_xor(v, o);
    return v;
}
DI float wave_max(float v) {
#pragma unroll
    for (int o = 1; o < 64; o <<= 1) v = fmaxf(v, __shfl_xor(v, o));
    return v;
}
DI int fresh_lane() { int l = (int)__builtin_amdgcn_mbcnt_hi(~0u, __builtin_amdgcn_mbcnt_lo(~0u, 0u)); asm volatile("" : "+v"(l)); return l; }
DI int cond_of_row(int r) { return r < T_CTX ? 0 : 1 + ((r - T_CTX) >> 10); }
DI const float* xrow_in(const Params& p, int r) { return r < T_CTX ? p.in[0] + (size_t)r * D : p.in[1] + (size_t)(r - T_CTX) * D; }

DI float* ws_mod(const Params& p) { return (float*)(p.ws + WS_MOD); }
DI float* ws_cos(const Params& p) { return (float*)(p.ws + WS_ROPE); }
DI float* ws_sin(const Params& p) { return (float*)(p.ws + WS_ROPE) + 1024 * 32; }
template <class X> DI X* wsp(const Params& p, size_t off) { return (X*)(p.ws + off); }
DI const float* modp(const Params& p, int l, int ci, int j) { return ws_mod(p) + ((size_t)(l * 9 + ci) * MODW + (size_t)j * D); }

#define XB_TMO      128
#define XB_XCNT(j)  (256  + 64 * (j))
#define XB_XSUB(j)  (1280 + 64 * (j))
#define XB_XGEN(j)  (2304 + 64 * (j))
#define XB_TOP      3328
#define XB_TOPGEN   3392
#define XCD_BAR_WORDS 3456
#define XB_SPIN_CAP (1u << 18)

__device__ __forceinline__ unsigned xb_ld(unsigned* p)              { return __hip_atomic_load(p, __ATOMIC_RELAXED, __HIP_MEMORY_SCOPE_AGENT); }
__device__ __forceinline__ unsigned xb_add(unsigned* p, unsigned v) { return __hip_atomic_fetch_add(p, v, __ATOMIC_RELAXED, __HIP_MEMORY_SCOPE_AGENT); }
__device__ __forceinline__ unsigned xb_xcc_id() { return (unsigned)__builtin_amdgcn_s_getreg((3 << 11) | 20) & 0xFu; }
#define XB_SPIN(cond, bar) do { unsigned _sp = 0; while (cond) { __builtin_amdgcn_s_sleep(1); \
    if ((++_sp & 255u) == 0u) { if (xb_ld(&(bar)[XB_TMO])) break; if (_sp > XB_SPIN_CAP) { atomicAdd(&(bar)[XB_TMO], 1u); break; } } } } while (0)

struct XcdBarrier {
    unsigned* bar; unsigned x;
    volatile LAS unsigned* st;
};

__device__ __forceinline__ XcdBarrier xcd_barrier_post(unsigned* bar, volatile LAS unsigned* st) {
    XcdBarrier b; b.bar = bar; b.x = xb_xcc_id(); b.st = st;
    if (threadIdx.x == 0) (void)xb_add(&bar[XB_XCNT(b.x)], 1u);
    return b;
}
__device__ __forceinline__ void xcd_barrier_complete(unsigned* bar, unsigned x, unsigned& nloc, unsigned& nx) {
    const unsigned G = gridDim.x * gridDim.y * gridDim.z;
    unsigned sum, cnt, mine, sp = 0u;
    for (;;) {
        sum = 0u; cnt = 0u; mine = 0u;
#pragma unroll
        for (unsigned j = 0; j < 16; ++j) { const unsigned c = xb_ld(&bar[XB_XCNT(j)]); sum += c; cnt += (c > 0u) ? 1u : 0u; mine = (j == x) ? c : mine; }
        if (sum == G) break;
        __builtin_amdgcn_s_sleep(1);
        if ((++sp & 255u) == 0u) { if (xb_ld(&bar[XB_TMO])) break; if (sp > XB_SPIN_CAP) { atomicAdd(&bar[XB_TMO], 1u); break; } }
    }
    nloc = mine > 0u ? mine : 1u; nx = cnt > 0u ? cnt : 1u;
}

__device__ __forceinline__ void xcd_barrier(const XcdBarrier& b) {
    asm volatile("s_waitcnt vmcnt(0)" ::: "memory");
    __syncthreads();
    if (threadIdx.x == 0) {
        unsigned* bar = b.bar;
        __builtin_amdgcn_s_waitcnt(0);
        unsigned nloc = b.st[0], nx = b.st[1];
        if (nloc == 0u) { xcd_barrier_complete(bar, b.x, nloc, nx); b.st[0] = nloc; b.st[1] = nx; }
        const unsigned old = xb_add(&bar[XB_XSUB(b.x)], 1u);
        const unsigned gen = old / nloc;
        if (old + 1u == (gen + 1u) * nloc) {
            __builtin_amdgcn_fence(__ATOMIC_RELEASE, "agent");
            asm volatile("s_waitcnt vmcnt(0)" ::: "memory");
            const unsigned og = xb_add(&bar[XB_TOP], 1u);
            const unsigned tg = og / nx;
            if (og + 1u == (tg + 1u) * nx) xb_add(&bar[XB_TOPGEN], 1u);
            else XB_SPIN(xb_ld(&bar[XB_TOPGEN]) == tg, bar);
            __builtin_amdgcn_fence(__ATOMIC_ACQUIRE, "agent");
            xb_add(&bar[XB_XGEN(b.x)], 1u);
            asm volatile("s_waitcnt vmcnt(0)" ::: "memory");
        } else {
            XB_SPIN(xb_ld(&bar[XB_XGEN(b.x)]) == gen, bar);
            __builtin_amdgcn_fence(__ATOMIC_ACQUIRE, "agent");
            asm volatile("s_waitcnt vmcnt(0)" ::: "memory");
        }
    }
    __syncthreads();
}
constexpr int CW_BAR = 4096;


DI void ph_mod(const Params& p, unsigned char* lds_raw) {
    float* s_lds = (float*)lds_raw;
    float* red = s_lds + 9 * 2048;
    const int tid = threadIdx.x, lane = tid & 63, wave = __builtin_amdgcn_readfirstlane(tid >> 6);
    const float* c = p.in[6]; const float* c_ctx = p.in[7]; const float* w_ada = p.in[8]; const float* b_ada = p.in[9];
    for (int i = tid; i < 9 * 2048; i += NTHREADS) { const int ci = i >> 11, k = i & 2047; const float v = ci == 0 ? c_ctx[k] : c[(ci - 1) * 2048 + k]; s_lds[i] = v / (1.f + expf(-v)); }
    __syncthreads();
    float* MOD = ws_mod(p);
    for (int it = blockIdx.x; it < 384; it += gridDim.x) {
        const int l = it / 192, c0 = (it % 192) * 64;
        const int kq = tid >> 4, cl = tid & 15;
        const float* w = w_ada + (size_t)l * 2048 * MODW + c0 + 4 * cl;
        float acc[9][4];
#pragma unroll
        for (int ci = 0; ci < 9; ++ci)
#pragma unroll
            for (int j = 0; j < 4; ++j) acc[ci][j] = 0.f;
#pragma unroll 8
        for (int kk = 0; kk < 64; ++kk) {
            const int k = kq * 64 + kk;
            const f32x4 wv = *(const f32x4*)(w + (size_t)k * MODW);
#pragma unroll
            for (int ci = 0; ci < 9; ++ci) { const float s = s_lds[ci * 2048 + k];
#pragma unroll
                for (int j = 0; j < 4; ++j) acc[ci][j] += s * wv[j]; }
        }
#pragma unroll
        for (int ci = 0; ci < 9; ++ci)
#pragma unroll
            for (int j = 0; j < 4; ++j) { float v = acc[ci][j]; v += __shfl_xor(v, 16); v += __shfl_xor(v, 32); acc[ci][j] = v; }
        if (lane < 16) {
#pragma unroll
            for (int ci = 0; ci < 9; ++ci)
#pragma unroll
                for (int j = 0; j < 4; ++j) red[(wave * 9 + ci) * 64 + 4 * cl + j] = acc[ci][j];
        }
        __syncthreads();
        for (int o = tid; o < 576; o += NTHREADS) { const int ci = o >> 6, cc = o & 63; float s = 0.f;
#pragma unroll
            for (int w8 = 0; w8 < 8; ++w8) s += red[(w8 * 9 + ci) * 64 + cc];
            MOD[(size_t)(l * 9 + ci) * MODW + c0 + cc] = s + b_ada[l * MODW + c0 + cc]; }
        __syncthreads();
    }
}

constexpr int CV_INE = 928, CV_UQ = 192, CV_UKV = 128, CV_POOL = 64, CV_OUT = 1024, CV_INO = 1280, CV_MOE = 98304;
constexpr int CV_TOTAL = CV_INE + CV_UQ + CV_UKV + CV_POOL + CV_OUT + CV_INO + CV_OUT + CV_MOE;
DI void cvt_item(const Params& p, int item, int lane) {
    const float* src; bf16_t* dst; int K, N, ldd, nb, kb, map = 0, a = 0; float f8s = 0.f;
    if (item < CV_INE) { src = p.in[10]; dst = wsp<bf16_t>(p, WS_WINE); K = 2048; N = 1856; ldd = 2048; nb = item % 29; kb = item / 29; map = 1; }
    else if ((item -= CV_INE) < CV_UQ) { src = p.in[13]; dst = wsp<bf16_t>(p, WS_W2); K = 512; N = 1536; ldd = 1792; nb = item % 24; kb = item / 24; }
    else if ((item -= CV_UQ) < CV_UKV) { src = p.in[14]; dst = wsp<bf16_t>(p, WS_W2); K = 256; N = 2048; ldd = 1792; nb = item % 32; kb = item / 32; map = 2; }
    else if ((item -= CV_UKV) < CV_POOL) { const int g = item >> 4, r = item & 15; src = p.in[15] + (size_t)g * 65536; dst = wsp<bf16_t>(p, WS_W2); K = 256; N = 256; ldd = 1792; nb = r & 3; kb = r >> 2; a = 3584 + g * 256; }
    else if ((item -= CV_POOL) < CV_OUT) { src = p.in[17]; dst = wsp<bf16_t>(p, WS_WOUTE); K = 2048; N = 2048; ldd = 2048; nb = item & 31; kb = item >> 5; }
    else if ((item -= CV_OUT) < CV_INO) { src = p.in[18]; dst = wsp<bf16_t>(p, WS_WINO); K = 2048; N = 2560; ldd = 2048; nb = item % 40; kb = item / 40; }
    else if ((item -= CV_INO) < CV_OUT) { src = p.in[20]; dst = wsp<bf16_t>(p, WS_WOUTO); K = 2048; N = 2048; ldd = 2048; nb = item & 31; kb = item >> 5; }
    else { item -= CV_OUT; const int mat = item >> 10, w = item & 1023, le = mat / 3, kind = mat % 3; K = 2048; N = 2048; ldd = 2048; nb = w & 31; kb = w >> 5;
        src = p.in[24 + kind] + (size_t)le * 2048 * 2048;
        if (kind == 2) dst = wsp<bf16_t>(p, WS_WDN) + (size_t)le * 2048 * 2048; else { dst = wsp<bf16_t>(p, WS_WGU) + (size_t)le * 4096 * 2048; map = 3; a = kind * 128; }
        if (MOE_F8) { f8s = kind == 2 ? DN_WSCALE : GU_WSCALE; dst = (bf16_t*)((unsigned char*)(kind == 2 ? wsp<bf16_t>(p, WS_WDN) : wsp<bf16_t>(p, WS_WGU)) + (size_t)le * (kind == 2 ? 2048 : 4096) * 2048); } }
    const int n = nb * 64 + lane;
    const float* s = src + (size_t)(kb * 64) * N + n;
    float v[64];
#pragma unroll
    for (int k = 0; k < 64; ++k) v[k] = s[(size_t)k * N];
    int drow;
    if (map == 0) drow = n + a;
    else if (map == 1) drow = n < 768 ? n : (n < 832 ? 1792 + (n - 768) : 768 + (n - 832));
    else if (map == 2) { const int h = n >> 8, j = n & 255; drow = j < 128 ? 1536 + h * 128 + j : 2560 + h * 128 + (j - 128); }
    else drow = (n >> 7) * 256 + (n & 127) + a;
    if (f8s != 0.f) { u32x4* d8 = (u32x4*)((unsigned char*)dst + (size_t)drow * 2048 + kb * 64);
#pragma unroll
        for (int c16 = 0; c16 < 4; ++c16) { u32x4 o; const float* w = v + 16 * c16;
            o.x = pk4_fp8(w[0] * f8s, w[1] * f8s, w[2] * f8s, w[3] * f8s); o.y = pk4_fp8(w[4] * f8s, w[5] * f8s, w[6] * f8s, w[7] * f8s); o.z = pk4_fp8(w[8] * f8s, w[9] * f8s, w[10] * f8s, w[11] * f8s); o.w = pk4_fp8(w[12] * f8s, w[13] * f8s, w[14] * f8s, w[15] * f8s); d8[c16] = o; }
        return; }
    u32x4* d = (u32x4*)(dst + (size_t)drow * ldd + kb * 64);
#pragma unroll
    for (int c8 = 0; c8 < 8; ++c8) { u32x4 o; o.x = pk2(v[8 * c8], v[8 * c8 + 1]); o.y = pk2(v[8 * c8 + 2], v[8 * c8 + 3]); o.z = pk2(v[8 * c8 + 4], v[8 * c8 + 5]); o.w = pk2(v[8 * c8 + 6], v[8 * c8 + 7]); d[c8] = o; }
}
DI void ph_convert(const Params& p, int item_lo, int item_hi) {
    const int lane = threadIdx.x & 63, gw = blockIdx.x * NWAVES + __builtin_amdgcn_readfirstlane(threadIdx.x >> 6), NGW = gridDim.x * NWAVES;
    for (int it = item_lo + gw; it < item_hi; it += NGW) cvt_item(p, it, lane);
}

DI void ph_misc(const Params& p) {
    const size_t gt = (size_t)blockIdx.x * NTHREADS + threadIdx.x, NGT = (size_t)gridDim.x * NTHREADS;
    float* cosT = ws_cos(p); float* sinT = ws_sin(p);
    for (size_t i = gt; i < 1024 * 32; i += NGT) { const int s = (int)(i >> 5), f = (int)(i & 31);
        const float inv = powf(10000.f, -(float)(f & 15) / 16.f); const float pos = f < 16 ? (float)(s >> 6) : (float)(s & 63); const float ang = pos * inv;
        cosT[i] = cosf(ang); sinT[i] = sinf(ang); }
    bf16_t* ACT2 = wsp<bf16_t>(p, WS_ACT2); bf16_t* KPE = wsp<bf16_t>(p, WS_KPE); bf16_t* KO = wsp<bf16_t>(p, WS_KO); bf16_t* VTO = wsp<bf16_t>(p, WS_VTO);
    const float* cckv = p.in[2]; const float* ckpe = p.in[3]; const float* csk = p.in[4]; const float* csv = p.in[5];
    for (size_t i = gt; i < (size_t)TC * 256 / 4; i += NGT) { const size_t e = i * 4; const int j = (int)(e >> 8), cc = (int)(e & 255); const f32x4 v = *(const f32x4*)(cckv + e);
        u32x2 o; o.x = pk2(v[0], v[1]); o.y = pk2(v[2], v[3]); *(u32x2*)(ACT2 + (size_t)(T + j) * 1792 + 512 + cc) = o;
        const f32x4 k = *(const f32x4*)(csk + e); u32x2 o2; o2.x = pk2(k[0], k[1]); o2.y = pk2(k[2], k[3]); *(u32x2*)(KO + (size_t)(T + j) * 256 + cc) = o2; }
    for (size_t i = gt; i < (size_t)TC * 64 / 4; i += NGT) { const size_t e = i * 4; const f32x4 v = *(const f32x4*)(ckpe + e); u32x2 o; o.x = pk2(v[0], v[1]); o.y = pk2(v[2], v[3]); *(u32x2*)(KPE + (size_t)T * 64 + e) = o; }
    for (size_t i = gt; i < (size_t)256 * (TC / 8); i += NGT) { const int f = (int)(i / (TC / 8)), j8 = (int)(i % (TC / 8)) * 8; float v[8];
#pragma unroll
        for (int q = 0; q < 8; ++q) v[q] = csv[(size_t)(j8 + q) * 256 + f];
        u32x4 o; o.x = pk2(v[0], v[1]); o.y = pk2(v[2], v[3]); o.z = pk2(v[4], v[5]); o.w = pk2(v[6], v[7]); *(u32x4*)(VTO + (size_t)f * TX + T + j8) = o; }
}

DI void ph_h0(const Params& p) {
    const int lane = threadIdx.x & 63, gw = blockIdx.x * NWAVES + __builtin_amdgcn_readfirstlane(threadIdx.x >> 6), NGW = gridDim.x * NWAVES;
    bf16_t* H = wsp<bf16_t>(p, WS_H);
    for (int r = gw; r < T; r += NGW) {
        const int ci = cond_of_row(r); const float* x = xrow_in(p, r); const float* sh = modp(p, 0, ci, 0); const float* sc = modp(p, 0, ci, 1);
#pragma unroll
        for (int j = 0; j < 8; ++j) { const int c0 = lane * 4 + 256 * j; const f32x4 v = *(const f32x4*)(x + c0), a = *(const f32x4*)(sc + c0), b = *(const f32x4*)(sh + c0);
            const f32x4 h = v * (1.f + a) + b; u32x2 o; o.x = pk2(h[0], h[1]); o.y = pk2(h[2], h[3]); *(u32x2*)(H + (size_t)r * D + c0) = o; }
    }
}

DI void ph_e1(const Params& p) {
    const int lane = threadIdx.x & 63, gw = blockIdx.x * NWAVES + __builtin_amdgcn_readfirstlane(threadIdx.x >> 6), NGW = gridDim.x * NWAVES;
    const float* PJ = wsp<float>(p, WS_PJ); bf16_t* ACT2 = wsp<bf16_t>(p, WS_ACT2);
    const float* qn = p.in[11]; const float* kvn = p.in[12];
    for (int r = gw; r < T; r += NGW) {
        const float* pr = PJ + (size_t)r * 1792; bf16_t* ar = ACT2 + (size_t)r * 1792;
        {
            f32x4 v[2]; float ss = 0.f;
#pragma unroll
            for (int j = 0; j < 2; ++j) { v[j] = *(const f32x4*)(pr + lane * 4 + 256 * j); ss += (v[j][0] * v[j][0] + v[j][1] * v[j][1]) + (v[j][2] * v[j][2] + v[j][3] * v[j][3]); }
            const float rs = rsqrtf(wave_sum(ss) * (1.f / 512.f) + 1e-6f);
#pragma unroll
            for (int j = 0; j < 2; ++j) { const int c0 = lane * 4 + 256 * j; const f32x4 g = *(const f32x4*)(qn + c0); const f32x4 y = v[j] * rs * g; u32x2 o; o.x = pk2(y[0], y[1]); o.y = pk2(y[2], y[3]); *(u32x2*)(ar + c0) = o; }
        }
        {
            const int c0 = lane * 4; const f32x4 v = *(const f32x4*)(pr + 512 + c0); float ss = (v[0] * v[0] + v[1] * v[1]) + (v[2] * v[2] + v[3] * v[3]);
            const float rs = rsqrtf(wave_sum(ss) * (1.f / 256.f) + 1e-6f); const f32x4 g = *(const f32x4*)(kvn + c0); const f32x4 y = v * rs * g;
            u32x2 o; o.x = pk2(y[0], y[1]); o.y = pk2(y[2], y[3]); *(u32x2*)(ar + 512 + c0) = o;
            if (r < T_CTX) *(f32x4*)(p.out + O_CKV + (size_t)r * 256 + c0) = y;
        }
        {
            int s, S, rb; if (r < T_CTX) { s = r & 255; S = 256; rb = r - s; } else { s = (r - T_CTX) & 1023; S = 1024; rb = r - s; }
#pragma unroll
            for (int g = 0; g < 4; ++g) { const int half = 1 << g; const int lo = max(s - half, 0), hi = min(s + half, S); const int c0 = 768 + g * 256 + lane * 4;
                f32x4 sum = {0.f, 0.f, 0.f, 0.f};
                for (int t = lo; t < hi; ++t) sum += *(const f32x4*)(PJ + (size_t)(rb + t) * 1792 + c0);
                const f32x4 u = *(const f32x4*)(pr + c0); const f32x4 y = sum / (float)(hi - lo) - u;
                u32x2 o; o.x = pk2(y[0], y[1]); o.y = pk2(y[2], y[3]); *(u32x2*)(ar + c0) = o; }
        }
    }
}

DI void ph_ln1(const Params& p, int l, unsigned char* lds_raw) {
    const int tid = threadIdx.x, lane = tid & 63, gw = blockIdx.x * NWAVES + __builtin_amdgcn_readfirstlane(tid >> 6), NGW = gridDim.x * NWAVES;
    float* wT = (float*)lds_raw;
    const float* wr = p.in[23] + (size_t)l * 2048 * 16;
    for (int i = tid; i < 2048 * 16; i += NTHREADS) { const int d = i >> 4, e = i & 15; wT[e * 2048 + d] = wr[i]; }
    __syncthreads();
    const float* Y = wsp<float>(p, WS_Y); float* X1 = wsp<float>(p, WS_X1); bf16_t* H = wsp<bf16_t>(p, WS_H); float* AFF = wsp<float>(p, WS_AFF);
    const float* lg = p.in[21] + l * D; const float* lb = p.in[22] + l * D;
    for (int r = gw; r < T; r += NGW) {
        const int ci = cond_of_row(r); const float* sh = modp(p, l, ci, 3); const float* sc = modp(p, l, ci, 4);
        f32x4 v[8]; float s = 0.f;
#pragma unroll
        for (int j = 0; j < 8; ++j) { v[j] = *(const f32x4*)(Y + (size_t)r * D + lane * 4 + 256 * j); s += (v[j][0] + v[j][1]) + (v[j][2] + v[j][3]); }
        const float mean = wave_sum(s) * (1.f / D); float s2 = 0.f;
#pragma unroll
        for (int j = 0; j < 8; ++j) { v[j] = v[j] - mean; s2 += (v[j][0] * v[j][0] + v[j][1] * v[j][1]) + (v[j][2] * v[j][2] + v[j][3] * v[j][3]); }
        const float rstd = rsqrtf(wave_sum(s2) * (1.f / D) + 1e-5f);
#pragma unroll
        for (int j = 0; j < 8; ++j) { const int c0 = lane * 4 + 256 * j; const f32x4 x1 = v[j] * rstd * *(const f32x4*)(lg + c0) + *(const f32x4*)(lb + c0);
            *(f32x4*)(X1 + (size_t)r * D + c0) = x1;
            const f32x4 h = x1 * (1.f + *(const f32x4*)(sc + c0)) + *(const f32x4*)(sh + c0); v[j] = h;
            u32x2 o; o.x = pk2(h[0], h[1]); o.y = pk2(h[2], h[3]); *(u32x2*)(H + (size_t)r * D + c0) = o; }
        float mine = -1e30f;
#pragma unroll 2
        for (int e = 0; e < 16; ++e) { float a = 0.f;
#pragma unroll
            for (int j = 0; j < 8; ++j) { const f32x4 w = *(const f32x4*)(wT + e * 2048 + lane * 4 + 256 * j); a += (v[j][0] * w[0] + v[j][1] * w[1]) + (v[j][2] * w[2] + v[j][3] * w[3]); }
            a = wave_sum(a); mine = (lane == e) ? a : mine; }
        const float m = wave_max(mine);
        const float ex = lane < 16 ? expf(mine - m) : 0.f;
        const float den = wave_sum(ex);
        mine = ex;
        if (lane < 16) AFF[(size_t)r * 16 + lane] = mine / den;
    }
}

DI void ph_topk(const Params& p, unsigned char* lds_raw) {
    const int tid = threadIdx.x, lane = tid & 63, wave = __builtin_amdgcn_readfirstlane(tid >> 6);
    float* vals = (float*)lds_raw;
    int* sel = (int*)(vals + 1024);
    const float* AFF = wsp<float>(p, WS_AFF); int* INV = wsp<int>(p, WS_INV); const bf16_t* H = wsp<bf16_t>(p, WS_H); bf16_t* XS = wsp<bf16_t>(p, WS_XS);
    for (int it = blockIdx.x; it < 384; it += gridDim.x) {
        int n, cap, r0, e, sb;
        if (it < 256) { const int b = it >> 4; e = it & 15; n = 256; cap = 32; r0 = b * 256; sb = b * 32; }
        else { const int q = it - 256, b = q >> 4; e = q & 15; n = 1024; cap = 128; r0 = T_CTX + b * 1024; sb = 512 + b * 128; }
        for (int i = tid; i < n; i += NTHREADS) vals[i] = AFF[(size_t)(r0 + i) * 16 + e];
        __syncthreads();
        for (int i = tid; i < n; i += NTHREADS) { const float vi = vals[i]; int cnt = 0;
            for (int j = 0; j < n; ++j) { const float vj = vals[j]; cnt += (vj > vi || (vj == vi && j < i)) ? 1 : 0; }
            if (cnt < cap) { sel[cnt] = i; INV[(size_t)(r0 + i) * 16 + e] = sb + cnt; } else INV[(size_t)(r0 + i) * 16 + e] = -1; }
        __syncthreads();
        for (int k = wave; k < cap; k += NWAVES) { const int r = r0 + sel[k]; const u32x4* src = (const u32x4*)(H + (size_t)r * D);
            if (MOE_F8) { u32x2* dst = (u32x2*)((unsigned char*)XS + (size_t)(e * NSLOT + sb + k) * D);
#pragma unroll
                for (int j = 0; j < 4; ++j) { const u32x4 w = src[lane + 64 * j]; u32x2 o; o.x = pk4_fp8(bflo(w.x), bfhi(w.x), bflo(w.y), bfhi(w.y)); o.y = pk4_fp8(bflo(w.z), bfhi(w.z), bflo(w.w), bfhi(w.w)); dst[lane + 64 * j] = o; } }
            else { u32x4* dst = (u32x4*)(XS + (size_t)(e * NSLOT + sb + k) * D);
#pragma unroll
                for (int j = 0; j < 4; ++j) dst[lane + 64 * j] = src[lane + 64 * j]; } }
        __syncthreads();
    }
}

DI void ph_ln2(const Params& p, int l) {
    const int lane = threadIdx.x & 63, gw = blockIdx.x * NWAVES + __builtin_amdgcn_readfirstlane(threadIdx.x >> 6), NGW = gridDim.x * NWAVES;
    const float* X1 = wsp<float>(p, WS_X1); const float* AFF = wsp<float>(p, WS_AFF); const int* INV = wsp<int>(p, WS_INV); const bf16_t* YE = wsp<bf16_t>(p, WS_YE);
    float* XL = wsp<float>(p, WS_XL); bf16_t* H = wsp<bf16_t>(p, WS_H);
    const float* lg = p.in[27] + l * D; const float* lb = p.in[28] + l * D;
    for (int r = gw; r < T; r += NGW) {
        const int ci = cond_of_row(r); const float* g2 = modp(p, l, ci, 5);
        f32x4 f[8];
#pragma unroll
        for (int j = 0; j < 8; ++j) f[j] = (f32x4){0.f, 0.f, 0.f, 0.f};
        for (int e = 0; e < 16; ++e) { const int slot = INV[(size_t)r * 16 + e]; if (slot < 0) continue; const float w = AFF[(size_t)r * 16 + e];
            const bf16_t* y = YE + (size_t)(e * NSLOT + slot) * D;
#pragma unroll
            for (int j = 0; j < 8; ++j) { const u32x2 q = *(const u32x2*)(y + lane * 4 + 256 * j); f[j][0] += w * bflo(q.x); f[j][1] += w * bfhi(q.x); f[j][2] += w * bflo(q.y); f[j][3] += w * bfhi(q.y); } }
        float s = 0.f;
#pragma unroll
        for (int j = 0; j < 8; ++j) { const int c0 = lane * 4 + 256 * j; f[j] = DN_ALPHA * *(const f32x4*)(X1 + (size_t)r * D + c0) + *(const f32x4*)(g2 + c0) * f[j]; s += (f[j][0] + f[j][1]) + (f[j][2] + f[j][3]); }
        const float mean = wave_sum(s) * (1.f / D); float s2 = 0.f;
#pragma unroll
        for (int j = 0; j < 8; ++j) { f[j] = f[j] - mean; s2 += (f[j][0] * f[j][0] + f[j][1] * f[j][1]) + (f[j][2] * f[j][2] + f[j][3] * f[j][3]); }
        const float rstd = rsqrtf(wave_sum(s2) * (1.f / D) + 1e-5f);
        const float* sh = modp(p, 1, ci, 0); const float* sc = modp(p, 1, ci, 1);
#pragma unroll
        for (int j = 0; j < 8; ++j) { const int c0 = lane * 4 + 256 * j; const f32x4 x = f[j] * rstd * *(const f32x4*)(lg + c0) + *(const f32x4*)(lb + c0);
            if (l == 0) { *(f32x4*)(XL + (size_t)r * D + c0) = x; const f32x4 h = x * (1.f + *(const f32x4*)(sc + c0)) + *(const f32x4*)(sh + c0);
                u32x2 o; o.x = pk2(h[0], h[1]); o.y = pk2(h[2], h[3]); *(u32x2*)(H + (size_t)r * D + c0) = o; }
            else *(f32x4*)(p.out + O_Y + (size_t)r * D + c0) = x; }
    }
}

struct Unit { const char* A; const char* B; unsigned lda, ldb; int nt; int pm, pn; int mode; int aux; };
DI int vcu_of(int bx, int G) { return (G % 8 == 0) ? (bx % 8) * (G / 8) + bx / 8 : bx; }

DI void rope8(const Params& p, int s, int pi0, float* v) {
    const f32x4 c = *(const f32x4*)(ws_cos(p) + s * 32 + pi0), sn = *(const f32x4*)(ws_sin(p) + s * 32 + pi0);
#pragma unroll
    for (int i = 0; i < 4; ++i) { const float x1 = v[2 * i], x2 = v[2 * i + 1]; v[2 * i] = x1 * c[i] - x2 * sn[i]; v[2 * i + 1] = x1 * sn[i] + x2 * c[i]; }
}
DI void st_bf16x8(bf16_t* dst, const float* v) { u32x4 w; w.x = pk2(v[0], v[1]); w.y = pk2(v[2], v[3]); w.z = pk2(v[4], v[5]); w.w = pk2(v[6], v[7]); *(u32x4*)dst = w; }
DI void st_f32x8(float* dst, const float* v) { *(f32x4*)dst = (f32x4){v[0], v[1], v[2], v[3]}; *(f32x4*)(dst + 4) = (f32x4){v[4], v[5], v[6], v[7]}; }

struct SchedInEven { const Params* p; int G, c;
    DI bool next(int i, Unit& u) const { const int L = i * G + c; if (L >= 48 * 8) return false; u.pm = L >> 3; u.pn = L & 7;
        u.A = (const char*)wsp<bf16_t>(*p, WS_H) + (size_t)u.pm * 256 * 4096; u.B = (const char*)wsp<bf16_t>(*p, WS_WINE) + (size_t)u.pn * 256 * 4096; u.lda = 4096; u.ldb = 4096; u.nt = 32; u.mode = 0; u.aux = 0; return true; } };
struct EpiInEven { static constexpr bool PAIR = false, F8 = false; const Params* p;
    DI void store(const Unit& u, int row, int col, float* v) const {
        const int r = u.pm * 256 + row, gc = u.pn * 256 + col;
        if (gc < 1792) { st_f32x8(wsp<float>(*p, WS_PJ) + (size_t)r * 1792 + gc, v); return; }
        if (gc >= 1856) return;
        const int j0 = gc - 1792;
        if (r < T_CTX) st_f32x8(p->out + O_KPE + (size_t)r * 64 + j0, v); else rope8(*p, (r - T_CTX) & 1023, j0 >> 1, v);
        st_bf16x8(wsp<bf16_t>(*p, WS_KPE) + (size_t)r * 64 + j0, v);
    } };

constexpr int E2_Q = 48 * 6, E2_K = 64 * 4, E2_V = 4 * 64, E2_P = 48 * 4, E2_TOTAL = E2_Q + E2_K + E2_V + E2_P;
struct SchedE2 { const Params* p; int G, c;
    DI bool next(int i, Unit& u) const { int L = i * G + c; if (L >= E2_TOTAL) return false;
        const char* ACT2 = (const char*)wsp<bf16_t>(*p, WS_ACT2); const char* W2 = (const char*)wsp<bf16_t>(*p, WS_W2); u.aux = 0;
        if (L < E2_Q) { u.mode = 0; u.pm = L / 6; u.pn = L % 6; u.A = ACT2 + (size_t)u.pm * 256 * 3584; u.lda = 3584; u.B = W2 + (size_t)u.pn * 256 * 3584; u.ldb = 3584; u.nt = 8; return true; }
        L -= E2_Q;
        if (L < E2_K) { u.mode = 1; u.pm = L >> 2; u.pn = L & 3; u.A = ACT2 + (size_t)u.pm * 256 * 3584 + 512 * 2; u.lda = 3584; u.B = W2 + (size_t)(1536 + u.pn * 256) * 3584; u.ldb = 3584; u.nt = 4; return true; }
        L -= E2_K;
        if (L < E2_V) { u.mode = 2; u.pm = L >> 6; u.pn = L & 63; u.A = W2 + (size_t)(2560 + u.pm * 256) * 3584; u.lda = 3584; u.B = ACT2 + (size_t)u.pn * 256 * 3584 + 512 * 2; u.ldb = 3584; u.nt = 4; return true; }
        L -= E2_V;
        u.mode = 3; u.pm = L >> 2; u.aux = L & 3; u.pn = 0; u.A = ACT2 + (size_t)u.pm * 256 * 3584 + (768 + u.aux * 256) * 2; u.lda = 3584; u.B = W2 + (size_t)(3584 + u.aux * 256) * 3584; u.ldb = 3584; u.nt = 4; return true; } };
struct EpiE2 { static constexpr bool PAIR = false, F8 = false; const Params* p;
    DI void store(const Unit& u, int row, int col, float* v) const {
        const int r = u.pm * 256 + row, gc = u.pn * 256 + col;
        if (u.mode == 0) { const int dd = gc % 192; if (dd >= 128 && r >= T_CTX) rope8(*p, (r - T_CTX) & 1023, (dd - 128) >> 1, v);
#pragma unroll
            for (int i = 0; i < 8; ++i) v[i] *= QS_MLA;
            st_bf16x8(wsp<bf16_t>(*p, WS_Q) + (size_t)r * 1536 + gc, v); }
        else if (u.mode == 1) st_bf16x8(wsp<bf16_t>(*p, WS_KN) + (size_t)r * 1024 + gc, v);
        else if (u.mode == 2) st_bf16x8(wsp<bf16_t>(*p, WS_VT) + (size_t)r * TX + gc, v);
        else { const float* ps = p->in[16] + u.aux * 256 + col;
#pragma unroll
            for (int i = 0; i < 8; ++i) v[i] *= ps[i];
            st_bf16x8(wsp<bf16_t>(*p, WS_MIX) + (size_t)r * 2048 + 1024 + u.aux * 256 + col, v); }
    } };

struct SchedOut { const Params* p; int G, c, l;
    DI bool next(int i, Unit& u) const { const int L = i * G + c; if (L >= 48 * 8) return false; u.pm = L >> 3; u.pn = L & 7;
        u.A = (const char*)wsp<bf16_t>(*p, WS_MIX) + (size_t)u.pm * 256 * 4096; u.B = (const char*)wsp<bf16_t>(*p, l == 0 ? WS_WOUTE : WS_WOUTO) + (size_t)u.pn * 256 * 4096; u.lda = 4096; u.ldb = 4096; u.nt = 32; u.mode = 0; u.aux = 0; return true; } };
struct EpiOut { static constexpr bool PAIR = false, F8 = false; const Params* p; int l;
    DI void store(const Unit& u, int row, int col, float* v) const {
        const int r = u.pm * 256 + row, gc = u.pn * 256 + col;
        const float* x = (l == 0 ? xrow_in(*p, r) : wsp<float>(*p, WS_XL) + (size_t)r * D) + gc; const float* g1 = modp(*p, l, cond_of_row(r), 2) + gc;
        const f32x4 x0 = *(const f32x4*)x, x1 = *(const f32x4*)(x + 4), g0 = *(const f32x4*)g1, g4 = *(const f32x4*)(g1 + 4);
#pragma unroll
        for (int i = 0; i < 4; ++i) { v[i] = DN_ALPHA * x0[i] + g0[i] * v[i]; v[4 + i] = DN_ALPHA * x1[i] + g4[i] * v[4 + i]; }
        st_f32x8(wsp<float>(*p, WS_Y) + (size_t)r * D + gc, v);
    } };

struct SchedGU { const Params* p; int G, c, l;
    DI bool next(int i, Unit& u) const { const int L = i * G + c; if (L >= 16 * 96) return false; const int e = L / 96, rem = L % 96; u.pn = rem / 6; u.pm = e * 6 + rem % 6; u.aux = e;
        constexpr unsigned P = MOE_F8 ? 2048 : 4096;
        u.A = (const char*)wsp<bf16_t>(*p, WS_XS) + (size_t)u.pm * 256 * P; u.B = (const char*)wsp<bf16_t>(*p, WS_WGU) + ((size_t)(l * 16 + e) * 4096 + (size_t)u.pn * 256) * P; u.lda = P; u.ldb = P; u.nt = MOE_F8 ? 16 : 32; u.mode = 0; return true; } };
struct EpiGU { static constexpr bool PAIR = true, F8 = MOE_F8 != 0; const Params* p;
    DI void store2(const Unit& u, int row, int col, const float* g, const float* up) const {
        float h[8];
#pragma unroll
        for (int i = 0; i < 8; ++i) { const float gg = MOE_F8 ? g[i] * (1.f / GU_WSCALE) : g[i], uu = MOE_F8 ? up[i] * (1.f / GU_WSCALE) : up[i]; h[i] = gg / (1.f + __expf(-gg)) * uu; }
        if (MOE_F8) { u32x2 o; o.x = pk4_fp8(h[0], h[1], h[2], h[3]); o.y = pk4_fp8(h[4], h[5], h[6], h[7]); *(u32x2*)((unsigned char*)wsp<bf16_t>(*p, WS_HID) + (size_t)(u.pm * 256 + row) * D + u.pn * 128 + col) = o; }
        else st_bf16x8(wsp<bf16_t>(*p, WS_HID) + (size_t)(u.pm * 256 + row) * D + u.pn * 128 + col, h);
    } };

struct SchedDown { const Params* p; int G, c, l;
    DI bool next(int i, Unit& u) const { const int L = i * G + c; if (L >= 16 * 48) return false; const int e = L / 48, rem = L % 48; u.pn = rem / 6; u.pm = e * 6 + rem % 6; u.aux = e;
        constexpr unsigned P = MOE_F8 ? 2048 : 4096;
        u.A = (const char*)wsp<bf16_t>(*p, WS_HID) + (size_t)u.pm * 256 * P; u.B = (const char*)wsp<bf16_t>(*p, WS_WDN) + ((size_t)(l * 16 + e) * 2048 + (size_t)u.pn * 256) * P; u.lda = P; u.ldb = P; u.nt = MOE_F8 ? 16 : 32; u.mode = 0; return true; } };
struct EpiDown { static constexpr bool PAIR = false, F8 = MOE_F8 != 0; const Params* p;
    DI void store(const Unit& u, int row, int col, float* v) const {
        if (MOE_F8) {
#pragma unroll
            for (int i = 0; i < 8; ++i) v[i] *= (1.f / DN_WSCALE); }
        st_bf16x8(wsp<bf16_t>(*p, WS_YE) + (size_t)(u.pm * 256 + row) * D + u.pn * 256 + col, v); } };

constexpr int IO_QK = 48 * 9, IO_V = 16, IO_VT = 48, IO_TOTAL = IO_QK + IO_V + IO_VT;
struct SchedInOdd { const Params* p; int G, c;
    DI bool next(int i, Unit& u) const { int L = i * G + c; if (L >= IO_TOTAL) return false;
        const char* Hb = (const char*)wsp<bf16_t>(*p, WS_H); const char* W = (const char*)wsp<bf16_t>(*p, WS_WINO); u.aux = 0; u.nt = 32; u.lda = 4096; u.ldb = 4096;
        if (L < IO_QK) { u.mode = 0; u.pm = L / 9; u.pn = L % 9; u.A = Hb + (size_t)u.pm * 256 * 4096; u.B = W + (size_t)u.pn * 256 * 4096; return true; }
        L -= IO_QK;
        if (L < IO_V) { u.mode = 1; u.pm = L; u.pn = 9; u.A = Hb + (size_t)u.pm * 256 * 4096; u.B = W + (size_t)9 * 256 * 4096; return true; }
        L -= IO_V;
        u.mode = 2; u.pm = 0; u.pn = L; u.A = W + (size_t)9 * 256 * 4096; u.B = Hb + (size_t)u.pn * 256 * 4096; return true; } };
struct EpiInOdd { static constexpr bool PAIR = false, F8 = false; const Params* p;
    DI void store(const Unit& u, int row, int col, float* v) const {
        const int r = u.pm * 256 + row, gc = u.pn * 256 + col;
        if (u.mode == 0) {
            if (gc < 2048) { if (r >= T_CTX) rope8(*p, (r - T_CTX) & 1023, (gc & 63) >> 1, v);
#pragma unroll
                for (int i = 0; i < 8; ++i) v[i] *= QS_SWA;
                st_bf16x8(wsp<bf16_t>(*p, WS_Q) + (size_t)r * 2048 + gc, v); }
            else { const int kc = gc - 2048; if (r < T_CTX) st_f32x8(p->out + O_SK + (size_t)r * 256 + kc, v); else rope8(*p, (r - T_CTX) & 1023, (kc & 63) >> 1, v);
                st_bf16x8(wsp<bf16_t>(*p, WS_KO) + (size_t)r * 256 + kc, v); } }
        else if (u.mode == 1) st_f32x8(p->out + O_SV + (size_t)r * 256 + col, v);
        else st_bf16x8(wsp<bf16_t>(*p, WS_VTO) + (size_t)row * TX + gc, v);
    } };

namespace pg8 {
typedef short bf16x8 __attribute__((ext_vector_type(8)));
typedef int i32x4 __attribute__((ext_vector_type(4)));
typedef int i32x8 __attribute__((ext_vector_type(8)));
DI i32x8 cat8(bf16x8 lo, bf16x8 hi) { return __builtin_shufflevector(__builtin_bit_cast(i32x4, lo), __builtin_bit_cast(i32x4, hi), 0, 1, 2, 3, 4, 5, 6, 7); }
constexpr int BM = 256, BK = 64, HALF = 128, HTB = HALF * BK * 2  , STAGE_BYTES = 8 * HTB;
DI int lds_byte(int r, int c) { const int st = (r >> 4) * 2 + (c >> 5), rr = r & 15, cc = c & 31, ob = rr * 64 + cc * 2; return st * 1024 + (ob ^ (((ob >> 9) & 1) << 5)); }
DI void stage_rc(int b, int& R, int& C) { const int st = b / 1024, sb = b % 1024, swz = sb ^ (((sb >> 9) & 1) << 5); R = (st >> 1) * 16 + swz / 64; C = (st & 1) * 32 + (swz % 64) / 2; }
DI int perm32(int rho) { const int n = rho >> 4, i = rho & 15; return 8 * (i >> 2) + 4 * n + (i & 3); }

template <bool F8> struct Frag;
template <> struct Frag<false> { bf16x8 k0, k1; DI void set(bf16x8 a, bf16x8 b) { k0 = a; k1 = b; } };
template <> struct Frag<true> { i32x8 w; DI void set(bf16x8 a, bf16x8 b) { w = cat8(a, b); } };
template <class Epi, class Sched, bool ALIGN_EPI = true>
DI void gemm_phase(LAS unsigned char* lds, const Sched& S, const Epi& E, int wid) {
    const int lane = fresh_lane(), tid = wid * 64 + lane, wr = wid >> 2, wc = wid & 3, fr = lane & 15, fq = lane >> 4;
    int RA[2], RB[2], CB[2];
#pragma unroll
    for (int i = 0; i < 2; ++i) { int R, C; stage_rc(tid * 16 + i * 8192, R, C); RA[i] = R; RB[i] = (R & ~31) + perm32(R & 31); CB[i] = C * 2; }
    constexpr size_t kstep = (size_t)(BK * 2);
    const unsigned ldsw = (unsigned)wid * 1024u;
    const int aoff = lds_byte(wr * 64 + fr, fq * 8), boff = lds_byte(wc * 32 + fr, fq * 8);
#define PG8_SA(b, h) (((b) * 2 + (h)) * HTB)
#define PG8_SB(b, h) ((4 + (b) * 2 + (h)) * HTB)
#define PG8_STAGE(bufoff, gbase, v0, v1) do { unsigned o0_ = (v0), o1_ = (v1); asm volatile("" : "+v"(o0_), "+v"(o1_)); \
        __builtin_amdgcn_global_load_lds((const unsigned*)((const char*)(gbase) + o0_), (LAS unsigned*)(lds + (bufoff) + ldsw), 16, 0, 0); \
        __builtin_amdgcn_global_load_lds((const unsigned*)((const char*)(gbase) + o1_), (LAS unsigned*)(lds + (bufoff) + ldsw + 8192), 16, 0, 0); } while (0)
#define PG8_LDA(dst, b, h) do { _Pragma("unroll") for (int m = 0; m < 4; ++m) { const bf16x8 f0_ = *(const LAS bf16x8*)(lds + PG8_SA(b, h) + aoff + m * 2048), f1_ = *(const LAS bf16x8*)(lds + PG8_SA(b, h) + aoff + m * 2048 + 1024); dst[m].set(f0_, f1_); } } while (0)
#define PG8_LDB(dst, b, h) do { _Pragma("unroll") for (int n = 0; n < 2; ++n) { const bf16x8 f0_ = *(const LAS bf16x8*)(lds + PG8_SB(b, h) + boff + n * 2048), f1_ = *(const LAS bf16x8*)(lds + PG8_SB(b, h) + boff + n * 2048 + 1024); dst[n].set(f0_, f1_); } } while (0)
#define PG8_MMA(ai, bj, At, Bt) do { __builtin_amdgcn_s_setprio(1); _Pragma("unroll") for (int m = 0; m < 4; ++m) _Pragma("unroll") for (int n = 0; n < 2; ++n) { \
        if constexpr (Epi::F8) acc[ai][bj][m][n] = __builtin_amdgcn_mfma_scale_f32_16x16x128_f8f6f4(Bt[n].w, At[m].w, acc[ai][bj][m][n], 0, 0, 0, 0x7f7f7f7f, 0, 0x7f7f7f7f); \
        else { acc[ai][bj][m][n] = __builtin_amdgcn_mfma_f32_16x16x32_bf16(Bt[n].k0, At[m].k0, acc[ai][bj][m][n], 0, 0, 0); acc[ai][bj][m][n] = __builtin_amdgcn_mfma_f32_16x16x32_bf16(Bt[n].k1, At[m].k1, acc[ai][bj][m][n], 0, 0, 0); } } \
        __builtin_amdgcn_s_setprio(0); } while (0)
#define PG8_WAIT_V(n) asm volatile("s_waitcnt vmcnt(" #n ")" ::: "memory")
#define PG8_WAIT_L(n) asm volatile("s_waitcnt lgkmcnt(" #n ")" ::: "memory")
#define PG8_BAR __builtin_amdgcn_s_barrier()
#define PG8_SCHED __builtin_amdgcn_sched_barrier(0)
    Unit cur, nxt; int ui = 0;
    if (!S.next(0, cur)) return;
    f32x4 acc[2][2][4][2];
#pragma unroll
    for (int a = 0; a < 2; ++a)
#pragma unroll
        for (int b = 0; b < 2; ++b)
#pragma unroll
            for (int m = 0; m < 4; ++m)
#pragma unroll
                for (int n = 0; n < 2; ++n) acc[a][b][m][n] = (f32x4){0.f, 0.f, 0.f, 0.f};
    Frag<Epi::F8> At[4], B0[2], B1[2];
    const char* cA = cur.A; const char* cB = cur.B;
    const unsigned ld = cur.lda;
    const unsigned vA0 = RA[0] * ld + CB[0], vA1 = RA[1] * ld + CB[1], vB0 = RB[0] * ld + CB[0], vB1 = RB[1] * ld + CB[1];
    const size_t hA = (size_t)HALF * ld, hB = hA;
    PG8_STAGE(PG8_SB(0, 0), cB, vB0, vB1); PG8_STAGE(PG8_SB(0, 1), cB + hB, vB0, vB1); PG8_STAGE(PG8_SA(0, 0), cA, vA0, vA1); PG8_STAGE(PG8_SA(0, 1), cA + hA, vA0, vA1);
    if (wr == 1) PG8_BAR;
    PG8_WAIT_V(2); PG8_BAR;
    PG8_STAGE(PG8_SB(1, 0), cB + kstep, vB0, vB1); PG8_STAGE(PG8_SA(1, 0), cA + kstep, vA0, vA1); PG8_STAGE(PG8_SB(1, 1), cB + hB + kstep, vB0, vB1);
    PG8_WAIT_V(6); PG8_BAR;
    for (;;) {
        const bool has_next = S.next(ui + 1, nxt);
        const char* nA = has_next ? nxt.A : cA; const char* nB = has_next ? nxt.B : cB;
        const int nt = cur.nt;
        for (int t = 0; t < nt; t += 2) {
            const bool last = (t == nt - 2);
            const char* a1 = cA + (size_t)(t + 1) * kstep;
            const char* a2 = last ? nA : cA + (size_t)(t + 2) * kstep; const char* b2 = last ? nB : cB + (size_t)(t + 2) * kstep;
            const char* a3 = a2 + kstep; const char* b3 = b2 + kstep;
            PG8_LDB(B0, 0, 0); PG8_LDB(B1, 0, 1); PG8_SCHED; PG8_LDA(At, 0, 0); PG8_STAGE(PG8_SA(1, 1), a1 + hA, vA0, vA1);
            PG8_WAIT_V(8); PG8_WAIT_L(0); PG8_BAR; PG8_MMA(0, 0, At, B0); PG8_MMA(0, 1, At, B1); PG8_BAR; PG8_SCHED;
            PG8_LDA(At, 0, 1); PG8_STAGE(PG8_SB(0, 0), b2, vB0, vB1); PG8_STAGE(PG8_SB(0, 1), b2 + hB, vB0, vB1); PG8_STAGE(PG8_SA(0, 0), a2, vA0, vA1);
            PG8_WAIT_V(8); PG8_WAIT_L(0); PG8_BAR; PG8_MMA(1, 0, At, B0); PG8_MMA(1, 1, At, B1); PG8_BAR; PG8_SCHED;
            PG8_LDB(B0, 1, 0); PG8_LDB(B1, 1, 1); PG8_SCHED; PG8_LDA(At, 1, 0); PG8_STAGE(PG8_SA(0, 1), a2 + hA, vA0, vA1);
            PG8_WAIT_V(8); PG8_WAIT_L(0); PG8_BAR; PG8_MMA(0, 0, At, B0); PG8_MMA(0, 1, At, B1); PG8_BAR; PG8_SCHED;
            PG8_LDA(At, 1, 1); PG8_STAGE(PG8_SB(1, 0), b3, vB0, vB1); PG8_STAGE(PG8_SB(1, 1), b3 + hB, vB0, vB1); PG8_STAGE(PG8_SA(1, 0), a3, vA0, vA1);
            PG8_WAIT_V(8); PG8_WAIT_L(0); PG8_BAR; PG8_MMA(1, 0, At, B0); PG8_MMA(1, 1, At, B1); PG8_BAR; PG8_SCHED;
        }
        if constexpr (ALIGN_EPI) { if (wr == 0) PG8_BAR; }
        {
            const int el_ = fresh_lane(); const int fr_ = el_ & 15, fq_ = el_ >> 4;
#pragma unroll
            for (int ai = 0; ai < 2; ++ai)
#pragma unroll
                for (int m = 0; m < 4; ++m) { const int row = ai * HALF + wr * 64 + m * 16 + fr_;
                    if constexpr (Epi::PAIR) { float g[8], up[8];
#pragma unroll
                        for (int j = 0; j < 4; ++j) { g[j] = acc[ai][0][m][0][j]; g[4 + j] = acc[ai][0][m][1][j]; up[j] = acc[ai][1][m][0][j]; up[4 + j] = acc[ai][1][m][1][j]; }
                        E.store2(cur, row, wc * 32 + 8 * fq_, g, up); }
                    else {
#pragma unroll
                        for (int bj = 0; bj < 2; ++bj) { float v[8];
#pragma unroll
                            for (int j = 0; j < 4; ++j) { v[j] = acc[ai][bj][m][0][j]; v[4 + j] = acc[ai][bj][m][1][j]; }
                            E.store(cur, row, bj * HALF + wc * 32 + 8 * fq_, v); } } }
        }
        if (!has_next) break;
#pragma unroll
        for (int a = 0; a < 2; ++a)
#pragma unroll
            for (int b = 0; b < 2; ++b)
#pragma unroll
                for (int m = 0; m < 4; ++m)
#pragma unroll
                    for (int n = 0; n < 2; ++n) acc[a][b][m][n] = (f32x4){0.f, 0.f, 0.f, 0.f};
        cur = nxt; cA = nA; cB = nB; ++ui;
        if constexpr (ALIGN_EPI) { if (wr == 1) PG8_BAR; }
    }
    PG8_WAIT_V(0);
    if constexpr (!ALIGN_EPI) { if (wr == 0) PG8_BAR; }
    PG8_BAR;
#undef PG8_SA
#undef PG8_SB
#undef PG8_STAGE
#undef PG8_LDA
#undef PG8_LDB
#undef PG8_MMA
#undef PG8_WAIT_V
#undef PG8_WAIT_L
#undef PG8_BAR
#undef PG8_SCHED
}
}

namespace att {
typedef short bf16x8 __attribute__((ext_vector_type(8)));
typedef short s16x4 __attribute__((ext_vector_type(4)));
typedef float f32x16 __attribute__((ext_vector_type(16)));
typedef float f32x2_t __attribute__((ext_vector_type(2)));
typedef __bf16 bf16x2_t __attribute__((ext_vector_type(2)));
DI unsigned cvtpk(float lo, float hi) { f32x2_t v = {lo, hi}; bf16x2_t b = __builtin_convertvector(v, bf16x2_t); return __builtin_bit_cast(unsigned, b); }
DI int crow(int r, int h) { return (r & 3) + 8 * (r >> 2) + 4 * h; }

template <bool SWA>
DI void attn_phase(const Params& p, LAS unsigned char* lds, int G, int c) {
    constexpr int DK = SWA ? 64 : 192, DV = SWA ? 64 : 128, KSTR = DK * 2 + 16, VSTR = 136;
    constexpr int KB = 64 * KSTR, VB = DV * VSTR, STG = KB + VB;
    constexpr int CPR = DK / 8, NKC = (64 * CPR) / NTHREADS, NVC = (DV * 8) / NTHREADS, NQ = DK / 16, NDV = DV / 32;
    constexpr int LDQ = SWA ? 2048 : 1536, NUNITS = SWA ? 1536 : 384;
    static_assert(2 * STG <= 131072, "attention LDS");
    const int tid = threadIdx.x, lane = tid & 63, wid = __builtin_amdgcn_readfirstlane(tid >> 6), q = lane & 31, hh = lane >> 5;
    const bf16_t* Q = wsp<bf16_t>(p, WS_Q); const bf16_t* KN = wsp<bf16_t>(p, SWA ? WS_KO : WS_KN); const bf16_t* KPE = wsp<bf16_t>(p, WS_KPE);
    const bf16_t* VT = wsp<bf16_t>(p, SWA ? WS_VTO : WS_VT); bf16_t* MIX = wsp<bf16_t>(p, WS_MIX);
    for (int L = c; L < NUNITS; L += G) {
        int rowbase, hk, nt0, nt1, key0a, key0b = 0, kpos0 = 0, qpos0 = 0; bool masked = false;
        if (!SWA) {
            if (L < 256) { const int b = L >> 5, qt = L & 3; hk = (L >> 2) & 7; rowbase = T_CTX + b * 1024 + qt * 256; key0a = T_CTX + b * 1024; nt0 = 16; key0b = T + b * 512; nt1 = 8; }
            else { const int Lc = L - 256, b = Lc >> 3; hk = Lc & 7; rowbase = b * 256; key0a = b * 256; nt0 = 4; nt1 = 0; }
        } else {
            if (L < 1024) { const int b = L >> 7, t0 = (L & 31) * 32; hk = (L >> 5) & 3; rowbase = T_CTX + b * 1024 + t0;
                const int lo = max(t0 - 128, 0) & ~63, hi = min((t0 + 160 + 63) & ~63, 1024);
                key0a = T_CTX + b * 1024 + lo; nt0 = (hi - lo) >> 6; kpos0 = lo; qpos0 = t0; masked = true; key0b = T + b * 512; nt1 = 8; }
            else { const int Lc = L - 1024, b = Lc >> 5; hk = (Lc >> 3) & 3; rowbase = b * 256 + (Lc & 7) * 32; key0a = b * 256; nt0 = 4; nt1 = 0; }
        }
        const int total = nt0 + nt1;
        const int qrow = SWA ? rowbase + q : rowbase + wid * 32 + q;
        const int qhead = SWA ? hk * 8 + wid : hk;
        bf16x8 qf[NQ];
#pragma unroll
        for (int s = 0; s < NQ; ++s) qf[s] = *(const bf16x8*)(Q + (size_t)qrow * LDQ + qhead * DK + 16 * s + 8 * hh);
        f32x16 o[NDV];
#pragma unroll
        for (int d = 0; d < NDV; ++d)
#pragma unroll
            for (int r = 0; r < 16; ++r) o[d][r] = 0.f;
        float m = SWA ? p.in[19][qhead] * LOG2E : -1e30f, l = (SWA && hh == 0) ? 1.f : 0.f;
        const int qpos = qpos0 + q;
        u32x4 kreg[NKC], vreg[NVC];
#define ATT_LOAD(t_) do { const int tt_ = (t_); const int kb_ = tt_ < nt0 ? key0a + tt_ * 64 : key0b + (tt_ - nt0) * 64; \
            _Pragma("unroll") for (int i = 0; i < NKC; ++i) { const int ch = tid + NTHREADS * i, j = ch / CPR, cc = ch % CPR; \
                const bf16_t* src = SWA ? KN + (size_t)(kb_ + j) * 256 + hk * 64 + cc * 8 : (cc < 16 ? KN + (size_t)(kb_ + j) * 1024 + hk * 128 + cc * 8 : KPE + (size_t)(kb_ + j) * 64 + (cc - 16) * 8); \
                kreg[i] = *(const u32x4*)src; } \
            _Pragma("unroll") for (int i = 0; i < NVC; ++i) { const int ch = tid + NTHREADS * i, dv = ch >> 3, cc = ch & 7; \
                vreg[i] = *(const u32x4*)(VT + (size_t)(hk * DV + dv) * TX + kb_ + cc * 8); } } while (0)
#define ATT_WRITE(buf_) do { LAS unsigned char* Kw = lds + (buf_) * STG; LAS unsigned char* Vw = Kw + KB; \
            _Pragma("unroll") for (int i = 0; i < NKC; ++i) { const int ch = tid + NTHREADS * i, j = ch / CPR, cc = ch % CPR; *(LAS u32x4*)(Kw + j * KSTR + cc * 16) = kreg[i]; } \
            _Pragma("unroll") for (int i = 0; i < NVC; ++i) { const int ch = tid + NTHREADS * i, dv = ch >> 3, cc = ch & 7; \
                *(LAS u32x2*)(Vw + dv * VSTR + cc * 16) = (u32x2){vreg[i].x, vreg[i].y}; *(LAS u32x2*)(Vw + dv * VSTR + cc * 16 + 8) = (u32x2){vreg[i].z, vreg[i].w}; } } while (0)
        ATT_LOAD(0); ATT_WRITE(0);
        __syncthreads();
        for (int t = 0; t < total; ++t) {
            const int buf = t & 1;
            if (t + 1 < total) ATT_LOAD(t + 1);
            const LAS unsigned char* Kl = lds + buf * STG; const LAS unsigned char* Vl = Kl + KB;
            f32x16 s0, s1;
#pragma unroll
            for (int r = 0; r < 16; ++r) { s0[r] = 0.f; s1[r] = 0.f; }
#pragma unroll
            for (int s = 0; s < NQ; ++s) {
                const bf16x8 a0 = *(const LAS bf16x8*)(Kl + q * KSTR + (16 * s + 8 * hh) * 2);
                const bf16x8 a1 = *(const LAS bf16x8*)(Kl + (32 + q) * KSTR + (16 * s + 8 * hh) * 2);
                s0 = __builtin_amdgcn_mfma_f32_32x32x16_bf16(a0, qf[s], s0, 0, 0, 0);
                s1 = __builtin_amdgcn_mfma_f32_32x32x16_bf16(a1, qf[s], s1, 0, 0, 0);
            }
            if (SWA && masked && t < nt0) {
                const int kp = kpos0 + t * 64 - qpos;
#pragma unroll
                for (int r = 0; r < 16; ++r) { const int d0 = kp + crow(r, hh), d1 = d0 + 32;
                    s0[r] = (d0 >= -128 && d0 <= 128) ? s0[r] : -1e30f; s1[r] = (d1 >= -128 && d1 <= 128) ? s1[r] : -1e30f; }
            }
            float tm = fmaxf(s0[0], s1[0]);
#pragma unroll
            for (int r = 1; r < 16; ++r) tm = fmaxf(tm, fmaxf(s0[r], s1[r]));
            tm = fmaxf(tm, __shfl_xor(tm, 32));
            const float mn = fmaxf(m, tm), alpha = __builtin_amdgcn_exp2f(m - mn); m = mn;
            l *= alpha;
#pragma unroll
            for (int d = 0; d < NDV; ++d)
#pragma unroll
                for (int r = 0; r < 16; ++r) o[d][r] *= alpha;
            float ls = 0.f;
#pragma unroll
            for (int r = 0; r < 16; ++r) { s0[r] = __builtin_amdgcn_exp2f(s0[r] - m); s1[r] = __builtin_amdgcn_exp2f(s1[r] - m); ls += s0[r] + s1[r]; }
            l += ls;
            bf16x8 pb[2][2];
#pragma unroll
            for (int s = 0; s < 2; ++s) {
                u32x4 w0, w1;
                w0.x = cvtpk(s0[8 * s + 0], s0[8 * s + 1]); w0.y = cvtpk(s0[8 * s + 2], s0[8 * s + 3]); w0.z = cvtpk(s0[8 * s + 4], s0[8 * s + 5]); w0.w = cvtpk(s0[8 * s + 6], s0[8 * s + 7]);
                w1.x = cvtpk(s1[8 * s + 0], s1[8 * s + 1]); w1.y = cvtpk(s1[8 * s + 2], s1[8 * s + 3]); w1.z = cvtpk(s1[8 * s + 4], s1[8 * s + 5]); w1.w = cvtpk(s1[8 * s + 6], s1[8 * s + 7]);
                pb[0][s] = __builtin_bit_cast(bf16x8, w0); pb[1][s] = __builtin_bit_cast(bf16x8, w1);
            }
#pragma unroll
            for (int d = 0; d < NDV; ++d)
#pragma unroll
                for (int blk = 0; blk < 2; ++blk)
#pragma unroll
                    for (int s = 0; s < 2; ++s) {
                        const LAS unsigned char* vp = Vl + (d * 32 + q) * VSTR + (blk * 32 + 16 * s + 4 * hh) * 2;
                        const s16x4 lo = *(const LAS s16x4*)vp, hi = *(const LAS s16x4*)(vp + 16);
                        const bf16x8 a = {lo[0], lo[1], lo[2], lo[3], hi[0], hi[1], hi[2], hi[3]};
                        o[d] = __builtin_amdgcn_mfma_f32_32x32x16_bf16(a, pb[blk][s], o[d], 0, 0, 0);
                    }
            if (t + 1 < total) ATT_WRITE(buf ^ 1);
            __syncthreads();
        }
#undef ATT_LOAD
#undef ATT_WRITE
        const float inv = 1.f / (l + __shfl_xor(l, 32));
        bf16_t* orow = MIX + (size_t)qrow * 2048 + qhead * DV;
#pragma unroll
        for (int d = 0; d < NDV; ++d)
#pragma unroll
            for (int g = 0; g < 4; ++g) { u32x2 w; w.x = cvtpk(o[d][4 * g] * inv, o[d][4 * g + 1] * inv); w.y = cvtpk(o[d][4 * g + 2] * inv, o[d][4 * g + 3] * inv);
                *(u32x2*)(orow + d * 32 + 8 * g + 4 * hh) = w; }
    }
}
}


#ifndef R_PRO
#define R_PRO 1
#endif
#ifndef R_MOE
#define R_MOE 1
#endif
#ifndef R_ATT
#define R_ATT 1
#endif
#ifndef R_GEMM
#define R_GEMM 1
#endif
#ifndef R_THIN
#define R_THIN 1
#endif
#ifndef R_LN1
#define R_LN1 1
#endif
#ifndef R_LN2
#define R_LN2 1
#endif
#ifndef R_TOPK
#define R_TOPK 1
#endif
#define REP(n) for (int _r = 0; _r < (n); ++_r)
#define REPS(n, ...) do { { __VA_ARGS__ } if ((n) > 1) { __VA_ARGS__ } } while (0)
constexpr int LDS_BYTES = 147456, MISC_OFF = 146432;
constexpr int NPH = 20;
__global__ void __launch_bounds__(NTHREADS, 2) mega(Params p) {
    extern __shared__ __attribute__((aligned(16))) unsigned char lds[];
    const int G = gridDim.x, c = vcu_of(blockIdx.x, G), wid = __builtin_amdgcn_readfirstlane(threadIdx.x >> 6);
    volatile LAS unsigned* MISC = (volatile LAS unsigned*)((LAS unsigned char*)lds + MISC_OFF);
    if (threadIdx.x < 4) MISC[threadIdx.x] = 0u;
    __syncthreads();
    XcdBarrier bar = xcd_barrier_post((unsigned*)(p.ws + WS_CTL) + CW_BAR, MISC);
    const int lo = p.ph_lo, hi = p.ph_hi;
#define IN(k) (lo <= (k) && (k) < hi)
#define SEAM(k) do { if (IN(k) && IN((k) + 1)) xcd_barrier(bar); } while (0)
    if (IN(0)) REP(R_PRO) { ph_mod(p, lds); ph_misc(p); ph_convert(p, 0, CV_TOTAL); } SEAM(0);
    if (IN(1)) REP(R_THIN) { ph_h0(p); } SEAM(1);
    if (IN(2)) REPS(R_GEMM, SchedInEven S{&p, G, c}; EpiInEven E{&p}; pg8::gemm_phase((LAS unsigned char*)lds, S, E, wid);); SEAM(2);
    if (IN(3)) REP(R_THIN) { ph_e1(p); } SEAM(3);
    if (IN(4)) REPS(R_GEMM, SchedE2 S{&p, G, c}; EpiE2 E{&p}; pg8::gemm_phase((LAS unsigned char*)lds, S, E, wid);); SEAM(4);
    if (IN(5)) REP(R_ATT) { att::attn_phase<false>(p, (LAS unsigned char*)lds, G, c); } SEAM(5);
    if (IN(6)) REPS(R_GEMM, SchedOut S{&p, G, c, 0}; EpiOut E{&p, 0}; pg8::gemm_phase((LAS unsigned char*)lds, S, E, wid);); SEAM(6);
    if (IN(7)) REP(R_LN1) { ph_ln1(p, 0, lds); } SEAM(7);
    if (IN(8)) REP(R_TOPK) { ph_topk(p, lds); } SEAM(8);
    if (IN(9)) REPS(R_MOE, SchedGU S{&p, G, c, 0}; EpiGU E{&p}; pg8::gemm_phase((LAS unsigned char*)lds, S, E, wid);); SEAM(9);
    if (IN(10)) REPS(R_MOE, SchedDown S{&p, G, c, 0}; EpiDown E{&p}; pg8::gemm_phase((LAS unsigned char*)lds, S, E, wid);); SEAM(10);
    if (IN(11)) REP(R_LN2) { ph_ln2(p, 0); } SEAM(11);
    if (IN(12)) REPS(R_GEMM, SchedInOdd S{&p, G, c}; EpiInOdd E{&p}; pg8::gemm_phase((LAS unsigned char*)lds, S, E, wid);); SEAM(12);
    if (IN(13)) REP(R_ATT) { att::attn_phase<true>(p, (LAS unsigned char*)lds, G, c); } SEAM(13);
    if (IN(14)) REPS(R_GEMM, SchedOut S{&p, G, c, 1}; EpiOut E{&p, 1}; pg8::gemm_phase((LAS unsigned char*)lds, S, E, wid);); SEAM(14);
    if (IN(15)) REP(R_LN1) { ph_ln1(p, 1, lds); } SEAM(15);
    if (IN(16)) REP(R_TOPK) { ph_topk(p, lds); } SEAM(16);
    if (IN(17)) REPS(R_MOE, SchedGU S{&p, G, c, 1}; EpiGU E{&p}; pg8::gemm_phase((LAS unsigned char*)lds, S, E, wid);); SEAM(17);
    if (IN(18)) REPS(R_MOE, SchedDown S{&p, G, c, 1}; EpiDown E{&p}; pg8::gemm_phase((LAS unsigned char*)lds, S, E, wid);); SEAM(18);
    if (IN(19)) REP(R_LN2) { ph_ln2(p, 1); }
#undef IN
#undef SEAM
}

extern "C" void kernel_launch(void* const* d_in, const int* in_sizes, int n_in, void* d_out, int out_size, void* d_ws, size_t ws_size, hipStream_t stream) {
    static int grid = 0;
    if (grid == 0) {
        if (n_in != 29 || out_size != (int)O_END || ws_size < WS_END) { fprintf(stderr, "kernel_launch: unexpected shapes (n_in %d out %d ws %zu need %zu)\n", n_in, out_size, ws_size, (size_t)WS_END); grid = -1; return; }
        int dev = 0, cus = 0, per_cu = 0;
        if (hipGetDevice(&dev) != hipSuccess || hipDeviceGetAttribute(&cus, hipDeviceAttributeMultiprocessorCount, dev) != hipSuccess) { grid = -1; return; }
        if (hipFuncSetAttribute((const void*)mega, hipFuncAttributeMaxDynamicSharedMemorySize, LDS_BYTES) != hipSuccess) { fprintf(stderr, "hipFuncSetAttribute failed\n"); grid = -1; return; }
        if (hipOccupancyMaxActiveBlocksPerMultiprocessor(&per_cu, (const void*)mega, NTHREADS, LDS_BYTES) != hipSuccess || per_cu < 1) fprintf(stderr, "occupancy query: %d\n", per_cu);
        (void)hipGetLastError();
        grid = cus > 0 ? cus : 256;
    }
    if (grid < 0) return;
    Params p{};
    for (int i = 0; i < 29; ++i) p.in[i] = (const float*)d_in[i];
    p.out = (float*)d_out; p.ws = (unsigned char*)d_ws; p.ph_lo = 0; p.ph_hi = NPH;
    (void)hipMemsetAsync((char*)d_ws + WS_CTL, 0, CTL_BYTES, stream);
    hipLaunchKernelGGL(mega, dim3(grid), dim3(NTHREADS), LDS_BYTES, stream, p);
}
```

```cpp
#include <hip/hip_runtime.h>
#include <cstdio>
#include <cstdint>

constexpr int D = 2048, T_CTX = 4096, T = 12288, TC = 4096, TX = 16384;
constexpr int MODW = 12288, NCOND = 9;
constexpr int NSLOT = 1536, NXS = 16 * NSLOT;
constexpr float DN_ALPHA = 1.41421356237309515f;
constexpr float LOG2E = 1.44269504088896341f;
constexpr float QS_MLA = 0.07216878364870322f * LOG2E;
constexpr float QS_SWA = 0.125f * LOG2E;
constexpr int NTHREADS = 512, NWAVES = 8;
#ifndef MOE_F8
#define MOE_F8 1
#endif
constexpr float GU_WSCALE = 32.f, DN_WSCALE = 64.f;

constexpr size_t O_Y = 0, O_CKV = 25165824, O_KPE = 26214400, O_SK = 26476544, O_SV = 27525120, O_END = 28573696;

constexpr size_t al256(size_t x) { return (x + 255) & ~(size_t)255; }
constexpr size_t WS_CTL = 0, CTL_BYTES = 1u << 20;
constexpr size_t WS_MOD = WS_CTL + CTL_BYTES;
constexpr size_t WS_ROPE = WS_MOD + al256((size_t)2 * 9 * 12288 * 4);
constexpr size_t WS_WINE = WS_ROPE + al256((size_t)2 * 1024 * 32 * 4);
constexpr size_t WS_W2 = WS_WINE + (size_t)2048 * 2048 * 2;
constexpr size_t WS_WOUTE = WS_W2 + (size_t)4608 * 1792 * 2;
constexpr size_t WS_WINO = WS_WOUTE + (size_t)2048 * 2048 * 2;
constexpr size_t WS_WOUTO = WS_WINO + (size_t)2560 * 2048 * 2;
constexpr size_t WS_WGU = WS_WOUTO + (size_t)2048 * 2048 * 2;
constexpr size_t WS_WDN = WS_WGU + (size_t)32 * 4096 * 2048 * 2;
constexpr size_t WS_H = WS_WDN + (size_t)32 * 2048 * 2048 * 2;
constexpr size_t WS_PJ = WS_H + (size_t)T * 2048 * 2;
constexpr size_t WS_ACT2 = WS_PJ + (size_t)T * 1792 * 4;
constexpr size_t WS_KPE = WS_ACT2 + (size_t)TX * 1792 * 2;
constexpr size_t WS_Q = WS_KPE + (size_t)TX * 64 * 2;
constexpr size_t WS_KN = WS_Q + (size_t)T * 2048 * 2;
constexpr size_t WS_VT = WS_KN + (size_t)TX * 1024 * 2;
constexpr size_t WS_VTO = WS_VT + (size_t)1024 * TX * 2;
constexpr size_t WS_KO = WS_VTO + (size_t)256 * TX * 2;
constexpr size_t WS_MIX = WS_KO + (size_t)TX * 256 * 2;
constexpr size_t WS_Y = WS_MIX + (size_t)T * 2048 * 2;
constexpr size_t WS_X1 = WS_Y + (size_t)T * 2048 * 4;
constexpr size_t WS_XL = WS_X1 + (size_t)T * 2048 * 4;
constexpr size_t WS_AFF = WS_XL + (size_t)T * 2048 * 4;
constexpr size_t WS_INV = WS_AFF + (size_t)T * 16 * 4;
constexpr size_t WS_XS = WS_INV + (size_t)T * 16 * 4;
constexpr size_t WS_HID = WS_XS + (size_t)NXS * 2048 * 2;
constexpr size_t WS_YE = WS_HID + (size_t)NXS * 2048 * 2;
constexpr size_t WS_AFFT = WS_YE + (size_t)NXS * 2048 * 2;
constexpr size_t WS_H8 = WS_AFFT + (size_t)T * 16 * 4;
constexpr size_t WS_DBG = WS_H8 + (size_t)T * 2048;
constexpr size_t WS_END = WS_DBG + (1u << 20);

typedef unsigned short bf16_t;
typedef float f32x4 __attribute__((ext_vector_type(4)));
typedef unsigned u32x4 __attribute__((ext_vector_type(4)));
typedef unsigned u32x2 __attribute__((ext_vector_type(2)));
#define LAS __attribute__((address_space(3)))
#define DI __device__ __forceinline__

struct Params {
    const float* in[29];
    float* out;
    unsigned char* ws;
    int ph_lo, ph_hi;
};

DI unsigned f2bf(float f) { unsigned u = __float_as_uint(f); return (u + 0x7fffu + ((u >> 16) & 1u)) >> 16; }
DI unsigned pk2(float lo, float hi) { return f2bf(lo) | (f2bf(hi) << 16); }
DI unsigned pk4_fp8(float a, float b, float c, float d) { unsigned w = 0; w = __builtin_amdgcn_cvt_pk_fp8_f32(a, b, w, false); w = __builtin_amdgcn_cvt_pk_fp8_f32(c, d, w, true); return w; }
DI float bf2f(unsigned b) { return __uint_as_float(b << 16); }
DI float bflo(unsigned w) { return __uint_as_float(w << 16); }
DI float bfhi(unsigned w) { return __uint_as_float(w & 0xffff0000u); }
DI float wave_sum(float v) {
#pragma unroll
    for (int o = 1; o < 64; o <<= 1) v += __shfl_xor(v, o);
    return v;
}
DI float wave_max(float v) {
#pragma unroll
    for (int o = 1; o < 64; o <<= 1) v = fmaxf(v, __shfl_xor(v, o));
    return v;
}
DI int fresh_lane() { int l = (int)__builtin_amdgcn_mbcnt_hi(~0u, __builtin_amdgcn_mbcnt_lo(~0u, 0u)); asm volatile("" : "+v"(l)); return l; }
DI int cond_of_row(int r) { return r < T_CTX ? 0 : 1 + ((r - T_CTX) >> 10); }
DI const float* xrow_in(const Params& p, int r) { return r < T_CTX ? p.in[0] + (size_t)r * D : p.in[1] + (size_t)(r - T_CTX) * D; }

DI float* ws_mod(const Params& p) { return (float*)(p.ws + WS_MOD); }
DI float* ws_cos(const Params& p) { return (float*)(p.ws + WS_ROPE); }
DI float* ws_sin(const Params& p) { return (float*)(p.ws + WS_ROPE) + 1024 * 32; }
template <class X> DI X* wsp(const Params& p, size_t off) { return (X*)(p.ws + off); }
DI const float* modp(const Params& p, int l, int ci, int j) { return ws_mod(p) + ((size_t)(l * 9 + ci) * MODW + (size_t)j * D); }

#define XB_TMO      128
#define XB_XCNT(j)  (256  + 64 * (j))
#define XB_XSUB(j)  (1280 + 64 * (j))
#define XB_XGEN(j)  (2304 + 64 * (j))
#define XB_TOP      3328
#define XB_TOPGEN   3392
#define XCD_BAR_WORDS 3456
#define XB_SPIN_CAP (1u << 18)

__device__ __forceinline__ unsigned xb_ld(unsigned* p)              { return __hip_atomic_load(p, __ATOMIC_RELAXED, __HIP_MEMORY_SCOPE_AGENT); }
__device__ __forceinline__ unsigned xb_add(unsigned* p, unsigned v) { return __hip_atomic_fetch_add(p, v, __ATOMIC_RELAXED, __HIP_MEMORY_SCOPE_AGENT); }
__device__ __forceinline__ unsigned xb_xcc_id() { return (unsigned)__builtin_amdgcn_s_getreg((3 << 11) | 20) & 0xFu; }
#define XB_SPIN(cond, bar) do { unsigned _sp = 0; while (cond) { __builtin_amdgcn_s_sleep(1); \
    if ((++_sp & 255u) == 0u) { if (xb_ld(&(bar)[XB_TMO])) break; if (_sp > XB_SPIN_CAP) { atomicAdd(&(bar)[XB_TMO], 1u); break; } } } } while (0)

struct XcdBarrier {
    unsigned* bar; unsigned x;
    volatile LAS unsigned* st;
};

__device__ __forceinline__ XcdBarrier xcd_barrier_post(unsigned* bar, volatile LAS unsigned* st) {
    XcdBarrier b; b.bar = bar; b.x = xb_xcc_id(); b.st = st;
    if (threadIdx.x == 0) (void)xb_add(&bar[XB_XCNT(b.x)], 1u);
    return b;
}
__device__ __forceinline__ void xcd_barrier_complete(unsigned* bar, unsigned x, unsigned& nloc, unsigned& nx) {
    const unsigned G = gridDim.x * gridDim.y * gridDim.z;
    unsigned sum, cnt, mine, sp = 0u;
    for (;;) {
        sum = 0u; cnt = 0u; mine = 0u;
#pragma unroll
        for (unsigned j = 0; j < 16; ++j) { const unsigned c = xb_ld(&bar[XB_XCNT(j)]); sum += c; cnt += (c > 0u) ? 1u : 0u; mine = (j == x) ? c : mine; }
        if (sum == G) break;
        __builtin_amdgcn_s_sleep(1);
        if ((++sp & 255u) == 0u) { if (xb_ld(&bar[XB_TMO])) break; if (sp > XB_SPIN_CAP) { atomicAdd(&bar[XB_TMO], 1u); break; } }
    }
    nloc = mine > 0u ? mine : 1u; nx = cnt > 0u ? cnt : 1u;
}

__device__ __forceinline__ void xcd_barrier(const XcdBarrier& b) {
    asm volatile("s_waitcnt vmcnt(0)" ::: "memory");
    __syncthreads();
    if (threadIdx.x == 0) {
        unsigned* bar = b.bar;
        __builtin_amdgcn_s_waitcnt(0);
        unsigned nloc = b.st[0], nx = b.st[1];
        if (nloc == 0u) { xcd_barrier_complete(bar, b.x, nloc, nx); b.st[0] = nloc; b.st[1] = nx; }
        const unsigned old = xb_add(&bar[XB_XSUB(b.x)], 1u);
        const unsigned gen = old / nloc;
        if (old + 1u == (gen + 1u) * nloc) {
            __builtin_amdgcn_fence(__ATOMIC_RELEASE, "agent");
            asm volatile("s_waitcnt vmcnt(0)" ::: "memory");
            const unsigned og = xb_add(&bar[XB_TOP], 1u);
            const unsigned tg = og / nx;
            if (og + 1u == (tg + 1u) * nx) xb_add(&bar[XB_TOPGEN], 1u);
            else XB_SPIN(xb_ld(&bar[XB_TOPGEN]) == tg, bar);
            __builtin_amdgcn_fence(__ATOMIC_ACQUIRE, "agent");
            xb_add(&bar[XB_XGEN(b.x)], 1u);
            asm volatile("s_waitcnt vmcnt(0)" ::: "memory");
        } else {
            XB_SPIN(xb_ld(&bar[XB_XGEN(b.x)]) == gen, bar);
            __builtin_amdgcn_fence(__ATOMIC_ACQUIRE, "agent");
            asm volatile("s_waitcnt vmcnt(0)" ::: "memory");
        }
    }
    __syncthreads();
}
constexpr int CW_BAR = 4096;


DI void ph_mod(const Params& p, unsigned char* lds_raw) {
    float* s_lds = (float*)lds_raw;
    float* red = s_lds + 9 * 2048;
    const int tid = threadIdx.x, lane = tid & 63, wave = __builtin_amdgcn_readfirstlane(tid >> 6);
    const float* c = p.in[6]; const float* c_ctx = p.in[7]; const float* w_ada = p.in[8]; const float* b_ada = p.in[9];
    for (int i = tid; i < 9 * 2048; i += NTHREADS) { const int ci = i >> 11, k = i & 2047; const float v = ci == 0 ? c_ctx[k] : c[(ci - 1) * 2048 + k]; s_lds[i] = v / (1.f + expf(-v)); }
    __syncthreads();
    float* MOD = ws_mod(p);
    for (int it = blockIdx.x; it < 384; it += gridDim.x) {
        const int l = it / 192, c0 = (it % 192) * 64;
        const int kq = tid >> 4, cl = tid & 15;
        const float* w = w_ada + (size_t)l * 2048 * MODW + c0 + 4 * cl;
        float acc[9][4];
#pragma unroll
        for (int ci = 0; ci < 9; ++ci)
#pragma unroll
            for (int j = 0; j < 4; ++j) acc[ci][j] = 0.f;
#pragma unroll 8
        for (int kk = 0; kk < 64; ++kk) {
            const int k = kq * 64 + kk;
            const f32x4 wv = *(const f32x4*)(w + (size_t)k * MODW);
#pragma unroll
            for (int ci = 0; ci < 9; ++ci) { const float s = s_lds[ci * 2048 + k];
#pragma unroll
                for (int j = 0; j < 4; ++j) acc[ci][j] += s * wv[j]; }
        }
#pragma unroll
        for (int ci = 0; ci < 9; ++ci)
#pragma unroll
            for (int j = 0; j < 4; ++j) { float v = acc[ci][j]; v += __shfl_xor(v, 16); v += __shfl_xor(v, 32); acc[ci][j] = v; }
        if (lane < 16) {
#pragma unroll
            for (int ci = 0; ci < 9; ++ci)
#pragma unroll
                for (int j = 0; j < 4; ++j) red[(wave * 9 + ci) * 64 + 4 * cl + j] = acc[ci][j];
        }
        __syncthreads();
        for (int o = tid; o < 576; o += NTHREADS) { const int ci = o >> 6, cc = o & 63; float s = 0.f;
#pragma unroll
            for (int w8 = 0; w8 < 8; ++w8) s += red[(w8 * 9 + ci) * 64 + cc];
            MOD[(size_t)(l * 9 + ci) * MODW + c0 + cc] = s + b_ada[l * MODW + c0 + cc]; }
        __syncthreads();
    }
}

constexpr int CV_INE = 928, CV_UQ = 192, CV_UKV = 128, CV_POOL = 64, CV_OUT = 1024, CV_INO = 1280, CV_MOE = 98304;
constexpr int CV_TOTAL = CV_INE + CV_UQ + CV_UKV + CV_POOL + CV_OUT + CV_INO + CV_OUT + CV_MOE;
DI void cvt_item(const Params& p, int item, int lane) {
    const float* src; bf16_t* dst; int K, N, ldd, nb, kb, map = 0, a = 0; float f8s = 0.f;
    if (item < CV_INE) { src = p.in[10]; dst = wsp<bf16_t>(p, WS_WINE); K = 2048; N = 1856; ldd = 2048; nb = item % 29; kb = item / 29; map = 1; }
    else if ((item -= CV_INE) < CV_UQ) { src = p.in[13]; dst = wsp<bf16_t>(p, WS_W2); K = 512; N = 1536; ldd = 1792; nb = item % 24; kb = item / 24; }
    else if ((item -= CV_UQ) < CV_UKV) { src = p.in[14]; dst = wsp<bf16_t>(p, WS_W2); K = 256; N = 2048; ldd = 1792; nb = item % 32; kb = item / 32; map = 2; }
    else if ((item -= CV_UKV) < CV_POOL) { const int g = item >> 4, r = item & 15; src = p.in[15] + (size_t)g * 65536; dst = wsp<bf16_t>(p, WS_W2); K = 256; N = 256; ldd = 1792; nb = r & 3; kb = r >> 2; a = 3584 + g * 256; }
    else if ((item -= CV_POOL) < CV_OUT) { src = p.in[17]; dst = wsp<bf16_t>(p, WS_WOUTE); K = 2048; N = 2048; ldd = 2048; nb = item & 31; kb = item >> 5; }
    else if ((item -= CV_OUT) < CV_INO) { src = p.in[18]; dst = wsp<bf16_t>(p, WS_WINO); K = 2048; N = 2560; ldd = 2048; nb = item % 40; kb = item / 40; }
    else if ((item -= CV_INO) < CV_OUT) { src = p.in[20]; dst = wsp<bf16_t>(p, WS_WOUTO); K = 2048; N = 2048; ldd = 2048; nb = item & 31; kb = item >> 5; }
    else { item -= CV_OUT; const int mat = item >> 10, w = item & 1023, le = mat / 3, kind = mat % 3; K = 2048; N = 2048; ldd = 2048; nb = w & 31; kb = w >> 5;
        src = p.in[24 + kind] + (size_t)le * 2048 * 2048;
        if (kind == 2) dst = wsp<bf16_t>(p, WS_WDN) + (size_t)le * 2048 * 2048; else { dst = wsp<bf16_t>(p, WS_WGU) + (size_t)le * 4096 * 2048; map = 3; a = kind * 128; }
        if (MOE_F8) { f8s = kind == 2 ? DN_WSCALE : GU_WSCALE; dst = (bf16_t*)((unsigned char*)(kind == 2 ? wsp<bf16_t>(p, WS_WDN) : wsp<bf16_t>(p, WS_WGU)) + (size_t)le * (kind == 2 ? 2048 : 4096) * 2048); } }
    const int n = nb * 64 + lane;
    const float* s = src + (size_t)(kb * 64) * N + n;
    float v[64];
#pragma unroll
    for (int k = 0; k < 64; ++k) v[k] = s[(size_t)k * N];
    int drow;
    if (map == 0) drow = n + a;
    else if (map == 1) drow = n < 768 ? n : (n < 832 ? 1792 + (n - 768) : 768 + (n - 832));
    else if (map == 2) { const int h = n >> 8, j = n & 255; drow = j < 128 ? 1536 + h * 128 + j : 2560 + h * 128 + (j - 128); }
    else drow = (n >> 7) * 256 + (n & 127) + a;
    if (f8s != 0.f) { u32x4* d8 = (u32x4*)((unsigned char*)dst + (size_t)drow * 2048 + kb * 64);
#pragma unroll
        for (int c16 = 0; c16 < 4; ++c16) { u32x4 o; const float* w = v + 16 * c16;
            o.x = pk4_fp8(w[0] * f8s, w[1] * f8s, w[2] * f8s, w[3] * f8s); o.y = pk4_fp8(w[4] * f8s, w[5] * f8s, w[6] * f8s, w[7] * f8s); o.z = pk4_fp8(w[8] * f8s, w[9] * f8s, w[10] * f8s, w[11] * f8s); o.w = pk4_fp8(w[12] * f8s, w[13] * f8s, w[14] * f8s, w[15] * f8s); d8[c16] = o; }
        return; }
    u32x4* d = (u32x4*)(dst + (size_t)drow * ldd + kb * 64);
#pragma unroll
    for (int c8 = 0; c8 < 8; ++c8) { u32x4 o; o.x = pk2(v[8 * c8], v[8 * c8 + 1]); o.y = pk2(v[8 * c8 + 2], v[8 * c8 + 3]); o.z = pk2(v[8 * c8 + 4], v[8 * c8 + 5]); o.w = pk2(v[8 * c8 + 6], v[8 * c8 + 7]); d[c8] = o; }
}
DI void ph_convert(const Params& p, int item_lo, int item_hi) {
    const int lane = threadIdx.x & 63, gw = blockIdx.x * NWAVES + __builtin_amdgcn_readfirstlane(threadIdx.x >> 6), NGW = gridDim.x * NWAVES;
    for (int it = item_lo + gw; it < item_hi; it += NGW) cvt_item(p, it, lane);
}

DI void ph_misc(const Params& p) {
    const size_t gt = (size_t)blockIdx.x * NTHREADS + threadIdx.x, NGT = (size_t)gridDim.x * NTHREADS;
    float* cosT = ws_cos(p); float* sinT = ws_sin(p);
    for (size_t i = gt; i < 1024 * 32; i += NGT) { const int s = (int)(i >> 5), f = (int)(i & 31);
        const float inv = powf(10000.f, -(float)(f & 15) / 16.f); const float pos = f < 16 ? (float)(s >> 6) : (float)(s & 63); const float ang = pos * inv;
        cosT[i] = cosf(ang); sinT[i] = sinf(ang); }
    bf16_t* ACT2 = wsp<bf16_t>(p, WS_ACT2); bf16_t* KPE = wsp<bf16_t>(p, WS_KPE); bf16_t* KO = wsp<bf16_t>(p, WS_KO); bf16_t* VTO = wsp<bf16_t>(p, WS_VTO);
    const float* cckv = p.in[2]; const float* ckpe = p.in[3]; const float* csk = p.in[4]; const float* csv = p.in[5];
    for (size_t i = gt; i < (size_t)TC * 256 / 4; i += NGT) { const size_t e = i * 4; const int j = (int)(e >> 8), cc = (int)(e & 255); const f32x4 v = *(const f32x4*)(cckv + e);
        u32x2 o; o.x = pk2(v[0], v[1]); o.y = pk2(v[2], v[3]); *(u32x2*)(ACT2 + (size_t)(T + j) * 1792 + 512 + cc) = o;
        const f32x4 k = *(const f32x4*)(csk + e); u32x2 o2; o2.x = pk2(k[0], k[1]); o2.y = pk2(k[2], k[3]); *(u32x2*)(KO + (size_t)(T + j) * 256 + cc) = o2; }
    for (size_t i = gt; i < (size_t)TC * 64 / 4; i += NGT) { const size_t e = i * 4; const f32x4 v = *(const f32x4*)(ckpe + e); u32x2 o; o.x = pk2(v[0], v[1]); o.y = pk2(v[2], v[3]); *(u32x2*)(KPE + (size_t)T * 64 + e) = o; }
    for (size_t i = gt; i < (size_t)256 * (TC / 8); i += NGT) { const int f = (int)(i / (TC / 8)), j8 = (int)(i % (TC / 8)) * 8; float v[8];
#pragma unroll
        for (int q = 0; q < 8; ++q) v[q] = csv[(size_t)(j8 + q) * 256 + f];
        u32x4 o; o.x = pk2(v[0], v[1]); o.y = pk2(v[2], v[3]); o.z = pk2(v[4], v[5]); o.w = pk2(v[6], v[7]); *(u32x4*)(VTO + (size_t)f * TX + T + j8) = o; }
}

DI void ph_h0(const Params& p) {
    const int lane = threadIdx.x & 63, gw = blockIdx.x * NWAVES + __builtin_amdgcn_readfirstlane(threadIdx.x >> 6), NGW = gridDim.x * NWAVES;
    bf16_t* H = wsp<bf16_t>(p, WS_H);
    for (int r = gw; r < T; r += NGW) {
        const int ci = cond_of_row(r); const float* x = xrow_in(p, r); const float* sh = modp(p, 0, ci, 0); const float* sc = modp(p, 0, ci, 1);
#pragma unroll
        for (int j = 0; j < 8; ++j) { const int c0 = lane * 4 + 256 * j; const f32x4 v = *(const f32x4*)(x + c0), a = *(const f32x4*)(sc + c0), b = *(const f32x4*)(sh + c0);
            const f32x4 h = v * (1.f + a) + b; u32x2 o; o.x = pk2(h[0], h[1]); o.y = pk2(h[2], h[3]); *(u32x2*)(H + (size_t)r * D + c0) = o; }
    }
}

DI void ph_e1(const Params& p) {
    const int lane = threadIdx.x & 63, gw = blockIdx.x * NWAVES + __builtin_amdgcn_readfirstlane(threadIdx.x >> 6), NGW = gridDim.x * NWAVES;
    const float* PJ = wsp<float>(p, WS_PJ); bf16_t* ACT2 = wsp<bf16_t>(p, WS_ACT2);
    const float* qn = p.in[11]; const float* kvn = p.in[12];
    for (int r = gw; r < T; r += NGW) {
        const float* pr = PJ + (size_t)r * 1792; bf16_t* ar = ACT2 + (size_t)r * 1792;
        {
            f32x4 v[2]; float ss = 0.f;
#pragma unroll
            for (int j = 0; j < 2; ++j) { v[j] = *(const f32x4*)(pr + lane * 4 + 256 * j); ss += (v[j][0] * v[j][0] + v[j][1] * v[j][1]) + (v[j][2] * v[j][2] + v[j][3] * v[j][3]); }
            const float rs = rsqrtf(wave_sum(ss) * (1.f / 512.f) + 1e-6f);
#pragma unroll
            for (int j = 0; j < 2; ++j) { const int c0 = lane * 4 + 256 * j; const f32x4 g = *(const f32x4*)(qn + c0); const f32x4 y = v[j] * rs * g; u32x2 o; o.x = pk2(y[0], y[1]); o.y = pk2(y[2], y[3]); *(u32x2*)(ar + c0) = o; }
        }
        {
            const int c0 = lane * 4; const f32x4 v = *(const f32x4*)(pr + 512 + c0); float ss = (v[0] * v[0] + v[1] * v[1]) + (v[2] * v[2] + v[3] * v[3]);
            const float rs = rsqrtf(wave_sum(ss) * (1.f / 256.f) + 1e-6f); const f32x4 g = *(const f32x4*)(kvn + c0); const f32x4 y = v * rs * g;
            u32x2 o; o.x = pk2(y[0], y[1]); o.y = pk2(y[2], y[3]); *(u32x2*)(ar + 512 + c0) = o;
            if (r < T_CTX) *(f32x4*)(p.out + O_CKV + (size_t)r * 256 + c0) = y;
        }
        {
            int s, S, rb; if (r < T_CTX) { s = r & 255; S = 256; rb = r - s; } else { s = (r - T_CTX) & 1023; S = 1024; rb = r - s; }
#pragma unroll
            for (int g = 0; g < 4; ++g) { const int half = 1 << g; const int lo = max(s - half, 0), hi = min(s + half, S); const int c0 = 768 + g * 256 + lane * 4;
                f32x4 sum = {0.f, 0.f, 0.f, 0.f};
                for (int t = lo; t < hi; ++t) sum += *(const f32x4*)(PJ + (size_t)(rb + t) * 1792 + c0);
                const f32x4 u = *(const f32x4*)(pr + c0); const f32x4 y = sum / (float)(hi - lo) - u;
                u32x2 o; o.x = pk2(y[0], y[1]); o.y = pk2(y[2], y[3]); *(u32x2*)(ar + c0) = o; }
        }
    }
}

DI void ph_ln1(const Params& p, int l, unsigned char* lds_raw) {
    const int tid = threadIdx.x, lane = tid & 63, gw = blockIdx.x * NWAVES + __builtin_amdgcn_readfirstlane(tid >> 6), NGW = gridDim.x * NWAVES;
    float* wT = (float*)lds_raw;
    const float* wr = p.in[23] + (size_t)l * 2048 * 16;
    for (int i = tid; i < 2048 * 16; i += NTHREADS) { const int d = i >> 4, e = i & 15; wT[e * 2048 + d] = wr[i]; }
    __syncthreads();
    const float* Y = wsp<float>(p, WS_Y); float* X1 = wsp<float>(p, WS_X1); bf16_t* H = wsp<bf16_t>(p, WS_H); float* AFF = wsp<float>(p, WS_AFF); float* AFFT = wsp<float>(p, WS_AFFT);
    unsigned char* H8 = wsp<unsigned char>(p, WS_H8);
    const float* lg = p.in[21] + l * D; const float* lb = p.in[22] + l * D;
    f32x4 v[8], vn[8];
    int r = gw;
    if (r < T) {
#pragma unroll
        for (int j = 0; j < 4; ++j) { const float* y = Y + (size_t)r * D + lane * 8 + 512 * j; v[2 * j] = *(const f32x4*)y; v[2 * j + 1] = *(const f32x4*)(y + 4); } }
    for (; r < T; r += NGW) {
        const int rn = r + NGW;
        if (rn < T) {
#pragma unroll
            for (int j = 0; j < 4; ++j) { const float* y = Y + (size_t)rn * D + lane * 8 + 512 * j; vn[2 * j] = *(const f32x4*)y; vn[2 * j + 1] = *(const f32x4*)(y + 4); } }
        const int ci = cond_of_row(r); const float* sh = modp(p, l, ci, 3); const float* sc = modp(p, l, ci, 4);
        float s = 0.f;
#pragma unroll
        for (int j = 0; j < 8; ++j) s += (v[j][0] + v[j][1]) + (v[j][2] + v[j][3]);
        const float mean = wave_sum(s) * (1.f / D); float s2 = 0.f;
#pragma unroll
        for (int j = 0; j < 8; ++j) { v[j] = v[j] - mean; s2 += (v[j][0] * v[j][0] + v[j][1] * v[j][1]) + (v[j][2] * v[j][2] + v[j][3] * v[j][3]); }
        const float rstd = rsqrtf(wave_sum(s2) * (1.f / D) + 1e-5f);
#pragma unroll
        for (int j = 0; j < 4; ++j) { const int c0 = lane * 8 + 512 * j;
#pragma unroll
            for (int q = 0; q < 2; ++q) { const int cc = c0 + 4 * q; const f32x4 x1 = v[2 * j + q] * rstd * *(const f32x4*)(lg + cc) + *(const f32x4*)(lb + cc);
                *(f32x4*)(X1 + (size_t)r * D + cc) = x1; v[2 * j + q] = x1 * (1.f + *(const f32x4*)(sc + cc)) + *(const f32x4*)(sh + cc); }
            const f32x4 a = v[2 * j], b = v[2 * j + 1];
            u32x4 o; o.x = pk2(a[0], a[1]); o.y = pk2(a[2], a[3]); o.z = pk2(b[0], b[1]); o.w = pk2(b[2], b[3]); *(u32x4*)(H + (size_t)r * D + c0) = o;
            u32x2 o8; o8.x = pk4_fp8(a[0], a[1], a[2], a[3]); o8.y = pk4_fp8(b[0], b[1], b[2], b[3]); *(u32x2*)(H8 + (size_t)r * D + c0) = o8; }
        float mine = -1e30f;
#pragma unroll 2
        for (int e = 0; e < 16; ++e) { float a = 0.f;
#pragma unroll
            for (int j = 0; j < 4; ++j) { const float* wp = wT + e * 2048 + lane * 8 + 512 * j; const f32x4 w0 = *(const f32x4*)wp, w1 = *(const f32x4*)(wp + 4); const f32x4 h0 = v[2 * j], h1 = v[2 * j + 1];
                a += ((h0[0] * w0[0] + h0[1] * w0[1]) + (h0[2] * w0[2] + h0[3] * w0[3])) + ((h1[0] * w1[0] + h1[1] * w1[1]) + (h1[2] * w1[2] + h1[3] * w1[3])); }
            a = wave_sum(a); mine = (lane == e) ? a : mine; }
        const float m = wave_max(mine);
        const float ex = lane < 16 ? expf(mine - m) : 0.f;
        const float den = wave_sum(ex);
        if (lane < 16) { const float af = ex / den; AFF[(size_t)r * 16 + lane] = af; AFFT[(size_t)lane * T + r] = af; }
#pragma unroll
        for (int j = 0; j < 8; ++j) v[j] = vn[j];
    }
}

DI void ph_topk(const Params& p, unsigned char* lds_raw) {
    const int tid = threadIdx.x, lane = tid & 63, wave = __builtin_amdgcn_readfirstlane(tid >> 6);
    float* vals = (float*)lds_raw;
    int* cnt2 = (int*)(vals + 1024);
    int* selrow = cnt2 + 256;
    int* selslot = selrow + 256;
    int* nsel = selslot + 256;
    const float* AFFT = wsp<float>(p, WS_AFFT); int* INV = wsp<int>(p, WS_INV); const bf16_t* H = wsp<bf16_t>(p, WS_H); const unsigned char* H8 = wsp<unsigned char>(p, WS_H8); bf16_t* XS = wsp<bf16_t>(p, WS_XS);
    for (int it = blockIdx.x; it < 768; it += gridDim.x) {
        int n, cap, r0, e, sb, c0;
        if (it < 256) { const int b = it >> 4; e = it & 15; n = 256; cap = 32; r0 = b * 256; sb = b * 32; c0 = 0; }
        else { const int q = it - 256, li = q >> 2, b = li >> 4; e = li & 15; n = 1024; cap = 128; r0 = T_CTX + b * 1024; sb = 512 + b * 128; c0 = (q & 3) * 256; }
        for (int i = tid; i < n; i += NTHREADS) vals[i] = AFFT[(size_t)e * T + r0 + i];
        if (tid == 0) *nsel = 0;
        __syncthreads();
        const int ci = c0 + (tid & 255), half = tid >> 8, jn = n >> 1, j0 = half * jn;
        const float vi = vals[ci]; int cnt = 0;
        for (int j = j0; j < j0 + jn; ++j) { const float vj = vals[j]; cnt += (vj > vi || (vj == vi && j < ci)) ? 1 : 0; }
        if (half) cnt2[tid & 255] = cnt;
        __syncthreads();
        if (!half) { cnt += cnt2[tid];
            if (cnt < cap) { const int pos = atomicAdd(nsel, 1); selrow[pos] = ci; selslot[pos] = cnt; INV[(size_t)(r0 + ci) * 16 + e] = sb + cnt; } else INV[(size_t)(r0 + ci) * 16 + e] = -1; }
        __syncthreads();
        const int ns = *nsel;
        for (int k = wave; k < ns; k += NWAVES) { const int r = r0 + selrow[k]; const size_t drow = (size_t)(e * NSLOT + sb + selslot[k]);
            if (MOE_F8) { const u32x4* src = (const u32x4*)(H8 + (size_t)r * D); u32x4* dst = (u32x4*)((unsigned char*)XS + drow * D);
#pragma unroll
                for (int j = 0; j < 2; ++j) dst[lane + 64 * j] = src[lane + 64 * j]; }
            else { const u32x4* src = (const u32x4*)(H + (size_t)r * D); u32x4* dst = (u32x4*)(XS + drow * D);
#pragma unroll
                for (int j = 0; j < 4; ++j) dst[lane + 64 * j] = src[lane + 64 * j]; } }
        __syncthreads();
    }
}

DI void ph_ln2(const Params& p, int l) {
    const int lane = threadIdx.x & 63, gw = blockIdx.x * NWAVES + __builtin_amdgcn_readfirstlane(threadIdx.x >> 6), NGW = gridDim.x * NWAVES;
    const float* X1 = wsp<float>(p, WS_X1); const float* AFF = wsp<float>(p, WS_AFF); const int* INV = wsp<int>(p, WS_INV); const bf16_t* YE = wsp<bf16_t>(p, WS_YE);
    float* XL = wsp<float>(p, WS_XL); bf16_t* H = wsp<bf16_t>(p, WS_H);
    const float* lg = p.in[27] + l * D; const float* lb = p.in[28] + l * D;
    f32x4 x[8], xn[8]; int sl = -1, sln = -1; float af = 0.f, afn = 0.f;
    int r = gw;
    if (r < T) {
#pragma unroll
        for (int j = 0; j < 4; ++j) { const float* y = X1 + (size_t)r * D + lane * 8 + 512 * j; x[2 * j] = *(const f32x4*)y; x[2 * j + 1] = *(const f32x4*)(y + 4); }
        if (lane < 16) { sl = INV[(size_t)r * 16 + lane]; af = AFF[(size_t)r * 16 + lane]; } }
    for (; r < T; r += NGW) {
        const int rn = r + NGW;
        if (rn < T) {
#pragma unroll
            for (int j = 0; j < 4; ++j) { const float* y = X1 + (size_t)rn * D + lane * 8 + 512 * j; xn[2 * j] = *(const f32x4*)y; xn[2 * j + 1] = *(const f32x4*)(y + 4); }
            if (lane < 16) { sln = INV[(size_t)rn * 16 + lane]; afn = AFF[(size_t)rn * 16 + lane]; } }
        const int ci = cond_of_row(r); const float* g2 = modp(p, l, ci, 5);
        f32x4 f[8];
#pragma unroll
        for (int j = 0; j < 8; ++j) f[j] = (f32x4){0.f, 0.f, 0.f, 0.f};
        for (int e = 0; e < 16; ++e) { const int slot = __shfl(sl, e); if (slot < 0) continue; const float w = __shfl(af, e);
            const bf16_t* y = YE + (size_t)(e * NSLOT + slot) * D + lane * 8;
#pragma unroll
            for (int j = 0; j < 4; ++j) { const u32x4 q = *(const u32x4*)(y + 512 * j);
                f[2 * j][0] += w * bflo(q.x); f[2 * j][1] += w * bfhi(q.x); f[2 * j][2] += w * bflo(q.y); f[2 * j][3] += w * bfhi(q.y);
                f[2 * j + 1][0] += w * bflo(q.z); f[2 * j + 1][1] += w * bfhi(q.z); f[2 * j + 1][2] += w * bflo(q.w); f[2 * j + 1][3] += w * bfhi(q.w); } }
        float s = 0.f;
#pragma unroll
        for (int j = 0; j < 8; ++j) { const int c0 = lane * 8 + 512 * (j >> 1) + 4 * (j & 1); f[j] = DN_ALPHA * x[j] + *(const f32x4*)(g2 + c0) * f[j]; s += (f[j][0] + f[j][1]) + (f[j][2] + f[j][3]); }
        const float mean = wave_sum(s) * (1.f / D); float s2 = 0.f;
#pragma unroll
        for (int j = 0; j < 8; ++j) { f[j] = f[j] - mean; s2 += (f[j][0] * f[j][0] + f[j][1] * f[j][1]) + (f[j][2] * f[j][2] + f[j][3] * f[j][3]); }
        const float rstd = rsqrtf(wave_sum(s2) * (1.f / D) + 1e-5f);
        const float* sh = modp(p, 1, ci, 0); const float* sc = modp(p, 1, ci, 1);
#pragma unroll
        for (int j = 0; j < 4; ++j) { const int c0 = lane * 8 + 512 * j; f32x4 o[2];
#pragma unroll
            for (int q = 0; q < 2; ++q) { const int cc = c0 + 4 * q; o[q] = f[2 * j + q] * rstd * *(const f32x4*)(lg + cc) + *(const f32x4*)(lb + cc);
                if (l == 0) { *(f32x4*)(XL + (size_t)r * D + cc) = o[q]; o[q] = o[q] * (1.f + *(const f32x4*)(sc + cc)) + *(const f32x4*)(sh + cc); }
                else *(f32x4*)(p.out + O_Y + (size_t)r * D + cc) = o[q]; }
            if (l == 0) { u32x4 w; w.x = pk2(o[0][0], o[0][1]); w.y = pk2(o[0][2], o[0][3]); w.z = pk2(o[1][0], o[1][1]); w.w = pk2(o[1][2], o[1][3]); *(u32x4*)(H + (size_t)r * D + c0) = w; } }
#pragma unroll
        for (int j = 0; j < 8; ++j) x[j] = xn[j];
        sl = sln; af = afn;
    }
}

struct Unit { const char* A; const char* B; unsigned lda, ldb; int nt; int pm, pn; int mode; int aux; };
DI int vcu_of(int bx, int G) { return (G % 8 == 0) ? (bx % 8) * (G / 8) + bx / 8 : bx; }

DI void rope8(const Params& p, int s, int pi0, float* v) {
    const f32x4 c = *(const f32x4*)(ws_cos(p) + s * 32 + pi0), sn = *(const f32x4*)(ws_sin(p) + s * 32 + pi0);
#pragma unroll
    for (int i = 0; i < 4; ++i) { const float x1 = v[2 * i], x2 = v[2 * i + 1]; v[2 * i] = x1 * c[i] - x2 * sn[i]; v[2 * i + 1] = x1 * sn[i] + x2 * c[i]; }
}
DI void st_bf16x8(bf16_t* dst, const float* v) { u32x4 w; w.x = pk2(v[0], v[1]); w.y = pk2(v[2], v[3]); w.z = pk2(v[4], v[5]); w.w = pk2(v[6], v[7]); *(u32x4*)dst = w; }
DI void st_f32x8(float* dst, const float* v) { *(f32x4*)dst = (f32x4){v[0], v[1], v[2], v[3]}; *(f32x4*)(dst + 4) = (f32x4){v[4], v[5], v[6], v[7]}; }

struct SchedInEven { const Params* p; int G, c;
    DI bool next(int i, Unit& u) const { const int L = i * G + c; if (L >= 48 * 8) return false; u.pm = L >> 3; u.pn = L & 7;
        u.A = (const char*)wsp<bf16_t>(*p, WS_H) + (size_t)u.pm * 256 * 4096; u.B = (const char*)wsp<bf16_t>(*p, WS_WINE) + (size_t)u.pn * 256 * 4096; u.lda = 4096; u.ldb = 4096; u.nt = 32; u.mode = 0; u.aux = 0; return true; } };
struct EpiInEven { static constexpr bool PAIR = false, F8 = false; const Params* p;
    DI void store(const Unit& u, int row, int col, float* v) const {
        const int r = u.pm * 256 + row, gc = u.pn * 256 + col;
        if (gc < 1792) { st_f32x8(wsp<float>(*p, WS_PJ) + (size_t)r * 1792 + gc, v); return; }
        if (gc >= 1856) return;
        const int j0 = gc - 1792;
        if (r < T_CTX) st_f32x8(p->out + O_KPE + (size_t)r * 64 + j0, v); else rope8(*p, (r - T_CTX) & 1023, j0 >> 1, v);
        st_bf16x8(wsp<bf16_t>(*p, WS_KPE) + (size_t)r * 64 + j0, v);
    } };

constexpr int E2_Q = 48 * 6, E2_K = 64 * 4, E2_V = 4 * 64, E2_P = 48 * 4, E2_TOTAL = E2_Q + E2_K + E2_V + E2_P;
struct SchedE2 { const Params* p; int G, c;
    DI bool next(int i, Unit& u) const { int L = i * G + c; if (L >= E2_TOTAL) return false;
        const char* ACT2 = (const char*)wsp<bf16_t>(*p, WS_ACT2); const char* W2 = (const char*)wsp<bf16_t>(*p, WS_W2); u.aux = 0;
        if (L < E2_Q) { u.mode = 0; u.pm = L / 6; u.pn = L % 6; u.A = ACT2 + (size_t)u.pm * 256 * 3584; u.lda = 3584; u.B = W2 + (size_t)u.pn * 256 * 3584; u.ldb = 3584; u.nt = 8; return true; }
        L -= E2_Q;
        if (L < E2_K) { u.mode = 1; u.pm = L >> 2; u.pn = L & 3; u.A = ACT2 + (size_t)u.pm * 256 * 3584 + 512 * 2; u.lda = 3584; u.B = W2 + (size_t)(1536 + u.pn * 256) * 3584; u.ldb = 3584; u.nt = 4; return true; }
        L -= E2_K;
        if (L < E2_V) { u.mode = 2; u.pm = L >> 6; u.pn = L & 63; u.A = W2 + (size_t)(2560 + u.pm * 256) * 3584; u.lda = 3584; u.B = ACT2 + (size_t)u.pn * 256 * 3584 + 512 * 2; u.ldb = 3584; u.nt = 4; return true; }
        L -= E2_V;
        u.mode = 3; u.pm = L >> 2; u.aux = L & 3; u.pn = 0; u.A = ACT2 + (size_t)u.pm * 256 * 3584 + (768 + u.aux * 256) * 2; u.lda = 3584; u.B = W2 + (size_t)(3584 + u.aux * 256) * 3584; u.ldb = 3584; u.nt = 4; return true; } };
struct EpiE2 { static constexpr bool PAIR = false, F8 = false; const Params* p;
    DI void store(const Unit& u, int row, int col, float* v) const {
        const int r = u.pm * 256 + row, gc = u.pn * 256 + col;
        if (u.mode == 0) { const int dd = gc % 192; if (dd >= 128 && r >= T_CTX) rope8(*p, (r - T_CTX) & 1023, (dd - 128) >> 1, v);
#pragma unroll
            for (int i = 0; i < 8; ++i) v[i] *= QS_MLA;
            st_bf16x8(wsp<bf16_t>(*p, WS_Q) + (size_t)r * 1536 + gc, v); }
        else if (u.mode == 1) st_bf16x8(wsp<bf16_t>(*p, WS_KN) + (size_t)r * 1024 + gc, v);
        else if (u.mode == 2) st_bf16x8(wsp<bf16_t>(*p, WS_VT) + (size_t)r * TX + gc, v);
        else { const float* ps = p->in[16] + u.aux * 256 + col;
#pragma unroll
            for (int i = 0; i < 8; ++i) v[i] *= ps[i];
            st_bf16x8(wsp<bf16_t>(*p, WS_MIX) + (size_t)r * 2048 + 1024 + u.aux * 256 + col, v); }
    } };

struct SchedOut { const Params* p; int G, c, l;
    DI bool next(int i, Unit& u) const { const int L = i * G + c; if (L >= 48 * 8) return false; u.pm = L >> 3; u.pn = L & 7;
        u.A = (const char*)wsp<bf16_t>(*p, WS_MIX) + (size_t)u.pm * 256 * 4096; u.B = (const char*)wsp<bf16_t>(*p, l == 0 ? WS_WOUTE : WS_WOUTO) + (size_t)u.pn * 256 * 4096; u.lda = 4096; u.ldb = 4096; u.nt = 32; u.mode = 0; u.aux = 0; return true; } };
struct EpiOut { static constexpr bool PAIR = false, F8 = false; const Params* p; int l;
    DI void store(const Unit& u, int row, int col, float* v) const {
        const int r = u.pm * 256 + row, gc = u.pn * 256 + col;
        const float* x = (l == 0 ? xrow_in(*p, r) : wsp<float>(*p, WS_XL) + (size_t)r * D) + gc; const float* g1 = modp(*p, l, cond_of_row(r), 2) + gc;
        const f32x4 x0 = *(const f32x4*)x, x1 = *(const f32x4*)(x + 4), g0 = *(const f32x4*)g1, g4 = *(const f32x4*)(g1 + 4);
#pragma unroll
        for (int i = 0; i < 4; ++i) { v[i] = DN_ALPHA * x0[i] + g0[i] * v[i]; v[4 + i] = DN_ALPHA * x1[i] + g4[i] * v[4 + i]; }
        st_f32x8(wsp<float>(*p, WS_Y) + (size_t)r * D + gc, v);
    } };

struct SchedGU { const Params* p; int G, c, l;
    DI bool next(int i, Unit& u) const { const int L = i * G + c; if (L >= 16 * 96) return false; const int e = L / 96, rem = L % 96; u.pn = rem / 6; u.pm = e * 6 + rem % 6; u.aux = e;
        constexpr unsigned P = MOE_F8 ? 2048 : 4096;
        u.A = (const char*)wsp<bf16_t>(*p, WS_XS) + (size_t)u.pm * 256 * P; u.B = (const char*)wsp<bf16_t>(*p, WS_WGU) + ((size_t)(l * 16 + e) * 4096 + (size_t)u.pn * 256) * P; u.lda = P; u.ldb = P; u.nt = MOE_F8 ? 16 : 32; u.mode = 0; return true; } };
struct EpiGU { static constexpr bool PAIR = true, F8 = MOE_F8 != 0; const Params* p;
    DI void store2(const Unit& u, int row, int col, const float* g, const float* up) const {
        float h[8];
#pragma unroll
        for (int i = 0; i < 8; ++i) { const float gg = MOE_F8 ? g[i] * (1.f / GU_WSCALE) : g[i], uu = MOE_F8 ? up[i] * (1.f / GU_WSCALE) : up[i]; h[i] = gg / (1.f + __expf(-gg)) * uu; }
        if (MOE_F8) { u32x2 o; o.x = pk4_fp8(h[0], h[1], h[2], h[3]); o.y = pk4_fp8(h[4], h[5], h[6], h[7]); *(u32x2*)((unsigned char*)wsp<bf16_t>(*p, WS_HID) + (size_t)(u.pm * 256 + row) * D + u.pn * 128 + col) = o; }
        else st_bf16x8(wsp<bf16_t>(*p, WS_HID) + (size_t)(u.pm * 256 + row) * D + u.pn * 128 + col, h);
    } };

struct SchedDown { const Params* p; int G, c, l;
    DI bool next(int i, Unit& u) const { const int L = i * G + c; if (L >= 16 * 48) return false; const int e = L / 48, rem = L % 48; u.pn = rem / 6; u.pm = e * 6 + rem % 6; u.aux = e;
        constexpr unsigned P = MOE_F8 ? 2048 : 4096;
        u.A = (const char*)wsp<bf16_t>(*p, WS_HID) + (size_t)u.pm * 256 * P; u.B = (const char*)wsp<bf16_t>(*p, WS_WDN) + ((size_t)(l * 16 + e) * 2048 + (size_t)u.pn * 256) * P; u.lda = P; u.ldb = P; u.nt = MOE_F8 ? 16 : 32; u.mode = 0; return true; } };
struct EpiDown { static constexpr bool PAIR = false, F8 = MOE_F8 != 0; const Params* p;
    DI void store(const Unit& u, int row, int col, float* v) const {
        if (MOE_F8) {
#pragma unroll
            for (int i = 0; i < 8; ++i) v[i] *= (1.f / DN_WSCALE); }
        st_bf16x8(wsp<bf16_t>(*p, WS_YE) + (size_t)(u.pm * 256 + row) * D + u.pn * 256 + col, v); } };

constexpr int IO_QK = 48 * 9, IO_V = 16, IO_VT = 48, IO_TOTAL = IO_QK + IO_V + IO_VT;
struct SchedInOdd { const Params* p; int G, c;
    DI bool next(int i, Unit& u) const { int L = i * G + c; if (L >= IO_TOTAL) return false;
        const char* Hb = (const char*)wsp<bf16_t>(*p, WS_H); const char* W = (const char*)wsp<bf16_t>(*p, WS_WINO); u.aux = 0; u.nt = 32; u.lda = 4096; u.ldb = 4096;
        if (L < IO_QK) { u.mode = 0; u.pm = L / 9; u.pn = L % 9; u.A = Hb + (size_t)u.pm * 256 * 4096; u.B = W + (size_t)u.pn * 256 * 4096; return true; }
        L -= IO_QK;
        if (L < IO_V) { u.mode = 1; u.pm = L; u.pn = 9; u.A = Hb + (size_t)u.pm * 256 * 4096; u.B = W + (size_t)9 * 256 * 4096; return true; }
        L -= IO_V;
        u.mode = 2; u.pm = 0; u.pn = L; u.A = W + (size_t)9 * 256 * 4096; u.B = Hb + (size_t)u.pn * 256 * 4096; return true; } };
struct EpiInOdd { static constexpr bool PAIR = false, F8 = false; const Params* p;
    DI void store(const Unit& u, int row, int col, float* v) const {
        const int r = u.pm * 256 + row, gc = u.pn * 256 + col;
        if (u.mode == 0) {
            if (gc < 2048) { if (r >= T_CTX) rope8(*p, (r - T_CTX) & 1023, (gc & 63) >> 1, v);
#pragma unroll
                for (int i = 0; i < 8; ++i) v[i] *= QS_SWA;
                st_bf16x8(wsp<bf16_t>(*p, WS_Q) + (size_t)r * 2048 + gc, v); }
            else { const int kc = gc - 2048; if (r < T_CTX) st_f32x8(p->out + O_SK + (size_t)r * 256 + kc, v); else rope8(*p, (r - T_CTX) & 1023, (kc & 63) >> 1, v);
                st_bf16x8(wsp<bf16_t>(*p, WS_KO) + (size_t)r * 256 + kc, v); } }
        else if (u.mode == 1) st_f32x8(p->out + O_SV + (size_t)r * 256 + col, v);
        else st_bf16x8(wsp<bf16_t>(*p, WS_VTO) + (size_t)row * TX + gc, v);
    } };

namespace pg8 {
typedef short bf16x8 __attribute__((ext_vector_type(8)));
typedef int i32x4 __attribute__((ext_vector_type(4)));
typedef int i32x8 __attribute__((ext_vector_type(8)));
DI i32x8 cat8(bf16x8 lo, bf16x8 hi) { return __builtin_shufflevector(__builtin_bit_cast(i32x4, lo), __builtin_bit_cast(i32x4, hi), 0, 1, 2, 3, 4, 5, 6, 7); }
constexpr int BM = 256, BK = 64, HALF = 128, HTB = HALF * BK * 2  , STAGE_BYTES = 8 * HTB;
DI int lds_byte(int r, int c) { const int st = (r >> 4) * 2 + (c >> 5), rr = r & 15, cc = c & 31, ob = rr * 64 + cc * 2; return st * 1024 + (ob ^ (((ob >> 9) & 1) << 5)); }
DI void stage_rc(int b, int& R, int& C) { const int st = b / 1024, sb = b % 1024, swz = sb ^ (((sb >> 9) & 1) << 5); R = (st >> 1) * 16 + swz / 64; C = (st & 1) * 32 + (swz % 64) / 2; }
DI int perm32(int rho) { const int n = rho >> 4, i = rho & 15; return 8 * (i >> 2) + 4 * n + (i & 3); }

template <bool F8> struct Frag;
template <> struct Frag<false> { bf16x8 k0, k1; DI void set(bf16x8 a, bf16x8 b) { k0 = a; k1 = b; } };
template <> struct Frag<true> { i32x8 w; DI void set(bf16x8 a, bf16x8 b) { w = cat8(a, b); } };
template <class Epi, class Sched, bool ALIGN_EPI = true>
DI void gemm_phase(LAS unsigned char* lds, const Sched& S, const Epi& E, int wid) {
    const int lane = fresh_lane(), tid = wid * 64 + lane, wr = wid >> 2, wc = wid & 3, fr = lane & 15, fq = lane >> 4;
    int RA[2], RB[2], CB[2];
#pragma unroll
    for (int i = 0; i < 2; ++i) { int R, C; stage_rc(tid * 16 + i * 8192, R, C); RA[i] = R; RB[i] = (R & ~31) + perm32(R & 31); CB[i] = C * 2; }
    constexpr size_t kstep = (size_t)(BK * 2);
    const unsigned ldsw = (unsigned)wid * 1024u;
    const int aoff = lds_byte(wr * 64 + fr, fq * 8), boff = lds_byte(wc * 32 + fr, fq * 8);
#define PG8_SA(b, h) (((b) * 2 + (h)) * HTB)
#define PG8_SB(b, h) ((4 + (b) * 2 + (h)) * HTB)
#define PG8_STAGE(bufoff, gbase, v0, v1) do { unsigned o0_ = (v0), o1_ = (v1); asm volatile("" : "+v"(o0_), "+v"(o1_)); \
        __builtin_amdgcn_global_load_lds((const unsigned*)((const char*)(gbase) + o0_), (LAS unsigned*)(lds + (bufoff) + ldsw), 16, 0, 0); \
        __builtin_amdgcn_global_load_lds((const unsigned*)((const char*)(gbase) + o1_), (LAS unsigned*)(lds + (bufoff) + ldsw + 8192), 16, 0, 0); } while (0)
#define PG8_LDA(dst, b, h) do { _Pragma("unroll") for (int m = 0; m < 4; ++m) { const bf16x8 f0_ = *(const LAS bf16x8*)(lds + PG8_SA(b, h) + aoff + m * 2048), f1_ = *(const LAS bf16x8*)(lds + PG8_SA(b, h) + aoff + m * 2048 + 1024); dst[m].set(f0_, f1_); } } while (0)
#define PG8_LDB(dst, b, h) do { _Pragma("unroll") for (int n = 0; n < 2; ++n) { const bf16x8 f0_ = *(const LAS bf16x8*)(lds + PG8_SB(b, h) + boff + n * 2048), f1_ = *(const LAS bf16x8*)(lds + PG8_SB(b, h) + boff + n * 2048 + 1024); dst[n].set(f0_, f1_); } } while (0)
#define PG8_MMA(ai, bj, At, Bt) do { __builtin_amdgcn_s_setprio(1); _Pragma("unroll") for (int m = 0; m < 4; ++m) _Pragma("unroll") for (int n = 0; n < 2; ++n) { \
        if constexpr (Epi::F8) acc[ai][bj][m][n] = __builtin_amdgcn_mfma_scale_f32_16x16x128_f8f6f4(Bt[n].w, At[m].w, acc[ai][bj][m][n], 0, 0, 0, 0x7f7f7f7f, 0, 0x7f7f7f7f); \
        else { acc[ai][bj][m][n] = __builtin_amdgcn_mfma_f32_16x16x32_bf16(Bt[n].k0, At[m].k0, acc[ai][bj][m][n], 0, 0, 0); acc[ai][bj][m][n] = __builtin_amdgcn_mfma_f32_16x16x32_bf16(Bt[n].k1, At[m].k1, acc[ai][bj][m][n], 0, 0, 0); } } \
        __builtin_amdgcn_s_setprio(0); } while (0)
#define PG8_WAIT_V(n) asm volatile("s_waitcnt vmcnt(" #n ")" ::: "memory")
#define PG8_WAIT_L(n) asm volatile("s_waitcnt lgkmcnt(" #n ")" ::: "memory")
#define PG8_BAR __builtin_amdgcn_s_barrier()
#define PG8_SCHED __builtin_amdgcn_sched_barrier(0)
    Unit cur, nxt; int ui = 0;
    if (!S.next(0, cur)) return;
    f32x4 acc[2][2][4][2];
#pragma unroll
    for (int a = 0; a < 2; ++a)
#pragma unroll
        for (int b = 0; b < 2; ++b)
#pragma unroll
            for (int m = 0; m < 4; ++m)
#pragma unroll
                for (int n = 0; n < 2; ++n) acc[a][b][m][n] = (f32x4){0.f, 0.f, 0.f, 0.f};
    Frag<Epi::F8> At[4], B0[2], B1[2];
    const char* cA = cur.A; const char* cB = cur.B;
    const unsigned ld = cur.lda;
    const unsigned vA0 = RA[0] * ld + CB[0], vA1 = RA[1] * ld + CB[1], vB0 = RB[0] * ld + CB[0], vB1 = RB[1] * ld + CB[1];
    const size_t hA = (size_t)HALF * ld, hB = hA;
    PG8_STAGE(PG8_SB(0, 0), cB, vB0, vB1); PG8_STAGE(PG8_SB(0, 1), cB + hB, vB0, vB1); PG8_STAGE(PG8_SA(0, 0), cA, vA0, vA1); PG8_STAGE(PG8_SA(0, 1), cA + hA, vA0, vA1);
    if (wr == 1) PG8_BAR;
    PG8_WAIT_V(2); PG8_BAR;
    PG8_STAGE(PG8_SB(1, 0), cB + kstep, vB0, vB1); PG8_STAGE(PG8_SA(1, 0), cA + kstep, vA0, vA1); PG8_STAGE(PG8_SB(1, 1), cB + hB + kstep, vB0, vB1);
    PG8_WAIT_V(6); PG8_BAR;
    for (;;) {
        const bool has_next = S.next(ui + 1, nxt);
        const char* nA = has_next ? nxt.A : cA; const char* nB = has_next ? nxt.B : cB;
        const int nt = cur.nt;
        for (int t = 0; t < nt; t += 2) {
            const bool last = (t == nt - 2);
            const char* a1 = cA + (size_t)(t + 1) * kstep;
            const char* a2 = last ? nA : cA + (size_t)(t + 2) * kstep; const char* b2 = last ? nB : cB + (size_t)(t + 2) * kstep;
            const char* a3 = a2 + kstep; const char* b3 = b2 + kstep;
            PG8_LDB(B0, 0, 0); PG8_LDB(B1, 0, 1); PG8_SCHED; PG8_LDA(At, 0, 0); PG8_STAGE(PG8_SA(1, 1), a1 + hA, vA0, vA1);
            PG8_WAIT_V(8); PG8_WAIT_L(0); PG8_BAR; PG8_MMA(0, 0, At, B0); PG8_MMA(0, 1, At, B1); PG8_BAR; PG8_SCHED;
            PG8_LDA(At, 0, 1); PG8_STAGE(PG8_SB(0, 0), b2, vB0, vB1); PG8_STAGE(PG8_SB(0, 1), b2 + hB, vB0, vB1); PG8_STAGE(PG8_SA(0, 0), a2, vA0, vA1);
            PG8_WAIT_V(8); PG8_WAIT_L(0); PG8_BAR; PG8_MMA(1, 0, At, B0); PG8_MMA(1, 1, At, B1); PG8_BAR; PG8_SCHED;
            PG8_LDB(B0, 1, 0); PG8_LDB(B1, 1, 1); PG8_SCHED; PG8_LDA(At, 1, 0); PG8_STAGE(PG8_SA(0, 1), a2 + hA, vA0, vA1);
            PG8_WAIT_V(8); PG8_WAIT_L(0); PG8_BAR; PG8_MMA(0, 0, At, B0); PG8_MMA(0, 1, At, B1); PG8_BAR; PG8_SCHED;
            PG8_LDA(At, 1, 1); PG8_STAGE(PG8_SB(1, 0), b3, vB0, vB1); PG8_STAGE(PG8_SB(1, 1), b3 + hB, vB0, vB1); PG8_STAGE(PG8_SA(1, 0), a3, vA0, vA1);
            PG8_WAIT_V(8); PG8_WAIT_L(0); PG8_BAR; PG8_MMA(1, 0, At, B0); PG8_MMA(1, 1, At, B1); PG8_BAR; PG8_SCHED;
        }
        if constexpr (ALIGN_EPI) { if (wr == 0) PG8_BAR; }
        {
            const int el_ = fresh_lane(); const int fr_ = el_ & 15, fq_ = el_ >> 4;
#pragma unroll
            for (int ai = 0; ai < 2; ++ai)
#pragma unroll
                for (int m = 0; m < 4; ++m) { const int row = ai * HALF + wr * 64 + m * 16 + fr_;
                    if constexpr (Epi::PAIR) { float g[8], up[8];
#pragma unroll
                        for (int j = 0; j < 4; ++j) { g[j] = acc[ai][0][m][0][j]; g[4 + j] = acc[ai][0][m][1][j]; up[j] = acc[ai][1][m][0][j]; up[4 + j] = acc[ai][1][m][1][j]; }
                        E.store2(cur, row, wc * 32 + 8 * fq_, g, up); }
                    else {
#pragma unroll
                        for (int bj = 0; bj < 2; ++bj) { float v[8];
#pragma unroll
                            for (int j = 0; j < 4; ++j) { v[j] = acc[ai][bj][m][0][j]; v[4 + j] = acc[ai][bj][m][1][j]; }
                            E.store(cur, row, bj * HALF + wc * 32 + 8 * fq_, v); } } }
        }
        if (!has_next) break;
#pragma unroll
        for (int a = 0; a < 2; ++a)
#pragma unroll
            for (int b = 0; b < 2; ++b)
#pragma unroll
                for (int m = 0; m < 4; ++m)
#pragma unroll
                    for (int n = 0; n < 2; ++n) acc[a][b][m][n] = (f32x4){0.f, 0.f, 0.f, 0.f};
        cur = nxt; cA = nA; cB = nB; ++ui;
        if constexpr (ALIGN_EPI) { if (wr == 1) PG8_BAR; }
    }
    PG8_WAIT_V(0);
    if constexpr (!ALIGN_EPI) { if (wr == 0) PG8_BAR; }
    PG8_BAR;
#undef PG8_SA
#undef PG8_SB
#undef PG8_STAGE
#undef PG8_LDA
#undef PG8_LDB
#undef PG8_MMA
#undef PG8_WAIT_V
#undef PG8_WAIT_L
#undef PG8_BAR
#undef PG8_SCHED
}
}

namespace att {
typedef short bf16x8 __attribute__((ext_vector_type(8)));
typedef short s16x4 __attribute__((ext_vector_type(4)));
typedef float f32x16 __attribute__((ext_vector_type(16)));
typedef float f32x2_t __attribute__((ext_vector_type(2)));
typedef __bf16 bf16x2_t __attribute__((ext_vector_type(2)));
DI unsigned cvtpk(float lo, float hi) { f32x2_t v = {lo, hi}; bf16x2_t b = __builtin_convertvector(v, bf16x2_t); return __builtin_bit_cast(unsigned, b); }
DI int crow(int r, int h) { return (r & 3) + 8 * (r >> 2) + 4 * h; }

template <bool SWA>
DI void attn_phase(const Params& p, LAS unsigned char* lds, int G, int c) {
    constexpr int DK = SWA ? 64 : 192, DV = SWA ? 64 : 128, KSTR = DK * 2 + 16, VSTR = 136;
    constexpr int KB = 64 * KSTR, VB = DV * VSTR, STG = KB + VB;
    constexpr int CPR = DK / 8, NKC = (64 * CPR) / NTHREADS, NVC = (DV * 8) / NTHREADS, NQ = DK / 16, NDV = DV / 32;
    constexpr int LDQ = SWA ? 2048 : 1536, NUNITS = SWA ? 1536 : 384;
    static_assert(2 * STG <= 131072, "attention LDS");
    const int tid = threadIdx.x, lane = tid & 63, wid = __builtin_amdgcn_readfirstlane(tid >> 6), q = lane & 31, hh = lane >> 5;
    const bf16_t* Q = wsp<bf16_t>(p, WS_Q); const bf16_t* KN = wsp<bf16_t>(p, SWA ? WS_KO : WS_KN); const bf16_t* KPE = wsp<bf16_t>(p, WS_KPE);
    const bf16_t* VT = wsp<bf16_t>(p, SWA ? WS_VTO : WS_VT); bf16_t* MIX = wsp<bf16_t>(p, WS_MIX);
    for (int L = c; L < NUNITS; L += G) {
        int rowbase, hk, nt0, nt1, key0a, key0b = 0, kpos0 = 0, qpos0 = 0; bool masked = false;
        if (!SWA) {
            if (L < 256) { const int b = L >> 5, qt = L & 3; hk = (L >> 2) & 7; rowbase = T_CTX + b * 1024 + qt * 256; key0a = T_CTX + b * 1024; nt0 = 16; key0b = T + b * 512; nt1 = 8; }
            else { const int Lc = L - 256, b = Lc >> 3; hk = Lc & 7; rowbase = b * 256; key0a = b * 256; nt0 = 4; nt1 = 0; }
        } else {
            if (L < 1024) { const int b = L >> 7, t0 = (L & 31) * 32; hk = (L >> 5) & 3; rowbase = T_CTX + b * 1024 + t0;
                const int lo = max(t0 - 128, 0) & ~63, hi = min((t0 + 160 + 63) & ~63, 1024);
                key0a = T_CTX + b * 1024 + lo; nt0 = (hi - lo) >> 6; kpos0 = lo; qpos0 = t0; masked = true; key0b = T + b * 512; nt1 = 8; }
            else { const int Lc = L - 1024, b = Lc >> 5; hk = (Lc >> 3) & 3; rowbase = b * 256 + (Lc & 7) * 32; key0a = b * 256; nt0 = 4; nt1 = 0; }
        }
        const int total = nt0 + nt1;
        const int qrow = SWA ? rowbase + q : rowbase + wid * 32 + q;
        const int qhead = SWA ? hk * 8 + wid : hk;
        bf16x8 qf[NQ];
#pragma unroll
        for (int s = 0; s < NQ; ++s) qf[s] = *(const bf16x8*)(Q + (size_t)qrow * LDQ + qhead * DK + 16 * s + 8 * hh);
        f32x16 o[NDV];
#pragma unroll
        for (int d = 0; d < NDV; ++d)
#pragma unroll
            for (int r = 0; r < 16; ++r) o[d][r] = 0.f;
        float m = SWA ? p.in[19][qhead] * LOG2E : -1e30f, l = (SWA && hh == 0) ? 1.f : 0.f;
        const int qpos = qpos0 + q;
        u32x4 kreg[NKC], vreg[NVC];
#define ATT_LOAD(t_) do { const int tt_ = (t_); const int kb_ = tt_ < nt0 ? key0a + tt_ * 64 : key0b + (tt_ - nt0) * 64; \
            _Pragma("unroll") for (int i = 0; i < NKC; ++i) { const int ch = tid + NTHREADS * i, j = ch / CPR, cc = ch % CPR; \
                const bf16_t* src = SWA ? KN + (size_t)(kb_ + j) * 256 + hk * 64 + cc * 8 : (cc < 16 ? KN + (size_t)(kb_ + j) * 1024 + hk * 128 + cc * 8 : KPE + (size_t)(kb_ + j) * 64 + (cc - 16) * 8); \
                kreg[i] = *(const u32x4*)src; } \
            _Pragma("unroll") for (int i = 0; i < NVC; ++i) { const int ch = tid + NTHREADS * i, dv = ch >> 3, cc = ch & 7; \
                vreg[i] = *(const u32x4*)(VT + (size_t)(hk * DV + dv) * TX + kb_ + cc * 8); } } while (0)
#define ATT_WRITE(buf_) do { LAS unsigned char* Kw = lds + (buf_) * STG; LAS unsigned char* Vw = Kw + KB; \
            _Pragma("unroll") for (int i = 0; i < NKC; ++i) { const int ch = tid + NTHREADS * i, j = ch / CPR, cc = ch % CPR; *(LAS u32x4*)(Kw + j * KSTR + cc * 16) = kreg[i]; } \
            _Pragma("unroll") for (int i = 0; i < NVC; ++i) { const int ch = tid + NTHREADS * i, dv = ch >> 3, cc = ch & 7; \
                *(LAS u32x2*)(Vw + dv * VSTR + cc * 16) = (u32x2){vreg[i].x, vreg[i].y}; *(LAS u32x2*)(Vw + dv * VSTR + cc * 16 + 8) = (u32x2){vreg[i].z, vreg[i].w}; } } while (0)
        ATT_LOAD(0); ATT_WRITE(0);
        __syncthreads();
        for (int t = 0; t < total; ++t) {
            const int buf = t & 1;
            if (t + 1 < total) ATT_LOAD(t + 1);
            const LAS unsigned char* Kl = lds + buf * STG; const LAS unsigned char* Vl = Kl + KB;
            f32x16 s0, s1;
#pragma unroll
            for (int r = 0; r < 16; ++r) { s0[r] = 0.f; s1[r] = 0.f; }
#pragma unroll
            for (int s = 0; s < NQ; ++s) {
                const bf16x8 a0 = *(const LAS bf16x8*)(Kl + q * KSTR + (16 * s + 8 * hh) * 2);
                const bf16x8 a1 = *(const LAS bf16x8*)(Kl + (32 + q) * KSTR + (16 * s + 8 * hh) * 2);
                s0 = __builtin_amdgcn_mfma_f32_32x32x16_bf16(a0, qf[s], s0, 0, 0, 0);
                s1 = __builtin_amdgcn_mfma_f32_32x32x16_bf16(a1, qf[s], s1, 0, 0, 0);
            }
            if (SWA && masked && t < nt0) {
                const int kp = kpos0 + t * 64 - qpos;
#pragma unroll
                for (int r = 0; r < 16; ++r) { const int d0 = kp + crow(r, hh), d1 = d0 + 32;
                    s0[r] = (d0 >= -128 && d0 <= 128) ? s0[r] : -1e30f; s1[r] = (d1 >= -128 && d1 <= 128) ? s1[r] : -1e30f; }
            }
            float tm = fmaxf(s0[0], s1[0]);
#pragma unroll
            for (int r = 1; r < 16; ++r) tm = fmaxf(tm, fmaxf(s0[r], s1[r]));
            tm = fmaxf(tm, __shfl_xor(tm, 32));
            const float mn = fmaxf(m, tm), alpha = __builtin_amdgcn_exp2f(m - mn); m = mn;
            l *= alpha;
#pragma unroll
            for (int d = 0; d < NDV; ++d)
#pragma unroll
                for (int r = 0; r < 16; ++r) o[d][r] *= alpha;
            float ls = 0.f;
#pragma unroll
            for (int r = 0; r < 16; ++r) { s0[r] = __builtin_amdgcn_exp2f(s0[r] - m); s1[r] = __builtin_amdgcn_exp2f(s1[r] - m); ls += s0[r] + s1[r]; }
            l += ls;
            bf16x8 pb[2][2];
#pragma unroll
            for (int s = 0; s < 2; ++s) {
                u32x4 w0, w1;
                w0.x = cvtpk(s0[8 * s + 0], s0[8 * s + 1]); w0.y = cvtpk(s0[8 * s + 2], s0[8 * s + 3]); w0.z = cvtpk(s0[8 * s + 4], s0[8 * s + 5]); w0.w = cvtpk(s0[8 * s + 6], s0[8 * s + 7]);
                w1.x = cvtpk(s1[8 * s + 0], s1[8 * s + 1]); w1.y = cvtpk(s1[8 * s + 2], s1[8 * s + 3]); w1.z = cvtpk(s1[8 * s + 4], s1[8 * s + 5]); w1.w = cvtpk(s1[8 * s + 6], s1[8 * s + 7]);
                pb[0][s] = __builtin_bit_cast(bf16x8, w0); pb[1][s] = __builtin_bit_cast(bf16x8, w1);
            }
#pragma unroll
            for (int d = 0; d < NDV; ++d)
#pragma unroll
                for (int blk = 0; blk < 2; ++blk)
#pragma unroll
                    for (int s = 0; s < 2; ++s) {
                        const LAS unsigned char* vp = Vl + (d * 32 + q) * VSTR + (blk * 32 + 16 * s + 4 * hh) * 2;
                        const s16x4 lo = *(const LAS s16x4*)vp, hi = *(const LAS s16x4*)(vp + 16);
                        const bf16x8 a = {lo[0], lo[1], lo[2], lo[3], hi[0], hi[1], hi[2], hi[3]};
                        o[d] = __builtin_amdgcn_mfma_f32_32x32x16_bf16(a, pb[blk][s], o[d], 0, 0, 0);
                    }
            if (t + 1 < total) ATT_WRITE(buf ^ 1);
            __syncthreads();
        }
#undef ATT_LOAD
#undef ATT_WRITE
        const float inv = 1.f / (l + __shfl_xor(l, 32));
        bf16_t* orow = MIX + (size_t)qrow * 2048 + qhead * DV;
#pragma unroll
        for (int d = 0; d < NDV; ++d)
#pragma unroll
            for (int g = 0; g < 4; ++g) { u32x2 w; w.x = cvtpk(o[d][4 * g] * inv, o[d][4 * g + 1] * inv); w.y = cvtpk(o[d][4 * g + 2] * inv, o[d][4 * g + 3] * inv);
                *(u32x2*)(orow + d * 32 + 8 * g + 4 * hh) = w; }
    }
}
}


#ifndef R_PRO
#define R_PRO 1
#endif
#ifndef R_MOE
#define R_MOE 1
#endif
#ifndef R_ATT
#define R_ATT 1
#endif
#ifndef R_GEMM
#define R_GEMM 1
#endif
#ifndef R_THIN
#define R_THIN 1
#endif
#ifndef R_LN1
#define R_LN1 1
#endif
#ifndef R_LN2
#define R_LN2 1
#endif
#ifndef R_TOPK
#define R_TOPK 1
#endif
#define REP(n) for (int _r = 0; _r < (n); ++_r)
#define REPS(n, ...) do { { __VA_ARGS__ } if ((n) > 1) { __VA_ARGS__ } } while (0)
constexpr int LDS_BYTES = 147456, MISC_OFF = 146432;
constexpr int NPH = 20;
__global__ void __launch_bounds__(NTHREADS, 2) mega(Params p) {
    extern __shared__ __attribute__((aligned(16))) unsigned char lds[];
    const int G = gridDim.x, c = vcu_of(blockIdx.x, G), wid = __builtin_amdgcn_readfirstlane(threadIdx.x >> 6);
    volatile LAS unsigned* MISC = (volatile LAS unsigned*)((LAS unsigned char*)lds + MISC_OFF);
    if (threadIdx.x < 4) MISC[threadIdx.x] = 0u;
    __syncthreads();
    XcdBarrier bar = xcd_barrier_post((unsigned*)(p.ws + WS_CTL) + CW_BAR, MISC);
    const int lo = p.ph_lo, hi = p.ph_hi;
#define IN(k) (lo <= (k) && (k) < hi)
#define SEAM(k) do { if (IN(k) && IN((k) + 1)) xcd_barrier(bar); } while (0)
    if (IN(0)) REP(R_PRO) { ph_mod(p, lds); ph_misc(p); ph_convert(p, 0, CV_TOTAL); } SEAM(0);
    if (IN(1)) REP(R_THIN) { ph_h0(p); } SEAM(1);
    if (IN(2)) REPS(R_GEMM, SchedInEven S{&p, G, c}; EpiInEven E{&p}; pg8::gemm_phase((LAS unsigned char*)lds, S, E, wid);); SEAM(2);
    if (IN(3)) REP(R_THIN) { ph_e1(p); } SEAM(3);
    if (IN(4)) REPS(R_GEMM, SchedE2 S{&p, G, c}; EpiE2 E{&p}; pg8::gemm_phase((LAS unsigned char*)lds, S, E, wid);); SEAM(4);
    if (IN(5)) REP(R_ATT) { att::attn_phase<false>(p, (LAS unsigned char*)lds, G, c); } SEAM(5);
    if (IN(6)) REPS(R_GEMM, SchedOut S{&p, G, c, 0}; EpiOut E{&p, 0}; pg8::gemm_phase((LAS unsigned char*)lds, S, E, wid);); SEAM(6);
    if (IN(7)) REP(R_LN1) { ph_ln1(p, 0, lds); } SEAM(7);
    if (IN(8)) REP(R_TOPK) { ph_topk(p, lds); } SEAM(8);
    if (IN(9)) REPS(R_MOE, SchedGU S{&p, G, c, 0}; EpiGU E{&p}; pg8::gemm_phase((LAS unsigned char*)lds, S, E, wid);); SEAM(9);
    if (IN(10)) REPS(R_MOE, SchedDown S{&p, G, c, 0}; EpiDown E{&p}; pg8::gemm_phase((LAS unsigned char*)lds, S, E, wid);); SEAM(10);
    if (IN(11)) REP(R_LN2) { ph_ln2(p, 0); } SEAM(11);
    if (IN(12)) REPS(R_GEMM, SchedInOdd S{&p, G, c}; EpiInOdd E{&p}; pg8::gemm_phase((LAS unsigned char*)lds, S, E, wid);); SEAM(12);
    if (IN(13)) REP(R_ATT) { att::attn_phase<true>(p, (LAS unsigned char*)lds, G, c); } SEAM(13);
    if (IN(14)) REPS(R_GEMM, SchedOut S{&p, G, c, 1}; EpiOut E{&p, 1}; pg8::gemm_phase((LAS unsigned char*)lds, S, E, wid);); SEAM(14);
    if (IN(15)) REP(R_LN1) { ph_ln1(p, 1, lds); } SEAM(15);
    if (IN(16)) REP(R_TOPK) { ph_topk(p, lds); } SEAM(16);
    if (IN(17)) REPS(R_MOE, SchedGU S{&p, G, c, 1}; EpiGU E{&p}; pg8::gemm_phase((LAS unsigned char*)lds, S, E, wid);); SEAM(17);
    if (IN(18)) REPS(R_MOE, SchedDown S{&p, G, c, 1}; EpiDown E{&p}; pg8::gemm_phase((LAS unsigned char*)lds, S, E, wid);); SEAM(18);
    if (IN(19)) REP(R_LN2) { ph_ln2(p, 1); }
#undef IN
#undef SEAM
}

extern "C" void kernel_launch(void* const* d_in, const int* in_sizes, int n_in, void* d_out, int out_size, void* d_ws, size_t ws_size, hipStream_t stream) {
    static int grid = 0;
    if (grid == 0) {
        if (n_in != 29 || out_size != (int)O_END || ws_size < WS_END) { fprintf(stderr, "kernel_launch: unexpected shapes (n_in %d out %d ws %zu need %zu)\n", n_in, out_size, ws_size, (size_t)WS_END); grid = -1; return; }
        int dev = 0, cus = 0, per_cu = 0;
        if (hipGetDevice(&dev) != hipSuccess || hipDeviceGetAttribute(&cus, hipDeviceAttributeMultiprocessorCount, dev) != hipSuccess) { grid = -1; return; }
        if (hipFuncSetAttribute((const void*)mega, hipFuncAttributeMaxDynamicSharedMemorySize, LDS_BYTES) != hipSuccess) { fprintf(stderr, "hipFuncSetAttribute failed\n"); grid = -1; return; }
        if (hipOccupancyMaxActiveBlocksPerMultiprocessor(&per_cu, (const void*)mega, NTHREADS, LDS_BYTES) != hipSuccess || per_cu < 1) fprintf(stderr, "occupancy query: %d\n", per_cu);
        (void)hipGetLastError();
        grid = cus > 0 ? cus : 256;
    }
    if (grid < 0) return;
    Params p{};
    for (int i = 0; i < 29; ++i) p.in[i] = (const float*)d_in[i];
    p.out = (float*)d_out; p.ws = (unsigned char*)d_ws; p.ph_lo = 0; p.ph_hi = NPH;
    (void)hipMemsetAsync((char*)d_ws + WS_CTL, 0, CTL_BYTES, stream);
    hipLaunchKernelGGL(mega, dim3(grid), dim3(NTHREADS), LDS_BYTES, stream, p);
}
```

```cpp
#include <hip/hip_runtime.h>
#include <cstdio>
#include <cstdint>

constexpr int D = 2048, T_CTX = 4096, T = 12288, TC = 4096, TX = 16384;
constexpr int MODW = 12288, NCOND = 9;
constexpr int NSLOT = 1536, NXS = 16 * NSLOT;
constexpr float DN_ALPHA = 1.41421356237309515f;
constexpr float LOG2E = 1.44269504088896341f;
constexpr float QS_MLA = 0.07216878364870322f * LOG2E;
constexpr float QS_SWA = 0.125f * LOG2E;
constexpr int NTHREADS = 512, NWAVES = 8;
#ifndef MOE_F8
#define MOE_F8 1
#endif
constexpr float GU_WSCALE = 32.f, DN_WSCALE = 64.f;

constexpr size_t O_Y = 0, O_CKV = 25165824, O_KPE = 26214400, O_SK = 26476544, O_SV = 27525120, O_END = 28573696;

constexpr size_t al256(size_t x) { return (x + 255) & ~(size_t)255; }
constexpr size_t WS_CTL = 0, CTL_BYTES = 1u << 20;
constexpr size_t WS_MOD = WS_CTL + CTL_BYTES;
constexpr size_t WS_ROPE = WS_MOD + al256((size_t)2 * 9 * 12288 * 4);
constexpr size_t WS_WINE = WS_ROPE + al256((size_t)2 * 1024 * 32 * 4);
constexpr size_t WS_W2 = WS_WINE + (size_t)2048 * 2048 * 2;
constexpr size_t WS_WOUTE = WS_W2 + (size_t)4608 * 1792 * 2;
constexpr size_t WS_WINO = WS_WOUTE + (size_t)2048 * 2048 * 2;
constexpr size_t WS_WOUTO = WS_WINO + (size_t)2560 * 2048 * 2;
constexpr size_t WS_WGU = WS_WOUTO + (size_t)2048 * 2048 * 2;
constexpr size_t WS_WDN = WS_WGU + (size_t)32 * 4096 * 2048 * 2;
constexpr size_t WS_H = WS_WDN + (size_t)32 * 2048 * 2048 * 2;
constexpr size_t WS_PJ = WS_H + (size_t)T * 2048 * 2;
constexpr size_t WS_ACT2 = WS_PJ + (size_t)T * 1792 * 4;
constexpr size_t WS_KPE = WS_ACT2 + (size_t)TX * 1792 * 2;
constexpr size_t WS_Q = WS_KPE + (size_t)TX * 64 * 2;
constexpr size_t WS_KN = WS_Q + (size_t)T * 2048 * 2;
constexpr size_t WS_VT = WS_KN + (size_t)TX * 1024 * 2;
constexpr size_t WS_VTO = WS_VT + (size_t)1024 * TX * 2;
constexpr size_t WS_KO = WS_VTO + (size_t)256 * TX * 2;
constexpr size_t WS_MIX = WS_KO + (size_t)TX * 256 * 2;
constexpr size_t WS_Y = WS_MIX + (size_t)T * 2048 * 2;
constexpr size_t WS_X1 = WS_Y + (size_t)T * 2048 * 4;
constexpr size_t WS_XL = WS_X1 + (size_t)T * 2048 * 4;
constexpr size_t WS_AFF = WS_XL + (size_t)T * 2048 * 4;
constexpr size_t WS_INV = WS_AFF + (size_t)T * 16 * 4;
constexpr size_t WS_XS = WS_INV + (size_t)T * 16 * 4;
constexpr size_t WS_HID = WS_XS + (size_t)NXS * 2048 * 2;
constexpr size_t WS_YE = WS_HID + (size_t)NXS * 2048 * 2;
constexpr size_t WS_AFFT = WS_YE + (size_t)NXS * 2048 * 2;
constexpr size_t WS_H8 = WS_AFFT + (size_t)T * 16 * 4;
constexpr size_t WS_STAT = WS_H8 + (size_t)T * 2048;
constexpr size_t WS_DBG = WS_STAT + (size_t)T * 8;
constexpr size_t WS_END = WS_DBG + (1u << 20);

typedef unsigned short bf16_t;
typedef float f32x4 __attribute__((ext_vector_type(4)));
typedef unsigned u32x4 __attribute__((ext_vector_type(4)));
typedef unsigned u32x2 __attribute__((ext_vector_type(2)));
typedef float f32x2 __attribute__((ext_vector_type(2)));
#define LAS __attribute__((address_space(3)))
#define DI __device__ __forceinline__

struct Params {
    const float* in[29];
    float* out;
    unsigned char* ws;
    int ph_lo, ph_hi;
};

DI unsigned f2bf(float f) { unsigned u = __float_as_uint(f); return (u + 0x7fffu + ((u >> 16) & 1u)) >> 16; }
DI unsigned pk2(float lo, float hi) { return f2bf(lo) | (f2bf(hi) << 16); }
DI unsigned pk4_fp8(float a, float b, float c, float d) { unsigned w = 0; w = __builtin_amdgcn_cvt_pk_fp8_f32(a, b, w, false); w = __builtin_amdgcn_cvt_pk_fp8_f32(c, d, w, true); return w; }
DI float bf2f(unsigned b) { return __uint_as_float(b << 16); }
DI float bflo(unsigned w) { return __uint_as_float(w << 16); }
DI float bfhi(unsigned w) { return __uint_as_float(w & 0xffff0000u); }
DI float wave_sum(float v) {
#pragma unroll
    for (int o = 1; o < 64; o <<= 1) v += __shfl_xor(v, o);
    return v;
}
DI float wave_max(float v) {
#pragma unroll
    for (int o = 1; o < 64; o <<= 1) v = fmaxf(v, __shfl_xor(v, o));
    return v;
}
DI int fresh_lane() { int l = (int)__builtin_amdgcn_mbcnt_hi(~0u, __builtin_amdgcn_mbcnt_lo(~0u, 0u)); asm volatile("" : "+v"(l)); return l; }
DI int cond_of_row(int r) { return r < T_CTX ? 0 : 1 + ((r - T_CTX) >> 10); }
DI const float* xrow_in(const Params& p, int r) { return r < T_CTX ? p.in[0] + (size_t)r * D : p.in[1] + (size_t)(r - T_CTX) * D; }

DI float* ws_mod(const Params& p) { return (float*)(p.ws + WS_MOD); }
DI float* ws_cos(const Params& p) { return (float*)(p.ws + WS_ROPE); }
DI float* ws_sin(const Params& p) { return (float*)(p.ws + WS_ROPE) + 1024 * 32; }
template <class X> DI X* wsp(const Params& p, size_t off) { return (X*)(p.ws + off); }
DI const float* modp(const Params& p, int l, int ci, int j) { return ws_mod(p) + ((size_t)(l * 9 + ci) * MODW + (size_t)j * D); }

#define XB_TMO      128
#define XB_XCNT(j)  (256  + 64 * (j))
#define XB_XSUB(j)  (1280 + 64 * (j))
#define XB_XGEN(j)  (2304 + 64 * (j))
#define XB_TOP      3328
#define XB_TOPGEN   3392
#define XCD_BAR_WORDS 3456
#define XB_SPIN_CAP (1u << 18)

__device__ __forceinline__ unsigned xb_ld(unsigned* p)              { return __hip_atomic_load(p, __ATOMIC_RELAXED, __HIP_MEMORY_SCOPE_AGENT); }
__device__ __forceinline__ unsigned xb_add(unsigned* p, unsigned v) { return __hip_atomic_fetch_add(p, v, __ATOMIC_RELAXED, __HIP_MEMORY_SCOPE_AGENT); }
__device__ __forceinline__ unsigned xb_xcc_id() { return (unsigned)__builtin_amdgcn_s_getreg((3 << 11) | 20) & 0xFu; }
#define XB_SPIN(cond, bar) do { unsigned _sp = 0; while (cond) { __builtin_amdgcn_s_sleep(1); \
    if ((++_sp & 255u) == 0u) { if (xb_ld(&(bar)[XB_TMO])) break; if (_sp > XB_SPIN_CAP) { atomicAdd(&(bar)[XB_TMO], 1u); break; } } } } while (0)

struct XcdBarrier {
    unsigned* bar; unsigned x;
    volatile LAS unsigned* st;
};

__device__ __forceinline__ XcdBarrier xcd_barrier_post(unsigned* bar, volatile LAS unsigned* st) {
    XcdBarrier b; b.bar = bar; b.x = xb_xcc_id(); b.st = st;
    if (threadIdx.x == 0) (void)xb_add(&bar[XB_XCNT(b.x)], 1u);
    return b;
}
__device__ __forceinline__ void xcd_barrier_complete(unsigned* bar, unsigned x, unsigned& nloc, unsigned& nx) {
    const unsigned G = gridDim.x * gridDim.y * gridDim.z;
    unsigned sum, cnt, mine, sp = 0u;
    for (;;) {
        sum = 0u; cnt = 0u; mine = 0u;
#pragma unroll
        for (unsigned j = 0; j < 16; ++j) { const unsigned c = xb_ld(&bar[XB_XCNT(j)]); sum += c; cnt += (c > 0u) ? 1u : 0u; mine = (j == x) ? c : mine; }
        if (sum == G) break;
        __builtin_amdgcn_s_sleep(1);
        if ((++sp & 255u) == 0u) { if (xb_ld(&bar[XB_TMO])) break; if (sp > XB_SPIN_CAP) { atomicAdd(&bar[XB_TMO], 1u); break; } }
    }
    nloc = mine > 0u ? mine : 1u; nx = cnt > 0u ? cnt : 1u;
}

__device__ __forceinline__ void xcd_barrier(const XcdBarrier& b) {
    asm volatile("s_waitcnt vmcnt(0)" ::: "memory");
    __syncthreads();
    if (threadIdx.x == 0) {
        unsigned* bar = b.bar;
        __builtin_amdgcn_s_waitcnt(0);
        unsigned nloc = b.st[0], nx = b.st[1];
        if (nloc == 0u) { xcd_barrier_complete(bar, b.x, nloc, nx); b.st[0] = nloc; b.st[1] = nx; }
        const unsigned old = xb_add(&bar[XB_XSUB(b.x)], 1u);
        const unsigned gen = old / nloc;
        if (old + 1u == (gen + 1u) * nloc) {
            __builtin_amdgcn_fence(__ATOMIC_RELEASE, "agent");
            asm volatile("s_waitcnt vmcnt(0)" ::: "memory");
            const unsigned og = xb_add(&bar[XB_TOP], 1u);
            const unsigned tg = og / nx;
            if (og + 1u == (tg + 1u) * nx) xb_add(&bar[XB_TOPGEN], 1u);
            else XB_SPIN(xb_ld(&bar[XB_TOPGEN]) == tg, bar);
            __builtin_amdgcn_fence(__ATOMIC_ACQUIRE, "agent");
            xb_add(&bar[XB_XGEN(b.x)], 1u);
            asm volatile("s_waitcnt vmcnt(0)" ::: "memory");
        } else {
            XB_SPIN(xb_ld(&bar[XB_XGEN(b.x)]) == gen, bar);
            __builtin_amdgcn_fence(__ATOMIC_ACQUIRE, "agent");
            asm volatile("s_waitcnt vmcnt(0)" ::: "memory");
        }
    }
    __syncthreads();
}
constexpr int CW_BAR = 4096;


DI void ph_mod(const Params& p, unsigned char* lds_raw) {
    float* s_lds = (float*)lds_raw;
    float* red = s_lds + 9 * 2048;
    const int tid = threadIdx.x, lane = tid & 63, wave = __builtin_amdgcn_readfirstlane(tid >> 6);
    const float* c = p.in[6]; const float* c_ctx = p.in[7]; const float* w_ada = p.in[8]; const float* b_ada = p.in[9];
    for (int i = tid; i < 9 * 2048; i += NTHREADS) { const int ci = i >> 11, k = i & 2047; const float v = ci == 0 ? c_ctx[k] : c[(ci - 1) * 2048 + k]; s_lds[i] = v / (1.f + expf(-v)); }
    __syncthreads();
    float* MOD = ws_mod(p);
    for (int it = blockIdx.x; it < 384; it += gridDim.x) {
        const int l = it / 192, c0 = (it % 192) * 64;
        const int kq = tid >> 4, cl = tid & 15;
        const float* w = w_ada + (size_t)l * 2048 * MODW + c0 + 4 * cl;
        float acc[9][4];
#pragma unroll
        for (int ci = 0; ci < 9; ++ci)
#pragma unroll
            for (int j = 0; j < 4; ++j) acc[ci][j] = 0.f;
#pragma unroll 8
        for (int kk = 0; kk < 64; ++kk) {
            const int k = kq * 64 + kk;
            const f32x4 wv = *(const f32x4*)(w + (size_t)k * MODW);
#pragma unroll
            for (int ci = 0; ci < 9; ++ci) { const float s = s_lds[ci * 2048 + k];
#pragma unroll
                for (int j = 0; j < 4; ++j) acc[ci][j] += s * wv[j]; }
        }
#pragma unroll
        for (int ci = 0; ci < 9; ++ci)
#pragma unroll
            for (int j = 0; j < 4; ++j) { float v = acc[ci][j]; v += __shfl_xor(v, 16); v += __shfl_xor(v, 32); acc[ci][j] = v; }
        if (lane < 16) {
#pragma unroll
            for (int ci = 0; ci < 9; ++ci)
#pragma unroll
                for (int j = 0; j < 4; ++j) red[(wave * 9 + ci) * 64 + 4 * cl + j] = acc[ci][j];
        }
        __syncthreads();
        for (int o = tid; o < 576; o += NTHREADS) { const int ci = o >> 6, cc = o & 63; float s = 0.f;
#pragma unroll
            for (int w8 = 0; w8 < 8; ++w8) s += red[(w8 * 9 + ci) * 64 + cc];
            MOD[(size_t)(l * 9 + ci) * MODW + c0 + cc] = s + b_ada[l * MODW + c0 + cc]; }
        __syncthreads();
    }
}

constexpr int CV_INE = 928, CV_UQ = 192, CV_UKV = 128, CV_POOL = 64, CV_OUT = 1024, CV_INO = 1280, CV_MOE = 98304;
constexpr int CV_TOTAL = CV_INE + CV_UQ + CV_UKV + CV_POOL + CV_OUT + CV_INO + CV_OUT + CV_MOE;
DI void cvt_item(const Params& p, int item, int lane) {
    const float* src; bf16_t* dst; int K, N, ldd, nb, kb, map = 0, a = 0; float f8s = 0.f;
    if (item < CV_INE) { src = p.in[10]; dst = wsp<bf16_t>(p, WS_WINE); K = 2048; N = 1856; ldd = 2048; nb = item % 29; kb = item / 29; map = 1; }
    else if ((item -= CV_INE) < CV_UQ) { src = p.in[13]; dst = wsp<bf16_t>(p, WS_W2); K = 512; N = 1536; ldd = 1792; nb = item % 24; kb = item / 24; }
    else if ((item -= CV_UQ) < CV_UKV) { src = p.in[14]; dst = wsp<bf16_t>(p, WS_W2); K = 256; N = 2048; ldd = 1792; nb = item % 32; kb = item / 32; map = 2; }
    else if ((item -= CV_UKV) < CV_POOL) { const int g = item >> 4, r = item & 15; src = p.in[15] + (size_t)g * 65536; dst = wsp<bf16_t>(p, WS_W2); K = 256; N = 256; ldd = 1792; nb = r & 3; kb = r >> 2; a = 3584 + g * 256; }
    else if ((item -= CV_POOL) < CV_OUT) { src = p.in[17]; dst = wsp<bf16_t>(p, WS_WOUTE); K = 2048; N = 2048; ldd = 2048; nb = item & 31; kb = item >> 5; }
    else if ((item -= CV_OUT) < CV_INO) { src = p.in[18]; dst = wsp<bf16_t>(p, WS_WINO); K = 2048; N = 2560; ldd = 2048; nb = item % 40; kb = item / 40; }
    else if ((item -= CV_INO) < CV_OUT) { src = p.in[20]; dst = wsp<bf16_t>(p, WS_WOUTO); K = 2048; N = 2048; ldd = 2048; nb = item & 31; kb = item >> 5; }
    else { item -= CV_OUT; const int mat = item >> 10, w = item & 1023, le = mat / 3, kind = mat % 3; K = 2048; N = 2048; ldd = 2048; nb = w & 31; kb = w >> 5;
        src = p.in[24 + kind] + (size_t)le * 2048 * 2048;
        if (kind == 2) dst = wsp<bf16_t>(p, WS_WDN) + (size_t)le * 2048 * 2048; else { dst = wsp<bf16_t>(p, WS_WGU) + (size_t)le * 4096 * 2048; map = 3; a = kind * 128; }
        if (MOE_F8) { f8s = kind == 2 ? DN_WSCALE : GU_WSCALE; dst = (bf16_t*)((unsigned char*)(kind == 2 ? wsp<bf16_t>(p, WS_WDN) : wsp<bf16_t>(p, WS_WGU)) + (size_t)le * (kind == 2 ? 2048 : 4096) * 2048); } }
    const int n = nb * 64 + lane;
    const float* s = src + (size_t)(kb * 64) * N + n;
    float v[64];
#pragma unroll
    for (int k = 0; k < 64; ++k) v[k] = __builtin_nontemporal_load(s + (size_t)k * N);
    int drow;
    if (map == 0) drow = n + a;
    else if (map == 1) drow = n < 768 ? n : (n < 832 ? 1792 + (n - 768) : 768 + (n - 832));
    else if (map == 2) { const int h = n >> 8, j = n & 255; drow = j < 128 ? 1536 + h * 128 + j : 2560 + h * 128 + (j - 128); }
    else drow = (n >> 7) * 256 + (n & 127) + a;
    if (f8s != 0.f) { u32x4* d8 = (u32x4*)((unsigned char*)dst + (size_t)drow * 2048 + kb * 64);
#pragma unroll
        for (int c16 = 0; c16 < 4; ++c16) { u32x4 o; const float* w = v + 16 * c16;
            o.x = pk4_fp8(w[0] * f8s, w[1] * f8s, w[2] * f8s, w[3] * f8s); o.y = pk4_fp8(w[4] * f8s, w[5] * f8s, w[6] * f8s, w[7] * f8s); o.z = pk4_fp8(w[8] * f8s, w[9] * f8s, w[10] * f8s, w[11] * f8s); o.w = pk4_fp8(w[12] * f8s, w[13] * f8s, w[14] * f8s, w[15] * f8s); d8[c16] = o; }
        return; }
    u32x4* d = (u32x4*)(dst + (size_t)drow * ldd + kb * 64);
#pragma unroll
    for (int c8 = 0; c8 < 8; ++c8) { u32x4 o; o.x = pk2(v[8 * c8], v[8 * c8 + 1]); o.y = pk2(v[8 * c8 + 2], v[8 * c8 + 3]); o.z = pk2(v[8 * c8 + 4], v[8 * c8 + 5]); o.w = pk2(v[8 * c8 + 6], v[8 * c8 + 7]); d[c8] = o; }
}
DI void ph_convert(const Params& p, int item_lo, int item_hi, int bid, int nblk) {
    const int lane = threadIdx.x & 63, gw = bid * NWAVES + __builtin_amdgcn_readfirstlane(threadIdx.x >> 6), NGW = nblk * NWAVES;
    for (int it = item_lo + gw; it < item_hi; it += NGW) cvt_item(p, it, lane);
}

DI void ph_misc(const Params& p) {
    const size_t gt = (size_t)blockIdx.x * NTHREADS + threadIdx.x, NGT = (size_t)gridDim.x * NTHREADS;
    float* cosT = ws_cos(p); float* sinT = ws_sin(p);
    for (size_t i = gt; i < 1024 * 32; i += NGT) { const int s = (int)(i >> 5), f = (int)(i & 31);
        const float inv = powf(10000.f, -(float)(f & 15) / 16.f); const float pos = f < 16 ? (float)(s >> 6) : (float)(s & 63); const float ang = pos * inv;
        cosT[i] = cosf(ang); sinT[i] = sinf(ang); }
    bf16_t* ACT2 = wsp<bf16_t>(p, WS_ACT2); bf16_t* KPE = wsp<bf16_t>(p, WS_KPE); bf16_t* KO = wsp<bf16_t>(p, WS_KO); bf16_t* VTO = wsp<bf16_t>(p, WS_VTO);
    const float* cckv = p.in[2]; const float* ckpe = p.in[3]; const float* csk = p.in[4]; const float* csv = p.in[5];
    for (size_t i = gt; i < (size_t)TC * 256 / 4; i += NGT) { const size_t e = i * 4; const int j = (int)(e >> 8), cc = (int)(e & 255); const f32x4 v = *(const f32x4*)(cckv + e);
        u32x2 o; o.x = pk2(v[0], v[1]); o.y = pk2(v[2], v[3]); *(u32x2*)(ACT2 + (size_t)(T + j) * 1792 + 512 + cc) = o;
        const f32x4 k = *(const f32x4*)(csk + e); u32x2 o2; o2.x = pk2(k[0], k[1]); o2.y = pk2(k[2], k[3]); *(u32x2*)(KO + (size_t)(T + j) * 256 + cc) = o2; }
    for (size_t i = gt; i < (size_t)TC * 64 / 4; i += NGT) { const size_t e = i * 4; const f32x4 v = *(const f32x4*)(ckpe + e); u32x2 o; o.x = pk2(v[0], v[1]); o.y = pk2(v[2], v[3]); *(u32x2*)(KPE + (size_t)T * 64 + e) = o; }
    for (size_t i = gt; i < (size_t)256 * (TC / 8); i += NGT) { const int f = (int)(i / (TC / 8)), j8 = (int)(i % (TC / 8)) * 8; float v[8];
#pragma unroll
        for (int q = 0; q < 8; ++q) v[q] = csv[(size_t)(j8 + q) * 256 + f];
        u32x4 o; o.x = pk2(v[0], v[1]); o.y = pk2(v[2], v[3]); o.z = pk2(v[4], v[5]); o.w = pk2(v[6], v[7]); *(u32x4*)(VTO + (size_t)f * TX + T + j8) = o; }
}

DI void ph_h0(const Params& p) {
    const int lane = threadIdx.x & 63, gw = blockIdx.x * NWAVES + __builtin_amdgcn_readfirstlane(threadIdx.x >> 6), NGW = gridDim.x * NWAVES;
    bf16_t* H = wsp<bf16_t>(p, WS_H);
    for (int r = gw; r < T; r += NGW) {
        const int ci = cond_of_row(r); const float* x = xrow_in(p, r); const float* sh = modp(p, 0, ci, 0); const float* sc = modp(p, 0, ci, 1);
#pragma unroll
        for (int j = 0; j < 8; ++j) { const int c0 = lane * 4 + 256 * j; const f32x4 v = *(const f32x4*)(x + c0), a = *(const f32x4*)(sc + c0), b = *(const f32x4*)(sh + c0);
            const f32x4 h = v * (1.f + a) + b; u32x2 o; o.x = pk2(h[0], h[1]); o.y = pk2(h[2], h[3]); *(u32x2*)(H + (size_t)r * D + c0) = o; }
    }
}

DI void ph_e1(const Params& p) {
    const int lane = threadIdx.x & 63, gw = blockIdx.x * NWAVES + __builtin_amdgcn_readfirstlane(threadIdx.x >> 6), NGW = gridDim.x * NWAVES;
    const float* PJ = wsp<float>(p, WS_PJ); bf16_t* ACT2 = wsp<bf16_t>(p, WS_ACT2);
    const float* qn = p.in[11]; const float* kvn = p.in[12];
    for (int r = gw; r < T; r += NGW) {
        const float* pr = PJ + (size_t)r * 1792; bf16_t* ar = ACT2 + (size_t)r * 1792;
        {
            f32x4 v[2]; float ss = 0.f;
#pragma unroll
            for (int j = 0; j < 2; ++j) { v[j] = *(const f32x4*)(pr + lane * 4 + 256 * j); ss += (v[j][0] * v[j][0] + v[j][1] * v[j][1]) + (v[j][2] * v[j][2] + v[j][3] * v[j][3]); }
            const float rs = rsqrtf(wave_sum(ss) * (1.f / 512.f) + 1e-6f);
#pragma unroll
            for (int j = 0; j < 2; ++j) { const int c0 = lane * 4 + 256 * j; const f32x4 g = *(const f32x4*)(qn + c0); const f32x4 y = v[j] * rs * g; u32x2 o; o.x = pk2(y[0], y[1]); o.y = pk2(y[2], y[3]); *(u32x2*)(ar + c0) = o; }
        }
        {
            const int c0 = lane * 4; const f32x4 v = *(const f32x4*)(pr + 512 + c0); float ss = (v[0] * v[0] + v[1] * v[1]) + (v[2] * v[2] + v[3] * v[3]);
            const float rs = rsqrtf(wave_sum(ss) * (1.f / 256.f) + 1e-6f); const f32x4 g = *(const f32x4*)(kvn + c0); const f32x4 y = v * rs * g;
            u32x2 o; o.x = pk2(y[0], y[1]); o.y = pk2(y[2], y[3]); *(u32x2*)(ar + 512 + c0) = o;
            if (r < T_CTX) *(f32x4*)(p.out + O_CKV + (size_t)r * 256 + c0) = y;
        }
        {
            int s, S, rb; if (r < T_CTX) { s = r & 255; S = 256; rb = r - s; } else { s = (r - T_CTX) & 1023; S = 1024; rb = r - s; }
#pragma unroll
            for (int g = 0; g < 4; ++g) { const int half = 1 << g; const int lo = max(s - half, 0), hi = min(s + half, S); const int c0 = 768 + g * 256 + lane * 4;
                f32x4 sum = {0.f, 0.f, 0.f, 0.f};
                for (int t = lo; t < hi; ++t) sum += *(const f32x4*)(PJ + (size_t)(rb + t) * 1792 + c0);
                const f32x4 u = *(const f32x4*)(pr + c0); const f32x4 y = sum / (float)(hi - lo) - u;
                u32x2 o; o.x = pk2(y[0], y[1]); o.y = pk2(y[2], y[3]); *(u32x2*)(ar + c0) = o; }
        }
    }
}

DI void ph_ln1(const Params& p, int l, unsigned char* lds_raw) {
    const int tid = threadIdx.x, lane = tid & 63, gw = blockIdx.x * NWAVES + __builtin_amdgcn_readfirstlane(tid >> 6), NGW = gridDim.x * NWAVES;
    float* wT = (float*)lds_raw;
    const float* wr = p.in[23] + (size_t)l * 2048 * 16;
    for (int i = tid; i < 2048 * 16; i += NTHREADS) { const int d = i >> 4, e = i & 15; wT[e * 2048 + d] = wr[i]; }
    __syncthreads();
    const float* Y = wsp<float>(p, WS_Y); float* STAT = wsp<float>(p, WS_STAT); bf16_t* H = wsp<bf16_t>(p, WS_H); float* AFF = wsp<float>(p, WS_AFF); float* AFFT = wsp<float>(p, WS_AFFT);
    unsigned char* H8 = wsp<unsigned char>(p, WS_H8);
    const float* lg = p.in[21] + l * D; const float* lb = p.in[22] + l * D;
    f32x4 v[8], vn[8];
    int r = gw;
    if (r < T) {
#pragma unroll
        for (int j = 0; j < 4; ++j) { const float* y = Y + (size_t)r * D + lane * 8 + 512 * j; v[2 * j] = *(const f32x4*)y; v[2 * j + 1] = *(const f32x4*)(y + 4); } }
    for (; r < T; r += NGW) {
        const int rn = r + NGW;
        if (rn < T) {
#pragma unroll
            for (int j = 0; j < 4; ++j) { const float* y = Y + (size_t)rn * D + lane * 8 + 512 * j; vn[2 * j] = *(const f32x4*)y; vn[2 * j + 1] = *(const f32x4*)(y + 4); } }
        const int ci = cond_of_row(r); const float* sh = modp(p, l, ci, 3); const float* sc = modp(p, l, ci, 4);
        float s = 0.f;
#pragma unroll
        for (int j = 0; j < 8; ++j) s += (v[j][0] + v[j][1]) + (v[j][2] + v[j][3]);
        const float mean = wave_sum(s) * (1.f / D); float s2 = 0.f;
#pragma unroll
        for (int j = 0; j < 8; ++j) { v[j] = v[j] - mean; s2 += (v[j][0] * v[j][0] + v[j][1] * v[j][1]) + (v[j][2] * v[j][2] + v[j][3] * v[j][3]); }
        const float rstd = rsqrtf(wave_sum(s2) * (1.f / D) + 1e-5f);
#pragma unroll
        for (int j = 0; j < 4; ++j) { const int c0 = lane * 8 + 512 * j;
#pragma unroll
            for (int q = 0; q < 2; ++q) { const int cc = c0 + 4 * q; const f32x4 x1 = v[2 * j + q] * rstd * *(const f32x4*)(lg + cc) + *(const f32x4*)(lb + cc);
                v[2 * j + q] = x1 * (1.f + *(const f32x4*)(sc + cc)) + *(const f32x4*)(sh + cc); }
            const f32x4 a = v[2 * j], b = v[2 * j + 1];
            if (!MOE_F8) { u32x4 o; o.x = pk2(a[0], a[1]); o.y = pk2(a[2], a[3]); o.z = pk2(b[0], b[1]); o.w = pk2(b[2], b[3]); *(u32x4*)(H + (size_t)r * D + c0) = o; }
            u32x2 o8; o8.x = pk4_fp8(a[0], a[1], a[2], a[3]); o8.y = pk4_fp8(b[0], b[1], b[2], b[3]); *(u32x2*)(H8 + (size_t)r * D + c0) = o8; }
        float mine = -1e30f;
#pragma unroll 2
        for (int e = 0; e < 16; ++e) { float a = 0.f;
#pragma unroll
            for (int j = 0; j < 4; ++j) { const float* wp = wT + e * 2048 + lane * 8 + 512 * j; const f32x4 w0 = *(const f32x4*)wp, w1 = *(const f32x4*)(wp + 4); const f32x4 h0 = v[2 * j], h1 = v[2 * j + 1];
                a += ((h0[0] * w0[0] + h0[1] * w0[1]) + (h0[2] * w0[2] + h0[3] * w0[3])) + ((h1[0] * w1[0] + h1[1] * w1[1]) + (h1[2] * w1[2] + h1[3] * w1[3])); }
            a = wave_sum(a); mine = (lane == e) ? a : mine; }
        const float m = wave_max(mine);
        const float ex = lane < 16 ? expf(mine - m) : 0.f;
        const float den = wave_sum(ex);
        if (lane < 16) { const float af = ex / den; AFF[(size_t)r * 16 + lane] = af; AFFT[(size_t)lane * T + r] = af; }
        if (lane == 0) *(f32x2*)(STAT + 2 * (size_t)r) = (f32x2){mean, rstd};
#pragma unroll
        for (int j = 0; j < 8; ++j) v[j] = vn[j];
    }
}

DI void ph_topk(const Params& p, unsigned char* lds_raw) {
    const int tid = threadIdx.x, lane = tid & 63, wave = __builtin_amdgcn_readfirstlane(tid >> 6);
    float* vals = (float*)lds_raw;
    int* cnt2 = (int*)(vals + 1024);
    int* selrow = cnt2 + 256;
    int* selslot = selrow + 256;
    int* nsel = selslot + 256;
    const float* AFFT = wsp<float>(p, WS_AFFT); int* INV = wsp<int>(p, WS_INV); const bf16_t* H = wsp<bf16_t>(p, WS_H); const unsigned char* H8 = wsp<unsigned char>(p, WS_H8); bf16_t* XS = wsp<bf16_t>(p, WS_XS);
    for (int it = blockIdx.x; it < 768; it += gridDim.x) {
        int n, cap, r0, e, sb, c0;
        if (it < 256) { const int b = it >> 4; e = it & 15; n = 256; cap = 32; r0 = b * 256; sb = b * 32; c0 = 0; }
        else { const int q = it - 256, li = q >> 2, b = li >> 4; e = li & 15; n = 1024; cap = 128; r0 = T_CTX + b * 1024; sb = 512 + b * 128; c0 = (q & 3) * 256; }
        for (int i = tid; i < n; i += NTHREADS) vals[i] = AFFT[(size_t)e * T + r0 + i];
        if (tid == 0) *nsel = 0;
        __syncthreads();
        const int ci = c0 + (tid & 255), half = tid >> 8, jn = n >> 1, j0 = half * jn;
        const float vi = vals[ci]; int cnt = 0;
        for (int j = j0; j < j0 + jn; ++j) { const float vj = vals[j]; cnt += (vj > vi || (vj == vi && j < ci)) ? 1 : 0; }
        if (half) cnt2[tid & 255] = cnt;
        __syncthreads();
        if (!half) { cnt += cnt2[tid];
            if (cnt < cap) { const int pos = atomicAdd(nsel, 1); selrow[pos] = ci; selslot[pos] = cnt; INV[(size_t)(r0 + ci) * 16 + e] = sb + cnt; } else INV[(size_t)(r0 + ci) * 16 + e] = -1; }
        __syncthreads();
        const int ns = *nsel;
        for (int k = wave; k < ns; k += NWAVES) { const int r = r0 + selrow[k]; const size_t drow = (size_t)(e * NSLOT + sb + selslot[k]);
            if (MOE_F8) { const u32x4* src = (const u32x4*)(H8 + (size_t)r * D); u32x4* dst = (u32x4*)((unsigned char*)XS + drow * D);
#pragma unroll
                for (int j = 0; j < 2; ++j) dst[lane + 64 * j] = src[lane + 64 * j]; }
            else { const u32x4* src = (const u32x4*)(H + (size_t)r * D); u32x4* dst = (u32x4*)(XS + drow * D);
#pragma unroll
                for (int j = 0; j < 4; ++j) dst[lane + 64 * j] = src[lane + 64 * j]; } }
        __syncthreads();
    }
}

DI void ph_ln2(const Params& p, int l) {
    const int lane = threadIdx.x & 63, gw = blockIdx.x * NWAVES + __builtin_amdgcn_readfirstlane(threadIdx.x >> 6), NGW = gridDim.x * NWAVES;
    const float* X1 = wsp<float>(p, WS_Y); const float* STAT = wsp<float>(p, WS_STAT); const float* l1g = p.in[21] + l * D; const float* l1b = p.in[22] + l * D;
    const float* AFF = wsp<float>(p, WS_AFF); const int* INV = wsp<int>(p, WS_INV); const bf16_t* YE = wsp<bf16_t>(p, WS_YE);
    float* XL = wsp<float>(p, WS_XL); bf16_t* H = wsp<bf16_t>(p, WS_H);
    const float* lg = p.in[27] + l * D; const float* lb = p.in[28] + l * D;
    f32x4 x[8], xn[8]; int sl = -1, sln = -1; float af = 0.f, afn = 0.f; f32x2 st = {0.f, 1.f}, stn = {0.f, 1.f};
    int r = gw;
    if (r < T) {
#pragma unroll
        for (int j = 0; j < 4; ++j) { const float* y = X1 + (size_t)r * D + lane * 8 + 512 * j; x[2 * j] = *(const f32x4*)y; x[2 * j + 1] = *(const f32x4*)(y + 4); }
        if (lane < 16) { sl = INV[(size_t)r * 16 + lane]; af = AFF[(size_t)r * 16 + lane]; } st = *(const f32x2*)(STAT + 2 * (size_t)r); }
    for (; r < T; r += NGW) {
        const int rn = r + NGW;
        if (rn < T) {
#pragma unroll
            for (int j = 0; j < 4; ++j) { const float* y = X1 + (size_t)rn * D + lane * 8 + 512 * j; xn[2 * j] = *(const f32x4*)y; xn[2 * j + 1] = *(const f32x4*)(y + 4); }
            if (lane < 16) { sln = INV[(size_t)rn * 16 + lane]; afn = AFF[(size_t)rn * 16 + lane]; } stn = *(const f32x2*)(STAT + 2 * (size_t)rn); }
        const int ci = cond_of_row(r); const float* g2 = modp(p, l, ci, 5);
        f32x4 f[8];
#pragma unroll
        for (int j = 0; j < 8; ++j) f[j] = (f32x4){0.f, 0.f, 0.f, 0.f};
        {
            unsigned long long mk = __ballot(sl >= 0) & 0xffffull;
            while (mk) {
                const int e0 = __builtin_ctzll(mk); mk &= mk - 1; const bool two = mk != 0ull; const int e1 = two ? __builtin_ctzll(mk) : e0; if (two) mk &= mk - 1;
                const int s0 = __shfl(sl, e0), s1 = __shfl(sl, e1); const float w0 = __shfl(af, e0), w1 = two ? __shfl(af, e1) : 0.f;
                const bf16_t* y0 = YE + (size_t)(e0 * NSLOT + s0) * D + lane * 8; const bf16_t* y1 = YE + (size_t)(e1 * NSLOT + s1) * D + lane * 8;
                u32x4 q0[4], q1[4];
#pragma unroll
                for (int j = 0; j < 4; ++j) { q0[j] = *(const u32x4*)(y0 + 512 * j); q1[j] = *(const u32x4*)(y1 + 512 * j); }
#pragma unroll
                for (int j = 0; j < 4; ++j) {
                    f[2 * j][0] += w0 * bflo(q0[j].x) + w1 * bflo(q1[j].x); f[2 * j][1] += w0 * bfhi(q0[j].x) + w1 * bfhi(q1[j].x); f[2 * j][2] += w0 * bflo(q0[j].y) + w1 * bflo(q1[j].y); f[2 * j][3] += w0 * bfhi(q0[j].y) + w1 * bfhi(q1[j].y);
                    f[2 * j + 1][0] += w0 * bflo(q0[j].z) + w1 * bflo(q1[j].z); f[2 * j + 1][1] += w0 * bfhi(q0[j].z) + w1 * bfhi(q1[j].z); f[2 * j + 1][2] += w0 * bflo(q0[j].w) + w1 * bflo(q1[j].w); f[2 * j + 1][3] += w0 * bfhi(q0[j].w) + w1 * bfhi(q1[j].w); }
            }
        }
        float s = 0.f;
#pragma unroll
        for (int j = 0; j < 8; ++j) { const int c0 = lane * 8 + 512 * (j >> 1) + 4 * (j & 1); const f32x4 x1 = (x[j] - st[0]) * st[1] * *(const f32x4*)(l1g + c0) + *(const f32x4*)(l1b + c0);
            f[j] = DN_ALPHA * x1 + *(const f32x4*)(g2 + c0) * f[j]; s += (f[j][0] + f[j][1]) + (f[j][2] + f[j][3]); }
        const float mean = wave_sum(s) * (1.f / D); float s2 = 0.f;
#pragma unroll
        for (int j = 0; j < 8; ++j) { f[j] = f[j] - mean; s2 += (f[j][0] * f[j][0] + f[j][1] * f[j][1]) + (f[j][2] * f[j][2] + f[j][3] * f[j][3]); }
        const float rstd = rsqrtf(wave_sum(s2) * (1.f / D) + 1e-5f);
        const float* sh = modp(p, 1, ci, 0); const float* sc = modp(p, 1, ci, 1);
#pragma unroll
        for (int j = 0; j < 4; ++j) { const int c0 = lane * 8 + 512 * j; f32x4 o[2];
#pragma unroll
            for (int q = 0; q < 2; ++q) { const int cc = c0 + 4 * q; o[q] = f[2 * j + q] * rstd * *(const f32x4*)(lg + cc) + *(const f32x4*)(lb + cc);
                if (l == 0) { *(f32x4*)(XL + (size_t)r * D + cc) = o[q]; o[q] = o[q] * (1.f + *(const f32x4*)(sc + cc)) + *(const f32x4*)(sh + cc); }
                else *(f32x4*)(p.out + O_Y + (size_t)r * D + cc) = o[q]; }
            if (l == 0) { u32x4 w; w.x = pk2(o[0][0], o[0][1]); w.y = pk2(o[0][2], o[0][3]); w.z = pk2(o[1][0], o[1][1]); w.w = pk2(o[1][2], o[1][3]); *(u32x4*)(H + (size_t)r * D + c0) = w; } }
#pragma unroll
        for (int j = 0; j < 8; ++j) x[j] = xn[j];
        sl = sln; af = afn; st = stn;
    }
}

template <int PAT> DI void ph_readonly(const Params& p) {
    const int lane = threadIdx.x & 63, gw = blockIdx.x * NWAVES + __builtin_amdgcn_readfirstlane(threadIdx.x >> 6), NGW = gridDim.x * NWAVES;
    float accum = 0.f;
    for (int it = gw; it < 98304; it += NGW) {
        const int mat = it >> 10, w = it & 1023, le = mat / 3, kind = mat % 3;
        const float* base = p.in[24 + kind] + (size_t)le * 2048 * 2048;
        if (PAT == 0) { const int nb = w & 31, kb = w >> 5; const float* s = base + (size_t)(kb * 64) * 2048 + nb * 64 + lane; float v[64];
#pragma unroll
            for (int k = 0; k < 64; ++k) v[k] = __builtin_nontemporal_load(s + (size_t)k * 2048);
#pragma unroll
            for (int k = 0; k < 64; ++k) accum += v[k]; }
        else if (PAT == 1) { const int nb8 = w & 7, kb16 = w >> 3; const float* s = base + (size_t)(kb16 * 16) * 2048 + nb8 * 256 + 4 * lane; f32x4 v[16];
#pragma unroll
            for (int k = 0; k < 16; ++k) v[k] = __builtin_nontemporal_load((const f32x4*)(s + (size_t)k * 2048));
#pragma unroll
            for (int k = 0; k < 16; ++k) accum += (v[k][0] + v[k][1]) + (v[k][2] + v[k][3]); }
        else { const float* s = base + (size_t)w * 4096 + 4 * lane; f32x4 v[16];
#pragma unroll
            for (int k = 0; k < 16; ++k) v[k] = __builtin_nontemporal_load((const f32x4*)(s + (size_t)k * 256));
#pragma unroll
            for (int k = 0; k < 16; ++k) accum += (v[k][0] + v[k][1]) + (v[k][2] + v[k][3]); }
    }
    if (lane == 0) wsp<float>(p, WS_DBG)[gw] = accum + wave_sum(accum);
}

struct Unit { const char* A; const char* B; unsigned lda, ldb; int nt; int pm, pn; int mode; int aux; };
DI int vcu_of(int bx, int G) { return (G % 8 == 0) ? (bx % 8) * (G / 8) + bx / 8 : bx; }

DI void rope8(const Params& p, int s, int pi0, float* v) {
    const f32x4 c = *(const f32x4*)(ws_cos(p) + s * 32 + pi0), sn = *(const f32x4*)(ws_sin(p) + s * 32 + pi0);
#pragma unroll
    for (int i = 0; i < 4; ++i) { const float x1 = v[2 * i], x2 = v[2 * i + 1]; v[2 * i] = x1 * c[i] - x2 * sn[i]; v[2 * i + 1] = x1 * sn[i] + x2 * c[i]; }
}
DI void st_bf16x8(bf16_t* dst, const float* v) { u32x4 w; w.x = pk2(v[0], v[1]); w.y = pk2(v[2], v[3]); w.z = pk2(v[4], v[5]); w.w = pk2(v[6], v[7]); *(u32x4*)dst = w; }
DI void st_f32x8(float* dst, const float* v) { *(f32x4*)dst = (f32x4){v[0], v[1], v[2], v[3]}; *(f32x4*)(dst + 4) = (f32x4){v[4], v[5], v[6], v[7]}; }

struct SchedInEven { const Params* p; int G, c;
    DI bool next(int i, Unit& u) const { const int L = i * G + c; if (L >= 48 * 8) return false; u.pm = L >> 3; u.pn = L & 7;
        u.A = (const char*)wsp<bf16_t>(*p, WS_H) + (size_t)u.pm * 256 * 4096; u.B = (const char*)wsp<bf16_t>(*p, WS_WINE) + (size_t)u.pn * 256 * 4096; u.lda = 4096; u.ldb = 4096; u.nt = 32; u.mode = 0; u.aux = 0; return true; } };
struct EpiInEven { static constexpr bool PAIR = false, F8 = false; const Params* p;
    DI void store(const Unit& u, int row, int col, float* v) const {
        const int r = u.pm * 256 + row, gc = u.pn * 256 + col;
        if (gc < 1792) { st_f32x8(wsp<float>(*p, WS_PJ) + (size_t)r * 1792 + gc, v); return; }
        if (gc >= 1856) return;
        const int j0 = gc - 1792;
        if (r < T_CTX) st_f32x8(p->out + O_KPE + (size_t)r * 64 + j0, v); else rope8(*p, (r - T_CTX) & 1023, j0 >> 1, v);
        st_bf16x8(wsp<bf16_t>(*p, WS_KPE) + (size_t)r * 64 + j0, v);
    } };

constexpr int E2_Q = 48 * 6, E2_K = 64 * 4, E2_V = 4 * 64, E2_P = 48 * 4, E2_TOTAL = E2_Q + E2_K + E2_V + E2_P;
struct SchedE2 { const Params* p; int G, c;
    DI bool next(int i, Unit& u) const { int L;
        if (G == 256) { if (c < 32) { if (i > 2) return false; L = i == 0 ? c : (i == 1 ? 256 + c : E2_Q + c); } else { if (i > 3) return false; L = i == 0 ? c : E2_Q + 32 + (c - 32) * 3 + (i - 1); } }
        else { L = i * G + c; if (L >= E2_TOTAL) return false; }
        const char* ACT2 = (const char*)wsp<bf16_t>(*p, WS_ACT2); const char* W2 = (const char*)wsp<bf16_t>(*p, WS_W2); u.aux = 0;
        if (L < E2_Q) { u.mode = 0; u.pm = L / 6; u.pn = L % 6; u.A = ACT2 + (size_t)u.pm * 256 * 3584; u.lda = 3584; u.B = W2 + (size_t)u.pn * 256 * 3584; u.ldb = 3584; u.nt = 8; return true; }
        L -= E2_Q;
        if (L < E2_K) { u.mode = 1; u.pm = L >> 2; u.pn = L & 3; u.A = ACT2 + (size_t)u.pm * 256 * 3584 + 512 * 2; u.lda = 3584; u.B = W2 + (size_t)(1536 + u.pn * 256) * 3584; u.ldb = 3584; u.nt = 4; return true; }
        L -= E2_K;
        if (L < E2_V) { u.mode = 2; u.pm = L >> 6; u.pn = L & 63; u.A = W2 + (size_t)(2560 + u.pm * 256) * 3584; u.lda = 3584; u.B = ACT2 + (size_t)u.pn * 256 * 3584 + 512 * 2; u.ldb = 3584; u.nt = 4; return true; }
        L -= E2_V;
        u.mode = 3; u.pm = L >> 2; u.aux = L & 3; u.pn = 0; u.A = ACT2 + (size_t)u.pm * 256 * 3584 + (768 + u.aux * 256) * 2; u.lda = 3584; u.B = W2 + (size_t)(3584 + u.aux * 256) * 3584; u.ldb = 3584; u.nt = 4; return true; } };
struct EpiE2 { static constexpr bool PAIR = false, F8 = false; const Params* p;
    DI void store(const Unit& u, int row, int col, float* v) const {
        const int r = u.pm * 256 + row, gc = u.pn * 256 + col;
        if (u.mode == 0) { const int dd = gc % 192; if (dd >= 128 && r >= T_CTX) rope8(*p, (r - T_CTX) & 1023, (dd - 128) >> 1, v);
#pragma unroll
            for (int i = 0; i < 8; ++i) v[i] *= QS_MLA;
            st_bf16x8(wsp<bf16_t>(*p, WS_Q) + (size_t)r * 1536 + gc, v); }
        else if (u.mode == 1) st_bf16x8(wsp<bf16_t>(*p, WS_KN) + (size_t)r * 1024 + gc, v);
        else if (u.mode == 2) st_bf16x8(wsp<bf16_t>(*p, WS_VT) + (size_t)r * TX + gc, v);
        else { const float* ps = p->in[16] + u.aux * 256 + col;
#pragma unroll
            for (int i = 0; i < 8; ++i) v[i] *= ps[i];
            st_bf16x8(wsp<bf16_t>(*p, WS_MIX) + (size_t)r * 2048 + 1024 + u.aux * 256 + col, v); }
    } };

struct SchedOut { const Params* p; int G, c, l;
    DI bool next(int i, Unit& u) const { const int L = i * G + c; if (L >= 48 * 8) return false; u.pm = L >> 3; u.pn = L & 7;
        u.A = (const char*)wsp<bf16_t>(*p, WS_MIX) + (size_t)u.pm * 256 * 4096; u.B = (const char*)wsp<bf16_t>(*p, l == 0 ? WS_WOUTE : WS_WOUTO) + (size_t)u.pn * 256 * 4096; u.lda = 4096; u.ldb = 4096; u.nt = 32; u.mode = 0; u.aux = 0; return true; } };
struct EpiOut { static constexpr bool PAIR = false, F8 = false; const Params* p; int l;
    DI void store(const Unit& u, int row, int col, float* v) const {
        const int r = u.pm * 256 + row, gc = u.pn * 256 + col;
        const float* x = (l == 0 ? xrow_in(*p, r) : wsp<float>(*p, WS_XL) + (size_t)r * D) + gc; const float* g1 = modp(*p, l, cond_of_row(r), 2) + gc;
        const f32x4 x0 = *(const f32x4*)x, x1 = *(const f32x4*)(x + 4), g0 = *(const f32x4*)g1, g4 = *(const f32x4*)(g1 + 4);
#pragma unroll
        for (int i = 0; i < 4; ++i) { v[i] = DN_ALPHA * x0[i] + g0[i] * v[i]; v[4 + i] = DN_ALPHA * x1[i] + g4[i] * v[4 + i]; }
        st_f32x8(wsp<float>(*p, WS_Y) + (size_t)r * D + gc, v);
    } };

struct SchedGU { const Params* p; int G, c, l;
    DI bool next(int i, Unit& u) const { const int L = i * G + c; if (L >= 16 * 96) return false; const int e = L / 96, rem = L % 96; u.pn = rem / 6; u.pm = e * 6 + rem % 6; u.aux = e;
        constexpr unsigned P = MOE_F8 ? 2048 : 4096;
        u.A = (const char*)wsp<bf16_t>(*p, WS_XS) + (size_t)u.pm * 256 * P; u.B = (const char*)wsp<bf16_t>(*p, WS_WGU) + ((size_t)(l * 16 + e) * 4096 + (size_t)u.pn * 256) * P; u.lda = P; u.ldb = P; u.nt = MOE_F8 ? 16 : 32; u.mode = 0; return true; } };
struct EpiGU { static constexpr bool PAIR = true, F8 = MOE_F8 != 0; const Params* p;
    DI void store2(const Unit& u, int row, int col, const float* g, const float* up) const {
        float h[8];
#pragma unroll
        for (int i = 0; i < 8; ++i) { const float gg = MOE_F8 ? g[i] * (1.f / GU_WSCALE) : g[i], uu = MOE_F8 ? up[i] * (1.f / GU_WSCALE) : up[i]; h[i] = gg / (1.f + __expf(-gg)) * uu; }
        if (MOE_F8) { u32x2 o; o.x = pk4_fp8(h[0], h[1], h[2], h[3]); o.y = pk4_fp8(h[4], h[5], h[6], h[7]); *(u32x2*)((unsigned char*)wsp<bf16_t>(*p, WS_HID) + (size_t)(u.pm * 256 + row) * D + u.pn * 128 + col) = o; }
        else st_bf16x8(wsp<bf16_t>(*p, WS_HID) + (size_t)(u.pm * 256 + row) * D + u.pn * 128 + col, h);
    } };

struct SchedDown { const Params* p; int G, c, l;
    DI bool next(int i, Unit& u) const { const int L = i * G + c; if (L >= 16 * 48) return false; const int e = L / 48, rem = L % 48; u.pn = rem / 6; u.pm = e * 6 + rem % 6; u.aux = e;
        constexpr unsigned P = MOE_F8 ? 2048 : 4096;
        u.A = (const char*)wsp<bf16_t>(*p, WS_HID) + (size_t)u.pm * 256 * P; u.B = (const char*)wsp<bf16_t>(*p, WS_WDN) + ((size_t)(l * 16 + e) * 2048 + (size_t)u.pn * 256) * P; u.lda = P; u.ldb = P; u.nt = MOE_F8 ? 16 : 32; u.mode = 0; return true; } };
struct EpiDown { static constexpr bool PAIR = false, F8 = MOE_F8 != 0; const Params* p;
    DI void store(const Unit& u, int row, int col, float* v) const {
        if (MOE_F8) {
#pragma unroll
            for (int i = 0; i < 8; ++i) v[i] *= (1.f / DN_WSCALE); }
        st_bf16x8(wsp<bf16_t>(*p, WS_YE) + (size_t)(u.pm * 256 + row) * D + u.pn * 256 + col, v); } };

constexpr int IO_QK = 48 * 9, IO_V = 16, IO_VT = 48, IO_TOTAL = IO_QK + IO_V + IO_VT;
struct SchedInOdd { const Params* p; int G, c;
    DI bool next(int i, Unit& u) const { int L = i * G + c; if (L >= IO_TOTAL) return false;
        const char* Hb = (const char*)wsp<bf16_t>(*p, WS_H); const char* W = (const char*)wsp<bf16_t>(*p, WS_WINO); u.aux = 0; u.nt = 32; u.lda = 4096; u.ldb = 4096;
        if (L < IO_QK) { u.mode = 0; u.pm = L / 9; u.pn = L % 9; u.A = Hb + (size_t)u.pm * 256 * 4096; u.B = W + (size_t)u.pn * 256 * 4096; return true; }
        L -= IO_QK;
        if (L < IO_V) { u.mode = 1; u.pm = L; u.pn = 9; u.A = Hb + (size_t)u.pm * 256 * 4096; u.B = W + (size_t)9 * 256 * 4096; return true; }
        L -= IO_V;
        u.mode = 2; u.pm = 0; u.pn = L; u.A = W + (size_t)9 * 256 * 4096; u.B = Hb + (size_t)u.pn * 256 * 4096; return true; } };
struct EpiInOdd { static constexpr bool PAIR = false, F8 = false; const Params* p;
    DI void store(const Unit& u, int row, int col, float* v) const {
        const int r = u.pm * 256 + row, gc = u.pn * 256 + col;
        if (u.mode == 0) {
            if (gc < 2048) { if (r >= T_CTX) rope8(*p, (r - T_CTX) & 1023, (gc & 63) >> 1, v);
#pragma unroll
                for (int i = 0; i < 8; ++i) v[i] *= QS_SWA;
                st_bf16x8(wsp<bf16_t>(*p, WS_Q) + (size_t)r * 2048 + gc, v); }
            else { const int kc = gc - 2048; if (r < T_CTX) st_f32x8(p->out + O_SK + (size_t)r * 256 + kc, v); else rope8(*p, (r - T_CTX) & 1023, (kc & 63) >> 1, v);
                st_bf16x8(wsp<bf16_t>(*p, WS_KO) + (size_t)r * 256 + kc, v); } }
        else if (u.mode == 1) st_f32x8(p->out + O_SV + (size_t)r * 256 + col, v);
        else st_bf16x8(wsp<bf16_t>(*p, WS_VTO) + (size_t)row * TX + gc, v);
    } };

namespace pg8 {
typedef short bf16x8 __attribute__((ext_vector_type(8)));
typedef int i32x4 __attribute__((ext_vector_type(4)));
typedef int i32x8 __attribute__((ext_vector_type(8)));
DI i32x8 cat8(bf16x8 lo, bf16x8 hi) { return __builtin_shufflevector(__builtin_bit_cast(i32x4, lo), __builtin_bit_cast(i32x4, hi), 0, 1, 2, 3, 4, 5, 6, 7); }
constexpr int BM = 256, BK = 64, HALF = 128, HTB = HALF * BK * 2  , STAGE_BYTES = 8 * HTB;
DI int lds_byte(int r, int c) { const int st = (r >> 4) * 2 + (c >> 5), rr = r & 15, cc = c & 31, ob = rr * 64 + cc * 2; return st * 1024 + (ob ^ (((ob >> 9) & 1) << 5)); }
DI void stage_rc(int b, int& R, int& C) { const int st = b / 1024, sb = b % 1024, swz = sb ^ (((sb >> 9) & 1) << 5); R = (st >> 1) * 16 + swz / 64; C = (st & 1) * 32 + (swz % 64) / 2; }
DI int perm32(int rho) { const int n = rho >> 4, i = rho & 15; return 8 * (i >> 2) + 4 * n + (i & 3); }

template <bool F8> struct Frag;
template <> struct Frag<false> { bf16x8 k0, k1; DI void set(bf16x8 a, bf16x8 b) { k0 = a; k1 = b; } };
template <> struct Frag<true> { i32x8 w; DI void set(bf16x8 a, bf16x8 b) { w = cat8(a, b); } };
template <class Epi, class Sched, bool ALIGN_EPI = true>
DI void gemm_phase(LAS unsigned char* lds, const Sched& S, const Epi& E, int wid) {
    const int lane = fresh_lane(), tid = wid * 64 + lane, wr = wid >> 2, wc = wid & 3, fr = lane & 15, fq = lane >> 4;
    int RA[2], RB[2], CB[2];
#pragma unroll
    for (int i = 0; i < 2; ++i) { int R, C; stage_rc(tid * 16 + i * 8192, R, C); RA[i] = R; RB[i] = (R & ~31) + perm32(R & 31); CB[i] = C * 2; }
    constexpr size_t kstep = (size_t)(BK * 2);
    const unsigned ldsw = (unsigned)wid * 1024u;
    const int aoff = lds_byte(wr * 64 + fr, fq * 8), boff = lds_byte(wc * 32 + fr, fq * 8);
#define PG8_SA(b, h) (((b) * 2 + (h)) * HTB)
#define PG8_SB(b, h) ((4 + (b) * 2 + (h)) * HTB)
#define PG8_STAGE(bufoff, gbase, v0, v1) do { unsigned o0_ = (v0), o1_ = (v1); asm volatile("" : "+v"(o0_), "+v"(o1_)); \
        __builtin_amdgcn_global_load_lds((const unsigned*)((const char*)(gbase) + o0_), (LAS unsigned*)(lds + (bufoff) + ldsw), 16, 0, 0); \
        __builtin_amdgcn_global_load_lds((const unsigned*)((const char*)(gbase) + o1_), (LAS unsigned*)(lds + (bufoff) + ldsw + 8192), 16, 0, 0); } while (0)
#define PG8_LDA(dst, b, h) do { _Pragma("unroll") for (int m = 0; m < 4; ++m) { const bf16x8 f0_ = *(const LAS bf16x8*)(lds + PG8_SA(b, h) + aoff + m * 2048), f1_ = *(const LAS bf16x8*)(lds + PG8_SA(b, h) + aoff + m * 2048 + 1024); dst[m].set(f0_, f1_); } } while (0)
#define PG8_LDB(dst, b, h) do { _Pragma("unroll") for (int n = 0; n < 2; ++n) { const bf16x8 f0_ = *(const LAS bf16x8*)(lds + PG8_SB(b, h) + boff + n * 2048), f1_ = *(const LAS bf16x8*)(lds + PG8_SB(b, h) + boff + n * 2048 + 1024); dst[n].set(f0_, f1_); } } while (0)
#define PG8_MMA(ai, bj, At, Bt) do { __builtin_amdgcn_s_setprio(1); _Pragma("unroll") for (int m = 0; m < 4; ++m) _Pragma("unroll") for (int n = 0; n < 2; ++n) { \
        if constexpr (Epi::F8) acc[ai][bj][m][n] = __builtin_amdgcn_mfma_scale_f32_16x16x128_f8f6f4(Bt[n].w, At[m].w, acc[ai][bj][m][n], 0, 0, 0, 0x7f7f7f7f, 0, 0x7f7f7f7f); \
        else { acc[ai][bj][m][n] = __builtin_amdgcn_mfma_f32_16x16x32_bf16(Bt[n].k0, At[m].k0, acc[ai][bj][m][n], 0, 0, 0); acc[ai][bj][m][n] = __builtin_amdgcn_mfma_f32_16x16x32_bf16(Bt[n].k1, At[m].k1, acc[ai][bj][m][n], 0, 0, 0); } } \
        __builtin_amdgcn_s_setprio(0); } while (0)
#define PG8_WAIT_V(n) asm volatile("s_waitcnt vmcnt(" #n ")" ::: "memory")
#define PG8_WAIT_L(n) asm volatile("s_waitcnt lgkmcnt(" #n ")" ::: "memory")
#define PG8_BAR __builtin_amdgcn_s_barrier()
#define PG8_SCHED __builtin_amdgcn_sched_barrier(0)
    Unit cur, nxt; int ui = 0;
    if (!S.next(0, cur)) return;
    f32x4 acc[2][2][4][2];
#pragma unroll
    for (int a = 0; a < 2; ++a)
#pragma unroll
        for (int b = 0; b < 2; ++b)
#pragma unroll
            for (int m = 0; m < 4; ++m)
#pragma unroll
                for (int n = 0; n < 2; ++n) acc[a][b][m][n] = (f32x4){0.f, 0.f, 0.f, 0.f};
    Frag<Epi::F8> At[4], B0[2], B1[2];
    const char* cA = cur.A; const char* cB = cur.B;
    const unsigned ld = cur.lda;
    const unsigned vA0 = RA[0] * ld + CB[0], vA1 = RA[1] * ld + CB[1], vB0 = RB[0] * ld + CB[0], vB1 = RB[1] * ld + CB[1];
    const size_t hA = (size_t)HALF * ld, hB = hA;
    PG8_STAGE(PG8_SB(0, 0), cB, vB0, vB1); PG8_STAGE(PG8_SB(0, 1), cB + hB, vB0, vB1); PG8_STAGE(PG8_SA(0, 0), cA, vA0, vA1); PG8_STAGE(PG8_SA(0, 1), cA + hA, vA0, vA1);
    if (wr == 1) PG8_BAR;
    PG8_WAIT_V(2); PG8_BAR;
    PG8_STAGE(PG8_SB(1, 0), cB + kstep, vB0, vB1); PG8_STAGE(PG8_SA(1, 0), cA + kstep, vA0, vA1); PG8_STAGE(PG8_SB(1, 1), cB + hB + kstep, vB0, vB1);
    PG8_WAIT_V(6); PG8_BAR;
    for (;;) {
        const bool has_next = S.next(ui + 1, nxt);
        const char* nA = has_next ? nxt.A : cA; const char* nB = has_next ? nxt.B : cB;
        const int nt = cur.nt;
        for (int t = 0; t < nt; t += 2) {
            const bool last = (t == nt - 2);
            const char* a1 = cA + (size_t)(t + 1) * kstep;
            const char* a2 = last ? nA : cA + (size_t)(t + 2) * kstep; const char* b2 = last ? nB : cB + (size_t)(t + 2) * kstep;
            const char* a3 = a2 + kstep; const char* b3 = b2 + kstep;
            PG8_LDB(B0, 0, 0); PG8_LDB(B1, 0, 1); PG8_SCHED; PG8_LDA(At, 0, 0); PG8_STAGE(PG8_SA(1, 1), a1 + hA, vA0, vA1);
            PG8_WAIT_V(8); PG8_WAIT_L(0); PG8_BAR; PG8_MMA(0, 0, At, B0); PG8_MMA(0, 1, At, B1); PG8_BAR; PG8_SCHED;
            PG8_LDA(At, 0, 1); PG8_STAGE(PG8_SB(0, 0), b2, vB0, vB1); PG8_STAGE(PG8_SB(0, 1), b2 + hB, vB0, vB1); PG8_STAGE(PG8_SA(0, 0), a2, vA0, vA1);
            PG8_WAIT_V(8); PG8_WAIT_L(0); PG8_BAR; PG8_MMA(1, 0, At, B0); PG8_MMA(1, 1, At, B1); PG8_BAR; PG8_SCHED;
            PG8_LDB(B0, 1, 0); PG8_LDB(B1, 1, 1); PG8_SCHED; PG8_LDA(At, 1, 0); PG8_STAGE(PG8_SA(0, 1), a2 + hA, vA0, vA1);
            PG8_WAIT_V(8); PG8_WAIT_L(0); PG8_BAR; PG8_MMA(0, 0, At, B0); PG8_MMA(0, 1, At, B1); PG8_BAR; PG8_SCHED;
            PG8_LDA(At, 1, 1); PG8_STAGE(PG8_SB(1, 0), b3, vB0, vB1); PG8_STAGE(PG8_SB(1, 1), b3 + hB, vB0, vB1); PG8_STAGE(PG8_SA(1, 0), a3, vA0, vA1);
            PG8_WAIT_V(8); PG8_WAIT_L(0); PG8_BAR; PG8_MMA(1, 0, At, B0); PG8_MMA(1, 1, At, B1); PG8_BAR; PG8_SCHED;
        }
        if constexpr (ALIGN_EPI) { if (wr == 0) PG8_BAR; }
        {
            const int el_ = fresh_lane(); const int fr_ = el_ & 15, fq_ = el_ >> 4;
#pragma unroll
            for (int ai = 0; ai < 2; ++ai)
#pragma unroll
                for (int m = 0; m < 4; ++m) { const int row = ai * HALF + wr * 64 + m * 16 + fr_;
                    if constexpr (Epi::PAIR) { float g[8], up[8];
#pragma unroll
                        for (int j = 0; j < 4; ++j) { g[j] = acc[ai][0][m][0][j]; g[4 + j] = acc[ai][0][m][1][j]; up[j] = acc[ai][1][m][0][j]; up[4 + j] = acc[ai][1][m][1][j]; }
                        E.store2(cur, row, wc * 32 + 8 * fq_, g, up); }
                    else {
#pragma unroll
                        for (int bj = 0; bj < 2; ++bj) { float v[8];
#pragma unroll
                            for (int j = 0; j < 4; ++j) { v[j] = acc[ai][bj][m][0][j]; v[4 + j] = acc[ai][bj][m][1][j]; }
                            E.store(cur, row, bj * HALF + wc * 32 + 8 * fq_, v); } } }
        }
        if (!has_next) break;
#pragma unroll
        for (int a = 0; a < 2; ++a)
#pragma unroll
            for (int b = 0; b < 2; ++b)
#pragma unroll
                for (int m = 0; m < 4; ++m)
#pragma unroll
                    for (int n = 0; n < 2; ++n) acc[a][b][m][n] = (f32x4){0.f, 0.f, 0.f, 0.f};
        cur = nxt; cA = nA; cB = nB; ++ui;
        if constexpr (ALIGN_EPI) { if (wr == 1) PG8_BAR; }
    }
    PG8_WAIT_V(0);
    if constexpr (!ALIGN_EPI) { if (wr == 0) PG8_BAR; }
    PG8_BAR;
#undef PG8_SA
#undef PG8_SB
#undef PG8_STAGE
#undef PG8_LDA
#undef PG8_LDB
#undef PG8_MMA
#undef PG8_WAIT_V
#undef PG8_WAIT_L
#undef PG8_BAR
#undef PG8_SCHED
}
}

namespace att {
typedef short bf16x8 __attribute__((ext_vector_type(8)));
typedef short s16x4 __attribute__((ext_vector_type(4)));
typedef float f32x16 __attribute__((ext_vector_type(16)));
typedef float f32x2_t __attribute__((ext_vector_type(2)));
typedef __bf16 bf16x2_t __attribute__((ext_vector_type(2)));
DI unsigned cvtpk(float lo, float hi) { f32x2_t v = {lo, hi}; bf16x2_t b = __builtin_convertvector(v, bf16x2_t); return __builtin_bit_cast(unsigned, b); }
DI int crow(int r, int h) { return (r & 3) + 8 * (r >> 2) + 4 * h; }

template <bool SWA>
DI void attn_phase(const Params& p, LAS unsigned char* lds, int G, int c) {
    constexpr int DK = SWA ? 64 : 192, DV = SWA ? 64 : 128, KSTR = DK * 2 + 16, VSTR = 136;
    constexpr int KB = 64 * KSTR, VB = DV * VSTR, STG = KB + VB;
    constexpr int CPR = DK / 8, NKC = (64 * CPR) / NTHREADS, NVC = (DV * 8) / NTHREADS, NQ = DK / 16, NDV = DV / 32;
    constexpr int LDQ = SWA ? 2048 : 1536, NUNITS = SWA ? 1536 : 384;
    static_assert(2 * STG <= 131072, "attention LDS");
    const int tid = threadIdx.x, lane = tid & 63, wid = __builtin_amdgcn_readfirstlane(tid >> 6), q = lane & 31, hh = lane >> 5;
    const bf16_t* Q = wsp<bf16_t>(p, WS_Q); const bf16_t* KN = wsp<bf16_t>(p, SWA ? WS_KO : WS_KN); const bf16_t* KPE = wsp<bf16_t>(p, WS_KPE);
    const bf16_t* VT = wsp<bf16_t>(p, SWA ? WS_VTO : WS_VT); bf16_t* MIX = wsp<bf16_t>(p, WS_MIX);
    for (int L = c; L < NUNITS; L += G) {
        int rowbase, hk, nt0, nt1, key0a, key0b = 0, kpos0 = 0, qpos0 = 0; bool masked = false;
        if (!SWA) {
            if (L < 256) { const int b = L >> 5, qt = L & 3; hk = (L >> 2) & 7; rowbase = T_CTX + b * 1024 + qt * 256; key0a = T_CTX + b * 1024; nt0 = 16; key0b = T + b * 512; nt1 = 8; }
            else { const int Lc = L - 256, b = Lc >> 3; hk = Lc & 7; rowbase = b * 256; key0a = b * 256; nt0 = 4; nt1 = 0; }
        } else {
            if (L < 1024) { const int b = L >> 7, t0 = (L & 31) * 32; hk = (L >> 5) & 3; rowbase = T_CTX + b * 1024 + t0;
                const int lo = max(t0 - 128, 0) & ~63, hi = min((t0 + 160 + 63) & ~63, 1024);
                key0a = T_CTX + b * 1024 + lo; nt0 = (hi - lo) >> 6; kpos0 = lo; qpos0 = t0; masked = true; key0b = T + b * 512; nt1 = 8; }
            else { const int Lc = L - 1024, b = Lc >> 5; hk = (Lc >> 3) & 3; rowbase = b * 256 + (Lc & 7) * 32; key0a = b * 256; nt0 = 4; nt1 = 0; }
        }
        const int total = nt0 + nt1;
        const int qrow = SWA ? rowbase + q : rowbase + wid * 32 + q;
        const int qhead = SWA ? hk * 8 + wid : hk;
        bf16x8 qf[NQ];
#pragma unroll
        for (int s = 0; s < NQ; ++s) qf[s] = *(const bf16x8*)(Q + (size_t)qrow * LDQ + qhead * DK + 16 * s + 8 * hh);
        f32x16 o[NDV];
#pragma unroll
        for (int d = 0; d < NDV; ++d)
#pragma unroll
            for (int r = 0; r < 16; ++r) o[d][r] = 0.f;
        float m = SWA ? p.in[19][qhead] * LOG2E : -1e30f, l = (SWA && hh == 0) ? 1.f : 0.f;
        const int qpos = qpos0 + q;
        u32x4 kreg[NKC], vreg[NVC];
#define ATT_LOAD(t_) do { const int tt_ = (t_); const int kb_ = tt_ < nt0 ? key0a + tt_ * 64 : key0b + (tt_ - nt0) * 64; \
            _Pragma("unroll") for (int i = 0; i < NKC; ++i) { const int ch = tid + NTHREADS * i, j = ch / CPR, cc = ch % CPR; \
                const bf16_t* src = SWA ? KN + (size_t)(kb_ + j) * 256 + hk * 64 + cc * 8 : (cc < 16 ? KN + (size_t)(kb_ + j) * 1024 + hk * 128 + cc * 8 : KPE + (size_t)(kb_ + j) * 64 + (cc - 16) * 8); \
                kreg[i] = *(const u32x4*)src; } \
            _Pragma("unroll") for (int i = 0; i < NVC; ++i) { const int ch = tid + NTHREADS * i, dv = ch >> 3, cc = ch & 7; \
                vreg[i] = *(const u32x4*)(VT + (size_t)(hk * DV + dv) * TX + kb_ + cc * 8); } } while (0)
#define ATT_WRITE(buf_) do { LAS unsigned char* Kw = lds + (buf_) * STG; LAS unsigned char* Vw = Kw + KB; \
            _Pragma("unroll") for (int i = 0; i < NKC; ++i) { const int ch = tid + NTHREADS * i, j = ch / CPR, cc = ch % CPR; *(LAS u32x4*)(Kw + j * KSTR + cc * 16) = kreg[i]; } \
            _Pragma("unroll") for (int i = 0; i < NVC; ++i) { const int ch = tid + NTHREADS * i, dv = ch >> 3, cc = ch & 7; \
                *(LAS u32x2*)(Vw + dv * VSTR + cc * 16) = (u32x2){vreg[i].x, vreg[i].y}; *(LAS u32x2*)(Vw + dv * VSTR + cc * 16 + 8) = (u32x2){vreg[i].z, vreg[i].w}; } } while (0)
        ATT_LOAD(0); ATT_WRITE(0);
        __syncthreads();
        for (int t = 0; t < total; ++t) {
            const int buf = t & 1;
            if (t + 1 < total) ATT_LOAD(t + 1);
            const LAS unsigned char* Kl = lds + buf * STG; const LAS unsigned char* Vl = Kl + KB;
            f32x16 s0, s1;
#pragma unroll
            for (int r = 0; r < 16; ++r) { s0[r] = 0.f; s1[r] = 0.f; }
#pragma unroll
            for (int s = 0; s < NQ; ++s) {
                const bf16x8 a0 = *(const LAS bf16x8*)(Kl + q * KSTR + (16 * s + 8 * hh) * 2);
                const bf16x8 a1 = *(const LAS bf16x8*)(Kl + (32 + q) * KSTR + (16 * s + 8 * hh) * 2);
                s0 = __builtin_amdgcn_mfma_f32_32x32x16_bf16(a0, qf[s], s0, 0, 0, 0);
                s1 = __builtin_amdgcn_mfma_f32_32x32x16_bf16(a1, qf[s], s1, 0, 0, 0);
            }
            if (SWA && masked && t < nt0) {
                const int kp = kpos0 + t * 64 - qpos;
#pragma unroll
                for (int r = 0; r < 16; ++r) { const int d0 = kp + crow(r, hh), d1 = d0 + 32;
                    s0[r] = (d0 >= -128 && d0 <= 128) ? s0[r] : -1e30f; s1[r] = (d1 >= -128 && d1 <= 128) ? s1[r] : -1e30f; }
            }
            float tm = fmaxf(s0[0], s1[0]);
#pragma unroll
            for (int r = 1; r < 16; ++r) tm = fmaxf(tm, fmaxf(s0[r], s1[r]));
            tm = fmaxf(tm, __shfl_xor(tm, 32));
            const float mn = fmaxf(m, tm), alpha = __builtin_amdgcn_exp2f(m - mn); m = mn;
            l *= alpha;
#pragma unroll
            for (int d = 0; d < NDV; ++d)
#pragma unroll
                for (int r = 0; r < 16; ++r) o[d][r] *= alpha;
            float ls = 0.f;
#pragma unroll
            for (int r = 0; r < 16; ++r) { s0[r] = __builtin_amdgcn_exp2f(s0[r] - m); s1[r] = __builtin_amdgcn_exp2f(s1[r] - m); ls += s0[r] + s1[r]; }
            l += ls;
            bf16x8 pb[2][2];
#pragma unroll
            for (int s = 0; s < 2; ++s) {
                u32x4 w0, w1;
                w0.x = cvtpk(s0[8 * s + 0], s0[8 * s + 1]); w0.y = cvtpk(s0[8 * s + 2], s0[8 * s + 3]); w0.z = cvtpk(s0[8 * s + 4], s0[8 * s + 5]); w0.w = cvtpk(s0[8 * s + 6], s0[8 * s + 7]);
                w1.x = cvtpk(s1[8 * s + 0], s1[8 * s + 1]); w1.y = cvtpk(s1[8 * s + 2], s1[8 * s + 3]); w1.z = cvtpk(s1[8 * s + 4], s1[8 * s + 5]); w1.w = cvtpk(s1[8 * s + 6], s1[8 * s + 7]);
                pb[0][s] = __builtin_bit_cast(bf16x8, w0); pb[1][s] = __builtin_bit_cast(bf16x8, w1);
            }
#pragma unroll
            for (int d = 0; d < NDV; ++d)
#pragma unroll
                for (int blk = 0; blk < 2; ++blk)
#pragma unroll
                    for (int s = 0; s < 2; ++s) {
                        const LAS unsigned char* vp = Vl + (d * 32 + q) * VSTR + (blk * 32 + 16 * s + 4 * hh) * 2;
                        const s16x4 lo = *(const LAS s16x4*)vp, hi = *(const LAS s16x4*)(vp + 16);
                        const bf16x8 a = {lo[0], lo[1], lo[2], lo[3], hi[0], hi[1], hi[2], hi[3]};
                        o[d] = __builtin_amdgcn_mfma_f32_32x32x16_bf16(a, pb[blk][s], o[d], 0, 0, 0);
                    }
            if (t + 1 < total) ATT_WRITE(buf ^ 1);
            __syncthreads();
        }
#undef ATT_LOAD
#undef ATT_WRITE
        const float inv = 1.f / (l + __shfl_xor(l, 32));
        bf16_t* orow = MIX + (size_t)qrow * 2048 + qhead * DV;
#pragma unroll
        for (int d = 0; d < NDV; ++d)
#pragma unroll
            for (int g = 0; g < 4; ++g) { u32x2 w; w.x = cvtpk(o[d][4 * g] * inv, o[d][4 * g + 1] * inv); w.y = cvtpk(o[d][4 * g + 2] * inv, o[d][4 * g + 3] * inv);
                *(u32x2*)(orow + d * 32 + 8 * g + 4 * hh) = w; }
    }
}
}


#ifndef R_PRO
#define R_PRO 1
#endif
#ifndef R_MOE
#define R_MOE 1
#endif
#ifndef R_ATT
#define R_ATT 1
#endif
#ifndef R_GEMM
#define R_GEMM 1
#endif
#ifndef R_THIN
#define R_THIN 1
#endif
#ifndef R_LN1
#define R_LN1 1
#endif
#ifndef R_LN2
#define R_LN2 1
#endif
#ifndef R_TOPK
#define R_TOPK 1
#endif
#define REP(n) for (int _r = 0; _r < (n); ++_r)
#define REPS(n, ...) do { { __VA_ARGS__ } if ((n) > 1) { __VA_ARGS__ } } while (0)
constexpr int LDS_BYTES = 147456, MISC_OFF = 146432;
constexpr int NPH = 20;
constexpr int CV_IDLE = 7680;
__global__ void __launch_bounds__(NTHREADS, 2) mega(Params p) {
    extern __shared__ __attribute__((aligned(16))) unsigned char lds[];
    const int G = gridDim.x, c = vcu_of(blockIdx.x, G), wid = __builtin_amdgcn_readfirstlane(threadIdx.x >> 6);
    volatile LAS unsigned* MISC = (volatile LAS unsigned*)((LAS unsigned char*)lds + MISC_OFF);
    if (threadIdx.x < 4) MISC[threadIdx.x] = 0u;
    __syncthreads();
    XcdBarrier bar = xcd_barrier_post((unsigned*)(p.ws + WS_CTL) + CW_BAR, MISC);
    const int lo = p.ph_lo, hi = p.ph_hi;
#define IN(k) (lo <= (k) && (k) < hi)
#define SEAM(k) do { if (IN(k) && IN((k) + 1)) xcd_barrier(bar); } while (0)
    if (IN(0)) REP(R_PRO) { ph_mod(p, lds); ph_misc(p); ph_convert(p, 0, G == 256 ? CV_TOTAL - 2 * CV_IDLE : CV_TOTAL, blockIdx.x, G);
#ifdef RD_PAT
        ph_readonly<RD_PAT>(p);
#endif
    } SEAM(0);
    if (IN(1)) REP(R_THIN) { ph_h0(p); } SEAM(1);
    if (IN(2)) { REPS(R_GEMM, SchedInEven S{&p, G, c}; EpiInEven E{&p}; pg8::gemm_phase((LAS unsigned char*)lds, S, E, wid);); if (G == 256 && c >= 128) ph_convert(p, CV_TOTAL - 2 * CV_IDLE, CV_TOTAL - CV_IDLE, c - 128, 128); } SEAM(2);
    if (IN(3)) REP(R_THIN) { ph_e1(p); } SEAM(3);
    if (IN(4)) REPS(R_GEMM, SchedE2 S{&p, G, c}; EpiE2 E{&p}; pg8::gemm_phase((LAS unsigned char*)lds, S, E, wid);); SEAM(4);
    if (IN(5)) REP(R_ATT) { att::attn_phase<false>(p, (LAS unsigned char*)lds, G, c); } SEAM(5);
    if (IN(6)) { REPS(R_GEMM, SchedOut S{&p, G, c, 0}; EpiOut E{&p, 0}; pg8::gemm_phase((LAS unsigned char*)lds, S, E, wid);); if (G == 256 && c >= 128) ph_convert(p, CV_TOTAL - CV_IDLE, CV_TOTAL, c - 128, 128); } SEAM(6);
    if (IN(7)) REP(R_LN1) { ph_ln1(p, 0, lds); } SEAM(7);
    if (IN(8)) REP(R_TOPK) { ph_topk(p, lds); } SEAM(8);
    if (IN(9)) REPS(R_MOE, SchedGU S{&p, G, c, 0}; EpiGU E{&p}; pg8::gemm_phase((LAS unsigned char*)lds, S, E, wid);); SEAM(9);
    if (IN(10)) REPS(R_MOE, SchedDown S{&p, G, c, 0}; EpiDown E{&p}; pg8::gemm_phase((LAS unsigned char*)lds, S, E, wid);); SEAM(10);
    if (IN(11)) REP(R_LN2) { ph_ln2(p, 0); } SEAM(11);
    if (IN(12)) REPS(R_GEMM, SchedInOdd S{&p, G, c}; EpiInOdd E{&p}; pg8::gemm_phase((LAS unsigned char*)lds, S, E, wid);); SEAM(12);
    if (IN(13)) REP(R_ATT) { att::attn_phase<true>(p, (LAS unsigned char*)lds, G, c); } SEAM(13);
    if (IN(14)) REPS(R_GEMM, SchedOut S{&p, G, c, 1}; EpiOut E{&p, 1}; pg8::gemm_phase((LAS unsigned char*)lds, S, E, wid);); SEAM(14);
    if (IN(15)) REP(R_LN1) { ph_ln1(p, 1, lds); } SEAM(15);
    if (IN(16)) REP(R_TOPK) { ph_topk(p, lds); } SEAM(16);
    if (IN(17)) REPS(R_MOE, SchedGU S{&p, G, c, 1}; EpiGU E{&p}; pg8::gemm_phase((LAS unsigned char*)lds, S, E, wid);); SEAM(17);
    if (IN(18)) REPS(R_MOE, SchedDown S{&p, G, c, 1}; EpiDown E{&p}; pg8::gemm_phase((LAS unsigned char*)lds, S, E, wid);); SEAM(18);
    if (IN(19)) REP(R_LN2) { ph_ln2(p, 1); }
#undef IN
#undef SEAM
}

extern "C" void kernel_launch(void* const* d_in, const int* in_sizes, int n_in, void* d_out, int out_size, void* d_ws, size_t ws_size, hipStream_t stream) {
    static int grid = 0;
    if (grid == 0) {
        if (n_in != 29 || out_size != (int)O_END || ws_size < WS_END) { fprintf(stderr, "kernel_launch: unexpected shapes (n_in %d out %d ws %zu need %zu)\n", n_in, out_size, ws_size, (size_t)WS_END); grid = -1; return; }
        int dev = 0, cus = 0, per_cu = 0;
        if (hipGetDevice(&dev) != hipSuccess || hipDeviceGetAttribute(&cus, hipDeviceAttributeMultiprocessorCount, dev) != hipSuccess) { grid = -1; return; }
        if (hipFuncSetAttribute((const void*)mega, hipFuncAttributeMaxDynamicSharedMemorySize, LDS_BYTES) != hipSuccess) { fprintf(stderr, "hipFuncSetAttribute failed\n"); grid = -1; return; }
        if (hipOccupancyMaxActiveBlocksPerMultiprocessor(&per_cu, (const void*)mega, NTHREADS, LDS_BYTES) != hipSuccess || per_cu < 1) fprintf(stderr, "occupancy query: %d\n", per_cu);
        (void)hipGetLastError();
        grid = cus > 0 ? cus : 256;
    }
    if (grid < 0) return;
    Params p{};
    for (int i = 0; i < 29; ++i) p.in[i] = (const float*)d_in[i];
    p.out = (float*)d_out; p.ws = (unsigned char*)d_ws; p.ph_lo = 0; p.ph_hi = NPH;
    (void)hipMemsetAsync((char*)d_ws + WS_CTL, 0, CTL_BYTES, stream);
    hipLaunchKernelGGL(mega, dim3(grid), dim3(NTHREADS), LDS_BYTES, stream, p);
}
```

```cpp
#include <hip/hip_runtime.h>
#include <cstdio>
#include <cstdint>

constexpr int D = 2048, T_CTX = 4096, T = 12288, TC = 4096, TX = 16384;
constexpr int MODW = 12288, NCOND = 9;
constexpr int NSLOT = 1536, NXS = 16 * NSLOT;
constexpr float DN_ALPHA = 1.41421356237309515f;
constexpr float LOG2E = 1.44269504088896341f;
constexpr float QS_MLA = 0.07216878364870322f * LOG2E;
constexpr float QS_SWA = 0.125f * LOG2E;
constexpr int NTHREADS = 512, NWAVES = 8;
#ifndef MOE_F8
#define MOE_F8 1
#endif
constexpr float GU_WSCALE = 32.f, DN_WSCALE = 64.f;

constexpr size_t O_Y = 0, O_CKV = 25165824, O_KPE = 26214400, O_SK = 26476544, O_SV = 27525120, O_END = 28573696;

constexpr size_t al256(size_t x) { return (x + 255) & ~(size_t)255; }
constexpr size_t WS_CTL = 0, CTL_BYTES = 1u << 20;
constexpr size_t WS_MOD = WS_CTL + CTL_BYTES;
constexpr size_t WS_ROPE = WS_MOD + al256((size_t)2 * 9 * 12288 * 4);
constexpr size_t WS_WINE = WS_ROPE + al256((size_t)2 * 1024 * 32 * 4);
constexpr size_t WS_W2 = WS_WINE + (size_t)2048 * 2048 * 2;
constexpr size_t WS_WOUTE = WS_W2 + (size_t)4608 * 1792 * 2;
constexpr size_t WS_WINO = WS_WOUTE + (size_t)2048 * 2048 * 2;
constexpr size_t WS_WOUTO = WS_WINO + (size_t)2560 * 2048 * 2;
constexpr size_t WS_WGU = WS_WOUTO + (size_t)2048 * 2048 * 2;
constexpr size_t WS_WDN = WS_WGU + (size_t)32 * 4096 * 2048 * 2;
constexpr size_t WS_H = WS_WDN + (size_t)32 * 2048 * 2048 * 2;
constexpr size_t WS_PJ = WS_H + (size_t)T * 2048 * 2;
constexpr size_t WS_ACT2 = WS_PJ + (size_t)T * 1792 * 4;
constexpr size_t WS_KPE = WS_ACT2 + (size_t)TX * 1792 * 2;
constexpr size_t WS_Q = WS_KPE + (size_t)TX * 64 * 2;
constexpr size_t WS_KN = WS_Q + (size_t)T * 2048 * 2;
constexpr size_t WS_VT = WS_KN + (size_t)TX * 1024 * 2;
constexpr size_t WS_VTO = WS_VT + (size_t)1024 * TX * 2;
constexpr size_t WS_KO = WS_VTO + (size_t)256 * TX * 2;
constexpr size_t WS_MIX = WS_KO + (size_t)TX * 256 * 2;
constexpr size_t WS_Y = WS_MIX + (size_t)T * 2048 * 2;
constexpr size_t WS_X1 = WS_Y + (size_t)T * 2048 * 4;
constexpr size_t WS_XL = WS_X1 + (size_t)T * 2048 * 4;
constexpr size_t WS_AFF = WS_XL + (size_t)T * 2048 * 4;
constexpr size_t WS_INV = WS_AFF + (size_t)T * 16 * 4;
constexpr size_t WS_XS = WS_INV + (size_t)T * 16 * 4;
constexpr size_t WS_HID = WS_XS + (size_t)NXS * 2048 * 2;
constexpr size_t WS_YE = WS_HID + (size_t)NXS * 2048 * 2;
constexpr size_t WS_AFFT = WS_YE + (size_t)NXS * 2048 * 2;
constexpr size_t WS_H8 = WS_AFFT + (size_t)T * 16 * 4;
constexpr size_t WS_STAT = WS_H8 + (size_t)T * 2048;
constexpr size_t WS_MODP = WS_STAT + (size_t)T * 8;
constexpr size_t WS_DBG = WS_MODP + (size_t)4 * 2 * 9 * 12288 * 4;
constexpr size_t WS_END = WS_DBG + (1u << 20);

typedef unsigned short bf16_t;
typedef float f32x4 __attribute__((ext_vector_type(4)));
typedef unsigned u32x4 __attribute__((ext_vector_type(4)));
typedef unsigned u32x2 __attribute__((ext_vector_type(2)));
typedef float f32x2 __attribute__((ext_vector_type(2)));
#define LAS __attribute__((address_space(3)))
#define DI __device__ __forceinline__

struct Params {
    const float* in[29];
    float* out;
    unsigned char* ws;
    int ph_lo, ph_hi;
};

DI unsigned f2bf(float f) { unsigned u = __float_as_uint(f); return (u + 0x7fffu + ((u >> 16) & 1u)) >> 16; }
DI unsigned pk2(float lo, float hi) { return f2bf(lo) | (f2bf(hi) << 16); }
DI unsigned pk4_fp8(float a, float b, float c, float d) { unsigned w = 0; w = __builtin_amdgcn_cvt_pk_fp8_f32(a, b, w, false); w = __builtin_amdgcn_cvt_pk_fp8_f32(c, d, w, true); return w; }
DI float bf2f(unsigned b) { return __uint_as_float(b << 16); }
DI float bflo(unsigned w) { return __uint_as_float(w << 16); }
DI float bfhi(unsigned w) { return __uint_as_float(w & 0xffff0000u); }
DI float wave_sum(float v) {
#pragma unroll
    for (int o = 1; o < 64; o <<= 1) v += __shfl_xor(v, o);
    return v;
}
DI float wave_max(float v) {
#pragma unroll
    for (int o = 1; o < 64; o <<= 1) v = fmaxf(v, __shfl_xor(v, o));
    return v;
}
DI int fresh_lane() { int l = (int)__builtin_amdgcn_mbcnt_hi(~0u, __builtin_amdgcn_mbcnt_lo(~0u, 0u)); asm volatile("" : "+v"(l)); return l; }
DI int cond_of_row(int r) { return r < T_CTX ? 0 : 1 + ((r - T_CTX) >> 10); }
DI const float* xrow_in(const Params& p, int r) { return r < T_CTX ? p.in[0] + (size_t)r * D : p.in[1] + (size_t)(r - T_CTX) * D; }

DI float* ws_mod(const Params& p) { return (float*)(p.ws + WS_MOD); }
DI float* ws_cos(const Params& p) { return (float*)(p.ws + WS_ROPE); }
DI float* ws_sin(const Params& p) { return (float*)(p.ws + WS_ROPE) + 1024 * 32; }
template <class X> DI X* wsp(const Params& p, size_t off) { return (X*)(p.ws + off); }
DI const float* modp(const Params& p, int l, int ci, int j) { return ws_mod(p) + ((size_t)(l * 9 + ci) * MODW + (size_t)j * D); }

#define XB_TMO      128
#define XB_XCNT(j)  (256  + 64 * (j))
#define XB_XSUB(j)  (1280 + 64 * (j))
#define XB_XGEN(j)  (2304 + 64 * (j))
#define XB_TOP      3328
#define XB_TOPGEN   3392
#define XCD_BAR_WORDS 3456
#define XB_SPIN_CAP (1u << 18)

__device__ __forceinline__ unsigned xb_ld(unsigned* p)              { return __hip_atomic_load(p, __ATOMIC_RELAXED, __HIP_MEMORY_SCOPE_AGENT); }
__device__ __forceinline__ unsigned xb_add(unsigned* p, unsigned v) { return __hip_atomic_fetch_add(p, v, __ATOMIC_RELAXED, __HIP_MEMORY_SCOPE_AGENT); }
__device__ __forceinline__ unsigned xb_xcc_id() { return (unsigned)__builtin_amdgcn_s_getreg((3 << 11) | 20) & 0xFu; }
#define XB_SPIN(cond, bar) do { unsigned _sp = 0; while (cond) { __builtin_amdgcn_s_sleep(1); \
    if ((++_sp & 255u) == 0u) { if (xb_ld(&(bar)[XB_TMO])) break; if (_sp > XB_SPIN_CAP) { atomicAdd(&(bar)[XB_TMO], 1u); break; } } } } while (0)

struct XcdBarrier {
    unsigned* bar; unsigned x;
    volatile LAS unsigned* st;
};

__device__ __forceinline__ XcdBarrier xcd_barrier_post(unsigned* bar, volatile LAS unsigned* st) {
    XcdBarrier b; b.bar = bar; b.x = xb_xcc_id(); b.st = st;
    if (threadIdx.x == 0) (void)xb_add(&bar[XB_XCNT(b.x)], 1u);
    return b;
}
__device__ __forceinline__ void xcd_barrier_complete(unsigned* bar, unsigned x, unsigned& nloc, unsigned& nx) {
    const unsigned G = gridDim.x * gridDim.y * gridDim.z;
    unsigned sum, cnt, mine, sp = 0u;
    for (;;) {
        sum = 0u; cnt = 0u; mine = 0u;
#pragma unroll
        for (unsigned j = 0; j < 16; ++j) { const unsigned c = xb_ld(&bar[XB_XCNT(j)]); sum += c; cnt += (c > 0u) ? 1u : 0u; mine = (j == x) ? c : mine; }
        if (sum == G) break;
        __builtin_amdgcn_s_sleep(1);
        if ((++sp & 255u) == 0u) { if (xb_ld(&bar[XB_TMO])) break; if (sp > XB_SPIN_CAP) { atomicAdd(&bar[XB_TMO], 1u); break; } }
    }
    nloc = mine > 0u ? mine : 1u; nx = cnt > 0u ? cnt : 1u;
}

__device__ __forceinline__ void xcd_barrier(const XcdBarrier& b) {
    asm volatile("s_waitcnt vmcnt(0)" ::: "memory");
    __syncthreads();
    if (threadIdx.x == 0) {
        unsigned* bar = b.bar;
        __builtin_amdgcn_s_waitcnt(0);
        unsigned nloc = b.st[0], nx = b.st[1];
        if (nloc == 0u) { xcd_barrier_complete(bar, b.x, nloc, nx); b.st[0] = nloc; b.st[1] = nx; }
        const unsigned old = xb_add(&bar[XB_XSUB(b.x)], 1u);
        const unsigned gen = old / nloc;
        if (old + 1u == (gen + 1u) * nloc) {
            __builtin_amdgcn_fence(__ATOMIC_RELEASE, "agent");
            asm volatile("s_waitcnt vmcnt(0)" ::: "memory");
            const unsigned og = xb_add(&bar[XB_TOP], 1u);
            const unsigned tg = og / nx;
            if (og + 1u == (tg + 1u) * nx) xb_add(&bar[XB_TOPGEN], 1u);
            else XB_SPIN(xb_ld(&bar[XB_TOPGEN]) == tg, bar);
            __builtin_amdgcn_fence(__ATOMIC_ACQUIRE, "agent");
            xb_add(&bar[XB_XGEN(b.x)], 1u);
            asm volatile("s_waitcnt vmcnt(0)" ::: "memory");
        } else {
            XB_SPIN(xb_ld(&bar[XB_XGEN(b.x)]) == gen, bar);
            __builtin_amdgcn_fence(__ATOMIC_ACQUIRE, "agent");
            asm volatile("s_waitcnt vmcnt(0)" ::: "memory");
        }
    }
    __syncthreads();
}
constexpr int CW_BAR = 4096;


DI void ph_mod(const Params& p, unsigned char* lds_raw) {
    float* s_q = (float*)lds_raw;
    float* red = s_q + 9 * 512;
    const int tid = threadIdx.x, lane = tid & 63, wave = __builtin_amdgcn_readfirstlane(tid >> 6);
    const float* c = p.in[6]; const float* c_ctx = p.in[7]; const float* w_ada = p.in[8];
    float* MODP = wsp<float>(p, WS_MODP);
    for (int it = blockIdx.x; it < 384; it += gridDim.x) {
        const int l = it / 192, rem = it % 192, cg = rem >> 2, kq4 = rem & 3;
        for (int i = tid; i < 9 * 512; i += NTHREADS) { const int ci = i >> 9, k = kq4 * 512 + (i & 511); const float v = ci == 0 ? c_ctx[k] : c[(ci - 1) * 2048 + k]; s_q[i] = v / (1.f + expf(-v)); }
        __syncthreads();
        const float* w = w_ada + ((size_t)l * 2048 + kq4 * 512 + wave * 64) * MODW + cg * 256 + 4 * lane;
        float acc[9][4];
#pragma unroll
        for (int ci = 0; ci < 9; ++ci)
#pragma unroll
            for (int j = 0; j < 4; ++j) acc[ci][j] = 0.f;
#pragma unroll 8
        for (int kk = 0; kk < 64; ++kk) {
            const f32x4 wv = __builtin_nontemporal_load((const f32x4*)(w + (size_t)kk * MODW));
#pragma unroll
            for (int ci = 0; ci < 9; ++ci) { const float s = s_q[ci * 512 + wave * 64 + kk];
#pragma unroll
                for (int j = 0; j < 4; ++j) acc[ci][j] += s * wv[j]; }
        }
#pragma unroll
        for (int ci = 0; ci < 9; ++ci) *(f32x4*)(red + (wave * 9 + ci) * 256 + 4 * lane) = (f32x4){acc[ci][0], acc[ci][1], acc[ci][2], acc[ci][3]};
        __syncthreads();
        for (int o = tid; o < 9 * 256; o += NTHREADS) { const int ci = o >> 8, cc = o & 255; float s = 0.f;
#pragma unroll
            for (int w8 = 0; w8 < 8; ++w8) s += red[(w8 * 9 + ci) * 256 + cc];
            MODP[((size_t)(kq4 * 2 + l) * 9 + ci) * MODW + cg * 256 + cc] = s; }
        __syncthreads();
    }
}
DI void ph_modreduce(const Params& p) {
    const float* MODP = wsp<float>(p, WS_MODP); float* MOD = ws_mod(p); const float* b_ada = p.in[9];
    const int n4 = 2 * 9 * MODW / 4;
    for (int i = blockIdx.x * NTHREADS + threadIdx.x; i < n4; i += gridDim.x * NTHREADS) { const int e = i * 4, l = e / (9 * MODW), col = e % MODW;
        f32x4 s = *(const f32x4*)(b_ada + l * MODW + col);
#pragma unroll
        for (int q = 0; q < 4; ++q) s += *(const f32x4*)(MODP + (size_t)q * 2 * 9 * MODW + e);
        *(f32x4*)(MOD + e) = s; }
}
DI f32x4 mod_from_partials(const Params& p, int l, int ci, int j, int col) {
    const float* MODP = wsp<float>(p, WS_MODP); const size_t e = (size_t)(l * 9 + ci) * MODW + (size_t)j * D + col;
    f32x4 s = *(const f32x4*)(p.in[9] + l * MODW + j * D + col);
#pragma unroll
    for (int q = 0; q < 4; ++q) s += *(const f32x4*)(MODP + (size_t)q * 2 * 9 * MODW + e);
    return s;
}

constexpr int CV_INE = 928, CV_UQ = 192, CV_UKV = 128, CV_POOL = 64, CV_OUT = 1024, CV_INO = 1280, CV_MOE = 98304;
constexpr int CV_TOTAL = CV_INE + CV_UQ + CV_UKV + CV_POOL + CV_OUT + CV_INO + CV_OUT + CV_MOE;
DI void cvt_item(const Params& p, int item, int lane) {
    const float* src; bf16_t* dst; int K, N, ldd, nb, kb, map = 0, a = 0; float f8s = 0.f;
    if (item < CV_INE) { src = p.in[10]; dst = wsp<bf16_t>(p, WS_WINE); K = 2048; N = 1856; ldd = 2048; nb = item % 29; kb = item / 29; map = 1; }
    else if ((item -= CV_INE) < CV_UQ) { src = p.in[13]; dst = wsp<bf16_t>(p, WS_W2); K = 512; N = 1536; ldd = 1792; nb = item % 24; kb = item / 24; }
    else if ((item -= CV_UQ) < CV_UKV) { src = p.in[14]; dst = wsp<bf16_t>(p, WS_W2); K = 256; N = 2048; ldd = 1792; nb = item % 32; kb = item / 32; map = 2; }
    else if ((item -= CV_UKV) < CV_POOL) { const int g = item >> 4, r = item & 15; src = p.in[15] + (size_t)g * 65536; dst = wsp<bf16_t>(p, WS_W2); K = 256; N = 256; ldd = 1792; nb = r & 3; kb = r >> 2; a = 3584 + g * 256; }
    else if ((item -= CV_POOL) < CV_OUT) { src = p.in[17]; dst = wsp<bf16_t>(p, WS_WOUTE); K = 2048; N = 2048; ldd = 2048; nb = item & 31; kb = item >> 5; }
    else if ((item -= CV_OUT) < CV_INO) { src = p.in[18]; dst = wsp<bf16_t>(p, WS_WINO); K = 2048; N = 2560; ldd = 2048; nb = item % 40; kb = item / 40; }
    else if ((item -= CV_INO) < CV_OUT) { src = p.in[20]; dst = wsp<bf16_t>(p, WS_WOUTO); K = 2048; N = 2048; ldd = 2048; nb = item & 31; kb = item >> 5; }
    else { item -= CV_OUT; const int mat = item >> 10, w = item & 1023, le = mat / 3, kind = mat % 3; K = 2048; N = 2048; ldd = 2048; nb = w & 31; kb = w >> 5;
        src = p.in[24 + kind] + (size_t)le * 2048 * 2048;
        if (kind == 2) dst = wsp<bf16_t>(p, WS_WDN) + (size_t)le * 2048 * 2048; else { dst = wsp<bf16_t>(p, WS_WGU) + (size_t)le * 4096 * 2048; map = 3; a = kind * 128; }
        if (MOE_F8) { f8s = kind == 2 ? DN_WSCALE : GU_WSCALE; dst = (bf16_t*)((unsigned char*)(kind == 2 ? wsp<bf16_t>(p, WS_WDN) : wsp<bf16_t>(p, WS_WGU)) + (size_t)le * (kind == 2 ? 2048 : 4096) * 2048); } }
    const int n = nb * 64 + lane;
    const float* s = src + (size_t)(kb * 64) * N + n;
    float v[64];
#pragma unroll
    for (int k = 0; k < 64; ++k) v[k] = __builtin_nontemporal_load(s + (size_t)k * N);
    int drow;
    if (map == 0) drow = n + a;
    else if (map == 1) drow = n < 768 ? n : (n < 832 ? 1792 + (n - 768) : 768 + (n - 832));
    else if (map == 2) { const int h = n >> 8, j = n & 255; drow = j < 128 ? 1536 + h * 128 + j : 2560 + h * 128 + (j - 128); }
    else drow = (n >> 7) * 256 + (n & 127) + a;
    if (f8s != 0.f) { u32x4* d8 = (u32x4*)((unsigned char*)dst + (size_t)drow * 2048 + kb * 64);
#pragma unroll
        for (int c16 = 0; c16 < 4; ++c16) { u32x4 o; const float* w = v + 16 * c16;
            o.x = pk4_fp8(w[0] * f8s, w[1] * f8s, w[2] * f8s, w[3] * f8s); o.y = pk4_fp8(w[4] * f8s, w[5] * f8s, w[6] * f8s, w[7] * f8s); o.z = pk4_fp8(w[8] * f8s, w[9] * f8s, w[10] * f8s, w[11] * f8s); o.w = pk4_fp8(w[12] * f8s, w[13] * f8s, w[14] * f8s, w[15] * f8s); d8[c16] = o; }
        return; }
    u32x4* d = (u32x4*)(dst + (size_t)drow * ldd + kb * 64);
#pragma unroll
    for (int c8 = 0; c8 < 8; ++c8) { u32x4 o; o.x = pk2(v[8 * c8], v[8 * c8 + 1]); o.y = pk2(v[8 * c8 + 2], v[8 * c8 + 3]); o.z = pk2(v[8 * c8 + 4], v[8 * c8 + 5]); o.w = pk2(v[8 * c8 + 6], v[8 * c8 + 7]); d[c8] = o; }
}
DI void ph_convert(const Params& p, int item_lo, int item_hi, int bid, int nblk, int nwv) {
    const int wv_ = __builtin_amdgcn_readfirstlane(threadIdx.x >> 6); if (wv_ >= nwv) return;
    const int lane = threadIdx.x & 63, gw = bid * nwv + wv_, NGW = nblk * nwv;
    for (int it = item_lo + gw; it < item_hi; it += NGW) cvt_item(p, it, lane);
}

DI void ph_misc(const Params& p) {
    const size_t gt = (size_t)blockIdx.x * NTHREADS + threadIdx.x, NGT = (size_t)gridDim.x * NTHREADS;
    float* cosT = ws_cos(p); float* sinT = ws_sin(p);
    for (size_t i = gt; i < 1024 * 32; i += NGT) { const int s = (int)(i >> 5), f = (int)(i & 31);
        const float inv = powf(10000.f, -(float)(f & 15) / 16.f); const float pos = f < 16 ? (float)(s >> 6) : (float)(s & 63); const float ang = pos * inv;
        cosT[i] = cosf(ang); sinT[i] = sinf(ang); }
    bf16_t* ACT2 = wsp<bf16_t>(p, WS_ACT2); bf16_t* KPE = wsp<bf16_t>(p, WS_KPE); bf16_t* KO = wsp<bf16_t>(p, WS_KO); bf16_t* VTO = wsp<bf16_t>(p, WS_VTO);
    const float* cckv = p.in[2]; const float* ckpe = p.in[3]; const float* csk = p.in[4]; const float* csv = p.in[5];
    for (size_t i = gt; i < (size_t)TC * 256 / 4; i += NGT) { const size_t e = i * 4; const int j = (int)(e >> 8), cc = (int)(e & 255); const f32x4 v = *(const f32x4*)(cckv + e);
        u32x2 o; o.x = pk2(v[0], v[1]); o.y = pk2(v[2], v[3]); *(u32x2*)(ACT2 + (size_t)(T + j) * 1792 + 512 + cc) = o;
        const f32x4 k = *(const f32x4*)(csk + e); u32x2 o2; o2.x = pk2(k[0], k[1]); o2.y = pk2(k[2], k[3]); *(u32x2*)(KO + (size_t)(T + j) * 256 + cc) = o2; }
    for (size_t i = gt; i < (size_t)TC * 64 / 4; i += NGT) { const size_t e = i * 4; const f32x4 v = *(const f32x4*)(ckpe + e); u32x2 o; o.x = pk2(v[0], v[1]); o.y = pk2(v[2], v[3]); *(u32x2*)(KPE + (size_t)T * 64 + e) = o; }
    for (size_t i = gt; i < (size_t)256 * (TC / 8); i += NGT) { const int f = (int)(i / (TC / 8)), j8 = (int)(i % (TC / 8)) * 8; float v[8];
#pragma unroll
        for (int q = 0; q < 8; ++q) v[q] = csv[(size_t)(j8 + q) * 256 + f];
        u32x4 o; o.x = pk2(v[0], v[1]); o.y = pk2(v[2], v[3]); o.z = pk2(v[4], v[5]); o.w = pk2(v[6], v[7]); *(u32x4*)(VTO + (size_t)f * TX + T + j8) = o; }
}

DI void ph_h0(const Params& p) {
    const int lane = threadIdx.x & 63, gw = blockIdx.x * NWAVES + __builtin_amdgcn_readfirstlane(threadIdx.x >> 6), NGW = gridDim.x * NWAVES;
    bf16_t* H = wsp<bf16_t>(p, WS_H);
    f32x4 v[8], vn[8]; int r = gw;
    if (r < T) { const float* x = xrow_in(p, r) + lane * 8;
#pragma unroll
        for (int j = 0; j < 4; ++j) { v[2 * j] = __builtin_nontemporal_load((const f32x4*)(x + 512 * j)); v[2 * j + 1] = __builtin_nontemporal_load((const f32x4*)(x + 512 * j + 4)); } }
    for (; r < T; r += NGW) {
        const int rn = r + NGW;
        if (rn < T) { const float* x = xrow_in(p, rn) + lane * 8;
#pragma unroll
            for (int j = 0; j < 4; ++j) { vn[2 * j] = __builtin_nontemporal_load((const f32x4*)(x + 512 * j)); vn[2 * j + 1] = __builtin_nontemporal_load((const f32x4*)(x + 512 * j + 4)); } }
        const int ci = cond_of_row(r);
#pragma unroll
        for (int j = 0; j < 4; ++j) { const int c0 = lane * 8 + 512 * j;
            const f32x4 h0 = v[2 * j] * (1.f + mod_from_partials(p, 0, ci, 1, c0)) + mod_from_partials(p, 0, ci, 0, c0), h1 = v[2 * j + 1] * (1.f + mod_from_partials(p, 0, ci, 1, c0 + 4)) + mod_from_partials(p, 0, ci, 0, c0 + 4);
            u32x4 o; o.x = pk2(h0[0], h0[1]); o.y = pk2(h0[2], h0[3]); o.z = pk2(h1[0], h1[1]); o.w = pk2(h1[2], h1[3]); *(u32x4*)(H + (size_t)r * D + c0) = o; }
#pragma unroll
        for (int j = 0; j < 8; ++j) v[j] = vn[j];
    }
}

DI void ph_e1(const Params& p) {
    const int lane = threadIdx.x & 63, gw = blockIdx.x * NWAVES + __builtin_amdgcn_readfirstlane(threadIdx.x >> 6), NGW = gridDim.x * NWAVES;
    const float* PJ = wsp<float>(p, WS_PJ); bf16_t* ACT2 = wsp<bf16_t>(p, WS_ACT2);
    const float* qn = p.in[11]; const float* kvn = p.in[12];
    for (int r = gw; r < T; r += NGW) {
        const float* pr = PJ + (size_t)r * 1792; bf16_t* ar = ACT2 + (size_t)r * 1792;
        {
            f32x4 v[2]; float ss = 0.f;
#pragma unroll
            for (int j = 0; j < 2; ++j) { v[j] = *(const f32x4*)(pr + lane * 4 + 256 * j); ss += (v[j][0] * v[j][0] + v[j][1] * v[j][1]) + (v[j][2] * v[j][2] + v[j][3] * v[j][3]); }
            const float rs = rsqrtf(wave_sum(ss) * (1.f / 512.f) + 1e-6f);
#pragma unroll
            for (int j = 0; j < 2; ++j) { const int c0 = lane * 4 + 256 * j; const f32x4 g = *(const f32x4*)(qn + c0); const f32x4 y = v[j] * rs * g; u32x2 o; o.x = pk2(y[0], y[1]); o.y = pk2(y[2], y[3]); *(u32x2*)(ar + c0) = o; }
        }
        {
            const int c0 = lane * 4; const f32x4 v = *(const f32x4*)(pr + 512 + c0); float ss = (v[0] * v[0] + v[1] * v[1]) + (v[2] * v[2] + v[3] * v[3]);
            const float rs = rsqrtf(wave_sum(ss) * (1.f / 256.f) + 1e-6f); const f32x4 g = *(const f32x4*)(kvn + c0); const f32x4 y = v * rs * g;
            u32x2 o; o.x = pk2(y[0], y[1]); o.y = pk2(y[2], y[3]); *(u32x2*)(ar + 512 + c0) = o;
            if (r < T_CTX) *(f32x4*)(p.out + O_CKV + (size_t)r * 256 + c0) = y;
        }
        {
            int s, S, rb; if (r < T_CTX) { s = r & 255; S = 256; rb = r - s; } else { s = (r - T_CTX) & 1023; S = 1024; rb = r - s; }
#pragma unroll
            for (int g = 0; g < 4; ++g) { const int half = 1 << g; const int lo = max(s - half, 0), hi = min(s + half, S); const int c0 = 768 + g * 256 + lane * 4;
                f32x4 sum = {0.f, 0.f, 0.f, 0.f};
                for (int t = lo; t < hi; ++t) sum += *(const f32x4*)(PJ + (size_t)(rb + t) * 1792 + c0);
                const f32x4 u = *(const f32x4*)(pr + c0); const f32x4 y = sum / (float)(hi - lo) - u;
                u32x2 o; o.x = pk2(y[0], y[1]); o.y = pk2(y[2], y[3]); *(u32x2*)(ar + c0) = o; }
        }
    }
}

DI void ph_ln1(const Params& p, int l, unsigned char* lds_raw) {
    const int tid = threadIdx.x, lane = tid & 63, gw = blockIdx.x * NWAVES + __builtin_amdgcn_readfirstlane(tid >> 6), NGW = gridDim.x * NWAVES;
    float* wT = (float*)lds_raw;
    const float* wr = p.in[23] + (size_t)l * 2048 * 16;
    for (int i = tid; i < 2048 * 16; i += NTHREADS) { const int d = i >> 4, e = i & 15; wT[e * 2048 + d] = wr[i]; }
    __syncthreads();
    const float* Y = wsp<float>(p, WS_Y); float* STAT = wsp<float>(p, WS_STAT); bf16_t* H = wsp<bf16_t>(p, WS_H); float* AFF = wsp<float>(p, WS_AFF); float* AFFT = wsp<float>(p, WS_AFFT);
    unsigned char* H8 = wsp<unsigned char>(p, WS_H8);
    const float* lg = p.in[21] + l * D; const float* lb = p.in[22] + l * D;
    f32x4 v[8], vn[8];
    int r = gw;
    if (r < T) {
#pragma unroll
        for (int j = 0; j < 4; ++j) { const float* y = Y + (size_t)r * D + lane * 8 + 512 * j; v[2 * j] = *(const f32x4*)y; v[2 * j + 1] = *(const f32x4*)(y + 4); } }
    for (; r < T; r += NGW) {
        const int rn = r + NGW;
        if (rn < T) {
#pragma unroll
            for (int j = 0; j < 4; ++j) { const float* y = Y + (size_t)rn * D + lane * 8 + 512 * j; vn[2 * j] = *(const f32x4*)y; vn[2 * j + 1] = *(const f32x4*)(y + 4); } }
        const int ci = cond_of_row(r); const float* sh = modp(p, l, ci, 3); const float* sc = modp(p, l, ci, 4);
        float s = 0.f;
#pragma unroll
        for (int j = 0; j < 8; ++j) s += (v[j][0] + v[j][1]) + (v[j][2] + v[j][3]);
        const float mean = wave_sum(s) * (1.f / D); float s2 = 0.f;
#pragma unroll
        for (int j = 0; j < 8; ++j) { v[j] = v[j] - mean; s2 += (v[j][0] * v[j][0] + v[j][1] * v[j][1]) + (v[j][2] * v[j][2] + v[j][3] * v[j][3]); }
        const float rstd = rsqrtf(wave_sum(s2) * (1.f / D) + 1e-5f);
#pragma unroll
        for (int j = 0; j < 4; ++j) { const int c0 = lane * 8 + 512 * j;
#pragma unroll
            for (int q = 0; q < 2; ++q) { const int cc = c0 + 4 * q; const f32x4 x1 = v[2 * j + q] * rstd * *(const f32x4*)(lg + cc) + *(const f32x4*)(lb + cc);
                v[2 * j + q] = x1 * (1.f + *(const f32x4*)(sc + cc)) + *(const f32x4*)(sh + cc); }
            const f32x4 a = v[2 * j], b = v[2 * j + 1];
            if (!MOE_F8) { u32x4 o; o.x = pk2(a[0], a[1]); o.y = pk2(a[2], a[3]); o.z = pk2(b[0], b[1]); o.w = pk2(b[2], b[3]); *(u32x4*)(H + (size_t)r * D + c0) = o; }
            u32x2 o8; o8.x = pk4_fp8(a[0], a[1], a[2], a[3]); o8.y = pk4_fp8(b[0], b[1], b[2], b[3]); *(u32x2*)(H8 + (size_t)r * D + c0) = o8; }
        float mine = -1e30f;
#pragma unroll 2
        for (int e = 0; e < 16; ++e) { float a = 0.f;
#pragma unroll
            for (int j = 0; j < 4; ++j) { const float* wp = wT + e * 2048 + lane * 8 + 512 * j; const f32x4 w0 = *(const f32x4*)wp, w1 = *(const f32x4*)(wp + 4); const f32x4 h0 = v[2 * j], h1 = v[2 * j + 1];
                a += ((h0[0] * w0[0] + h0[1] * w0[1]) + (h0[2] * w0[2] + h0[3] * w0[3])) + ((h1[0] * w1[0] + h1[1] * w1[1]) + (h1[2] * w1[2] + h1[3] * w1[3])); }
            a = wave_sum(a); mine = (lane == e) ? a : mine; }
        const float m = wave_max(mine);
        const float ex = lane < 16 ? expf(mine - m) : 0.f;
        const float den = wave_sum(ex);
        if (lane < 16) { const float af = ex / den; AFF[(size_t)r * 16 + lane] = af; AFFT[(size_t)lane * T + r] = af; }
        if (lane == 0) *(f32x2*)(STAT + 2 * (size_t)r) = (f32x2){mean, rstd};
#pragma unroll
        for (int j = 0; j < 8; ++j) v[j] = vn[j];
    }
}

DI void ph_topk(const Params& p, unsigned char* lds_raw) {
    const int tid = threadIdx.x, lane = tid & 63, wave = __builtin_amdgcn_readfirstlane(tid >> 6);
    float* vals = (float*)lds_raw;
    int* cnt2 = (int*)(vals + 1024);
    int* selrow = cnt2 + 256;
    int* selslot = selrow + 256;
    int* nsel = selslot + 256;
    const float* AFFT = wsp<float>(p, WS_AFFT); int* INV = wsp<int>(p, WS_INV); const bf16_t* H = wsp<bf16_t>(p, WS_H); const unsigned char* H8 = wsp<unsigned char>(p, WS_H8); bf16_t* XS = wsp<bf16_t>(p, WS_XS);
    for (int it = blockIdx.x; it < 768; it += gridDim.x) {
        int n, cap, r0, e, sb, c0;
        if (it < 256) { const int b = it >> 4; e = it & 15; n = 256; cap = 32; r0 = b * 256; sb = b * 32; c0 = 0; }
        else { const int q = it - 256, li = q >> 2, b = li >> 4; e = li & 15; n = 1024; cap = 128; r0 = T_CTX + b * 1024; sb = 512 + b * 128; c0 = (q & 3) * 256; }
        for (int i = tid; i < n; i += NTHREADS) vals[i] = AFFT[(size_t)e * T + r0 + i];
        if (tid == 0) *nsel = 0;
        __syncthreads();
        const int ci = c0 + (tid & 255), half = tid >> 8, jn = n >> 1, j0 = half * jn;
        const float vi = vals[ci]; int cnt = 0;
        for (int j = j0; j < j0 + jn; ++j) { const float vj = vals[j]; cnt += (vj > vi || (vj == vi && j < ci)) ? 1 : 0; }
        if (half) cnt2[tid & 255] = cnt;
        __syncthreads();
        if (!half) { cnt += cnt2[tid];
            if (cnt < cap) { const int pos = atomicAdd(nsel, 1); selrow[pos] = ci; selslot[pos] = cnt; INV[(size_t)(r0 + ci) * 16 + e] = sb + cnt; } else INV[(size_t)(r0 + ci) * 16 + e] = -1; }
        __syncthreads();
        const int ns = *nsel;
        for (int k = wave; k < ns; k += NWAVES) { const int r = r0 + selrow[k]; const size_t drow = (size_t)(e * NSLOT + sb + selslot[k]);
            if (MOE_F8) { const u32x4* src = (const u32x4*)(H8 + (size_t)r * D); u32x4* dst = (u32x4*)((unsigned char*)XS + drow * D);
#pragma unroll
                for (int j = 0; j < 2; ++j) dst[lane + 64 * j] = src[lane + 64 * j]; }
            else { const u32x4* src = (const u32x4*)(H + (size_t)r * D); u32x4* dst = (u32x4*)(XS + drow * D);
#pragma unroll
                for (int j = 0; j < 4; ++j) dst[lane + 64 * j] = src[lane + 64 * j]; } }
        __syncthreads();
    }
}

DI void ph_ln2(const Params& p, int l) {
    const int lane = threadIdx.x & 63, gw = blockIdx.x * NWAVES + __builtin_amdgcn_readfirstlane(threadIdx.x >> 6), NGW = gridDim.x * NWAVES;
    const float* X1 = wsp<float>(p, WS_Y); const float* STAT = wsp<float>(p, WS_STAT); const float* l1g = p.in[21] + l * D; const float* l1b = p.in[22] + l * D;
    const float* AFF = wsp<float>(p, WS_AFF); const int* INV = wsp<int>(p, WS_INV); const bf16_t* YE = wsp<bf16_t>(p, WS_YE);
    float* XL = wsp<float>(p, WS_XL); bf16_t* H = wsp<bf16_t>(p, WS_H);
    const float* lg = p.in[27] + l * D; const float* lb = p.in[28] + l * D;
    f32x4 x[8], xn[8]; int sl = -1, sln = -1; float af = 0.f, afn = 0.f; f32x2 st = {0.f, 1.f}, stn = {0.f, 1.f};
    int r = gw;
    if (r < T) {
#pragma unroll
        for (int j = 0; j < 4; ++j) { const float* y = X1 + (size_t)r * D + lane * 8 + 512 * j; x[2 * j] = *(const f32x4*)y; x[2 * j + 1] = *(const f32x4*)(y + 4); }
        if (lane < 16) { sl = INV[(size_t)r * 16 + lane]; af = AFF[(size_t)r * 16 + lane]; } st = *(const f32x2*)(STAT + 2 * (size_t)r); }
    for (; r < T; r += NGW) {
        const int rn = r + NGW;
        if (rn < T) {
#pragma unroll
            for (int j = 0; j < 4; ++j) { const float* y = X1 + (size_t)rn * D + lane * 8 + 512 * j; xn[2 * j] = *(const f32x4*)y; xn[2 * j + 1] = *(const f32x4*)(y + 4); }
            if (lane < 16) { sln = INV[(size_t)rn * 16 + lane]; afn = AFF[(size_t)rn * 16 + lane]; } stn = *(const f32x2*)(STAT + 2 * (size_t)rn); }
        const int ci = cond_of_row(r); const float* g2 = modp(p, l, ci, 5);
        f32x4 f[8];
#pragma unroll
        for (int j = 0; j < 8; ++j) f[j] = (f32x4){0.f, 0.f, 0.f, 0.f};
        {
            unsigned long long mk = __ballot(sl >= 0) & 0xffffull;
            while (mk) {
                const int e0 = __builtin_ctzll(mk); mk &= mk - 1; const bool two = mk != 0ull; const int e1 = two ? __builtin_ctzll(mk) : e0; if (two) mk &= mk - 1;
                const int s0 = __shfl(sl, e0), s1 = __shfl(sl, e1); const float w0 = __shfl(af, e0), w1 = two ? __shfl(af, e1) : 0.f;
                const bf16_t* y0 = YE + (size_t)(e0 * NSLOT + s0) * D + lane * 8; const bf16_t* y1 = YE + (size_t)(e1 * NSLOT + s1) * D + lane * 8;
                u32x4 q0[4], q1[4];
#pragma unroll
                for (int j = 0; j < 4; ++j) { q0[j] = *(const u32x4*)(y0 + 512 * j); q1[j] = *(const u32x4*)(y1 + 512 * j); }
#pragma unroll
                for (int j = 0; j < 4; ++j) {
                    f[2 * j][0] += w0 * bflo(q0[j].x) + w1 * bflo(q1[j].x); f[2 * j][1] += w0 * bfhi(q0[j].x) + w1 * bfhi(q1[j].x); f[2 * j][2] += w0 * bflo(q0[j].y) + w1 * bflo(q1[j].y); f[2 * j][3] += w0 * bfhi(q0[j].y) + w1 * bfhi(q1[j].y);
                    f[2 * j + 1][0] += w0 * bflo(q0[j].z) + w1 * bflo(q1[j].z); f[2 * j + 1][1] += w0 * bfhi(q0[j].z) + w1 * bfhi(q1[j].z); f[2 * j + 1][2] += w0 * bflo(q0[j].w) + w1 * bflo(q1[j].w); f[2 * j + 1][3] += w0 * bfhi(q0[j].w) + w1 * bfhi(q1[j].w); }
            }
        }
        float s = 0.f;
#pragma unroll
        for (int j = 0; j < 8; ++j) { const int c0 = lane * 8 + 512 * (j >> 1) + 4 * (j & 1); const f32x4 x1 = (x[j] - st[0]) * st[1] * *(const f32x4*)(l1g + c0) + *(const f32x4*)(l1b + c0);
            f[j] = DN_ALPHA * x1 + *(const f32x4*)(g2 + c0) * f[j]; s += (f[j][0] + f[j][1]) + (f[j][2] + f[j][3]); }
        const float mean = wave_sum(s) * (1.f / D); float s2 = 0.f;
#pragma unroll
        for (int j = 0; j < 8; ++j) { f[j] = f[j] - mean; s2 += (f[j][0] * f[j][0] + f[j][1] * f[j][1]) + (f[j][2] * f[j][2] + f[j][3] * f[j][3]); }
        const float rstd = rsqrtf(wave_sum(s2) * (1.f / D) + 1e-5f);
        const float* sh = modp(p, 1, ci, 0); const float* sc = modp(p, 1, ci, 1);
#pragma unroll
        for (int j = 0; j < 4; ++j) { const int c0 = lane * 8 + 512 * j; f32x4 o[2];
#pragma unroll
            for (int q = 0; q < 2; ++q) { const int cc = c0 + 4 * q; o[q] = f[2 * j + q] * rstd * *(const f32x4*)(lg + cc) + *(const f32x4*)(lb + cc);
                if (l == 0) { *(f32x4*)(XL + (size_t)r * D + cc) = o[q]; o[q] = o[q] * (1.f + *(const f32x4*)(sc + cc)) + *(const f32x4*)(sh + cc); }
                else *(f32x4*)(p.out + O_Y + (size_t)r * D + cc) = o[q]; }
            if (l == 0) { u32x4 w; w.x = pk2(o[0][0], o[0][1]); w.y = pk2(o[0][2], o[0][3]); w.z = pk2(o[1][0], o[1][1]); w.w = pk2(o[1][2], o[1][3]); *(u32x4*)(H + (size_t)r * D + c0) = w; } }
#pragma unroll
        for (int j = 0; j < 8; ++j) x[j] = xn[j];
        sl = sln; af = afn; st = stn;
    }
}

template <int PAT> DI void ph_readonly(const Params& p) {
    const int lane = threadIdx.x & 63, gw = blockIdx.x * NWAVES + __builtin_amdgcn_readfirstlane(threadIdx.x >> 6), NGW = gridDim.x * NWAVES;
    float accum = 0.f;
    for (int it = gw; it < 98304; it += NGW) {
        const int mat = it >> 10, w = it & 1023, le = mat / 3, kind = mat % 3;
        const float* base = p.in[24 + kind] + (size_t)le * 2048 * 2048;
        if (PAT == 0) { const int nb = w & 31, kb = w >> 5; const float* s = base + (size_t)(kb * 64) * 2048 + nb * 64 + lane; float v[64];
#pragma unroll
            for (int k = 0; k < 64; ++k) v[k] = __builtin_nontemporal_load(s + (size_t)k * 2048);
#pragma unroll
            for (int k = 0; k < 64; ++k) accum += v[k]; }
        else if (PAT == 1) { const int nb8 = w & 7, kb16 = w >> 3; const float* s = base + (size_t)(kb16 * 16) * 2048 + nb8 * 256 + 4 * lane; f32x4 v[16];
#pragma unroll
            for (int k = 0; k < 16; ++k) v[k] = __builtin_nontemporal_load((const f32x4*)(s + (size_t)k * 2048));
#pragma unroll
            for (int k = 0; k < 16; ++k) accum += (v[k][0] + v[k][1]) + (v[k][2] + v[k][3]); }
        else { const float* s = base + (size_t)w * 4096 + 4 * lane; f32x4 v[16];
#pragma unroll
            for (int k = 0; k < 16; ++k) v[k] = __builtin_nontemporal_load((const f32x4*)(s + (size_t)k * 256));
#pragma unroll
            for (int k = 0; k < 16; ++k) accum += (v[k][0] + v[k][1]) + (v[k][2] + v[k][3]); }
    }
    if (lane == 0) wsp<float>(p, WS_DBG)[gw] = accum + wave_sum(accum);
}

struct Unit { const char* A; const char* B; unsigned lda, ldb; int nt; int pm, pn; int mode; int aux; };
DI int vcu_of(int bx, int G) { return (G % 8 == 0) ? (bx % 8) * (G / 8) + bx / 8 : bx; }

DI void rope8(const Params& p, int s, int pi0, float* v) {
    const f32x4 c = *(const f32x4*)(ws_cos(p) + s * 32 + pi0), sn = *(const f32x4*)(ws_sin(p) + s * 32 + pi0);
#pragma unroll
    for (int i = 0; i < 4; ++i) { const float x1 = v[2 * i], x2 = v[2 * i + 1]; v[2 * i] = x1 * c[i] - x2 * sn[i]; v[2 * i + 1] = x1 * sn[i] + x2 * c[i]; }
}
DI void st_bf16x8(bf16_t* dst, const float* v) { u32x4 w; w.x = pk2(v[0], v[1]); w.y = pk2(v[2], v[3]); w.z = pk2(v[4], v[5]); w.w = pk2(v[6], v[7]); *(u32x4*)dst = w; }
DI void st_f32x8(float* dst, const float* v) { *(f32x4*)dst = (f32x4){v[0], v[1], v[2], v[3]}; *(f32x4*)(dst + 4) = (f32x4){v[4], v[5], v[6], v[7]}; }

struct SchedInEven { const Params* p; int G, c;
    DI bool next(int i, Unit& u) const { const int L = i * G + c; if (L >= 48 * 8) return false; u.pm = L >> 3; u.pn = L & 7;
        u.A = (const char*)wsp<bf16_t>(*p, WS_H) + (size_t)u.pm * 256 * 4096; u.B = (const char*)wsp<bf16_t>(*p, WS_WINE) + (size_t)u.pn * 256 * 4096; u.lda = 4096; u.ldb = 4096; u.nt = 32; u.mode = 0; u.aux = 0; return true; } };
struct EpiInEven { static constexpr bool PAIR = false, F8 = false; const Params* p;
    DI void store(const Unit& u, int row, int col, float* v) const {
        const int r = u.pm * 256 + row, gc = u.pn * 256 + col;
        if (gc < 1792) { st_f32x8(wsp<float>(*p, WS_PJ) + (size_t)r * 1792 + gc, v); return; }
        if (gc >= 1856) return;
        const int j0 = gc - 1792;
        if (r < T_CTX) st_f32x8(p->out + O_KPE + (size_t)r * 64 + j0, v); else rope8(*p, (r - T_CTX) & 1023, j0 >> 1, v);
        st_bf16x8(wsp<bf16_t>(*p, WS_KPE) + (size_t)r * 64 + j0, v);
    } };

constexpr int E2_Q = 48 * 6, E2_K = 64 * 4, E2_V = 4 * 64, E2_P = 48 * 4, E2_TOTAL = E2_Q + E2_K + E2_V + E2_P;
struct SchedE2 { const Params* p; int G, c;
    DI bool next(int i, Unit& u) const { int L;
        if (G == 256) { if (c < 32) { if (i > 2) return false; L = i == 0 ? c : (i == 1 ? 256 + c : E2_Q + c); } else { if (i > 3) return false; L = i == 0 ? c : E2_Q + 32 + (c - 32) * 3 + (i - 1); } }
        else { L = i * G + c; if (L >= E2_TOTAL) return false; }
        const char* ACT2 = (const char*)wsp<bf16_t>(*p, WS_ACT2); const char* W2 = (const char*)wsp<bf16_t>(*p, WS_W2); u.aux = 0;
        if (L < E2_Q) { u.mode = 0; u.pm = L / 6; u.pn = L % 6; u.A = ACT2 + (size_t)u.pm * 256 * 3584; u.lda = 3584; u.B = W2 + (size_t)u.pn * 256 * 3584; u.ldb = 3584; u.nt = 8; return true; }
        L -= E2_Q;
        if (L < E2_K) { u.mode = 1; u.pm = L >> 2; u.pn = L & 3; u.A = ACT2 + (size_t)u.pm * 256 * 3584 + 512 * 2; u.lda = 3584; u.B = W2 + (size_t)(1536 + u.pn * 256) * 3584; u.ldb = 3584; u.nt = 4; return true; }
        L -= E2_K;
        if (L < E2_V) { u.mode = 2; u.pm = L >> 6; u.pn = L & 63; u.A = W2 + (size_t)(2560 + u.pm * 256) * 3584; u.lda = 3584; u.B = ACT2 + (size_t)u.pn * 256 * 3584 + 512 * 2; u.ldb = 3584; u.nt = 4; return true; }
        L -= E2_V;
        u.mode = 3; u.pm = L >> 2; u.aux = L & 3; u.pn = 0; u.A = ACT2 + (size_t)u.pm * 256 * 3584 + (768 + u.aux * 256) * 2; u.lda = 3584; u.B = W2 + (size_t)(3584 + u.aux * 256) * 3584; u.ldb = 3584; u.nt = 4; return true; } };
struct EpiE2 { static constexpr bool PAIR = false, F8 = false; const Params* p;
    DI void store(const Unit& u, int row, int col, float* v) const {
        const int r = u.pm * 256 + row, gc = u.pn * 256 + col;
        if (u.mode == 0) { const int dd = gc % 192; if (dd >= 128 && r >= T_CTX) rope8(*p, (r - T_CTX) & 1023, (dd - 128) >> 1, v);
#pragma unroll
            for (int i = 0; i < 8; ++i) v[i] *= QS_MLA;
            st_bf16x8(wsp<bf16_t>(*p, WS_Q) + (size_t)r * 1536 + gc, v); }
        else if (u.mode == 1) st_bf16x8(wsp<bf16_t>(*p, WS_KN) + (size_t)r * 1024 + gc, v);
        else if (u.mode == 2) st_bf16x8(wsp<bf16_t>(*p, WS_VT) + (size_t)r * TX + gc, v);
        else { const float* ps = p->in[16] + u.aux * 256 + col;
#pragma unroll
            for (int i = 0; i < 8; ++i) v[i] *= ps[i];
            st_bf16x8(wsp<bf16_t>(*p, WS_MIX) + (size_t)r * 2048 + 1024 + u.aux * 256 + col, v); }
    } };

struct SchedOut { const Params* p; int G, c, l;
    DI bool next(int i, Unit& u) const { const int L = i * G + c; if (L >= 48 * 8) return false; u.pm = L >> 3; u.pn = L & 7;
        u.A = (const char*)wsp<bf16_t>(*p, WS_MIX) + (size_t)u.pm * 256 * 4096; u.B = (const char*)wsp<bf16_t>(*p, l == 0 ? WS_WOUTE : WS_WOUTO) + (size_t)u.pn * 256 * 4096; u.lda = 4096; u.ldb = 4096; u.nt = 32; u.mode = 0; u.aux = 0; return true; } };
struct EpiOut { static constexpr bool PAIR = false, F8 = false; const Params* p; int l;
    DI void store(const Unit& u, int row, int col, float* v) const {
        const int r = u.pm * 256 + row, gc = u.pn * 256 + col;
        const float* x = (l == 0 ? xrow_in(*p, r) : wsp<float>(*p, WS_XL) + (size_t)r * D) + gc; const float* g1 = modp(*p, l, cond_of_row(r), 2) + gc;
        const f32x4 x0 = *(const f32x4*)x, x1 = *(const f32x4*)(x + 4), g0 = *(const f32x4*)g1, g4 = *(const f32x4*)(g1 + 4);
#pragma unroll
        for (int i = 0; i < 4; ++i) { v[i] = DN_ALPHA * x0[i] + g0[i] * v[i]; v[4 + i] = DN_ALPHA * x1[i] + g4[i] * v[4 + i]; }
        st_f32x8(wsp<float>(*p, WS_Y) + (size_t)r * D + gc, v);
    } };

struct SchedGU { const Params* p; int G, c, l;
    DI bool next(int i, Unit& u) const { const int L = i * G + c; if (L >= 16 * 96) return false; const int e = L / 96, rem = L % 96; u.pn = rem / 6; u.pm = e * 6 + rem % 6; u.aux = e;
        constexpr unsigned P = MOE_F8 ? 2048 : 4096;
        u.A = (const char*)wsp<bf16_t>(*p, WS_XS) + (size_t)u.pm * 256 * P; u.B = (const char*)wsp<bf16_t>(*p, WS_WGU) + ((size_t)(l * 16 + e) * 4096 + (size_t)u.pn * 256) * P; u.lda = P; u.ldb = P; u.nt = MOE_F8 ? 16 : 32; u.mode = 0; return true; } };
struct EpiGU { static constexpr bool PAIR = true, F8 = MOE_F8 != 0; const Params* p;
    DI void store2(const Unit& u, int row, int col, const float* g, const float* up) const {
        float h[8];
#pragma unroll
        for (int i = 0; i < 8; ++i) { const float gg = MOE_F8 ? g[i] * (1.f / GU_WSCALE) : g[i], uu = MOE_F8 ? up[i] * (1.f / GU_WSCALE) : up[i]; h[i] = gg / (1.f + __expf(-gg)) * uu; }
        if (MOE_F8) { u32x2 o; o.x = pk4_fp8(h[0], h[1], h[2], h[3]); o.y = pk4_fp8(h[4], h[5], h[6], h[7]); *(u32x2*)((unsigned char*)wsp<bf16_t>(*p, WS_HID) + (size_t)(u.pm * 256 + row) * D + u.pn * 128 + col) = o; }
        else st_bf16x8(wsp<bf16_t>(*p, WS_HID) + (size_t)(u.pm * 256 + row) * D + u.pn * 128 + col, h);
    } };

struct SchedDown { const Params* p; int G, c, l;
    DI bool next(int i, Unit& u) const { const int L = i * G + c; if (L >= 16 * 48) return false; const int e = L / 48, rem = L % 48; u.pn = rem / 6; u.pm = e * 6 + rem % 6; u.aux = e;
        constexpr unsigned P = MOE_F8 ? 2048 : 4096;
        u.A = (const char*)wsp<bf16_t>(*p, WS_HID) + (size_t)u.pm * 256 * P; u.B = (const char*)wsp<bf16_t>(*p, WS_WDN) + ((size_t)(l * 16 + e) * 2048 + (size_t)u.pn * 256) * P; u.lda = P; u.ldb = P; u.nt = MOE_F8 ? 16 : 32; u.mode = 0; return true; } };
struct EpiDown { static constexpr bool PAIR = false, F8 = MOE_F8 != 0; const Params* p;
    DI void store(const Unit& u, int row, int col, float* v) const {
        if (MOE_F8) {
#pragma unroll
            for (int i = 0; i < 8; ++i) v[i] *= (1.f / DN_WSCALE); }
        st_bf16x8(wsp<bf16_t>(*p, WS_YE) + (size_t)(u.pm * 256 + row) * D + u.pn * 256 + col, v); } };

constexpr int IO_QK = 48 * 9, IO_V = 16, IO_VT = 48, IO_TOTAL = IO_QK + IO_V + IO_VT;
struct SchedInOdd { const Params* p; int G, c;
    DI bool next(int i, Unit& u) const { int L = i * G + c; if (L >= IO_TOTAL) return false;
        const char* Hb = (const char*)wsp<bf16_t>(*p, WS_H); const char* W = (const char*)wsp<bf16_t>(*p, WS_WINO); u.aux = 0; u.nt = 32; u.lda = 4096; u.ldb = 4096;
        if (L < IO_QK) { u.mode = 0; u.pm = L / 9; u.pn = L % 9; u.A = Hb + (size_t)u.pm * 256 * 4096; u.B = W + (size_t)u.pn * 256 * 4096; return true; }
        L -= IO_QK;
        if (L < IO_V) { u.mode = 1; u.pm = L; u.pn = 9; u.A = Hb + (size_t)u.pm * 256 * 4096; u.B = W + (size_t)9 * 256 * 4096; return true; }
        L -= IO_V;
        u.mode = 2; u.pm = 0; u.pn = L; u.A = W + (size_t)9 * 256 * 4096; u.B = Hb + (size_t)u.pn * 256 * 4096; return true; } };
struct EpiInOdd { static constexpr bool PAIR = false, F8 = false; const Params* p;
    DI void store(const Unit& u, int row, int col, float* v) const {
        const int r = u.pm * 256 + row, gc = u.pn * 256 + col;
        if (u.mode == 0) {
            if (gc < 2048) { if (r >= T_CTX) rope8(*p, (r - T_CTX) & 1023, (gc & 63) >> 1, v);
#pragma unroll
                for (int i = 0; i < 8; ++i) v[i] *= QS_SWA;
                st_bf16x8(wsp<bf16_t>(*p, WS_Q) + (size_t)r * 2048 + gc, v); }
            else { const int kc = gc - 2048; if (r < T_CTX) st_f32x8(p->out + O_SK + (size_t)r * 256 + kc, v); else rope8(*p, (r - T_CTX) & 1023, (kc & 63) >> 1, v);
                st_bf16x8(wsp<bf16_t>(*p, WS_KO) + (size_t)r * 256 + kc, v); } }
        else if (u.mode == 1) st_f32x8(p->out + O_SV + (size_t)r * 256 + col, v);
        else st_bf16x8(wsp<bf16_t>(*p, WS_VTO) + (size_t)row * TX + gc, v);
    } };

namespace pg8 {
typedef short bf16x8 __attribute__((ext_vector_type(8)));
typedef int i32x4 __attribute__((ext_vector_type(4)));
typedef int i32x8 __attribute__((ext_vector_type(8)));
DI i32x8 cat8(bf16x8 lo, bf16x8 hi) { return __builtin_shufflevector(__builtin_bit_cast(i32x4, lo), __builtin_bit_cast(i32x4, hi), 0, 1, 2, 3, 4, 5, 6, 7); }
constexpr int BM = 256, BK = 64, HALF = 128, HTB = HALF * BK * 2  , STAGE_BYTES = 8 * HTB;
DI int lds_byte(int r, int c) { const int st = (r >> 4) * 2 + (c >> 5), rr = r & 15, cc = c & 31, ob = rr * 64 + cc * 2; return st * 1024 + (ob ^ (((ob >> 9) & 1) << 5)); }
DI void stage_rc(int b, int& R, int& C) { const int st = b / 1024, sb = b % 1024, swz = sb ^ (((sb >> 9) & 1) << 5); R = (st >> 1) * 16 + swz / 64; C = (st & 1) * 32 + (swz % 64) / 2; }
DI int perm32(int rho) { const int n = rho >> 4, i = rho & 15; return 8 * (i >> 2) + 4 * n + (i & 3); }

template <bool F8> struct Frag;
template <> struct Frag<false> { bf16x8 k0, k1; DI void set(bf16x8 a, bf16x8 b) { k0 = a; k1 = b; } };
template <> struct Frag<true> { i32x8 w; DI void set(bf16x8 a, bf16x8 b) { w = cat8(a, b); } };
template <class Epi, class Sched, bool ALIGN_EPI = true>
DI void gemm_phase(LAS unsigned char* lds, const Sched& S, const Epi& E, int wid) {
    const int lane = fresh_lane(), tid = wid * 64 + lane, wr = wid >> 2, wc = wid & 3, fr = lane & 15, fq = lane >> 4;
    int RA[2], RB[2], CB[2];
#pragma unroll
    for (int i = 0; i < 2; ++i) { int R, C; stage_rc(tid * 16 + i * 8192, R, C); RA[i] = R; RB[i] = (R & ~31) + perm32(R & 31); CB[i] = C * 2; }
    constexpr size_t kstep = (size_t)(BK * 2);
    const unsigned ldsw = (unsigned)wid * 1024u;
    const int aoff = lds_byte(wr * 64 + fr, fq * 8), boff = lds_byte(wc * 32 + fr, fq * 8);
#define PG8_SA(b, h) (((b) * 2 + (h)) * HTB)
#define PG8_SB(b, h) ((4 + (b) * 2 + (h)) * HTB)
#define PG8_STAGE(bufoff, gbase, v0, v1) do { unsigned o0_ = (v0), o1_ = (v1); asm volatile("" : "+v"(o0_), "+v"(o1_)); \
        __builtin_amdgcn_global_load_lds((const unsigned*)((const char*)(gbase) + o0_), (LAS unsigned*)(lds + (bufoff) + ldsw), 16, 0, 0); \
        __builtin_amdgcn_global_load_lds((const unsigned*)((const char*)(gbase) + o1_), (LAS unsigned*)(lds + (bufoff) + ldsw + 8192), 16, 0, 0); } while (0)
#define PG8_LDA(dst, b, h) do { _Pragma("unroll") for (int m = 0; m < 4; ++m) { const bf16x8 f0_ = *(const LAS bf16x8*)(lds + PG8_SA(b, h) + aoff + m * 2048), f1_ = *(const LAS bf16x8*)(lds + PG8_SA(b, h) + aoff + m * 2048 + 1024); dst[m].set(f0_, f1_); } } while (0)
#define PG8_LDB(dst, b, h) do { _Pragma("unroll") for (int n = 0; n < 2; ++n) { const bf16x8 f0_ = *(const LAS bf16x8*)(lds + PG8_SB(b, h) + boff + n * 2048), f1_ = *(const LAS bf16x8*)(lds + PG8_SB(b, h) + boff + n * 2048 + 1024); dst[n].set(f0_, f1_); } } while (0)
#define PG8_MMA(ai, bj, At, Bt) do { __builtin_amdgcn_s_setprio(1); _Pragma("unroll") for (int m = 0; m < 4; ++m) _Pragma("unroll") for (int n = 0; n < 2; ++n) { \
        if constexpr (Epi::F8) acc[ai][bj][m][n] = __builtin_amdgcn_mfma_scale_f32_16x16x128_f8f6f4(Bt[n].w, At[m].w, acc[ai][bj][m][n], 0, 0, 0, 0x7f7f7f7f, 0, 0x7f7f7f7f); \
        else { acc[ai][bj][m][n] = __builtin_amdgcn_mfma_f32_16x16x32_bf16(Bt[n].k0, At[m].k0, acc[ai][bj][m][n], 0, 0, 0); acc[ai][bj][m][n] = __builtin_amdgcn_mfma_f32_16x16x32_bf16(Bt[n].k1, At[m].k1, acc[ai][bj][m][n], 0, 0, 0); } } \
        __builtin_amdgcn_s_setprio(0); } while (0)
#define PG8_WAIT_V(n) asm volatile("s_waitcnt vmcnt(" #n ")" ::: "memory")
#define PG8_WAIT_L(n) asm volatile("s_waitcnt lgkmcnt(" #n ")" ::: "memory")
#define PG8_BAR __builtin_amdgcn_s_barrier()
#define PG8_SCHED __builtin_amdgcn_sched_barrier(0)
    Unit cur, nxt; int ui = 0;
    if (!S.next(0, cur)) return;
    f32x4 acc[2][2][4][2];
#pragma unroll
    for (int a = 0; a < 2; ++a)
#pragma unroll
        for (int b = 0; b < 2; ++b)
#pragma unroll
            for (int m = 0; m < 4; ++m)
#pragma unroll
                for (int n = 0; n < 2; ++n) acc[a][b][m][n] = (f32x4){0.f, 0.f, 0.f, 0.f};
    Frag<Epi::F8> At[4], B0[2], B1[2];
    const char* cA = cur.A; const char* cB = cur.B;
    const unsigned ld = cur.lda;
    const unsigned vA0 = RA[0] * ld + CB[0], vA1 = RA[1] * ld + CB[1], vB0 = RB[0] * ld + CB[0], vB1 = RB[1] * ld + CB[1];
    const size_t hA = (size_t)HALF * ld, hB = hA;
    PG8_STAGE(PG8_SB(0, 0), cB, vB0, vB1); PG8_STAGE(PG8_SB(0, 1), cB + hB, vB0, vB1); PG8_STAGE(PG8_SA(0, 0), cA, vA0, vA1); PG8_STAGE(PG8_SA(0, 1), cA + hA, vA0, vA1);
    if (wr == 1) PG8_BAR;
    PG8_WAIT_V(2); PG8_BAR;
    PG8_STAGE(PG8_SB(1, 0), cB + kstep, vB0, vB1); PG8_STAGE(PG8_SA(1, 0), cA + kstep, vA0, vA1); PG8_STAGE(PG8_SB(1, 1), cB + hB + kstep, vB0, vB1);
    PG8_WAIT_V(6); PG8_BAR;
    for (;;) {
        const bool has_next = S.next(ui + 1, nxt);
        const char* nA = has_next ? nxt.A : cA; const char* nB = has_next ? nxt.B : cB;
        const int nt = cur.nt;
        for (int t = 0; t < nt; t += 2) {
            const bool last = (t == nt - 2);
            const char* a1 = cA + (size_t)(t + 1) * kstep;
            const char* a2 = last ? nA : cA + (size_t)(t + 2) * kstep; const char* b2 = last ? nB : cB + (size_t)(t + 2) * kstep;
            const char* a3 = a2 + kstep; const char* b3 = b2 + kstep;
            PG8_LDB(B0, 0, 0); PG8_LDB(B1, 0, 1); PG8_SCHED; PG8_LDA(At, 0, 0); PG8_STAGE(PG8_SA(1, 1), a1 + hA, vA0, vA1);
            PG8_WAIT_V(8); PG8_WAIT_L(0); PG8_BAR; PG8_MMA(0, 0, At, B0); PG8_MMA(0, 1, At, B1); PG8_BAR; PG8_SCHED;
            PG8_LDA(At, 0, 1); PG8_STAGE(PG8_SB(0, 0), b2, vB0, vB1); PG8_STAGE(PG8_SB(0, 1), b2 + hB, vB0, vB1); PG8_STAGE(PG8_SA(0, 0), a2, vA0, vA1);
            PG8_WAIT_V(8); PG8_WAIT_L(0); PG8_BAR; PG8_MMA(1, 0, At, B0); PG8_MMA(1, 1, At, B1); PG8_BAR; PG8_SCHED;
            PG8_LDB(B0, 1, 0); PG8_LDB(B1, 1, 1); PG8_SCHED; PG8_LDA(At, 1, 0); PG8_STAGE(PG8_SA(0, 1), a2 + hA, vA0, vA1);
            PG8_WAIT_V(8); PG8_WAIT_L(0); PG8_BAR; PG8_MMA(0, 0, At, B0); PG8_MMA(0, 1, At, B1); PG8_BAR; PG8_SCHED;
            PG8_LDA(At, 1, 1); PG8_STAGE(PG8_SB(1, 0), b3, vB0, vB1); PG8_STAGE(PG8_SB(1, 1), b3 + hB, vB0, vB1); PG8_STAGE(PG8_SA(1, 0), a3, vA0, vA1);
            PG8_WAIT_V(8); PG8_WAIT_L(0); PG8_BAR; PG8_MMA(1, 0, At, B0); PG8_MMA(1, 1, At, B1); PG8_BAR; PG8_SCHED;
        }
        if constexpr (ALIGN_EPI) { if (wr == 0) PG8_BAR; }
        {
            const int el_ = fresh_lane(); const int fr_ = el_ & 15, fq_ = el_ >> 4;
#pragma unroll
            for (int ai = 0; ai < 2; ++ai)
#pragma unroll
                for (int m = 0; m < 4; ++m) { const int row = ai * HALF + wr * 64 + m * 16 + fr_;
                    if constexpr (Epi::PAIR) { float g[8], up[8];
#pragma unroll
                        for (int j = 0; j < 4; ++j) { g[j] = acc[ai][0][m][0][j]; g[4 + j] = acc[ai][0][m][1][j]; up[j] = acc[ai][1][m][0][j]; up[4 + j] = acc[ai][1][m][1][j]; }
                        E.store2(cur, row, wc * 32 + 8 * fq_, g, up); }
                    else {
#pragma unroll
                        for (int bj = 0; bj < 2; ++bj) { float v[8];
#pragma unroll
                            for (int j = 0; j < 4; ++j) { v[j] = acc[ai][bj][m][0][j]; v[4 + j] = acc[ai][bj][m][1][j]; }
                            E.store(cur, row, bj * HALF + wc * 32 + 8 * fq_, v); } } }
        }
        if (!has_next) break;
#pragma unroll
        for (int a = 0; a < 2; ++a)
#pragma unroll
            for (int b = 0; b < 2; ++b)
#pragma unroll
                for (int m = 0; m < 4; ++m)
#pragma unroll
                    for (int n = 0; n < 2; ++n) acc[a][b][m][n] = (f32x4){0.f, 0.f, 0.f, 0.f};
        cur = nxt; cA = nA; cB = nB; ++ui;
        if constexpr (ALIGN_EPI) { if (wr == 1) PG8_BAR; }
    }
    PG8_WAIT_V(0);
    if constexpr (!ALIGN_EPI) { if (wr == 0) PG8_BAR; }
    PG8_BAR;
#undef PG8_SA
#undef PG8_SB
#undef PG8_STAGE
#undef PG8_LDA
#undef PG8_LDB
#undef PG8_MMA
#undef PG8_WAIT_V
#undef PG8_WAIT_L
#undef PG8_BAR
#undef PG8_SCHED
}
}

namespace att {
typedef short bf16x8 __attribute__((ext_vector_type(8)));
typedef short s16x4 __attribute__((ext_vector_type(4)));
typedef float f32x16 __attribute__((ext_vector_type(16)));
typedef float f32x2_t __attribute__((ext_vector_type(2)));
typedef __bf16 bf16x2_t __attribute__((ext_vector_type(2)));
DI unsigned cvtpk(float lo, float hi) { f32x2_t v = {lo, hi}; bf16x2_t b = __builtin_convertvector(v, bf16x2_t); return __builtin_bit_cast(unsigned, b); }
DI int crow(int r, int h) { return (r & 3) + 8 * (r >> 2) + 4 * h; }

template <bool SWA>
DI void attn_phase(const Params& p, LAS unsigned char* lds, int G, int c) {
    constexpr int DK = SWA ? 64 : 192, DV = SWA ? 64 : 128, KSTR = DK * 2 + 16, VSTR = 136;
    constexpr int QB = SWA ? 2 : 1;
    constexpr int KB = 64 * KSTR, VB = DV * VSTR, STG = KB + VB;
    constexpr int CPR = DK / 8, NKC = (64 * CPR) / NTHREADS, NVC = (DV * 8) / NTHREADS, NQ = DK / 16, NDV = DV / 32;
    constexpr int LDQ = SWA ? 2048 : 1536, NUNITS = SWA ? 768 : 384;
    static_assert(2 * STG <= 131072, "attention LDS");
    const int tid = threadIdx.x, lane = tid & 63, wid = __builtin_amdgcn_readfirstlane(tid >> 6), q = lane & 31, hh = lane >> 5;
    const bf16_t* Q = wsp<bf16_t>(p, WS_Q); const bf16_t* KN = wsp<bf16_t>(p, SWA ? WS_KO : WS_KN); const bf16_t* KPE = wsp<bf16_t>(p, WS_KPE);
    const bf16_t* VT = wsp<bf16_t>(p, SWA ? WS_VTO : WS_VT); bf16_t* MIX = wsp<bf16_t>(p, WS_MIX);
    for (int L = c; L < NUNITS; L += G) {
        int rowbase, hk, nt0, nt1, key0a, key0b = 0, kpos0 = 0, qpos0 = 0; bool masked = false;
        if (!SWA) {
            if (L < 256) { const int b = L >> 5, qt = L & 3; hk = (L >> 2) & 7; rowbase = T_CTX + b * 1024 + qt * 256; key0a = T_CTX + b * 1024; nt0 = 16; key0b = T + b * 512; nt1 = 8; }
            else { const int Lc = L - 256, b = Lc >> 3; hk = Lc & 7; rowbase = b * 256; key0a = b * 256; nt0 = 4; nt1 = 0; }
        } else {
            if (L < 512) { const int b = L >> 6, t0 = (L & 15) * 64; hk = (L >> 4) & 3; rowbase = T_CTX + b * 1024 + t0;
                const int lo = max(t0 - 128, 0) & ~63, hi = min((t0 + 192 + 63) & ~63, 1024);
                key0a = T_CTX + b * 1024 + lo; nt0 = (hi - lo) >> 6; kpos0 = lo; qpos0 = t0; masked = true; key0b = T + b * 512; nt1 = 8; }
            else { const int Lc = L - 512, b = Lc >> 4; hk = (Lc >> 2) & 3; rowbase = b * 256 + (Lc & 3) * 64; key0a = b * 256; nt0 = 4; nt1 = 0; }
        }
        const int total = nt0 + nt1;
        const int qrow0 = SWA ? rowbase + q : rowbase + wid * 32 + q;
        const int qhead = SWA ? hk * 8 + wid : hk;
        bf16x8 qf[QB][NQ];
#pragma unroll
        for (int qb = 0; qb < QB; ++qb)
#pragma unroll
            for (int s = 0; s < NQ; ++s) qf[qb][s] = *(const bf16x8*)(Q + (size_t)(qrow0 + 32 * qb) * LDQ + qhead * DK + 16 * s + 8 * hh);
        f32x16 o[QB][NDV];
#pragma unroll
        for (int qb = 0; qb < QB; ++qb)
#pragma unroll
            for (int d = 0; d < NDV; ++d)
#pragma unroll
                for (int r = 0; r < 16; ++r) o[qb][d][r] = 0.f;
        float m[QB], l[QB];
#pragma unroll
        for (int qb = 0; qb < QB; ++qb) { m[qb] = SWA ? p.in[19][qhead] * LOG2E : -1e30f; l[qb] = (SWA && hh == 0) ? 1.f : 0.f; }
        const int qpos = qpos0 + q;
        u32x4 kreg[NKC], vreg[NVC];
#define ATT_LOAD(t_) do { const int tt_ = (t_); const int kb_ = tt_ < nt0 ? key0a + tt_ * 64 : key0b + (tt_ - nt0) * 64; \
            _Pragma("unroll") for (int i = 0; i < NKC; ++i) { const int ch = tid + NTHREADS * i, j = ch / CPR, cc = ch % CPR; \
                const bf16_t* src = SWA ? KN + (size_t)(kb_ + j) * 256 + hk * 64 + cc * 8 : (cc < 16 ? KN + (size_t)(kb_ + j) * 1024 + hk * 128 + cc * 8 : KPE + (size_t)(kb_ + j) * 64 + (cc - 16) * 8); \
                kreg[i] = *(const u32x4*)src; } \
            _Pragma("unroll") for (int i = 0; i < NVC; ++i) { const int ch = tid + NTHREADS * i, dv = ch >> 3, cc = ch & 7; \
                vreg[i] = *(const u32x4*)(VT + (size_t)(hk * DV + dv) * TX + kb_ + cc * 8); } } while (0)
#define ATT_WRITE(buf_) do { LAS unsigned char* Kw = lds + (buf_) * STG; LAS unsigned char* Vw = Kw + KB; \
            _Pragma("unroll") for (int i = 0; i < NKC; ++i) { const int ch = tid + NTHREADS * i, j = ch / CPR, cc = ch % CPR; *(LAS u32x4*)(Kw + j * KSTR + cc * 16) = kreg[i]; } \
            _Pragma("unroll") for (int i = 0; i < NVC; ++i) { const int ch = tid + NTHREADS * i, dv = ch >> 3, cc = ch & 7; \
                *(LAS u32x2*)(Vw + dv * VSTR + cc * 16) = (u32x2){vreg[i].x, vreg[i].y}; *(LAS u32x2*)(Vw + dv * VSTR + cc * 16 + 8) = (u32x2){vreg[i].z, vreg[i].w}; } } while (0)
        ATT_LOAD(0); ATT_WRITE(0);
        __syncthreads();
        for (int t = 0; t < total; ++t) {
            const int buf = t & 1;
            if (t + 1 < total) ATT_LOAD(t + 1);
            const LAS unsigned char* Kl = lds + buf * STG; const LAS unsigned char* Vl = Kl + KB;
#pragma unroll
            for (int qb = 0; qb < QB; ++qb) {
                f32x16 s0, s1;
#pragma unroll
                for (int r = 0; r < 16; ++r) { s0[r] = 0.f; s1[r] = 0.f; }
#pragma unroll
                for (int s = 0; s < NQ; ++s) {
                    const bf16x8 a0 = *(const LAS bf16x8*)(Kl + q * KSTR + (16 * s + 8 * hh) * 2);
                    const bf16x8 a1 = *(const LAS bf16x8*)(Kl + (32 + q) * KSTR + (16 * s + 8 * hh) * 2);
                    s0 = __builtin_amdgcn_mfma_f32_32x32x16_bf16(a0, qf[qb][s], s0, 0, 0, 0);
                    s1 = __builtin_amdgcn_mfma_f32_32x32x16_bf16(a1, qf[qb][s], s1, 0, 0, 0);
                }
                if (SWA && masked && t < nt0) {
                    const int kp = kpos0 + t * 64 - (qpos + 32 * qb);
#pragma unroll
                    for (int r = 0; r < 16; ++r) { const int d0 = kp + crow(r, hh), d1 = d0 + 32;
                        s0[r] = (d0 >= -128 && d0 <= 128) ? s0[r] : -1e30f; s1[r] = (d1 >= -128 && d1 <= 128) ? s1[r] : -1e30f; }
                }
                float tm = fmaxf(s0[0], s1[0]);
#pragma unroll
                for (int r = 1; r < 16; ++r) tm = fmaxf(tm, fmaxf(s0[r], s1[r]));
                tm = fmaxf(tm, __shfl_xor(tm, 32));
                const float mn = fmaxf(m[qb], tm);
                if (!__all(mn == m[qb])) {
                    const float alpha = __builtin_amdgcn_exp2f(m[qb] - mn); m[qb] = mn; l[qb] *= alpha;
#pragma unroll
                    for (int d = 0; d < NDV; ++d)
#pragma unroll
                        for (int r = 0; r < 16; ++r) o[qb][d][r] *= alpha; }
                float ls = 0.f;
#pragma unroll
                for (int r = 0; r < 16; ++r) { s0[r] = __builtin_amdgcn_exp2f(s0[r] - m[qb]); s1[r] = __builtin_amdgcn_exp2f(s1[r] - m[qb]); ls += s0[r] + s1[r]; }
                l[qb] += ls;
                bf16x8 pb[2][2];
#pragma unroll
                for (int s = 0; s < 2; ++s) {
                    u32x4 w0, w1;
                    w0.x = cvtpk(s0[8 * s + 0], s0[8 * s + 1]); w0.y = cvtpk(s0[8 * s + 2], s0[8 * s + 3]); w0.z = cvtpk(s0[8 * s + 4], s0[8 * s + 5]); w0.w = cvtpk(s0[8 * s + 6], s0[8 * s + 7]);
                    w1.x = cvtpk(s1[8 * s + 0], s1[8 * s + 1]); w1.y = cvtpk(s1[8 * s + 2], s1[8 * s + 3]); w1.z = cvtpk(s1[8 * s + 4], s1[8 * s + 5]); w1.w = cvtpk(s1[8 * s + 6], s1[8 * s + 7]);
                    pb[0][s] = __builtin_bit_cast(bf16x8, w0); pb[1][s] = __builtin_bit_cast(bf16x8, w1);
                }
#pragma unroll
                for (int d = 0; d < NDV; ++d)
#pragma unroll
                    for (int blk = 0; blk < 2; ++blk)
#pragma unroll
                        for (int s = 0; s < 2; ++s) {
                            const LAS unsigned char* vp = Vl + (d * 32 + q) * VSTR + (blk * 32 + 16 * s + 4 * hh) * 2;
                            const s16x4 lo = *(const LAS s16x4*)vp, hi = *(const LAS s16x4*)(vp + 16);
                            const bf16x8 a = {lo[0], lo[1], lo[2], lo[3], hi[0], hi[1], hi[2], hi[3]};
                            o[qb][d] = __builtin_amdgcn_mfma_f32_32x32x16_bf16(a, pb[blk][s], o[qb][d], 0, 0, 0);
                        }
                if (QB > 1) __builtin_amdgcn_sched_barrier(0);
            }
            if (t + 1 < total) ATT_WRITE(buf ^ 1);
            __syncthreads();
        }
#undef ATT_LOAD
#undef ATT_WRITE
#pragma unroll
        for (int qb = 0; qb < QB; ++qb) {
            const float inv = 1.f / (l[qb] + __shfl_xor(l[qb], 32));
            bf16_t* orow = MIX + (size_t)(qrow0 + 32 * qb) * 2048 + qhead * DV;
#pragma unroll
            for (int d = 0; d < NDV; ++d)
#pragma unroll
                for (int g = 0; g < 4; ++g) { u32x2 w; w.x = cvtpk(o[qb][d][4 * g] * inv, o[qb][d][4 * g + 1] * inv); w.y = cvtpk(o[qb][d][4 * g + 2] * inv, o[qb][d][4 * g + 3] * inv);
                    *(u32x2*)(orow + d * 32 + 8 * g + 4 * hh) = w; }
        }
    }
}
}


#ifndef R_PRO
#define R_PRO 1
#endif
#ifndef R_MOE
#define R_MOE 1
#endif
#ifndef R_ATT
#define R_ATT 1
#endif
#ifndef R_ATTM
#define R_ATTM R_ATT
#endif
#ifndef R_ATTS
#define R_ATTS R_ATT
#endif
#ifndef R_GEMM
#define R_GEMM 1
#endif
#ifndef R_THIN
#define R_THIN 1
#endif
#ifndef R_LN1
#define R_LN1 1
#endif
#ifndef R_LN2
#define R_LN2 1
#endif
#ifndef R_TOPK
#define R_TOPK 1
#endif
#define REP(n) for (int _r = 0; _r < (n); ++_r)
#define REPS(n, ...) do { { __VA_ARGS__ } if ((n) > 1) { __VA_ARGS__ } } while (0)
constexpr int LDS_BYTES = 147456, MISC_OFF = 146432;
constexpr int NPH = 20;
#ifndef CVT_WAVES
#define CVT_WAVES 2
#endif
constexpr int CV_IDLE = 10240;
__global__ void __launch_bounds__(NTHREADS, 2) mega(Params p) {
    extern __shared__ __attribute__((aligned(16))) unsigned char lds[];
    const int G = gridDim.x, c = vcu_of(blockIdx.x, G), wid = __builtin_amdgcn_readfirstlane(threadIdx.x >> 6);
    volatile LAS unsigned* MISC = (volatile LAS unsigned*)((LAS unsigned char*)lds + MISC_OFF);
    if (threadIdx.x < 4) MISC[threadIdx.x] = 0u;
    __syncthreads();
    XcdBarrier bar = xcd_barrier_post((unsigned*)(p.ws + WS_CTL) + CW_BAR, MISC);
    const int lo = p.ph_lo, hi = p.ph_hi;
#define IN(k) (lo <= (k) && (k) < hi)
#ifdef STAMP_A
    unsigned long long* stamps_ = wsp<unsigned long long>(p, WS_DBG + 65536);
#define STAMP(k) do { if (blockIdx.x == 0 && threadIdx.x == 0) stamps_[k] = __builtin_amdgcn_s_memrealtime(); } while (0)
#else
#define STAMP(k) do { } while (0)
#endif
    STAMP(0); STAMP(23);
#ifndef R_BAR
#define R_BAR 1
#endif
#define SEAM(k) do { if (IN(k) && IN((k) + 1)) { xcd_barrier(bar); if (R_BAR > 1) xcd_barrier(bar); } STAMP((k) + 1); } while (0)
    if (IN(0)) REP(R_PRO) { ph_mod(p, lds); STAMP(21); ph_misc(p); STAMP(22); ph_convert(p, 0, G == 256 ? CV_TOTAL - 3 * CV_IDLE : CV_TOTAL, blockIdx.x, G, CVT_WAVES);
#ifdef RD_PAT
        ph_readonly<RD_PAT>(p);
#endif
    } SEAM(0);
    if (IN(1)) REP(R_THIN) { ph_modreduce(p); ph_h0(p); } SEAM(1);
    if (IN(2)) { REPS(R_GEMM, SchedInEven S{&p, G, c}; EpiInEven E{&p}; pg8::gemm_phase((LAS unsigned char*)lds, S, E, wid);); if (G == 256 && c >= 128) ph_convert(p, CV_TOTAL - 3 * CV_IDLE, CV_TOTAL - 2 * CV_IDLE, c - 128, 128, CVT_WAVES); } SEAM(2);
    if (IN(3)) REP(R_THIN) { ph_e1(p); } SEAM(3);
    if (IN(4)) REPS(R_GEMM, SchedE2 S{&p, G, c}; EpiE2 E{&p}; pg8::gemm_phase((LAS unsigned char*)lds, S, E, wid);); SEAM(4);
    if (IN(5)) REP(R_ATTM) { att::attn_phase<false>(p, (LAS unsigned char*)lds, G, c); } SEAM(5);
    if (IN(6)) { REPS(R_GEMM, SchedOut S{&p, G, c, 0}; EpiOut E{&p, 0}; pg8::gemm_phase((LAS unsigned char*)lds, S, E, wid);); if (G == 256 && c >= 128) ph_convert(p, CV_TOTAL - 2 * CV_IDLE, CV_TOTAL - CV_IDLE, c - 128, 128, CVT_WAVES); } SEAM(6);
    if (IN(7)) REP(R_LN1) { ph_ln1(p, 0, lds); } SEAM(7);
    if (IN(8)) REP(R_TOPK) { ph_topk(p, lds); } SEAM(8);
    if (IN(9)) REPS(R_MOE, SchedGU S{&p, G, c, 0}; EpiGU E{&p}; pg8::gemm_phase((LAS unsigned char*)lds, S, E, wid);); SEAM(9);
    if (IN(10)) REPS(R_MOE, SchedDown S{&p, G, c, 0}; EpiDown E{&p}; pg8::gemm_phase((LAS unsigned char*)lds, S, E, wid);); SEAM(10);
    if (IN(11)) REP(R_LN2) { ph_ln2(p, 0); } SEAM(11);
    if (IN(12)) REPS(R_GEMM, SchedInOdd S{&p, G, c}; EpiInOdd E{&p}; pg8::gemm_phase((LAS unsigned char*)lds, S, E, wid);); SEAM(12);
    if (IN(13)) REP(R_ATTS) { att::attn_phase<true>(p, (LAS unsigned char*)lds, G, c); } SEAM(13);
    if (IN(14)) { REPS(R_GEMM, SchedOut S{&p, G, c, 1}; EpiOut E{&p, 1}; pg8::gemm_phase((LAS unsigned char*)lds, S, E, wid);); if (G == 256 && c >= 128) ph_convert(p, CV_TOTAL - CV_IDLE, CV_TOTAL, c - 128, 128, CVT_WAVES); } SEAM(14);
    if (IN(15)) REP(R_LN1) { ph_ln1(p, 1, lds); } SEAM(15);
    if (IN(16)) REP(R_TOPK) { ph_topk(p, lds); } SEAM(16);
    if (IN(17)) REPS(R_MOE, SchedGU S{&p, G, c, 1}; EpiGU E{&p}; pg8::gemm_phase((LAS unsigned char*)lds, S, E, wid);); SEAM(17);
    if (IN(18)) REPS(R_MOE, SchedDown S{&p, G, c, 1}; EpiDown E{&p}; pg8::gemm_phase((LAS unsigned char*)lds, S, E, wid);); SEAM(18);
    if (IN(19)) REP(R_LN2) { ph_ln2(p, 1); }
#ifdef STAMP_A
    STAMP(20);
    if (blockIdx.x == 0 && threadIdx.x == 0) {
        asm volatile("s_waitcnt vmcnt(0)" ::: "memory");
        const unsigned long long d = (__hip_atomic_load(&stamps_[STAMP_B], __ATOMIC_RELAXED, __HIP_MEMORY_SCOPE_AGENT) - __hip_atomic_load(&stamps_[STAMP_A], __ATOMIC_RELAXED, __HIP_MEMORY_SCOPE_AGENT)) * 4ull;
        const unsigned long long t0 = __builtin_amdgcn_s_memrealtime();
        while (__builtin_amdgcn_s_memrealtime() - t0 < d) __builtin_amdgcn_s_sleep(8);
    }
#endif
#undef IN
#undef SEAM
}

extern "C" void kernel_launch(void* const* d_in, const int* in_sizes, int n_in, void* d_out, int out_size, void* d_ws, size_t ws_size, hipStream_t stream) {
    static int grid = 0;
    if (grid == 0) {
        if (n_in != 29 || out_size != (int)O_END || ws_size < WS_END) { fprintf(stderr, "kernel_launch: unexpected shapes (n_in %d out %d ws %zu need %zu)\n", n_in, out_size, ws_size, (size_t)WS_END); grid = -1; return; }
        int dev = 0, cus = 0, per_cu = 0;
        if (hipGetDevice(&dev) != hipSuccess || hipDeviceGetAttribute(&cus, hipDeviceAttributeMultiprocessorCount, dev) != hipSuccess) { grid = -1; return; }
        if (hipFuncSetAttribute((const void*)mega, hipFuncAttributeMaxDynamicSharedMemorySize, LDS_BYTES) != hipSuccess) { fprintf(stderr, "hipFuncSetAttribute failed\n"); grid = -1; return; }
        if (hipOccupancyMaxActiveBlocksPerMultiprocessor(&per_cu, (const void*)mega, NTHREADS, LDS_BYTES) != hipSuccess || per_cu < 1) fprintf(stderr, "occupancy query: %d\n", per_cu);
        (void)hipGetLastError();
        grid = cus > 0 ? cus : 256;
    }
    if (grid < 0) return;
    Params p{};
    for (int i = 0; i < 29; ++i) p.in[i] = (const float*)d_in[i];
    p.out = (float*)d_out; p.ws = (unsigned char*)d_ws; p.ph_lo = 0; p.ph_hi = NPH;
    (void)hipMemsetAsync((char*)d_ws + WS_CTL, 0, CTL_BYTES, stream);
    hipLaunchKernelGGL(mega, dim3(grid), dim3(NTHREADS), LDS_BYTES, stream, p);
}
```

```cpp
#include <hip/hip_runtime.h>
#include <cstdio>
#include <cstdint>

constexpr int D = 2048, T_CTX = 4096, T = 12288, TC = 4096, TX = 16384;
constexpr int MODW = 12288, NCOND = 9;
constexpr int NSLOT = 1536, NXS = 16 * NSLOT;
constexpr float DN_ALPHA = 1.41421356237309515f;
constexpr float LOG2E = 1.44269504088896341f;
constexpr float QS_MLA = 0.07216878364870322f * LOG2E;
constexpr float QS_SWA = 0.125f * LOG2E;
constexpr int NTHREADS = 512, NWAVES = 8;
#ifndef MOE_F8
#define MOE_F8 1
#endif
#ifndef OUT_F8
#define OUT_F8 1
#endif
constexpr float GU_WSCALE = 32.f, DN_WSCALE = 64.f, OUT_WSCALE = 64.f;

constexpr size_t O_Y = 0, O_CKV = 25165824, O_KPE = 26214400, O_SK = 26476544, O_SV = 27525120, O_END = 28573696;

constexpr size_t al256(size_t x) { return (x + 255) & ~(size_t)255; }
constexpr size_t WS_CTL = 0, CTL_BYTES = 1u << 20;
constexpr size_t WS_MOD = WS_CTL + CTL_BYTES;
constexpr size_t WS_ROPE = WS_MOD + al256((size_t)2 * 9 * 12288 * 4);
constexpr size_t WS_WINE = WS_ROPE + al256((size_t)2 * 1024 * 32 * 4);
constexpr size_t WS_W2 = WS_WINE + (size_t)2048 * 2048 * 2;
constexpr size_t WS_WOUTE = WS_W2 + (size_t)4608 * 1792 * 2;
constexpr size_t WS_WINO = WS_WOUTE + (size_t)2048 * 2048 * 2;
constexpr size_t WS_WOUTO = WS_WINO + (size_t)2560 * 2048 * 2;
constexpr size_t WS_WGU = WS_WOUTO + (size_t)2048 * 2048 * 2;
constexpr size_t WS_WDN = WS_WGU + (size_t)32 * 4096 * 2048 * 2;
constexpr size_t WS_H = WS_WDN + (size_t)32 * 2048 * 2048 * 2;
constexpr size_t WS_PJ = WS_H + (size_t)T * 2048 * 2;
constexpr size_t WS_ACT2 = WS_PJ + (size_t)T * 1792 * 4;
constexpr size_t WS_KPE = WS_ACT2 + (size_t)TX * 1792 * 2;
constexpr size_t WS_Q = WS_KPE + (size_t)TX * 64 * 2;
constexpr size_t WS_KN = WS_Q + (size_t)T * 2048 * 2;
constexpr size_t WS_VT = WS_KN + (size_t)TX * 1024 * 2;
constexpr size_t WS_VTO = WS_VT + (size_t)1024 * TX * 2;
constexpr size_t WS_KO = WS_VTO + (size_t)256 * TX * 2;
constexpr size_t WS_MIX = WS_KO + (size_t)TX * 256 * 2;
constexpr size_t WS_Y = WS_MIX + (size_t)T * 2048 * 2;
constexpr size_t WS_X1 = WS_Y + (size_t)T * 2048 * 4;
constexpr size_t WS_XL = WS_X1 + (size_t)T * 2048 * 4;
constexpr size_t WS_AFF = WS_XL + (size_t)T * 2048 * 4;
constexpr size_t WS_INV = WS_AFF + (size_t)T * 16 * 4;
constexpr size_t WS_XS = WS_INV + (size_t)T * 16 * 4;
constexpr size_t WS_HID = WS_XS + (size_t)NXS * 2048 * 2;
constexpr size_t WS_YE = WS_HID + (size_t)NXS * 2048 * 2;
constexpr size_t WS_AFFT = WS_YE + (size_t)NXS * 2048 * 2;
constexpr size_t WS_H8 = WS_AFFT + (size_t)T * 16 * 4;
constexpr size_t WS_STAT = WS_H8 + (size_t)T * 2048;
constexpr size_t WS_MODP = WS_STAT + (size_t)T * 8;
constexpr size_t WS_GB = WS_MODP + (size_t)4 * 2 * 9 * 12288 * 4;
constexpr size_t WS_DBG = WS_GB + (size_t)2 * 9 * 2 * 2048 * 4;
constexpr size_t WS_END = WS_DBG + (1u << 20);

typedef unsigned short bf16_t;
typedef float f32x4 __attribute__((ext_vector_type(4)));
typedef unsigned u32x4 __attribute__((ext_vector_type(4)));
typedef unsigned u32x2 __attribute__((ext_vector_type(2)));
typedef float f32x2 __attribute__((ext_vector_type(2)));
#define LAS __attribute__((address_space(3)))
#define DI __device__ __forceinline__

struct Params {
    const float* in[29];
    float* out;
    unsigned char* ws;
    int ph_lo, ph_hi;
    int rpb, pad;
};

DI unsigned f2bf(float f) { unsigned u = __float_as_uint(f); return (u + 0x7fffu + ((u >> 16) & 1u)) >> 16; }
DI unsigned pk2(float lo, float hi) { return f2bf(lo) | (f2bf(hi) << 16); }
DI unsigned pk4_fp8(float a, float b, float c, float d) { unsigned w = 0; w = __builtin_amdgcn_cvt_pk_fp8_f32(a, b, w, false); w = __builtin_amdgcn_cvt_pk_fp8_f32(c, d, w, true); return w; }
DI float bf2f(unsigned b) { return __uint_as_float(b << 16); }
DI float bflo(unsigned w) { return __uint_as_float(w << 16); }
DI float bfhi(unsigned w) { return __uint_as_float(w & 0xffff0000u); }
DI float wave_sum(float v) {
#pragma unroll
    for (int o = 1; o < 64; o <<= 1) v += __shfl_xor(v, o);
    return v;
}
DI float wave_max(float v) {
#pragma unroll
    for (int o = 1; o < 64; o <<= 1) v = fmaxf(v, __shfl_xor(v, o));
    return v;
}
DI int fresh_lane() { int l = (int)__builtin_amdgcn_mbcnt_hi(~0u, __builtin_amdgcn_mbcnt_lo(~0u, 0u)); asm volatile("" : "+v"(l)); return l; }
DI int cond_of_row(int r) { return r < T_CTX ? 0 : 1 + ((r - T_CTX) >> 10); }
DI const float* xrow_in(const Params& p, int r) { return r < T_CTX ? p.in[0] + (size_t)r * D : p.in[1] + (size_t)(r - T_CTX) * D; }

DI float* ws_mod(const Params& p) { return (float*)(p.ws + WS_MOD); }
DI float* ws_cos(const Params& p) { return (float*)(p.ws + WS_ROPE); }
DI float* ws_sin(const Params& p) { return (float*)(p.ws + WS_ROPE) + 1024 * 32; }
template <class X> DI X* wsp(const Params& p, size_t off) { return (X*)(p.ws + off); }
DI const float* modp(const Params& p, int l, int ci, int j) { return ws_mod(p) + ((size_t)(l * 9 + ci) * MODW + (size_t)j * D); }

#define XB_TMO      128
#define XB_XCNT(j)  (256  + 64 * (j))
#define XB_XSUB(j)  (1280 + 64 * (j))
#define XB_XGEN(j)  (2304 + 64 * (j))
#define XB_TOP      3328
#define XB_TOPGEN   3392
#define XCD_BAR_WORDS 3456
#define XB_SPIN_CAP (1u << 18)

__device__ __forceinline__ unsigned xb_ld(unsigned* p)              { return __hip_atomic_load(p, __ATOMIC_RELAXED, __HIP_MEMORY_SCOPE_AGENT); }
__device__ __forceinline__ unsigned xb_add(unsigned* p, unsigned v) { return __hip_atomic_fetch_add(p, v, __ATOMIC_RELAXED, __HIP_MEMORY_SCOPE_AGENT); }
__device__ __forceinline__ unsigned xb_xcc_id() { return (unsigned)__builtin_amdgcn_s_getreg((3 << 11) | 20) & 0xFu; }
#define XB_SPIN(cond, bar) do { unsigned _sp = 0; while (cond) { __builtin_amdgcn_s_sleep(1); \
    if ((++_sp & 255u) == 0u) { if (xb_ld(&(bar)[XB_TMO])) break; if (_sp > XB_SPIN_CAP) { atomicAdd(&(bar)[XB_TMO], 1u); break; } } } } while (0)

struct XcdBarrier {
    unsigned* bar; unsigned x;
    volatile LAS unsigned* st;
};

__device__ __forceinline__ XcdBarrier xcd_barrier_post(unsigned* bar, volatile LAS unsigned* st) {
    XcdBarrier b; b.bar = bar; b.x = xb_xcc_id(); b.st = st;
    if (threadIdx.x == 0) (void)xb_add(&bar[XB_XCNT(b.x)], 1u);
    return b;
}
__device__ __forceinline__ void xcd_barrier_complete(unsigned* bar, unsigned x, unsigned& nloc, unsigned& nx) {
    const unsigned G = gridDim.x * gridDim.y * gridDim.z;
    unsigned sum, cnt, mine, sp = 0u;
    for (;;) {
        sum = 0u; cnt = 0u; mine = 0u;
#pragma unroll
        for (unsigned j = 0; j < 16; ++j) { const unsigned c = xb_ld(&bar[XB_XCNT(j)]); sum += c; cnt += (c > 0u) ? 1u : 0u; mine = (j == x) ? c : mine; }
        if (sum == G) break;
        __builtin_amdgcn_s_sleep(1);
        if ((++sp & 255u) == 0u) { if (xb_ld(&bar[XB_TMO])) break; if (sp > XB_SPIN_CAP) { atomicAdd(&bar[XB_TMO], 1u); break; } }
    }
    nloc = mine > 0u ? mine : 1u; nx = cnt > 0u ? cnt : 1u;
}

__device__ __forceinline__ void xcd_barrier(const XcdBarrier& b) {
    asm volatile("s_waitcnt vmcnt(0)" ::: "memory");
    __syncthreads();
    if (threadIdx.x == 0) {
        unsigned* bar = b.bar;
        __builtin_amdgcn_s_waitcnt(0);
        unsigned nloc = b.st[0], nx = b.st[1];
        if (nloc == 0u) { xcd_barrier_complete(bar, b.x, nloc, nx); b.st[0] = nloc; b.st[1] = nx; }
        const unsigned old = xb_add(&bar[XB_XSUB(b.x)], 1u);
        const unsigned gen = old / nloc;
        if (old + 1u == (gen + 1u) * nloc) {
            __builtin_amdgcn_fence(__ATOMIC_RELEASE, "agent");
            asm volatile("s_waitcnt vmcnt(0)" ::: "memory");
            const unsigned og = xb_add(&bar[XB_TOP], 1u);
            const unsigned tg = og / nx;
            if (og + 1u == (tg + 1u) * nx) xb_add(&bar[XB_TOPGEN], 1u);
            else XB_SPIN(xb_ld(&bar[XB_TOPGEN]) == tg, bar);
            __builtin_amdgcn_fence(__ATOMIC_ACQUIRE, "agent");
            xb_add(&bar[XB_XGEN(b.x)], 1u);
            asm volatile("s_waitcnt vmcnt(0)" ::: "memory");
        } else {
            XB_SPIN(xb_ld(&bar[XB_XGEN(b.x)]) == gen, bar);
            __builtin_amdgcn_fence(__ATOMIC_ACQUIRE, "agent");
            asm volatile("s_waitcnt vmcnt(0)" ::: "memory");
        }
    }
    __syncthreads();
}
constexpr int CW_BAR = 4096;


DI void ph_mod(const Params& p, int wid_, unsigned char* lds_raw) {
    float* s_q = (float*)lds_raw;
    float* red = s_q + 9 * 512;
    const int tid = (wid_ * 64 + fresh_lane()), lane = tid & 63, wave = wid_;
    const float* c = p.in[6]; const float* c_ctx = p.in[7]; const float* w_ada = p.in[8];
    float* MODP = wsp<float>(p, WS_MODP);
    for (int it = blockIdx.x; it < 384; it += gridDim.x) {
        const int l = it / 192, rem = it % 192, cg = rem >> 2, kq4 = rem & 3;
        for (int i = tid; i < 9 * 512; i += NTHREADS) { const int ci = i >> 9, k = kq4 * 512 + (i & 511); const float v = ci == 0 ? c_ctx[k] : c[(ci - 1) * 2048 + k]; s_q[i] = v / (1.f + expf(-v)); }
        __syncthreads();
        const float* w = w_ada + ((size_t)l * 2048 + kq4 * 512 + wave * 64) * MODW + cg * 256 + 4 * lane;
        float acc[9][4];
#pragma unroll
        for (int ci = 0; ci < 9; ++ci)
#pragma unroll
            for (int j = 0; j < 4; ++j) acc[ci][j] = 0.f;
#pragma unroll 8
        for (int kk = 0; kk < 64; ++kk) {
            const f32x4 wv = __builtin_nontemporal_load((const f32x4*)(w + (size_t)kk * MODW));
#pragma unroll
            for (int ci = 0; ci < 9; ++ci) { const float s = s_q[ci * 512 + wave * 64 + kk];
#pragma unroll
                for (int j = 0; j < 4; ++j) acc[ci][j] += s * wv[j]; }
        }
#pragma unroll
        for (int ci = 0; ci < 9; ++ci) *(f32x4*)(red + (wave * 9 + ci) * 256 + 4 * lane) = (f32x4){acc[ci][0], acc[ci][1], acc[ci][2], acc[ci][3]};
        __syncthreads();
        for (int o = tid; o < 9 * 256; o += NTHREADS) { const int ci = o >> 8, cc = o & 255; float s = 0.f;
#pragma unroll
            for (int w8 = 0; w8 < 8; ++w8) s += red[(w8 * 9 + ci) * 256 + cc];
            MODP[((size_t)(kq4 * 2 + l) * 9 + ci) * MODW + cg * 256 + cc] = s; }
        __syncthreads();
    }
}
DI void ph_modreduce(const Params& p, int wid_) {
    const float* MODP = wsp<float>(p, WS_MODP); float* MOD = ws_mod(p); const float* b_ada = p.in[9];
    const int n4 = 2 * 9 * MODW / 4;
    for (int i = blockIdx.x * NTHREADS + (wid_ * 64 + fresh_lane()); i < n4; i += gridDim.x * NTHREADS) { const int e = i * 4, l = e / (9 * MODW), col = e % MODW;
        f32x4 s = *(const f32x4*)(b_ada + l * MODW + col);
#pragma unroll
        for (int q = 0; q < 4; ++q) s += *(const f32x4*)(MODP + (size_t)q * 2 * 9 * MODW + e);
        *(f32x4*)(MOD + e) = s; }
}
DI f32x4 mod_from_partials(const Params& p, int l, int ci, int j, int col) {
    const float* MODP = wsp<float>(p, WS_MODP); const size_t e = (size_t)(l * 9 + ci) * MODW + (size_t)j * D + col;
    f32x4 s = *(const f32x4*)(p.in[9] + l * MODW + j * D + col);
#pragma unroll
    for (int q = 0; q < 4; ++q) s += *(const f32x4*)(MODP + (size_t)q * 2 * 9 * MODW + e);
    return s;
}

constexpr int CV_INE = 928, CV_UQ = 192, CV_UKV = 128, CV_POOL = 64, CV_OUT = 1024, CV_INO = 1280, CV_MOE = 98304;
constexpr int CV_TOTAL = CV_INE + CV_UQ + CV_UKV + CV_POOL + CV_OUT + CV_INO + CV_OUT + CV_MOE;
DI void cvt_item(const Params& p, int item, int lane) {
    const float* src; bf16_t* dst; int K, N, ldd, nb, kb, map = 0, a = 0; float f8s = 0.f;
    if (item < CV_INE) { src = p.in[10]; dst = wsp<bf16_t>(p, WS_WINE); K = 2048; N = 1856; ldd = 2048; nb = item % 29; kb = item / 29; map = 1; }
    else if ((item -= CV_INE) < CV_UQ) { src = p.in[13]; dst = wsp<bf16_t>(p, WS_W2); K = 512; N = 1536; ldd = 1792; nb = item % 24; kb = item / 24; }
    else if ((item -= CV_UQ) < CV_UKV) { src = p.in[14]; dst = wsp<bf16_t>(p, WS_W2); K = 256; N = 2048; ldd = 1792; nb = item % 32; kb = item / 32; map = 2; }
    else if ((item -= CV_UKV) < CV_POOL) { const int g = item >> 4, r = item & 15; src = p.in[15] + (size_t)g * 65536; dst = wsp<bf16_t>(p, WS_W2); K = 256; N = 256; ldd = 1792; nb = r & 3; kb = r >> 2; a = 3584 + g * 256; }
    else if ((item -= CV_POOL) < CV_OUT) { src = p.in[17]; dst = wsp<bf16_t>(p, WS_WOUTE); K = 2048; N = 2048; ldd = 2048; nb = item & 31; kb = item >> 5; if (OUT_F8) f8s = OUT_WSCALE; }
    else if ((item -= CV_OUT) < CV_INO) { src = p.in[18]; dst = wsp<bf16_t>(p, WS_WINO); K = 2048; N = 2560; ldd = 2048; nb = item % 40; kb = item / 40; }
    else if ((item -= CV_INO) < CV_OUT) { src = p.in[20]; dst = wsp<bf16_t>(p, WS_WOUTO); K = 2048; N = 2048; ldd = 2048; nb = item & 31; kb = item >> 5; if (OUT_F8) f8s = OUT_WSCALE; }
    else { item -= CV_OUT; const int mat = item >> 10, w = item & 1023, le = mat / 3, kind = mat % 3; K = 2048; N = 2048; ldd = 2048; nb = w & 31; kb = w >> 5;
        src = p.in[24 + kind] + (size_t)le * 2048 * 2048;
        if (kind == 2) dst = wsp<bf16_t>(p, WS_WDN) + (size_t)le * 2048 * 2048; else { dst = wsp<bf16_t>(p, WS_WGU) + (size_t)le * 4096 * 2048; map = 3; a = kind * 128; }
        if (MOE_F8) { f8s = kind == 2 ? DN_WSCALE : GU_WSCALE; dst = (bf16_t*)((unsigned char*)(kind == 2 ? wsp<bf16_t>(p, WS_WDN) : wsp<bf16_t>(p, WS_WGU)) + (size_t)le * (kind == 2 ? 2048 : 4096) * 2048); } }
    const int n = nb * 64 + lane;
    const float* s = src + (size_t)(kb * 64) * N + n;
    float v[64];
#pragma unroll
    for (int k = 0; k < 64; ++k) v[k] = __builtin_nontemporal_load(s + (size_t)k * N);
    int drow;
    if (map == 0) drow = n + a;
    else if (map == 1) drow = n < 768 ? n : (n < 832 ? 1792 + (n - 768) : 768 + (n - 832));
    else if (map == 2) { const int h = n >> 8, j = n & 255; drow = j < 128 ? 1536 + h * 128 + j : 2560 + h * 128 + (j - 128); }
    else drow = (n >> 7) * 256 + (n & 127) + a;
    if (f8s != 0.f) { u32x4* d8 = (u32x4*)((unsigned char*)dst + (size_t)drow * 2048 + kb * 64);
#pragma unroll
        for (int c16 = 0; c16 < 4; ++c16) { u32x4 o; const float* w = v + 16 * c16;
            o.x = pk4_fp8(w[0] * f8s, w[1] * f8s, w[2] * f8s, w[3] * f8s); o.y = pk4_fp8(w[4] * f8s, w[5] * f8s, w[6] * f8s, w[7] * f8s); o.z = pk4_fp8(w[8] * f8s, w[9] * f8s, w[10] * f8s, w[11] * f8s); o.w = pk4_fp8(w[12] * f8s, w[13] * f8s, w[14] * f8s, w[15] * f8s); d8[c16] = o; }
        return; }
    u32x4* d = (u32x4*)(dst + (size_t)drow * ldd + kb * 64);
#pragma unroll
    for (int c8 = 0; c8 < 8; ++c8) { u32x4 o; o.x = pk2(v[8 * c8], v[8 * c8 + 1]); o.y = pk2(v[8 * c8 + 2], v[8 * c8 + 3]); o.z = pk2(v[8 * c8 + 4], v[8 * c8 + 5]); o.w = pk2(v[8 * c8 + 6], v[8 * c8 + 7]); d[c8] = o; }
}
DI void ph_convert(const Params& p, int wid_, int item_lo, int item_hi, int bid, int nblk, int nwv) {
    const int wv_ = wid_; if (wv_ >= nwv) return;
    const int lane = (wid_ * 64 + fresh_lane()) & 63, gw = bid * nwv + wv_, NGW = nblk * nwv;
    for (int it = item_lo + gw; it < item_hi; it += NGW) cvt_item(p, it, lane);
}

DI void ph_misc(const Params& p, int wid_) {
    const size_t gt = (size_t)blockIdx.x * NTHREADS + (wid_ * 64 + fresh_lane()), NGT = (size_t)gridDim.x * NTHREADS;
    float* cosT = ws_cos(p); float* sinT = ws_sin(p);
    for (size_t i = gt; i < 1024 * 32; i += NGT) { const int s = (int)(i >> 5), f = (int)(i & 31);
        const float inv = powf(10000.f, -(float)(f & 15) / 16.f); const float pos = f < 16 ? (float)(s >> 6) : (float)(s & 63); const float ang = pos * inv;
        cosT[i] = cosf(ang); sinT[i] = sinf(ang); }
    bf16_t* ACT2 = wsp<bf16_t>(p, WS_ACT2); bf16_t* KPE = wsp<bf16_t>(p, WS_KPE); bf16_t* KO = wsp<bf16_t>(p, WS_KO); bf16_t* VTO = wsp<bf16_t>(p, WS_VTO);
    const float* cckv = p.in[2]; const float* ckpe = p.in[3]; const float* csk = p.in[4]; const float* csv = p.in[5];
    for (size_t i = gt; i < (size_t)TC * 256 / 4; i += NGT) { const size_t e = i * 4; const int j = (int)(e >> 8), cc = (int)(e & 255); const f32x4 v = *(const f32x4*)(cckv + e);
        u32x2 o; o.x = pk2(v[0], v[1]); o.y = pk2(v[2], v[3]); *(u32x2*)(ACT2 + (size_t)(T + j) * 1792 + 512 + cc) = o;
        const f32x4 k = *(const f32x4*)(csk + e); u32x2 o2; o2.x = pk2(k[0], k[1]); o2.y = pk2(k[2], k[3]); *(u32x2*)(KO + (size_t)(T + j) * 256 + cc) = o2; }
    for (size_t i = gt; i < (size_t)TC * 64 / 4; i += NGT) { const size_t e = i * 4; const f32x4 v = *(const f32x4*)(ckpe + e); u32x2 o; o.x = pk2(v[0], v[1]); o.y = pk2(v[2], v[3]); *(u32x2*)(KPE + (size_t)T * 64 + e) = o; }
    for (size_t i = gt; i < (size_t)256 * (TC / 8); i += NGT) { const int f = (int)(i / (TC / 8)), j8 = (int)(i % (TC / 8)) * 8; float v[8];
#pragma unroll
        for (int q = 0; q < 8; ++q) v[q] = csv[(size_t)(j8 + q) * 256 + f];
        u32x4 o; o.x = pk2(v[0], v[1]); o.y = pk2(v[2], v[3]); o.z = pk2(v[4], v[5]); o.w = pk2(v[6], v[7]); *(u32x4*)(VTO + (size_t)f * TX + T + j8) = o; }
}

DI void ph_h0(const Params& p, int wid_, unsigned char* lds_raw) {
    const int tid = (wid_ * 64 + fresh_lane()), lane = tid & 63, wv = wid_;
    const int rpb = p.rpb, rb0 = blockIdx.x * rpb, rb1 = min(rb0 + rpb, T);
    if (rb0 >= T) return;
    LAS float* P = (LAS float*)lds_raw;
    const int c_lo = cond_of_row(rb0);
    for (int i = tid; i < 2 * 2 * 512; i += NTHREADS) { const int cc = i >> 10, j = (i >> 9) & 1, col = (i & 511) * 4; const int ci = min(c_lo + cc, 8);
        *(LAS f32x4*)(P + (cc * 2 + j) * 2048 + col) = mod_from_partials(p, 0, ci, j, col); }
    __syncthreads();
    bf16_t* H = wsp<bf16_t>(p, WS_H);
    f32x4 v[8], vn[8]; int r = rb0 + wv;
    if (r < rb1) { const float* x = xrow_in(p, r) + lane * 8;
#pragma unroll
        for (int j = 0; j < 4; ++j) { v[2 * j] = __builtin_nontemporal_load((const f32x4*)(x + 512 * j)); v[2 * j + 1] = __builtin_nontemporal_load((const f32x4*)(x + 512 * j + 4)); } }
    for (; r < rb1; r += NWAVES) {
        const int rn = r + NWAVES;
        if (rn < rb1) { const float* x = xrow_in(p, rn) + lane * 8;
#pragma unroll
            for (int j = 0; j < 4; ++j) { vn[2 * j] = __builtin_nontemporal_load((const f32x4*)(x + 512 * j)); vn[2 * j + 1] = __builtin_nontemporal_load((const f32x4*)(x + 512 * j + 4)); } }
        asm volatile("" ::: "memory");
        const LAS float* sh = P + (cond_of_row(r) - c_lo) * 4096; const LAS float* sc = sh + 2048;
#pragma unroll
        for (int j = 0; j < 4; ++j) { const int c0 = lane * 8 + 512 * j;
            const f32x4 h0 = v[2 * j] * (1.f + *(const LAS f32x4*)(sc + c0)) + *(const LAS f32x4*)(sh + c0), h1 = v[2 * j + 1] * (1.f + *(const LAS f32x4*)(sc + c0 + 4)) + *(const LAS f32x4*)(sh + c0 + 4);
            u32x4 o; o.x = pk2(h0[0], h0[1]); o.y = pk2(h0[2], h0[3]); o.z = pk2(h1[0], h1[1]); o.w = pk2(h1[2], h1[3]); *(u32x4*)(H + (size_t)r * D + c0) = o; }
#pragma unroll
        for (int j = 0; j < 8; ++j) v[j] = vn[j];
    }
}

DI void ph_gb(const Params& p, int wid_) {
    float* GB = wsp<float>(p, WS_GB);
    for (int i = blockIdx.x * NTHREADS + (wid_ * 64 + fresh_lane()); i < 2 * 9 * 512; i += gridDim.x * NTHREADS) { const int l = i / (9 * 512), ci = (i / 512) % 9, col = (i & 511) * 4;
        const f32x4 g = *(const f32x4*)(p.in[21] + l * D + col), b = *(const f32x4*)(p.in[22] + l * D + col), sh = *(const f32x4*)(modp(p, l, ci, 3) + col), sc = *(const f32x4*)(modp(p, l, ci, 4) + col);
        *(f32x4*)(GB + ((size_t)(l * 9 + ci) * 2 + 0) * D + col) = g * (1.f + sc); *(f32x4*)(GB + ((size_t)(l * 9 + ci) * 2 + 1) * D + col) = b * (1.f + sc) + sh; }
}
DI void ph_e1(const Params& p, int wid_) {
    ph_gb(p, wid_);
    const int lane = fresh_lane();
    const int rpw = (p.rpb + NWAVES - 1) / NWAVES, rb0 = blockIdx.x * p.rpb, ra = rb0 + wid_ * rpw, rz = min(min(ra + rpw, rb0 + p.rpb), T);
    const float* PJ = wsp<float>(p, WS_PJ); bf16_t* ACT2 = wsp<bf16_t>(p, WS_ACT2);
    const float* qn = p.in[11]; const float* kvn = p.in[12];
    f32x4 wsum[4];
    for (int r = ra; r < rz; ++r) {
        const float* pr = PJ + (size_t)r * 1792; bf16_t* ar = ACT2 + (size_t)r * 1792;
        {
            f32x4 v[2]; float ss = 0.f;
#pragma unroll
            for (int j = 0; j < 2; ++j) { v[j] = *(const f32x4*)(pr + lane * 4 + 256 * j); ss += (v[j][0] * v[j][0] + v[j][1] * v[j][1]) + (v[j][2] * v[j][2] + v[j][3] * v[j][3]); }
            const float rs = rsqrtf(wave_sum(ss) * (1.f / 512.f) + 1e-6f);
#pragma unroll
            for (int j = 0; j < 2; ++j) { const int c0 = lane * 4 + 256 * j; const f32x4 g = *(const f32x4*)(qn + c0); const f32x4 y = v[j] * rs * g; u32x2 o; o.x = pk2(y[0], y[1]); o.y = pk2(y[2], y[3]); *(u32x2*)(ar + c0) = o; }
        }
        {
            const int c0 = lane * 4; const f32x4 v = *(const f32x4*)(pr + 512 + c0); float ss = (v[0] * v[0] + v[1] * v[1]) + (v[2] * v[2] + v[3] * v[3]);
            const float rs = rsqrtf(wave_sum(ss) * (1.f / 256.f) + 1e-6f); const f32x4 g = *(const f32x4*)(kvn + c0); const f32x4 y = v * rs * g;
            u32x2 o; o.x = pk2(y[0], y[1]); o.y = pk2(y[2], y[3]); *(u32x2*)(ar + 512 + c0) = o;
            if (r < T_CTX) *(f32x4*)(p.out + O_CKV + (size_t)r * 256 + c0) = y;
        }
        {
            int s, S, rb; if (r < T_CTX) { s = r & 255; S = 256; rb = r - s; } else { s = (r - T_CTX) & 1023; S = 1024; rb = r - s; }
            const bool fresh = (r == ra) || (s == 0);
#pragma unroll
            for (int g = 0; g < 4; ++g) { const int half = 1 << g; const int lo = max(s - half, 0), hi = min(s + half, S); const int c0 = 768 + g * 256 + lane * 4;
                if (fresh) { f32x4 sum = {0.f, 0.f, 0.f, 0.f};
                    for (int t = lo; t < hi; ++t) sum += *(const f32x4*)(PJ + (size_t)(rb + t) * 1792 + c0);
                    wsum[g] = sum; }
                else { if (s + half - 1 < S) wsum[g] += *(const f32x4*)(PJ + (size_t)(rb + s + half - 1) * 1792 + c0);
                    if (s - half - 1 >= 0) wsum[g] -= *(const f32x4*)(PJ + (size_t)(rb + s - half - 1) * 1792 + c0); }
                const f32x4 u = *(const f32x4*)(pr + c0); const f32x4 y = wsum[g] / (float)(hi - lo) - u;
                u32x2 o; o.x = pk2(y[0], y[1]); o.y = pk2(y[2], y[3]); *(u32x2*)(ar + c0) = o; }
        }
    }
}

DI void ph_ln1(const Params& p, int wid_, int l, unsigned char* lds_raw) {
    const int tid = (wid_ * 64 + fresh_lane()), lane = tid & 63, gw = blockIdx.x * NWAVES + wid_, NGW = gridDim.x * NWAVES;
    float* wT = (float*)lds_raw;
    const float* wr = p.in[23] + (size_t)l * 2048 * 16;
    for (int d = tid; d < 2048; d += NTHREADS) {
        const f32x4 w0 = *(const f32x4*)(wr + d * 16), w1 = *(const f32x4*)(wr + d * 16 + 4), w2 = *(const f32x4*)(wr + d * 16 + 8), w3 = *(const f32x4*)(wr + d * 16 + 12);
        const int dj = d >> 9, dl = (d & 511) >> 3, dq = (d >> 2) & 1, dc = d & 3, di = ((dj * 2 + dq) * 64 + dl) * 4 + dc;
#pragma unroll
        for (int e = 0; e < 4; ++e) { wT[e * 2048 + di] = w0[e]; wT[(4 + e) * 2048 + di] = w1[e]; wT[(8 + e) * 2048 + di] = w2[e]; wT[(12 + e) * 2048 + di] = w3[e]; } }
    __syncthreads();
    const float* Y = wsp<float>(p, WS_Y); float* STAT = wsp<float>(p, WS_STAT); bf16_t* H = wsp<bf16_t>(p, WS_H); float* AFF = wsp<float>(p, WS_AFF); float* AFFT = wsp<float>(p, WS_AFFT);
    unsigned char* H8 = wsp<unsigned char>(p, WS_H8);
    const float* lg = p.in[21] + l * D; const float* lb = p.in[22] + l * D;
    f32x4 v[8], vn[8], vm[8];
    int r = gw;
#define LN1_LOAD(dst, rr) do { if ((rr) < T) { _Pragma("unroll") for (int j = 0; j < 4; ++j) { const float* y = Y + (size_t)(rr) * D + lane * 8 + 512 * j; dst[2 * j] = *(const f32x4*)y; dst[2 * j + 1] = *(const f32x4*)(y + 4); } } } while (0)
    LN1_LOAD(v, r); LN1_LOAD(vn, r + NGW);
    for (; r < T; r += NGW) {
        LN1_LOAD(vm, r + 2 * NGW);
        const int ci = cond_of_row(r); const float* gv = wsp<float>(p, WS_GB) + (size_t)(l * 9 + ci) * 2 * D; const float* bv = gv + D;
        float s = 0.f;
#pragma unroll
        for (int j = 0; j < 8; ++j) s += (v[j][0] + v[j][1]) + (v[j][2] + v[j][3]);
        const float mean = wave_sum(s) * (1.f / D); float s2 = 0.f;
#pragma unroll
        for (int j = 0; j < 8; ++j) { v[j] = v[j] - mean; s2 += (v[j][0] * v[j][0] + v[j][1] * v[j][1]) + (v[j][2] * v[j][2] + v[j][3] * v[j][3]); }
        const float rstd = rsqrtf(wave_sum(s2) * (1.f / D) + 1e-5f);
#pragma unroll
        for (int j = 0; j < 4; ++j) { const int c0 = lane * 8 + 512 * j;
#pragma unroll
            for (int q = 0; q < 2; ++q) { const int cc = c0 + 4 * q; v[2 * j + q] = v[2 * j + q] * rstd * *(const f32x4*)(gv + cc) + *(const f32x4*)(bv + cc); }
            const f32x4 a = v[2 * j], b = v[2 * j + 1];
            if (!MOE_F8) { u32x4 o; o.x = pk2(a[0], a[1]); o.y = pk2(a[2], a[3]); o.z = pk2(b[0], b[1]); o.w = pk2(b[2], b[3]); *(u32x4*)(H + (size_t)r * D + c0) = o; }
            u32x2 o8; o8.x = pk4_fp8(a[0], a[1], a[2], a[3]); o8.y = pk4_fp8(b[0], b[1], b[2], b[3]); *(u32x2*)(H8 + (size_t)r * D + c0) = o8; }
        float pa[16];
#ifdef PROBE_ROUTER2
#pragma unroll
        for (int e = 0; e < 16; ++e) { float a = 0.f; if ((e & 1) == 0) asm volatile("" ::: "memory");
#pragma unroll
            for (int j = 0; j < 4; ++j) { const float* wp = wT + e * 2048 + j * 512 + lane * 4; const f32x4 w0 = *(const f32x4*)wp, w1 = *(const f32x4*)(wp + 256); const f32x4 h0 = v[2 * j], h1 = v[2 * j + 1];
                a += ((h0[0] * w0[0] + h0[1] * w0[1]) + (h0[2] * w0[2] + h0[3] * w0[3])) + ((h1[0] * w1[0] + h1[1] * w1[1]) + (h1[2] * w1[2] + h1[3] * w1[3])); }
            asm volatile("" :: "v"(a)); }
#endif
#pragma unroll
        for (int e = 0; e < 16; ++e) { float a = 0.f; if ((e & 1) == 0) asm volatile("" ::: "memory");
#pragma unroll
            for (int j = 0; j < 4; ++j) { const float* wp = wT + e * 2048 + j * 512 + lane * 4; const f32x4 w0 = *(const f32x4*)wp, w1 = *(const f32x4*)(wp + 256); const f32x4 h0 = v[2 * j], h1 = v[2 * j + 1];
                a += ((h0[0] * w0[0] + h0[1] * w0[1]) + (h0[2] * w0[2] + h0[3] * w0[3])) + ((h1[0] * w1[0] + h1[1] * w1[1]) + (h1[2] * w1[2] + h1[3] * w1[3])); }
            pa[e] = a; }
        float pb[8], pc[4], pd[2];
        { const bool hi = (lane & 32) != 0;
#pragma unroll
          for (int e = 0; e < 8; ++e) { const float keep = hi ? pa[e + 8] : pa[e], send = hi ? pa[e] : pa[e + 8]; pb[e] = keep + __shfl_xor(send, 32); } }
        { const bool hi = (lane & 16) != 0;
#pragma unroll
          for (int e = 0; e < 4; ++e) { const float keep = hi ? pb[e + 4] : pb[e], send = hi ? pb[e] : pb[e + 4]; pc[e] = keep + __shfl_xor(send, 16); } }
        { const bool hi = (lane & 8) != 0;
#pragma unroll
          for (int e = 0; e < 2; ++e) { const float keep = hi ? pc[e + 2] : pc[e], send = hi ? pc[e] : pc[e + 2]; pd[e] = keep + __shfl_xor(send, 8); } }
        float mine; { const bool hi = (lane & 4) != 0; const float keep = hi ? pd[1] : pd[0], send = hi ? pd[0] : pd[1]; mine = keep + __shfl_xor(send, 4); }
        mine += __shfl_xor(mine, 2); mine += __shfl_xor(mine, 1);
        const int myexp = ((lane >> 5) & 1) * 8 + ((lane >> 4) & 1) * 4 + ((lane >> 3) & 1) * 2 + ((lane >> 2) & 1);
        const float m = wave_max(mine);
        const float ex = expf(mine - m);
        const float den = wave_sum(ex) * 0.25f;
        if ((lane & 3) == 0) { const float af = ex / den; AFF[(size_t)r * 16 + myexp] = af; AFFT[(size_t)myexp * T + r] = af; }
        if (lane == 0) *(f32x2*)(STAT + 2 * (size_t)r) = (f32x2){mean, rstd};
#pragma unroll
        for (int j = 0; j < 8; ++j) { v[j] = vn[j]; vn[j] = vm[j]; }
    }
#undef LN1_LOAD
}

DI void ph_topk(const Params& p, int wid_, unsigned char* lds_raw) {
    const int tid = (wid_ * 64 + fresh_lane()), lane = tid & 63, wave = wid_;
    float* vals = (float*)lds_raw;
    int* cnt2 = (int*)(vals + 1024);
    int* selrow = cnt2 + 256;
    int* selslot = selrow + 256;
    int* nsel = selslot + 256;
    const float* AFFT = wsp<float>(p, WS_AFFT); int* INV = wsp<int>(p, WS_INV); const bf16_t* H = wsp<bf16_t>(p, WS_H); const unsigned char* H8 = wsp<unsigned char>(p, WS_H8); bf16_t* XS = wsp<bf16_t>(p, WS_XS);
    for (int it = blockIdx.x; it < 768; it += gridDim.x) {
        int n, cap, r0, e, sb, c0;
        if (it < 256) { const int b = it >> 4; e = it & 15; n = 256; cap = 32; r0 = b * 256; sb = b * 32; c0 = 0; }
        else { const int q = it - 256, li = q >> 2, b = li >> 4; e = li & 15; n = 1024; cap = 128; r0 = T_CTX + b * 1024; sb = 512 + b * 128; c0 = (q & 3) * 256; }
        for (int i = tid; i < n; i += NTHREADS) vals[i] = AFFT[(size_t)e * T + r0 + i];
        if (tid == 0) *nsel = 0;
        __syncthreads();
        const int ci = c0 + (tid & 255), half = tid >> 8, jn = n >> 1, j0 = half * jn;
        const float vi = vals[ci]; int cnt = 0;
        for (int j = j0; j < j0 + jn; ++j) { const float vj = vals[j]; cnt += (vj > vi || (vj == vi && j < ci)) ? 1 : 0; }
        if (half) cnt2[tid & 255] = cnt;
        __syncthreads();
        if (!half) { cnt += cnt2[tid];
            if (cnt < cap) { const int pos = atomicAdd(nsel, 1); selrow[pos] = ci; selslot[pos] = cnt; INV[(size_t)(r0 + ci) * 16 + e] = sb + cnt; } else INV[(size_t)(r0 + ci) * 16 + e] = -1; }
        __syncthreads();
        const int ns = *nsel;
        for (int k0 = wave; k0 < ns; k0 += 4 * NWAVES) {
            if (MOE_F8) { u32x4 bufr[4][2];
#pragma unroll
                for (int b = 0; b < 4; ++b) { const int k = k0 + NWAVES * b; if (k < ns) { const u32x4* src = (const u32x4*)(H8 + (size_t)(r0 + selrow[k]) * D); bufr[b][0] = src[lane]; bufr[b][1] = src[lane + 64]; } }
#pragma unroll
                for (int b = 0; b < 4; ++b) { const int k = k0 + NWAVES * b; if (k < ns) { u32x4* dst = (u32x4*)((unsigned char*)XS + (size_t)(e * NSLOT + sb + selslot[k]) * D); dst[lane] = bufr[b][0]; dst[lane + 64] = bufr[b][1]; } } }
            else {
#pragma unroll
                for (int b = 0; b < 4; ++b) { const int k = k0 + NWAVES * b; if (k < ns) { const u32x4* src = (const u32x4*)(H + (size_t)(r0 + selrow[k]) * D); u32x4* dst = (u32x4*)(XS + (size_t)(e * NSLOT + sb + selslot[k]) * D);
#pragma unroll
                    for (int j = 0; j < 4; ++j) dst[lane + 64 * j] = src[lane + 64 * j]; } } } }
        __syncthreads();
    }
}

DI void ph_ln2(const Params& p, int wid_, int l, unsigned char* lds_raw) {
    const int tid = (wid_ * 64 + fresh_lane()), lane = tid & 63, wv = wid_;
    const int rpb = p.rpb, rb0 = blockIdx.x * rpb, rb1 = min(rb0 + rpb, T);
    if (rb0 >= T) return;
    LAS float* PV = (LAS float*)lds_raw;
    LAS float* PC = PV + 4 * 2048;
    const int c_lo = cond_of_row(rb0);
    for (int i = tid; i < 4 * 512; i += NTHREADS) { const int w = i >> 9, col = (i & 511) * 4; const float* src = w == 0 ? p.in[21] + l * D : w == 1 ? p.in[22] + l * D : w == 2 ? p.in[27] + l * D : p.in[28] + l * D;
        *(LAS f32x4*)(PV + w * 2048 + col) = *(const f32x4*)(src + col); }
    for (int i = tid; i < 2 * 3 * 512; i += NTHREADS) { const int cc = i / 1536, w = (i / 512) % 3, col = (i & 511) * 4; const int ci = min(c_lo + cc, 8);
        const float* src = w == 0 ? modp(p, l, ci, 5) : modp(p, 1, ci, w == 1 ? 0 : 1);
        *(LAS f32x4*)(PC + (cc * 3 + w) * 2048 + col) = *(const f32x4*)(src + col); }
    __syncthreads();
    const float* Y = wsp<float>(p, WS_Y); const float* STAT = wsp<float>(p, WS_STAT);
    const float* AFF = wsp<float>(p, WS_AFF); const int* INV = wsp<int>(p, WS_INV); const bf16_t* YE = wsp<bf16_t>(p, WS_YE);
    float* XL = wsp<float>(p, WS_XL); bf16_t* H = wsp<bf16_t>(p, WS_H);
    f32x4 x[8], xn[8]; int sl = -1, sln = -1; float af = 0.f, afn = 0.f; f32x2 st = {0.f, 1.f}, stn = {0.f, 1.f};
    int r = rb0 + wv;
#define LN2_LOAD(dx, ds, da, dt, rr) do { if ((rr) < rb1) { _Pragma("unroll") for (int j = 0; j < 4; ++j) { const float* y = Y + (size_t)(rr) * D + lane * 8 + 512 * j; dx[2 * j] = *(const f32x4*)y; dx[2 * j + 1] = *(const f32x4*)(y + 4); } \
        if (lane < 16) { ds = INV[(size_t)(rr) * 16 + lane]; da = AFF[(size_t)(rr) * 16 + lane]; } dt = *(const f32x2*)(STAT + 2 * (size_t)(rr)); } } while (0)
    LN2_LOAD(x, sl, af, st, r);
    for (; r < rb1; r += NWAVES) {
        asm volatile("" ::: "memory");
        LN2_LOAD(xn, sln, afn, stn, r + NWAVES);
        const LAS float* pc = PC + (cond_of_row(r) - c_lo) * 3 * 2048;
        f32x4 f[8];
#pragma unroll
        for (int j = 0; j < 8; ++j) f[j] = (f32x4){0.f, 0.f, 0.f, 0.f};
        {
            unsigned long long mk = __ballot(sl >= 0) & 0xffffull;
            while (mk) {
                const int e0 = __builtin_ctzll(mk); mk &= mk - 1; const bool two = mk != 0ull; const int e1 = two ? __builtin_ctzll(mk) : e0; if (two) mk &= mk - 1;
                const int s0 = __shfl(sl, e0), s1 = __shfl(sl, e1); const float w0 = __shfl(af, e0), w1 = two ? __shfl(af, e1) : 0.f;
                const bf16_t* y0 = YE + (size_t)(e0 * NSLOT + s0) * D + lane * 8; const bf16_t* y1 = YE + (size_t)(e1 * NSLOT + s1) * D + lane * 8;
                u32x4 q0[4], q1[4];
#pragma unroll
                for (int j = 0; j < 4; ++j) { q0[j] = *(const u32x4*)(y0 + 512 * j); q1[j] = *(const u32x4*)(y1 + 512 * j); }
#pragma unroll
                for (int j = 0; j < 4; ++j) {
                    f[2 * j][0] += w0 * bflo(q0[j].x) + w1 * bflo(q1[j].x); f[2 * j][1] += w0 * bfhi(q0[j].x) + w1 * bfhi(q1[j].x); f[2 * j][2] += w0 * bflo(q0[j].y) + w1 * bflo(q1[j].y); f[2 * j][3] += w0 * bfhi(q0[j].y) + w1 * bfhi(q1[j].y);
                    f[2 * j + 1][0] += w0 * bflo(q0[j].z) + w1 * bflo(q1[j].z); f[2 * j + 1][1] += w0 * bfhi(q0[j].z) + w1 * bfhi(q1[j].z); f[2 * j + 1][2] += w0 * bflo(q0[j].w) + w1 * bflo(q1[j].w); f[2 * j + 1][3] += w0 * bfhi(q0[j].w) + w1 * bfhi(q1[j].w); }
            }
        }
        float s = 0.f;
#pragma unroll
        for (int j = 0; j < 8; ++j) { const int c0 = lane * 8 + 512 * (j >> 1) + 4 * (j & 1); const f32x4 x1 = (x[j] - st[0]) * st[1] * *(const LAS f32x4*)(PV + c0) + *(const LAS f32x4*)(PV + 2048 + c0);
            f[j] = DN_ALPHA * x1 + *(const LAS f32x4*)(pc + c0) * f[j]; s += (f[j][0] + f[j][1]) + (f[j][2] + f[j][3]); }
        const float mean = wave_sum(s) * (1.f / D); float s2 = 0.f;
#pragma unroll
        for (int j = 0; j < 8; ++j) { f[j] = f[j] - mean; s2 += (f[j][0] * f[j][0] + f[j][1] * f[j][1]) + (f[j][2] * f[j][2] + f[j][3] * f[j][3]); }
        const float rstd = rsqrtf(wave_sum(s2) * (1.f / D) + 1e-5f);
#pragma unroll
        for (int j = 0; j < 4; ++j) { const int c0 = lane * 8 + 512 * j; f32x4 o[2];
#pragma unroll
            for (int q = 0; q < 2; ++q) { const int cc = c0 + 4 * q; o[q] = f[2 * j + q] * rstd * *(const LAS f32x4*)(PV + 2 * 2048 + cc) + *(const LAS f32x4*)(PV + 3 * 2048 + cc);
                if (l == 0) { *(f32x4*)(XL + (size_t)r * D + cc) = o[q]; o[q] = o[q] * (1.f + *(const LAS f32x4*)(pc + 2 * 2048 + cc)) + *(const LAS f32x4*)(pc + 2048 + cc); }
                else *(f32x4*)(p.out + O_Y + (size_t)r * D + cc) = o[q]; }
            if (l == 0) { u32x4 w; w.x = pk2(o[0][0], o[0][1]); w.y = pk2(o[0][2], o[0][3]); w.z = pk2(o[1][0], o[1][1]); w.w = pk2(o[1][2], o[1][3]); *(u32x4*)(H + (size_t)r * D + c0) = w; } }
#pragma unroll
        for (int j = 0; j < 8; ++j) x[j] = xn[j];
        sl = sln; af = afn; st = stn;
    }
#undef LN2_LOAD
}
template <int PAT> DI void ph_readonly(const Params& p, int wid_) {
    const int lane = (wid_ * 64 + fresh_lane()) & 63, gw = blockIdx.x * NWAVES + wid_, NGW = gridDim.x * NWAVES;
    float accum = 0.f;
    for (int it = gw; it < 98304; it += NGW) {
        const int mat = it >> 10, w = it & 1023, le = mat / 3, kind = mat % 3;
        const float* base = p.in[24 + kind] + (size_t)le * 2048 * 2048;
        if (PAT == 0) { const int nb = w & 31, kb = w >> 5; const float* s = base + (size_t)(kb * 64) * 2048 + nb * 64 + lane; float v[64];
#pragma unroll
            for (int k = 0; k < 64; ++k) v[k] = __builtin_nontemporal_load(s + (size_t)k * 2048);
#pragma unroll
            for (int k = 0; k < 64; ++k) accum += v[k]; }
        else if (PAT == 1) { const int nb8 = w & 7, kb16 = w >> 3; const float* s = base + (size_t)(kb16 * 16) * 2048 + nb8 * 256 + 4 * lane; f32x4 v[16];
#pragma unroll
            for (int k = 0; k < 16; ++k) v[k] = __builtin_nontemporal_load((const f32x4*)(s + (size_t)k * 2048));
#pragma unroll
            for (int k = 0; k < 16; ++k) accum += (v[k][0] + v[k][1]) + (v[k][2] + v[k][3]); }
        else { const float* s = base + (size_t)w * 4096 + 4 * lane; f32x4 v[16];
#pragma unroll
            for (int k = 0; k < 16; ++k) v[k] = __builtin_nontemporal_load((const f32x4*)(s + (size_t)k * 256));
#pragma unroll
            for (int k = 0; k < 16; ++k) accum += (v[k][0] + v[k][1]) + (v[k][2] + v[k][3]); }
    }
    if (lane == 0) wsp<float>(p, WS_DBG)[gw] = accum + wave_sum(accum);
}

struct Unit { const char* A; const char* B; unsigned lda, ldb; int nt; int pm, pn; int mode; int aux; };
DI int vcu_of(int bx, int G) { return (G % 8 == 0) ? (bx % 8) * (G / 8) + bx / 8 : bx; }

DI void rope8(const Params& p, int s, int pi0, float* v) {
    const f32x4 c = *(const f32x4*)(ws_cos(p) + s * 32 + pi0), sn = *(const f32x4*)(ws_sin(p) + s * 32 + pi0);
#pragma unroll
    for (int i = 0; i < 4; ++i) { const float x1 = v[2 * i], x2 = v[2 * i + 1]; v[2 * i] = x1 * c[i] - x2 * sn[i]; v[2 * i + 1] = x1 * sn[i] + x2 * c[i]; }
}
DI void st_bf16x8(bf16_t* dst, const float* v) { u32x4 w; w.x = pk2(v[0], v[1]); w.y = pk2(v[2], v[3]); w.z = pk2(v[4], v[5]); w.w = pk2(v[6], v[7]); *(u32x4*)dst = w; }
DI void st_f32x8(float* dst, const float* v) { *(f32x4*)dst = (f32x4){v[0], v[1], v[2], v[3]}; *(f32x4*)(dst + 4) = (f32x4){v[4], v[5], v[6], v[7]}; }

struct SchedInEven { const Params* p; int G, c;
    DI bool next(int i, Unit& u) const { const int L = i * G + c; if (L >= 48 * 8) return false; u.pm = L >> 3; u.pn = L & 7;
        u.A = (const char*)wsp<bf16_t>(*p, WS_H) + (size_t)u.pm * 256 * 4096; u.B = (const char*)wsp<bf16_t>(*p, WS_WINE) + (size_t)u.pn * 256 * 4096; u.lda = 4096; u.ldb = 4096; u.nt = 32; u.mode = 0; u.aux = 0; return true; } };
struct EpiInEven { static constexpr bool PAIR = false, F8 = false; const Params* p;
    DI void store(const Unit& u, int row, int col, float* v) const {
        const int r = u.pm * 256 + row, gc = u.pn * 256 + col;
        if (gc < 1792) { st_f32x8(wsp<float>(*p, WS_PJ) + (size_t)r * 1792 + gc, v); return; }
        if (gc >= 1856) return;
        const int j0 = gc - 1792;
        if (r < T_CTX) st_f32x8(p->out + O_KPE + (size_t)r * 64 + j0, v); else rope8(*p, (r - T_CTX) & 1023, j0 >> 1, v);
        st_bf16x8(wsp<bf16_t>(*p, WS_KPE) + (size_t)r * 64 + j0, v);
    } };

constexpr int E2_Q = 48 * 6, E2_K = 64 * 4, E2_V = 4 * 64, E2_P = 48 * 4, E2_TOTAL = E2_Q + E2_K + E2_V + E2_P;
struct SchedE2 { const Params* p; int G, c;
    DI bool next(int i, Unit& u) const { int L;
        if (G == 256) { if (c < 32) { if (i > 2) return false; L = i == 0 ? c : (i == 1 ? 256 + c : E2_Q + c); } else { if (i > 3) return false; L = i == 0 ? c : E2_Q + 32 + (c - 32) * 3 + (i - 1); } }
        else { L = i * G + c; if (L >= E2_TOTAL) return false; }
        const char* ACT2 = (const char*)wsp<bf16_t>(*p, WS_ACT2); const char* W2 = (const char*)wsp<bf16_t>(*p, WS_W2); u.aux = 0;
        if (L < E2_Q) { u.mode = 0; u.pm = L / 6; u.pn = L % 6; u.A = ACT2 + (size_t)u.pm * 256 * 3584; u.lda = 3584; u.B = W2 + (size_t)u.pn * 256 * 3584; u.ldb = 3584; u.nt = 8; return true; }
        L -= E2_Q;
        if (L < E2_K) { u.mode = 1; u.pm = L >> 2; u.pn = L & 3; u.A = ACT2 + (size_t)u.pm * 256 * 3584 + 512 * 2; u.lda = 3584; u.B = W2 + (size_t)(1536 + u.pn * 256) * 3584; u.ldb = 3584; u.nt = 4; return true; }
        L -= E2_K;
        if (L < E2_V) { u.mode = 2; u.pm = L >> 6; u.pn = L & 63; u.A = W2 + (size_t)(2560 + u.pm * 256) * 3584; u.lda = 3584; u.B = ACT2 + (size_t)u.pn * 256 * 3584 + 512 * 2; u.ldb = 3584; u.nt = 4; return true; }
        L -= E2_V;
        u.mode = 3; u.pm = L >> 2; u.aux = L & 3; u.pn = 0; u.A = ACT2 + (size_t)u.pm * 256 * 3584 + (768 + u.aux * 256) * 2; u.lda = 3584; u.B = W2 + (size_t)(3584 + u.aux * 256) * 3584; u.ldb = 3584; u.nt = 4; return true; } };
struct EpiE2 { static constexpr bool PAIR = false, F8 = false; const Params* p;
    DI void store(const Unit& u, int row, int col, float* v) const {
        const int r = u.pm * 256 + row, gc = u.pn * 256 + col;
        if (u.mode == 0) { const int dd = gc % 192; if (dd >= 128 && r >= T_CTX) rope8(*p, (r - T_CTX) & 1023, (dd - 128) >> 1, v);
#pragma unroll
            for (int i = 0; i < 8; ++i) v[i] *= QS_MLA;
            st_bf16x8(wsp<bf16_t>(*p, WS_Q) + (size_t)r * 1536 + gc, v); }
        else if (u.mode == 1) st_bf16x8(wsp<bf16_t>(*p, WS_KN) + (size_t)r * 1024 + gc, v);
        else if (u.mode == 2) st_bf16x8(wsp<bf16_t>(*p, WS_VT) + (size_t)r * TX + gc, v);
        else { const float* ps = p->in[16] + u.aux * 256 + col;
#pragma unroll
            for (int i = 0; i < 8; ++i) v[i] *= ps[i];
            if (OUT_F8) { u32x2 o; o.x = pk4_fp8(v[0], v[1], v[2], v[3]); o.y = pk4_fp8(v[4], v[5], v[6], v[7]); *(u32x2*)((unsigned char*)wsp<bf16_t>(*p, WS_MIX) + (size_t)r * 2048 + 1024 + u.aux * 256 + col) = o; }
            else st_bf16x8(wsp<bf16_t>(*p, WS_MIX) + (size_t)r * 2048 + 1024 + u.aux * 256 + col, v); }
    } };

struct SchedOut { const Params* p; int G, c, l;
    DI bool next(int i, Unit& u) const { const int L = i * G + c; if (L >= 48 * 8) return false; u.pm = L >> 3; u.pn = L & 7;
        constexpr unsigned P = OUT_F8 ? 2048 : 4096;
        u.A = (const char*)wsp<bf16_t>(*p, WS_MIX) + (size_t)u.pm * 256 * P; u.B = (const char*)wsp<bf16_t>(*p, l == 0 ? WS_WOUTE : WS_WOUTO) + (size_t)u.pn * 256 * P; u.lda = P; u.ldb = P; u.nt = OUT_F8 ? 16 : 32; u.mode = 0; u.aux = 0; return true; } };
struct EpiOut { static constexpr bool PAIR = false, F8 = OUT_F8 != 0; const Params* p; int l;
    DI void store(const Unit& u, int row, int col, float* v) const {
        const int r = u.pm * 256 + row, gc = u.pn * 256 + col;
        const float* x = (l == 0 ? xrow_in(*p, r) : wsp<float>(*p, WS_XL) + (size_t)r * D) + gc; const float* g1 = modp(*p, l, cond_of_row(r), 2) + gc;
        const f32x4 x0 = *(const f32x4*)x, x1 = *(const f32x4*)(x + 4), g0 = *(const f32x4*)g1, g4 = *(const f32x4*)(g1 + 4);
#pragma unroll
        for (int i = 0; i < 4; ++i) { const float w0 = OUT_F8 ? g0[i] * (1.f / OUT_WSCALE) : g0[i], w4 = OUT_F8 ? g4[i] * (1.f / OUT_WSCALE) : g4[i]; v[i] = DN_ALPHA * x0[i] + w0 * v[i]; v[4 + i] = DN_ALPHA * x1[i] + w4 * v[4 + i]; }
        st_f32x8(wsp<float>(*p, WS_Y) + (size_t)r * D + gc, v);
    } };

struct SchedGU { const Params* p; int G, c, l;
    DI bool next(int i, Unit& u) const { const int L = i * G + c; if (L >= 16 * 96) return false; const int e = L / 96, rem = L % 96; u.pn = rem / 6; u.pm = e * 6 + rem % 6; u.aux = e;
        constexpr unsigned P = MOE_F8 ? 2048 : 4096;
        u.A = (const char*)wsp<bf16_t>(*p, WS_XS) + (size_t)u.pm * 256 * P; u.B = (const char*)wsp<bf16_t>(*p, WS_WGU) + ((size_t)(l * 16 + e) * 4096 + (size_t)u.pn * 256) * P; u.lda = P; u.ldb = P; u.nt = MOE_F8 ? 16 : 32; u.mode = 0; return true; } };
struct EpiGU { static constexpr bool PAIR = true, F8 = MOE_F8 != 0; const Params* p;
    DI void store2(const Unit& u, int row, int col, const float* g, const float* up) const {
        float h[8];
#pragma unroll
        for (int i = 0; i < 8; ++i) { const float gg = MOE_F8 ? g[i] * (1.f / GU_WSCALE) : g[i], uu = MOE_F8 ? up[i] * (1.f / GU_WSCALE) : up[i]; h[i] = gg / (1.f + __expf(-gg)) * uu; }
        if (MOE_F8) { u32x2 o; o.x = pk4_fp8(h[0], h[1], h[2], h[3]); o.y = pk4_fp8(h[4], h[5], h[6], h[7]); *(u32x2*)((unsigned char*)wsp<bf16_t>(*p, WS_HID) + (size_t)(u.pm * 256 + row) * D + u.pn * 128 + col) = o; }
        else st_bf16x8(wsp<bf16_t>(*p, WS_HID) + (size_t)(u.pm * 256 + row) * D + u.pn * 128 + col, h);
    } };

struct SchedDown { const Params* p; int G, c, l;
    DI bool next(int i, Unit& u) const { const int L = i * G + c; if (L >= 16 * 48) return false; const int e = L / 48, rem = L % 48; u.pn = rem / 6; u.pm = e * 6 + rem % 6; u.aux = e;
        constexpr unsigned P = MOE_F8 ? 2048 : 4096;
        u.A = (const char*)wsp<bf16_t>(*p, WS_HID) + (size_t)u.pm * 256 * P; u.B = (const char*)wsp<bf16_t>(*p, WS_WDN) + ((size_t)(l * 16 + e) * 2048 + (size_t)u.pn * 256) * P; u.lda = P; u.ldb = P; u.nt = MOE_F8 ? 16 : 32; u.mode = 0; return true; } };
struct EpiDown { static constexpr bool PAIR = false, F8 = MOE_F8 != 0; const Params* p;
    DI void store(const Unit& u, int row, int col, float* v) const {
        if (MOE_F8) {
#pragma unroll
            for (int i = 0; i < 8; ++i) v[i] *= (1.f / DN_WSCALE); }
        st_bf16x8(wsp<bf16_t>(*p, WS_YE) + (size_t)(u.pm * 256 + row) * D + u.pn * 256 + col, v); } };

constexpr int IO_QK = 48 * 9, IO_V = 16, IO_VT = 48, IO_TOTAL = IO_QK + IO_V + IO_VT;
struct SchedInOdd { const Params* p; int G, c;
    DI bool next(int i, Unit& u) const { int L = i * G + c; if (L >= IO_TOTAL) return false;
        const char* Hb = (const char*)wsp<bf16_t>(*p, WS_H); const char* W = (const char*)wsp<bf16_t>(*p, WS_WINO); u.aux = 0; u.nt = 32; u.lda = 4096; u.ldb = 4096;
        if (L < IO_QK) { u.mode = 0; u.pm = L / 9; u.pn = L % 9; u.A = Hb + (size_t)u.pm * 256 * 4096; u.B = W + (size_t)u.pn * 256 * 4096; return true; }
        L -= IO_QK;
        if (L < IO_V) { u.mode = 1; u.pm = L; u.pn = 9; u.A = Hb + (size_t)u.pm * 256 * 4096; u.B = W + (size_t)9 * 256 * 4096; return true; }
        L -= IO_V;
        u.mode = 2; u.pm = 0; u.pn = L; u.A = W + (size_t)9 * 256 * 4096; u.B = Hb + (size_t)u.pn * 256 * 4096; return true; } };
struct EpiInOdd { static constexpr bool PAIR = false, F8 = false; const Params* p;
    DI void store(const Unit& u, int row, int col, float* v) const {
        const int r = u.pm * 256 + row, gc = u.pn * 256 + col;
        if (u.mode == 0) {
            if (gc < 2048) { if (r >= T_CTX) rope8(*p, (r - T_CTX) & 1023, (gc & 63) >> 1, v);
#pragma unroll
                for (int i = 0; i < 8; ++i) v[i] *= QS_SWA;
                st_bf16x8(wsp<bf16_t>(*p, WS_Q) + (size_t)r * 2048 + gc, v); }
            else { const int kc = gc - 2048; if (r < T_CTX) st_f32x8(p->out + O_SK + (size_t)r * 256 + kc, v); else rope8(*p, (r - T_CTX) & 1023, (kc & 63) >> 1, v);
                st_bf16x8(wsp<bf16_t>(*p, WS_KO) + (size_t)r * 256 + kc, v); } }
        else if (u.mode == 1) st_f32x8(p->out + O_SV + (size_t)r * 256 + col, v);
        else st_bf16x8(wsp<bf16_t>(*p, WS_VTO) + (size_t)row * TX + gc, v);
    } };

namespace pg8 {
typedef short bf16x8 __attribute__((ext_vector_type(8)));
typedef int i32x4 __attribute__((ext_vector_type(4)));
typedef int i32x8 __attribute__((ext_vector_type(8)));
DI i32x8 cat8(bf16x8 lo, bf16x8 hi) { return __builtin_shufflevector(__builtin_bit_cast(i32x4, lo), __builtin_bit_cast(i32x4, hi), 0, 1, 2, 3, 4, 5, 6, 7); }
constexpr int BM = 256, BK = 64, HALF = 128, HTB = HALF * BK * 2  , STAGE_BYTES = 8 * HTB;
DI int lds_byte(int r, int c) { const int st = (r >> 4) * 2 + (c >> 5), rr = r & 15, cc = c & 31, ob = rr * 64 + cc * 2; return st * 1024 + (ob ^ (((ob >> 9) & 1) << 5)); }
DI void stage_rc(int b, int& R, int& C) { const int st = b / 1024, sb = b % 1024, swz = sb ^ (((sb >> 9) & 1) << 5); R = (st >> 1) * 16 + swz / 64; C = (st & 1) * 32 + (swz % 64) / 2; }
DI int perm32(int rho) { const int n = rho >> 4, i = rho & 15; return 8 * (i >> 2) + 4 * n + (i & 3); }

template <bool F8> struct Frag;
template <> struct Frag<false> { bf16x8 k0, k1; DI void set(bf16x8 a, bf16x8 b) { k0 = a; k1 = b; } };
template <> struct Frag<true> { i32x8 w; DI void set(bf16x8 a, bf16x8 b) { w = cat8(a, b); } };
template <class Epi, class Sched, bool ALIGN_EPI = true>
DI void gemm_phase(LAS unsigned char* lds, const Sched& S, const Epi& E, int wid) {
    const int lane = fresh_lane(), tid = wid * 64 + lane, wr = wid >> 2, wc = wid & 3, fr = lane & 15, fq = lane >> 4;
    int RA[2], RB[2], CB[2];
#pragma unroll
    for (int i = 0; i < 2; ++i) { int R, C; stage_rc(tid * 16 + i * 8192, R, C); RA[i] = R; RB[i] = (R & ~31) + perm32(R & 31); CB[i] = C * 2; }
    constexpr size_t kstep = (size_t)(BK * 2);
    const unsigned ldsw = (unsigned)wid * 1024u;
    const int aoff = lds_byte(wr * 64 + fr, fq * 8), boff = lds_byte(wc * 32 + fr, fq * 8);
#define PG8_SA(b, h) (((b) * 2 + (h)) * HTB)
#define PG8_SB(b, h) ((4 + (b) * 2 + (h)) * HTB)
#define PG8_STAGE(bufoff, gbase, v0, v1) do { unsigned o0_ = (v0), o1_ = (v1); asm volatile("" : "+v"(o0_), "+v"(o1_)); \
        __builtin_amdgcn_global_load_lds((const unsigned*)((const char*)(gbase) + o0_), (LAS unsigned*)(lds + (bufoff) + ldsw), 16, 0, 0); \
        __builtin_amdgcn_global_load_lds((const unsigned*)((const char*)(gbase) + o1_), (LAS unsigned*)(lds + (bufoff) + ldsw + 8192), 16, 0, 0); } while (0)
#define PG8_LDA(dst, b, h) do { _Pragma("unroll") for (int m = 0; m < 4; ++m) { const bf16x8 f0_ = *(const LAS bf16x8*)(lds + PG8_SA(b, h) + aoff + m * 2048), f1_ = *(const LAS bf16x8*)(lds + PG8_SA(b, h) + aoff + m * 2048 + 1024); dst[m].set(f0_, f1_); } } while (0)
#define PG8_LDB(dst, b, h) do { _Pragma("unroll") for (int n = 0; n < 2; ++n) { const bf16x8 f0_ = *(const LAS bf16x8*)(lds + PG8_SB(b, h) + boff + n * 2048), f1_ = *(const LAS bf16x8*)(lds + PG8_SB(b, h) + boff + n * 2048 + 1024); dst[n].set(f0_, f1_); } } while (0)
#define PG8_MMA(ai, bj, At, Bt) do { __builtin_amdgcn_s_setprio(1); _Pragma("unroll") for (int m = 0; m < 4; ++m) _Pragma("unroll") for (int n = 0; n < 2; ++n) { \
        if constexpr (Epi::F8) acc[ai][bj][m][n] = __builtin_amdgcn_mfma_scale_f32_16x16x128_f8f6f4(Bt[n].w, At[m].w, acc[ai][bj][m][n], 0, 0, 0, 0x7f7f7f7f, 0, 0x7f7f7f7f); \
        else { acc[ai][bj][m][n] = __builtin_amdgcn_mfma_f32_16x16x32_bf16(Bt[n].k0, At[m].k0, acc[ai][bj][m][n], 0, 0, 0); acc[ai][bj][m][n] = __builtin_amdgcn_mfma_f32_16x16x32_bf16(Bt[n].k1, At[m].k1, acc[ai][bj][m][n], 0, 0, 0); } } \
        __builtin_amdgcn_s_setprio(0); } while (0)
#define PG8_WAIT_V(n) asm volatile("s_waitcnt vmcnt(" #n ")" ::: "memory")
#define PG8_WAIT_L(n) asm volatile("s_waitcnt lgkmcnt(" #n ")" ::: "memory")
#define PG8_BAR __builtin_amdgcn_s_barrier()
#define PG8_SCHED __builtin_amdgcn_sched_barrier(0)
    Unit cur, nxt; int ui = 0;
    if (!S.next(0, cur)) return;
    f32x4 acc[2][2][4][2];
#pragma unroll
    for (int a = 0; a < 2; ++a)
#pragma unroll
        for (int b = 0; b < 2; ++b)
#pragma unroll
            for (int m = 0; m < 4; ++m)
#pragma unroll
                for (int n = 0; n < 2; ++n) acc[a][b][m][n] = (f32x4){0.f, 0.f, 0.f, 0.f};
    Frag<Epi::F8> At[4], B0[2], B1[2];
    const char* cA = cur.A; const char* cB = cur.B;
    const unsigned ld = cur.lda;
    const unsigned vA0 = RA[0] * ld + CB[0], vA1 = RA[1] * ld + CB[1], vB0 = RB[0] * ld + CB[0], vB1 = RB[1] * ld + CB[1];
    const size_t hA = (size_t)HALF * ld, hB = hA;
    PG8_STAGE(PG8_SB(0, 0), cB, vB0, vB1); PG8_STAGE(PG8_SB(0, 1), cB + hB, vB0, vB1); PG8_STAGE(PG8_SA(0, 0), cA, vA0, vA1); PG8_STAGE(PG8_SA(0, 1), cA + hA, vA0, vA1);
    if (wr == 1) PG8_BAR;
    PG8_WAIT_V(2); PG8_BAR;
    PG8_STAGE(PG8_SB(1, 0), cB + kstep, vB0, vB1); PG8_STAGE(PG8_SA(1, 0), cA + kstep, vA0, vA1); PG8_STAGE(PG8_SB(1, 1), cB + hB + kstep, vB0, vB1);
    PG8_WAIT_V(6); PG8_BAR;
    for (;;) {
        const bool has_next = S.next(ui + 1, nxt);
        const char* nA = has_next ? nxt.A : cA; const char* nB = has_next ? nxt.B : cB;
        const int nt = cur.nt;
        for (int t = 0; t < nt; t += 2) {
            const bool last = (t == nt - 2);
            const char* a1 = cA + (size_t)(t + 1) * kstep;
            const char* a2 = last ? nA : cA + (size_t)(t + 2) * kstep; const char* b2 = last ? nB : cB + (size_t)(t + 2) * kstep;
            const char* a3 = a2 + kstep; const char* b3 = b2 + kstep;
            PG8_LDB(B0, 0, 0); PG8_LDB(B1, 0, 1); PG8_SCHED; PG8_LDA(At, 0, 0); PG8_STAGE(PG8_SA(1, 1), a1 + hA, vA0, vA1);
            PG8_WAIT_V(8); PG8_WAIT_L(0); PG8_BAR; PG8_MMA(0, 0, At, B0); PG8_MMA(0, 1, At, B1); PG8_BAR; PG8_SCHED;
            PG8_LDA(At, 0, 1); PG8_STAGE(PG8_SB(0, 0), b2, vB0, vB1); PG8_STAGE(PG8_SB(0, 1), b2 + hB, vB0, vB1); PG8_STAGE(PG8_SA(0, 0), a2, vA0, vA1);
            PG8_WAIT_V(8); PG8_WAIT_L(0); PG8_BAR; PG8_MMA(1, 0, At, B0); PG8_MMA(1, 1, At, B1); PG8_BAR; PG8_SCHED;
            PG8_LDB(B0, 1, 0); PG8_LDB(B1, 1, 1); PG8_SCHED; PG8_LDA(At, 1, 0); PG8_STAGE(PG8_SA(0, 1), a2 + hA, vA0, vA1);
            PG8_WAIT_V(8); PG8_WAIT_L(0); PG8_BAR; PG8_MMA(0, 0, At, B0); PG8_MMA(0, 1, At, B1); PG8_BAR; PG8_SCHED;
            PG8_LDA(At, 1, 1); PG8_STAGE(PG8_SB(1, 0), b3, vB0, vB1); PG8_STAGE(PG8_SB(1, 1), b3 + hB, vB0, vB1); PG8_STAGE(PG8_SA(1, 0), a3, vA0, vA1);
            PG8_WAIT_V(8); PG8_WAIT_L(0); PG8_BAR; PG8_MMA(1, 0, At, B0); PG8_MMA(1, 1, At, B1); PG8_BAR; PG8_SCHED;
        }
        if constexpr (ALIGN_EPI) { if (wr == 0) PG8_BAR; }
        {
            const int el_ = fresh_lane(); const int fr_ = el_ & 15, fq_ = el_ >> 4;
#pragma unroll
            for (int ai = 0; ai < 2; ++ai)
#pragma unroll
                for (int m = 0; m < 4; ++m) { const int row = ai * HALF + wr * 64 + m * 16 + fr_;
                    if constexpr (Epi::PAIR) { float g[8], up[8];
#pragma unroll
                        for (int j = 0; j < 4; ++j) { g[j] = acc[ai][0][m][0][j]; g[4 + j] = acc[ai][0][m][1][j]; up[j] = acc[ai][1][m][0][j]; up[4 + j] = acc[ai][1][m][1][j]; }
                        E.store2(cur, row, wc * 32 + 8 * fq_, g, up); }
                    else {
#pragma unroll
                        for (int bj = 0; bj < 2; ++bj) { float v[8];
#pragma unroll
                            for (int j = 0; j < 4; ++j) { v[j] = acc[ai][bj][m][0][j]; v[4 + j] = acc[ai][bj][m][1][j]; }
                            E.store(cur, row, bj * HALF + wc * 32 + 8 * fq_, v); } } }
        }
        if (!has_next) break;
#pragma unroll
        for (int a = 0; a < 2; ++a)
#pragma unroll
            for (int b = 0; b < 2; ++b)
#pragma unroll
                for (int m = 0; m < 4; ++m)
#pragma unroll
                    for (int n = 0; n < 2; ++n) acc[a][b][m][n] = (f32x4){0.f, 0.f, 0.f, 0.f};
        cur = nxt; cA = nA; cB = nB; ++ui;
        if constexpr (ALIGN_EPI) { if (wr == 1) PG8_BAR; }
    }
    PG8_WAIT_V(0);
    if constexpr (!ALIGN_EPI) { if (wr == 0) PG8_BAR; }
    PG8_BAR;
#undef PG8_SA
#undef PG8_SB
#undef PG8_STAGE
#undef PG8_LDA
#undef PG8_LDB
#undef PG8_MMA
#undef PG8_WAIT_V
#undef PG8_WAIT_L
#undef PG8_BAR
#undef PG8_SCHED
}
}

namespace att {
typedef short bf16x8 __attribute__((ext_vector_type(8)));
typedef short s16x4 __attribute__((ext_vector_type(4)));
typedef float f32x16 __attribute__((ext_vector_type(16)));
typedef float f32x2_t __attribute__((ext_vector_type(2)));
typedef __bf16 bf16x2_t __attribute__((ext_vector_type(2)));
DI unsigned cvtpk(float lo, float hi) { f32x2_t v = {lo, hi}; bf16x2_t b = __builtin_convertvector(v, bf16x2_t); return __builtin_bit_cast(unsigned, b); }
DI int crow(int r, int h) { return (r & 3) + 8 * (r >> 2) + 4 * h; }

template <bool SWA>
DI void attn_phase(const Params& p, int wid_, LAS unsigned char* lds, int G, int c) {
    constexpr int DK = SWA ? 64 : 192, DV = SWA ? 64 : 128, KSTR = DK * 2 + 16, VSTR = 136;
    constexpr int QB = SWA ? 2 : 1;
    constexpr int KB = 64 * KSTR, VB = DV * VSTR, STG = KB + VB;
    constexpr int CPR = DK / 8, NKC = (64 * CPR) / NTHREADS, NVC = (DV * 8) / NTHREADS, NQ = DK / 16, NDV = DV / 32;
    constexpr int LDQ = SWA ? 2048 : 1536, NUNITS = SWA ? 768 : 384;
    static_assert(2 * STG <= 131072, "attention LDS");
    const int tid = (wid_ * 64 + fresh_lane()), lane = tid & 63, wid = wid_, q = lane & 31, hh = lane >> 5;
    const bf16_t* Q = wsp<bf16_t>(p, WS_Q); const bf16_t* KN = wsp<bf16_t>(p, SWA ? WS_KO : WS_KN); const bf16_t* KPE = wsp<bf16_t>(p, WS_KPE);
    const bf16_t* VT = wsp<bf16_t>(p, SWA ? WS_VTO : WS_VT); bf16_t* MIX = wsp<bf16_t>(p, WS_MIX);
    for (int L = c; L < NUNITS; L += G) {
        int rowbase, hk, nt0, nt1, key0a, key0b = 0, kpos0 = 0, qpos0 = 0; bool masked = false;
        if (!SWA) {
            if (L < 256) { const int b = L >> 5, qt = L & 3; hk = (L >> 2) & 7; rowbase = T_CTX + b * 1024 + qt * 256; key0a = T_CTX + b * 1024; nt0 = 16; key0b = T + b * 512; nt1 = 8; }
            else { const int Lc = L - 256, b = Lc >> 3; hk = Lc & 7; rowbase = b * 256; key0a = b * 256; nt0 = 4; nt1 = 0; }
        } else {
            if (L < 512) { const int b = L >> 6, t0 = (L & 15) * 64; hk = (L >> 4) & 3; rowbase = T_CTX + b * 1024 + t0;
                const int lo = max(t0 - 128, 0) & ~63, hi = min((t0 + 192 + 63) & ~63, 1024);
                key0a = T_CTX + b * 1024 + lo; nt0 = (hi - lo) >> 6; kpos0 = lo; qpos0 = t0; masked = true; key0b = T + b * 512; nt1 = 8; }
            else { const int Lc = L - 512, b = Lc >> 4; hk = (Lc >> 2) & 3; rowbase = b * 256 + (Lc & 3) * 64; key0a = b * 256; nt0 = 4; nt1 = 0; }
        }
        const int total = nt0 + nt1;
        const int qrow0 = SWA ? rowbase + q : rowbase + wid * 32 + q;
        const int qhead = SWA ? hk * 8 + wid : hk;
        bf16x8 qf[QB][NQ];
#pragma unroll
        for (int qb = 0; qb < QB; ++qb)
#pragma unroll
            for (int s = 0; s < NQ; ++s) qf[qb][s] = *(const bf16x8*)(Q + (size_t)(qrow0 + 32 * qb) * LDQ + qhead * DK + 16 * s + 8 * hh);
        f32x16 o[QB][NDV];
#pragma unroll
        for (int qb = 0; qb < QB; ++qb)
#pragma unroll
            for (int d = 0; d < NDV; ++d)
#pragma unroll
                for (int r = 0; r < 16; ++r) o[qb][d][r] = 0.f;
        float m[QB], l[QB];
#pragma unroll
        for (int qb = 0; qb < QB; ++qb) { m[qb] = SWA ? p.in[19][qhead] * LOG2E : -1e30f; l[qb] = (SWA && hh == 0) ? 1.f : 0.f; }
        const int qpos = qpos0 + q;
        u32x4 kreg[NKC], vreg[NVC];
#define ATT_LOAD(t_) do { const int tt_ = (t_); const int kb_ = tt_ < nt0 ? key0a + tt_ * 64 : key0b + (tt_ - nt0) * 64; \
            _Pragma("unroll") for (int i = 0; i < NKC; ++i) { const int ch = tid + NTHREADS * i, j = ch / CPR, cc = ch % CPR; \
                const bf16_t* src = SWA ? KN + (size_t)(kb_ + j) * 256 + hk * 64 + cc * 8 : (cc < 16 ? KN + (size_t)(kb_ + j) * 1024 + hk * 128 + cc * 8 : KPE + (size_t)(kb_ + j) * 64 + (cc - 16) * 8); \
                kreg[i] = *(const u32x4*)src; } \
            _Pragma("unroll") for (int i = 0; i < NVC; ++i) { const int ch = tid + NTHREADS * i, dv = ch >> 3, cc = ch & 7; \
                vreg[i] = *(const u32x4*)(VT + (size_t)(hk * DV + dv) * TX + kb_ + cc * 8); } } while (0)
#define ATT_WRITE(buf_) do { LAS unsigned char* Kw = lds + (buf_) * STG; LAS unsigned char* Vw = Kw + KB; \
            _Pragma("unroll") for (int i = 0; i < NKC; ++i) { const int ch = tid + NTHREADS * i, j = ch / CPR, cc = ch % CPR; *(LAS u32x4*)(Kw + j * KSTR + cc * 16) = kreg[i]; } \
            _Pragma("unroll") for (int i = 0; i < NVC; ++i) { const int ch = tid + NTHREADS * i, dv = ch >> 3, cc = ch & 7; \
                *(LAS u32x2*)(Vw + dv * VSTR + cc * 16) = (u32x2){vreg[i].x, vreg[i].y}; *(LAS u32x2*)(Vw + dv * VSTR + cc * 16 + 8) = (u32x2){vreg[i].z, vreg[i].w}; } } while (0)
        ATT_LOAD(0); ATT_WRITE(0);
        __syncthreads();
        for (int t = 0; t < total; ++t) {
            const int buf = t & 1;
            if (t + 1 < total) ATT_LOAD(t + 1);
            const LAS unsigned char* Kl = lds + buf * STG; const LAS unsigned char* Vl = Kl + KB;
#pragma unroll
            for (int qb = 0; qb < QB; ++qb) {
                f32x16 s0, s1;
#pragma unroll
                for (int r = 0; r < 16; ++r) { s0[r] = 0.f; s1[r] = 0.f; }
#pragma unroll
                for (int s = 0; s < NQ; ++s) {
                    const bf16x8 a0 = *(const LAS bf16x8*)(Kl + q * KSTR + (16 * s + 8 * hh) * 2);
                    const bf16x8 a1 = *(const LAS bf16x8*)(Kl + (32 + q) * KSTR + (16 * s + 8 * hh) * 2);
                    s0 = __builtin_amdgcn_mfma_f32_32x32x16_bf16(a0, qf[qb][s], s0, 0, 0, 0);
                    s1 = __builtin_amdgcn_mfma_f32_32x32x16_bf16(a1, qf[qb][s], s1, 0, 0, 0);
                }
                if (SWA && masked && t < nt0) {
                    const int kp = kpos0 + t * 64 - (qpos + 32 * qb);
#pragma unroll
                    for (int r = 0; r < 16; ++r) { const int d0 = kp + crow(r, hh), d1 = d0 + 32;
                        s0[r] = (d0 >= -128 && d0 <= 128) ? s0[r] : -1e30f; s1[r] = (d1 >= -128 && d1 <= 128) ? s1[r] : -1e30f; }
                }
                float tm = fmaxf(s0[0], s1[0]);
#pragma unroll
                for (int r = 1; r < 16; ++r) tm = fmaxf(tm, fmaxf(s0[r], s1[r]));
                tm = fmaxf(tm, __shfl_xor(tm, 32));
                const float mn = fmaxf(m[qb], tm);
                if (!__all(mn == m[qb])) {
                    const float alpha = __builtin_amdgcn_exp2f(m[qb] - mn); m[qb] = mn; l[qb] *= alpha;
#pragma unroll
                    for (int d = 0; d < NDV; ++d)
#pragma unroll
                        for (int r = 0; r < 16; ++r) o[qb][d][r] *= alpha; }
                float ls = 0.f;
#pragma unroll
                for (int r = 0; r < 16; ++r) { s0[r] = __builtin_amdgcn_exp2f(s0[r] - m[qb]); s1[r] = __builtin_amdgcn_exp2f(s1[r] - m[qb]); ls += s0[r] + s1[r]; }
                l[qb] += ls;
                bf16x8 pb[2][2];
#pragma unroll
                for (int s = 0; s < 2; ++s) {
                    u32x4 w0, w1;
                    w0.x = cvtpk(s0[8 * s + 0], s0[8 * s + 1]); w0.y = cvtpk(s0[8 * s + 2], s0[8 * s + 3]); w0.z = cvtpk(s0[8 * s + 4], s0[8 * s + 5]); w0.w = cvtpk(s0[8 * s + 6], s0[8 * s + 7]);
                    w1.x = cvtpk(s1[8 * s + 0], s1[8 * s + 1]); w1.y = cvtpk(s1[8 * s + 2], s1[8 * s + 3]); w1.z = cvtpk(s1[8 * s + 4], s1[8 * s + 5]); w1.w = cvtpk(s1[8 * s + 6], s1[8 * s + 7]);
                    pb[0][s] = __builtin_bit_cast(bf16x8, w0); pb[1][s] = __builtin_bit_cast(bf16x8, w1);
                }
#pragma unroll
                for (int d = 0; d < NDV; ++d)
#pragma unroll
                    for (int blk = 0; blk < 2; ++blk)
#pragma unroll
                        for (int s = 0; s < 2; ++s) {
                            const LAS unsigned char* vp = Vl + (d * 32 + q) * VSTR + (blk * 32 + 16 * s + 4 * hh) * 2;
                            const s16x4 lo = *(const LAS s16x4*)vp, hi = *(const LAS s16x4*)(vp + 16);
                            const bf16x8 a = {lo[0], lo[1], lo[2], lo[3], hi[0], hi[1], hi[2], hi[3]};
                            o[qb][d] = __builtin_amdgcn_mfma_f32_32x32x16_bf16(a, pb[blk][s], o[qb][d], 0, 0, 0);
                        }
                if (QB > 1) __builtin_amdgcn_sched_barrier(0);
            }
            if (t + 1 < total) ATT_WRITE(buf ^ 1);
            __syncthreads();
        }
#undef ATT_LOAD
#undef ATT_WRITE
#pragma unroll
        for (int qb = 0; qb < QB; ++qb) {
            const float inv = 1.f / (l[qb] + __shfl_xor(l[qb], 32));
            bf16_t* orow = MIX + (size_t)(qrow0 + 32 * qb) * 2048 + qhead * DV;
            unsigned char* orow8 = (unsigned char*)MIX + (size_t)(qrow0 + 32 * qb) * 2048 + qhead * DV;
#pragma unroll
            for (int d = 0; d < NDV; ++d)
#pragma unroll
                for (int g = 0; g < 4; ++g) {
                    if (OUT_F8) *(unsigned*)(orow8 + d * 32 + 8 * g + 4 * hh) = pk4_fp8(o[qb][d][4 * g] * inv, o[qb][d][4 * g + 1] * inv, o[qb][d][4 * g + 2] * inv, o[qb][d][4 * g + 3] * inv);
                    else { u32x2 w; w.x = cvtpk(o[qb][d][4 * g] * inv, o[qb][d][4 * g + 1] * inv); w.y = cvtpk(o[qb][d][4 * g + 2] * inv, o[qb][d][4 * g + 3] * inv); *(u32x2*)(orow + d * 32 + 8 * g + 4 * hh) = w; } }
        }
    }
}
}


#ifndef R_PRO
#define R_PRO 1
#endif
#ifndef R_MOE
#define R_MOE 1
#endif
#ifndef R_ATT
#define R_ATT 1
#endif
#ifndef R_ATTM
#define R_ATTM R_ATT
#endif
#ifndef R_ATTS
#define R_ATTS R_ATT
#endif
#ifndef R_GEMM
#define R_GEMM 1
#endif
#ifndef R_THIN
#define R_THIN 1
#endif
#ifndef R_LN1
#define R_LN1 1
#endif
#ifndef R_LN2
#define R_LN2 1
#endif
#ifndef R_TOPK
#define R_TOPK 1
#endif
#define REP(n) for (int _r = 0; _r < (n); ++_r)
#define REPS(n, ...) do { { __VA_ARGS__ } if ((n) > 1) { __VA_ARGS__ } } while (0)
constexpr int LDS_BYTES = 147456, MISC_OFF = 146432;
constexpr int NPH = 20;
#ifndef CVT_WAVES
#define CVT_WAVES 2
#endif
constexpr int CV_IDLE = 10240;
__global__ void __launch_bounds__(NTHREADS, 2) mega(Params p) {
    extern __shared__ __attribute__((aligned(16))) unsigned char lds[];
    const int G = gridDim.x, c = vcu_of(blockIdx.x, G), wid = __builtin_amdgcn_readfirstlane(threadIdx.x >> 6);
    volatile LAS unsigned* MISC = (volatile LAS unsigned*)((LAS unsigned char*)lds + MISC_OFF);
    if (threadIdx.x < 4) MISC[threadIdx.x] = 0u;
    __syncthreads();
    XcdBarrier bar = xcd_barrier_post((unsigned*)(p.ws + WS_CTL) + CW_BAR, MISC);
    const int lo = p.ph_lo, hi = p.ph_hi;
#define IN(k) (lo <= (k) && (k) < hi)
#ifdef STAMP_A
#define stamps_ (wsp<unsigned long long>(p, WS_DBG + 65536))
#define STAMP(k) do { if (blockIdx.x == 0 && wid == 0 && fresh_lane() == 0) stamps_[k] = __builtin_amdgcn_s_memrealtime(); } while (0)
#else
#define STAMP(k) do { } while (0)
#endif
    STAMP(0); STAMP(23);
#ifndef R_BAR
#define R_BAR 1
#endif
#define SEAM(k) do { if (IN(k) && IN((k) + 1)) { xcd_barrier(bar); if (R_BAR > 1) xcd_barrier(bar); } STAMP((k) + 1); } while (0)
    if (IN(0)) REP(R_PRO) { ph_mod(p, wid, lds); STAMP(21); ph_misc(p, wid); STAMP(22); ph_convert(p, wid, 0, G == 256 ? CV_TOTAL - 3 * CV_IDLE : CV_TOTAL, blockIdx.x, G, CVT_WAVES);
#ifdef RD_PAT
        ph_readonly<RD_PAT>(p, wid);
#endif
    } SEAM(0);
    if (IN(1)) REP(R_THIN) { ph_modreduce(p, wid); ph_h0(p, wid, lds); } SEAM(1);
    if (IN(2)) { REPS(R_GEMM, SchedInEven S{&p, G, c}; EpiInEven E{&p}; pg8::gemm_phase((LAS unsigned char*)lds, S, E, wid);); if (G == 256 && c >= 128) ph_convert(p, wid, CV_TOTAL - 3 * CV_IDLE, CV_TOTAL - 2 * CV_IDLE, c - 128, 128, CVT_WAVES); } SEAM(2);
    if (IN(3)) REP(R_THIN) { ph_e1(p, wid); } SEAM(3);
    if (IN(4)) REPS(R_GEMM, SchedE2 S{&p, G, c}; EpiE2 E{&p}; pg8::gemm_phase((LAS unsigned char*)lds, S, E, wid);); SEAM(4);
    if (IN(5)) REP(R_ATTM) { att::attn_phase<false>(p, wid, (LAS unsigned char*)lds, G, c); } SEAM(5);
    if (IN(6)) { REPS(R_GEMM, SchedOut S{&p, G, c, 0}; EpiOut E{&p, 0}; pg8::gemm_phase((LAS unsigned char*)lds, S, E, wid);); if (G == 256 && c >= 128) ph_convert(p, wid, CV_TOTAL - 2 * CV_IDLE, CV_TOTAL - CV_IDLE, c - 128, 128, CVT_WAVES); } SEAM(6);
    if (IN(7)) REP(R_LN1) { ph_ln1(p, wid, 0, lds); } SEAM(7);
    if (IN(8)) REP(R_TOPK) { ph_topk(p, wid, lds); } SEAM(8);
    if (IN(9)) REPS(R_MOE, SchedGU S{&p, G, c, 0}; EpiGU E{&p}; pg8::gemm_phase((LAS unsigned char*)lds, S, E, wid);); SEAM(9);
    if (IN(10)) REPS(R_MOE, SchedDown S{&p, G, c, 0}; EpiDown E{&p}; pg8::gemm_phase((LAS unsigned char*)lds, S, E, wid);); SEAM(10);
    if (IN(11)) REP(R_LN2) { ph_ln2(p, wid, 0, lds); } SEAM(11);
    if (IN(12)) REPS(R_GEMM, SchedInOdd S{&p, G, c}; EpiInOdd E{&p}; pg8::gemm_phase((LAS unsigned char*)lds, S, E, wid);); SEAM(12);
    if (IN(13)) REP(R_ATTS) { att::attn_phase<true>(p, wid, (LAS unsigned char*)lds, G, c); } SEAM(13);
    if (IN(14)) { REPS(R_GEMM, SchedOut S{&p, G, c, 1}; EpiOut E{&p, 1}; pg8::gemm_phase((LAS unsigned char*)lds, S, E, wid);); if (G == 256 && c >= 128) ph_convert(p, wid, CV_TOTAL - CV_IDLE, CV_TOTAL, c - 128, 128, CVT_WAVES); } SEAM(14);
    if (IN(15)) REP(R_LN1) { ph_ln1(p, wid, 1, lds); } SEAM(15);
    if (IN(16)) REP(R_TOPK) { ph_topk(p, wid, lds); } SEAM(16);
    if (IN(17)) REPS(R_MOE, SchedGU S{&p, G, c, 1}; EpiGU E{&p}; pg8::gemm_phase((LAS unsigned char*)lds, S, E, wid);); SEAM(17);
    if (IN(18)) REPS(R_MOE, SchedDown S{&p, G, c, 1}; EpiDown E{&p}; pg8::gemm_phase((LAS unsigned char*)lds, S, E, wid);); SEAM(18);
    if (IN(19)) REP(R_LN2) { ph_ln2(p, wid, 1, lds); }
#ifdef STAMP_A
    STAMP(20);
    if (blockIdx.x == 0 && wid == 0 && fresh_lane() == 0) {
        asm volatile("s_waitcnt vmcnt(0)" ::: "memory");
        const unsigned long long d = (__hip_atomic_load(&stamps_[STAMP_B], __ATOMIC_RELAXED, __HIP_MEMORY_SCOPE_AGENT) - __hip_atomic_load(&stamps_[STAMP_A], __ATOMIC_RELAXED, __HIP_MEMORY_SCOPE_AGENT)) * 4ull;
        const unsigned long long t0 = __builtin_amdgcn_s_memrealtime();
        while (__builtin_amdgcn_s_memrealtime() - t0 < d) __builtin_amdgcn_s_sleep(8);
    }
#endif
#undef IN
#undef SEAM
}

extern "C" void kernel_launch(void* const* d_in, const int* in_sizes, int n_in, void* d_out, int out_size, void* d_ws, size_t ws_size, hipStream_t stream) {
    static int grid = 0;
    if (grid == 0) {
        if (n_in != 29 || out_size != (int)O_END || ws_size < WS_END) { fprintf(stderr, "kernel_launch: unexpected shapes (n_in %d out %d ws %zu need %zu)\n", n_in, out_size, ws_size, (size_t)WS_END); grid = -1; return; }
        int dev = 0, cus = 0, per_cu = 0;
        if (hipGetDevice(&dev) != hipSuccess || hipDeviceGetAttribute(&cus, hipDeviceAttributeMultiprocessorCount, dev) != hipSuccess) { grid = -1; return; }
        if (hipFuncSetAttribute((const void*)mega, hipFuncAttributeMaxDynamicSharedMemorySize, LDS_BYTES) != hipSuccess) { fprintf(stderr, "hipFuncSetAttribute failed\n"); grid = -1; return; }
        if (hipOccupancyMaxActiveBlocksPerMultiprocessor(&per_cu, (const void*)mega, NTHREADS, LDS_BYTES) != hipSuccess || per_cu < 1) fprintf(stderr, "occupancy query: %d\n", per_cu);
        (void)hipGetLastError();
        grid = cus > 0 ? cus : 256;
    }
    if (grid < 0) return;
    Params p{};
    for (int i = 0; i < 29; ++i) p.in[i] = (const float*)d_in[i];
    p.out = (float*)d_out; p.ws = (unsigned char*)d_ws; p.ph_lo = 0; p.ph_hi = NPH; p.rpb = (T + grid - 1) / grid; p.pad = 0;
    (void)hipMemsetAsync((char*)d_ws + WS_CTL, 0, CTL_BYTES, stream);
    hipLaunchKernelGGL(mega, dim3(grid), dim3(NTHREADS), LDS_BYTES, stream, p);
}
```

```cpp
#include <hip/hip_runtime.h>
#include <cstdio>
#include <cstdint>

constexpr int D = 2048, T_CTX = 4096, T = 12288, TC = 4096, TX = 16384;
constexpr int MODW = 12288, NCOND = 9;
constexpr int NSLOT = 1536, NXS = 16 * NSLOT;
constexpr float DN_ALPHA = 1.41421356237309515f;
constexpr float LOG2E = 1.44269504088896341f;
constexpr float QS_MLA = 0.07216878364870322f * LOG2E;
constexpr float QS_SWA = 0.125f * LOG2E;
constexpr int NTHREADS = 512, NWAVES = 8;
#ifndef MOE_F8
#define MOE_F8 1
#endif
#ifndef OUT_F8
#define OUT_F8 1
#endif
constexpr float GU_WSCALE = 32.f, DN_WSCALE = 64.f, OUT_WSCALE = 64.f;

constexpr size_t O_Y = 0, O_CKV = 25165824, O_KPE = 26214400, O_SK = 26476544, O_SV = 27525120, O_END = 28573696;

constexpr size_t al256(size_t x) { return (x + 255) & ~(size_t)255; }
constexpr size_t WS_CTL = 0, CTL_BYTES = 1u << 20;
constexpr size_t WS_MOD = WS_CTL + CTL_BYTES;
constexpr size_t WS_ROPE = WS_MOD + al256((size_t)2 * 9 * 12288 * 4);
constexpr size_t WS_WINE = WS_ROPE + al256((size_t)2 * 1024 * 32 * 4);
constexpr size_t WS_W2 = WS_WINE + (size_t)2048 * 2048 * 2;
constexpr size_t WS_WOUTE = WS_W2 + (size_t)4608 * 1792 * 2;
constexpr size_t WS_WINO = WS_WOUTE + (size_t)2048 * 2048 * 2;
constexpr size_t WS_WOUTO = WS_WINO + (size_t)2560 * 2048 * 2;
constexpr size_t WS_WGU = WS_WOUTO + (size_t)2048 * 2048 * 2;
constexpr size_t WS_WDN = WS_WGU + (size_t)32 * 4096 * 2048 * 2;
constexpr size_t WS_H = WS_WDN + (size_t)32 * 2048 * 2048 * 2;
constexpr size_t WS_PJ = WS_H + (size_t)T * 2048 * 2;
constexpr size_t WS_ACT2 = WS_PJ + (size_t)T * 1792 * 4;
constexpr size_t WS_KPE = WS_ACT2 + (size_t)TX * 1792 * 2;
constexpr size_t WS_Q = WS_KPE + (size_t)TX * 64 * 2;
constexpr size_t WS_KN = WS_Q + (size_t)T * 2048 * 2;
constexpr size_t WS_VT = WS_KN + (size_t)TX * 1024 * 2;
constexpr size_t WS_VTO = WS_VT + (size_t)1024 * TX * 2;
constexpr size_t WS_KO = WS_VTO + (size_t)256 * TX * 2;
constexpr size_t WS_MIX = WS_KO + (size_t)TX * 256 * 2;
constexpr size_t WS_Y = WS_MIX + (size_t)T * 2048 * 2;
constexpr size_t WS_X1 = WS_Y + (size_t)T * 2048 * 4;
constexpr size_t WS_XL = WS_X1 + (size_t)T * 2048 * 4;
constexpr size_t WS_AFF = WS_XL + (size_t)T * 2048 * 4;
constexpr size_t WS_INV = WS_AFF + (size_t)T * 16 * 4;
constexpr size_t WS_XS = WS_INV + (size_t)T * 16 * 4;
constexpr size_t WS_HID = WS_XS + (size_t)NXS * 2048 * 2;
constexpr size_t WS_YE = WS_HID + (size_t)NXS * 2048 * 2;
constexpr size_t WS_AFFT = WS_YE + (size_t)NXS * 2048 * 2;
constexpr size_t WS_H8 = WS_AFFT + (size_t)T * 16 * 4;
constexpr size_t WS_STAT = WS_H8 + (size_t)T * 2048;
constexpr size_t WS_MODP = WS_STAT + (size_t)T * 8;
constexpr size_t WS_GB = WS_MODP + (size_t)4 * 2 * 9 * 12288 * 4;
constexpr size_t WS_DBG = WS_GB + (size_t)2 * 9 * 2 * 2048 * 4;
constexpr size_t WS_END = WS_DBG + (1u << 20);

typedef unsigned short bf16_t;
typedef float f32x4 __attribute__((ext_vector_type(4)));
typedef unsigned u32x4 __attribute__((ext_vector_type(4)));
typedef unsigned u32x2 __attribute__((ext_vector_type(2)));
typedef float f32x2 __attribute__((ext_vector_type(2)));
#define LAS __attribute__((address_space(3)))
#define DI __device__ __forceinline__

struct Params {
    const float* in[29];
    float* out;
    unsigned char* ws;
    int ph_lo, ph_hi;
    int rpb, pad;
};

DI unsigned f2bf(float f) { unsigned u = __float_as_uint(f); return (u + 0x7fffu + ((u >> 16) & 1u)) >> 16; }
typedef __bf16 bf16x2_hw __attribute__((ext_vector_type(2)));
DI unsigned pk2(float lo, float hi) { f32x2 v = {lo, hi}; bf16x2_hw b = __builtin_convertvector(v, bf16x2_hw); return __builtin_bit_cast(unsigned, b); }
DI unsigned pk4_fp8(float a, float b, float c, float d) { unsigned w = 0; w = __builtin_amdgcn_cvt_pk_fp8_f32(a, b, w, false); w = __builtin_amdgcn_cvt_pk_fp8_f32(c, d, w, true); return w; }
DI float bf2f(unsigned b) { return __uint_as_float(b << 16); }
DI float bflo(unsigned w) { return __uint_as_float(w << 16); }
DI float bfhi(unsigned w) { return __uint_as_float(w & 0xffff0000u); }
DI float wave_sum(float v) {
#pragma unroll
    for (int o = 1; o < 64; o <<= 1) v += __shfl_xor(v, o);
    return v;
}
DI float wave_max(float v) {
#pragma unroll
    for (int o = 1; o < 64; o <<= 1) v = fmaxf(v, __shfl_xor(v, o));
    return v;
}
DI int fresh_lane() { int l = (int)__builtin_amdgcn_mbcnt_hi(~0u, __builtin_amdgcn_mbcnt_lo(~0u, 0u)); asm volatile("" : "+v"(l)); return l; }
DI int cond_of_row(int r) { return r < T_CTX ? 0 : 1 + ((r - T_CTX) >> 10); }
DI const float* xrow_in(const Params& p, int r) { return r < T_CTX ? p.in[0] + (size_t)r * D : p.in[1] + (size_t)(r - T_CTX) * D; }

DI float* ws_mod(const Params& p) { return (float*)(p.ws + WS_MOD); }
DI float* ws_cos(const Params& p) { return (float*)(p.ws + WS_ROPE); }
DI float* ws_sin(const Params& p) { return (float*)(p.ws + WS_ROPE) + 1024 * 32; }
template <class X> DI X* wsp(const Params& p, size_t off) { return (X*)(p.ws + off); }
DI const float* modp(const Params& p, int l, int ci, int j) { return ws_mod(p) + ((size_t)(l * 9 + ci) * MODW + (size_t)j * D); }

#define XB_TMO      128
#define XB_XCNT(j)  (256  + 64 * (j))
#define XB_XSUB(j)  (1280 + 64 * (j))
#define XB_XGEN(j)  (2304 + 64 * (j))
#define XB_TOP      3328
#define XB_TOPGEN   3392
#define XCD_BAR_WORDS 3456
#define XB_SPIN_CAP (1u << 18)

__device__ __forceinline__ unsigned xb_ld(unsigned* p)              { return __hip_atomic_load(p, __ATOMIC_RELAXED, __HIP_MEMORY_SCOPE_AGENT); }
__device__ __forceinline__ unsigned xb_add(unsigned* p, unsigned v) { return __hip_atomic_fetch_add(p, v, __ATOMIC_RELAXED, __HIP_MEMORY_SCOPE_AGENT); }
__device__ __forceinline__ unsigned xb_xcc_id() { return (unsigned)__builtin_amdgcn_s_getreg((3 << 11) | 20) & 0xFu; }
#define XB_SPIN(cond, bar) do { unsigned _sp = 0; while (cond) { __builtin_amdgcn_s_sleep(1); \
    if ((++_sp & 255u) == 0u) { if (xb_ld(&(bar)[XB_TMO])) break; if (_sp > XB_SPIN_CAP) { atomicAdd(&(bar)[XB_TMO], 1u); break; } } } } while (0)

struct XcdBarrier {
    unsigned* bar; unsigned x;
    volatile LAS unsigned* st;
};

__device__ __forceinline__ XcdBarrier xcd_barrier_post(unsigned* bar, volatile LAS unsigned* st) {
    XcdBarrier b; b.bar = bar; b.x = xb_xcc_id(); b.st = st;
    if (threadIdx.x == 0) (void)xb_add(&bar[XB_XCNT(b.x)], 1u);
    return b;
}
__device__ __forceinline__ void xcd_barrier_complete(unsigned* bar, unsigned x, unsigned& nloc, unsigned& nx) {
    const unsigned G = gridDim.x * gridDim.y * gridDim.z;
    unsigned sum, cnt, mine, sp = 0u;
    for (;;) {
        sum = 0u; cnt = 0u; mine = 0u;
#pragma unroll
        for (unsigned j = 0; j < 16; ++j) { const unsigned c = xb_ld(&bar[XB_XCNT(j)]); sum += c; cnt += (c > 0u) ? 1u : 0u; mine = (j == x) ? c : mine; }
        if (sum == G) break;
        __builtin_amdgcn_s_sleep(1);
        if ((++sp & 255u) == 0u) { if (xb_ld(&bar[XB_TMO])) break; if (sp > XB_SPIN_CAP) { atomicAdd(&bar[XB_TMO], 1u); break; } }
    }
    nloc = mine > 0u ? mine : 1u; nx = cnt > 0u ? cnt : 1u;
}

__device__ __forceinline__ void xcd_barrier(const XcdBarrier& b) {
    asm volatile("s_waitcnt vmcnt(0)" ::: "memory");
    __syncthreads();
    if (threadIdx.x == 0) {
        unsigned* bar = b.bar;
        __builtin_amdgcn_s_waitcnt(0);
        unsigned nloc = b.st[0], nx = b.st[1];
        if (nloc == 0u) { xcd_barrier_complete(bar, b.x, nloc, nx); b.st[0] = nloc; b.st[1] = nx; }
        const unsigned old = xb_add(&bar[XB_XSUB(b.x)], 1u);
        const unsigned gen = old / nloc;
        if (old + 1u == (gen + 1u) * nloc) {
            __builtin_amdgcn_fence(__ATOMIC_RELEASE, "agent");
            asm volatile("s_waitcnt vmcnt(0)" ::: "memory");
            const unsigned og = xb_add(&bar[XB_TOP], 1u);
            const unsigned tg = og / nx;
            if (og + 1u == (tg + 1u) * nx) xb_add(&bar[XB_TOPGEN], 1u);
            else XB_SPIN(xb_ld(&bar[XB_TOPGEN]) == tg, bar);
            __builtin_amdgcn_fence(__ATOMIC_ACQUIRE, "agent");
            xb_add(&bar[XB_XGEN(b.x)], 1u);
            asm volatile("s_waitcnt vmcnt(0)" ::: "memory");
        } else {
            XB_SPIN(xb_ld(&bar[XB_XGEN(b.x)]) == gen, bar);
            __builtin_amdgcn_fence(__ATOMIC_ACQUIRE, "agent");
            asm volatile("s_waitcnt vmcnt(0)" ::: "memory");
        }
    }
    __syncthreads();
}
constexpr int CW_BAR = 4096;


DI void ph_mod(const Params& p, int wid_, unsigned char* lds_raw) {
    float* s_q = (float*)lds_raw;
    float* red = s_q + 9 * 512;
    const int tid = (wid_ * 64 + fresh_lane()), lane = tid & 63, wave = wid_;
    const float* c = p.in[6]; const float* c_ctx = p.in[7]; const float* w_ada = p.in[8];
    float* MODP = wsp<float>(p, WS_MODP);
    for (int it = blockIdx.x; it < 384; it += gridDim.x) {
        const int l = it / 192, rem = it % 192, cg = rem >> 2, kq4 = rem & 3;
        for (int i = tid; i < 9 * 512; i += NTHREADS) { const int ci = i >> 9, k = kq4 * 512 + (i & 511); const float v = ci == 0 ? c_ctx[k] : c[(ci - 1) * 2048 + k]; s_q[i] = v / (1.f + expf(-v)); }
        __syncthreads();
        const float* w = w_ada + ((size_t)l * 2048 + kq4 * 512 + wave * 64) * MODW + cg * 256 + 4 * lane;
        float acc[9][4];
#pragma unroll
        for (int ci = 0; ci < 9; ++ci)
#pragma unroll
            for (int j = 0; j < 4; ++j) acc[ci][j] = 0.f;
#pragma unroll 8
        for (int kk = 0; kk < 64; ++kk) {
            const f32x4 wv = __builtin_nontemporal_load((const f32x4*)(w + (size_t)kk * MODW));
#pragma unroll
            for (int ci = 0; ci < 9; ++ci) { const float s = s_q[ci * 512 + wave * 64 + kk];
#pragma unroll
                for (int j = 0; j < 4; ++j) acc[ci][j] += s * wv[j]; }
        }
#pragma unroll
        for (int ci = 0; ci < 9; ++ci) *(f32x4*)(red + (wave * 9 + ci) * 256 + 4 * lane) = (f32x4){acc[ci][0], acc[ci][1], acc[ci][2], acc[ci][3]};
        __syncthreads();
        for (int o = tid; o < 9 * 256; o += NTHREADS) { const int ci = o >> 8, cc = o & 255; float s = 0.f;
#pragma unroll
            for (int w8 = 0; w8 < 8; ++w8) s += red[(w8 * 9 + ci) * 256 + cc];
            MODP[((size_t)(kq4 * 2 + l) * 9 + ci) * MODW + cg * 256 + cc] = s; }
        __syncthreads();
    }
}
DI void ph_modreduce(const Params& p, int wid_) {
    const float* MODP = wsp<float>(p, WS_MODP); float* MOD = ws_mod(p); const float* b_ada = p.in[9];
    const int n4 = 2 * 9 * MODW / 4;
    for (int i = blockIdx.x * NTHREADS + (wid_ * 64 + fresh_lane()); i < n4; i += gridDim.x * NTHREADS) { const int e = i * 4, l = e / (9 * MODW), col = e % MODW;
        f32x4 s = *(const f32x4*)(b_ada + l * MODW + col);
#pragma unroll
        for (int q = 0; q < 4; ++q) s += *(const f32x4*)(MODP + (size_t)q * 2 * 9 * MODW + e);
        *(f32x4*)(MOD + e) = s; }
}
DI f32x4 mod_from_partials(const Params& p, int l, int ci, int j, int col) {
    const float* MODP = wsp<float>(p, WS_MODP); const size_t e = (size_t)(l * 9 + ci) * MODW + (size_t)j * D + col;
    f32x4 s = *(const f32x4*)(p.in[9] + l * MODW + j * D + col);
#pragma unroll
    for (int q = 0; q < 4; ++q) s += *(const f32x4*)(MODP + (size_t)q * 2 * 9 * MODW + e);
    return s;
}

constexpr int CV_INE = 928, CV_UQ = 192, CV_UKV = 128, CV_POOL = 64, CV_OUT = 1024, CV_INO = 1280, CV_MOE = 98304;
constexpr int CV_TOTAL = CV_INE + CV_UQ + CV_UKV + CV_POOL + CV_OUT + CV_INO + CV_OUT + CV_MOE;
DI void cvt_item(const Params& p, int item, int lane) {
    const float* src; bf16_t* dst; int K, N, ldd, nb, kb, map = 0, a = 0; float f8s = 0.f;
    if (item < CV_INE) { src = p.in[10]; dst = wsp<bf16_t>(p, WS_WINE); K = 2048; N = 1856; ldd = 2048; nb = item % 29; kb = item / 29; map = 1; }
    else if ((item -= CV_INE) < CV_UQ) { src = p.in[13]; dst = wsp<bf16_t>(p, WS_W2); K = 512; N = 1536; ldd = 1792; nb = item % 24; kb = item / 24; }
    else if ((item -= CV_UQ) < CV_UKV) { src = p.in[14]; dst = wsp<bf16_t>(p, WS_W2); K = 256; N = 2048; ldd = 1792; nb = item % 32; kb = item / 32; map = 2; }
    else if ((item -= CV_UKV) < CV_POOL) { const int g = item >> 4, r = item & 15; src = p.in[15] + (size_t)g * 65536; dst = wsp<bf16_t>(p, WS_W2); K = 256; N = 256; ldd = 1792; nb = r & 3; kb = r >> 2; a = 3584 + g * 256; }
    else if ((item -= CV_POOL) < CV_OUT) { src = p.in[17]; dst = wsp<bf16_t>(p, WS_WOUTE); K = 2048; N = 2048; ldd = 2048; nb = item & 31; kb = item >> 5; if (OUT_F8) f8s = OUT_WSCALE; }
    else if ((item -= CV_OUT) < CV_INO) { src = p.in[18]; dst = wsp<bf16_t>(p, WS_WINO); K = 2048; N = 2560; ldd = 2048; nb = item % 40; kb = item / 40; }
    else if ((item -= CV_INO) < CV_OUT) { src = p.in[20]; dst = wsp<bf16_t>(p, WS_WOUTO); K = 2048; N = 2048; ldd = 2048; nb = item & 31; kb = item >> 5; if (OUT_F8) f8s = OUT_WSCALE; }
    else { item -= CV_OUT; const int mat = item >> 10, w = item & 1023, le = mat / 3, kind = mat % 3; K = 2048; N = 2048; ldd = 2048; nb = w & 31; kb = w >> 5;
        src = p.in[24 + kind] + (size_t)le * 2048 * 2048;
        if (kind == 2) dst = wsp<bf16_t>(p, WS_WDN) + (size_t)le * 2048 * 2048; else { dst = wsp<bf16_t>(p, WS_WGU) + (size_t)le * 4096 * 2048; map = 3; a = kind * 128; }
        if (MOE_F8) { f8s = kind == 2 ? DN_WSCALE : GU_WSCALE; dst = (bf16_t*)((unsigned char*)(kind == 2 ? wsp<bf16_t>(p, WS_WDN) : wsp<bf16_t>(p, WS_WGU)) + (size_t)le * (kind == 2 ? 2048 : 4096) * 2048); } }
    const int n = nb * 64 + lane;
    const float* s = src + (size_t)(kb * 64) * N + n;
    float v[64];
#pragma unroll
    for (int k = 0; k < 64; ++k) v[k] = __builtin_nontemporal_load(s + (size_t)k * N);
    int drow;
    if (map == 0) drow = n + a;
    else if (map == 1) drow = n < 768 ? n : (n < 832 ? 1792 + (n - 768) : 768 + (n - 832));
    else if (map == 2) { const int h = n >> 8, j = n & 255; drow = j < 128 ? 1536 + h * 128 + j : 2560 + h * 128 + (j - 128); }
    else drow = (n >> 7) * 256 + (n & 127) + a;
    if (f8s != 0.f) { u32x4* d8 = (u32x4*)((unsigned char*)dst + (size_t)drow * 2048 + kb * 64);
#pragma unroll
        for (int c16 = 0; c16 < 4; ++c16) { u32x4 o; const float* w = v + 16 * c16;
            o.x = pk4_fp8(w[0] * f8s, w[1] * f8s, w[2] * f8s, w[3] * f8s); o.y = pk4_fp8(w[4] * f8s, w[5] * f8s, w[6] * f8s, w[7] * f8s); o.z = pk4_fp8(w[8] * f8s, w[9] * f8s, w[10] * f8s, w[11] * f8s); o.w = pk4_fp8(w[12] * f8s, w[13] * f8s, w[14] * f8s, w[15] * f8s); d8[c16] = o; }
        return; }
    u32x4* d = (u32x4*)(dst + (size_t)drow * ldd + kb * 64);
#pragma unroll
    for (int c8 = 0; c8 < 8; ++c8) { u32x4 o; o.x = pk2(v[8 * c8], v[8 * c8 + 1]); o.y = pk2(v[8 * c8 + 2], v[8 * c8 + 3]); o.z = pk2(v[8 * c8 + 4], v[8 * c8 + 5]); o.w = pk2(v[8 * c8 + 6], v[8 * c8 + 7]); d[c8] = o; }
}
DI void ph_convert(const Params& p, int wid_, int item_lo, int item_hi, int bid, int nblk, int nwv) {
    const int wv_ = wid_; if (wv_ >= nwv) return;
    const int lane = (wid_ * 64 + fresh_lane()) & 63, gw = bid * nwv + wv_, NGW = nblk * nwv;
    for (int it = item_lo + gw; it < item_hi; it += NGW) cvt_item(p, it, lane);
}

DI void ph_misc(const Params& p, int wid_) {
    const size_t gt = (size_t)blockIdx.x * NTHREADS + (wid_ * 64 + fresh_lane()), NGT = (size_t)gridDim.x * NTHREADS;
    float* cosT = ws_cos(p); float* sinT = ws_sin(p);
    for (size_t i = gt; i < 1024 * 32; i += NGT) { const int s = (int)(i >> 5), f = (int)(i & 31);
        const float inv = powf(10000.f, -(float)(f & 15) / 16.f); const float pos = f < 16 ? (float)(s >> 6) : (float)(s & 63); const float ang = pos * inv;
        cosT[i] = cosf(ang); sinT[i] = sinf(ang); }
    bf16_t* ACT2 = wsp<bf16_t>(p, WS_ACT2); bf16_t* KPE = wsp<bf16_t>(p, WS_KPE); bf16_t* KO = wsp<bf16_t>(p, WS_KO); bf16_t* VTO = wsp<bf16_t>(p, WS_VTO);
    const float* cckv = p.in[2]; const float* ckpe = p.in[3]; const float* csk = p.in[4]; const float* csv = p.in[5];
    for (size_t i = gt; i < (size_t)TC * 256 / 4; i += NGT) { const size_t e = i * 4; const int j = (int)(e >> 8), cc = (int)(e & 255); const f32x4 v = *(const f32x4*)(cckv + e);
        u32x2 o; o.x = pk2(v[0], v[1]); o.y = pk2(v[2], v[3]); *(u32x2*)(ACT2 + (size_t)(T + j) * 1792 + 512 + cc) = o;
        const f32x4 k = *(const f32x4*)(csk + e); u32x2 o2; o2.x = pk2(k[0], k[1]); o2.y = pk2(k[2], k[3]); *(u32x2*)(KO + (size_t)(T + j) * 256 + cc) = o2; }
    for (size_t i = gt; i < (size_t)TC * 64 / 4; i += NGT) { const size_t e = i * 4; const f32x4 v = *(const f32x4*)(ckpe + e); u32x2 o; o.x = pk2(v[0], v[1]); o.y = pk2(v[2], v[3]); *(u32x2*)(KPE + (size_t)T * 64 + e) = o; }
    for (size_t i = gt; i < (size_t)256 * (TC / 8); i += NGT) { const int f = (int)(i / (TC / 8)), j8 = (int)(i % (TC / 8)) * 8; float v[8];
#pragma unroll
        for (int q = 0; q < 8; ++q) v[q] = csv[(size_t)(j8 + q) * 256 + f];
        u32x4 o; o.x = pk2(v[0], v[1]); o.y = pk2(v[2], v[3]); o.z = pk2(v[4], v[5]); o.w = pk2(v[6], v[7]); *(u32x4*)(VTO + (size_t)f * TX + T + j8) = o; }
}

DI void ph_h0(const Params& p, int wid_, unsigned char* lds_raw) {
    const int tid = (wid_ * 64 + fresh_lane()), lane = tid & 63, wv = wid_;
    const int rpb = p.rpb, rb0 = blockIdx.x * rpb, rb1 = min(rb0 + rpb, T);
    if (rb0 >= T) return;
    LAS float* P = (LAS float*)lds_raw;
    const int c_lo = cond_of_row(rb0);
    for (int i = tid; i < 2 * 2 * 512; i += NTHREADS) { const int cc = i >> 10, j = (i >> 9) & 1, col = (i & 511) * 4; const int ci = min(c_lo + cc, 8);
        *(LAS f32x4*)(P + (cc * 2 + j) * 2048 + col) = mod_from_partials(p, 0, ci, j, col); }
    __syncthreads();
    bf16_t* H = wsp<bf16_t>(p, WS_H);
    f32x4 v[8], vn[8]; int r = rb0 + wv;
    if (r < rb1) { const float* x = xrow_in(p, r) + lane * 8;
#pragma unroll
        for (int j = 0; j < 4; ++j) { v[2 * j] = __builtin_nontemporal_load((const f32x4*)(x + 512 * j)); v[2 * j + 1] = __builtin_nontemporal_load((const f32x4*)(x + 512 * j + 4)); } }
    for (; r < rb1; r += NWAVES) {
        const int rn = r + NWAVES;
        if (rn < rb1) { const float* x = xrow_in(p, rn) + lane * 8;
#pragma unroll
            for (int j = 0; j < 4; ++j) { vn[2 * j] = __builtin_nontemporal_load((const f32x4*)(x + 512 * j)); vn[2 * j + 1] = __builtin_nontemporal_load((const f32x4*)(x + 512 * j + 4)); } }
        asm volatile("" ::: "memory");
        const LAS float* sh = P + (cond_of_row(r) - c_lo) * 4096; const LAS float* sc = sh + 2048;
#pragma unroll
        for (int j = 0; j < 4; ++j) { const int c0 = lane * 8 + 512 * j;
            const f32x4 h0 = v[2 * j] * (1.f + *(const LAS f32x4*)(sc + c0)) + *(const LAS f32x4*)(sh + c0), h1 = v[2 * j + 1] * (1.f + *(const LAS f32x4*)(sc + c0 + 4)) + *(const LAS f32x4*)(sh + c0 + 4);
            u32x4 o; o.x = pk2(h0[0], h0[1]); o.y = pk2(h0[2], h0[3]); o.z = pk2(h1[0], h1[1]); o.w = pk2(h1[2], h1[3]); *(u32x4*)(H + (size_t)r * D + c0) = o; }
#pragma unroll
        for (int j = 0; j < 8; ++j) v[j] = vn[j];
    }
}

DI void ph_gb(const Params& p, int wid_) {
    float* GB = wsp<float>(p, WS_GB);
    for (int i = blockIdx.x * NTHREADS + (wid_ * 64 + fresh_lane()); i < 2 * 9 * 512; i += gridDim.x * NTHREADS) { const int l = i / (9 * 512), ci = (i / 512) % 9, col = (i & 511) * 4;
        const f32x4 g = *(const f32x4*)(p.in[21] + l * D + col), b = *(const f32x4*)(p.in[22] + l * D + col), sh = *(const f32x4*)(modp(p, l, ci, 3) + col), sc = *(const f32x4*)(modp(p, l, ci, 4) + col);
        *(f32x4*)(GB + ((size_t)(l * 9 + ci) * 2 + 0) * D + col) = g * (1.f + sc); *(f32x4*)(GB + ((size_t)(l * 9 + ci) * 2 + 1) * D + col) = b * (1.f + sc) + sh; }
}
struct E1Row { f32x4 cq[2], ckv, u[4], ad[4], sb[4]; };
DI void e1_seq(int r, int& s, int& S, int& rb) { if (r < T_CTX) { s = r & 255; S = 256; } else { s = (r - T_CTX) & 1023; S = 1024; } rb = r - s; }
DI void e1_load(const float* PJ, int r, int lane, E1Row& L) {
    const float* pr = PJ + (size_t)r * 1792; int s, S, rb; e1_seq(r, s, S, rb);
    L.cq[0] = *(const f32x4*)(pr + lane * 4); L.cq[1] = *(const f32x4*)(pr + lane * 4 + 256); L.ckv = *(const f32x4*)(pr + 512 + lane * 4);
#pragma unroll
    for (int g = 0; g < 4; ++g) { const int half = 1 << g, c0 = 768 + g * 256 + lane * 4; const int ia = s + half - 1, ib = s - half - 1;
        L.u[g] = *(const f32x4*)(pr + c0);
        const float ma = ia < S ? 1.f : 0.f, mb = ib >= 0 ? 1.f : 0.f;
        L.ad[g] = *(const f32x4*)(PJ + (size_t)(rb + min(ia, S - 1)) * 1792 + c0) * ma; L.sb[g] = *(const f32x4*)(PJ + (size_t)(rb + max(ib, 0)) * 1792 + c0) * mb; }
}
DI void e1_window_before(const float* PJ, int r, int lane, f32x4 (&wsum)[4]) {
    int s, S, rb; e1_seq(r, s, S, rb);
#pragma unroll
    for (int g = 0; g < 4; ++g) { const int half = 1 << g, c0 = 768 + g * 256 + lane * 4; const int lo = max(s - 1 - half, 0), hi = min(s - 1 + half, S);
        f32x4 sum = {0.f, 0.f, 0.f, 0.f};
        for (int t = lo; t < hi; ++t) sum += *(const f32x4*)(PJ + (size_t)(rb + t) * 1792 + c0);
        wsum[g] = sum; }
}
DI void ph_e1(const Params& p, int wid_) {
    ph_gb(p, wid_);
    const int lane = fresh_lane();
    const int rpw = (p.rpb + NWAVES - 1) / NWAVES, rb0 = blockIdx.x * p.rpb, ra = rb0 + wid_ * rpw, rz = min(min(ra + rpw, rb0 + p.rpb), T);
    if (ra >= rz) return;
    const float* PJ = wsp<float>(p, WS_PJ); bf16_t* ACT2 = wsp<bf16_t>(p, WS_ACT2);
    const float* qn = p.in[11]; const float* kvn = p.in[12];
    const f32x4 gq0 = *(const f32x4*)(qn + lane * 4), gq1 = *(const f32x4*)(qn + lane * 4 + 256), gkv = *(const f32x4*)(kvn + lane * 4);
    f32x4 wsum[4]; E1Row A, B;
    e1_load(PJ, ra, lane, A);
    e1_window_before(PJ, ra, lane, wsum);
    for (int r = ra; r < rz; ++r) {
        if (r + 1 < rz) e1_load(PJ, r + 1, lane, B);
        bf16_t* ar = ACT2 + (size_t)r * 1792; int s, S, rb; e1_seq(r, s, S, rb);
        if (s == 0 && r != ra) e1_window_before(PJ, r, lane, wsum);
        {
            const float ss = ((A.cq[0][0] * A.cq[0][0] + A.cq[0][1] * A.cq[0][1]) + (A.cq[0][2] * A.cq[0][2] + A.cq[0][3] * A.cq[0][3])) + ((A.cq[1][0] * A.cq[1][0] + A.cq[1][1] * A.cq[1][1]) + (A.cq[1][2] * A.cq[1][2] + A.cq[1][3] * A.cq[1][3]));
            const float rs = rsqrtf(wave_sum(ss) * (1.f / 512.f) + 1e-6f);
            const f32x4 y0 = A.cq[0] * rs * gq0, y1 = A.cq[1] * rs * gq1;
            u32x2 o; o.x = pk2(y0[0], y0[1]); o.y = pk2(y0[2], y0[3]); *(u32x2*)(ar + lane * 4) = o; o.x = pk2(y1[0], y1[1]); o.y = pk2(y1[2], y1[3]); *(u32x2*)(ar + lane * 4 + 256) = o;
        }
        {
            const int c0 = lane * 4; const f32x4 v = A.ckv; const float ss = (v[0] * v[0] + v[1] * v[1]) + (v[2] * v[2] + v[3] * v[3]);
            const float rs = rsqrtf(wave_sum(ss) * (1.f / 256.f) + 1e-6f); const f32x4 y = v * rs * gkv;
            u32x2 o; o.x = pk2(y[0], y[1]); o.y = pk2(y[2], y[3]); *(u32x2*)(ar + 512 + c0) = o;
            if (r < T_CTX) *(f32x4*)(p.out + O_CKV + (size_t)r * 256 + c0) = y;
        }
#pragma unroll
        for (int g = 0; g < 4; ++g) {
            const int half = 1 << g; const int lo = max(s - half, 0), hi = min(s + half, S); const int c0 = 768 + g * 256 + lane * 4;
            wsum[g] = wsum[g] + A.ad[g] - A.sb[g];
            const f32x4 y = wsum[g] / (float)(hi - lo) - A.u[g];
            u32x2 o; o.x = pk2(y[0], y[1]); o.y = pk2(y[2], y[3]); *(u32x2*)(ar + c0) = o; }
        A = B;
    }
}

DI void ph_ln1(const Params& p, int wid_, int l, unsigned char* lds_raw) {
    const int tid = (wid_ * 64 + fresh_lane()), lane = tid & 63, gw = blockIdx.x * NWAVES + wid_, NGW = gridDim.x * NWAVES;
    float* wT = (float*)lds_raw;
    const float* wr = p.in[23] + (size_t)l * 2048 * 16;
    for (int d = tid; d < 2048; d += NTHREADS) {
        const f32x4 w0 = *(const f32x4*)(wr + d * 16), w1 = *(const f32x4*)(wr + d * 16 + 4), w2 = *(const f32x4*)(wr + d * 16 + 8), w3 = *(const f32x4*)(wr + d * 16 + 12);
        const int dj = d >> 9, dl = (d & 511) >> 3, dq = (d >> 2) & 1, dc = d & 3, di = ((dj * 2 + dq) * 64 + dl) * 4 + dc;
#pragma unroll
        for (int e = 0; e < 4; ++e) { wT[e * 2048 + di] = w0[e]; wT[(4 + e) * 2048 + di] = w1[e]; wT[(8 + e) * 2048 + di] = w2[e]; wT[(12 + e) * 2048 + di] = w3[e]; } }
    __syncthreads();
    const float* Y = wsp<float>(p, WS_Y); float* STAT = wsp<float>(p, WS_STAT); bf16_t* H = wsp<bf16_t>(p, WS_H); float* AFF = wsp<float>(p, WS_AFF); float* AFFT = wsp<float>(p, WS_AFFT);
    unsigned char* H8 = wsp<unsigned char>(p, WS_H8);
    const float* lg = p.in[21] + l * D; const float* lb = p.in[22] + l * D;
    f32x4 v[8], vn[8], gg[8], gb[8];
    int r = gw;
#define LN1_LOAD(dst, rr) do { if ((rr) < T) { _Pragma("unroll") for (int j = 0; j < 4; ++j) { const float* y = Y + (size_t)(rr) * D + lane * 8 + 512 * j; dst[2 * j] = *(const f32x4*)y; dst[2 * j + 1] = *(const f32x4*)(y + 4); } } } while (0)
    LN1_LOAD(v, r);
    for (; r < T; r += NGW) {
        LN1_LOAD(vn, r + NGW);
        const int ci = cond_of_row(r); const float* gv = wsp<float>(p, WS_GB) + (size_t)(l * 9 + ci) * 2 * D; const float* bv = gv + D;
#pragma unroll
        for (int j = 0; j < 8; ++j) { const int cc = lane * 8 + 512 * (j >> 1) + 4 * (j & 1); gg[j] = *(const f32x4*)(gv + cc); gb[j] = *(const f32x4*)(bv + cc); }
        float s = 0.f;
#pragma unroll
        for (int j = 0; j < 8; ++j) s += (v[j][0] + v[j][1]) + (v[j][2] + v[j][3]);
        const float mean = wave_sum(s) * (1.f / D); float s2 = 0.f;
#pragma unroll
        for (int j = 0; j < 8; ++j) { v[j] = v[j] - mean; s2 += (v[j][0] * v[j][0] + v[j][1] * v[j][1]) + (v[j][2] * v[j][2] + v[j][3] * v[j][3]); }
        const float rstd = rsqrtf(wave_sum(s2) * (1.f / D) + 1e-5f);
#pragma unroll
        for (int j = 0; j < 4; ++j) { const int c0 = lane * 8 + 512 * j;
#pragma unroll
            for (int q = 0; q < 2; ++q) { const int cc = c0 + 4 * q; v[2 * j + q] = v[2 * j + q] * rstd * gg[2 * j + q] + gb[2 * j + q]; (void)cc; }
            const f32x4 a = v[2 * j], b = v[2 * j + 1];
            if (!MOE_F8) { u32x4 o; o.x = pk2(a[0], a[1]); o.y = pk2(a[2], a[3]); o.z = pk2(b[0], b[1]); o.w = pk2(b[2], b[3]); *(u32x4*)(H + (size_t)r * D + c0) = o; }
            u32x2 o8; o8.x = pk4_fp8(a[0], a[1], a[2], a[3]); o8.y = pk4_fp8(b[0], b[1], b[2], b[3]); *(u32x2*)(H8 + (size_t)r * D + c0) = o8; }
        float pa[16];
#ifdef PROBE_ROUTER2
#pragma unroll
        for (int e = 0; e < 16; ++e) { float a = 0.f; if ((e & 1) == 0) asm volatile("" ::: "memory");
#pragma unroll
            for (int j = 0; j < 4; ++j) { const float* wp = wT + e * 2048 + j * 512 + lane * 4; const f32x4 w0 = *(const f32x4*)wp, w1 = *(const f32x4*)(wp + 256); const f32x4 h0 = v[2 * j], h1 = v[2 * j + 1];
                a += ((h0[0] * w0[0] + h0[1] * w0[1]) + (h0[2] * w0[2] + h0[3] * w0[3])) + ((h1[0] * w1[0] + h1[1] * w1[1]) + (h1[2] * w1[2] + h1[3] * w1[3])); }
            asm volatile("" :: "v"(a)); }
#endif
#pragma unroll
        for (int e = 0; e < 16; ++e) { float a = 0.f; if ((e & 1) == 0) asm volatile("" ::: "memory");
#pragma unroll
            for (int j = 0; j < 4; ++j) { const float* wp = wT + e * 2048 + j * 512 + lane * 4; const f32x4 w0 = *(const f32x4*)wp, w1 = *(const f32x4*)(wp + 256); const f32x4 h0 = v[2 * j], h1 = v[2 * j + 1];
                a += ((h0[0] * w0[0] + h0[1] * w0[1]) + (h0[2] * w0[2] + h0[3] * w0[3])) + ((h1[0] * w1[0] + h1[1] * w1[1]) + (h1[2] * w1[2] + h1[3] * w1[3])); }
            pa[e] = a; }
        float pb[8], pc[4], pd[2];
        { const bool hi = (lane & 32) != 0;
#pragma unroll
          for (int e = 0; e < 8; ++e) { const float keep = hi ? pa[e + 8] : pa[e], send = hi ? pa[e] : pa[e + 8]; pb[e] = keep + __shfl_xor(send, 32); } }
        { const bool hi = (lane & 16) != 0;
#pragma unroll
          for (int e = 0; e < 4; ++e) { const float keep = hi ? pb[e + 4] : pb[e], send = hi ? pb[e] : pb[e + 4]; pc[e] = keep + __shfl_xor(send, 16); } }
        { const bool hi = (lane & 8) != 0;
#pragma unroll
          for (int e = 0; e < 2; ++e) { const float keep = hi ? pc[e + 2] : pc[e], send = hi ? pc[e] : pc[e + 2]; pd[e] = keep + __shfl_xor(send, 8); } }
        float mine; { const bool hi = (lane & 4) != 0; const float keep = hi ? pd[1] : pd[0], send = hi ? pd[0] : pd[1]; mine = keep + __shfl_xor(send, 4); }
        mine += __shfl_xor(mine, 2); mine += __shfl_xor(mine, 1);
        const int myexp = ((lane >> 5) & 1) * 8 + ((lane >> 4) & 1) * 4 + ((lane >> 3) & 1) * 2 + ((lane >> 2) & 1);
        const float m = wave_max(mine);
        const float ex = expf(mine - m);
        const float den = wave_sum(ex) * 0.25f;
        if ((lane & 3) == 0) { const float af = ex / den; AFF[(size_t)r * 16 + myexp] = af; AFFT[(size_t)myexp * T + r] = af; }
        if (lane == 0) *(f32x2*)(STAT + 2 * (size_t)r) = (f32x2){mean, rstd};
#pragma unroll
        for (int j = 0; j < 8; ++j) v[j] = vn[j];
    }
#undef LN1_LOAD
}

DI void ph_topk(const Params& p, int wid_, unsigned char* lds_raw) {
    const int tid = (wid_ * 64 + fresh_lane()), lane = tid & 63, wave = wid_;
    float* vals = (float*)lds_raw;
    int* cnt2 = (int*)(vals + 1024);
    int* selrow = cnt2 + 256;
    int* selslot = selrow + 256;
    int* nsel = selslot + 256;
    const float* AFFT = wsp<float>(p, WS_AFFT); int* INV = wsp<int>(p, WS_INV); const bf16_t* H = wsp<bf16_t>(p, WS_H); const unsigned char* H8 = wsp<unsigned char>(p, WS_H8); bf16_t* XS = wsp<bf16_t>(p, WS_XS);
    for (int it = blockIdx.x; it < 768; it += gridDim.x) {
        int n, cap, r0, e, sb, c0;
        if (it < 256) { const int b = it >> 4; e = it & 15; n = 256; cap = 32; r0 = b * 256; sb = b * 32; c0 = 0; }
        else { const int q = it - 256, li = q >> 2, b = li >> 4; e = li & 15; n = 1024; cap = 128; r0 = T_CTX + b * 1024; sb = 512 + b * 128; c0 = (q & 3) * 256; }
        for (int i = tid; i < n; i += NTHREADS) vals[i] = AFFT[(size_t)e * T + r0 + i];
        if (tid == 0) *nsel = 0;
        __syncthreads();
        const int ci = c0 + (tid & 255), half = tid >> 8, jn = n >> 1, j0 = half * jn;
        const float vi = vals[ci]; int cnt = 0;
#pragma unroll 4
        for (int j = j0; j < j0 + jn; j += 4) { const f32x4 w = *(const f32x4*)(vals + j);
            cnt += ((w[0] > vi || (w[0] == vi && j < ci)) ? 1 : 0) + ((w[1] > vi || (w[1] == vi && j + 1 < ci)) ? 1 : 0) + ((w[2] > vi || (w[2] == vi && j + 2 < ci)) ? 1 : 0) + ((w[3] > vi || (w[3] == vi && j + 3 < ci)) ? 1 : 0); }
        if (half) cnt2[tid & 255] = cnt;
        __syncthreads();
        if (!half) { cnt += cnt2[tid];
            if (cnt < cap) { const int pos = atomicAdd(nsel, 1); selrow[pos] = ci; selslot[pos] = cnt; INV[(size_t)(r0 + ci) * 16 + e] = sb + cnt; } else INV[(size_t)(r0 + ci) * 16 + e] = -1; }
        __syncthreads();
        const int ns = *nsel;
        for (int k0 = wave; k0 < ns; k0 += 4 * NWAVES) {
            if (MOE_F8) { u32x4 bufr[4][2];
#pragma unroll
                for (int b = 0; b < 4; ++b) { const int k = k0 + NWAVES * b; if (k < ns) { const u32x4* src = (const u32x4*)(H8 + (size_t)(r0 + selrow[k]) * D); bufr[b][0] = src[lane]; bufr[b][1] = src[lane + 64]; } }
#pragma unroll
                for (int b = 0; b < 4; ++b) { const int k = k0 + NWAVES * b; if (k < ns) { u32x4* dst = (u32x4*)((unsigned char*)XS + (size_t)(e * NSLOT + sb + selslot[k]) * D); dst[lane] = bufr[b][0]; dst[lane + 64] = bufr[b][1]; } } }
            else {
#pragma unroll
                for (int b = 0; b < 4; ++b) { const int k = k0 + NWAVES * b; if (k < ns) { const u32x4* src = (const u32x4*)(H + (size_t)(r0 + selrow[k]) * D); u32x4* dst = (u32x4*)(XS + (size_t)(e * NSLOT + sb + selslot[k]) * D);
#pragma unroll
                    for (int j = 0; j < 4; ++j) dst[lane + 64 * j] = src[lane + 64 * j]; } } } }
        __syncthreads();
    }
}

DI void ph_ln2(const Params& p, int wid_, int l, unsigned char* lds_raw) {
    const int tid = (wid_ * 64 + fresh_lane()), lane = tid & 63, wv = wid_;
    const int rpb = p.rpb, rb0 = blockIdx.x * rpb, rb1 = min(rb0 + rpb, T);
    if (rb0 >= T) return;
    LAS float* PV = (LAS float*)lds_raw;
    LAS float* PC = PV + 4 * 2048;
    const int c_lo = cond_of_row(rb0);
    for (int i = tid; i < 4 * 512; i += NTHREADS) { const int w = i >> 9, col = (i & 511) * 4; const float* src = w == 0 ? p.in[21] + l * D : w == 1 ? p.in[22] + l * D : w == 2 ? p.in[27] + l * D : p.in[28] + l * D;
        *(LAS f32x4*)(PV + w * 2048 + col) = *(const f32x4*)(src + col); }
    for (int i = tid; i < 2 * 3 * 512; i += NTHREADS) { const int cc = i / 1536, w = (i / 512) % 3, col = (i & 511) * 4; const int ci = min(c_lo + cc, 8);
        const float* src = w == 0 ? modp(p, l, ci, 5) : modp(p, 1, ci, w == 1 ? 0 : 1);
        *(LAS f32x4*)(PC + (cc * 3 + w) * 2048 + col) = *(const f32x4*)(src + col); }
    __syncthreads();
    const float* Y = wsp<float>(p, WS_Y); const float* STAT = wsp<float>(p, WS_STAT);
    const float* AFF = wsp<float>(p, WS_AFF); const int* INV = wsp<int>(p, WS_INV); const bf16_t* YE = wsp<bf16_t>(p, WS_YE);
    float* XL = wsp<float>(p, WS_XL); bf16_t* H = wsp<bf16_t>(p, WS_H);
    f32x4 x[8], xn[8]; int sl = -1, sln = -1; float af = 0.f, afn = 0.f; f32x2 st = {0.f, 1.f}, stn = {0.f, 1.f};
    int r = rb0 + wv;
#define LN2_LOAD(dx, ds, da, dt, rr) do { if ((rr) < rb1) { _Pragma("unroll") for (int j = 0; j < 4; ++j) { const float* y = Y + (size_t)(rr) * D + lane * 8 + 512 * j; dx[2 * j] = *(const f32x4*)y; dx[2 * j + 1] = *(const f32x4*)(y + 4); } \
        if (lane < 16) { ds = INV[(size_t)(rr) * 16 + lane]; da = AFF[(size_t)(rr) * 16 + lane]; } dt = *(const f32x2*)(STAT + 2 * (size_t)(rr)); } } while (0)
    LN2_LOAD(x, sl, af, st, r);
    for (; r < rb1; r += NWAVES) {
        asm volatile("" ::: "memory");
        LN2_LOAD(xn, sln, afn, stn, r + NWAVES);
        const LAS float* pc = PC + (cond_of_row(r) - c_lo) * 3 * 2048;
        f32x4 f[8];
#pragma unroll
        for (int j = 0; j < 8; ++j) f[j] = (f32x4){0.f, 0.f, 0.f, 0.f};
        {
            unsigned long long mk = __ballot(sl >= 0) & 0xffffull;
            while (mk) {
                const int e0 = __builtin_ctzll(mk); mk &= mk - 1; const bool two = mk != 0ull; const int e1 = two ? __builtin_ctzll(mk) : e0; if (two) mk &= mk - 1;
                const int s0 = __shfl(sl, e0), s1 = __shfl(sl, e1); const float w0 = __shfl(af, e0), w1 = two ? __shfl(af, e1) : 0.f;
                const bf16_t* y0 = YE + (size_t)(e0 * NSLOT + s0) * D + lane * 8; const bf16_t* y1 = YE + (size_t)(e1 * NSLOT + s1) * D + lane * 8;
                u32x4 q0[4], q1[4];
#pragma unroll
                for (int j = 0; j < 4; ++j) { q0[j] = *(const u32x4*)(y0 + 512 * j); q1[j] = *(const u32x4*)(y1 + 512 * j); }
#pragma unroll
                for (int j = 0; j < 4; ++j) {
                    f[2 * j][0] += w0 * bflo(q0[j].x) + w1 * bflo(q1[j].x); f[2 * j][1] += w0 * bfhi(q0[j].x) + w1 * bfhi(q1[j].x); f[2 * j][2] += w0 * bflo(q0[j].y) + w1 * bflo(q1[j].y); f[2 * j][3] += w0 * bfhi(q0[j].y) + w1 * bfhi(q1[j].y);
                    f[2 * j + 1][0] += w0 * bflo(q0[j].z) + w1 * bflo(q1[j].z); f[2 * j + 1][1] += w0 * bfhi(q0[j].z) + w1 * bfhi(q1[j].z); f[2 * j + 1][2] += w0 * bflo(q0[j].w) + w1 * bflo(q1[j].w); f[2 * j + 1][3] += w0 * bfhi(q0[j].w) + w1 * bfhi(q1[j].w); }
            }
        }
        float s = 0.f;
#pragma unroll
        for (int j = 0; j < 8; ++j) { const int c0 = lane * 8 + 512 * (j >> 1) + 4 * (j & 1); const f32x4 x1 = (x[j] - st[0]) * st[1] * *(const LAS f32x4*)(PV + c0) + *(const LAS f32x4*)(PV + 2048 + c0);
            f[j] = DN_ALPHA * x1 + *(const LAS f32x4*)(pc + c0) * f[j]; s += (f[j][0] + f[j][1]) + (f[j][2] + f[j][3]); }
        const float mean = wave_sum(s) * (1.f / D); float s2 = 0.f;
#pragma unroll
        for (int j = 0; j < 8; ++j) { f[j] = f[j] - mean; s2 += (f[j][0] * f[j][0] + f[j][1] * f[j][1]) + (f[j][2] * f[j][2] + f[j][3] * f[j][3]); }
        const float rstd = rsqrtf(wave_sum(s2) * (1.f / D) + 1e-5f);
#pragma unroll
        for (int j = 0; j < 4; ++j) { const int c0 = lane * 8 + 512 * j; f32x4 o[2];
#pragma unroll
            for (int q = 0; q < 2; ++q) { const int cc = c0 + 4 * q; o[q] = f[2 * j + q] * rstd * *(const LAS f32x4*)(PV + 2 * 2048 + cc) + *(const LAS f32x4*)(PV + 3 * 2048 + cc);
                if (l == 0) { *(f32x4*)(XL + (size_t)r * D + cc) = o[q]; o[q] = o[q] * (1.f + *(const LAS f32x4*)(pc + 2 * 2048 + cc)) + *(const LAS f32x4*)(pc + 2048 + cc); }
                else *(f32x4*)(p.out + O_Y + (size_t)r * D + cc) = o[q]; }
            if (l == 0) { u32x4 w; w.x = pk2(o[0][0], o[0][1]); w.y = pk2(o[0][2], o[0][3]); w.z = pk2(o[1][0], o[1][1]); w.w = pk2(o[1][2], o[1][3]); *(u32x4*)(H + (size_t)r * D + c0) = w; } }
#pragma unroll
        for (int j = 0; j < 8; ++j) x[j] = xn[j];
        sl = sln; af = afn; st = stn;
    }
#undef LN2_LOAD
}
template <int PAT> DI void ph_readonly(const Params& p, int wid_) {
    const int lane = (wid_ * 64 + fresh_lane()) & 63, gw = blockIdx.x * NWAVES + wid_, NGW = gridDim.x * NWAVES;
    float accum = 0.f;
    for (int it = gw; it < 98304; it += NGW) {
        const int mat = it >> 10, w = it & 1023, le = mat / 3, kind = mat % 3;
        const float* base = p.in[24 + kind] + (size_t)le * 2048 * 2048;
        if (PAT == 0) { const int nb = w & 31, kb = w >> 5; const float* s = base + (size_t)(kb * 64) * 2048 + nb * 64 + lane; float v[64];
#pragma unroll
            for (int k = 0; k < 64; ++k) v[k] = __builtin_nontemporal_load(s + (size_t)k * 2048);
#pragma unroll
            for (int k = 0; k < 64; ++k) accum += v[k]; }
        else if (PAT == 1) { const int nb8 = w & 7, kb16 = w >> 3; const float* s = base + (size_t)(kb16 * 16) * 2048 + nb8 * 256 + 4 * lane; f32x4 v[16];
#pragma unroll
            for (int k = 0; k < 16; ++k) v[k] = __builtin_nontemporal_load((const f32x4*)(s + (size_t)k * 2048));
#pragma unroll
            for (int k = 0; k < 16; ++k) accum += (v[k][0] + v[k][1]) + (v[k][2] + v[k][3]); }
        else { const float* s = base + (size_t)w * 4096 + 4 * lane; f32x4 v[16];
#pragma unroll
            for (int k = 0; k < 16; ++k) v[k] = __builtin_nontemporal_load((const f32x4*)(s + (size_t)k * 256));
#pragma unroll
            for (int k = 0; k < 16; ++k) accum += (v[k][0] + v[k][1]) + (v[k][2] + v[k][3]); }
    }
    if (lane == 0) wsp<float>(p, WS_DBG)[gw] = accum + wave_sum(accum);
}

struct Unit { const char* A; const char* B; unsigned lda, ldb; int nt; int pm, pn; int mode; int aux; };
DI int vcu_of(int bx, int G) { return (G % 8 == 0) ? (bx % 8) * (G / 8) + bx / 8 : bx; }

DI void rope8(const Params& p, int s, int pi0, float* v) {
    const f32x4 c = *(const f32x4*)(ws_cos(p) + s * 32 + pi0), sn = *(const f32x4*)(ws_sin(p) + s * 32 + pi0);
#pragma unroll
    for (int i = 0; i < 4; ++i) { const float x1 = v[2 * i], x2 = v[2 * i + 1]; v[2 * i] = x1 * c[i] - x2 * sn[i]; v[2 * i + 1] = x1 * sn[i] + x2 * c[i]; }
}
DI void st_bf16x8(bf16_t* dst, const float* v) { u32x4 w; w.x = pk2(v[0], v[1]); w.y = pk2(v[2], v[3]); w.z = pk2(v[4], v[5]); w.w = pk2(v[6], v[7]); *(u32x4*)dst = w; }
DI void st_f32x8(float* dst, const float* v) { *(f32x4*)dst = (f32x4){v[0], v[1], v[2], v[3]}; *(f32x4*)(dst + 4) = (f32x4){v[4], v[5], v[6], v[7]}; }

struct SchedInEven { const Params* p; int G, c;
    DI bool next(int i, Unit& u) const { const int L = i * G + c; if (L >= 48 * 8) return false; u.pm = L >> 3; u.pn = L & 7;
        u.A = (const char*)wsp<bf16_t>(*p, WS_H) + (size_t)u.pm * 256 * 4096; u.B = (const char*)wsp<bf16_t>(*p, WS_WINE) + (size_t)u.pn * 256 * 4096; u.lda = 4096; u.ldb = 4096; u.nt = 32; u.mode = 0; u.aux = 0; return true; } };
struct EpiInEven { static constexpr bool HAS_STATE = false; static constexpr bool PAIR = false, F8 = false; const Params* p;
    DI void store(const Unit& u, int row, int col, float* v) const {
        const int r = u.pm * 256 + row, gc = u.pn * 256 + col;
        if (gc < 1792) { st_f32x8(wsp<float>(*p, WS_PJ) + (size_t)r * 1792 + gc, v); return; }
        if (gc >= 1856) return;
        const int j0 = gc - 1792;
        if (r < T_CTX) st_f32x8(p->out + O_KPE + (size_t)r * 64 + j0, v); else rope8(*p, (r - T_CTX) & 1023, j0 >> 1, v);
        st_bf16x8(wsp<bf16_t>(*p, WS_KPE) + (size_t)r * 64 + j0, v);
    } };

constexpr int E2_Q = 48 * 6, E2_K = 64 * 4, E2_V = 4 * 64, E2_P = 48 * 4, E2_TOTAL = E2_Q + E2_K + E2_V + E2_P;
struct SchedE2 { const Params* p; int G, c;
    DI bool next(int i, Unit& u) const { int L;
        if (G == 256) { if (c < 32) { if (i > 2) return false; L = i == 0 ? c : (i == 1 ? 256 + c : E2_Q + c); } else { if (i > 3) return false; L = i == 0 ? c : E2_Q + 32 + (c - 32) * 3 + (i - 1); } }
        else { L = i * G + c; if (L >= E2_TOTAL) return false; }
        const char* ACT2 = (const char*)wsp<bf16_t>(*p, WS_ACT2); const char* W2 = (const char*)wsp<bf16_t>(*p, WS_W2); u.aux = 0;
        if (L < E2_Q) { u.mode = 0; u.pm = L / 6; u.pn = L % 6; u.A = ACT2 + (size_t)u.pm * 256 * 3584; u.lda = 3584; u.B = W2 + (size_t)u.pn * 256 * 3584; u.ldb = 3584; u.nt = 8; return true; }
        L -= E2_Q;
        if (L < E2_K) { u.mode = 1; u.pm = L >> 2; u.pn = L & 3; u.A = ACT2 + (size_t)u.pm * 256 * 3584 + 512 * 2; u.lda = 3584; u.B = W2 + (size_t)(1536 + u.pn * 256) * 3584; u.ldb = 3584; u.nt = 4; return true; }
        L -= E2_K;
        if (L < E2_V) { u.mode = 2; u.pm = L >> 6; u.pn = L & 63; u.A = W2 + (size_t)(2560 + u.pm * 256) * 3584; u.lda = 3584; u.B = ACT2 + (size_t)u.pn * 256 * 3584 + 512 * 2; u.ldb = 3584; u.nt = 4; return true; }
        L -= E2_V;
        u.mode = 3; u.pm = L >> 2; u.aux = L & 3; u.pn = 0; u.A = ACT2 + (size_t)u.pm * 256 * 3584 + (768 + u.aux * 256) * 2; u.lda = 3584; u.B = W2 + (size_t)(3584 + u.aux * 256) * 3584; u.ldb = 3584; u.nt = 4; return true; } };
struct EpiE2 { static constexpr bool HAS_STATE = false; static constexpr bool PAIR = false, F8 = false; const Params* p;
    DI void store(const Unit& u, int row, int col, float* v) const {
        const int r = u.pm * 256 + row, gc = u.pn * 256 + col;
        if (u.mode == 0) { const int dd = gc % 192; if (dd >= 128 && r >= T_CTX) rope8(*p, (r - T_CTX) & 1023, (dd - 128) >> 1, v);
#pragma unroll
            for (int i = 0; i < 8; ++i) v[i] *= QS_MLA;
            st_bf16x8(wsp<bf16_t>(*p, WS_Q) + (size_t)r * 1536 + gc, v); }
        else if (u.mode == 1) st_bf16x8(wsp<bf16_t>(*p, WS_KN) + (size_t)r * 1024 + gc, v);
        else if (u.mode == 2) st_bf16x8(wsp<bf16_t>(*p, WS_VT) + (size_t)r * TX + gc, v);
        else { const float* ps = p->in[16] + u.aux * 256 + col;
#pragma unroll
            for (int i = 0; i < 8; ++i) v[i] *= ps[i];
            if (OUT_F8) { u32x2 o; o.x = pk4_fp8(v[0], v[1], v[2], v[3]); o.y = pk4_fp8(v[4], v[5], v[6], v[7]); *(u32x2*)((unsigned char*)wsp<bf16_t>(*p, WS_MIX) + (size_t)r * 2048 + 1024 + u.aux * 256 + col) = o; }
            else st_bf16x8(wsp<bf16_t>(*p, WS_MIX) + (size_t)r * 2048 + 1024 + u.aux * 256 + col, v); }
    } };

struct SchedOut { const Params* p; int G, c, l;
    DI bool next(int i, Unit& u) const { const int L = i * G + c; if (L >= 48 * 8) return false; u.pm = L >> 3; u.pn = L & 7;
        constexpr unsigned P = OUT_F8 ? 2048 : 4096;
        u.A = (const char*)wsp<bf16_t>(*p, WS_MIX) + (size_t)u.pm * 256 * P; u.B = (const char*)wsp<bf16_t>(*p, l == 0 ? WS_WOUTE : WS_WOUTO) + (size_t)u.pn * 256 * P; u.lda = P; u.ldb = P; u.nt = OUT_F8 ? 16 : 32; u.mode = 0; u.aux = 0; return true; } };
struct EpiOut { static constexpr bool HAS_STATE = false; static constexpr bool PAIR = false, F8 = OUT_F8 != 0; const Params* p; int l;
    DI void store(const Unit& u, int row, int col, float* v) const {
        const int r = u.pm * 256 + row, gc = u.pn * 256 + col;
        const float* x = (l == 0 ? xrow_in(*p, r) : wsp<float>(*p, WS_XL) + (size_t)r * D) + gc; const float* g1 = modp(*p, l, cond_of_row(r), 2) + gc;
        const f32x4 x0 = *(const f32x4*)x, x1 = *(const f32x4*)(x + 4), g0 = *(const f32x4*)g1, g4 = *(const f32x4*)(g1 + 4);
#pragma unroll
        for (int i = 0; i < 4; ++i) { const float w0 = OUT_F8 ? g0[i] * (1.f / OUT_WSCALE) : g0[i], w4 = OUT_F8 ? g4[i] * (1.f / OUT_WSCALE) : g4[i]; v[i] = DN_ALPHA * x0[i] + w0 * v[i]; v[4 + i] = DN_ALPHA * x1[i] + w4 * v[4 + i]; }
        st_f32x8(wsp<float>(*p, WS_Y) + (size_t)r * D + gc, v);
    } };

struct SchedGU { const Params* p; int G, c, l;
    DI bool next(int i, Unit& u) const { const int L = i * G + c; if (L >= 16 * 96) return false; const int e = L / 96, rem = L % 96; u.pn = rem / 6; u.pm = e * 6 + rem % 6; u.aux = e;
        constexpr unsigned P = MOE_F8 ? 2048 : 4096;
        u.A = (const char*)wsp<bf16_t>(*p, WS_XS) + (size_t)u.pm * 256 * P; u.B = (const char*)wsp<bf16_t>(*p, WS_WGU) + ((size_t)(l * 16 + e) * 4096 + (size_t)u.pn * 256) * P; u.lda = P; u.ldb = P; u.nt = MOE_F8 ? 16 : 32; u.mode = 0; return true; } };
struct EpiGU { static constexpr bool HAS_STATE = false; static constexpr bool PAIR = true, F8 = MOE_F8 != 0; const Params* p;
    DI void store2(const Unit& u, int row, int col, const float* g, const float* up) const {
        float h[8];
#pragma unroll
        for (int i = 0; i < 8; ++i) { const float gg = MOE_F8 ? g[i] * (1.f / GU_WSCALE) : g[i], uu = MOE_F8 ? up[i] * (1.f / GU_WSCALE) : up[i]; h[i] = gg / (1.f + __expf(-gg)) * uu; }
        if (MOE_F8) { u32x2 o; o.x = pk4_fp8(h[0], h[1], h[2], h[3]); o.y = pk4_fp8(h[4], h[5], h[6], h[7]); *(u32x2*)((unsigned char*)wsp<bf16_t>(*p, WS_HID) + (size_t)(u.pm * 256 + row) * D + u.pn * 128 + col) = o; }
        else st_bf16x8(wsp<bf16_t>(*p, WS_HID) + (size_t)(u.pm * 256 + row) * D + u.pn * 128 + col, h);
    } };

struct SchedDown { const Params* p; int G, c, l;
    DI bool next(int i, Unit& u) const { const int L = i * G + c; if (L >= 16 * 48) return false; const int e = L / 48, rem = L % 48; u.pn = rem / 6; u.pm = e * 6 + rem % 6; u.aux = e;
        constexpr unsigned P = MOE_F8 ? 2048 : 4096;
        u.A = (const char*)wsp<bf16_t>(*p, WS_HID) + (size_t)u.pm * 256 * P; u.B = (const char*)wsp<bf16_t>(*p, WS_WDN) + ((size_t)(l * 16 + e) * 2048 + (size_t)u.pn * 256) * P; u.lda = P; u.ldb = P; u.nt = MOE_F8 ? 16 : 32; u.mode = 0; return true; } };
struct EpiDown { static constexpr bool HAS_STATE = false; static constexpr bool PAIR = false, F8 = MOE_F8 != 0; const Params* p;
    DI void store(const Unit& u, int row, int col, float* v) const {
        if (MOE_F8) {
#pragma unroll
            for (int i = 0; i < 8; ++i) v[i] *= (1.f / DN_WSCALE); }
        st_bf16x8(wsp<bf16_t>(*p, WS_YE) + (size_t)(u.pm * 256 + row) * D + u.pn * 256 + col, v); } };

constexpr int IO_QK = 48 * 9, IO_V = 16, IO_VT = 48, IO_TOTAL = IO_QK + IO_V + IO_VT;
struct SchedInOdd { const Params* p; int G, c;
    DI bool next(int i, Unit& u) const { int L = i * G + c; if (L >= IO_TOTAL) return false;
        const char* Hb = (const char*)wsp<bf16_t>(*p, WS_H); const char* W = (const char*)wsp<bf16_t>(*p, WS_WINO); u.aux = 0; u.nt = 32; u.lda = 4096; u.ldb = 4096;
        if (L < IO_QK) { u.mode = 0; u.pm = L / 9; u.pn = L % 9; u.A = Hb + (size_t)u.pm * 256 * 4096; u.B = W + (size_t)u.pn * 256 * 4096; return true; }
        L -= IO_QK;
        if (L < IO_V) { u.mode = 1; u.pm = L; u.pn = 9; u.A = Hb + (size_t)u.pm * 256 * 4096; u.B = W + (size_t)9 * 256 * 4096; return true; }
        L -= IO_V;
        u.mode = 2; u.pm = 0; u.pn = L; u.A = W + (size_t)9 * 256 * 4096; u.B = Hb + (size_t)u.pn * 256 * 4096; return true; } };
struct EpiInOdd { static constexpr bool HAS_STATE = true; static constexpr bool PAIR = false, F8 = false; const Params* p;
    struct State { f32x4 c[4], s[4]; bool rot; };
    DI void begin(State& st, const Unit& u, int row0, int col0) const {
        st.rot = u.mode == 0 && u.pm * 256 >= T_CTX;
        if (st.rot) { const int pi0 = (col0 & 63) >> 1;
#pragma unroll
            for (int ri = 0; ri < 4; ++ri) { const int r = u.pm * 256 + ri * 16 + row0, sp = (r - T_CTX) & 1023;
                st.c[ri] = *(const f32x4*)(ws_cos(*p) + sp * 32 + pi0); st.s[ri] = *(const f32x4*)(ws_sin(*p) + sp * 32 + pi0); } }
    }
    DI void store_st(const State& st, int ri, const Unit& u, int row, int col, float* v) const {
        const int r = u.pm * 256 + row, gc = u.pn * 256 + col;
        if (u.mode == 0) {
            if (gc < 2048) {
                if (st.rot) {
#pragma unroll
                    for (int i = 0; i < 4; ++i) { const float x1 = v[2 * i], x2 = v[2 * i + 1]; v[2 * i] = x1 * st.c[ri][i] - x2 * st.s[ri][i]; v[2 * i + 1] = x1 * st.s[ri][i] + x2 * st.c[ri][i]; } }
#pragma unroll
                for (int i = 0; i < 8; ++i) v[i] *= QS_SWA;
                st_bf16x8(wsp<bf16_t>(*p, WS_Q) + (size_t)r * 2048 + gc, v); }
            else { const int kc = gc - 2048; if (r < T_CTX) st_f32x8(p->out + O_SK + (size_t)r * 256 + kc, v);
                if (st.rot) {
#pragma unroll
                    for (int i = 0; i < 4; ++i) { const float x1 = v[2 * i], x2 = v[2 * i + 1]; v[2 * i] = x1 * st.c[ri][i] - x2 * st.s[ri][i]; v[2 * i + 1] = x1 * st.s[ri][i] + x2 * st.c[ri][i]; } }
                st_bf16x8(wsp<bf16_t>(*p, WS_KO) + (size_t)r * 256 + kc, v); } }
        else if (u.mode == 1) st_f32x8(p->out + O_SV + (size_t)r * 256 + col, v);
        else st_bf16x8(wsp<bf16_t>(*p, WS_VTO) + (size_t)row * TX + gc, v);
    }
    DI void store(const Unit& u, int row, int col, float* v) const {
        const int r = u.pm * 256 + row, gc = u.pn * 256 + col;
        if (u.mode == 0) {
            if (gc < 2048) { if (r >= T_CTX) rope8(*p, (r - T_CTX) & 1023, (gc & 63) >> 1, v);
#pragma unroll
                for (int i = 0; i < 8; ++i) v[i] *= QS_SWA;
                st_bf16x8(wsp<bf16_t>(*p, WS_Q) + (size_t)r * 2048 + gc, v); }
            else { const int kc = gc - 2048; if (r < T_CTX) st_f32x8(p->out + O_SK + (size_t)r * 256 + kc, v); else rope8(*p, (r - T_CTX) & 1023, (kc & 63) >> 1, v);
                st_bf16x8(wsp<bf16_t>(*p, WS_KO) + (size_t)r * 256 + kc, v); } }
        else if (u.mode == 1) st_f32x8(p->out + O_SV + (size_t)r * 256 + col, v);
        else st_bf16x8(wsp<bf16_t>(*p, WS_VTO) + (size_t)row * TX + gc, v);
    } };

namespace pg8 {
typedef short bf16x8 __attribute__((ext_vector_type(8)));
typedef int i32x4 __attribute__((ext_vector_type(4)));
typedef int i32x8 __attribute__((ext_vector_type(8)));
DI i32x8 cat8(bf16x8 lo, bf16x8 hi) { return __builtin_shufflevector(__builtin_bit_cast(i32x4, lo), __builtin_bit_cast(i32x4, hi), 0, 1, 2, 3, 4, 5, 6, 7); }
constexpr int BM = 256, BK = 64, HALF = 128, HTB = HALF * BK * 2  , STAGE_BYTES = 8 * HTB;
DI int lds_byte(int r, int c) { const int st = (r >> 4) * 2 + (c >> 5), rr = r & 15, cc = c & 31, ob = rr * 64 + cc * 2; return st * 1024 + (ob ^ (((ob >> 9) & 1) << 5)); }
DI void stage_rc(int b, int& R, int& C) { const int st = b / 1024, sb = b % 1024, swz = sb ^ (((sb >> 9) & 1) << 5); R = (st >> 1) * 16 + swz / 64; C = (st & 1) * 32 + (swz % 64) / 2; }
DI int perm32(int rho) { const int n = rho >> 4, i = rho & 15; return 8 * (i >> 2) + 4 * n + (i & 3); }

template <bool F8> struct Frag;
template <> struct Frag<false> { bf16x8 k0, k1; DI void set(bf16x8 a, bf16x8 b) { k0 = a; k1 = b; } };
template <> struct Frag<true> { i32x8 w; DI void set(bf16x8 a, bf16x8 b) { w = cat8(a, b); } };
template <class Epi, class Sched, bool ALIGN_EPI = true>
DI void gemm_phase(LAS unsigned char* lds, const Sched& S, const Epi& E, int wid) {
    const int lane = fresh_lane(), tid = wid * 64 + lane, wr = wid >> 2, wc = wid & 3, fr = lane & 15, fq = lane >> 4;
    int RA[2], RB[2], CB[2];
#pragma unroll
    for (int i = 0; i < 2; ++i) { int R, C; stage_rc(tid * 16 + i * 8192, R, C); RA[i] = R; RB[i] = (R & ~31) + perm32(R & 31); CB[i] = C * 2; }
    constexpr size_t kstep = (size_t)(BK * 2);
    const unsigned ldsw = (unsigned)wid * 1024u;
    const int aoff = lds_byte(wr * 64 + fr, fq * 8), boff = lds_byte(wc * 32 + fr, fq * 8);
#define PG8_SA(b, h) (((b) * 2 + (h)) * HTB)
#define PG8_SB(b, h) ((4 + (b) * 2 + (h)) * HTB)
#define PG8_STAGE(bufoff, gbase, v0, v1) do { unsigned o0_ = (v0), o1_ = (v1); asm volatile("" : "+v"(o0_), "+v"(o1_)); \
        __builtin_amdgcn_global_load_lds((const unsigned*)((const char*)(gbase) + o0_), (LAS unsigned*)(lds + (bufoff) + ldsw), 16, 0, 0); \
        __builtin_amdgcn_global_load_lds((const unsigned*)((const char*)(gbase) + o1_), (LAS unsigned*)(lds + (bufoff) + ldsw + 8192), 16, 0, 0); } while (0)
#define PG8_LDA(dst, b, h) do { _Pragma("unroll") for (int m = 0; m < 4; ++m) { const bf16x8 f0_ = *(const LAS bf16x8*)(lds + PG8_SA(b, h) + aoff + m * 2048), f1_ = *(const LAS bf16x8*)(lds + PG8_SA(b, h) + aoff + m * 2048 + 1024); dst[m].set(f0_, f1_); } } while (0)
#define PG8_LDB(dst, b, h) do { _Pragma("unroll") for (int n = 0; n < 2; ++n) { const bf16x8 f0_ = *(const LAS bf16x8*)(lds + PG8_SB(b, h) + boff + n * 2048), f1_ = *(const LAS bf16x8*)(lds + PG8_SB(b, h) + boff + n * 2048 + 1024); dst[n].set(f0_, f1_); } } while (0)
#define PG8_MMA(ai, bj, At, Bt) do { __builtin_amdgcn_s_setprio(1); _Pragma("unroll") for (int m = 0; m < 4; ++m) _Pragma("unroll") for (int n = 0; n < 2; ++n) { \
        if constexpr (Epi::F8) acc[ai][bj][m][n] = __builtin_amdgcn_mfma_scale_f32_16x16x128_f8f6f4(Bt[n].w, At[m].w, acc[ai][bj][m][n], 0, 0, 0, 0x7f7f7f7f, 0, 0x7f7f7f7f); \
        else { acc[ai][bj][m][n] = __builtin_amdgcn_mfma_f32_16x16x32_bf16(Bt[n].k0, At[m].k0, acc[ai][bj][m][n], 0, 0, 0); acc[ai][bj][m][n] = __builtin_amdgcn_mfma_f32_16x16x32_bf16(Bt[n].k1, At[m].k1, acc[ai][bj][m][n], 0, 0, 0); } } \
        __builtin_amdgcn_s_setprio(0); } while (0)
#define PG8_WAIT_V(n) asm volatile("s_waitcnt vmcnt(" #n ")" ::: "memory")
#define PG8_WAIT_L(n) asm volatile("s_waitcnt lgkmcnt(" #n ")" ::: "memory")
#define PG8_BAR __builtin_amdgcn_s_barrier()
#define PG8_SCHED __builtin_amdgcn_sched_barrier(0)
    Unit cur, nxt; int ui = 0;
    if (!S.next(0, cur)) return;
    f32x4 acc[2][2][4][2];
#pragma unroll
    for (int a = 0; a < 2; ++a)
#pragma unroll
        for (int b = 0; b < 2; ++b)
#pragma unroll
            for (int m = 0; m < 4; ++m)
#pragma unroll
                for (int n = 0; n < 2; ++n) acc[a][b][m][n] = (f32x4){0.f, 0.f, 0.f, 0.f};
    Frag<Epi::F8> At[4], B0[2], B1[2];
    const char* cA = cur.A; const char* cB = cur.B;
    const unsigned ld = cur.lda;
    const unsigned vA0 = RA[0] * ld + CB[0], vA1 = RA[1] * ld + CB[1], vB0 = RB[0] * ld + CB[0], vB1 = RB[1] * ld + CB[1];
    const size_t hA = (size_t)HALF * ld, hB = hA;
    PG8_STAGE(PG8_SB(0, 0), cB, vB0, vB1); PG8_STAGE(PG8_SB(0, 1), cB + hB, vB0, vB1); PG8_STAGE(PG8_SA(0, 0), cA, vA0, vA1); PG8_STAGE(PG8_SA(0, 1), cA + hA, vA0, vA1);
    if (wr == 1) PG8_BAR;
    PG8_WAIT_V(2); PG8_BAR;
    PG8_STAGE(PG8_SB(1, 0), cB + kstep, vB0, vB1); PG8_STAGE(PG8_SA(1, 0), cA + kstep, vA0, vA1); PG8_STAGE(PG8_SB(1, 1), cB + hB + kstep, vB0, vB1);
    PG8_WAIT_V(6); PG8_BAR;
    for (;;) {
        const bool has_next = S.next(ui + 1, nxt);
        const char* nA = has_next ? nxt.A : cA; const char* nB = has_next ? nxt.B : cB;
        const int nt = cur.nt;
        for (int t = 0; t < nt; t += 2) {
            const bool last = (t == nt - 2);
            const char* a1 = cA + (size_t)(t + 1) * kstep;
            const char* a2 = last ? nA : cA + (size_t)(t + 2) * kstep; const char* b2 = last ? nB : cB + (size_t)(t + 2) * kstep;
            const char* a3 = a2 + kstep; const char* b3 = b2 + kstep;
            PG8_LDB(B0, 0, 0); PG8_LDB(B1, 0, 1); PG8_SCHED; PG8_LDA(At, 0, 0); PG8_STAGE(PG8_SA(1, 1), a1 + hA, vA0, vA1);
            PG8_WAIT_V(8); PG8_WAIT_L(0); PG8_BAR; PG8_MMA(0, 0, At, B0); PG8_MMA(0, 1, At, B1); PG8_BAR; PG8_SCHED;
            PG8_LDA(At, 0, 1); PG8_STAGE(PG8_SB(0, 0), b2, vB0, vB1); PG8_STAGE(PG8_SB(0, 1), b2 + hB, vB0, vB1); PG8_STAGE(PG8_SA(0, 0), a2, vA0, vA1);
            PG8_WAIT_V(8); PG8_WAIT_L(0); PG8_BAR; PG8_MMA(1, 0, At, B0); PG8_MMA(1, 1, At, B1); PG8_BAR; PG8_SCHED;
            PG8_LDB(B0, 1, 0); PG8_LDB(B1, 1, 1); PG8_SCHED; PG8_LDA(At, 1, 0); PG8_STAGE(PG8_SA(0, 1), a2 + hA, vA0, vA1);
            PG8_WAIT_V(8); PG8_WAIT_L(0); PG8_BAR; PG8_MMA(0, 0, At, B0); PG8_MMA(0, 1, At, B1); PG8_BAR; PG8_SCHED;
            PG8_LDA(At, 1, 1); PG8_STAGE(PG8_SB(1, 0), b3, vB0, vB1); PG8_STAGE(PG8_SB(1, 1), b3 + hB, vB0, vB1); PG8_STAGE(PG8_SA(1, 0), a3, vA0, vA1);
            PG8_WAIT_V(8); PG8_WAIT_L(0); PG8_BAR; PG8_MMA(1, 0, At, B0); PG8_MMA(1, 1, At, B1); PG8_BAR; PG8_SCHED;
        }
        if constexpr (ALIGN_EPI) { if (wr == 0) PG8_BAR; }
        {
            const int el_ = fresh_lane(); const int fr_ = el_ & 15, fq_ = el_ >> 4;
            if constexpr (Epi::HAS_STATE) {
#pragma unroll
                for (int ai = 0; ai < 2; ++ai) { typename Epi::State st; E.begin(st, cur, ai * HALF + wr * 64 + fr_, wc * 32 + 8 * fq_);
#pragma unroll
                    for (int m = 0; m < 4; ++m) { const int row = ai * HALF + wr * 64 + m * 16 + fr_;
#pragma unroll
                        for (int bj = 0; bj < 2; ++bj) { float v[8];
#pragma unroll
                            for (int j = 0; j < 4; ++j) { v[j] = acc[ai][bj][m][0][j]; v[4 + j] = acc[ai][bj][m][1][j]; }
                            E.store_st(st, m, cur, row, bj * HALF + wc * 32 + 8 * fq_, v); } } }
            } else {
#pragma unroll
            for (int ai = 0; ai < 2; ++ai)
#pragma unroll
                for (int m = 0; m < 4; ++m) { const int row = ai * HALF + wr * 64 + m * 16 + fr_;
                    if constexpr (Epi::PAIR) { float g[8], up[8];
#pragma unroll
                        for (int j = 0; j < 4; ++j) { g[j] = acc[ai][0][m][0][j]; g[4 + j] = acc[ai][0][m][1][j]; up[j] = acc[ai][1][m][0][j]; up[4 + j] = acc[ai][1][m][1][j]; }
                        E.store2(cur, row, wc * 32 + 8 * fq_, g, up); }
                    else {
#pragma unroll
                        for (int bj = 0; bj < 2; ++bj) { float v[8];
#pragma unroll
                            for (int j = 0; j < 4; ++j) { v[j] = acc[ai][bj][m][0][j]; v[4 + j] = acc[ai][bj][m][1][j]; }
                            E.store(cur, row, bj * HALF + wc * 32 + 8 * fq_, v); } } }
            }
        }
        if (!has_next) break;
#pragma unroll
        for (int a = 0; a < 2; ++a)
#pragma unroll
            for (int b = 0; b < 2; ++b)
#pragma unroll
                for (int m = 0; m < 4; ++m)
#pragma unroll
                    for (int n = 0; n < 2; ++n) acc[a][b][m][n] = (f32x4){0.f, 0.f, 0.f, 0.f};
        cur = nxt; cA = nA; cB = nB; ++ui;
        if constexpr (ALIGN_EPI) { if (wr == 1) PG8_BAR; }
    }
    PG8_WAIT_V(0);
    if constexpr (!ALIGN_EPI) { if (wr == 0) PG8_BAR; }
    PG8_BAR;
#undef PG8_SA
#undef PG8_SB
#undef PG8_STAGE
#undef PG8_LDA
#undef PG8_LDB
#undef PG8_MMA
#undef PG8_WAIT_V
#undef PG8_WAIT_L
#undef PG8_BAR
#undef PG8_SCHED
}
}

namespace att {
typedef short bf16x8 __attribute__((ext_vector_type(8)));
typedef short s16x4 __attribute__((ext_vector_type(4)));
typedef float f32x16 __attribute__((ext_vector_type(16)));
typedef float f32x2_t __attribute__((ext_vector_type(2)));
typedef __bf16 bf16x2_t __attribute__((ext_vector_type(2)));
DI unsigned cvtpk(float lo, float hi) { f32x2_t v = {lo, hi}; bf16x2_t b = __builtin_convertvector(v, bf16x2_t); return __builtin_bit_cast(unsigned, b); }
DI int crow(int r, int h) { return (r & 3) + 8 * (r >> 2) + 4 * h; }

template <bool SWA>
DI void attn_phase(const Params& p, int wid_, LAS unsigned char* lds, int G, int c) {
    constexpr int DK = SWA ? 64 : 192, DV = SWA ? 64 : 128, KSTR = DK * 2 + 16, VSTR = 136;
    constexpr int QB = SWA ? 2 : 1;
    constexpr int KB = 64 * KSTR, VB = DV * VSTR, STG = KB + VB;
    constexpr int CPR = DK / 8, NKC = (64 * CPR) / NTHREADS, NVC = (DV * 8) / NTHREADS, NQ = DK / 16, NDV = DV / 32;
    constexpr int LDQ = SWA ? 2048 : 1536, NUNITS = SWA ? 768 : 384;
    static_assert(2 * STG <= 131072, "attention LDS");
    const int tid = (wid_ * 64 + fresh_lane()), lane = tid & 63, wid = wid_, q = lane & 31, hh = lane >> 5;
    const bf16_t* Q = wsp<bf16_t>(p, WS_Q); const bf16_t* KN = wsp<bf16_t>(p, SWA ? WS_KO : WS_KN); const bf16_t* KPE = wsp<bf16_t>(p, WS_KPE);
    const bf16_t* VT = wsp<bf16_t>(p, SWA ? WS_VTO : WS_VT); bf16_t* MIX = wsp<bf16_t>(p, WS_MIX);
    for (int L = c; L < NUNITS; L += G) {
        int rowbase, hk, nt0, nt1, key0a, key0b = 0, kpos0 = 0, qpos0 = 0; bool masked = false;
        if (!SWA) {
            if (L < 256) { const int b = L >> 5, qt = L & 3; hk = (L >> 2) & 7; rowbase = T_CTX + b * 1024 + qt * 256; key0a = T_CTX + b * 1024; nt0 = 16; key0b = T + b * 512; nt1 = 8; }
            else { const int Lc = L - 256, b = Lc >> 3; hk = Lc & 7; rowbase = b * 256; key0a = b * 256; nt0 = 4; nt1 = 0; }
        } else {
            if (L < 512) { const int b = L >> 6, t0 = (L & 15) * 64; hk = (L >> 4) & 3; rowbase = T_CTX + b * 1024 + t0;
                const int lo = max(t0 - 128, 0) & ~63, hi = min((t0 + 192 + 63) & ~63, 1024);
                key0a = T_CTX + b * 1024 + lo; nt0 = (hi - lo) >> 6; kpos0 = lo; qpos0 = t0; masked = true; key0b = T + b * 512; nt1 = 8; }
            else { const int Lc = L - 512, b = Lc >> 4; hk = (Lc >> 2) & 3; rowbase = b * 256 + (Lc & 3) * 64; key0a = b * 256; nt0 = 4; nt1 = 0; }
        }
        const int total = nt0 + nt1;
        const int qrow0 = SWA ? rowbase + q : rowbase + wid * 32 + q;
        const int qhead = SWA ? hk * 8 + wid : hk;
        bf16x8 qf[QB][NQ];
#pragma unroll
        for (int qb = 0; qb < QB; ++qb)
#pragma unroll
            for (int s = 0; s < NQ; ++s) qf[qb][s] = *(const bf16x8*)(Q + (size_t)(qrow0 + 32 * qb) * LDQ + qhead * DK + 16 * s + 8 * hh);
        f32x16 o[QB][NDV];
#pragma unroll
        for (int qb = 0; qb < QB; ++qb)
#pragma unroll
            for (int d = 0; d < NDV; ++d)
#pragma unroll
                for (int r = 0; r < 16; ++r) o[qb][d][r] = 0.f;
        float m[QB], l[QB];
#pragma unroll
        for (int qb = 0; qb < QB; ++qb) { m[qb] = SWA ? p.in[19][qhead] * LOG2E : -1e30f; l[qb] = (SWA && hh == 0) ? 1.f : 0.f; }
        const int qpos = qpos0 + q;
        u32x4 kreg[NKC], vreg[NVC];
#define ATT_LOAD(t_) do { const int tt_ = (t_); const int kb_ = tt_ < nt0 ? key0a + tt_ * 64 : key0b + (tt_ - nt0) * 64; \
            _Pragma("unroll") for (int i = 0; i < NKC; ++i) { const int ch = tid + NTHREADS * i, j = ch / CPR, cc = ch % CPR; \
                const bf16_t* src = SWA ? KN + (size_t)(kb_ + j) * 256 + hk * 64 + cc * 8 : (cc < 16 ? KN + (size_t)(kb_ + j) * 1024 + hk * 128 + cc * 8 : KPE + (size_t)(kb_ + j) * 64 + (cc - 16) * 8); \
                kreg[i] = *(const u32x4*)src; } \
            _Pragma("unroll") for (int i = 0; i < NVC; ++i) { const int ch = tid + NTHREADS * i, dv = ch >> 3, cc = ch & 7; \
                vreg[i] = *(const u32x4*)(VT + (size_t)(hk * DV + dv) * TX + kb_ + cc * 8); } } while (0)
#define ATT_WRITE(buf_) do { LAS unsigned char* Kw = lds + (buf_) * STG; LAS unsigned char* Vw = Kw + KB; \
            _Pragma("unroll") for (int i = 0; i < NKC; ++i) { const int ch = tid + NTHREADS * i, j = ch / CPR, cc = ch % CPR; *(LAS u32x4*)(Kw + j * KSTR + cc * 16) = kreg[i]; } \
            _Pragma("unroll") for (int i = 0; i < NVC; ++i) { const int ch = tid + NTHREADS * i, dv = ch >> 3, cc = ch & 7; \
                *(LAS u32x2*)(Vw + dv * VSTR + cc * 16) = (u32x2){vreg[i].x, vreg[i].y}; *(LAS u32x2*)(Vw + dv * VSTR + cc * 16 + 8) = (u32x2){vreg[i].z, vreg[i].w}; } } while (0)
        ATT_LOAD(0); ATT_WRITE(0);
        __syncthreads();
        for (int t = 0; t < total; ++t) {
            const int buf = t & 1;
            if (t + 1 < total) ATT_LOAD(t + 1);
            const LAS unsigned char* Kl = lds + buf * STG; const LAS unsigned char* Vl = Kl + KB;
#pragma unroll
            for (int qb = 0; qb < QB; ++qb) {
                f32x16 s0, s1;
#pragma unroll
                for (int r = 0; r < 16; ++r) { s0[r] = 0.f; s1[r] = 0.f; }
#pragma unroll
                for (int s = 0; s < NQ; ++s) {
                    const bf16x8 a0 = *(const LAS bf16x8*)(Kl + q * KSTR + (16 * s + 8 * hh) * 2);
                    const bf16x8 a1 = *(const LAS bf16x8*)(Kl + (32 + q) * KSTR + (16 * s + 8 * hh) * 2);
                    s0 = __builtin_amdgcn_mfma_f32_32x32x16_bf16(a0, qf[qb][s], s0, 0, 0, 0);
                    s1 = __builtin_amdgcn_mfma_f32_32x32x16_bf16(a1, qf[qb][s], s1, 0, 0, 0);
                }
                if (SWA && masked && t < nt0) {
                    const int kp = kpos0 + t * 64 - (qpos + 32 * qb);
#pragma unroll
                    for (int r = 0; r < 16; ++r) { const int d0 = kp + crow(r, hh), d1 = d0 + 32;
                        s0[r] = (d0 >= -128 && d0 <= 128) ? s0[r] : -1e30f; s1[r] = (d1 >= -128 && d1 <= 128) ? s1[r] : -1e30f; }
                }
                float tm = fmaxf(s0[0], s1[0]);
#pragma unroll
                for (int r = 1; r < 16; ++r) tm = fmaxf(tm, fmaxf(s0[r], s1[r]));
                tm = fmaxf(tm, __shfl_xor(tm, 32));
                const float mn = fmaxf(m[qb], tm);
                if (!__all(mn == m[qb])) {
                    const float alpha = __builtin_amdgcn_exp2f(m[qb] - mn); m[qb] = mn; l[qb] *= alpha;
#pragma unroll
                    for (int d = 0; d < NDV; ++d)
#pragma unroll
                        for (int r = 0; r < 16; ++r) o[qb][d][r] *= alpha; }
                float ls = 0.f;
#pragma unroll
                for (int r = 0; r < 16; ++r) { s0[r] = __builtin_amdgcn_exp2f(s0[r] - m[qb]); s1[r] = __builtin_amdgcn_exp2f(s1[r] - m[qb]); ls += s0[r] + s1[r]; }
                l[qb] += ls;
                bf16x8 pb[2][2];
#pragma unroll
                for (int s = 0; s < 2; ++s) {
                    u32x4 w0, w1;
                    w0.x = cvtpk(s0[8 * s + 0], s0[8 * s + 1]); w0.y = cvtpk(s0[8 * s + 2], s0[8 * s + 3]); w0.z = cvtpk(s0[8 * s + 4], s0[8 * s + 5]); w0.w = cvtpk(s0[8 * s + 6], s0[8 * s + 7]);
                    w1.x = cvtpk(s1[8 * s + 0], s1[8 * s + 1]); w1.y = cvtpk(s1[8 * s + 2], s1[8 * s + 3]); w1.z = cvtpk(s1[8 * s + 4], s1[8 * s + 5]); w1.w = cvtpk(s1[8 * s + 6], s1[8 * s + 7]);
                    pb[0][s] = __builtin_bit_cast(bf16x8, w0); pb[1][s] = __builtin_bit_cast(bf16x8, w1);
                }
#pragma unroll
                for (int d = 0; d < NDV; ++d)
#pragma unroll
                    for (int blk = 0; blk < 2; ++blk)
#pragma unroll
                        for (int s = 0; s < 2; ++s) {
                            const LAS unsigned char* vp = Vl + (d * 32 + q) * VSTR + (blk * 32 + 16 * s + 4 * hh) * 2;
                            const s16x4 lo = *(const LAS s16x4*)vp, hi = *(const LAS s16x4*)(vp + 16);
                            const bf16x8 a = {lo[0], lo[1], lo[2], lo[3], hi[0], hi[1], hi[2], hi[3]};
                            o[qb][d] = __builtin_amdgcn_mfma_f32_32x32x16_bf16(a, pb[blk][s], o[qb][d], 0, 0, 0);
                        }
                if (QB > 1) __builtin_amdgcn_sched_barrier(0);
            }
            if (t + 1 < total) ATT_WRITE(buf ^ 1);
            __syncthreads();
        }
#undef ATT_LOAD
#undef ATT_WRITE
#pragma unroll
        for (int qb = 0; qb < QB; ++qb) {
            const float inv = 1.f / (l[qb] + __shfl_xor(l[qb], 32));
            bf16_t* orow = MIX + (size_t)(qrow0 + 32 * qb) * 2048 + qhead * DV;
            unsigned char* orow8 = (unsigned char*)MIX + (size_t)(qrow0 + 32 * qb) * 2048 + qhead * DV;
#pragma unroll
            for (int d = 0; d < NDV; ++d)
#pragma unroll
                for (int g = 0; g < 4; ++g) {
                    if (OUT_F8) *(unsigned*)(orow8 + d * 32 + 8 * g + 4 * hh) = pk4_fp8(o[qb][d][4 * g] * inv, o[qb][d][4 * g + 1] * inv, o[qb][d][4 * g + 2] * inv, o[qb][d][4 * g + 3] * inv);
                    else { u32x2 w; w.x = cvtpk(o[qb][d][4 * g] * inv, o[qb][d][4 * g + 1] * inv); w.y = cvtpk(o[qb][d][4 * g + 2] * inv, o[qb][d][4 * g + 3] * inv); *(u32x2*)(orow + d * 32 + 8 * g + 4 * hh) = w; } }
        }
    }
}
}


#ifndef R_PRO
#define R_PRO 1
#endif
#ifndef R_MOE
#define R_MOE 1
#endif
#ifndef R_ATT
#define R_ATT 1
#endif
#ifndef R_ATTM
#define R_ATTM R_ATT
#endif
#ifndef R_ATTS
#define R_ATTS R_ATT
#endif
#ifndef R_GEMM
#define R_GEMM 1
#endif
#ifndef R_THIN
#define R_THIN 1
#endif
#ifndef R_LN1
#define R_LN1 1
#endif
#ifndef R_LN2
#define R_LN2 1
#endif
#ifndef R_TOPK
#define R_TOPK 1
#endif
#define REP(n) for (int _r = 0; _r < (n); ++_r)
#define REPS(n, ...) do { { __VA_ARGS__ } if ((n) > 1) { __VA_ARGS__ } } while (0)
constexpr int LDS_BYTES = 147456, MISC_OFF = 146432;
constexpr int NPH = 20;
#ifndef CVT_WAVES
#define CVT_WAVES 2
#endif
#ifndef CVT_IDLE_WAVES
#define CVT_IDLE_WAVES 8
#endif
#ifndef CV_IDLE2
#define CV_IDLE2 10240
#endif
#ifndef CV_IDLE6
#define CV_IDLE6 10240
#endif
constexpr int CV_I2 = CV_IDLE2, CV_I6 = CV_IDLE6, CV_IALL = CV_I2 + 2 * CV_I6;
__global__ void __launch_bounds__(NTHREADS, 2) mega(Params p) {
    extern __shared__ __attribute__((aligned(16))) unsigned char lds[];
    const int G = gridDim.x, c = vcu_of(blockIdx.x, G), wid = __builtin_amdgcn_readfirstlane(threadIdx.x >> 6);
    volatile LAS unsigned* MISC = (volatile LAS unsigned*)((LAS unsigned char*)lds + MISC_OFF);
    if (threadIdx.x < 4) MISC[threadIdx.x] = 0u;
    __syncthreads();
    XcdBarrier bar = xcd_barrier_post((unsigned*)(p.ws + WS_CTL) + CW_BAR, MISC);
    const int lo = p.ph_lo, hi = p.ph_hi;
#define IN(k) (lo <= (k) && (k) < hi)
#ifdef STAMP_A
#define stamps_ (wsp<unsigned long long>(p, WS_DBG + 65536))
#define STAMP(k) do { if (blockIdx.x == 0 && wid == 0 && fresh_lane() == 0) stamps_[k] = __builtin_amdgcn_s_memrealtime(); } while (0)
#else
#define STAMP(k) do { } while (0)
#endif
    STAMP(0); STAMP(23);
#ifndef R_BAR
#define R_BAR 1
#endif
#define SEAM(k) do { if (IN(k) && IN((k) + 1)) { xcd_barrier(bar); if (R_BAR > 1) xcd_barrier(bar); } STAMP((k) + 1); } while (0)
    if (IN(0)) REP(R_PRO) { ph_mod(p, wid, lds); STAMP(21); ph_misc(p, wid); STAMP(22); ph_convert(p, wid, 0, G == 256 ? CV_TOTAL - CV_IALL : CV_TOTAL, blockIdx.x, G, CVT_WAVES);
#ifdef RD_PAT
        ph_readonly<RD_PAT>(p, wid);
#endif
    } SEAM(0);
    if (IN(1)) REP(R_THIN) { ph_modreduce(p, wid); ph_h0(p, wid, lds); } SEAM(1);
    if (IN(2)) { REPS(R_GEMM, SchedInEven S{&p, G, c}; EpiInEven E{&p}; pg8::gemm_phase((LAS unsigned char*)lds, S, E, wid);); if (G == 256 && c >= 128) ph_convert(p, wid, CV_TOTAL - CV_IALL, CV_TOTAL - 2 * CV_I6, c - 128, 128, CVT_IDLE_WAVES); } SEAM(2);
    if (IN(3)) REP(R_THIN) { ph_e1(p, wid); } SEAM(3);
    if (IN(4)) REPS(R_GEMM, SchedE2 S{&p, G, c}; EpiE2 E{&p}; pg8::gemm_phase((LAS unsigned char*)lds, S, E, wid);); SEAM(4);
    if (IN(5)) REP(R_ATTM) { att::attn_phase<false>(p, wid, (LAS unsigned char*)lds, G, c); } SEAM(5);
    if (IN(6)) { REPS(R_GEMM, SchedOut S{&p, G, c, 0}; EpiOut E{&p, 0}; pg8::gemm_phase((LAS unsigned char*)lds, S, E, wid);); if (G == 256 && c >= 128) ph_convert(p, wid, CV_TOTAL - 2 * CV_I6, CV_TOTAL - CV_I6, c - 128, 128, CVT_IDLE_WAVES); } SEAM(6);
    if (IN(7)) REP(R_LN1) { ph_ln1(p, wid, 0, lds); } SEAM(7);
    if (IN(8)) REP(R_TOPK) { ph_topk(p, wid, lds); } SEAM(8);
    if (IN(9)) REPS(R_MOE, SchedGU S{&p, G, c, 0}; EpiGU E{&p}; pg8::gemm_phase((LAS unsigned char*)lds, S, E, wid);); SEAM(9);
    if (IN(10)) REPS(R_MOE, SchedDown S{&p, G, c, 0}; EpiDown E{&p}; pg8::gemm_phase((LAS unsigned char*)lds, S, E, wid);); SEAM(10);
    if (IN(11)) REP(R_LN2) { ph_ln2(p, wid, 0, lds); } SEAM(11);
    if (IN(12)) REPS(R_GEMM, SchedInOdd S{&p, G, c}; EpiInOdd E{&p}; pg8::gemm_phase((LAS unsigned char*)lds, S, E, wid);); SEAM(12);
    if (IN(13)) REP(R_ATTS) { att::attn_phase<true>(p, wid, (LAS unsigned char*)lds, G, c); } SEAM(13);
    if (IN(14)) { REPS(R_GEMM, SchedOut S{&p, G, c, 1}; EpiOut E{&p, 1}; pg8::gemm_phase((LAS unsigned char*)lds, S, E, wid);); if (G == 256 && c >= 128) ph_convert(p, wid, CV_TOTAL - CV_I6, CV_TOTAL, c - 128, 128, CVT_IDLE_WAVES); } SEAM(14);
    if (IN(15)) REP(R_LN1) { ph_ln1(p, wid, 1, lds); } SEAM(15);
    if (IN(16)) REP(R_TOPK) { ph_topk(p, wid, lds); } SEAM(16);
    if (IN(17)) REPS(R_MOE, SchedGU S{&p, G, c, 1}; EpiGU E{&p}; pg8::gemm_phase((LAS unsigned char*)lds, S, E, wid);); SEAM(17);
    if (IN(18)) REPS(R_MOE, SchedDown S{&p, G, c, 1}; EpiDown E{&p}; pg8::gemm_phase((LAS unsigned char*)lds, S, E, wid);); SEAM(18);
    if (IN(19)) REP(R_LN2) { ph_ln2(p, wid, 1, lds); }
#ifdef STAMP_A
    STAMP(20);
    if (blockIdx.x == 0 && wid == 0 && fresh_lane() == 0) {
        asm volatile("s_waitcnt vmcnt(0)" ::: "memory");
        const unsigned long long d = (__hip_atomic_load(&stamps_[STAMP_B], __ATOMIC_RELAXED, __HIP_MEMORY_SCOPE_AGENT) - __hip_atomic_load(&stamps_[STAMP_A], __ATOMIC_RELAXED, __HIP_MEMORY_SCOPE_AGENT)) * 4ull;
        const unsigned long long t0 = __builtin_amdgcn_s_memrealtime();
        while (__builtin_amdgcn_s_memrealtime() - t0 < d) __builtin_amdgcn_s_sleep(8);
    }
#endif
#undef IN
#undef SEAM
}

extern "C" void kernel_launch(void* const* d_in, const int* in_sizes, int n_in, void* d_out, int out_size, void* d_ws, size_t ws_size, hipStream_t stream) {
    static int grid = 0;
    if (grid == 0) {
        if (n_in != 29 || out_size != (int)O_END || ws_size < WS_END) { fprintf(stderr, "kernel_launch: unexpected shapes (n_in %d out %d ws %zu need %zu)\n", n_in, out_size, ws_size, (size_t)WS_END); grid = -1; return; }
        int dev = 0, cus = 0, per_cu = 0;
        if (hipGetDevice(&dev) != hipSuccess || hipDeviceGetAttribute(&cus, hipDeviceAttributeMultiprocessorCount, dev) != hipSuccess) { grid = -1; return; }
        if (hipFuncSetAttribute((const void*)mega, hipFuncAttributeMaxDynamicSharedMemorySize, LDS_BYTES) != hipSuccess) { fprintf(stderr, "hipFuncSetAttribute failed\n"); grid = -1; return; }
        if (hipOccupancyMaxActiveBlocksPerMultiprocessor(&per_cu, (const void*)mega, NTHREADS, LDS_BYTES) != hipSuccess || per_cu < 1) fprintf(stderr, "occupancy query: %d\n", per_cu);
        (void)hipGetLastError();
        grid = cus > 0 ? cus : 256;
    }
    if (grid < 0) return;
    Params p{};
    for (int i = 0; i < 29; ++i) p.in[i] = (const float*)d_in[i];
    p.out = (float*)d_out; p.ws = (unsigned char*)d_ws; p.ph_lo = 0; p.ph_hi = NPH; p.rpb = (T + grid - 1) / grid; p.pad = 0;
    (void)hipMemsetAsync((char*)d_ws + WS_CTL, 0, CTL_BYTES, stream);
    hipLaunchKernelGGL(mega, dim3(grid), dim3(NTHREADS), LDS_BYTES, stream, p);
}
```

```cpp
#include <hip/hip_runtime.h>
#include <cstdio>
#include <cstdint>

constexpr int D = 2048, T_CTX = 4096, T = 12288, TC = 4096, TX = 16384;
constexpr int MODW = 12288, NCOND = 9;
constexpr int NSLOT = 1536, NXS = 16 * NSLOT;
constexpr float DN_ALPHA = 1.41421356237309515f;
constexpr float LOG2E = 1.44269504088896341f;
constexpr float QS_MLA = 0.07216878364870322f * LOG2E;
constexpr float QS_SWA = 0.125f * LOG2E;
constexpr int NTHREADS = 512, NWAVES = 8;
#ifndef MOE_F8
#define MOE_F8 1
#endif
#ifndef OUT_F8
#define OUT_F8 1
#endif
constexpr float GU_WSCALE = 32.f, DN_WSCALE = 64.f, OUT_WSCALE = 64.f;

constexpr size_t O_Y = 0, O_CKV = 25165824, O_KPE = 26214400, O_SK = 26476544, O_SV = 27525120, O_END = 28573696;

constexpr size_t al256(size_t x) { return (x + 255) & ~(size_t)255; }
constexpr size_t WS_CTL = 0, CTL_BYTES = 1u << 20;
constexpr size_t WS_MOD = WS_CTL + CTL_BYTES;
constexpr size_t WS_ROPE = WS_MOD + al256((size_t)2 * 9 * 12288 * 4);
constexpr size_t WS_WINE = WS_ROPE + al256((size_t)2 * 1024 * 32 * 4);
constexpr size_t WS_W2 = WS_WINE + (size_t)2048 * 2048 * 2;
constexpr size_t WS_WOUTE = WS_W2 + (size_t)4608 * 1792 * 2;
constexpr size_t WS_WINO = WS_WOUTE + (size_t)2048 * 2048 * 2;
constexpr size_t WS_WOUTO = WS_WINO + (size_t)2560 * 2048 * 2;
constexpr size_t WS_WGU = WS_WOUTO + (size_t)2048 * 2048 * 2;
constexpr size_t WS_WDN = WS_WGU + (size_t)32 * 4096 * 2048 * 2;
constexpr size_t WS_H = WS_WDN + (size_t)32 * 2048 * 2048 * 2;
constexpr size_t WS_PJ = WS_H + (size_t)T * 2048 * 2;
constexpr size_t WS_ACT2 = WS_PJ + (size_t)T * 1792 * 4;
constexpr size_t WS_KPE = WS_ACT2 + (size_t)TX * 1792 * 2;
constexpr size_t WS_Q = WS_KPE + (size_t)TX * 64 * 2;
constexpr size_t WS_KN = WS_Q + (size_t)T * 2048 * 2;
constexpr size_t WS_VT = WS_KN + (size_t)TX * 1024 * 2;
constexpr size_t WS_VTO = WS_VT + (size_t)1024 * TX * 2;
constexpr size_t WS_KO = WS_VTO + (size_t)256 * TX * 2;
constexpr size_t WS_MIX = WS_KO + (size_t)TX * 256 * 2;
constexpr size_t WS_Y = WS_MIX + (size_t)T * 2048 * 2;
constexpr size_t WS_X1 = WS_Y + (size_t)T * 2048 * 4;
constexpr size_t WS_XL = WS_X1 + (size_t)T * 2048 * 4;
constexpr size_t WS_AFF = WS_XL + (size_t)T * 2048 * 4;
constexpr size_t WS_INV = WS_AFF + (size_t)T * 16 * 4;
constexpr size_t WS_XS = WS_INV + (size_t)T * 16 * 4;
constexpr size_t WS_HID = WS_XS + (size_t)NXS * 2048 * 2;
constexpr size_t WS_YE = WS_HID + (size_t)NXS * 2048 * 2;
constexpr size_t WS_AFFT = WS_YE + (size_t)NXS * 2048 * 2;
constexpr size_t WS_H8 = WS_AFFT + (size_t)T * 16 * 4;
constexpr size_t WS_STAT = WS_H8 + (size_t)T * 2048;
constexpr size_t WS_MODP = WS_STAT + (size_t)T * 8;
constexpr size_t WS_GB = WS_MODP + (size_t)4 * 2 * 9 * 12288 * 4;
constexpr size_t WS_DBG = WS_GB + (size_t)2 * 9 * 2 * 2048 * 4;
constexpr size_t WS_END = WS_DBG + (1u << 20);

typedef unsigned short bf16_t;
typedef float f32x4 __attribute__((ext_vector_type(4)));
typedef unsigned u32x4 __attribute__((ext_vector_type(4)));
typedef unsigned u32x2 __attribute__((ext_vector_type(2)));
typedef float f32x2 __attribute__((ext_vector_type(2)));
#define LAS __attribute__((address_space(3)))
#define DI __device__ __forceinline__

struct Params {
    const float* in[29];
    float* out;
    unsigned char* ws;
    int ph_lo, ph_hi;
    int rpb, pad;
};

DI unsigned f2bf(float f) { unsigned u = __float_as_uint(f); return (u + 0x7fffu + ((u >> 16) & 1u)) >> 16; }
typedef __bf16 bf16x2_hw __attribute__((ext_vector_type(2)));
DI unsigned pk2(float lo, float hi) { f32x2 v = {lo, hi}; bf16x2_hw b = __builtin_convertvector(v, bf16x2_hw); return __builtin_bit_cast(unsigned, b); }
DI unsigned pk4_fp8(float a, float b, float c, float d) { unsigned w = 0; w = __builtin_amdgcn_cvt_pk_fp8_f32(a, b, w, false); w = __builtin_amdgcn_cvt_pk_fp8_f32(c, d, w, true); return w; }
DI float bf2f(unsigned b) { return __uint_as_float(b << 16); }
DI float bflo(unsigned w) { return __uint_as_float(w << 16); }
DI float bfhi(unsigned w) { return __uint_as_float(w & 0xffff0000u); }
DI float wave_sum(float v) {
#pragma unroll
    for (int o = 1; o < 64; o <<= 1) v += __shfl_xor(v, o);
    return v;
}
DI float wave_max(float v) {
#pragma unroll
    for (int o = 1; o < 64; o <<= 1) v = fmaxf(v, __shfl_xor(v, o));
    return v;
}
DI int fresh_lane() { int l = (int)__builtin_amdgcn_mbcnt_hi(~0u, __builtin_amdgcn_mbcnt_lo(~0u, 0u)); asm volatile("" : "+v"(l)); return l; }
DI int cond_of_row(int r) { return r < T_CTX ? 0 : 1 + ((r - T_CTX) >> 10); }
DI const float* xrow_in(const Params& p, int r) { return r < T_CTX ? p.in[0] + (size_t)r * D : p.in[1] + (size_t)(r - T_CTX) * D; }

DI float* ws_mod(const Params& p) { return (float*)(p.ws + WS_MOD); }
DI float* ws_cos(const Params& p) { return (float*)(p.ws + WS_ROPE); }
DI float* ws_sin(const Params& p) { return (float*)(p.ws + WS_ROPE) + 1024 * 32; }
template <class X> DI X* wsp(const Params& p, size_t off) { return (X*)(p.ws + off); }
DI const float* modp(const Params& p, int l, int ci, int j) { return ws_mod(p) + ((size_t)(l * 9 + ci) * MODW + (size_t)j * D); }

#define XB_TMO      128
#define XB_XCNT(j)  (256  + 64 * (j))
#define XB_XSUB(j)  (1280 + 64 * (j))
#define XB_XGEN(j)  (2304 + 64 * (j))
#define XB_TOP      3328
#define XB_TOPGEN   3392
#define XCD_BAR_WORDS 3456
#define XB_SPIN_CAP (1u << 18)

__device__ __forceinline__ unsigned xb_ld(unsigned* p)              { return __hip_atomic_load(p, __ATOMIC_RELAXED, __HIP_MEMORY_SCOPE_AGENT); }
__device__ __forceinline__ unsigned xb_add(unsigned* p, unsigned v) { return __hip_atomic_fetch_add(p, v, __ATOMIC_RELAXED, __HIP_MEMORY_SCOPE_AGENT); }
__device__ __forceinline__ unsigned xb_xcc_id() { return (unsigned)__builtin_amdgcn_s_getreg((3 << 11) | 20) & 0xFu; }
#define XB_SPIN(cond, bar) do { unsigned _sp = 0; while (cond) { __builtin_amdgcn_s_sleep(1); \
    if ((++_sp & 255u) == 0u) { if (xb_ld(&(bar)[XB_TMO])) break; if (_sp > XB_SPIN_CAP) { atomicAdd(&(bar)[XB_TMO], 1u); break; } } } } while (0)

struct XcdBarrier {
    unsigned* bar; unsigned x;
    volatile LAS unsigned* st;
};

__device__ __forceinline__ XcdBarrier xcd_barrier_post(unsigned* bar, volatile LAS unsigned* st) {
    XcdBarrier b; b.bar = bar; b.x = xb_xcc_id(); b.st = st;
    if (threadIdx.x == 0) (void)xb_add(&bar[XB_XCNT(b.x)], 1u);
    return b;
}
__device__ __forceinline__ void xcd_barrier_complete(unsigned* bar, unsigned x, unsigned& nloc, unsigned& nx) {
    const unsigned G = gridDim.x * gridDim.y * gridDim.z;
    unsigned sum, cnt, mine, sp = 0u;
    for (;;) {
        sum = 0u; cnt = 0u; mine = 0u;
#pragma unroll
        for (unsigned j = 0; j < 16; ++j) { const unsigned c = xb_ld(&bar[XB_XCNT(j)]); sum += c; cnt += (c > 0u) ? 1u : 0u; mine = (j == x) ? c : mine; }
        if (sum == G) break;
        __builtin_amdgcn_s_sleep(1);
        if ((++sp & 255u) == 0u) { if (xb_ld(&bar[XB_TMO])) break; if (sp > XB_SPIN_CAP) { atomicAdd(&bar[XB_TMO], 1u); break; } }
    }
    nloc = mine > 0u ? mine : 1u; nx = cnt > 0u ? cnt : 1u;
}

__device__ __forceinline__ void xcd_barrier(const XcdBarrier& b) {
    asm volatile("s_waitcnt vmcnt(0)" ::: "memory");
    __syncthreads();
    if (threadIdx.x == 0) {
        unsigned* bar = b.bar;
        __builtin_amdgcn_s_waitcnt(0);
        unsigned nloc = b.st[0], nx = b.st[1];
        if (nloc == 0u) { xcd_barrier_complete(bar, b.x, nloc, nx); b.st[0] = nloc; b.st[1] = nx; }
        const unsigned old = xb_add(&bar[XB_XSUB(b.x)], 1u);
        const unsigned gen = old / nloc;
        if (old + 1u == (gen + 1u) * nloc) {
            __builtin_amdgcn_fence(__ATOMIC_RELEASE, "agent");
            asm volatile("s_waitcnt vmcnt(0)" ::: "memory");
            const unsigned og = xb_add(&bar[XB_TOP], 1u);
            const unsigned tg = og / nx;
            if (og + 1u == (tg + 1u) * nx) xb_add(&bar[XB_TOPGEN], 1u);
            else XB_SPIN(xb_ld(&bar[XB_TOPGEN]) == tg, bar);
            __builtin_amdgcn_fence(__ATOMIC_ACQUIRE, "agent");
            xb_add(&bar[XB_XGEN(b.x)], 1u);
            asm volatile("s_waitcnt vmcnt(0)" ::: "memory");
        } else {
            XB_SPIN(xb_ld(&bar[XB_XGEN(b.x)]) == gen, bar);
            __builtin_amdgcn_fence(__ATOMIC_ACQUIRE, "agent");
            asm volatile("s_waitcnt vmcnt(0)" ::: "memory");
        }
    }
    __syncthreads();
}
constexpr int CW_BAR = 4096;


DI void ph_mod(const Params& p, int wid_, unsigned char* lds_raw) {
    float* s_q = (float*)lds_raw;
    float* red = s_q + 9 * 512;
    const int tid = (wid_ * 64 + fresh_lane()), lane = tid & 63, wave = wid_;
    const float* c = p.in[6]; const float* c_ctx = p.in[7]; const float* w_ada = p.in[8];
    float* MODP = wsp<float>(p, WS_MODP);
    for (int it = blockIdx.x; it < 384; it += gridDim.x) {
        const int l = it / 192, rem = it % 192, cg = rem >> 2, kq4 = rem & 3;
        for (int i = tid; i < 9 * 512; i += NTHREADS) { const int ci = i >> 9, k = kq4 * 512 + (i & 511); const float v = ci == 0 ? c_ctx[k] : c[(ci - 1) * 2048 + k]; s_q[i] = v / (1.f + expf(-v)); }
        __syncthreads();
        const float* w = w_ada + ((size_t)l * 2048 + kq4 * 512 + wave * 64) * MODW + cg * 256 + 4 * lane;
        float acc[9][4];
#pragma unroll
        for (int ci = 0; ci < 9; ++ci)
#pragma unroll
            for (int j = 0; j < 4; ++j) acc[ci][j] = 0.f;
#pragma unroll 8
        for (int kk = 0; kk < 64; ++kk) {
            const f32x4 wv = __builtin_nontemporal_load((const f32x4*)(w + (size_t)kk * MODW));
#pragma unroll
            for (int ci = 0; ci < 9; ++ci) { const float s = s_q[ci * 512 + wave * 64 + kk];
#pragma unroll
                for (int j = 0; j < 4; ++j) acc[ci][j] += s * wv[j]; }
        }
#pragma unroll
        for (int ci = 0; ci < 9; ++ci) *(f32x4*)(red + (wave * 9 + ci) * 256 + 4 * lane) = (f32x4){acc[ci][0], acc[ci][1], acc[ci][2], acc[ci][3]};
        __syncthreads();
        for (int o = tid; o < 9 * 256; o += NTHREADS) { const int ci = o >> 8, cc = o & 255; float s = 0.f;
#pragma unroll
            for (int w8 = 0; w8 < 8; ++w8) s += red[(w8 * 9 + ci) * 256 + cc];
            MODP[((size_t)(kq4 * 2 + l) * 9 + ci) * MODW + cg * 256 + cc] = s; }
        __syncthreads();
    }
}
DI void ph_modreduce(const Params& p, int wid_) {
    const float* MODP = wsp<float>(p, WS_MODP); float* MOD = ws_mod(p); const float* b_ada = p.in[9];
    const int n4 = 2 * 9 * MODW / 4;
    for (int i = blockIdx.x * NTHREADS + (wid_ * 64 + fresh_lane()); i < n4; i += gridDim.x * NTHREADS) { const int e = i * 4, l = e / (9 * MODW), col = e % MODW;
        f32x4 s = *(const f32x4*)(b_ada + l * MODW + col);
#pragma unroll
        for (int q = 0; q < 4; ++q) s += *(const f32x4*)(MODP + (size_t)q * 2 * 9 * MODW + e);
        *(f32x4*)(MOD + e) = s; }
}
DI f32x4 mod_from_partials(const Params& p, int l, int ci, int j, int col) {
    const float* MODP = wsp<float>(p, WS_MODP); const size_t e = (size_t)(l * 9 + ci) * MODW + (size_t)j * D + col;
    f32x4 s = *(const f32x4*)(p.in[9] + l * MODW + j * D + col);
#pragma unroll
    for (int q = 0; q < 4; ++q) s += *(const f32x4*)(MODP + (size_t)q * 2 * 9 * MODW + e);
    return s;
}

constexpr int CV_INE = 928, CV_UQ = 192, CV_UKV = 128, CV_POOL = 64, CV_OUT = 1024, CV_INO = 1280, CV_MOE = 98304;
constexpr int CV_TOTAL = CV_INE + CV_UQ + CV_UKV + CV_POOL + CV_OUT + CV_INO + CV_OUT + CV_MOE;
DI void cvt_f8_item(const float* src, int N, unsigned char* dst, int nrows, int w, int lane, float scale, int gu_kind) {
    const int nb8 = w & 7, kb16 = w >> 3, n4 = nb8 * 256 + 4 * lane;
    const float* s = src + (size_t)(kb16 * 16) * N + n4;
    f32x4 v[16];
#pragma unroll
    for (int k = 0; k < 16; ++k) v[k] = __builtin_nontemporal_load((const f32x4*)(s + (size_t)k * N));
    const int dr = gu_kind < 0 ? n4 : (n4 >> 7) * 256 + (n4 & 127) + gu_kind * 128;
    u32x4* d = (u32x4*)(dst + ((size_t)kb16 * nrows + dr) * 16);
#pragma unroll
    for (int j = 0; j < 4; ++j) { u32x4 o;
        o.x = pk4_fp8(v[0][j] * scale, v[1][j] * scale, v[2][j] * scale, v[3][j] * scale); o.y = pk4_fp8(v[4][j] * scale, v[5][j] * scale, v[6][j] * scale, v[7][j] * scale);
        o.z = pk4_fp8(v[8][j] * scale, v[9][j] * scale, v[10][j] * scale, v[11][j] * scale); o.w = pk4_fp8(v[12][j] * scale, v[13][j] * scale, v[14][j] * scale, v[15][j] * scale);
        d[j] = o; }
}
DI void cvt_item(const Params& p, int item, int lane) {
    const float* src; bf16_t* dst; int K, N, ldd, nb, kb, map = 0, a = 0;
    if (item < CV_INE) { src = p.in[10]; dst = wsp<bf16_t>(p, WS_WINE); K = 2048; N = 1856; ldd = 2048; nb = item % 29; kb = item / 29; map = 1; }
    else if ((item -= CV_INE) < CV_UQ) { src = p.in[13]; dst = wsp<bf16_t>(p, WS_W2); K = 512; N = 1536; ldd = 1792; nb = item % 24; kb = item / 24; }
    else if ((item -= CV_UQ) < CV_UKV) { src = p.in[14]; dst = wsp<bf16_t>(p, WS_W2); K = 256; N = 2048; ldd = 1792; nb = item % 32; kb = item / 32; map = 2; }
    else if ((item -= CV_UKV) < CV_POOL) { const int g = item >> 4, r = item & 15; src = p.in[15] + (size_t)g * 65536; dst = wsp<bf16_t>(p, WS_W2); K = 256; N = 256; ldd = 1792; nb = r & 3; kb = r >> 2; a = 3584 + g * 256; }
    else if ((item -= CV_POOL) < CV_OUT) { if (OUT_F8) { cvt_f8_item(p.in[17], 2048, wsp<unsigned char>(p, WS_WOUTE), 2048, item, lane, OUT_WSCALE, -1); return; } src = p.in[17]; dst = wsp<bf16_t>(p, WS_WOUTE); K = 2048; N = 2048; ldd = 2048; nb = item & 31; kb = item >> 5; }
    else if ((item -= CV_OUT) < CV_INO) { src = p.in[18]; dst = wsp<bf16_t>(p, WS_WINO); K = 2048; N = 2560; ldd = 2048; nb = item % 40; kb = item / 40; }
    else if ((item -= CV_INO) < CV_OUT) { if (OUT_F8) { cvt_f8_item(p.in[20], 2048, wsp<unsigned char>(p, WS_WOUTO), 2048, item, lane, OUT_WSCALE, -1); return; } src = p.in[20]; dst = wsp<bf16_t>(p, WS_WOUTO); K = 2048; N = 2048; ldd = 2048; nb = item & 31; kb = item >> 5; }
    else { item -= CV_OUT; const int mat = item >> 10, w = item & 1023, le = mat / 3, kind = mat % 3; K = 2048; N = 2048; ldd = 2048; nb = w & 31; kb = w >> 5;
        src = p.in[24 + kind] + (size_t)le * 2048 * 2048;
        if (MOE_F8) { if (kind == 2) cvt_f8_item(src, 2048, wsp<unsigned char>(p, WS_WDN) + (size_t)le * 2048 * 2048, 2048, w, lane, DN_WSCALE, -1);
            else cvt_f8_item(src, 2048, wsp<unsigned char>(p, WS_WGU) + (size_t)le * 4096 * 2048, 4096, w, lane, GU_WSCALE, kind); return; }
        if (kind == 2) dst = wsp<bf16_t>(p, WS_WDN) + (size_t)le * 2048 * 2048; else { dst = wsp<bf16_t>(p, WS_WGU) + (size_t)le * 4096 * 2048; map = 3; a = kind * 128; } }
    const int n = nb * 64 + lane;
    const float* s = src + (size_t)(kb * 64) * N + n;
    float v[64];
#pragma unroll
    for (int k = 0; k < 64; ++k) v[k] = __builtin_nontemporal_load(s + (size_t)k * N);
    int drow;
    if (map == 0) drow = n + a;
    else if (map == 1) drow = n < 768 ? n : (n < 832 ? 1792 + (n - 768) : 768 + (n - 832));
    else if (map == 2) { const int h = n >> 8, j = n & 255; drow = j < 128 ? 1536 + h * 128 + j : 2560 + h * 128 + (j - 128); }
    else drow = (n >> 7) * 256 + (n & 127) + a;
    u32x4* d = (u32x4*)(dst + (size_t)drow * ldd + kb * 64);
#pragma unroll
    for (int c8 = 0; c8 < 8; ++c8) { u32x4 o; o.x = pk2(v[8 * c8], v[8 * c8 + 1]); o.y = pk2(v[8 * c8 + 2], v[8 * c8 + 3]); o.z = pk2(v[8 * c8 + 4], v[8 * c8 + 5]); o.w = pk2(v[8 * c8 + 6], v[8 * c8 + 7]); d[c8] = o; }
}
DI void ph_convert(const Params& p, int wid_, int item_lo, int item_hi, int bid, int nblk, int nwv) {
    const int wv_ = wid_; if (wv_ >= nwv) return;
    const int lane = (wid_ * 64 + fresh_lane()) & 63, gw = bid * nwv + wv_, NGW = nblk * nwv;
    for (int it = item_lo + gw; it < item_hi; it += NGW) cvt_item(p, it, lane);
}

DI void moe_f8_addr(const Params& p, int item, int lane, const float*& s, u32x4*& d, float& scale) {
    const int mat = item >> 10, w = item & 1023, le = mat / 3, kind = mat % 3, nb8 = w & 7, kb16 = w >> 3, n4 = nb8 * 256 + 4 * lane;
    s = p.in[24 + kind] + (size_t)le * 2048 * 2048 + (size_t)(kb16 * 16) * 2048 + n4;
    const int nrows = kind == 2 ? 2048 : 4096, dr = kind == 2 ? n4 : (n4 >> 7) * 256 + (n4 & 127) + kind * 128;
    unsigned char* base = kind == 2 ? wsp<unsigned char>(p, WS_WDN) + (size_t)le * 2048 * 2048 : wsp<unsigned char>(p, WS_WGU) + (size_t)le * 4096 * 2048;
    d = (u32x4*)(base + ((size_t)kb16 * nrows + dr) * 16); scale = kind == 2 ? DN_WSCALE : GU_WSCALE;
}
DI void ph_convert_moe_bg(const Params& p, int wid_, int moe_lo, int moe_hi, int bid, int nblk, int nwv) {
    if (wid_ >= nwv) return;
    const int lane = fresh_lane(), NGW = nblk * nwv; int it = moe_lo + bid * nwv + wid_;
    if (it >= moe_hi) return;
    const float* s; u32x4* d; float sc; f32x4 v[16], vn[16];
    moe_f8_addr(p, it, lane, s, d, sc);
#pragma unroll
    for (int k = 0; k < 16; ++k) v[k] = __builtin_nontemporal_load((const f32x4*)(s + (size_t)k * 2048));
    for (;;) {
        const int itn = it + NGW; const bool more = itn < moe_hi; const float* sn = s; u32x4* dn = d; float scn = sc;
        if (more) { moe_f8_addr(p, itn, lane, sn, dn, scn);
#pragma unroll
            for (int k = 0; k < 16; ++k) vn[k] = __builtin_nontemporal_load((const f32x4*)(sn + (size_t)k * 2048)); }
#pragma unroll
        for (int j = 0; j < 4; ++j) { u32x4 o;
            o.x = pk4_fp8(v[0][j] * sc, v[1][j] * sc, v[2][j] * sc, v[3][j] * sc); o.y = pk4_fp8(v[4][j] * sc, v[5][j] * sc, v[6][j] * sc, v[7][j] * sc);
            o.z = pk4_fp8(v[8][j] * sc, v[9][j] * sc, v[10][j] * sc, v[11][j] * sc); o.w = pk4_fp8(v[12][j] * sc, v[13][j] * sc, v[14][j] * sc, v[15][j] * sc);
            d[j] = o; }
        if (!more) break;
        it = itn; d = dn; sc = scn; s = sn;
#pragma unroll
        for (int k = 0; k < 16; ++k) v[k] = vn[k];
    }
}

DI void ph_misc(const Params& p, int wid_) {
    const size_t gt = (size_t)blockIdx.x * NTHREADS + (wid_ * 64 + fresh_lane()), NGT = (size_t)gridDim.x * NTHREADS;
    float* cosT = ws_cos(p); float* sinT = ws_sin(p);
    for (size_t i = gt; i < 1024 * 32; i += NGT) { const int s = (int)(i >> 5), f = (int)(i & 31);
        const float inv = powf(10000.f, -(float)(f & 15) / 16.f); const float pos = f < 16 ? (float)(s >> 6) : (float)(s & 63); const float ang = pos * inv;
        cosT[i] = cosf(ang); sinT[i] = sinf(ang); }
    bf16_t* ACT2 = wsp<bf16_t>(p, WS_ACT2); bf16_t* KPE = wsp<bf16_t>(p, WS_KPE); bf16_t* KO = wsp<bf16_t>(p, WS_KO); bf16_t* VTO = wsp<bf16_t>(p, WS_VTO);
    const float* cckv = p.in[2]; const float* ckpe = p.in[3]; const float* csk = p.in[4]; const float* csv = p.in[5];
    for (size_t i = gt; i < (size_t)TC * 256 / 4; i += NGT) { const size_t e = i * 4; const int j = (int)(e >> 8), cc = (int)(e & 255); const f32x4 v = *(const f32x4*)(cckv + e);
        u32x2 o; o.x = pk2(v[0], v[1]); o.y = pk2(v[2], v[3]); *(u32x2*)(ACT2 + (size_t)(T + j) * 1792 + 512 + cc) = o;
        const f32x4 k = *(const f32x4*)(csk + e); u32x2 o2; o2.x = pk2(k[0], k[1]); o2.y = pk2(k[2], k[3]); *(u32x2*)(KO + (size_t)(T + j) * 256 + cc) = o2; }
    for (size_t i = gt; i < (size_t)TC * 64 / 4; i += NGT) { const size_t e = i * 4; const f32x4 v = *(const f32x4*)(ckpe + e); u32x2 o; o.x = pk2(v[0], v[1]); o.y = pk2(v[2], v[3]); *(u32x2*)(KPE + (size_t)T * 64 + e) = o; }
    for (size_t i = gt; i < (size_t)256 * (TC / 8); i += NGT) { const int f = (int)(i / (TC / 8)), j8 = (int)(i % (TC / 8)) * 8; float v[8];
#pragma unroll
        for (int q = 0; q < 8; ++q) v[q] = csv[(size_t)(j8 + q) * 256 + f];
        u32x4 o; o.x = pk2(v[0], v[1]); o.y = pk2(v[2], v[3]); o.z = pk2(v[4], v[5]); o.w = pk2(v[6], v[7]); *(u32x4*)(VTO + (size_t)f * TX + T + j8) = o; }
}

DI void ph_h0(const Params& p, int wid_, unsigned char* lds_raw) {
    const int tid = (wid_ * 64 + fresh_lane()), lane = tid & 63, wv = wid_;
    const int rpb = p.rpb, rb0 = blockIdx.x * rpb, rb1 = min(rb0 + rpb, T);
    if (rb0 >= T) return;
    LAS float* P = (LAS float*)lds_raw;
    const int c_lo = cond_of_row(rb0);
    for (int i = tid; i < 2 * 2 * 512; i += NTHREADS) { const int cc = i >> 10, j = (i >> 9) & 1, col = (i & 511) * 4; const int ci = min(c_lo + cc, 8);
        *(LAS f32x4*)(P + (cc * 2 + j) * 2048 + col) = mod_from_partials(p, 0, ci, j, col); }
    __syncthreads();
    bf16_t* H = wsp<bf16_t>(p, WS_H);
    f32x4 v[8], vn[8]; int r = rb0 + wv;
    if (r < rb1) { const float* x = xrow_in(p, r) + lane * 8;
#pragma unroll
        for (int j = 0; j < 4; ++j) { v[2 * j] = __builtin_nontemporal_load((const f32x4*)(x + 512 * j)); v[2 * j + 1] = __builtin_nontemporal_load((const f32x4*)(x + 512 * j + 4)); } }
    for (; r < rb1; r += NWAVES) {
        const int rn = r + NWAVES;
        if (rn < rb1) { const float* x = xrow_in(p, rn) + lane * 8;
#pragma unroll
            for (int j = 0; j < 4; ++j) { vn[2 * j] = __builtin_nontemporal_load((const f32x4*)(x + 512 * j)); vn[2 * j + 1] = __builtin_nontemporal_load((const f32x4*)(x + 512 * j + 4)); } }
        asm volatile("" ::: "memory");
        const LAS float* sh = P + (cond_of_row(r) - c_lo) * 4096; const LAS float* sc = sh + 2048;
#pragma unroll
        for (int j = 0; j < 4; ++j) { const int c0 = lane * 8 + 512 * j;
            const f32x4 h0 = v[2 * j] * (1.f + *(const LAS f32x4*)(sc + c0)) + *(const LAS f32x4*)(sh + c0), h1 = v[2 * j + 1] * (1.f + *(const LAS f32x4*)(sc + c0 + 4)) + *(const LAS f32x4*)(sh + c0 + 4);
            u32x4 o; o.x = pk2(h0[0], h0[1]); o.y = pk2(h0[2], h0[3]); o.z = pk2(h1[0], h1[1]); o.w = pk2(h1[2], h1[3]); *(u32x4*)(H + (size_t)r * D + c0) = o; }
#pragma unroll
        for (int j = 0; j < 8; ++j) v[j] = vn[j];
    }
}

DI void ph_gb(const Params& p, int wid_) {
    float* GB = wsp<float>(p, WS_GB);
    for (int i = blockIdx.x * NTHREADS + (wid_ * 64 + fresh_lane()); i < 2 * 9 * 512; i += gridDim.x * NTHREADS) { const int l = i / (9 * 512), ci = (i / 512) % 9, col = (i & 511) * 4;
        const f32x4 g = *(const f32x4*)(p.in[21] + l * D + col), b = *(const f32x4*)(p.in[22] + l * D + col), sh = *(const f32x4*)(modp(p, l, ci, 3) + col), sc = *(const f32x4*)(modp(p, l, ci, 4) + col);
        *(f32x4*)(GB + ((size_t)(l * 9 + ci) * 2 + 0) * D + col) = g * (1.f + sc); *(f32x4*)(GB + ((size_t)(l * 9 + ci) * 2 + 1) * D + col) = b * (1.f + sc) + sh; }
}
struct E1Row { f32x4 cq[2], ckv, u[4], ad[4], sb[4]; };
DI void e1_seq(int r, int& s, int& S, int& rb) { if (r < T_CTX) { s = r & 255; S = 256; } else { s = (r - T_CTX) & 1023; S = 1024; } rb = r - s; }
DI void e1_load(const float* PJ, int r, int lane, E1Row& L) {
    const float* pr = PJ + (size_t)r * 1792; int s, S, rb; e1_seq(r, s, S, rb);
    L.cq[0] = *(const f32x4*)(pr + lane * 4); L.cq[1] = *(const f32x4*)(pr + lane * 4 + 256); L.ckv = *(const f32x4*)(pr + 512 + lane * 4);
#pragma unroll
    for (int g = 0; g < 4; ++g) { const int half = 1 << g, c0 = 768 + g * 256 + lane * 4; const int ia = s + half - 1, ib = s - half - 1;
        L.u[g] = *(const f32x4*)(pr + c0);
        const float ma = ia < S ? 1.f : 0.f, mb = ib >= 0 ? 1.f : 0.f;
        L.ad[g] = *(const f32x4*)(PJ + (size_t)(rb + min(ia, S - 1)) * 1792 + c0) * ma; L.sb[g] = *(const f32x4*)(PJ + (size_t)(rb + max(ib, 0)) * 1792 + c0) * mb; }
}
DI void e1_window_before(const float* PJ, int r, int lane, f32x4 (&wsum)[4]) {
    int s, S, rb; e1_seq(r, s, S, rb);
#pragma unroll
    for (int g = 0; g < 4; ++g) { const int half = 1 << g, c0 = 768 + g * 256 + lane * 4; const int lo = max(s - 1 - half, 0), hi = min(s - 1 + half, S);
        f32x4 sum = {0.f, 0.f, 0.f, 0.f};
        for (int t = lo; t < hi; ++t) sum += *(const f32x4*)(PJ + (size_t)(rb + t) * 1792 + c0);
        wsum[g] = sum; }
}
DI void ph_e1(const Params& p, int wid_) {
    ph_gb(p, wid_);
    const int lane = fresh_lane();
    const int rpw = (p.rpb + NWAVES - 1) / NWAVES, rb0 = blockIdx.x * p.rpb, ra = rb0 + wid_ * rpw, rz = min(min(ra + rpw, rb0 + p.rpb), T);
    if (ra >= rz) return;
    const float* PJ = wsp<float>(p, WS_PJ); bf16_t* ACT2 = wsp<bf16_t>(p, WS_ACT2);
    const float* qn = p.in[11]; const float* kvn = p.in[12];
    const f32x4 gq0 = *(const f32x4*)(qn + lane * 4), gq1 = *(const f32x4*)(qn + lane * 4 + 256), gkv = *(const f32x4*)(kvn + lane * 4);
    f32x4 wsum[4]; E1Row A, B;
    e1_load(PJ, ra, lane, A);
    e1_window_before(PJ, ra, lane, wsum);
    for (int r = ra; r < rz; ++r) {
        if (r + 1 < rz) e1_load(PJ, r + 1, lane, B);
        bf16_t* ar = ACT2 + (size_t)r * 1792; int s, S, rb; e1_seq(r, s, S, rb);
        if (s == 0 && r != ra) e1_window_before(PJ, r, lane, wsum);
        {
            const float ss = ((A.cq[0][0] * A.cq[0][0] + A.cq[0][1] * A.cq[0][1]) + (A.cq[0][2] * A.cq[0][2] + A.cq[0][3] * A.cq[0][3])) + ((A.cq[1][0] * A.cq[1][0] + A.cq[1][1] * A.cq[1][1]) + (A.cq[1][2] * A.cq[1][2] + A.cq[1][3] * A.cq[1][3]));
            const float rs = rsqrtf(wave_sum(ss) * (1.f / 512.f) + 1e-6f);
            const f32x4 y0 = A.cq[0] * rs * gq0, y1 = A.cq[1] * rs * gq1;
            u32x2 o; o.x = pk2(y0[0], y0[1]); o.y = pk2(y0[2], y0[3]); *(u32x2*)(ar + lane * 4) = o; o.x = pk2(y1[0], y1[1]); o.y = pk2(y1[2], y1[3]); *(u32x2*)(ar + lane * 4 + 256) = o;
        }
        {
            const int c0 = lane * 4; const f32x4 v = A.ckv; const float ss = (v[0] * v[0] + v[1] * v[1]) + (v[2] * v[2] + v[3] * v[3]);
            const float rs = rsqrtf(wave_sum(ss) * (1.f / 256.f) + 1e-6f); const f32x4 y = v * rs * gkv;
            u32x2 o; o.x = pk2(y[0], y[1]); o.y = pk2(y[2], y[3]); *(u32x2*)(ar + 512 + c0) = o;
            if (r < T_CTX) *(f32x4*)(p.out + O_CKV + (size_t)r * 256 + c0) = y;
        }
#pragma unroll
        for (int g = 0; g < 4; ++g) {
            const int half = 1 << g; const int lo = max(s - half, 0), hi = min(s + half, S); const int c0 = 768 + g * 256 + lane * 4;
            wsum[g] = wsum[g] + A.ad[g] - A.sb[g];
            const f32x4 y = wsum[g] * __builtin_amdgcn_rcpf((float)(hi - lo)) - A.u[g];
            u32x2 o; o.x = pk2(y[0], y[1]); o.y = pk2(y[2], y[3]); *(u32x2*)(ar + c0) = o; }
        A = B;
    }
}

DI void ph_ln1(const Params& p, int wid_, int l, unsigned char* lds_raw) {
    const int tid = (wid_ * 64 + fresh_lane()), lane = tid & 63, gw = blockIdx.x * NWAVES + wid_, NGW = gridDim.x * NWAVES;
    float* wT = (float*)lds_raw;
    const float* wr = p.in[23] + (size_t)l * 2048 * 16;
    for (int d = tid; d < 2048; d += NTHREADS) {
        const f32x4 w0 = *(const f32x4*)(wr + d * 16), w1 = *(const f32x4*)(wr + d * 16 + 4), w2 = *(const f32x4*)(wr + d * 16 + 8), w3 = *(const f32x4*)(wr + d * 16 + 12);
        const int dj = d >> 9, dl = (d & 511) >> 3, dq = (d >> 2) & 1, dc = d & 3, di = ((dj * 2 + dq) * 64 + dl) * 4 + dc;
#pragma unroll
        for (int e = 0; e < 4; ++e) { wT[e * 2048 + di] = w0[e]; wT[(4 + e) * 2048 + di] = w1[e]; wT[(8 + e) * 2048 + di] = w2[e]; wT[(12 + e) * 2048 + di] = w3[e]; } }
    __syncthreads();
    const float* Y = wsp<float>(p, WS_Y); float* STAT = wsp<float>(p, WS_STAT); bf16_t* H = wsp<bf16_t>(p, WS_H); float* AFF = wsp<float>(p, WS_AFF); float* AFFT = wsp<float>(p, WS_AFFT);
    unsigned char* H8 = wsp<unsigned char>(p, WS_H8);
    const float* lg = p.in[21] + l * D; const float* lb = p.in[22] + l * D;
    f32x4 v[8], vn[8], gg[8], gb[8];
    int r = gw;
#define LN1_LOAD(dst, rr) do { if ((rr) < T) { _Pragma("unroll") for (int j = 0; j < 4; ++j) { const float* y = Y + (size_t)(rr) * D + lane * 8 + 512 * j; dst[2 * j] = *(const f32x4*)y; dst[2 * j + 1] = *(const f32x4*)(y + 4); } } } while (0)
    LN1_LOAD(v, r);
    for (; r < T; r += NGW) {
        LN1_LOAD(vn, r + NGW);
        const int ci = cond_of_row(r); const float* gv = wsp<float>(p, WS_GB) + (size_t)(l * 9 + ci) * 2 * D; const float* bv = gv + D;
#pragma unroll
        for (int j = 0; j < 8; ++j) { const int cc = lane * 8 + 512 * (j >> 1) + 4 * (j & 1); gg[j] = *(const f32x4*)(gv + cc); gb[j] = *(const f32x4*)(bv + cc); }
        float s = 0.f;
#pragma unroll
        for (int j = 0; j < 8; ++j) s += (v[j][0] + v[j][1]) + (v[j][2] + v[j][3]);
        const float mean = wave_sum(s) * (1.f / D); float s2 = 0.f;
#pragma unroll
        for (int j = 0; j < 8; ++j) { v[j] = v[j] - mean; s2 += (v[j][0] * v[j][0] + v[j][1] * v[j][1]) + (v[j][2] * v[j][2] + v[j][3] * v[j][3]); }
        const float rstd = rsqrtf(wave_sum(s2) * (1.f / D) + 1e-5f);
#pragma unroll
        for (int j = 0; j < 4; ++j) { const int c0 = lane * 8 + 512 * j;
#pragma unroll
            for (int q = 0; q < 2; ++q) { const int cc = c0 + 4 * q; v[2 * j + q] = v[2 * j + q] * rstd * gg[2 * j + q] + gb[2 * j + q]; (void)cc; }
            const f32x4 a = v[2 * j], b = v[2 * j + 1];
            if (!MOE_F8) { u32x4 o; o.x = pk2(a[0], a[1]); o.y = pk2(a[2], a[3]); o.z = pk2(b[0], b[1]); o.w = pk2(b[2], b[3]); *(u32x4*)(H + (size_t)r * D + c0) = o; }
            u32x2 o8; o8.x = pk4_fp8(a[0], a[1], a[2], a[3]); o8.y = pk4_fp8(b[0], b[1], b[2], b[3]); *(u32x2*)(H8 + (size_t)r * D + c0) = o8; }
        float pa[16];
#ifdef PROBE_ROUTER2
#pragma unroll
        for (int e = 0; e < 16; ++e) { float a = 0.f; if ((e & 1) == 0) asm volatile("" ::: "memory");
#pragma unroll
            for (int j = 0; j < 4; ++j) { const float* wp = wT + e * 2048 + j * 512 + lane * 4; const f32x4 w0 = *(const f32x4*)wp, w1 = *(const f32x4*)(wp + 256); const f32x4 h0 = v[2 * j], h1 = v[2 * j + 1];
                a += ((h0[0] * w0[0] + h0[1] * w0[1]) + (h0[2] * w0[2] + h0[3] * w0[3])) + ((h1[0] * w1[0] + h1[1] * w1[1]) + (h1[2] * w1[2] + h1[3] * w1[3])); }
            asm volatile("" :: "v"(a)); }
#endif
#pragma unroll
        for (int e = 0; e < 16; ++e) { float a = 0.f; if ((e & 1) == 0) asm volatile("" ::: "memory");
#pragma unroll
            for (int j = 0; j < 4; ++j) { const float* wp = wT + e * 2048 + j * 512 + lane * 4; const f32x4 w0 = *(const f32x4*)wp, w1 = *(const f32x4*)(wp + 256); const f32x4 h0 = v[2 * j], h1 = v[2 * j + 1];
                a += ((h0[0] * w0[0] + h0[1] * w0[1]) + (h0[2] * w0[2] + h0[3] * w0[3])) + ((h1[0] * w1[0] + h1[1] * w1[1]) + (h1[2] * w1[2] + h1[3] * w1[3])); }
            pa[e] = a; }
        float pb[8], pc[4], pd[2];
        { const bool hi = (lane & 32) != 0;
#pragma unroll
          for (int e = 0; e < 8; ++e) { const float keep = hi ? pa[e + 8] : pa[e], send = hi ? pa[e] : pa[e + 8]; pb[e] = keep + __shfl_xor(send, 32); } }
        { const bool hi = (lane & 16) != 0;
#pragma unroll
          for (int e = 0; e < 4; ++e) { const float keep = hi ? pb[e + 4] : pb[e], send = hi ? pb[e] : pb[e + 4]; pc[e] = keep + __shfl_xor(send, 16); } }
        { const bool hi = (lane & 8) != 0;
#pragma unroll
          for (int e = 0; e < 2; ++e) { const float keep = hi ? pc[e + 2] : pc[e], send = hi ? pc[e] : pc[e + 2]; pd[e] = keep + __shfl_xor(send, 8); } }
        float mine; { const bool hi = (lane & 4) != 0; const float keep = hi ? pd[1] : pd[0], send = hi ? pd[0] : pd[1]; mine = keep + __shfl_xor(send, 4); }
        mine += __shfl_xor(mine, 2); mine += __shfl_xor(mine, 1);
        const int myexp = ((lane >> 5) & 1) * 8 + ((lane >> 4) & 1) * 4 + ((lane >> 3) & 1) * 2 + ((lane >> 2) & 1);
        const float m = wave_max(mine);
        const float ex = expf(mine - m);
        const float den = wave_sum(ex) * 0.25f;
        if ((lane & 3) == 0) { const float af = ex / den; AFF[(size_t)r * 16 + myexp] = af; AFFT[(size_t)myexp * T + r] = af; }
        if (lane == 0) *(f32x2*)(STAT + 2 * (size_t)r) = (f32x2){mean, rstd};
#pragma unroll
        for (int j = 0; j < 8; ++j) v[j] = vn[j];
    }
#undef LN1_LOAD
}

DI void ph_topk(const Params& p, int wid_, unsigned char* lds_raw) {
    const int tid = (wid_ * 64 + fresh_lane()), lane = tid & 63, wave = wid_;
    float* vals = (float*)lds_raw;
    int* cnt2 = (int*)(vals + 1024);
    int* selrow = cnt2 + 256;
    int* selslot = selrow + 256;
    int* nsel = selslot + 256;
    const float* AFFT = wsp<float>(p, WS_AFFT); int* INV = wsp<int>(p, WS_INV); const bf16_t* H = wsp<bf16_t>(p, WS_H); const unsigned char* H8 = wsp<unsigned char>(p, WS_H8); bf16_t* XS = wsp<bf16_t>(p, WS_XS);
    for (int it = blockIdx.x; it < 768; it += gridDim.x) {
        int n, cap, r0, e, sb, c0;
        if (it < 256) { const int b = it >> 4; e = it & 15; n = 256; cap = 32; r0 = b * 256; sb = b * 32; c0 = 0; }
        else { const int q = it - 256, li = q >> 2, b = li >> 4; e = li & 15; n = 1024; cap = 128; r0 = T_CTX + b * 1024; sb = 512 + b * 128; c0 = (q & 3) * 256; }
        for (int i = tid; i < n; i += NTHREADS) vals[i] = AFFT[(size_t)e * T + r0 + i];
        if (tid == 0) *nsel = 0;
        __syncthreads();
        const int ci = c0 + (tid & 255), half = tid >> 8, jn = n >> 1, j0 = half * jn;
        const float vi = vals[ci]; int cnt = 0;
#pragma unroll 4
        for (int j = j0; j < j0 + jn; j += 4) { const f32x4 w = *(const f32x4*)(vals + j);
            cnt += ((w[0] > vi || (w[0] == vi && j < ci)) ? 1 : 0) + ((w[1] > vi || (w[1] == vi && j + 1 < ci)) ? 1 : 0) + ((w[2] > vi || (w[2] == vi && j + 2 < ci)) ? 1 : 0) + ((w[3] > vi || (w[3] == vi && j + 3 < ci)) ? 1 : 0); }
        if (half) cnt2[tid & 255] = cnt;
        __syncthreads();
        if (!half) { cnt += cnt2[tid];
            if (cnt < cap) { const int pos = atomicAdd(nsel, 1); selrow[pos] = ci; selslot[pos] = cnt; INV[(size_t)(r0 + ci) * 16 + e] = sb + cnt; } else INV[(size_t)(r0 + ci) * 16 + e] = -1; }
        __syncthreads();
        const int ns = *nsel;
        for (int k0 = wave; k0 < ns; k0 += 4 * NWAVES) {
            if (MOE_F8) { u32x4 bufr[4][2];
#pragma unroll
                for (int b = 0; b < 4; ++b) { const int k = k0 + NWAVES * b; if (k < ns) { const u32x4* src = (const u32x4*)(H8 + (size_t)(r0 + selrow[k]) * D); bufr[b][0] = src[lane]; bufr[b][1] = src[lane + 64]; } }
#pragma unroll
                for (int b = 0; b < 4; ++b) { const int k = k0 + NWAVES * b; if (k < ns) { u32x4* dst = (u32x4*)((unsigned char*)XS + (size_t)(e * NSLOT + sb + selslot[k]) * D); dst[lane] = bufr[b][0]; dst[lane + 64] = bufr[b][1]; } } }
            else {
#pragma unroll
                for (int b = 0; b < 4; ++b) { const int k = k0 + NWAVES * b; if (k < ns) { const u32x4* src = (const u32x4*)(H + (size_t)(r0 + selrow[k]) * D); u32x4* dst = (u32x4*)(XS + (size_t)(e * NSLOT + sb + selslot[k]) * D);
#pragma unroll
                    for (int j = 0; j < 4; ++j) dst[lane + 64 * j] = src[lane + 64 * j]; } } } }
        __syncthreads();
    }
}

DI void ph_ln2(const Params& p, int wid_, int l, unsigned char* lds_raw) {
    const int tid = (wid_ * 64 + fresh_lane()), lane = tid & 63, wv = wid_;
    const int rpb = p.rpb, rb0 = blockIdx.x * rpb, rb1 = min(rb0 + rpb, T);
    if (rb0 >= T) return;
    LAS float* PV = (LAS float*)lds_raw;
    LAS float* PC = PV + 4 * 2048;
    const int c_lo = cond_of_row(rb0);
    for (int i = tid; i < 4 * 512; i += NTHREADS) { const int w = i >> 9, col = (i & 511) * 4; const float* src = w == 0 ? p.in[21] + l * D : w == 1 ? p.in[22] + l * D : w == 2 ? p.in[27] + l * D : p.in[28] + l * D;
        *(LAS f32x4*)(PV + w * 2048 + col) = *(const f32x4*)(src + col); }
    for (int i = tid; i < 2 * 3 * 512; i += NTHREADS) { const int cc = i / 1536, w = (i / 512) % 3, col = (i & 511) * 4; const int ci = min(c_lo + cc, 8);
        const float* src = w == 0 ? modp(p, l, ci, 5) : modp(p, 1, ci, w == 1 ? 0 : 1);
        *(LAS f32x4*)(PC + (cc * 3 + w) * 2048 + col) = *(const f32x4*)(src + col); }
    __syncthreads();
    const float* Y = wsp<float>(p, WS_Y); const float* STAT = wsp<float>(p, WS_STAT);
    const float* AFF = wsp<float>(p, WS_AFF); const int* INV = wsp<int>(p, WS_INV); const bf16_t* YE = wsp<bf16_t>(p, WS_YE);
    float* XL = wsp<float>(p, WS_XL); bf16_t* H = wsp<bf16_t>(p, WS_H);
    f32x4 x[8], xn[8]; int sl = -1, sln = -1; float af = 0.f, afn = 0.f; f32x2 st = {0.f, 1.f}, stn = {0.f, 1.f};
    int r = rb0 + wv;
#define LN2_LOAD(dx, ds, da, dt, rr) do { if ((rr) < rb1) { _Pragma("unroll") for (int j = 0; j < 4; ++j) { const float* y = Y + (size_t)(rr) * D + lane * 8 + 512 * j; dx[2 * j] = *(const f32x4*)y; dx[2 * j + 1] = *(const f32x4*)(y + 4); } \
        if (lane < 16) { ds = INV[(size_t)(rr) * 16 + lane]; da = AFF[(size_t)(rr) * 16 + lane]; } dt = *(const f32x2*)(STAT + 2 * (size_t)(rr)); } } while (0)
    LN2_LOAD(x, sl, af, st, r);
    for (; r < rb1; r += NWAVES) {
        asm volatile("" ::: "memory");
        LN2_LOAD(xn, sln, afn, stn, r + NWAVES);
        const LAS float* pc = PC + (cond_of_row(r) - c_lo) * 3 * 2048;
        f32x4 f[8];
#pragma unroll
        for (int j = 0; j < 8; ++j) f[j] = (f32x4){0.f, 0.f, 0.f, 0.f};
        {
            unsigned long long mk = __ballot(sl >= 0) & 0xffffull;
            while (mk) {
                const int e0 = __builtin_ctzll(mk); mk &= mk - 1; const bool two = mk != 0ull; const int e1 = two ? __builtin_ctzll(mk) : e0; if (two) mk &= mk - 1;
                const int s0 = __shfl(sl, e0), s1 = __shfl(sl, e1); const float w0 = __shfl(af, e0), w1 = two ? __shfl(af, e1) : 0.f;
                const bf16_t* y0 = YE + (size_t)(e0 * NSLOT + s0) * D + lane * 8; const bf16_t* y1 = YE + (size_t)(e1 * NSLOT + s1) * D + lane * 8;
                u32x4 q0[4], q1[4];
#pragma unroll
                for (int j = 0; j < 4; ++j) { q0[j] = *(const u32x4*)(y0 + 512 * j); q1[j] = *(const u32x4*)(y1 + 512 * j); }
#pragma unroll
                for (int j = 0; j < 4; ++j) {
                    f[2 * j][0] += w0 * bflo(q0[j].x) + w1 * bflo(q1[j].x); f[2 * j][1] += w0 * bfhi(q0[j].x) + w1 * bfhi(q1[j].x); f[2 * j][2] += w0 * bflo(q0[j].y) + w1 * bflo(q1[j].y); f[2 * j][3] += w0 * bfhi(q0[j].y) + w1 * bfhi(q1[j].y);
                    f[2 * j + 1][0] += w0 * bflo(q0[j].z) + w1 * bflo(q1[j].z); f[2 * j + 1][1] += w0 * bfhi(q0[j].z) + w1 * bfhi(q1[j].z); f[2 * j + 1][2] += w0 * bflo(q0[j].w) + w1 * bflo(q1[j].w); f[2 * j + 1][3] += w0 * bfhi(q0[j].w) + w1 * bfhi(q1[j].w); }
            }
        }
        float s = 0.f;
#pragma unroll
        for (int j = 0; j < 8; ++j) { const int c0 = lane * 8 + 512 * (j >> 1) + 4 * (j & 1); const f32x4 x1 = (x[j] - st[0]) * st[1] * *(const LAS f32x4*)(PV + c0) + *(const LAS f32x4*)(PV + 2048 + c0);
            f[j] = DN_ALPHA * x1 + *(const LAS f32x4*)(pc + c0) * f[j]; s += (f[j][0] + f[j][1]) + (f[j][2] + f[j][3]); }
        const float mean = wave_sum(s) * (1.f / D); float s2 = 0.f;
#pragma unroll
        for (int j = 0; j < 8; ++j) { f[j] = f[j] - mean; s2 += (f[j][0] * f[j][0] + f[j][1] * f[j][1]) + (f[j][2] * f[j][2] + f[j][3] * f[j][3]); }
        const float rstd = rsqrtf(wave_sum(s2) * (1.f / D) + 1e-5f);
#pragma unroll
        for (int j = 0; j < 4; ++j) { const int c0 = lane * 8 + 512 * j; f32x4 o[2];
#pragma unroll
            for (int q = 0; q < 2; ++q) { const int cc = c0 + 4 * q; o[q] = f[2 * j + q] * rstd * *(const LAS f32x4*)(PV + 2 * 2048 + cc) + *(const LAS f32x4*)(PV + 3 * 2048 + cc);
                if (l == 0) { *(f32x4*)(XL + (size_t)r * D + cc) = o[q]; o[q] = o[q] * (1.f + *(const LAS f32x4*)(pc + 2 * 2048 + cc)) + *(const LAS f32x4*)(pc + 2048 + cc); }
                else *(f32x4*)(p.out + O_Y + (size_t)r * D + cc) = o[q]; }
            if (l == 0) { u32x4 w; w.x = pk2(o[0][0], o[0][1]); w.y = pk2(o[0][2], o[0][3]); w.z = pk2(o[1][0], o[1][1]); w.w = pk2(o[1][2], o[1][3]); *(u32x4*)(H + (size_t)r * D + c0) = w; } }
#pragma unroll
        for (int j = 0; j < 8; ++j) x[j] = xn[j];
        sl = sln; af = afn; st = stn;
    }
#undef LN2_LOAD
}
template <int PAT> DI void ph_readonly(const Params& p, int wid_) {
    const int lane = (wid_ * 64 + fresh_lane()) & 63, gw = blockIdx.x * NWAVES + wid_, NGW = gridDim.x * NWAVES;
    float accum = 0.f;
    for (int it = gw; it < 98304; it += NGW) {
        const int mat = it >> 10, w = it & 1023, le = mat / 3, kind = mat % 3;
        const float* base = p.in[24 + kind] + (size_t)le * 2048 * 2048;
        if (PAT == 0) { const int nb = w & 31, kb = w >> 5; const float* s = base + (size_t)(kb * 64) * 2048 + nb * 64 + lane; float v[64];
#pragma unroll
            for (int k = 0; k < 64; ++k) v[k] = __builtin_nontemporal_load(s + (size_t)k * 2048);
#pragma unroll
            for (int k = 0; k < 64; ++k) accum += v[k]; }
        else if (PAT == 1) { const int nb8 = w & 7, kb16 = w >> 3; const float* s = base + (size_t)(kb16 * 16) * 2048 + nb8 * 256 + 4 * lane; f32x4 v[16];
#pragma unroll
            for (int k = 0; k < 16; ++k) v[k] = __builtin_nontemporal_load((const f32x4*)(s + (size_t)k * 2048));
#pragma unroll
            for (int k = 0; k < 16; ++k) accum += (v[k][0] + v[k][1]) + (v[k][2] + v[k][3]); }
        else { const float* s = base + (size_t)w * 4096 + 4 * lane; f32x4 v[16];
#pragma unroll
            for (int k = 0; k < 16; ++k) v[k] = __builtin_nontemporal_load((const f32x4*)(s + (size_t)k * 256));
#pragma unroll
            for (int k = 0; k < 16; ++k) accum += (v[k][0] + v[k][1]) + (v[k][2] + v[k][3]); }
    }
    if (lane == 0) wsp<float>(p, WS_DBG)[gw] = accum + wave_sum(accum);
}

struct Unit { const char* A; const char* B; unsigned lda, ldb; int nt; int pm, pn; int mode; int aux; };
DI int vcu_of(int bx, int G) { return (G % 8 == 0) ? (bx % 8) * (G / 8) + bx / 8 : bx; }

DI void rope8(const Params& p, int s, int pi0, float* v) {
    const f32x4 c = *(const f32x4*)(ws_cos(p) + s * 32 + pi0), sn = *(const f32x4*)(ws_sin(p) + s * 32 + pi0);
#pragma unroll
    for (int i = 0; i < 4; ++i) { const float x1 = v[2 * i], x2 = v[2 * i + 1]; v[2 * i] = x1 * c[i] - x2 * sn[i]; v[2 * i + 1] = x1 * sn[i] + x2 * c[i]; }
}
DI void st_bf16x8(bf16_t* dst, const float* v) { u32x4 w; w.x = pk2(v[0], v[1]); w.y = pk2(v[2], v[3]); w.z = pk2(v[4], v[5]); w.w = pk2(v[6], v[7]); *(u32x4*)dst = w; }
DI void st_f32x8(float* dst, const float* v) { *(f32x4*)dst = (f32x4){v[0], v[1], v[2], v[3]}; *(f32x4*)(dst + 4) = (f32x4){v[4], v[5], v[6], v[7]}; }

struct SchedInEven { static constexpr bool BK16 = false; const Params* p; int G, c;
    DI bool next(int i, Unit& u) const { const int L = i * G + c; if (L >= 48 * 8) return false; u.pm = L >> 3; u.pn = L & 7;
        u.A = (const char*)wsp<bf16_t>(*p, WS_H) + (size_t)u.pm * 256 * 4096; u.B = (const char*)wsp<bf16_t>(*p, WS_WINE) + (size_t)u.pn * 256 * 4096; u.lda = 4096; u.ldb = 4096; u.nt = 32; u.mode = 0; u.aux = 0; return true; } };
struct EpiInEven { static constexpr bool HAS_STATE = false; static constexpr bool PAIR = false, F8 = false; const Params* p;
    DI void store(const Unit& u, int row, int col, float* v) const {
        const int r = u.pm * 256 + row, gc = u.pn * 256 + col;
        if (gc < 1792) { st_f32x8(wsp<float>(*p, WS_PJ) + (size_t)r * 1792 + gc, v); return; }
        if (gc >= 1856) return;
        const int j0 = gc - 1792;
        if (r < T_CTX) st_f32x8(p->out + O_KPE + (size_t)r * 64 + j0, v); else rope8(*p, (r - T_CTX) & 1023, j0 >> 1, v);
        st_bf16x8(wsp<bf16_t>(*p, WS_KPE) + (size_t)r * 64 + j0, v);
    } };

constexpr int E2_Q = 48 * 6, E2_K = 64 * 4, E2_V = 4 * 64, E2_P = 48 * 4, E2_TOTAL = E2_Q + E2_K + E2_V + E2_P;
struct SchedE2 { static constexpr bool BK16 = false; const Params* p; int G, c;
    DI bool next(int i, Unit& u) const { int L;
        if (G == 256) { if (c < 32) { if (i > 2) return false; L = i == 0 ? c : (i == 1 ? 256 + c : E2_Q + c); } else { if (i > 3) return false; L = i == 0 ? c : E2_Q + 32 + (c - 32) * 3 + (i - 1); } }
        else { L = i * G + c; if (L >= E2_TOTAL) return false; }
        const char* ACT2 = (const char*)wsp<bf16_t>(*p, WS_ACT2); const char* W2 = (const char*)wsp<bf16_t>(*p, WS_W2); u.aux = 0;
        if (L < E2_Q) { u.mode = 0; u.pm = L / 6; u.pn = L % 6; u.A = ACT2 + (size_t)u.pm * 256 * 3584; u.lda = 3584; u.B = W2 + (size_t)u.pn * 256 * 3584; u.ldb = 3584; u.nt = 8; return true; }
        L -= E2_Q;
        if (L < E2_K) { u.mode = 1; u.pm = L >> 2; u.pn = L & 3; u.A = ACT2 + (size_t)u.pm * 256 * 3584 + 512 * 2; u.lda = 3584; u.B = W2 + (size_t)(1536 + u.pn * 256) * 3584; u.ldb = 3584; u.nt = 4; return true; }
        L -= E2_K;
        if (L < E2_V) { u.mode = 2; u.pm = L >> 6; u.pn = L & 63; u.A = W2 + (size_t)(2560 + u.pm * 256) * 3584; u.lda = 3584; u.B = ACT2 + (size_t)u.pn * 256 * 3584 + 512 * 2; u.ldb = 3584; u.nt = 4; return true; }
        L -= E2_V;
        u.mode = 3; u.pm = L >> 2; u.aux = L & 3; u.pn = 0; u.A = ACT2 + (size_t)u.pm * 256 * 3584 + (768 + u.aux * 256) * 2; u.lda = 3584; u.B = W2 + (size_t)(3584 + u.aux * 256) * 3584; u.ldb = 3584; u.nt = 4; return true; } };
struct EpiE2 { static constexpr bool HAS_STATE = false; static constexpr bool PAIR = false, F8 = false; const Params* p;
    DI void store(const Unit& u, int row, int col, float* v) const {
        const int r = u.pm * 256 + row, gc = u.pn * 256 + col;
        if (u.mode == 0) { const int dd = gc % 192; if (dd >= 128 && r >= T_CTX) rope8(*p, (r - T_CTX) & 1023, (dd - 128) >> 1, v);
#pragma unroll
            for (int i = 0; i < 8; ++i) v[i] *= QS_MLA;
            st_bf16x8(wsp<bf16_t>(*p, WS_Q) + (size_t)r * 1536 + gc, v); }
        else if (u.mode == 1) st_bf16x8(wsp<bf16_t>(*p, WS_KN) + (size_t)r * 1024 + gc, v);
        else if (u.mode == 2) st_bf16x8(wsp<bf16_t>(*p, WS_VT) + (size_t)r * TX + gc, v);
        else { const float* ps = p->in[16] + u.aux * 256 + col;
#pragma unroll
            for (int i = 0; i < 8; ++i) v[i] *= ps[i];
            if (OUT_F8) { u32x2 o; o.x = pk4_fp8(v[0], v[1], v[2], v[3]); o.y = pk4_fp8(v[4], v[5], v[6], v[7]); *(u32x2*)((unsigned char*)wsp<bf16_t>(*p, WS_MIX) + (size_t)r * 2048 + 1024 + u.aux * 256 + col) = o; }
            else st_bf16x8(wsp<bf16_t>(*p, WS_MIX) + (size_t)r * 2048 + 1024 + u.aux * 256 + col, v); }
    } };

struct SchedOut { static constexpr bool BK16 = OUT_F8 != 0; const Params* p; int G, c, l;
    DI bool next(int i, Unit& u) const { const int L = i * G + c; if (L >= 48 * 8) return false; u.pm = L >> 3; u.pn = L & 7;
        constexpr unsigned P = OUT_F8 ? 2048 : 4096;
        u.A = (const char*)wsp<bf16_t>(*p, WS_MIX) + (size_t)u.pm * 256 * P; u.B = (const char*)wsp<bf16_t>(*p, l == 0 ? WS_WOUTE : WS_WOUTO) + (OUT_F8 ? (size_t)u.pn * 256 * 16 : (size_t)u.pn * 256 * P); u.lda = P; u.ldb = OUT_F8 ? 2048 * 16 : P; u.nt = OUT_F8 ? 16 : 32; u.mode = 0; u.aux = 0; return true; } };
struct EpiOut { static constexpr bool HAS_STATE = false; static constexpr bool PAIR = false, F8 = OUT_F8 != 0; const Params* p; int l;
    DI void store(const Unit& u, int row, int col, float* v) const {
        const int r = u.pm * 256 + row, gc = u.pn * 256 + col;
        const float* x = (l == 0 ? xrow_in(*p, r) : wsp<float>(*p, WS_XL) + (size_t)r * D) + gc; const float* g1 = modp(*p, l, cond_of_row(r), 2) + gc;
        const f32x4 x0 = *(const f32x4*)x, x1 = *(const f32x4*)(x + 4), g0 = *(const f32x4*)g1, g4 = *(const f32x4*)(g1 + 4);
#pragma unroll
        for (int i = 0; i < 4; ++i) { const float w0 = OUT_F8 ? g0[i] * (1.f / OUT_WSCALE) : g0[i], w4 = OUT_F8 ? g4[i] * (1.f / OUT_WSCALE) : g4[i]; v[i] = DN_ALPHA * x0[i] + w0 * v[i]; v[4 + i] = DN_ALPHA * x1[i] + w4 * v[4 + i]; }
        st_f32x8(wsp<float>(*p, WS_Y) + (size_t)r * D + gc, v);
    } };

struct SchedGU { static constexpr bool BK16 = MOE_F8 != 0; const Params* p; int G, c, l;
    DI bool next(int i, Unit& u) const { const int L = i * G + c; if (L >= 16 * 96) return false; const int e = L / 96, rem = L % 96; u.pn = rem / 6; u.pm = e * 6 + rem % 6; u.aux = e;
        constexpr unsigned P = MOE_F8 ? 2048 : 4096;
        u.A = (const char*)wsp<bf16_t>(*p, WS_XS) + (size_t)u.pm * 256 * P; u.B = (const char*)wsp<bf16_t>(*p, WS_WGU) + (MOE_F8 ? (size_t)(l * 16 + e) * 4096 * 2048 + (size_t)u.pn * 256 * 16 : ((size_t)(l * 16 + e) * 4096 + (size_t)u.pn * 256) * P); u.lda = P; u.ldb = MOE_F8 ? 4096 * 16 : P; u.nt = MOE_F8 ? 16 : 32; u.mode = 0; return true; } };
struct EpiGU { static constexpr bool HAS_STATE = false; static constexpr bool PAIR = true, F8 = MOE_F8 != 0; const Params* p;
    DI void store2(const Unit& u, int row, int col, const float* g, const float* up) const {
        float h[8];
#pragma unroll
        for (int i = 0; i < 8; ++i) { const float gg = MOE_F8 ? g[i] * (1.f / GU_WSCALE) : g[i], uu = MOE_F8 ? up[i] * (1.f / GU_WSCALE) : up[i]; h[i] = gg * uu * __builtin_amdgcn_rcpf(1.f + __expf(-gg)); }
        if (MOE_F8) { u32x2 o; o.x = pk4_fp8(h[0], h[1], h[2], h[3]); o.y = pk4_fp8(h[4], h[5], h[6], h[7]); *(u32x2*)((unsigned char*)wsp<bf16_t>(*p, WS_HID) + (size_t)(u.pm * 256 + row) * D + u.pn * 128 + col) = o; }
        else st_bf16x8(wsp<bf16_t>(*p, WS_HID) + (size_t)(u.pm * 256 + row) * D + u.pn * 128 + col, h);
    } };

struct SchedDown { static constexpr bool BK16 = MOE_F8 != 0; const Params* p; int G, c, l;
    DI bool next(int i, Unit& u) const { const int L = i * G + c; if (L >= 16 * 48) return false; const int e = L / 48, rem = L % 48; u.pn = rem / 6; u.pm = e * 6 + rem % 6; u.aux = e;
        constexpr unsigned P = MOE_F8 ? 2048 : 4096;
        u.A = (const char*)wsp<bf16_t>(*p, WS_HID) + (size_t)u.pm * 256 * P; u.B = (const char*)wsp<bf16_t>(*p, WS_WDN) + (MOE_F8 ? (size_t)(l * 16 + e) * 2048 * 2048 + (size_t)u.pn * 256 * 16 : ((size_t)(l * 16 + e) * 2048 + (size_t)u.pn * 256) * P); u.lda = P; u.ldb = MOE_F8 ? 2048 * 16 : P; u.nt = MOE_F8 ? 16 : 32; u.mode = 0; return true; } };
struct EpiDown { static constexpr bool HAS_STATE = false; static constexpr bool PAIR = false, F8 = MOE_F8 != 0; const Params* p;
    DI void store(const Unit& u, int row, int col, float* v) const {
        if (MOE_F8) {
#pragma unroll
            for (int i = 0; i < 8; ++i) v[i] *= (1.f / DN_WSCALE); }
        st_bf16x8(wsp<bf16_t>(*p, WS_YE) + (size_t)(u.pm * 256 + row) * D + u.pn * 256 + col, v); } };

constexpr int IO_QK = 48 * 9, IO_V = 16, IO_VT = 48, IO_TOTAL = IO_QK + IO_V + IO_VT;
struct SchedInOdd { static constexpr bool BK16 = false; const Params* p; int G, c;
    DI bool next(int i, Unit& u) const { int L = i * G + c; if (L >= IO_TOTAL) return false;
        const char* Hb = (const char*)wsp<bf16_t>(*p, WS_H); const char* W = (const char*)wsp<bf16_t>(*p, WS_WINO); u.aux = 0; u.nt = 32; u.lda = 4096; u.ldb = 4096;
        if (L < IO_QK) { u.mode = 0; u.pm = L / 9; u.pn = L % 9; u.A = Hb + (size_t)u.pm * 256 * 4096; u.B = W + (size_t)u.pn * 256 * 4096; return true; }
        L -= IO_QK;
        if (L < IO_V) { u.mode = 1; u.pm = L; u.pn = 9; u.A = Hb + (size_t)u.pm * 256 * 4096; u.B = W + (size_t)9 * 256 * 4096; return true; }
        L -= IO_V;
        u.mode = 2; u.pm = 0; u.pn = L; u.A = W + (size_t)9 * 256 * 4096; u.B = Hb + (size_t)u.pn * 256 * 4096; return true; } };
struct EpiInOdd { static constexpr bool HAS_STATE = true; static constexpr bool PAIR = false, F8 = false; const Params* p;
    struct State { f32x4 c[4], s[4]; bool rot; };
    DI void begin(State& st, const Unit& u, int row0, int col0) const {
        st.rot = u.mode == 0 && u.pm * 256 >= T_CTX;
        if (st.rot) { const int pi0 = (col0 & 63) >> 1;
#pragma unroll
            for (int ri = 0; ri < 4; ++ri) { const int r = u.pm * 256 + ri * 16 + row0, sp = (r - T_CTX) & 1023;
                st.c[ri] = *(const f32x4*)(ws_cos(*p) + sp * 32 + pi0); st.s[ri] = *(const f32x4*)(ws_sin(*p) + sp * 32 + pi0); } }
    }
    DI void store_st(const State& st, int ri, const Unit& u, int row, int col, float* v) const {
        const int r = u.pm * 256 + row, gc = u.pn * 256 + col;
        if (u.mode == 0) {
            if (gc < 2048) {
                if (st.rot) {
#pragma unroll
                    for (int i = 0; i < 4; ++i) { const float x1 = v[2 * i], x2 = v[2 * i + 1]; v[2 * i] = x1 * st.c[ri][i] - x2 * st.s[ri][i]; v[2 * i + 1] = x1 * st.s[ri][i] + x2 * st.c[ri][i]; } }
#pragma unroll
                for (int i = 0; i < 8; ++i) v[i] *= QS_SWA;
                st_bf16x8(wsp<bf16_t>(*p, WS_Q) + (size_t)r * 2048 + gc, v); }
            else { const int kc = gc - 2048; if (r < T_CTX) st_f32x8(p->out + O_SK + (size_t)r * 256 + kc, v);
                if (st.rot) {
#pragma unroll
                    for (int i = 0; i < 4; ++i) { const float x1 = v[2 * i], x2 = v[2 * i + 1]; v[2 * i] = x1 * st.c[ri][i] - x2 * st.s[ri][i]; v[2 * i + 1] = x1 * st.s[ri][i] + x2 * st.c[ri][i]; } }
                st_bf16x8(wsp<bf16_t>(*p, WS_KO) + (size_t)r * 256 + kc, v); } }
        else if (u.mode == 1) st_f32x8(p->out + O_SV + (size_t)r * 256 + col, v);
        else st_bf16x8(wsp<bf16_t>(*p, WS_VTO) + (size_t)row * TX + gc, v);
    }
    DI void store(const Unit& u, int row, int col, float* v) const {
        const int r = u.pm * 256 + row, gc = u.pn * 256 + col;
        if (u.mode == 0) {
            if (gc < 2048) { if (r >= T_CTX) rope8(*p, (r - T_CTX) & 1023, (gc & 63) >> 1, v);
#pragma unroll
                for (int i = 0; i < 8; ++i) v[i] *= QS_SWA;
                st_bf16x8(wsp<bf16_t>(*p, WS_Q) + (size_t)r * 2048 + gc, v); }
            else { const int kc = gc - 2048; if (r < T_CTX) st_f32x8(p->out + O_SK + (size_t)r * 256 + kc, v); else rope8(*p, (r - T_CTX) & 1023, (kc & 63) >> 1, v);
                st_bf16x8(wsp<bf16_t>(*p, WS_KO) + (size_t)r * 256 + kc, v); } }
        else if (u.mode == 1) st_f32x8(p->out + O_SV + (size_t)r * 256 + col, v);
        else st_bf16x8(wsp<bf16_t>(*p, WS_VTO) + (size_t)row * TX + gc, v);
    } };

namespace pg8 {
typedef short bf16x8 __attribute__((ext_vector_type(8)));
typedef int i32x4 __attribute__((ext_vector_type(4)));
typedef int i32x8 __attribute__((ext_vector_type(8)));
DI i32x8 cat8(bf16x8 lo, bf16x8 hi) { return __builtin_shufflevector(__builtin_bit_cast(i32x4, lo), __builtin_bit_cast(i32x4, hi), 0, 1, 2, 3, 4, 5, 6, 7); }
constexpr int BM = 256, BK = 64, HALF = 128, HTB = HALF * BK * 2  , STAGE_BYTES = 8 * HTB;
DI int lds_byte(int r, int c) { const int st = (r >> 4) * 2 + (c >> 5), rr = r & 15, cc = c & 31, ob = rr * 64 + cc * 2; return st * 1024 + (ob ^ (((ob >> 9) & 1) << 5)); }
DI void stage_rc(int b, int& R, int& C) { const int st = b / 1024, sb = b % 1024, swz = sb ^ (((sb >> 9) & 1) << 5); R = (st >> 1) * 16 + swz / 64; C = (st & 1) * 32 + (swz % 64) / 2; }
DI int perm32(int rho) { const int n = rho >> 4, i = rho & 15; return 8 * (i >> 2) + 4 * n + (i & 3); }

template <bool F8> struct Frag;
template <> struct Frag<false> { bf16x8 k0, k1; DI void set(bf16x8 a, bf16x8 b) { k0 = a; k1 = b; } };
template <> struct Frag<true> { i32x8 w; DI void set(bf16x8 a, bf16x8 b) { w = cat8(a, b); } };
template <class Epi, class Sched, bool ALIGN_EPI = true>
DI void gemm_phase(LAS unsigned char* lds, const Sched& S, const Epi& E, int wid) {
    const int lane = fresh_lane(), tid = wid * 64 + lane, wr = wid >> 2, wc = wid & 3, fr = lane & 15, fq = lane >> 4;
    int RA[2], RB[2], CB[2];
#pragma unroll
    for (int i = 0; i < 2; ++i) { int R, C; stage_rc(tid * 16 + i * 8192, R, C); RA[i] = R; RB[i] = (R & ~31) + perm32(R & 31); CB[i] = C * 2; }
    constexpr size_t kstep = (size_t)(BK * 2);
    const unsigned ldsw = (unsigned)wid * 1024u;
    const int aoff = lds_byte(wr * 64 + fr, fq * 8), boff = lds_byte(wc * 32 + fr, fq * 8);
#define PG8_SA(b, h) (((b) * 2 + (h)) * HTB)
#define PG8_SB(b, h) ((4 + (b) * 2 + (h)) * HTB)
#define PG8_STAGE(bufoff, gbase, v0, v1) do { unsigned o0_ = (v0), o1_ = (v1); asm volatile("" : "+v"(o0_), "+v"(o1_)); \
        __builtin_amdgcn_global_load_lds((const unsigned*)((const char*)(gbase) + o0_), (LAS unsigned*)(lds + (bufoff) + ldsw), 16, 0, 0); \
        __builtin_amdgcn_global_load_lds((const unsigned*)((const char*)(gbase) + o1_), (LAS unsigned*)(lds + (bufoff) + ldsw + 8192), 16, 0, 0); } while (0)
#define PG8_LDA(dst, b, h) do { _Pragma("unroll") for (int m = 0; m < 4; ++m) { const bf16x8 f0_ = *(const LAS bf16x8*)(lds + PG8_SA(b, h) + aoff + m * 2048), f1_ = *(const LAS bf16x8*)(lds + PG8_SA(b, h) + aoff + m * 2048 + 1024); dst[m].set(f0_, f1_); } } while (0)
#define PG8_LDB(dst, b, h) do { _Pragma("unroll") for (int n = 0; n < 2; ++n) { const bf16x8 f0_ = *(const LAS bf16x8*)(lds + PG8_SB(b, h) + boff + n * 2048), f1_ = *(const LAS bf16x8*)(lds + PG8_SB(b, h) + boff + n * 2048 + 1024); dst[n].set(f0_, f1_); } } while (0)
#define PG8_MMA(ai, bj, At, Bt) do { __builtin_amdgcn_s_setprio(1); _Pragma("unroll") for (int m = 0; m < 4; ++m) _Pragma("unroll") for (int n = 0; n < 2; ++n) { \
        if constexpr (Epi::F8) acc[ai][bj][m][n] = __builtin_amdgcn_mfma_scale_f32_16x16x128_f8f6f4(Bt[n].w, At[m].w, acc[ai][bj][m][n], 0, 0, 0, 0x7f7f7f7f, 0, 0x7f7f7f7f); \
        else { acc[ai][bj][m][n] = __builtin_amdgcn_mfma_f32_16x16x32_bf16(Bt[n].k0, At[m].k0, acc[ai][bj][m][n], 0, 0, 0); acc[ai][bj][m][n] = __builtin_amdgcn_mfma_f32_16x16x32_bf16(Bt[n].k1, At[m].k1, acc[ai][bj][m][n], 0, 0, 0); } } \
        __builtin_amdgcn_s_setprio(0); } while (0)
#define PG8_WAIT_V(n) asm volatile("s_waitcnt vmcnt(" #n ")" ::: "memory")
#define PG8_WAIT_L(n) asm volatile("s_waitcnt lgkmcnt(" #n ")" ::: "memory")
#define PG8_BAR __builtin_amdgcn_s_barrier()
#define PG8_SCHED __builtin_amdgcn_sched_barrier(0)
    Unit cur, nxt; int ui = 0;
    if (!S.next(0, cur)) return;
    f32x4 acc[2][2][4][2];
#pragma unroll
    for (int a = 0; a < 2; ++a)
#pragma unroll
        for (int b = 0; b < 2; ++b)
#pragma unroll
            for (int m = 0; m < 4; ++m)
#pragma unroll
                for (int n = 0; n < 2; ++n) acc[a][b][m][n] = (f32x4){0.f, 0.f, 0.f, 0.f};
    Frag<Epi::F8> At[4], B0[2], B1[2];
    const char* cA = cur.A; const char* cB = cur.B;
    const unsigned ld = cur.lda;
    const unsigned plane = cur.ldb;
    const unsigned vA0 = RA[0] * ld + CB[0], vA1 = RA[1] * ld + CB[1];
    const unsigned vB0 = Sched::BK16 ? (unsigned)(CB[0] >> 4) * plane + RB[0] * 16 : RB[0] * ld + CB[0], vB1 = Sched::BK16 ? (unsigned)(CB[1] >> 4) * plane + RB[1] * 16 : RB[1] * ld + CB[1];
    const size_t hA = (size_t)HALF * ld, hB = Sched::BK16 ? (size_t)HALF * 16 : hA;
    const size_t kstepB = Sched::BK16 ? (size_t)8 * plane : kstep;
    PG8_STAGE(PG8_SB(0, 0), cB, vB0, vB1); PG8_STAGE(PG8_SB(0, 1), cB + hB, vB0, vB1); PG8_STAGE(PG8_SA(0, 0), cA, vA0, vA1); PG8_STAGE(PG8_SA(0, 1), cA + hA, vA0, vA1);
    if (wr == 1) PG8_BAR;
    PG8_WAIT_V(2); PG8_BAR;
    PG8_STAGE(PG8_SB(1, 0), cB + kstepB, vB0, vB1); PG8_STAGE(PG8_SA(1, 0), cA + kstep, vA0, vA1); PG8_STAGE(PG8_SB(1, 1), cB + hB + kstepB, vB0, vB1);
    PG8_WAIT_V(6); PG8_BAR;
    for (;;) {
        const bool has_next = S.next(ui + 1, nxt);
        const char* nA = has_next ? nxt.A : cA; const char* nB = has_next ? nxt.B : cB;
        const int nt = cur.nt;
        for (int t = 0; t < nt; t += 2) {
            const bool last = (t == nt - 2);
            const char* a1 = cA + (size_t)(t + 1) * kstep;
            const char* a2 = last ? nA : cA + (size_t)(t + 2) * kstep; const char* b2 = last ? nB : cB + (size_t)(t + 2) * kstepB;
            const char* a3 = a2 + kstep; const char* b3 = b2 + kstepB;
            PG8_LDB(B0, 0, 0); PG8_LDB(B1, 0, 1); PG8_SCHED; PG8_LDA(At, 0, 0); PG8_STAGE(PG8_SA(1, 1), a1 + hA, vA0, vA1);
            PG8_WAIT_V(8); PG8_WAIT_L(0); PG8_BAR; PG8_MMA(0, 0, At, B0); PG8_MMA(0, 1, At, B1); PG8_BAR; PG8_SCHED;
            PG8_LDA(At, 0, 1); PG8_STAGE(PG8_SB(0, 0), b2, vB0, vB1); PG8_STAGE(PG8_SB(0, 1), b2 + hB, vB0, vB1); PG8_STAGE(PG8_SA(0, 0), a2, vA0, vA1);
            PG8_WAIT_V(8); PG8_WAIT_L(0); PG8_BAR; PG8_MMA(1, 0, At, B0); PG8_MMA(1, 1, At, B1); PG8_BAR; PG8_SCHED;
            PG8_LDB(B0, 1, 0); PG8_LDB(B1, 1, 1); PG8_SCHED; PG8_LDA(At, 1, 0); PG8_STAGE(PG8_SA(0, 1), a2 + hA, vA0, vA1);
            PG8_WAIT_V(8); PG8_WAIT_L(0); PG8_BAR; PG8_MMA(0, 0, At, B0); PG8_MMA(0, 1, At, B1); PG8_BAR; PG8_SCHED;
            PG8_LDA(At, 1, 1); PG8_STAGE(PG8_SB(1, 0), b3, vB0, vB1); PG8_STAGE(PG8_SB(1, 1), b3 + hB, vB0, vB1); PG8_STAGE(PG8_SA(1, 0), a3, vA0, vA1);
            PG8_WAIT_V(8); PG8_WAIT_L(0); PG8_BAR; PG8_MMA(1, 0, At, B0); PG8_MMA(1, 1, At, B1); PG8_BAR; PG8_SCHED;
        }
        if constexpr (ALIGN_EPI) { if (wr == 0) PG8_BAR; }
        {
            const int el_ = fresh_lane(); const int fr_ = el_ & 15, fq_ = el_ >> 4;
            if constexpr (Epi::HAS_STATE) {
#pragma unroll
                for (int ai = 0; ai < 2; ++ai) { typename Epi::State st; E.begin(st, cur, ai * HALF + wr * 64 + fr_, wc * 32 + 8 * fq_);
#pragma unroll
                    for (int m = 0; m < 4; ++m) { const int row = ai * HALF + wr * 64 + m * 16 + fr_;
#pragma unroll
                        for (int bj = 0; bj < 2; ++bj) { float v[8];
#pragma unroll
                            for (int j = 0; j < 4; ++j) { v[j] = acc[ai][bj][m][0][j]; v[4 + j] = acc[ai][bj][m][1][j]; }
                            E.store_st(st, m, cur, row, bj * HALF + wc * 32 + 8 * fq_, v); } } }
            } else {
#pragma unroll
            for (int ai = 0; ai < 2; ++ai)
#pragma unroll
                for (int m = 0; m < 4; ++m) { const int row = ai * HALF + wr * 64 + m * 16 + fr_;
                    if constexpr (Epi::PAIR) { float g[8], up[8];
#pragma unroll
                        for (int j = 0; j < 4; ++j) { g[j] = acc[ai][0][m][0][j]; g[4 + j] = acc[ai][0][m][1][j]; up[j] = acc[ai][1][m][0][j]; up[4 + j] = acc[ai][1][m][1][j]; }
                        E.store2(cur, row, wc * 32 + 8 * fq_, g, up); }
                    else {
#pragma unroll
                        for (int bj = 0; bj < 2; ++bj) { float v[8];
#pragma unroll
                            for (int j = 0; j < 4; ++j) { v[j] = acc[ai][bj][m][0][j]; v[4 + j] = acc[ai][bj][m][1][j]; }
                            E.store(cur, row, bj * HALF + wc * 32 + 8 * fq_, v); } } }
            }
        }
        if (!has_next) break;
#pragma unroll
        for (int a = 0; a < 2; ++a)
#pragma unroll
            for (int b = 0; b < 2; ++b)
#pragma unroll
                for (int m = 0; m < 4; ++m)
#pragma unroll
                    for (int n = 0; n < 2; ++n) acc[a][b][m][n] = (f32x4){0.f, 0.f, 0.f, 0.f};
        cur = nxt; cA = nA; cB = nB; ++ui;
        if constexpr (ALIGN_EPI) { if (wr == 1) PG8_BAR; }
    }
    PG8_WAIT_V(0);
    if constexpr (!ALIGN_EPI) { if (wr == 0) PG8_BAR; }
    PG8_BAR;
#undef PG8_SA
#undef PG8_SB
#undef PG8_STAGE
#undef PG8_LDA
#undef PG8_LDB
#undef PG8_MMA
#undef PG8_WAIT_V
#undef PG8_WAIT_L
#undef PG8_BAR
#undef PG8_SCHED
}
}

namespace att {
typedef short bf16x8 __attribute__((ext_vector_type(8)));
typedef short s16x4 __attribute__((ext_vector_type(4)));
typedef float f32x16 __attribute__((ext_vector_type(16)));
typedef float f32x2_t __attribute__((ext_vector_type(2)));
typedef __bf16 bf16x2_t __attribute__((ext_vector_type(2)));
DI unsigned cvtpk(float lo, float hi) { f32x2_t v = {lo, hi}; bf16x2_t b = __builtin_convertvector(v, bf16x2_t); return __builtin_bit_cast(unsigned, b); }
DI int crow(int r, int h) { return (r & 3) + 8 * (r >> 2) + 4 * h; }

template <bool SWA>
DI void attn_phase(const Params& p, int wid_, LAS unsigned char* lds, int G, int c) {
    constexpr int DK = SWA ? 64 : 192, DV = SWA ? 64 : 128, KSTR = DK * 2 + 16, VSTR = 136;
    constexpr int QB = SWA ? 2 : 1;
    constexpr int KB = 64 * KSTR, VB = DV * VSTR, STG = KB + VB;
    constexpr int CPR = DK / 8, NKC = (64 * CPR) / NTHREADS, NVC = (DV * 8) / NTHREADS, NQ = DK / 16, NDV = DV / 32;
    constexpr int LDQ = SWA ? 2048 : 1536, NUNITS = SWA ? 768 : 384;
    static_assert(2 * STG <= 131072, "attention LDS");
    const int tid = (wid_ * 64 + fresh_lane()), lane = tid & 63, wid = wid_, q = lane & 31, hh = lane >> 5;
    const bf16_t* Q = wsp<bf16_t>(p, WS_Q); const bf16_t* KN = wsp<bf16_t>(p, SWA ? WS_KO : WS_KN); const bf16_t* KPE = wsp<bf16_t>(p, WS_KPE);
    const bf16_t* VT = wsp<bf16_t>(p, SWA ? WS_VTO : WS_VT); bf16_t* MIX = wsp<bf16_t>(p, WS_MIX);
    for (int L = c; L < NUNITS; L += G) {
        int rowbase, hk, nt0, nt1, key0a, key0b = 0, kpos0 = 0, qpos0 = 0; bool masked = false;
        if (!SWA) {
            if (L < 256) { const int b = L >> 5, qt = L & 3; hk = (L >> 2) & 7; rowbase = T_CTX + b * 1024 + qt * 256; key0a = T_CTX + b * 1024; nt0 = 16; key0b = T + b * 512; nt1 = 8; }
            else { const int Lc = L - 256, b = Lc >> 3; hk = Lc & 7; rowbase = b * 256; key0a = b * 256; nt0 = 4; nt1 = 0; }
        } else {
            if (L < 512) { const int b = L >> 6, t0 = (L & 15) * 64; hk = (L >> 4) & 3; rowbase = T_CTX + b * 1024 + t0;
                const int lo = max(t0 - 128, 0) & ~63, hi = min((t0 + 192 + 63) & ~63, 1024);
                key0a = T_CTX + b * 1024 + lo; nt0 = (hi - lo) >> 6; kpos0 = lo; qpos0 = t0; masked = true; key0b = T + b * 512; nt1 = 8; }
            else { const int Lc = L - 512, b = Lc >> 4; hk = (Lc >> 2) & 3; rowbase = b * 256 + (Lc & 3) * 64; key0a = b * 256; nt0 = 4; nt1 = 0; }
        }
        const int total = nt0 + nt1;
        const int qrow0 = SWA ? rowbase + q : rowbase + wid * 32 + q;
        const int qhead = SWA ? hk * 8 + wid : hk;
        bf16x8 qf[QB][NQ];
#pragma unroll
        for (int qb = 0; qb < QB; ++qb)
#pragma unroll
            for (int s = 0; s < NQ; ++s) qf[qb][s] = *(const bf16x8*)(Q + (size_t)(qrow0 + 32 * qb) * LDQ + qhead * DK + 16 * s + 8 * hh);
        f32x16 o[QB][NDV];
#pragma unroll
        for (int qb = 0; qb < QB; ++qb)
#pragma unroll
            for (int d = 0; d < NDV; ++d)
#pragma unroll
                for (int r = 0; r < 16; ++r) o[qb][d][r] = 0.f;
        float m[QB], l[QB];
#pragma unroll
        for (int qb = 0; qb < QB; ++qb) { m[qb] = SWA ? p.in[19][qhead] * LOG2E : -1e30f; l[qb] = (SWA && hh == 0) ? 1.f : 0.f; }
        const int qpos = qpos0 + q;
        u32x4 kreg[NKC], vreg[NVC];
#define ATT_LOAD(t_) do { const int tt_ = (t_); const int kb_ = tt_ < nt0 ? key0a + tt_ * 64 : key0b + (tt_ - nt0) * 64; \
            _Pragma("unroll") for (int i = 0; i < NKC; ++i) { const int ch = tid + NTHREADS * i, j = ch / CPR, cc = ch % CPR; \
                const bf16_t* src = SWA ? KN + (size_t)(kb_ + j) * 256 + hk * 64 + cc * 8 : (cc < 16 ? KN + (size_t)(kb_ + j) * 1024 + hk * 128 + cc * 8 : KPE + (size_t)(kb_ + j) * 64 + (cc - 16) * 8); \
                kreg[i] = *(const u32x4*)src; } \
            _Pragma("unroll") for (int i = 0; i < NVC; ++i) { const int ch = tid + NTHREADS * i, dv = ch >> 3, cc = ch & 7; \
                vreg[i] = *(const u32x4*)(VT + (size_t)(hk * DV + dv) * TX + kb_ + cc * 8); } } while (0)
#define ATT_WRITE(buf_) do { LAS unsigned char* Kw = lds + (buf_) * STG; LAS unsigned char* Vw = Kw + KB; \
            _Pragma("unroll") for (int i = 0; i < NKC; ++i) { const int ch = tid + NTHREADS * i, j = ch / CPR, cc = ch % CPR; *(LAS u32x4*)(Kw + j * KSTR + cc * 16) = kreg[i]; } \
            _Pragma("unroll") for (int i = 0; i < NVC; ++i) { const int ch = tid + NTHREADS * i, dv = ch >> 3, cc = ch & 7; \
                *(LAS u32x2*)(Vw + dv * VSTR + cc * 16) = (u32x2){vreg[i].x, vreg[i].y}; *(LAS u32x2*)(Vw + dv * VSTR + cc * 16 + 8) = (u32x2){vreg[i].z, vreg[i].w}; } } while (0)
        ATT_LOAD(0); ATT_WRITE(0);
        __syncthreads();
        for (int t = 0; t < total; ++t) {
            const int buf = t & 1;
            if (t + 1 < total) ATT_LOAD(t + 1);
            const LAS unsigned char* Kl = lds + buf * STG; const LAS unsigned char* Vl = Kl + KB;
#pragma unroll
            for (int qb = 0; qb < QB; ++qb) {
                f32x16 s0, s1;
#pragma unroll
                for (int r = 0; r < 16; ++r) { s0[r] = 0.f; s1[r] = 0.f; }
#pragma unroll
                for (int s = 0; s < NQ; ++s) {
                    const bf16x8 a0 = *(const LAS bf16x8*)(Kl + q * KSTR + (16 * s + 8 * hh) * 2);
                    const bf16x8 a1 = *(const LAS bf16x8*)(Kl + (32 + q) * KSTR + (16 * s + 8 * hh) * 2);
                    s0 = __builtin_amdgcn_mfma_f32_32x32x16_bf16(a0, qf[qb][s], s0, 0, 0, 0);
                    s1 = __builtin_amdgcn_mfma_f32_32x32x16_bf16(a1, qf[qb][s], s1, 0, 0, 0);
                }
                if (SWA && masked && t < nt0) {
                    const int kp = kpos0 + t * 64 - (qpos + 32 * qb);
#pragma unroll
                    for (int r = 0; r < 16; ++r) { const int d0 = kp + crow(r, hh), d1 = d0 + 32;
                        s0[r] = (d0 >= -128 && d0 <= 128) ? s0[r] : -1e30f; s1[r] = (d1 >= -128 && d1 <= 128) ? s1[r] : -1e30f; }
                }
                float tm = fmaxf(s0[0], s1[0]);
#pragma unroll
                for (int r = 1; r < 16; ++r) tm = fmaxf(tm, fmaxf(s0[r], s1[r]));
                tm = fmaxf(tm, __shfl_xor(tm, 32));
                const float mn = fmaxf(m[qb], tm);
                if (!__all(mn == m[qb])) {
                    const float alpha = __builtin_amdgcn_exp2f(m[qb] - mn); m[qb] = mn; l[qb] *= alpha;
#pragma unroll
                    for (int d = 0; d < NDV; ++d)
#pragma unroll
                        for (int r = 0; r < 16; ++r) o[qb][d][r] *= alpha; }
                float ls = 0.f;
#pragma unroll
                for (int r = 0; r < 16; ++r) { s0[r] = __builtin_amdgcn_exp2f(s0[r] - m[qb]); s1[r] = __builtin_amdgcn_exp2f(s1[r] - m[qb]); ls += s0[r] + s1[r]; }
                l[qb] += ls;
                bf16x8 pb[2][2];
#pragma unroll
                for (int s = 0; s < 2; ++s) {
                    u32x4 w0, w1;
                    w0.x = cvtpk(s0[8 * s + 0], s0[8 * s + 1]); w0.y = cvtpk(s0[8 * s + 2], s0[8 * s + 3]); w0.z = cvtpk(s0[8 * s + 4], s0[8 * s + 5]); w0.w = cvtpk(s0[8 * s + 6], s0[8 * s + 7]);
                    w1.x = cvtpk(s1[8 * s + 0], s1[8 * s + 1]); w1.y = cvtpk(s1[8 * s + 2], s1[8 * s + 3]); w1.z = cvtpk(s1[8 * s + 4], s1[8 * s + 5]); w1.w = cvtpk(s1[8 * s + 6], s1[8 * s + 7]);
                    pb[0][s] = __builtin_bit_cast(bf16x8, w0); pb[1][s] = __builtin_bit_cast(bf16x8, w1);
                }
#pragma unroll
                for (int d = 0; d < NDV; ++d)
#pragma unroll
                    for (int blk = 0; blk < 2; ++blk)
#pragma unroll
                        for (int s = 0; s < 2; ++s) {
                            const LAS unsigned char* vp = Vl + (d * 32 + q) * VSTR + (blk * 32 + 16 * s + 4 * hh) * 2;
                            const s16x4 lo = *(const LAS s16x4*)vp, hi = *(const LAS s16x4*)(vp + 16);
                            const bf16x8 a = {lo[0], lo[1], lo[2], lo[3], hi[0], hi[1], hi[2], hi[3]};
                            o[qb][d] = __builtin_amdgcn_mfma_f32_32x32x16_bf16(a, pb[blk][s], o[qb][d], 0, 0, 0);
                        }
                if (QB > 1) __builtin_amdgcn_sched_barrier(0);
            }
            if (t + 1 < total) ATT_WRITE(buf ^ 1);
            __syncthreads();
        }
#undef ATT_LOAD
#undef ATT_WRITE
#pragma unroll
        for (int qb = 0; qb < QB; ++qb) {
            const float inv = 1.f / (l[qb] + __shfl_xor(l[qb], 32));
            bf16_t* orow = MIX + (size_t)(qrow0 + 32 * qb) * 2048 + qhead * DV;
            unsigned char* orow8 = (unsigned char*)MIX + (size_t)(qrow0 + 32 * qb) * 2048 + qhead * DV;
#pragma unroll
            for (int d = 0; d < NDV; ++d)
#pragma unroll
                for (int g = 0; g < 4; ++g) {
                    if (OUT_F8) *(unsigned*)(orow8 + d * 32 + 8 * g + 4 * hh) = pk4_fp8(o[qb][d][4 * g] * inv, o[qb][d][4 * g + 1] * inv, o[qb][d][4 * g + 2] * inv, o[qb][d][4 * g + 3] * inv);
                    else { u32x2 w; w.x = cvtpk(o[qb][d][4 * g] * inv, o[qb][d][4 * g + 1] * inv); w.y = cvtpk(o[qb][d][4 * g + 2] * inv, o[qb][d][4 * g + 3] * inv); *(u32x2*)(orow + d * 32 + 8 * g + 4 * hh) = w; } }
        }
    }
}
}


#ifndef R_PRO
#define R_PRO 1
#endif
#ifndef R_MOE
#define R_MOE 1
#endif
#ifndef R_ATT
#define R_ATT 1
#endif
#ifndef R_ATTM
#define R_ATTM R_ATT
#endif
#ifndef R_ATTS
#define R_ATTS R_ATT
#endif
#ifndef R_GEMM
#define R_GEMM 1
#endif
#ifndef R_THIN
#define R_THIN 1
#endif
#ifndef R_LN1
#define R_LN1 1
#endif
#ifndef R_LN2
#define R_LN2 1
#endif
#ifndef R_TOPK
#define R_TOPK 1
#endif
#define REP(n) for (int _r = 0; _r < (n); ++_r)
#define REPS(n, ...) do { { __VA_ARGS__ } if ((n) > 1) { __VA_ARGS__ } } while (0)
constexpr int LDS_BYTES = 147456, MISC_OFF = 146432;
constexpr int NPH = 20;
#ifndef CVT_WAVES
#define CVT_WAVES 4
#endif
#ifndef BG_MODE
#define BG_MODE 0
#endif
#ifndef BG_SPLIT
#define BG_SPLIT 32768
#endif
#ifndef CVT_IDLE_WAVES
#define CVT_IDLE_WAVES 8
#endif
#ifndef CV_IDLE2
#define CV_IDLE2 10240
#endif
#ifndef CV_IDLE6
#define CV_IDLE6 10240
#endif
constexpr int CV_I2 = CV_IDLE2, CV_I6 = CV_IDLE6, CV_IALL = CV_I2 + 2 * CV_I6;
__global__ void __launch_bounds__(NTHREADS, 2) mega(Params p) {
    extern __shared__ __attribute__((aligned(16))) unsigned char lds[];
    const int G = gridDim.x, c = vcu_of(blockIdx.x, G), wid = __builtin_amdgcn_readfirstlane(threadIdx.x >> 6);
    volatile LAS unsigned* MISC = (volatile LAS unsigned*)((LAS unsigned char*)lds + MISC_OFF);
    if (threadIdx.x < 4) MISC[threadIdx.x] = 0u;
    __syncthreads();
    XcdBarrier bar = xcd_barrier_post((unsigned*)(p.ws + WS_CTL) + CW_BAR, MISC);
    const int lo = p.ph_lo, hi = p.ph_hi;
#define IN(k) (lo <= (k) && (k) < hi)
#ifdef STAMP_A
#define stamps_ (wsp<unsigned long long>(p, WS_DBG + 65536))
#define STAMP(k) do { if (blockIdx.x == 0 && wid == 0 && fresh_lane() == 0) stamps_[k] = __builtin_amdgcn_s_memrealtime(); } while (0)
#else
#define STAMP(k) do { } while (0)
#endif
    STAMP(0); STAMP(23);
#ifndef R_BAR
#define R_BAR 1
#endif
#define SEAM(k) do { if (IN(k) && IN((k) + 1)) { xcd_barrier(bar); if (R_BAR > 1) xcd_barrier(bar); } STAMP((k) + 1); } while (0)
    if (IN(0)) REP(R_PRO) { ph_mod(p, wid, lds); STAMP(21); ph_misc(p, wid); STAMP(22); ph_convert(p, wid, 0, G == 256 ? (BG_MODE ? CV_TOTAL - CV_MOE / 2 : CV_TOTAL - CV_IALL) : CV_TOTAL, blockIdx.x, G, CVT_WAVES);
#ifdef RD_PAT
        ph_readonly<RD_PAT>(p, wid);
#endif
    } SEAM(0);
    if (IN(1)) REP(R_THIN) { ph_modreduce(p, wid); ph_h0(p, wid, lds); } SEAM(1);
    if (IN(2)) { REPS(R_GEMM, SchedInEven S{&p, G, c}; EpiInEven E{&p}; pg8::gemm_phase((LAS unsigned char*)lds, S, E, wid);); if (!BG_MODE && G == 256 && c >= 128) ph_convert(p, wid, CV_TOTAL - CV_IALL, CV_TOTAL - 2 * CV_I6, c - 128, 128, CVT_IDLE_WAVES); } SEAM(2);
    if (IN(3)) REP(R_THIN) { ph_e1(p, wid); } SEAM(3);
    if (IN(4)) REPS(R_GEMM, SchedE2 S{&p, G, c}; EpiE2 E{&p}; pg8::gemm_phase((LAS unsigned char*)lds, S, E, wid);); SEAM(4);
    if (IN(5)) REP(R_ATTM) { att::attn_phase<false>(p, wid, (LAS unsigned char*)lds, G, c); } SEAM(5);
    if (IN(6)) { REPS(R_GEMM, SchedOut S{&p, G, c, 0}; EpiOut E{&p, 0}; pg8::gemm_phase((LAS unsigned char*)lds, S, E, wid);); if (!BG_MODE && G == 256 && c >= 128) ph_convert(p, wid, CV_TOTAL - 2 * CV_I6, CV_TOTAL - CV_I6, c - 128, 128, CVT_IDLE_WAVES); } SEAM(6);
    if (IN(7)) REP(R_LN1) { ph_ln1(p, wid, 0, lds); } SEAM(7);
    if (IN(8)) REP(R_TOPK) { ph_topk(p, wid, lds); } SEAM(8);
    {
        const bool bgm = BG_MODE && G == 256, isbg = bgm && (c & 31) >= 24;
        const int fG = bgm ? 192 : G, fc = bgm ? (c >> 5) * 24 + (c & 31) : c, bgi = (c >> 5) * 8 + (c & 31) - 24;
        if (IN(9)) { if (isbg) ph_convert_moe_bg(p, wid, CV_MOE / 2, CV_MOE / 2 + BG_SPLIT, bgi, 64, 8); else REPS(R_MOE, SchedGU S{&p, fG, fc, 0}; EpiGU E{&p}; pg8::gemm_phase((LAS unsigned char*)lds, S, E, wid);); } SEAM(9);
        if (IN(10)) { if (isbg) ph_convert_moe_bg(p, wid, CV_MOE / 2 + BG_SPLIT, CV_MOE, bgi, 64, 8); else REPS(R_MOE, SchedDown S{&p, fG, fc, 0}; EpiDown E{&p}; pg8::gemm_phase((LAS unsigned char*)lds, S, E, wid);); } SEAM(10);
    }
    if (IN(11)) REP(R_LN2) { ph_ln2(p, wid, 0, lds); } SEAM(11);
    if (IN(12)) REPS(R_GEMM, SchedInOdd S{&p, G, c}; EpiInOdd E{&p}; pg8::gemm_phase((LAS unsigned char*)lds, S, E, wid);); SEAM(12);
    if (IN(13)) REP(R_ATTS) { att::attn_phase<true>(p, wid, (LAS unsigned char*)lds, G, c); } SEAM(13);
    if (IN(14)) { REPS(R_GEMM, SchedOut S{&p, G, c, 1}; EpiOut E{&p, 1}; pg8::gemm_phase((LAS unsigned char*)lds, S, E, wid);); if (!BG_MODE && G == 256 && c >= 128) ph_convert(p, wid, CV_TOTAL - CV_I6, CV_TOTAL, c - 128, 128, CVT_IDLE_WAVES); } SEAM(14);
    if (IN(15)) REP(R_LN1) { ph_ln1(p, wid, 1, lds); } SEAM(15);
    if (IN(16)) REP(R_TOPK) { ph_topk(p, wid, lds); } SEAM(16);
    if (IN(17)) REPS(R_MOE, SchedGU S{&p, G, c, 1}; EpiGU E{&p}; pg8::gemm_phase((LAS unsigned char*)lds, S, E, wid);); SEAM(17);
    if (IN(18)) REPS(R_MOE, SchedDown S{&p, G, c, 1}; EpiDown E{&p}; pg8::gemm_phase((LAS unsigned char*)lds, S, E, wid);); SEAM(18);
    if (IN(19)) REP(R_LN2) { ph_ln2(p, wid, 1, lds); }
#ifdef STAMP_A
    STAMP(20);
    if (blockIdx.x == 0 && wid == 0 && fresh_lane() == 0) {
        asm volatile("s_waitcnt vmcnt(0)" ::: "memory");
        const unsigned long long d = (__hip_atomic_load(&stamps_[STAMP_B], __ATOMIC_RELAXED, __HIP_MEMORY_SCOPE_AGENT) - __hip_atomic_load(&stamps_[STAMP_A], __ATOMIC_RELAXED, __HIP_MEMORY_SCOPE_AGENT)) * 4ull;
        const unsigned long long t0 = __builtin_amdgcn_s_memrealtime();
        while (__builtin_amdgcn_s_memrealtime() - t0 < d) __builtin_amdgcn_s_sleep(8);
    }
#endif
#undef IN
#undef SEAM
}

extern "C" void kernel_launch(void* const* d_in, const int* in_sizes, int n_in, void* d_out, int out_size, void* d_ws, size_t ws_size, hipStream_t stream) {
    static int grid = 0;
    if (grid == 0) {
        if (n_in != 29 || out_size != (int)O_END || ws_size < WS_END) { fprintf(stderr, "kernel_launch: unexpected shapes (n_in %d out %d ws %zu need %zu)\n", n_in, out_size, ws_size, (size_t)WS_END); grid = -1; return; }
        int dev = 0, cus = 0, per_cu = 0;
        if (hipGetDevice(&dev) != hipSuccess || hipDeviceGetAttribute(&cus, hipDeviceAttributeMultiprocessorCount, dev) != hipSuccess) { grid = -1; return; }
        if (hipFuncSetAttribute((const void*)mega, hipFuncAttributeMaxDynamicSharedMemorySize, LDS_BYTES) != hipSuccess) { fprintf(stderr, "hipFuncSetAttribute failed\n"); grid = -1; return; }
        if (hipOccupancyMaxActiveBlocksPerMultiprocessor(&per_cu, (const void*)mega, NTHREADS, LDS_BYTES) != hipSuccess || per_cu < 1) fprintf(stderr, "occupancy query: %d\n", per_cu);
        (void)hipGetLastError();
        grid = cus > 0 ? cus : 256;
    }
    if (grid < 0) return;
    Params p{};
    for (int i = 0; i < 29; ++i) p.in[i] = (const float*)d_in[i];
    p.out = (float*)d_out; p.ws = (unsigned char*)d_ws; p.ph_lo = 0; p.ph_hi = NPH; p.rpb = (T + grid - 1) / grid; p.pad = 0;
    (void)hipMemsetAsync((char*)d_ws + WS_CTL, 0, CTL_BYTES, stream);
    hipLaunchKernelGGL(mega, dim3(grid), dim3(NTHREADS), LDS_BYTES, stream, p);
}
```

```cpp
#include <hip/hip_runtime.h>
#include <cstdio>
#include <cstdint>

constexpr int D = 2048, T_CTX = 4096, T = 12288, TC = 4096, TX = 16384;
constexpr int MODW = 12288, NCOND = 9;
constexpr int NSLOT = 1536, NXS = 16 * NSLOT;
constexpr float DN_ALPHA = 1.41421356237309515f;
constexpr float LOG2E = 1.44269504088896341f;
constexpr float QS_MLA = 0.07216878364870322f * LOG2E;
constexpr float QS_SWA = 0.125f * LOG2E;
constexpr int NTHREADS = 512, NWAVES = 8;
#ifndef MOE_F8
#define MOE_F8 1
#endif
#ifndef OUT_F8
#define OUT_F8 1
#endif
constexpr float GU_WSCALE = 32.f, DN_WSCALE = 64.f, OUT_WSCALE = 64.f;

constexpr size_t O_Y = 0, O_CKV = 25165824, O_KPE = 26214400, O_SK = 26476544, O_SV = 27525120, O_END = 28573696;

constexpr size_t al256(size_t x) { return (x + 255) & ~(size_t)255; }
constexpr size_t WS_CTL = 0, CTL_BYTES = 1u << 20;
constexpr size_t WS_MOD = WS_CTL + CTL_BYTES;
constexpr size_t WS_ROPE = WS_MOD + al256((size_t)2 * 9 * 12288 * 4);
constexpr size_t WS_WINE = WS_ROPE + al256((size_t)2 * 1024 * 32 * 4);
constexpr size_t WS_W2 = WS_WINE + (size_t)2048 * 2048 * 2;
constexpr size_t WS_WOUTE = WS_W2 + (size_t)4608 * 1792 * 2;
constexpr size_t WS_WINO = WS_WOUTE + (size_t)2048 * 2048 * 2;
constexpr size_t WS_WOUTO = WS_WINO + (size_t)2560 * 2048 * 2;
constexpr size_t WS_WGU = WS_WOUTO + (size_t)2048 * 2048 * 2;
constexpr size_t WS_WDN = WS_WGU + (size_t)32 * 4096 * 2048 * 2;
constexpr size_t WS_H = WS_WDN + (size_t)32 * 2048 * 2048 * 2;
constexpr size_t WS_PJ = WS_H + (size_t)T * 2048 * 2;
constexpr size_t WS_ACT2 = WS_PJ + (size_t)T * 1792 * 4;
constexpr size_t WS_KPE = WS_ACT2 + (size_t)TX * 1792 * 2;
constexpr size_t WS_Q = WS_KPE + (size_t)TX * 64 * 2;
constexpr size_t WS_KN = WS_Q + (size_t)T * 2048 * 2;
constexpr size_t WS_VT = WS_KN + (size_t)TX * 1024 * 2;
constexpr size_t WS_VTO = WS_VT + (size_t)1024 * TX * 2;
constexpr size_t WS_KO = WS_VTO + (size_t)256 * TX * 2;
constexpr size_t WS_MIX = WS_KO + (size_t)TX * 256 * 2;
constexpr size_t WS_Y = WS_MIX + (size_t)T * 2048 * 2;
constexpr size_t WS_X1 = WS_Y + (size_t)T * 2048 * 4;
constexpr size_t WS_XL = WS_X1 + (size_t)T * 2048 * 4;
constexpr size_t WS_AFF = WS_XL + (size_t)T * 2048 * 4;
constexpr size_t WS_INV = WS_AFF + (size_t)T * 16 * 4;
constexpr size_t WS_XS = WS_INV + (size_t)T * 16 * 4;
constexpr size_t WS_HID = WS_XS + (size_t)NXS * 2048 * 2;
constexpr size_t WS_YE = WS_HID + (size_t)NXS * 2048 * 2;
constexpr size_t WS_AFFT = WS_YE + (size_t)NXS * 2048 * 2;
constexpr size_t WS_H8 = WS_AFFT + (size_t)T * 16 * 4;
constexpr size_t WS_STAT = WS_H8 + (size_t)T * 2048;
constexpr size_t WS_MODP = WS_STAT + (size_t)T * 8;
constexpr size_t WS_GB = WS_MODP + (size_t)4 * 2 * 9 * 12288 * 4;
constexpr size_t WS_DBG = WS_GB + (size_t)2 * 9 * 2 * 2048 * 4;
constexpr size_t WS_END = WS_DBG + (1u << 20);

typedef unsigned short bf16_t;
typedef float f32x4 __attribute__((ext_vector_type(4)));
typedef unsigned u32x4 __attribute__((ext_vector_type(4)));
typedef unsigned u32x2 __attribute__((ext_vector_type(2)));
typedef float f32x2 __attribute__((ext_vector_type(2)));
#define LAS __attribute__((address_space(3)))
#define DI __device__ __forceinline__

struct Params {
    const float* in[29];
    float* out;
    unsigned char* ws;
    int ph_lo, ph_hi;
    int rpb, pad;
};

DI unsigned f2bf(float f) { unsigned u = __float_as_uint(f); return (u + 0x7fffu + ((u >> 16) & 1u)) >> 16; }
typedef __bf16 bf16x2_hw __attribute__((ext_vector_type(2)));
DI unsigned pk2(float lo, float hi) { f32x2 v = {lo, hi}; bf16x2_hw b = __builtin_convertvector(v, bf16x2_hw); return __builtin_bit_cast(unsigned, b); }
DI unsigned pk4_fp8(float a, float b, float c, float d) { unsigned w = 0; w = __builtin_amdgcn_cvt_pk_fp8_f32(a, b, w, false); w = __builtin_amdgcn_cvt_pk_fp8_f32(c, d, w, true); return w; }
DI float bf2f(unsigned b) { return __uint_as_float(b << 16); }
DI float bflo(unsigned w) { return __uint_as_float(w << 16); }
DI float bfhi(unsigned w) { return __uint_as_float(w & 0xffff0000u); }
DI float wave_sum(float v) {
#pragma unroll
    for (int o = 1; o < 64; o <<= 1) v += __shfl_xor(v, o);
    return v;
}
DI float wave_max(float v) {
#pragma unroll
    for (int o = 1; o < 64; o <<= 1) v = fmaxf(v, __shfl_xor(v, o));
    return v;
}
DI int fresh_lane() { int l = (int)__builtin_amdgcn_mbcnt_hi(~0u, __builtin_amdgcn_mbcnt_lo(~0u, 0u)); asm volatile("" : "+v"(l)); return l; }
DI int cond_of_row(int r) { return r < T_CTX ? 0 : 1 + ((r - T_CTX) >> 10); }
DI const float* xrow_in(const Params& p, int r) { return r < T_CTX ? p.in[0] + (size_t)r * D : p.in[1] + (size_t)(r - T_CTX) * D; }

DI float* ws_mod(const Params& p) { return (float*)(p.ws + WS_MOD); }
DI float* ws_cos(const Params& p) { return (float*)(p.ws + WS_ROPE); }
DI float* ws_sin(const Params& p) { return (float*)(p.ws + WS_ROPE) + 1024 * 32; }
template <class X> DI X* wsp(const Params& p, size_t off) { return (X*)(p.ws + off); }
DI const float* modp(const Params& p, int l, int ci, int j) { return ws_mod(p) + ((size_t)(l * 9 + ci) * MODW + (size_t)j * D); }

#define XB_TMO      128
#define XB_XCNT(j)  (256  + 64 * (j))
#define XB_XSUB(j)  (1280 + 64 * (j))
#define XB_XGEN(j)  (2304 + 64 * (j))
#define XB_TOP      3328
#define XB_TOPGEN   3392
#define XCD_BAR_WORDS 3456
#define XB_SPIN_CAP (1u << 18)

__device__ __forceinline__ unsigned xb_ld(unsigned* p)              { return __hip_atomic_load(p, __ATOMIC_RELAXED, __HIP_MEMORY_SCOPE_AGENT); }
__device__ __forceinline__ unsigned xb_add(unsigned* p, unsigned v) { return __hip_atomic_fetch_add(p, v, __ATOMIC_RELAXED, __HIP_MEMORY_SCOPE_AGENT); }
__device__ __forceinline__ unsigned xb_xcc_id() { return (unsigned)__builtin_amdgcn_s_getreg((3 << 11) | 20) & 0xFu; }
#define XB_SPIN(cond, bar) do { unsigned _sp = 0; while (cond) { __builtin_amdgcn_s_sleep(1); \
    if ((++_sp & 255u) == 0u) { if (xb_ld(&(bar)[XB_TMO])) break; if (_sp > XB_SPIN_CAP) { atomicAdd(&(bar)[XB_TMO], 1u); break; } } } } while (0)

struct XcdBarrier {
    unsigned* bar; unsigned x;
    volatile LAS unsigned* st;
};

__device__ __forceinline__ XcdBarrier xcd_barrier_post(unsigned* bar, volatile LAS unsigned* st) {
    XcdBarrier b; b.bar = bar; b.x = xb_xcc_id(); b.st = st;
    if (threadIdx.x == 0) (void)xb_add(&bar[XB_XCNT(b.x)], 1u);
    return b;
}
__device__ __forceinline__ void xcd_barrier_complete(unsigned* bar, unsigned x, unsigned& nloc, unsigned& nx) {
    const unsigned G = gridDim.x * gridDim.y * gridDim.z;
    unsigned sum, cnt, mine, sp = 0u;
    for (;;) {
        sum = 0u; cnt = 0u; mine = 0u;
#pragma unroll
        for (unsigned j = 0; j < 16; ++j) { const unsigned c = xb_ld(&bar[XB_XCNT(j)]); sum += c; cnt += (c > 0u) ? 1u : 0u; mine = (j == x) ? c : mine; }
        if (sum == G) break;
        __builtin_amdgcn_s_sleep(1);
        if ((++sp & 255u) == 0u) { if (xb_ld(&bar[XB_TMO])) break; if (sp > XB_SPIN_CAP) { atomicAdd(&bar[XB_TMO], 1u); break; } }
    }
    nloc = mine > 0u ? mine : 1u; nx = cnt > 0u ? cnt : 1u;
}

__device__ __forceinline__ void xcd_barrier(const XcdBarrier& b) {
    asm volatile("s_waitcnt vmcnt(0)" ::: "memory");
    __syncthreads();
    if (threadIdx.x == 0) {
        unsigned* bar = b.bar;
        __builtin_amdgcn_s_waitcnt(0);
        unsigned nloc = b.st[0], nx = b.st[1];
        if (nloc == 0u) { xcd_barrier_complete(bar, b.x, nloc, nx); b.st[0] = nloc; b.st[1] = nx; }
        const unsigned old = xb_add(&bar[XB_XSUB(b.x)], 1u);
        const unsigned gen = old / nloc;
        if (old + 1u == (gen + 1u) * nloc) {
            __builtin_amdgcn_fence(__ATOMIC_RELEASE, "agent");
            asm volatile("s_waitcnt vmcnt(0)" ::: "memory");
            const unsigned og = xb_add(&bar[XB_TOP], 1u);
            const unsigned tg = og / nx;
            if (og + 1u == (tg + 1u) * nx) xb_add(&bar[XB_TOPGEN], 1u);
            else XB_SPIN(xb_ld(&bar[XB_TOPGEN]) == tg, bar);
            __builtin_amdgcn_fence(__ATOMIC_ACQUIRE, "agent");
            xb_add(&bar[XB_XGEN(b.x)], 1u);
            asm volatile("s_waitcnt vmcnt(0)" ::: "memory");
        } else {
            XB_SPIN(xb_ld(&bar[XB_XGEN(b.x)]) == gen, bar);
            __builtin_amdgcn_fence(__ATOMIC_ACQUIRE, "agent");
            asm volatile("s_waitcnt vmcnt(0)" ::: "memory");
        }
    }
    __syncthreads();
}
constexpr int CW_BAR = 4096;


DI void ph_mod(const Params& p, int wid_, unsigned char* lds_raw) {
    float* s_q = (float*)lds_raw;
    float* red = s_q + 9 * 512;
    const int tid = (wid_ * 64 + fresh_lane()), lane = tid & 63, wave = wid_;
    const float* c = p.in[6]; const float* c_ctx = p.in[7]; const float* w_ada = p.in[8];
    float* MODP = wsp<float>(p, WS_MODP);
    for (int it = blockIdx.x; it < 384; it += gridDim.x) {
        const int l = it / 192, rem = it % 192, cg = rem >> 2, kq4 = rem & 3;
        for (int i = tid; i < 9 * 512; i += NTHREADS) { const int ci = i >> 9, k = kq4 * 512 + (i & 511); const float v = ci == 0 ? c_ctx[k] : c[(ci - 1) * 2048 + k]; s_q[i] = v / (1.f + expf(-v)); }
        __syncthreads();
        const float* w = w_ada + ((size_t)l * 2048 + kq4 * 512 + wave * 64) * MODW + cg * 256 + 4 * lane;
        float acc[9][4];
#pragma unroll
        for (int ci = 0; ci < 9; ++ci)
#pragma unroll
            for (int j = 0; j < 4; ++j) acc[ci][j] = 0.f;
#pragma unroll 8
        for (int kk = 0; kk < 64; ++kk) {
            const f32x4 wv = __builtin_nontemporal_load((const f32x4*)(w + (size_t)kk * MODW));
#pragma unroll
            for (int ci = 0; ci < 9; ++ci) { const float s = s_q[ci * 512 + wave * 64 + kk];
#pragma unroll
                for (int j = 0; j < 4; ++j) acc[ci][j] += s * wv[j]; }
        }
#pragma unroll
        for (int ci = 0; ci < 9; ++ci) *(f32x4*)(red + (wave * 9 + ci) * 256 + 4 * lane) = (f32x4){acc[ci][0], acc[ci][1], acc[ci][2], acc[ci][3]};
        __syncthreads();
        for (int o = tid; o < 9 * 256; o += NTHREADS) { const int ci = o >> 8, cc = o & 255; float s = 0.f;
#pragma unroll
            for (int w8 = 0; w8 < 8; ++w8) s += red[(w8 * 9 + ci) * 256 + cc];
            MODP[((size_t)(kq4 * 2 + l) * 9 + ci) * MODW + cg * 256 + cc] = s; }
        __syncthreads();
    }
}
DI void ph_modreduce(const Params& p, int wid_) {
    const float* MODP = wsp<float>(p, WS_MODP); float* MOD = ws_mod(p); const float* b_ada = p.in[9];
    const int n4 = 2 * 9 * MODW / 4;
    for (int i = blockIdx.x * NTHREADS + (wid_ * 64 + fresh_lane()); i < n4; i += gridDim.x * NTHREADS) { const int e = i * 4, l = e / (9 * MODW), col = e % MODW;
        f32x4 s = *(const f32x4*)(b_ada + l * MODW + col);
#pragma unroll
        for (int q = 0; q < 4; ++q) s += *(const f32x4*)(MODP + (size_t)q * 2 * 9 * MODW + e);
        *(f32x4*)(MOD + e) = s; }
}
DI f32x4 mod_from_partials(const Params& p, int l, int ci, int j, int col) {
    const float* MODP = wsp<float>(p, WS_MODP); const size_t e = (size_t)(l * 9 + ci) * MODW + (size_t)j * D + col;
    f32x4 s = *(const f32x4*)(p.in[9] + l * MODW + j * D + col);
#pragma unroll
    for (int q = 0; q < 4; ++q) s += *(const f32x4*)(MODP + (size_t)q * 2 * 9 * MODW + e);
    return s;
}

constexpr int CV_INE = 928, CV_UQ = 192, CV_UKV = 128, CV_POOL = 64, CV_OUT = 1024, CV_INO = 1280, CV_MOE = 98304;
constexpr int CV_TOTAL = CV_INE + CV_UQ + CV_UKV + CV_POOL + CV_OUT + CV_INO + CV_OUT + CV_MOE;
DI void cvt_f8_item(const float* src, int N, unsigned char* dst, int nrows, int w, int lane, float scale, int gu_kind) {
    const int nb8 = w & 7, kb16 = w >> 3, n4 = nb8 * 256 + 4 * lane;
    const float* s = src + (size_t)(kb16 * 16) * N + n4;
    f32x4 v[16];
#pragma unroll
    for (int k = 0; k < 16; ++k) v[k] = __builtin_nontemporal_load((const f32x4*)(s + (size_t)k * N));
    const int dr = gu_kind < 0 ? n4 : (n4 >> 7) * 256 + (n4 & 127) + gu_kind * 128;
    u32x4* d = (u32x4*)(dst + ((size_t)kb16 * nrows + dr) * 16);
#pragma unroll
    for (int j = 0; j < 4; ++j) { u32x4 o;
        o.x = pk4_fp8(v[0][j] * scale, v[1][j] * scale, v[2][j] * scale, v[3][j] * scale); o.y = pk4_fp8(v[4][j] * scale, v[5][j] * scale, v[6][j] * scale, v[7][j] * scale);
        o.z = pk4_fp8(v[8][j] * scale, v[9][j] * scale, v[10][j] * scale, v[11][j] * scale); o.w = pk4_fp8(v[12][j] * scale, v[13][j] * scale, v[14][j] * scale, v[15][j] * scale);
        d[j] = o; }
}
DI void cvt_item(const Params& p, int item, int lane) {
    const float* src; bf16_t* dst; int K, N, ldd, nb, kb, map = 0, a = 0;
    if (item < CV_INE) { src = p.in[10]; dst = wsp<bf16_t>(p, WS_WINE); K = 2048; N = 1856; ldd = 2048; nb = item % 29; kb = item / 29; map = 1; }
    else if ((item -= CV_INE) < CV_UQ) { src = p.in[13]; dst = wsp<bf16_t>(p, WS_W2); K = 512; N = 1536; ldd = 1792; nb = item % 24; kb = item / 24; }
    else if ((item -= CV_UQ) < CV_UKV) { src = p.in[14]; dst = wsp<bf16_t>(p, WS_W2); K = 256; N = 2048; ldd = 1792; nb = item % 32; kb = item / 32; map = 2; }
    else if ((item -= CV_UKV) < CV_POOL) { const int g = item >> 4, r = item & 15; src = p.in[15] + (size_t)g * 65536; dst = wsp<bf16_t>(p, WS_W2); K = 256; N = 256; ldd = 1792; nb = r & 3; kb = r >> 2; a = 3584 + g * 256; }
    else if ((item -= CV_POOL) < CV_OUT) { if (OUT_F8) { cvt_f8_item(p.in[17], 2048, wsp<unsigned char>(p, WS_WOUTE), 2048, item, lane, OUT_WSCALE, -1); return; } src = p.in[17]; dst = wsp<bf16_t>(p, WS_WOUTE); K = 2048; N = 2048; ldd = 2048; nb = item & 31; kb = item >> 5; }
    else if ((item -= CV_OUT) < CV_INO) { src = p.in[18]; dst = wsp<bf16_t>(p, WS_WINO); K = 2048; N = 2560; ldd = 2048; nb = item % 40; kb = item / 40; }
    else if ((item -= CV_INO) < CV_OUT) { if (OUT_F8) { cvt_f8_item(p.in[20], 2048, wsp<unsigned char>(p, WS_WOUTO), 2048, item, lane, OUT_WSCALE, -1); return; } src = p.in[20]; dst = wsp<bf16_t>(p, WS_WOUTO); K = 2048; N = 2048; ldd = 2048; nb = item & 31; kb = item >> 5; }
    else { item -= CV_OUT; const int mat = item >> 10, w = item & 1023, le = mat / 3, kind = mat % 3; K = 2048; N = 2048; ldd = 2048; nb = w & 31; kb = w >> 5;
        src = p.in[24 + kind] + (size_t)le * 2048 * 2048;
        if (MOE_F8) { if (kind == 2) cvt_f8_item(src, 2048, wsp<unsigned char>(p, WS_WDN) + (size_t)le * 2048 * 2048, 2048, w, lane, DN_WSCALE, -1);
            else cvt_f8_item(src, 2048, wsp<unsigned char>(p, WS_WGU) + (size_t)le * 4096 * 2048, 4096, w, lane, GU_WSCALE, kind); return; }
        if (kind == 2) dst = wsp<bf16_t>(p, WS_WDN) + (size_t)le * 2048 * 2048; else { dst = wsp<bf16_t>(p, WS_WGU) + (size_t)le * 4096 * 2048; map = 3; a = kind * 128; } }
    const int n = nb * 64 + lane;
    const float* s = src + (size_t)(kb * 64) * N + n;
    float v[64];
#pragma unroll
    for (int k = 0; k < 64; ++k) v[k] = __builtin_nontemporal_load(s + (size_t)k * N);
    int drow;
    if (map == 0) drow = n + a;
    else if (map == 1) drow = n < 768 ? n : (n < 832 ? 1792 + (n - 768) : 768 + (n - 832));
    else if (map == 2) { const int h = n >> 8, j = n & 255; drow = j < 128 ? 1536 + h * 128 + j : 2560 + h * 128 + (j - 128); }
    else drow = (n >> 7) * 256 + (n & 127) + a;
    u32x4* d = (u32x4*)(dst + (size_t)drow * ldd + kb * 64);
#pragma unroll
    for (int c8 = 0; c8 < 8; ++c8) { u32x4 o; o.x = pk2(v[8 * c8], v[8 * c8 + 1]); o.y = pk2(v[8 * c8 + 2], v[8 * c8 + 3]); o.z = pk2(v[8 * c8 + 4], v[8 * c8 + 5]); o.w = pk2(v[8 * c8 + 6], v[8 * c8 + 7]); d[c8] = o; }
}
DI void ph_convert(const Params& p, int wid_, int item_lo, int item_hi, int bid, int nblk, int nwv) {
    const int wv_ = wid_; if (wv_ >= nwv) return;
    const int lane = (wid_ * 64 + fresh_lane()) & 63, gw = bid * nwv + wv_, NGW = nblk * nwv;
    for (int it = item_lo + gw; it < item_hi; it += NGW) cvt_item(p, it, lane);
}

DI void moe_f8_addr(const Params& p, int item, int lane, const float*& s, u32x4*& d, float& scale) {
    const int mat = item >> 10, w = item & 1023, le = mat / 3, kind = mat % 3, nb8 = w & 7, kb16 = w >> 3, n4 = nb8 * 256 + 4 * lane;
    s = p.in[24 + kind] + (size_t)le * 2048 * 2048 + (size_t)(kb16 * 16) * 2048 + n4;
    const int nrows = kind == 2 ? 2048 : 4096, dr = kind == 2 ? n4 : (n4 >> 7) * 256 + (n4 & 127) + kind * 128;
    unsigned char* base = kind == 2 ? wsp<unsigned char>(p, WS_WDN) + (size_t)le * 2048 * 2048 : wsp<unsigned char>(p, WS_WGU) + (size_t)le * 4096 * 2048;
    d = (u32x4*)(base + ((size_t)kb16 * nrows + dr) * 16); scale = kind == 2 ? DN_WSCALE : GU_WSCALE;
}
DI void ph_convert_moe_bg(const Params& p, int wid_, int moe_lo, int moe_hi, int bid, int nblk, int nwv) {
    if (wid_ >= nwv) return;
    const int lane = fresh_lane(), NGW = nblk * nwv; int it = moe_lo + bid * nwv + wid_;
    if (it >= moe_hi) return;
    const float* s; u32x4* d; float sc; f32x4 v[16], vn[16];
    moe_f8_addr(p, it, lane, s, d, sc);
#pragma unroll
    for (int k = 0; k < 16; ++k) v[k] = __builtin_nontemporal_load((const f32x4*)(s + (size_t)k * 2048));
    for (;;) {
        const int itn = it + NGW; const bool more = itn < moe_hi; const float* sn = s; u32x4* dn = d; float scn = sc;
        if (more) { moe_f8_addr(p, itn, lane, sn, dn, scn);
#pragma unroll
            for (int k = 0; k < 16; ++k) vn[k] = __builtin_nontemporal_load((const f32x4*)(sn + (size_t)k * 2048)); }
#pragma unroll
        for (int j = 0; j < 4; ++j) { u32x4 o;
            o.x = pk4_fp8(v[0][j] * sc, v[1][j] * sc, v[2][j] * sc, v[3][j] * sc); o.y = pk4_fp8(v[4][j] * sc, v[5][j] * sc, v[6][j] * sc, v[7][j] * sc);
            o.z = pk4_fp8(v[8][j] * sc, v[9][j] * sc, v[10][j] * sc, v[11][j] * sc); o.w = pk4_fp8(v[12][j] * sc, v[13][j] * sc, v[14][j] * sc, v[15][j] * sc);
            d[j] = o; }
        if (!more) break;
        it = itn; d = dn; sc = scn; s = sn;
#pragma unroll
        for (int k = 0; k < 16; ++k) v[k] = vn[k];
    }
}

DI void ph_misc(const Params& p, int wid_) {
    const size_t gt = (size_t)blockIdx.x * NTHREADS + (wid_ * 64 + fresh_lane()), NGT = (size_t)gridDim.x * NTHREADS;
    float* cosT = ws_cos(p); float* sinT = ws_sin(p);
    for (size_t i = gt; i < 1024 * 32; i += NGT) { const int s = (int)(i >> 5), f = (int)(i & 31);
        const float inv = powf(10000.f, -(float)(f & 15) / 16.f); const float pos = f < 16 ? (float)(s >> 6) : (float)(s & 63); const float ang = pos * inv;
        cosT[i] = cosf(ang); sinT[i] = sinf(ang); }
    bf16_t* ACT2 = wsp<bf16_t>(p, WS_ACT2); bf16_t* KPE = wsp<bf16_t>(p, WS_KPE); bf16_t* KO = wsp<bf16_t>(p, WS_KO); bf16_t* VTO = wsp<bf16_t>(p, WS_VTO);
    const float* cckv = p.in[2]; const float* ckpe = p.in[3]; const float* csk = p.in[4]; const float* csv = p.in[5];
    for (size_t i = gt; i < (size_t)TC * 256 / 4; i += NGT) { const size_t e = i * 4; const int j = (int)(e >> 8), cc = (int)(e & 255); const f32x4 v = *(const f32x4*)(cckv + e);
        u32x2 o; o.x = pk2(v[0], v[1]); o.y = pk2(v[2], v[3]); *(u32x2*)(ACT2 + (size_t)(T + j) * 1792 + 512 + cc) = o;
        const f32x4 k = *(const f32x4*)(csk + e); u32x2 o2; o2.x = pk2(k[0], k[1]); o2.y = pk2(k[2], k[3]); *(u32x2*)(KO + (size_t)(T + j) * 256 + cc) = o2; }
    for (size_t i = gt; i < (size_t)TC * 64 / 4; i += NGT) { const size_t e = i * 4; const f32x4 v = *(const f32x4*)(ckpe + e); u32x2 o; o.x = pk2(v[0], v[1]); o.y = pk2(v[2], v[3]); *(u32x2*)(KPE + (size_t)T * 64 + e) = o; }
    for (size_t i = gt; i < (size_t)256 * (TC / 8); i += NGT) { const int f = (int)(i / (TC / 8)), j8 = (int)(i % (TC / 8)) * 8; float v[8];
#pragma unroll
        for (int q = 0; q < 8; ++q) v[q] = csv[(size_t)(j8 + q) * 256 + f];
        u32x4 o; o.x = pk2(v[0], v[1]); o.y = pk2(v[2], v[3]); o.z = pk2(v[4], v[5]); o.w = pk2(v[6], v[7]); *(u32x4*)(VTO + (size_t)f * TX + T + j8) = o; }
}

DI void ph_h0(const Params& p, int wid_, unsigned char* lds_raw) {
    const int tid = (wid_ * 64 + fresh_lane()), lane = tid & 63, wv = wid_;
    const int rpb = p.rpb, rb0 = blockIdx.x * rpb, rb1 = min(rb0 + rpb, T);
    if (rb0 >= T) return;
    LAS float* P = (LAS float*)lds_raw;
    const int c_lo = cond_of_row(rb0);
    for (int i = tid; i < 2 * 2 * 512; i += NTHREADS) { const int cc = i >> 10, j = (i >> 9) & 1, col = (i & 511) * 4; const int ci = min(c_lo + cc, 8);
        *(LAS f32x4*)(P + (cc * 2 + j) * 2048 + col) = mod_from_partials(p, 0, ci, j, col); }
    __syncthreads();
    bf16_t* H = wsp<bf16_t>(p, WS_H);
    f32x4 v[8], vn[8]; int r = rb0 + wv;
    if (r < rb1) { const float* x = xrow_in(p, r) + lane * 8;
#pragma unroll
        for (int j = 0; j < 4; ++j) { v[2 * j] = __builtin_nontemporal_load((const f32x4*)(x + 512 * j)); v[2 * j + 1] = __builtin_nontemporal_load((const f32x4*)(x + 512 * j + 4)); } }
    for (; r < rb1; r += NWAVES) {
        const int rn = r + NWAVES;
        if (rn < rb1) { const float* x = xrow_in(p, rn) + lane * 8;
#pragma unroll
            for (int j = 0; j < 4; ++j) { vn[2 * j] = __builtin_nontemporal_load((const f32x4*)(x + 512 * j)); vn[2 * j + 1] = __builtin_nontemporal_load((const f32x4*)(x + 512 * j + 4)); } }
        asm volatile("" ::: "memory");
        const LAS float* sh = P + (cond_of_row(r) - c_lo) * 4096; const LAS float* sc = sh + 2048;
#pragma unroll
        for (int j = 0; j < 4; ++j) { const int c0 = lane * 8 + 512 * j;
            const f32x4 h0 = v[2 * j] * (1.f + *(const LAS f32x4*)(sc + c0)) + *(const LAS f32x4*)(sh + c0), h1 = v[2 * j + 1] * (1.f + *(const LAS f32x4*)(sc + c0 + 4)) + *(const LAS f32x4*)(sh + c0 + 4);
            u32x4 o; o.x = pk2(h0[0], h0[1]); o.y = pk2(h0[2], h0[3]); o.z = pk2(h1[0], h1[1]); o.w = pk2(h1[2], h1[3]); *(u32x4*)(H + (size_t)r * D + c0) = o; }
#pragma unroll
        for (int j = 0; j < 8; ++j) v[j] = vn[j];
    }
}

DI void ph_gb(const Params& p, int wid_) {
    float* GB = wsp<float>(p, WS_GB);
    for (int i = blockIdx.x * NTHREADS + (wid_ * 64 + fresh_lane()); i < 2 * 9 * 512; i += gridDim.x * NTHREADS) { const int l = i / (9 * 512), ci = (i / 512) % 9, col = (i & 511) * 4;
        const f32x4 g = *(const f32x4*)(p.in[21] + l * D + col), b = *(const f32x4*)(p.in[22] + l * D + col), sh = *(const f32x4*)(modp(p, l, ci, 3) + col), sc = *(const f32x4*)(modp(p, l, ci, 4) + col);
        *(f32x4*)(GB + ((size_t)(l * 9 + ci) * 2 + 0) * D + col) = g * (1.f + sc); *(f32x4*)(GB + ((size_t)(l * 9 + ci) * 2 + 1) * D + col) = b * (1.f + sc) + sh; }
}
struct E1Row { f32x4 cq[2], ckv, u[4], ad[4], sb[4]; };
DI void e1_seq(int r, int& s, int& S, int& rb) { if (r < T_CTX) { s = r & 255; S = 256; } else { s = (r - T_CTX) & 1023; S = 1024; } rb = r - s; }
DI void e1_load(const float* PJ, int r, int lane, E1Row& L) {
    const float* pr = PJ + (size_t)r * 1792; int s, S, rb; e1_seq(r, s, S, rb);
    L.cq[0] = *(const f32x4*)(pr + lane * 4); L.cq[1] = *(const f32x4*)(pr + lane * 4 + 256); L.ckv = *(const f32x4*)(pr + 512 + lane * 4);
#pragma unroll
    for (int g = 0; g < 4; ++g) { const int half = 1 << g, c0 = 768 + g * 256 + lane * 4; const int ia = s + half - 1, ib = s - half - 1;
        L.u[g] = *(const f32x4*)(pr + c0);
        const float ma = ia < S ? 1.f : 0.f, mb = ib >= 0 ? 1.f : 0.f;
        L.ad[g] = *(const f32x4*)(PJ + (size_t)(rb + min(ia, S - 1)) * 1792 + c0) * ma; L.sb[g] = *(const f32x4*)(PJ + (size_t)(rb + max(ib, 0)) * 1792 + c0) * mb; }
}
DI void e1_window_before(const float* PJ, int r, int lane, f32x4 (&wsum)[4]) {
    int s, S, rb; e1_seq(r, s, S, rb);
#pragma unroll
    for (int g = 0; g < 4; ++g) { const int half = 1 << g, c0 = 768 + g * 256 + lane * 4; const int lo = max(s - 1 - half, 0), hi = min(s - 1 + half, S);
        f32x4 sum = {0.f, 0.f, 0.f, 0.f};
        for (int t = lo; t < hi; ++t) sum += *(const f32x4*)(PJ + (size_t)(rb + t) * 1792 + c0);
        wsum[g] = sum; }
}
DI void ph_e1(const Params& p, int wid_) {
    ph_gb(p, wid_);
    const int lane = fresh_lane();
    const int rpw = (p.rpb + NWAVES - 1) / NWAVES, rb0 = blockIdx.x * p.rpb, ra = rb0 + wid_ * rpw, rz = min(min(ra + rpw, rb0 + p.rpb), T);
    if (ra >= rz) return;
    const float* PJ = wsp<float>(p, WS_PJ); bf16_t* ACT2 = wsp<bf16_t>(p, WS_ACT2);
    const float* qn = p.in[11]; const float* kvn = p.in[12];
    const f32x4 gq0 = *(const f32x4*)(qn + lane * 4), gq1 = *(const f32x4*)(qn + lane * 4 + 256), gkv = *(const f32x4*)(kvn + lane * 4);
    f32x4 wsum[4]; E1Row A, B;
    e1_load(PJ, ra, lane, A);
    e1_window_before(PJ, ra, lane, wsum);
    for (int r = ra; r < rz; ++r) {
        if (r + 1 < rz) e1_load(PJ, r + 1, lane, B);
        bf16_t* ar = ACT2 + (size_t)r * 1792; int s, S, rb; e1_seq(r, s, S, rb);
        if (s == 0 && r != ra) e1_window_before(PJ, r, lane, wsum);
        {
            const float ss = ((A.cq[0][0] * A.cq[0][0] + A.cq[0][1] * A.cq[0][1]) + (A.cq[0][2] * A.cq[0][2] + A.cq[0][3] * A.cq[0][3])) + ((A.cq[1][0] * A.cq[1][0] + A.cq[1][1] * A.cq[1][1]) + (A.cq[1][2] * A.cq[1][2] + A.cq[1][3] * A.cq[1][3]));
            const float rs = rsqrtf(wave_sum(ss) * (1.f / 512.f) + 1e-6f);
            const f32x4 y0 = A.cq[0] * rs * gq0, y1 = A.cq[1] * rs * gq1;
            u32x2 o; o.x = pk2(y0[0], y0[1]); o.y = pk2(y0[2], y0[3]); *(u32x2*)(ar + lane * 4) = o; o.x = pk2(y1[0], y1[1]); o.y = pk2(y1[2], y1[3]); *(u32x2*)(ar + lane * 4 + 256) = o;
        }
        {
            const int c0 = lane * 4; const f32x4 v = A.ckv; const float ss = (v[0] * v[0] + v[1] * v[1]) + (v[2] * v[2] + v[3] * v[3]);
            const float rs = rsqrtf(wave_sum(ss) * (1.f / 256.f) + 1e-6f); const f32x4 y = v * rs * gkv;
            u32x2 o; o.x = pk2(y[0], y[1]); o.y = pk2(y[2], y[3]); *(u32x2*)(ar + 512 + c0) = o;
            if (r < T_CTX) *(f32x4*)(p.out + O_CKV + (size_t)r * 256 + c0) = y;
        }
#pragma unroll
        for (int g = 0; g < 4; ++g) {
            const int half = 1 << g; const int lo = max(s - half, 0), hi = min(s + half, S); const int c0 = 768 + g * 256 + lane * 4;
            wsum[g] = wsum[g] + A.ad[g] - A.sb[g];
            const f32x4 y = wsum[g] * __builtin_amdgcn_rcpf((float)(hi - lo)) - A.u[g];
            u32x2 o; o.x = pk2(y[0], y[1]); o.y = pk2(y[2], y[3]); *(u32x2*)(ar + c0) = o; }
        A = B;
    }
}

DI void ph_ln1(const Params& p, int wid_, int l, unsigned char* lds_raw) {
    const int tid = (wid_ * 64 + fresh_lane()), lane = tid & 63, gw = blockIdx.x * NWAVES + wid_, NGW = gridDim.x * NWAVES;
    float* wT = (float*)lds_raw;
    const float* wr = p.in[23] + (size_t)l * 2048 * 16;
    for (int d = tid; d < 2048; d += NTHREADS) {
        const f32x4 w0 = *(const f32x4*)(wr + d * 16), w1 = *(const f32x4*)(wr + d * 16 + 4), w2 = *(const f32x4*)(wr + d * 16 + 8), w3 = *(const f32x4*)(wr + d * 16 + 12);
        const int dj = d >> 9, dl = (d & 511) >> 3, dq = (d >> 2) & 1, dc = d & 3, di = ((dj * 2 + dq) * 64 + dl) * 4 + dc;
#pragma unroll
        for (int e = 0; e < 4; ++e) { wT[e * 2048 + di] = w0[e]; wT[(4 + e) * 2048 + di] = w1[e]; wT[(8 + e) * 2048 + di] = w2[e]; wT[(12 + e) * 2048 + di] = w3[e]; } }
    __syncthreads();
    const float* Y = wsp<float>(p, WS_Y); float* STAT = wsp<float>(p, WS_STAT); bf16_t* H = wsp<bf16_t>(p, WS_H); float* AFF = wsp<float>(p, WS_AFF); float* AFFT = wsp<float>(p, WS_AFFT);
    unsigned char* H8 = wsp<unsigned char>(p, WS_H8);
    const float* lg = p.in[21] + l * D; const float* lb = p.in[22] + l * D;
    f32x4 v[8], vn[8], gg[8], gb[8];
    int r = gw;
#define LN1_LOAD(dst, rr) do { if ((rr) < T) { _Pragma("unroll") for (int j = 0; j < 4; ++j) { const float* y = Y + (size_t)(rr) * D + lane * 8 + 512 * j; dst[2 * j] = *(const f32x4*)y; dst[2 * j + 1] = *(const f32x4*)(y + 4); } } } while (0)
    LN1_LOAD(v, r);
    for (; r < T; r += NGW) {
        LN1_LOAD(vn, r + NGW);
        const int ci = cond_of_row(r); const float* gv = wsp<float>(p, WS_GB) + (size_t)(l * 9 + ci) * 2 * D; const float* bv = gv + D;
#pragma unroll
        for (int j = 0; j < 8; ++j) { const int cc = lane * 8 + 512 * (j >> 1) + 4 * (j & 1); gg[j] = *(const f32x4*)(gv + cc); gb[j] = *(const f32x4*)(bv + cc); }
        float s = 0.f;
#pragma unroll
        for (int j = 0; j < 8; ++j) s += (v[j][0] + v[j][1]) + (v[j][2] + v[j][3]);
        const float mean = wave_sum(s) * (1.f / D); float s2 = 0.f;
#pragma unroll
        for (int j = 0; j < 8; ++j) { v[j] = v[j] - mean; s2 += (v[j][0] * v[j][0] + v[j][1] * v[j][1]) + (v[j][2] * v[j][2] + v[j][3] * v[j][3]); }
        const float rstd = rsqrtf(wave_sum(s2) * (1.f / D) + 1e-5f);
#pragma unroll
        for (int j = 0; j < 4; ++j) { const int c0 = lane * 8 + 512 * j;
#pragma unroll
            for (int q = 0; q < 2; ++q) { const int cc = c0 + 4 * q; v[2 * j + q] = v[2 * j + q] * rstd * gg[2 * j + q] + gb[2 * j + q]; (void)cc; }
            const f32x4 a = v[2 * j], b = v[2 * j + 1];
            if (!MOE_F8) { u32x4 o; o.x = pk2(a[0], a[1]); o.y = pk2(a[2], a[3]); o.z = pk2(b[0], b[1]); o.w = pk2(b[2], b[3]); *(u32x4*)(H + (size_t)r * D + c0) = o; }
            u32x2 o8; o8.x = pk4_fp8(a[0], a[1], a[2], a[3]); o8.y = pk4_fp8(b[0], b[1], b[2], b[3]); *(u32x2*)(H8 + (size_t)r * D + c0) = o8; }
        float pa[16];
#ifdef PROBE_ROUTER2
#pragma unroll
        for (int e = 0; e < 16; ++e) { float a = 0.f; if ((e & 1) == 0) asm volatile("" ::: "memory");
#pragma unroll
            for (int j = 0; j < 4; ++j) { const float* wp = wT + e * 2048 + j * 512 + lane * 4; const f32x4 w0 = *(const f32x4*)wp, w1 = *(const f32x4*)(wp + 256); const f32x4 h0 = v[2 * j], h1 = v[2 * j + 1];
                a += ((h0[0] * w0[0] + h0[1] * w0[1]) + (h0[2] * w0[2] + h0[3] * w0[3])) + ((h1[0] * w1[0] + h1[1] * w1[1]) + (h1[2] * w1[2] + h1[3] * w1[3])); }
            asm volatile("" :: "v"(a)); }
#endif
#pragma unroll
        for (int e = 0; e < 16; ++e) { float a = 0.f; if ((e & 1) == 0) asm volatile("" ::: "memory");
#pragma unroll
            for (int j = 0; j < 4; ++j) { const float* wp = wT + e * 2048 + j * 512 + lane * 4; const f32x4 w0 = *(const f32x4*)wp, w1 = *(const f32x4*)(wp + 256); const f32x4 h0 = v[2 * j], h1 = v[2 * j + 1];
                a += ((h0[0] * w0[0] + h0[1] * w0[1]) + (h0[2] * w0[2] + h0[3] * w0[3])) + ((h1[0] * w1[0] + h1[1] * w1[1]) + (h1[2] * w1[2] + h1[3] * w1[3])); }
            pa[e] = a; }
        float pb[8], pc[4], pd[2];
        { const bool hi = (lane & 32) != 0;
#pragma unroll
          for (int e = 0; e < 8; ++e) { const float keep = hi ? pa[e + 8] : pa[e], send = hi ? pa[e] : pa[e + 8]; pb[e] = keep + __shfl_xor(send, 32); } }
        { const bool hi = (lane & 16) != 0;
#pragma unroll
          for (int e = 0; e < 4; ++e) { const float keep = hi ? pb[e + 4] : pb[e], send = hi ? pb[e] : pb[e + 4]; pc[e] = keep + __shfl_xor(send, 16); } }
        { const bool hi = (lane & 8) != 0;
#pragma unroll
          for (int e = 0; e < 2; ++e) { const float keep = hi ? pc[e + 2] : pc[e], send = hi ? pc[e] : pc[e + 2]; pd[e] = keep + __shfl_xor(send, 8); } }
        float mine; { const bool hi = (lane & 4) != 0; const float keep = hi ? pd[1] : pd[0], send = hi ? pd[0] : pd[1]; mine = keep + __shfl_xor(send, 4); }
        mine += __shfl_xor(mine, 2); mine += __shfl_xor(mine, 1);
        const int myexp = ((lane >> 5) & 1) * 8 + ((lane >> 4) & 1) * 4 + ((lane >> 3) & 1) * 2 + ((lane >> 2) & 1);
        const float m = wave_max(mine);
        const float ex = expf(mine - m);
        const float den = wave_sum(ex) * 0.25f;
        if ((lane & 3) == 0) { const float af = ex / den; AFF[(size_t)r * 16 + myexp] = af; AFFT[(size_t)myexp * T + r] = af; }
        if (lane == 0) *(f32x2*)(STAT + 2 * (size_t)r) = (f32x2){mean, rstd};
#pragma unroll
        for (int j = 0; j < 8; ++j) v[j] = vn[j];
    }
#undef LN1_LOAD
}

DI int wave_incl_scan(int v, int lane) {
#pragma unroll
    for (int o = 1; o < 64; o <<= 1) { const int u = __shfl_up(v, o); v += lane >= o ? u : 0; }
    return v;
}
DI int block_excl_scan2(int a0, int a1, int tid, int lane, int wave, int* wsum) {
    const int s = a0 + a1, incl = wave_incl_scan(s, lane);
    if (lane == 63) wsum[wave] = incl;
    __syncthreads();
    int base = 0;
#pragma unroll
    for (int w = 0; w < NWAVES; ++w) base += w < wave ? wsum[w] : 0;
    __syncthreads();
    return base + incl - s;
}
DI void ph_topk(const Params& p, int wid_, unsigned char* lds_raw) {
    const int tid = (wid_ * 64 + fresh_lane()), lane = tid & 63, wave = wid_;
    unsigned* vb = (unsigned*)lds_raw;
    int* hist = (int*)(vb + 1024);
    int* wsum = hist + 256;
    int* ctl = wsum + 16;
    int* selrow = ctl + 4;
    int* selslot = selrow + 128;
    int* nsel = selslot + 128;
    const float* AFFT = wsp<float>(p, WS_AFFT); int* INV = wsp<int>(p, WS_INV); const bf16_t* H = wsp<bf16_t>(p, WS_H); const unsigned char* H8 = wsp<unsigned char>(p, WS_H8); bf16_t* XS = wsp<bf16_t>(p, WS_XS);
    for (int it = blockIdx.x; it < 384; it += gridDim.x) {
        int n, cap, r0, e, sb;
        if (it < 128) { const int b = it >> 4; e = it & 15; n = 1024; cap = 128; r0 = T_CTX + b * 1024; sb = 512 + b * 128; }
        else { const int li = it - 128, b = li >> 4; e = li & 15; n = 256; cap = 32; r0 = b * 256; sb = b * 32; }
        const int i0 = 2 * tid, i1 = 2 * tid + 1;
        unsigned b0 = 0u, b1 = 0u;
        if (i0 < n) { const f32x2 a = *(const f32x2*)(AFFT + (size_t)e * T + r0 + i0); b0 = __float_as_uint(a[0]); b1 = __float_as_uint(a[1]); vb[i0] = b0; vb[i1] = b1; }
        if (tid == 0) *nsel = 0;
        unsigned prefix = 0u; int need = cap;
#pragma unroll
        for (int pass = 0; pass < 4; ++pass) { const int shift = 24 - 8 * pass;
            if (tid < 256) hist[tid] = 0;
            __syncthreads();
            if (i0 < n) { const bool m0 = pass == 0 || (b0 >> (shift + 8)) == prefix, m1 = pass == 0 || (b1 >> (shift + 8)) == prefix;
                if (m0) atomicAdd(&hist[(b0 >> shift) & 255u], 1); if (m1) atomicAdd(&hist[(b1 >> shift) & 255u], 1); }
            __syncthreads();
            if (wave == 0) { int h4[4], s = 0;
#pragma unroll
                for (int j = 0; j < 4; ++j) { h4[j] = hist[255 - (4 * lane + j)]; s += h4[j]; }
                const int incl = wave_incl_scan(s, lane), excl = incl - s;
                if (excl < need && need <= incl) { int cum = excl, bin = 0, nn = need; bool done = false;
#pragma unroll
                    for (int j = 0; j < 4; ++j) { if (!done) { if (cum + h4[j] >= need) { bin = 255 - (4 * lane + j); nn = need - cum; done = true; } else cum += h4[j]; } }
                    ctl[0] = bin; ctl[1] = nn; } }
            __syncthreads();
            prefix = (prefix << 8) | (unsigned)ctl[0]; need = ctl[1];
        }
        const int g0 = (i0 < n && b0 > prefix) ? 1 : 0, g1 = (i0 < n && b1 > prefix) ? 1 : 0, q0 = (i0 < n && b0 == prefix) ? 1 : 0, q1 = (i0 < n && b1 == prefix) ? 1 : 0;
        const int eqb = block_excl_scan2(q0, q1, tid, lane, wave, wsum);
        const int s0 = g0 | (q0 & (eqb < need ? 1 : 0)), s1 = g1 | (q1 & (eqb + q0 < need ? 1 : 0));
        const int slb = block_excl_scan2(s0, s1, tid, lane, wave, wsum);
        if (i0 < n) {
            INV[(size_t)(r0 + i0) * 16 + e] = s0 ? sb + slb : -1; INV[(size_t)(r0 + i1) * 16 + e] = s1 ? sb + slb + s0 : -1;
            if (s0) { const int pos = atomicAdd(nsel, 1); selrow[pos] = i0; selslot[pos] = slb; }
            if (s1) { const int pos = atomicAdd(nsel, 1); selrow[pos] = i1; selslot[pos] = slb + s0; } }
        __syncthreads();
        const int ns = *nsel;
        for (int k0 = wave; k0 < ns; k0 += 4 * NWAVES) {
            if (MOE_F8) { u32x4 bufr[4][2];
#pragma unroll
                for (int b = 0; b < 4; ++b) { const int k = k0 + NWAVES * b; if (k < ns) { const u32x4* src = (const u32x4*)(H8 + (size_t)(r0 + selrow[k]) * D); bufr[b][0] = src[lane]; bufr[b][1] = src[lane + 64]; } }
#pragma unroll
                for (int b = 0; b < 4; ++b) { const int k = k0 + NWAVES * b; if (k < ns) { u32x4* dst = (u32x4*)((unsigned char*)XS + (size_t)(e * NSLOT + sb + selslot[k]) * D); dst[lane] = bufr[b][0]; dst[lane + 64] = bufr[b][1]; } } }
            else {
#pragma unroll
                for (int b = 0; b < 4; ++b) { const int k = k0 + NWAVES * b; if (k < ns) { const u32x4* src = (const u32x4*)(H + (size_t)(r0 + selrow[k]) * D); u32x4* dst = (u32x4*)(XS + (size_t)(e * NSLOT + sb + selslot[k]) * D);
#pragma unroll
                    for (int j = 0; j < 4; ++j) dst[lane + 64 * j] = src[lane + 64 * j]; } } } }
        __syncthreads();
    }
}

DI void ph_ln2(const Params& p, int wid_, int l, unsigned char* lds_raw) {
    const int tid = (wid_ * 64 + fresh_lane()), lane = tid & 63, wv = wid_;
    const int rpb = p.rpb, rb0 = blockIdx.x * rpb, rb1 = min(rb0 + rpb, T);
    if (rb0 >= T) return;
    LAS float* PV = (LAS float*)lds_raw;
    LAS float* PC = PV + 4 * 2048;
    const int c_lo = cond_of_row(rb0);
    for (int i = tid; i < 4 * 512; i += NTHREADS) { const int w = i >> 9, col = (i & 511) * 4; const float* src = w == 0 ? p.in[21] + l * D : w == 1 ? p.in[22] + l * D : w == 2 ? p.in[27] + l * D : p.in[28] + l * D;
        *(LAS f32x4*)(PV + w * 2048 + col) = *(const f32x4*)(src + col); }
    for (int i = tid; i < 2 * 3 * 512; i += NTHREADS) { const int cc = i / 1536, w = (i / 512) % 3, col = (i & 511) * 4; const int ci = min(c_lo + cc, 8);
        const float* src = w == 0 ? modp(p, l, ci, 5) : modp(p, 1, ci, w == 1 ? 0 : 1);
        *(LAS f32x4*)(PC + (cc * 3 + w) * 2048 + col) = *(const f32x4*)(src + col); }
    __syncthreads();
    const float* Y = wsp<float>(p, WS_Y); const float* STAT = wsp<float>(p, WS_STAT);
    const float* AFF = wsp<float>(p, WS_AFF); const int* INV = wsp<int>(p, WS_INV); const bf16_t* YE = wsp<bf16_t>(p, WS_YE);
    float* XL = wsp<float>(p, WS_XL); bf16_t* H = wsp<bf16_t>(p, WS_H);
    f32x4 x[8], xn[8]; int sl = -1, sln = -1; float af = 0.f, afn = 0.f; f32x2 st = {0.f, 1.f}, stn = {0.f, 1.f};
    int r = rb0 + wv;
#define LN2_LOAD(dx, ds, da, dt, rr) do { if ((rr) < rb1) { _Pragma("unroll") for (int j = 0; j < 4; ++j) { const float* y = Y + (size_t)(rr) * D + lane * 8 + 512 * j; dx[2 * j] = *(const f32x4*)y; dx[2 * j + 1] = *(const f32x4*)(y + 4); } \
        if (lane < 16) { ds = INV[(size_t)(rr) * 16 + lane]; da = AFF[(size_t)(rr) * 16 + lane]; } dt = *(const f32x2*)(STAT + 2 * (size_t)(rr)); } } while (0)
    LN2_LOAD(x, sl, af, st, r);
    for (; r < rb1; r += NWAVES) {
        asm volatile("" ::: "memory");
        LN2_LOAD(xn, sln, afn, stn, r + NWAVES);
        const LAS float* pc = PC + (cond_of_row(r) - c_lo) * 3 * 2048;
        f32x4 f[8];
#pragma unroll
        for (int j = 0; j < 8; ++j) f[j] = (f32x4){0.f, 0.f, 0.f, 0.f};
        {
            unsigned long long mk = __ballot(sl >= 0) & 0xffffull;
            while (mk) {
                const int e0 = __builtin_ctzll(mk); mk &= mk - 1; const bool two = mk != 0ull; const int e1 = two ? __builtin_ctzll(mk) : e0; if (two) mk &= mk - 1;
                const int s0 = __shfl(sl, e0), s1 = __shfl(sl, e1); const float w0 = __shfl(af, e0), w1 = two ? __shfl(af, e1) : 0.f;
                const bf16_t* y0 = YE + (size_t)(e0 * NSLOT + s0) * D + lane * 8; const bf16_t* y1 = YE + (size_t)(e1 * NSLOT + s1) * D + lane * 8;
                u32x4 q0[4], q1[4];
#pragma unroll
                for (int j = 0; j < 4; ++j) { q0[j] = *(const u32x4*)(y0 + 512 * j); q1[j] = *(const u32x4*)(y1 + 512 * j); }
#pragma unroll
                for (int j = 0; j < 4; ++j) {
                    f[2 * j][0] += w0 * bflo(q0[j].x) + w1 * bflo(q1[j].x); f[2 * j][1] += w0 * bfhi(q0[j].x) + w1 * bfhi(q1[j].x); f[2 * j][2] += w0 * bflo(q0[j].y) + w1 * bflo(q1[j].y); f[2 * j][3] += w0 * bfhi(q0[j].y) + w1 * bfhi(q1[j].y);
                    f[2 * j + 1][0] += w0 * bflo(q0[j].z) + w1 * bflo(q1[j].z); f[2 * j + 1][1] += w0 * bfhi(q0[j].z) + w1 * bfhi(q1[j].z); f[2 * j + 1][2] += w0 * bflo(q0[j].w) + w1 * bflo(q1[j].w); f[2 * j + 1][3] += w0 * bfhi(q0[j].w) + w1 * bfhi(q1[j].w); }
            }
        }
        float s = 0.f;
#pragma unroll
        for (int j = 0; j < 8; ++j) { const int c0 = lane * 8 + 512 * (j >> 1) + 4 * (j & 1); const f32x4 x1 = (x[j] - st[0]) * st[1] * *(const LAS f32x4*)(PV + c0) + *(const LAS f32x4*)(PV + 2048 + c0);
            f[j] = DN_ALPHA * x1 + *(const LAS f32x4*)(pc + c0) * f[j]; s += (f[j][0] + f[j][1]) + (f[j][2] + f[j][3]); }
        const float mean = wave_sum(s) * (1.f / D); float s2 = 0.f;
#pragma unroll
        for (int j = 0; j < 8; ++j) { f[j] = f[j] - mean; s2 += (f[j][0] * f[j][0] + f[j][1] * f[j][1]) + (f[j][2] * f[j][2] + f[j][3] * f[j][3]); }
        const float rstd = rsqrtf(wave_sum(s2) * (1.f / D) + 1e-5f);
#pragma unroll
        for (int j = 0; j < 4; ++j) { const int c0 = lane * 8 + 512 * j; f32x4 o[2];
#pragma unroll
            for (int q = 0; q < 2; ++q) { const int cc = c0 + 4 * q; o[q] = f[2 * j + q] * rstd * *(const LAS f32x4*)(PV + 2 * 2048 + cc) + *(const LAS f32x4*)(PV + 3 * 2048 + cc);
                if (l == 0) { *(f32x4*)(XL + (size_t)r * D + cc) = o[q]; o[q] = o[q] * (1.f + *(const LAS f32x4*)(pc + 2 * 2048 + cc)) + *(const LAS f32x4*)(pc + 2048 + cc); }
                else *(f32x4*)(p.out + O_Y + (size_t)r * D + cc) = o[q]; }
            if (l == 0) { u32x4 w; w.x = pk2(o[0][0], o[0][1]); w.y = pk2(o[0][2], o[0][3]); w.z = pk2(o[1][0], o[1][1]); w.w = pk2(o[1][2], o[1][3]); *(u32x4*)(H + (size_t)r * D + c0) = w; } }
#pragma unroll
        for (int j = 0; j < 8; ++j) x[j] = xn[j];
        sl = sln; af = afn; st = stn;
    }
#undef LN2_LOAD
}
template <int PAT> DI void ph_readonly(const Params& p, int wid_) {
    const int lane = (wid_ * 64 + fresh_lane()) & 63, gw = blockIdx.x * NWAVES + wid_, NGW = gridDim.x * NWAVES;
    float accum = 0.f;
    for (int it = gw; it < 98304; it += NGW) {
        const int mat = it >> 10, w = it & 1023, le = mat / 3, kind = mat % 3;
        const float* base = p.in[24 + kind] + (size_t)le * 2048 * 2048;
        if (PAT == 0) { const int nb = w & 31, kb = w >> 5; const float* s = base + (size_t)(kb * 64) * 2048 + nb * 64 + lane; float v[64];
#pragma unroll
            for (int k = 0; k < 64; ++k) v[k] = __builtin_nontemporal_load(s + (size_t)k * 2048);
#pragma unroll
            for (int k = 0; k < 64; ++k) accum += v[k]; }
        else if (PAT == 1) { const int nb8 = w & 7, kb16 = w >> 3; const float* s = base + (size_t)(kb16 * 16) * 2048 + nb8 * 256 + 4 * lane; f32x4 v[16];
#pragma unroll
            for (int k = 0; k < 16; ++k) v[k] = __builtin_nontemporal_load((const f32x4*)(s + (size_t)k * 2048));
#pragma unroll
            for (int k = 0; k < 16; ++k) accum += (v[k][0] + v[k][1]) + (v[k][2] + v[k][3]); }
        else { const float* s = base + (size_t)w * 4096 + 4 * lane; f32x4 v[16];
#pragma unroll
            for (int k = 0; k < 16; ++k) v[k] = __builtin_nontemporal_load((const f32x4*)(s + (size_t)k * 256));
#pragma unroll
            for (int k = 0; k < 16; ++k) accum += (v[k][0] + v[k][1]) + (v[k][2] + v[k][3]); }
    }
    if (lane == 0) wsp<float>(p, WS_DBG)[gw] = accum + wave_sum(accum);
}

struct Unit { const char* A; const char* B; unsigned lda, ldb; int nt; int pm, pn; int mode; int aux; };
DI int vcu_of(int bx, int G) { return (G % 8 == 0) ? (bx % 8) * (G / 8) + bx / 8 : bx; }

DI void rope8(const Params& p, int s, int pi0, float* v) {
    const f32x4 c = *(const f32x4*)(ws_cos(p) + s * 32 + pi0), sn = *(const f32x4*)(ws_sin(p) + s * 32 + pi0);
#pragma unroll
    for (int i = 0; i < 4; ++i) { const float x1 = v[2 * i], x2 = v[2 * i + 1]; v[2 * i] = x1 * c[i] - x2 * sn[i]; v[2 * i + 1] = x1 * sn[i] + x2 * c[i]; }
}
DI void st_bf16x8(bf16_t* dst, const float* v) { u32x4 w; w.x = pk2(v[0], v[1]); w.y = pk2(v[2], v[3]); w.z = pk2(v[4], v[5]); w.w = pk2(v[6], v[7]); *(u32x4*)dst = w; }
DI void st_f32x8(float* dst, const float* v) { *(f32x4*)dst = (f32x4){v[0], v[1], v[2], v[3]}; *(f32x4*)(dst + 4) = (f32x4){v[4], v[5], v[6], v[7]}; }

struct SchedInEven { static constexpr bool BK16 = false; const Params* p; int G, c;
    DI bool next(int i, Unit& u) const { const int L = i * G + c; if (L >= 48 * 8) return false; u.pm = L >> 3; u.pn = L & 7;
        u.A = (const char*)wsp<bf16_t>(*p, WS_H) + (size_t)u.pm * 256 * 4096; u.B = (const char*)wsp<bf16_t>(*p, WS_WINE) + (size_t)u.pn * 256 * 4096; u.lda = 4096; u.ldb = 4096; u.nt = 32; u.mode = 0; u.aux = 0; return true; } };
struct EpiInEven { static constexpr bool HAS_STATE = false; static constexpr bool PAIR = false, F8 = false; const Params* p;
    DI void store(const Unit& u, int row, int col, float* v) const {
        const int r = u.pm * 256 + row, gc = u.pn * 256 + col;
        if (gc < 1792) { st_f32x8(wsp<float>(*p, WS_PJ) + (size_t)r * 1792 + gc, v); return; }
        if (gc >= 1856) return;
        const int j0 = gc - 1792;
        if (r < T_CTX) st_f32x8(p->out + O_KPE + (size_t)r * 64 + j0, v); else rope8(*p, (r - T_CTX) & 1023, j0 >> 1, v);
        st_bf16x8(wsp<bf16_t>(*p, WS_KPE) + (size_t)r * 64 + j0, v);
    } };

constexpr int E2_Q = 48 * 6, E2_K = 64 * 4, E2_V = 4 * 64, E2_P = 48 * 4, E2_TOTAL = E2_Q + E2_K + E2_V + E2_P;
struct SchedE2 { static constexpr bool BK16 = false; const Params* p; int G, c;
    DI bool next(int i, Unit& u) const { int L;
        if (G == 256) { if (c < 32) { if (i > 2) return false; L = i == 0 ? c : (i == 1 ? 256 + c : E2_Q + c); } else { if (i > 3) return false; L = i == 0 ? c : E2_Q + 32 + (c - 32) * 3 + (i - 1); } }
        else { L = i * G + c; if (L >= E2_TOTAL) return false; }
        const char* ACT2 = (const char*)wsp<bf16_t>(*p, WS_ACT2); const char* W2 = (const char*)wsp<bf16_t>(*p, WS_W2); u.aux = 0;
        if (L < E2_Q) { u.mode = 0; u.pm = L / 6; u.pn = L % 6; u.A = ACT2 + (size_t)u.pm * 256 * 3584; u.lda = 3584; u.B = W2 + (size_t)u.pn * 256 * 3584; u.ldb = 3584; u.nt = 8; return true; }
        L -= E2_Q;
        if (L < E2_K) { u.mode = 1; u.pm = L >> 2; u.pn = L & 3; u.A = ACT2 + (size_t)u.pm * 256 * 3584 + 512 * 2; u.lda = 3584; u.B = W2 + (size_t)(1536 + u.pn * 256) * 3584; u.ldb = 3584; u.nt = 4; return true; }
        L -= E2_K;
        if (L < E2_V) { u.mode = 2; u.pm = L >> 6; u.pn = L & 63; u.A = W2 + (size_t)(2560 + u.pm * 256) * 3584; u.lda = 3584; u.B = ACT2 + (size_t)u.pn * 256 * 3584 + 512 * 2; u.ldb = 3584; u.nt = 4; return true; }
        L -= E2_V;
        u.mode = 3; u.pm = L >> 2; u.aux = L & 3; u.pn = 0; u.A = ACT2 + (size_t)u.pm * 256 * 3584 + (768 + u.aux * 256) * 2; u.lda = 3584; u.B = W2 + (size_t)(3584 + u.aux * 256) * 3584; u.ldb = 3584; u.nt = 4; return true; } };
struct EpiE2 { static constexpr bool HAS_STATE = false; static constexpr bool PAIR = false, F8 = false; const Params* p;
    DI void store(const Unit& u, int row, int col, float* v) const {
        const int r = u.pm * 256 + row, gc = u.pn * 256 + col;
        if (u.mode == 0) { const int dd = gc % 192; if (dd >= 128 && r >= T_CTX) rope8(*p, (r - T_CTX) & 1023, (dd - 128) >> 1, v);
#pragma unroll
            for (int i = 0; i < 8; ++i) v[i] *= QS_MLA;
            st_bf16x8(wsp<bf16_t>(*p, WS_Q) + (size_t)r * 1536 + gc, v); }
        else if (u.mode == 1) st_bf16x8(wsp<bf16_t>(*p, WS_KN) + (size_t)r * 1024 + gc, v);
        else if (u.mode == 2) st_bf16x8(wsp<bf16_t>(*p, WS_VT) + (size_t)r * TX + gc, v);
        else { const float* ps = p->in[16] + u.aux * 256 + col;
#pragma unroll
            for (int i = 0; i < 8; ++i) v[i] *= ps[i];
            if (OUT_F8) { u32x2 o; o.x = pk4_fp8(v[0], v[1], v[2], v[3]); o.y = pk4_fp8(v[4], v[5], v[6], v[7]); *(u32x2*)((unsigned char*)wsp<bf16_t>(*p, WS_MIX) + (size_t)r * 2048 + 1024 + u.aux * 256 + col) = o; }
            else st_bf16x8(wsp<bf16_t>(*p, WS_MIX) + (size_t)r * 2048 + 1024 + u.aux * 256 + col, v); }
    } };

struct SchedOut { static constexpr bool BK16 = OUT_F8 != 0; const Params* p; int G, c, l;
    DI bool next(int i, Unit& u) const { const int L = i * G + c; if (L >= 48 * 8) return false; u.pm = L >> 3; u.pn = L & 7;
        constexpr unsigned P = OUT_F8 ? 2048 : 4096;
        u.A = (const char*)wsp<bf16_t>(*p, WS_MIX) + (size_t)u.pm * 256 * P; u.B = (const char*)wsp<bf16_t>(*p, l == 0 ? WS_WOUTE : WS_WOUTO) + (OUT_F8 ? (size_t)u.pn * 256 * 16 : (size_t)u.pn * 256 * P); u.lda = P; u.ldb = OUT_F8 ? 2048 * 16 : P; u.nt = OUT_F8 ? 16 : 32; u.mode = 0; u.aux = 0; return true; } };
struct EpiOut { static constexpr bool HAS_STATE = false; static constexpr bool PAIR = false, F8 = OUT_F8 != 0; const Params* p; int l;
    DI void store(const Unit& u, int row, int col, float* v) const {
        const int r = u.pm * 256 + row, gc = u.pn * 256 + col;
        const float* x = (l == 0 ? xrow_in(*p, r) : wsp<float>(*p, WS_XL) + (size_t)r * D) + gc; const float* g1 = modp(*p, l, cond_of_row(r), 2) + gc;
        const f32x4 x0 = *(const f32x4*)x, x1 = *(const f32x4*)(x + 4), g0 = *(const f32x4*)g1, g4 = *(const f32x4*)(g1 + 4);
#pragma unroll
        for (int i = 0; i < 4; ++i) { const float w0 = OUT_F8 ? g0[i] * (1.f / OUT_WSCALE) : g0[i], w4 = OUT_F8 ? g4[i] * (1.f / OUT_WSCALE) : g4[i]; v[i] = DN_ALPHA * x0[i] + w0 * v[i]; v[4 + i] = DN_ALPHA * x1[i] + w4 * v[4 + i]; }
        st_f32x8(wsp<float>(*p, WS_Y) + (size_t)r * D + gc, v);
    } };

struct SchedGU { static constexpr bool BK16 = MOE_F8 != 0; const Params* p; int G, c, l;
    DI bool next(int i, Unit& u) const { const int L = i * G + c; if (L >= 16 * 96) return false; const int e = L / 96, rem = L % 96; u.pn = rem / 6; u.pm = e * 6 + rem % 6; u.aux = e;
        constexpr unsigned P = MOE_F8 ? 2048 : 4096;
        u.A = (const char*)wsp<bf16_t>(*p, WS_XS) + (size_t)u.pm * 256 * P; u.B = (const char*)wsp<bf16_t>(*p, WS_WGU) + (MOE_F8 ? (size_t)(l * 16 + e) * 4096 * 2048 + (size_t)u.pn * 256 * 16 : ((size_t)(l * 16 + e) * 4096 + (size_t)u.pn * 256) * P); u.lda = P; u.ldb = MOE_F8 ? 4096 * 16 : P; u.nt = MOE_F8 ? 16 : 32; u.mode = 0; return true; } };
struct EpiGU { static constexpr bool HAS_STATE = false; static constexpr bool PAIR = true, F8 = MOE_F8 != 0; const Params* p;
    DI void store2(const Unit& u, int row, int col, const float* g, const float* up) const {
        float h[8];
#pragma unroll
        for (int i = 0; i < 8; ++i) { const float gg = MOE_F8 ? g[i] * (1.f / GU_WSCALE) : g[i], uu = MOE_F8 ? up[i] * (1.f / GU_WSCALE) : up[i]; h[i] = gg * uu * __builtin_amdgcn_rcpf(1.f + __expf(-gg)); }
        if (MOE_F8) { u32x2 o; o.x = pk4_fp8(h[0], h[1], h[2], h[3]); o.y = pk4_fp8(h[4], h[5], h[6], h[7]); *(u32x2*)((unsigned char*)wsp<bf16_t>(*p, WS_HID) + (size_t)(u.pm * 256 + row) * D + u.pn * 128 + col) = o; }
        else st_bf16x8(wsp<bf16_t>(*p, WS_HID) + (size_t)(u.pm * 256 + row) * D + u.pn * 128 + col, h);
    } };

struct SchedDown { static constexpr bool BK16 = MOE_F8 != 0; const Params* p; int G, c, l;
    DI bool next(int i, Unit& u) const { const int L = i * G + c; if (L >= 16 * 48) return false; const int e = L / 48, rem = L % 48; u.pn = rem / 6; u.pm = e * 6 + rem % 6; u.aux = e;
        constexpr unsigned P = MOE_F8 ? 2048 : 4096;
        u.A = (const char*)wsp<bf16_t>(*p, WS_HID) + (size_t)u.pm * 256 * P; u.B = (const char*)wsp<bf16_t>(*p, WS_WDN) + (MOE_F8 ? (size_t)(l * 16 + e) * 2048 * 2048 + (size_t)u.pn * 256 * 16 : ((size_t)(l * 16 + e) * 2048 + (size_t)u.pn * 256) * P); u.lda = P; u.ldb = MOE_F8 ? 2048 * 16 : P; u.nt = MOE_F8 ? 16 : 32; u.mode = 0; return true; } };
struct EpiDown { static constexpr bool HAS_STATE = false; static constexpr bool PAIR = false, F8 = MOE_F8 != 0; const Params* p;
    DI void store(const Unit& u, int row, int col, float* v) const {
        if (MOE_F8) {
#pragma unroll
            for (int i = 0; i < 8; ++i) v[i] *= (1.f / DN_WSCALE); }
        st_bf16x8(wsp<bf16_t>(*p, WS_YE) + (size_t)(u.pm * 256 + row) * D + u.pn * 256 + col, v); } };

constexpr int IO_QK = 48 * 9, IO_V = 16, IO_VT = 48, IO_TOTAL = IO_QK + IO_V + IO_VT;
struct SchedInOdd { static constexpr bool BK16 = false; const Params* p; int G, c;
    DI bool next(int i, Unit& u) const { int L = i * G + c; if (L >= IO_TOTAL) return false;
        const char* Hb = (const char*)wsp<bf16_t>(*p, WS_H); const char* W = (const char*)wsp<bf16_t>(*p, WS_WINO); u.aux = 0; u.nt = 32; u.lda = 4096; u.ldb = 4096;
        if (L < IO_QK) { u.mode = 0; u.pm = L / 9; u.pn = L % 9; u.A = Hb + (size_t)u.pm * 256 * 4096; u.B = W + (size_t)u.pn * 256 * 4096; return true; }
        L -= IO_QK;
        if (L < IO_V) { u.mode = 1; u.pm = L; u.pn = 9; u.A = Hb + (size_t)u.pm * 256 * 4096; u.B = W + (size_t)9 * 256 * 4096; return true; }
        L -= IO_V;
        u.mode = 2; u.pm = 0; u.pn = L; u.A = W + (size_t)9 * 256 * 4096; u.B = Hb + (size_t)u.pn * 256 * 4096; return true; } };
struct EpiInOdd { static constexpr bool HAS_STATE = true; static constexpr bool PAIR = false, F8 = false; const Params* p;
    struct State { f32x4 c[4], s[4]; bool rot; };
    DI void begin(State& st, const Unit& u, int row0, int col0) const {
        st.rot = u.mode == 0 && u.pm * 256 >= T_CTX;
        if (st.rot) { const int pi0 = (col0 & 63) >> 1;
#pragma unroll
            for (int ri = 0; ri < 4; ++ri) { const int r = u.pm * 256 + ri * 16 + row0, sp = (r - T_CTX) & 1023;
                st.c[ri] = *(const f32x4*)(ws_cos(*p) + sp * 32 + pi0); st.s[ri] = *(const f32x4*)(ws_sin(*p) + sp * 32 + pi0); } }
    }
    DI void store_st(const State& st, int ri, const Unit& u, int row, int col, float* v) const {
        const int r = u.pm * 256 + row, gc = u.pn * 256 + col;
        if (u.mode == 0) {
            if (gc < 2048) {
                if (st.rot) {
#pragma unroll
                    for (int i = 0; i < 4; ++i) { const float x1 = v[2 * i], x2 = v[2 * i + 1]; v[2 * i] = x1 * st.c[ri][i] - x2 * st.s[ri][i]; v[2 * i + 1] = x1 * st.s[ri][i] + x2 * st.c[ri][i]; } }
#pragma unroll
                for (int i = 0; i < 8; ++i) v[i] *= QS_SWA;
                st_bf16x8(wsp<bf16_t>(*p, WS_Q) + (size_t)r * 2048 + gc, v); }
            else { const int kc = gc - 2048; if (r < T_CTX) st_f32x8(p->out + O_SK + (size_t)r * 256 + kc, v);
                if (st.rot) {
#pragma unroll
                    for (int i = 0; i < 4; ++i) { const float x1 = v[2 * i], x2 = v[2 * i + 1]; v[2 * i] = x1 * st.c[ri][i] - x2 * st.s[ri][i]; v[2 * i + 1] = x1 * st.s[ri][i] + x2 * st.c[ri][i]; } }
                st_bf16x8(wsp<bf16_t>(*p, WS_KO) + (size_t)r * 256 + kc, v); } }
        else if (u.mode == 1) st_f32x8(p->out + O_SV + (size_t)r * 256 + col, v);
        else st_bf16x8(wsp<bf16_t>(*p, WS_VTO) + (size_t)row * TX + gc, v);
    }
    DI void store(const Unit& u, int row, int col, float* v) const {
        const int r = u.pm * 256 + row, gc = u.pn * 256 + col;
        if (u.mode == 0) {
            if (gc < 2048) { if (r >= T_CTX) rope8(*p, (r - T_CTX) & 1023, (gc & 63) >> 1, v);
#pragma unroll
                for (int i = 0; i < 8; ++i) v[i] *= QS_SWA;
                st_bf16x8(wsp<bf16_t>(*p, WS_Q) + (size_t)r * 2048 + gc, v); }
            else { const int kc = gc - 2048; if (r < T_CTX) st_f32x8(p->out + O_SK + (size_t)r * 256 + kc, v); else rope8(*p, (r - T_CTX) & 1023, (kc & 63) >> 1, v);
                st_bf16x8(wsp<bf16_t>(*p, WS_KO) + (size_t)r * 256 + kc, v); } }
        else if (u.mode == 1) st_f32x8(p->out + O_SV + (size_t)r * 256 + col, v);
        else st_bf16x8(wsp<bf16_t>(*p, WS_VTO) + (size_t)row * TX + gc, v);
    } };

namespace pg8 {
typedef short bf16x8 __attribute__((ext_vector_type(8)));
typedef int i32x4 __attribute__((ext_vector_type(4)));
typedef int i32x8 __attribute__((ext_vector_type(8)));
DI i32x8 cat8(bf16x8 lo, bf16x8 hi) { return __builtin_shufflevector(__builtin_bit_cast(i32x4, lo), __builtin_bit_cast(i32x4, hi), 0, 1, 2, 3, 4, 5, 6, 7); }
constexpr int BM = 256, BK = 64, HALF = 128, HTB = HALF * BK * 2  , STAGE_BYTES = 8 * HTB;
DI int lds_byte(int r, int c) { const int st = (r >> 4) * 2 + (c >> 5), rr = r & 15, cc = c & 31, ob = rr * 64 + cc * 2; return st * 1024 + (ob ^ (((ob >> 9) & 1) << 5)); }
DI void stage_rc(int b, int& R, int& C) { const int st = b / 1024, sb = b % 1024, swz = sb ^ (((sb >> 9) & 1) << 5); R = (st >> 1) * 16 + swz / 64; C = (st & 1) * 32 + (swz % 64) / 2; }
DI int perm32(int rho) { const int n = rho >> 4, i = rho & 15; return 8 * (i >> 2) + 4 * n + (i & 3); }

template <bool F8> struct Frag;
template <> struct Frag<false> { bf16x8 k0, k1; DI void set(bf16x8 a, bf16x8 b) { k0 = a; k1 = b; } };
template <> struct Frag<true> { i32x8 w; DI void set(bf16x8 a, bf16x8 b) { w = cat8(a, b); } };
template <class Epi, class Sched, bool ALIGN_EPI = true>
DI void gemm_phase(LAS unsigned char* lds, const Sched& S, const Epi& E, int wid) {
    const int lane = fresh_lane(), tid = wid * 64 + lane, wr = wid >> 2, wc = wid & 3, fr = lane & 15, fq = lane >> 4;
    int RA[2], RB[2], CB[2];
#pragma unroll
    for (int i = 0; i < 2; ++i) { int R, C; stage_rc(tid * 16 + i * 8192, R, C); RA[i] = R; RB[i] = (R & ~31) + perm32(R & 31); CB[i] = C * 2; }
    constexpr size_t kstep = (size_t)(BK * 2);
    const unsigned ldsw = (unsigned)wid * 1024u;
    const int aoff = lds_byte(wr * 64 + fr, fq * 8), boff = lds_byte(wc * 32 + fr, fq * 8);
#define PG8_SA(b, h) (((b) * 2 + (h)) * HTB)
#define PG8_SB(b, h) ((4 + (b) * 2 + (h)) * HTB)
#define PG8_STAGE(bufoff, gbase, v0, v1) do { unsigned o0_ = (v0), o1_ = (v1); asm volatile("" : "+v"(o0_), "+v"(o1_)); \
        __builtin_amdgcn_global_load_lds((const unsigned*)((const char*)(gbase) + o0_), (LAS unsigned*)(lds + (bufoff) + ldsw), 16, 0, 0); \
        __builtin_amdgcn_global_load_lds((const unsigned*)((const char*)(gbase) + o1_), (LAS unsigned*)(lds + (bufoff) + ldsw + 8192), 16, 0, 0); } while (0)
#define PG8_LDA(dst, b, h) do { _Pragma("unroll") for (int m = 0; m < 4; ++m) { const bf16x8 f0_ = *(const LAS bf16x8*)(lds + PG8_SA(b, h) + aoff + m * 2048), f1_ = *(const LAS bf16x8*)(lds + PG8_SA(b, h) + aoff + m * 2048 + 1024); dst[m].set(f0_, f1_); } } while (0)
#define PG8_LDB(dst, b, h) do { _Pragma("unroll") for (int n = 0; n < 2; ++n) { const bf16x8 f0_ = *(const LAS bf16x8*)(lds + PG8_SB(b, h) + boff + n * 2048), f1_ = *(const LAS bf16x8*)(lds + PG8_SB(b, h) + boff + n * 2048 + 1024); dst[n].set(f0_, f1_); } } while (0)
#define PG8_MMA(ai, bj, At, Bt) do { __builtin_amdgcn_s_setprio(1); _Pragma("unroll") for (int m = 0; m < 4; ++m) _Pragma("unroll") for (int n = 0; n < 2; ++n) { \
        if constexpr (Epi::F8) acc[ai][bj][m][n] = __builtin_amdgcn_mfma_scale_f32_16x16x128_f8f6f4(Bt[n].w, At[m].w, acc[ai][bj][m][n], 0, 0, 0, 0x7f7f7f7f, 0, 0x7f7f7f7f); \
        else { acc[ai][bj][m][n] = __builtin_amdgcn_mfma_f32_16x16x32_bf16(Bt[n].k0, At[m].k0, acc[ai][bj][m][n], 0, 0, 0); acc[ai][bj][m][n] = __builtin_amdgcn_mfma_f32_16x16x32_bf16(Bt[n].k1, At[m].k1, acc[ai][bj][m][n], 0, 0, 0); } } \
        __builtin_amdgcn_s_setprio(0); } while (0)
#define PG8_WAIT_V(n) asm volatile("s_waitcnt vmcnt(" #n ")" ::: "memory")
#define PG8_WAIT_L(n) asm volatile("s_waitcnt lgkmcnt(" #n ")" ::: "memory")
#define PG8_BAR __builtin_amdgcn_s_barrier()
#define PG8_SCHED __builtin_amdgcn_sched_barrier(0)
    Unit cur, nxt; int ui = 0;
    if (!S.next(0, cur)) return;
    f32x4 acc[2][2][4][2];
#pragma unroll
    for (int a = 0; a < 2; ++a)
#pragma unroll
        for (int b = 0; b < 2; ++b)
#pragma unroll
            for (int m = 0; m < 4; ++m)
#pragma unroll
                for (int n = 0; n < 2; ++n) acc[a][b][m][n] = (f32x4){0.f, 0.f, 0.f, 0.f};
    Frag<Epi::F8> At[4], B0[2], B1[2];
    const char* cA = cur.A; const char* cB = cur.B;
    const unsigned ld = cur.lda;
    const unsigned plane = cur.ldb;
    const unsigned vA0 = RA[0] * ld + CB[0], vA1 = RA[1] * ld + CB[1];
    const unsigned vB0 = Sched::BK16 ? (unsigned)(CB[0] >> 4) * plane + RB[0] * 16 : RB[0] * ld + CB[0], vB1 = Sched::BK16 ? (unsigned)(CB[1] >> 4) * plane + RB[1] * 16 : RB[1] * ld + CB[1];
    const size_t hA = (size_t)HALF * ld, hB = Sched::BK16 ? (size_t)HALF * 16 : hA;
    const size_t kstepB = Sched::BK16 ? (size_t)8 * plane : kstep;
    PG8_STAGE(PG8_SB(0, 0), cB, vB0, vB1); PG8_STAGE(PG8_SB(0, 1), cB + hB, vB0, vB1); PG8_STAGE(PG8_SA(0, 0), cA, vA0, vA1); PG8_STAGE(PG8_SA(0, 1), cA + hA, vA0, vA1);
    if (wr == 1) PG8_BAR;
    PG8_WAIT_V(2); PG8_BAR;
    PG8_STAGE(PG8_SB(1, 0), cB + kstepB, vB0, vB1); PG8_STAGE(PG8_SA(1, 0), cA + kstep, vA0, vA1); PG8_STAGE(PG8_SB(1, 1), cB + hB + kstepB, vB0, vB1);
    PG8_WAIT_V(6); PG8_BAR;
    for (;;) {
        const bool has_next = S.next(ui + 1, nxt);
        const char* nA = has_next ? nxt.A : cA; const char* nB = has_next ? nxt.B : cB;
        const int nt = cur.nt;
        for (int t = 0; t < nt; t += 2) {
            const bool last = (t == nt - 2);
            const char* a1 = cA + (size_t)(t + 1) * kstep;
            const char* a2 = last ? nA : cA + (size_t)(t + 2) * kstep; const char* b2 = last ? nB : cB + (size_t)(t + 2) * kstepB;
            const char* a3 = a2 + kstep; const char* b3 = b2 + kstepB;
            PG8_LDB(B0, 0, 0); PG8_LDB(B1, 0, 1); PG8_SCHED; PG8_LDA(At, 0, 0); PG8_STAGE(PG8_SA(1, 1), a1 + hA, vA0, vA1);
            PG8_WAIT_V(8); PG8_WAIT_L(0); PG8_BAR; PG8_MMA(0, 0, At, B0); PG8_MMA(0, 1, At, B1); PG8_BAR; PG8_SCHED;
            PG8_LDA(At, 0, 1); PG8_STAGE(PG8_SB(0, 0), b2, vB0, vB1); PG8_STAGE(PG8_SB(0, 1), b2 + hB, vB0, vB1); PG8_STAGE(PG8_SA(0, 0), a2, vA0, vA1);
            PG8_WAIT_V(8); PG8_WAIT_L(0); PG8_BAR; PG8_MMA(1, 0, At, B0); PG8_MMA(1, 1, At, B1); PG8_BAR; PG8_SCHED;
            PG8_LDB(B0, 1, 0); PG8_LDB(B1, 1, 1); PG8_SCHED; PG8_LDA(At, 1, 0); PG8_STAGE(PG8_SA(0, 1), a2 + hA, vA0, vA1);
            PG8_WAIT_V(8); PG8_WAIT_L(0); PG8_BAR; PG8_MMA(0, 0, At, B0); PG8_MMA(0, 1, At, B1); PG8_BAR; PG8_SCHED;
            PG8_LDA(At, 1, 1); PG8_STAGE(PG8_SB(1, 0), b3, vB0, vB1); PG8_STAGE(PG8_SB(1, 1), b3 + hB, vB0, vB1); PG8_STAGE(PG8_SA(1, 0), a3, vA0, vA1);
            PG8_WAIT_V(8); PG8_WAIT_L(0); PG8_BAR; PG8_MMA(1, 0, At, B0); PG8_MMA(1, 1, At, B1); PG8_BAR; PG8_SCHED;
        }
        if constexpr (ALIGN_EPI) { if (wr == 0) PG8_BAR; }
        {
            const int el_ = fresh_lane(); const int fr_ = el_ & 15, fq_ = el_ >> 4;
            if constexpr (Epi::HAS_STATE) {
#pragma unroll
                for (int ai = 0; ai < 2; ++ai) { typename Epi::State st; E.begin(st, cur, ai * HALF + wr * 64 + fr_, wc * 32 + 8 * fq_);
#pragma unroll
                    for (int m = 0; m < 4; ++m) { const int row = ai * HALF + wr * 64 + m * 16 + fr_;
#pragma unroll
                        for (int bj = 0; bj < 2; ++bj) { float v[8];
#pragma unroll
                            for (int j = 0; j < 4; ++j) { v[j] = acc[ai][bj][m][0][j]; v[4 + j] = acc[ai][bj][m][1][j]; }
                            E.store_st(st, m, cur, row, bj * HALF + wc * 32 + 8 * fq_, v); } } }
            } else {
#pragma unroll
            for (int ai = 0; ai < 2; ++ai)
#pragma unroll
                for (int m = 0; m < 4; ++m) { const int row = ai * HALF + wr * 64 + m * 16 + fr_;
                    if constexpr (Epi::PAIR) { float g[8], up[8];
#pragma unroll
                        for (int j = 0; j < 4; ++j) { g[j] = acc[ai][0][m][0][j]; g[4 + j] = acc[ai][0][m][1][j]; up[j] = acc[ai][1][m][0][j]; up[4 + j] = acc[ai][1][m][1][j]; }
                        E.store2(cur, row, wc * 32 + 8 * fq_, g, up);
#ifdef PROBE_EPI2
                        asm volatile("" ::: "memory"); E.store2(cur, row, wc * 32 + 8 * fq_, g, up);
#endif
                        }
                    else {
#pragma unroll
                        for (int bj = 0; bj < 2; ++bj) { float v[8];
#pragma unroll
                            for (int j = 0; j < 4; ++j) { v[j] = acc[ai][bj][m][0][j]; v[4 + j] = acc[ai][bj][m][1][j]; }
                            E.store(cur, row, bj * HALF + wc * 32 + 8 * fq_, v); } } }
            }
        }
        if (!has_next) break;
#pragma unroll
        for (int a = 0; a < 2; ++a)
#pragma unroll
            for (int b = 0; b < 2; ++b)
#pragma unroll
                for (int m = 0; m < 4; ++m)
#pragma unroll
                    for (int n = 0; n < 2; ++n) acc[a][b][m][n] = (f32x4){0.f, 0.f, 0.f, 0.f};
        cur = nxt; cA = nA; cB = nB; ++ui;
        if constexpr (ALIGN_EPI) { if (wr == 1) PG8_BAR; }
    }
    PG8_WAIT_V(0);
    if constexpr (!ALIGN_EPI) { if (wr == 0) PG8_BAR; }
    PG8_BAR;
#undef PG8_SA
#undef PG8_SB
#undef PG8_STAGE
#undef PG8_LDA
#undef PG8_LDB
#undef PG8_MMA
#undef PG8_WAIT_V
#undef PG8_WAIT_L
#undef PG8_BAR
#undef PG8_SCHED
}
}

namespace att {
typedef short bf16x8 __attribute__((ext_vector_type(8)));
typedef short s16x4 __attribute__((ext_vector_type(4)));
typedef float f32x16 __attribute__((ext_vector_type(16)));
typedef float f32x2_t __attribute__((ext_vector_type(2)));
typedef __bf16 bf16x2_t __attribute__((ext_vector_type(2)));
DI unsigned cvtpk(float lo, float hi) { f32x2_t v = {lo, hi}; bf16x2_t b = __builtin_convertvector(v, bf16x2_t); return __builtin_bit_cast(unsigned, b); }
DI int crow(int r, int h) { return (r & 3) + 8 * (r >> 2) + 4 * h; }
DI float max3f(float a, float b, float c) { float r; asm("v_max3_f32 %0, %1, %2, %3" : "=v"(r) : "v"(a), "v"(b), "v"(c)); return r; }

template <bool SWA>
DI void attn_phase(const Params& p, int wid_, LAS unsigned char* lds, int G, int c) {
    constexpr int DK = SWA ? 64 : 192, DV = SWA ? 64 : 128, KSTR = DK * 2 + 16, VSTR = 136;
    constexpr int QB = SWA ? 2 : 1;
    constexpr int KB = 64 * KSTR, VB = DV * VSTR, STG = KB + VB;
    constexpr int CPR = DK / 8, NKC = (64 * CPR) / NTHREADS, NVC = (DV * 8) / NTHREADS, NQ = DK / 16, NDV = DV / 32;
    constexpr int LDQ = SWA ? 2048 : 1536, NUNITS = SWA ? 768 : 384;
    static_assert(2 * STG <= 131072, "attention LDS");
    const int tid = (wid_ * 64 + fresh_lane()), lane = tid & 63, wid = wid_, q = lane & 31, hh = lane >> 5;
    const bf16_t* Q = wsp<bf16_t>(p, WS_Q); const bf16_t* KN = wsp<bf16_t>(p, SWA ? WS_KO : WS_KN); const bf16_t* KPE = wsp<bf16_t>(p, WS_KPE);
    const bf16_t* VT = wsp<bf16_t>(p, SWA ? WS_VTO : WS_VT); bf16_t* MIX = wsp<bf16_t>(p, WS_MIX);
    for (int L = c; L < NUNITS; L += G) {
        int rowbase, hk, nt0, nt1, key0a, key0b = 0, kpos0 = 0, qpos0 = 0; bool masked = false;
        if (!SWA) {
            if (L < 256) { const int b = L >> 5, qt = L & 3; hk = (L >> 2) & 7; rowbase = T_CTX + b * 1024 + qt * 256; key0a = T_CTX + b * 1024; nt0 = 16; key0b = T + b * 512; nt1 = 8; }
            else { const int Lc = L - 256, b = Lc >> 3; hk = Lc & 7; rowbase = b * 256; key0a = b * 256; nt0 = 4; nt1 = 0; }
        } else {
            if (L < 512) { const int b = L >> 6, t0 = (L & 15) * 64; hk = (L >> 4) & 3; rowbase = T_CTX + b * 1024 + t0;
                const int lo = max(t0 - 128, 0) & ~63, hi = min((t0 + 192 + 63) & ~63, 1024);
                key0a = T_CTX + b * 1024 + lo; nt0 = (hi - lo) >> 6; kpos0 = lo; qpos0 = t0; masked = true; key0b = T + b * 512; nt1 = 8; }
            else { const int Lc = L - 512, b = Lc >> 4; hk = (Lc >> 2) & 3; rowbase = b * 256 + (Lc & 3) * 64; key0a = b * 256; nt0 = 4; nt1 = 0; }
        }
        const int total = nt0 + nt1;
        const int qrow0 = SWA ? rowbase + q : rowbase + wid * 32 + q;
        const int qhead = SWA ? hk * 8 + wid : hk;
        bf16x8 qf[QB][NQ];
#pragma unroll
        for (int qb = 0; qb < QB; ++qb)
#pragma unroll
            for (int s = 0; s < NQ; ++s) qf[qb][s] = *(const bf16x8*)(Q + (size_t)(qrow0 + 32 * qb) * LDQ + qhead * DK + 16 * s + 8 * hh);
        f32x16 o[QB][NDV];
#pragma unroll
        for (int qb = 0; qb < QB; ++qb)
#pragma unroll
            for (int d = 0; d < NDV; ++d)
#pragma unroll
                for (int r = 0; r < 16; ++r) o[qb][d][r] = 0.f;
        float m[QB], l[QB];
#pragma unroll
        for (int qb = 0; qb < QB; ++qb) { m[qb] = SWA ? p.in[19][qhead] * LOG2E : -1e30f; l[qb] = (SWA && hh == 0) ? 1.f : 0.f; }
        const int qpos = qpos0 + q;
        u32x4 kreg[NKC], vreg[NVC];
#define ATT_LOAD(t_) do { const int tt_ = (t_); const int kb_ = tt_ < nt0 ? key0a + tt_ * 64 : key0b + (tt_ - nt0) * 64; \
            _Pragma("unroll") for (int i = 0; i < NKC; ++i) { const int ch = tid + NTHREADS * i, j = ch / CPR, cc = ch % CPR; \
                const bf16_t* src = SWA ? KN + (size_t)(kb_ + j) * 256 + hk * 64 + cc * 8 : (cc < 16 ? KN + (size_t)(kb_ + j) * 1024 + hk * 128 + cc * 8 : KPE + (size_t)(kb_ + j) * 64 + (cc - 16) * 8); \
                kreg[i] = *(const u32x4*)src; } \
            _Pragma("unroll") for (int i = 0; i < NVC; ++i) { const int ch = tid + NTHREADS * i, dv = ch >> 3, cc = ch & 7; \
                vreg[i] = *(const u32x4*)(VT + (size_t)(hk * DV + dv) * TX + kb_ + cc * 8); } } while (0)
#define ATT_WRITE(buf_) do { LAS unsigned char* Kw = lds + (buf_) * STG; LAS unsigned char* Vw = Kw + KB; \
            _Pragma("unroll") for (int i = 0; i < NKC; ++i) { const int ch = tid + NTHREADS * i, j = ch / CPR, cc = ch % CPR; *(LAS u32x4*)(Kw + j * KSTR + cc * 16) = kreg[i]; } \
            _Pragma("unroll") for (int i = 0; i < NVC; ++i) { const int ch = tid + NTHREADS * i, dv = ch >> 3, cc = ch & 7; \
                *(LAS u32x2*)(Vw + dv * VSTR + cc * 16) = (u32x2){vreg[i].x, vreg[i].y}; *(LAS u32x2*)(Vw + dv * VSTR + cc * 16 + 8) = (u32x2){vreg[i].z, vreg[i].w}; } } while (0)
        ATT_LOAD(0); ATT_WRITE(0);
        __syncthreads();
        for (int t = 0; t < total; ++t) {
            const int buf = t & 1;
            if (t + 1 < total) ATT_LOAD(t + 1);
            const LAS unsigned char* Kl = lds + buf * STG; const LAS unsigned char* Vl = Kl + KB;
            f32x16 s0[QB], s1[QB];
#pragma unroll
            for (int qb = 0; qb < QB; ++qb)
#pragma unroll
                for (int r = 0; r < 16; ++r) { s0[qb][r] = 0.f; s1[qb][r] = 0.f; }
#pragma unroll
            for (int s = 0; s < NQ; ++s) {
                const bf16x8 a0 = *(const LAS bf16x8*)(Kl + q * KSTR + (16 * s + 8 * hh) * 2);
                const bf16x8 a1 = *(const LAS bf16x8*)(Kl + (32 + q) * KSTR + (16 * s + 8 * hh) * 2);
#pragma unroll
                for (int qb = 0; qb < QB; ++qb) { s0[qb] = __builtin_amdgcn_mfma_f32_32x32x16_bf16(a0, qf[qb][s], s0[qb], 0, 0, 0); s1[qb] = __builtin_amdgcn_mfma_f32_32x32x16_bf16(a1, qf[qb][s], s1[qb], 0, 0, 0); }
            }
            bf16x8 pb[QB][2][2];
#pragma unroll
            for (int qb = 0; qb < QB; ++qb) {
                if (SWA && masked && t < nt0) {
                    const int kp = kpos0 + t * 64 - (qpos + 32 * qb);
#pragma unroll
                    for (int r = 0; r < 16; ++r) { const int d0 = kp + crow(r, hh), d1 = d0 + 32;
                        s0[qb][r] = (d0 >= -128 && d0 <= 128) ? s0[qb][r] : -1e30f; s1[qb][r] = (d1 >= -128 && d1 <= 128) ? s1[qb][r] : -1e30f; }
                }
                float tm = fmaxf(s0[qb][0], s1[qb][0]);
#pragma unroll
                for (int r = 1; r < 16; ++r) tm = max3f(tm, s0[qb][r], s1[qb][r]);
                tm = fmaxf(tm, __shfl_xor(tm, 32));
                const float mn = fmaxf(m[qb], tm);
                if (!__all(mn == m[qb])) {
                    const float alpha = __builtin_amdgcn_exp2f(m[qb] - mn); m[qb] = mn; l[qb] *= alpha;
#pragma unroll
                    for (int d = 0; d < NDV; ++d)
#pragma unroll
                        for (int r = 0; r < 16; ++r) o[qb][d][r] *= alpha; }
                float ls = 0.f;
#pragma unroll
                for (int r = 0; r < 16; ++r) { s0[qb][r] = __builtin_amdgcn_exp2f(s0[qb][r] - m[qb]); s1[qb][r] = __builtin_amdgcn_exp2f(s1[qb][r] - m[qb]); ls += s0[qb][r] + s1[qb][r]; }
                l[qb] += ls;
#pragma unroll
                for (int s = 0; s < 2; ++s) {
                    u32x4 w0, w1;
                    w0.x = cvtpk(s0[qb][8 * s + 0], s0[qb][8 * s + 1]); w0.y = cvtpk(s0[qb][8 * s + 2], s0[qb][8 * s + 3]); w0.z = cvtpk(s0[qb][8 * s + 4], s0[qb][8 * s + 5]); w0.w = cvtpk(s0[qb][8 * s + 6], s0[qb][8 * s + 7]);
                    w1.x = cvtpk(s1[qb][8 * s + 0], s1[qb][8 * s + 1]); w1.y = cvtpk(s1[qb][8 * s + 2], s1[qb][8 * s + 3]); w1.z = cvtpk(s1[qb][8 * s + 4], s1[qb][8 * s + 5]); w1.w = cvtpk(s1[qb][8 * s + 6], s1[qb][8 * s + 7]);
                    pb[qb][0][s] = __builtin_bit_cast(bf16x8, w0); pb[qb][1][s] = __builtin_bit_cast(bf16x8, w1);
                }
            }
#pragma unroll
            for (int d = 0; d < NDV; ++d)
#pragma unroll
                for (int blk = 0; blk < 2; ++blk)
#pragma unroll
                    for (int s = 0; s < 2; ++s) {
                        const LAS unsigned char* vp = Vl + (d * 32 + q) * VSTR + (blk * 32 + 16 * s + 4 * hh) * 2;
                        const s16x4 lo = *(const LAS s16x4*)vp, hi = *(const LAS s16x4*)(vp + 16);
                        const bf16x8 a = {lo[0], lo[1], lo[2], lo[3], hi[0], hi[1], hi[2], hi[3]};
#pragma unroll
                        for (int qb = 0; qb < QB; ++qb) o[qb][d] = __builtin_amdgcn_mfma_f32_32x32x16_bf16(a, pb[qb][blk][s], o[qb][d], 0, 0, 0);
                    }
            if (t + 1 < total) ATT_WRITE(buf ^ 1);
            __syncthreads();
        }
#undef ATT_LOAD
#undef ATT_WRITE
#pragma unroll
        for (int qb = 0; qb < QB; ++qb) {
            const float inv = 1.f / (l[qb] + __shfl_xor(l[qb], 32));
            bf16_t* orow = MIX + (size_t)(qrow0 + 32 * qb) * 2048 + qhead * DV;
            unsigned char* orow8 = (unsigned char*)MIX + (size_t)(qrow0 + 32 * qb) * 2048 + qhead * DV;
#pragma unroll
            for (int d = 0; d < NDV; ++d)
#pragma unroll
                for (int g = 0; g < 4; ++g) {
                    if (OUT_F8) *(unsigned*)(orow8 + d * 32 + 8 * g + 4 * hh) = pk4_fp8(o[qb][d][4 * g] * inv, o[qb][d][4 * g + 1] * inv, o[qb][d][4 * g + 2] * inv, o[qb][d][4 * g + 3] * inv);
                    else { u32x2 w; w.x = cvtpk(o[qb][d][4 * g] * inv, o[qb][d][4 * g + 1] * inv); w.y = cvtpk(o[qb][d][4 * g + 2] * inv, o[qb][d][4 * g + 3] * inv); *(u32x2*)(orow + d * 32 + 8 * g + 4 * hh) = w; } }
        }
    }
}
}


#ifndef R_PRO
#define R_PRO 1
#endif
#ifndef R_MOE
#define R_MOE 1
#endif
#ifndef R_ATT
#define R_ATT 1
#endif
#ifndef R_ATTM
#define R_ATTM R_ATT
#endif
#ifndef R_ATTS
#define R_ATTS R_ATT
#endif
#ifndef R_GEMM
#define R_GEMM 1
#endif
#ifndef R_THIN
#define R_THIN 1
#endif
#ifndef R_LN1
#define R_LN1 1
#endif
#ifndef R_LN2
#define R_LN2 1
#endif
#ifndef R_TOPK
#define R_TOPK 1
#endif
#define REP(n) for (int _r = 0; _r < (n); ++_r)
#define REPS(n, ...) do { { __VA_ARGS__ } if ((n) > 1) { __VA_ARGS__ } } while (0)
constexpr int LDS_BYTES = 147456, MISC_OFF = 146432;
constexpr int NPH = 20;
#ifndef CVT_WAVES
#define CVT_WAVES 4
#endif
#ifndef BG_MODE
#define BG_MODE 0
#endif
#ifndef BG_SPLIT
#define BG_SPLIT 32768
#endif
#ifndef CVT_IDLE_WAVES
#define CVT_IDLE_WAVES 8
#endif
#ifndef CV_IDLE2
#define CV_IDLE2 10240
#endif
#ifndef CV_IDLE6
#define CV_IDLE6 10240
#endif
constexpr int CV_I2 = CV_IDLE2, CV_I6 = CV_IDLE6, CV_IALL = CV_I2 + 2 * CV_I6;
__global__ void __launch_bounds__(NTHREADS, 2) mega(Params p) {
    extern __shared__ __attribute__((aligned(16))) unsigned char lds[];
    const int G = gridDim.x, c = vcu_of(blockIdx.x, G), wid = __builtin_amdgcn_readfirstlane(threadIdx.x >> 6);
    volatile LAS unsigned* MISC = (volatile LAS unsigned*)((LAS unsigned char*)lds + MISC_OFF);
    if (threadIdx.x < 4) MISC[threadIdx.x] = 0u;
    __syncthreads();
    XcdBarrier bar = xcd_barrier_post((unsigned*)(p.ws + WS_CTL) + CW_BAR, MISC);
    const int lo = p.ph_lo, hi = p.ph_hi;
#define IN(k) (lo <= (k) && (k) < hi)
#ifdef STAMP_A
#define stamps_ (wsp<unsigned long long>(p, WS_DBG + 65536))
#define STAMP(k) do { if (blockIdx.x == 0 && wid == 0 && fresh_lane() == 0) stamps_[k] = __builtin_amdgcn_s_memrealtime(); } while (0)
#else
#define STAMP(k) do { } while (0)
#endif
    STAMP(0); STAMP(23);
#ifndef R_BAR
#define R_BAR 1
#endif
#define SEAM(k) do { if (IN(k) && IN((k) + 1)) { xcd_barrier(bar); if (R_BAR > 1) xcd_barrier(bar); } STAMP((k) + 1); } while (0)
    if (IN(0)) REP(R_PRO) { ph_mod(p, wid, lds); STAMP(21); ph_misc(p, wid); STAMP(22); ph_convert(p, wid, 0, G == 256 ? (BG_MODE ? CV_TOTAL - CV_MOE / 2 : CV_TOTAL - CV_IALL) : CV_TOTAL, blockIdx.x, G, CVT_WAVES);
#ifdef RD_PAT
        ph_readonly<RD_PAT>(p, wid);
#endif
    } SEAM(0);
    if (IN(1)) REP(R_THIN) { ph_modreduce(p, wid); ph_h0(p, wid, lds); } SEAM(1);
    if (IN(2)) { REPS(R_GEMM, SchedInEven S{&p, G, c}; EpiInEven E{&p}; pg8::gemm_phase((LAS unsigned char*)lds, S, E, wid);); if (!BG_MODE && G == 256 && c >= 128) ph_convert(p, wid, CV_TOTAL - CV_IALL, CV_TOTAL - 2 * CV_I6, c - 128, 128, CVT_IDLE_WAVES); } SEAM(2);
    if (IN(3)) REP(R_THIN) { ph_e1(p, wid); } SEAM(3);
    #ifndef E2_ALIGN
#define E2_ALIGN true
#endif
    if (IN(4)) REPS(R_GEMM, SchedE2 S{&p, G, c}; EpiE2 E{&p}; pg8::gemm_phase<EpiE2, SchedE2, E2_ALIGN>((LAS unsigned char*)lds, S, E, wid);); SEAM(4);
    if (IN(5)) REP(R_ATTM) { att::attn_phase<false>(p, wid, (LAS unsigned char*)lds, G, c); } SEAM(5);
    if (IN(6)) { REPS(R_GEMM, SchedOut S{&p, G, c, 0}; EpiOut E{&p, 0}; pg8::gemm_phase((LAS unsigned char*)lds, S, E, wid);); if (!BG_MODE && G == 256 && c >= 128) ph_convert(p, wid, CV_TOTAL - 2 * CV_I6, CV_TOTAL - CV_I6, c - 128, 128, CVT_IDLE_WAVES); } SEAM(6);
    if (IN(7)) REP(R_LN1) { ph_ln1(p, wid, 0, lds); } SEAM(7);
    if (IN(8)) REP(R_TOPK) { ph_topk(p, wid, lds); } SEAM(8);
    {
        const bool bgm = BG_MODE && G == 256, isbg = bgm && (c & 31) >= 24;
        const int fG = bgm ? 192 : G, fc = bgm ? (c >> 5) * 24 + (c & 31) : c, bgi = (c >> 5) * 8 + (c & 31) - 24;
        if (IN(9)) { if (isbg) ph_convert_moe_bg(p, wid, CV_MOE / 2, CV_MOE / 2 + BG_SPLIT, bgi, 64, 8); else REPS(R_MOE, SchedGU S{&p, fG, fc, 0}; EpiGU E{&p}; pg8::gemm_phase((LAS unsigned char*)lds, S, E, wid);); } SEAM(9);
        if (IN(10)) { if (isbg) ph_convert_moe_bg(p, wid, CV_MOE / 2 + BG_SPLIT, CV_MOE, bgi, 64, 8); else REPS(R_MOE, SchedDown S{&p, fG, fc, 0}; EpiDown E{&p}; pg8::gemm_phase((LAS unsigned char*)lds, S, E, wid);); } SEAM(10);
    }
    if (IN(11)) REP(R_LN2) { ph_ln2(p, wid, 0, lds); } SEAM(11);
    if (IN(12)) REPS(R_GEMM, SchedInOdd S{&p, G, c}; EpiInOdd E{&p}; pg8::gemm_phase((LAS unsigned char*)lds, S, E, wid);); SEAM(12);
    if (IN(13)) REP(R_ATTS) { att::attn_phase<true>(p, wid, (LAS unsigned char*)lds, G, c); } SEAM(13);
    if (IN(14)) { REPS(R_GEMM, SchedOut S{&p, G, c, 1}; EpiOut E{&p, 1}; pg8::gemm_phase((LAS unsigned char*)lds, S, E, wid);); if (!BG_MODE && G == 256 && c >= 128) ph_convert(p, wid, CV_TOTAL - CV_I6, CV_TOTAL, c - 128, 128, CVT_IDLE_WAVES); } SEAM(14);
    if (IN(15)) REP(R_LN1) { ph_ln1(p, wid, 1, lds); } SEAM(15);
    if (IN(16)) REP(R_TOPK) { ph_topk(p, wid, lds); } SEAM(16);
    if (IN(17)) REPS(R_MOE, SchedGU S{&p, G, c, 1}; EpiGU E{&p}; pg8::gemm_phase((LAS unsigned char*)lds, S, E, wid);); SEAM(17);
    if (IN(18)) REPS(R_MOE, SchedDown S{&p, G, c, 1}; EpiDown E{&p}; pg8::gemm_phase((LAS unsigned char*)lds, S, E, wid);); SEAM(18);
    if (IN(19)) REP(R_LN2) { ph_ln2(p, wid, 1, lds); }
#ifdef STAMP_A
    STAMP(20);
    if (blockIdx.x == 0 && wid == 0 && fresh_lane() == 0) {
        asm volatile("s_waitcnt vmcnt(0)" ::: "memory");
        const unsigned long long d = (__hip_atomic_load(&stamps_[STAMP_B], __ATOMIC_RELAXED, __HIP_MEMORY_SCOPE_AGENT) - __hip_atomic_load(&stamps_[STAMP_A], __ATOMIC_RELAXED, __HIP_MEMORY_SCOPE_AGENT)) * 4ull;
        const unsigned long long t0 = __builtin_amdgcn_s_memrealtime();
        while (__builtin_amdgcn_s_memrealtime() - t0 < d) __builtin_amdgcn_s_sleep(8);
    }
#endif
#undef IN
#undef SEAM
}

extern "C" void kernel_launch(void* const* d_in, const int* in_sizes, int n_in, void* d_out, int out_size, void* d_ws, size_t ws_size, hipStream_t stream) {
    static int grid = 0;
    if (grid == 0) {
        if (n_in != 29 || out_size != (int)O_END || ws_size < WS_END) { fprintf(stderr, "kernel_launch: unexpected shapes (n_in %d out %d ws %zu need %zu)\n", n_in, out_size, ws_size, (size_t)WS_END); grid = -1; return; }
        int dev = 0, cus = 0, per_cu = 0;
        if (hipGetDevice(&dev) != hipSuccess || hipDeviceGetAttribute(&cus, hipDeviceAttributeMultiprocessorCount, dev) != hipSuccess) { grid = -1; return; }
        if (hipFuncSetAttribute((const void*)mega, hipFuncAttributeMaxDynamicSharedMemorySize, LDS_BYTES) != hipSuccess) { fprintf(stderr, "hipFuncSetAttribute failed\n"); grid = -1; return; }
        if (hipOccupancyMaxActiveBlocksPerMultiprocessor(&per_cu, (const void*)mega, NTHREADS, LDS_BYTES) != hipSuccess || per_cu < 1) fprintf(stderr, "occupancy query: %d\n", per_cu);
        (void)hipGetLastError();
        grid = cus > 0 ? cus : 256;
    }
    if (grid < 0) return;
    Params p{};
    for (int i = 0; i < 29; ++i) p.in[i] = (const float*)d_in[i];
    p.out = (float*)d_out; p.ws = (unsigned char*)d_ws; p.ph_lo = 0; p.ph_hi = NPH; p.rpb = (T + grid - 1) / grid; p.pad = 0;
    (void)hipMemsetAsync((char*)d_ws + WS_CTL, 0, 32768, stream);
    hipLaunchKernelGGL(mega, dim3(grid), dim3(NTHREADS), LDS_BYTES, stream, p);
}
```

```cpp
#include <hip/hip_runtime.h>
#include <cstdio>
#include <cstdint>

constexpr int D = 2048, T_CTX = 4096, T = 12288, TC = 4096, TX = 16384;
constexpr int MODW = 12288, NCOND = 9;
constexpr int NSLOT = 1536, NXS = 16 * NSLOT;
constexpr float DN_ALPHA = 1.41421356237309515f;
constexpr float LOG2E = 1.44269504088896341f;
constexpr float QS_MLA = 0.07216878364870322f * LOG2E;
constexpr float QS_SWA = 0.125f * LOG2E;
constexpr int NTHREADS = 512, NWAVES = 8;
#ifndef MOE_F8
#define MOE_F8 1
#endif
#ifndef OUT_F8
#define OUT_F8 1
#endif
constexpr float GU_WSCALE = 32.f, DN_WSCALE = 64.f, OUT_WSCALE = 64.f;

constexpr size_t O_Y = 0, O_CKV = 25165824, O_KPE = 26214400, O_SK = 26476544, O_SV = 27525120, O_END = 28573696;

constexpr size_t al256(size_t x) { return (x + 255) & ~(size_t)255; }
constexpr size_t WS_CTL = 0, CTL_BYTES = 1u << 20;
constexpr size_t WS_MOD = WS_CTL + CTL_BYTES;
constexpr size_t WS_ROPE = WS_MOD + al256((size_t)2 * 9 * 12288 * 4);
constexpr size_t WS_WINE = WS_ROPE + al256((size_t)2 * 1024 * 32 * 4);
constexpr size_t WS_W2 = WS_WINE + (size_t)2048 * 2048 * 2;
constexpr size_t WS_WOUTE = WS_W2 + (size_t)4608 * 1792 * 2;
constexpr size_t WS_WINO = WS_WOUTE + (size_t)2048 * 2048 * 2;
constexpr size_t WS_WOUTO = WS_WINO + (size_t)2560 * 2048 * 2;
constexpr size_t WS_WGU = WS_WOUTO + (size_t)2048 * 2048 * 2;
constexpr size_t WS_WDN = WS_WGU + (size_t)32 * 4096 * 2048 * 2;
constexpr size_t WS_H = WS_WDN + (size_t)32 * 2048 * 2048 * 2;
constexpr size_t WS_PJ = WS_H + (size_t)T * 2048 * 2;
constexpr size_t WS_ACT2 = WS_PJ + (size_t)T * 1792 * 4;
constexpr size_t WS_KPE = WS_ACT2 + (size_t)TX * 1792 * 2;
constexpr size_t WS_Q = WS_KPE + (size_t)TX * 64 * 2;
constexpr size_t WS_KN = WS_Q + (size_t)T * 2048 * 2;
constexpr size_t WS_VT = WS_KN + (size_t)TX * 1024 * 2;
constexpr size_t WS_VTO = WS_VT + (size_t)1024 * TX * 2;
constexpr size_t WS_KO = WS_VTO + (size_t)256 * TX * 2;
constexpr size_t WS_MIX = WS_KO + (size_t)TX * 256 * 2;
constexpr size_t WS_Y = WS_MIX + (size_t)T * 2048 * 2;
constexpr size_t WS_X1 = WS_Y + (size_t)T * 2048 * 4;
constexpr size_t WS_XL = WS_X1 + (size_t)T * 2048 * 4;
constexpr size_t WS_AFF = WS_XL + (size_t)T * 2048 * 4;
constexpr size_t WS_INV = WS_AFF + (size_t)T * 16 * 4;
constexpr size_t WS_XS = WS_INV + (size_t)T * 16 * 4;
constexpr size_t WS_HID = WS_XS + (size_t)NXS * 2048 * 2;
constexpr size_t WS_YE = WS_HID + (size_t)NXS * 2048 * 2;
constexpr size_t WS_AFFT = WS_YE + (size_t)NXS * 2048 * 2;
constexpr size_t WS_H8 = WS_AFFT + (size_t)T * 16 * 4;
constexpr size_t WS_STAT = WS_H8 + (size_t)T * 2048;
constexpr size_t WS_MODP = WS_STAT + (size_t)T * 8;
constexpr size_t WS_GB = WS_MODP + (size_t)4 * 2 * 9 * 12288 * 4;
constexpr size_t WS_DBG = WS_GB + (size_t)2 * 9 * 2 * 2048 * 4;
constexpr size_t WS_END = WS_DBG + (1u << 20);

typedef unsigned short bf16_t;
typedef float f32x4 __attribute__((ext_vector_type(4)));
typedef unsigned u32x4 __attribute__((ext_vector_type(4)));
typedef unsigned u32x2 __attribute__((ext_vector_type(2)));
typedef float f32x2 __attribute__((ext_vector_type(2)));
#define LAS __attribute__((address_space(3)))
#define DI __device__ __forceinline__

struct Params {
    const float* in[29];
    float* out;
    unsigned char* ws;
    int ph_lo, ph_hi;
    int rpb, pad;
};

DI unsigned f2bf(float f) { unsigned u = __float_as_uint(f); return (u + 0x7fffu + ((u >> 16) & 1u)) >> 16; }
typedef __bf16 bf16x2_hw __attribute__((ext_vector_type(2)));
DI unsigned pk2(float lo, float hi) { f32x2 v = {lo, hi}; bf16x2_hw b = __builtin_convertvector(v, bf16x2_hw); return __builtin_bit_cast(unsigned, b); }
DI unsigned pk4_fp8(float a, float b, float c, float d) { unsigned w = 0; w = __builtin_amdgcn_cvt_pk_fp8_f32(a, b, w, false); w = __builtin_amdgcn_cvt_pk_fp8_f32(c, d, w, true); return w; }
DI float bf2f(unsigned b) { return __uint_as_float(b << 16); }
DI float bflo(unsigned w) { return __uint_as_float(w << 16); }
DI float bfhi(unsigned w) { return __uint_as_float(w & 0xffff0000u); }
DI float wave_sum(float v) {
#pragma unroll
    for (int o = 1; o < 64; o <<= 1) v += __shfl_xor(v, o);
    return v;
}
DI float wave_max(float v) {
#pragma unroll
    for (int o = 1; o < 64; o <<= 1) v = fmaxf(v, __shfl_xor(v, o));
    return v;
}
DI int fresh_lane() { int l = (int)__builtin_amdgcn_mbcnt_hi(~0u, __builtin_amdgcn_mbcnt_lo(~0u, 0u)); asm volatile("" : "+v"(l)); return l; }
DI int cond_of_row(int r) { return r < T_CTX ? 0 : 1 + ((r - T_CTX) >> 10); }
DI const float* xrow_in(const Params& p, int r) { return r < T_CTX ? p.in[0] + (size_t)r * D : p.in[1] + (size_t)(r - T_CTX) * D; }

DI float* ws_mod(const Params& p) { return (float*)(p.ws + WS_MOD); }
DI float* ws_cos(const Params& p) { return (float*)(p.ws + WS_ROPE); }
DI float* ws_sin(const Params& p) { return (float*)(p.ws + WS_ROPE) + 1024 * 32; }
template <class X> DI X* wsp(const Params& p, size_t off) { return (X*)(p.ws + off); }
DI const float* modp(const Params& p, int l, int ci, int j) { return ws_mod(p) + ((size_t)(l * 9 + ci) * MODW + (size_t)j * D); }

#define XB_TMO      128
#define XB_XCNT(j)  (256  + 64 * (j))
#define XB_XSUB(j)  (1280 + 64 * (j))
#define XB_XGEN(j)  (2304 + 64 * (j))
#define XB_TOP      3328
#define XB_TOPGEN   3392
#define XCD_BAR_WORDS 3456
#define XB_SPIN_CAP (1u << 18)

__device__ __forceinline__ unsigned xb_ld(unsigned* p)              { return __hip_atomic_load(p, __ATOMIC_RELAXED, __HIP_MEMORY_SCOPE_AGENT); }
__device__ __forceinline__ unsigned xb_add(unsigned* p, unsigned v) { return __hip_atomic_fetch_add(p, v, __ATOMIC_RELAXED, __HIP_MEMORY_SCOPE_AGENT); }
__device__ __forceinline__ unsigned xb_xcc_id() { return (unsigned)__builtin_amdgcn_s_getreg((3 << 11) | 20) & 0xFu; }
#define XB_SPIN(cond, bar) do { unsigned _sp = 0; while (cond) { __builtin_amdgcn_s_sleep(1); \
    if ((++_sp & 255u) == 0u) { if (xb_ld(&(bar)[XB_TMO])) break; if (_sp > XB_SPIN_CAP) { atomicAdd(&(bar)[XB_TMO], 1u); break; } } } } while (0)

struct XcdBarrier {
    unsigned* bar; unsigned x;
    volatile LAS unsigned* st;
};

__device__ __forceinline__ XcdBarrier xcd_barrier_post(unsigned* bar, volatile LAS unsigned* st) {
    XcdBarrier b; b.bar = bar; b.x = xb_xcc_id(); b.st = st;
    if (threadIdx.x == 0) (void)xb_add(&bar[XB_XCNT(b.x)], 1u);
    return b;
}
__device__ __forceinline__ void xcd_barrier_complete(unsigned* bar, unsigned x, unsigned& nloc, unsigned& nx) {
    const unsigned G = gridDim.x * gridDim.y * gridDim.z;
    unsigned sum, cnt, mine, sp = 0u;
    for (;;) {
        sum = 0u; cnt = 0u; mine = 0u;
#pragma unroll
        for (unsigned j = 0; j < 16; ++j) { const unsigned c = xb_ld(&bar[XB_XCNT(j)]); sum += c; cnt += (c > 0u) ? 1u : 0u; mine = (j == x) ? c : mine; }
        if (sum == G) break;
        __builtin_amdgcn_s_sleep(1);
        if ((++sp & 255u) == 0u) { if (xb_ld(&bar[XB_TMO])) break; if (sp > XB_SPIN_CAP) { atomicAdd(&bar[XB_TMO], 1u); break; } }
    }
    nloc = mine > 0u ? mine : 1u; nx = cnt > 0u ? cnt : 1u;
}

__device__ __forceinline__ void xcd_barrier(const XcdBarrier& b) {
    asm volatile("s_waitcnt vmcnt(0)" ::: "memory");
    __syncthreads();
    if (threadIdx.x == 0) {
        unsigned* bar = b.bar;
        __builtin_amdgcn_s_waitcnt(0);
        unsigned nloc = b.st[0], nx = b.st[1];
        if (nloc == 0u) { xcd_barrier_complete(bar, b.x, nloc, nx); b.st[0] = nloc; b.st[1] = nx; }
        const unsigned old = xb_add(&bar[XB_XSUB(b.x)], 1u);
        const unsigned gen = old / nloc;
        if (old + 1u == (gen + 1u) * nloc) {
            __builtin_amdgcn_fence(__ATOMIC_RELEASE, "agent");
            asm volatile("s_waitcnt vmcnt(0)" ::: "memory");
            const unsigned og = xb_add(&bar[XB_TOP], 1u);
            const unsigned tg = og / nx;
            if (og + 1u == (tg + 1u) * nx) xb_add(&bar[XB_TOPGEN], 1u);
            else XB_SPIN(xb_ld(&bar[XB_TOPGEN]) == tg, bar);
            __builtin_amdgcn_fence(__ATOMIC_ACQUIRE, "agent");
            xb_add(&bar[XB_XGEN(b.x)], 1u);
            asm volatile("s_waitcnt vmcnt(0)" ::: "memory");
        } else {
            XB_SPIN(xb_ld(&bar[XB_XGEN(b.x)]) == gen, bar);
            __builtin_amdgcn_fence(__ATOMIC_ACQUIRE, "agent");
            asm volatile("s_waitcnt vmcnt(0)" ::: "memory");
        }
    }
    __syncthreads();
}
constexpr int CW_BAR = 4096;


DI void ph_mod(const Params& p, int wid_, unsigned char* lds_raw) {
    float* s_q = (float*)lds_raw;
    float* red = s_q + 9 * 512;
    const int tid = (wid_ * 64 + fresh_lane()), lane = tid & 63, wave = wid_;
    const float* c = p.in[6]; const float* c_ctx = p.in[7]; const float* w_ada = p.in[8];
    float* MODP = wsp<float>(p, WS_MODP);
    for (int it = blockIdx.x; it < 384; it += gridDim.x) {
        const int l = it / 192, rem = it % 192, cg = rem >> 2, kq4 = rem & 3;
        for (int i = tid; i < 9 * 512; i += NTHREADS) { const int ci = i >> 9, k = kq4 * 512 + (i & 511); const float v = ci == 0 ? c_ctx[k] : c[(ci - 1) * 2048 + k]; s_q[i] = v / (1.f + expf(-v)); }
        __syncthreads();
        const float* w = w_ada + ((size_t)l * 2048 + kq4 * 512 + wave * 64) * MODW + cg * 256 + 4 * lane;
        float acc[9][4];
#pragma unroll
        for (int ci = 0; ci < 9; ++ci)
#pragma unroll
            for (int j = 0; j < 4; ++j) acc[ci][j] = 0.f;
#pragma unroll 8
        for (int kk = 0; kk < 64; ++kk) {
            const f32x4 wv = __builtin_nontemporal_load((const f32x4*)(w + (size_t)kk * MODW));
#pragma unroll
            for (int ci = 0; ci < 9; ++ci) { const float s = s_q[ci * 512 + wave * 64 + kk];
#pragma unroll
                for (int j = 0; j < 4; ++j) acc[ci][j] += s * wv[j]; }
        }
#pragma unroll
        for (int ci = 0; ci < 9; ++ci) *(f32x4*)(red + (wave * 9 + ci) * 256 + 4 * lane) = (f32x4){acc[ci][0], acc[ci][1], acc[ci][2], acc[ci][3]};
        __syncthreads();
        for (int o = tid; o < 9 * 256; o += NTHREADS) { const int ci = o >> 8, cc = o & 255; float s = 0.f;
#pragma unroll
            for (int w8 = 0; w8 < 8; ++w8) s += red[(w8 * 9 + ci) * 256 + cc];
            MODP[((size_t)(kq4 * 2 + l) * 9 + ci) * MODW + cg * 256 + cc] = s; }
        __syncthreads();
    }
}
DI void ph_modreduce(const Params& p, int wid_) {
    const float* MODP = wsp<float>(p, WS_MODP); float* MOD = ws_mod(p); const float* b_ada = p.in[9];
    const int n4 = 2 * 9 * MODW / 4;
    for (int i = blockIdx.x * NTHREADS + (wid_ * 64 + fresh_lane()); i < n4; i += gridDim.x * NTHREADS) { const int e = i * 4, l = e / (9 * MODW), col = e % MODW;
        f32x4 s = *(const f32x4*)(b_ada + l * MODW + col);
#pragma unroll
        for (int q = 0; q < 4; ++q) s += *(const f32x4*)(MODP + (size_t)q * 2 * 9 * MODW + e);
        *(f32x4*)(MOD + e) = s; }
}
DI f32x4 mod_from_partials(const Params& p, int l, int ci, int j, int col) {
    const float* MODP = wsp<float>(p, WS_MODP); const size_t e = (size_t)(l * 9 + ci) * MODW + (size_t)j * D + col;
    f32x4 s = *(const f32x4*)(p.in[9] + l * MODW + j * D + col);
#pragma unroll
    for (int q = 0; q < 4; ++q) s += *(const f32x4*)(MODP + (size_t)q * 2 * 9 * MODW + e);
    return s;
}

constexpr int CV_INE = 928, CV_UQ = 192, CV_UKV = 128, CV_POOL = 64, CV_OUT = 1024, CV_INO = 1280, CV_MOE = 98304;
constexpr int CV_TOTAL = CV_INE + CV_UQ + CV_UKV + CV_POOL + CV_OUT + CV_INO + CV_OUT + CV_MOE;
DI void cvt_f8_item(const float* src, int N, unsigned char* dst, int nrows, int w, int lane, float scale, int gu_kind) {
    const int nb8 = w & 7, kb16 = w >> 3, n4 = nb8 * 256 + 4 * lane;
    const float* s = src + (size_t)(kb16 * 16) * N + n4;
    f32x4 v[16];
#pragma unroll
    for (int k = 0; k < 16; ++k) v[k] = __builtin_nontemporal_load((const f32x4*)(s + (size_t)k * N));
    const int dr = gu_kind < 0 ? n4 : (n4 >> 7) * 256 + (n4 & 127) + gu_kind * 128;
    u32x4* d = (u32x4*)(dst + ((size_t)kb16 * nrows + dr) * 16);
#pragma unroll
    for (int j = 0; j < 4; ++j) { u32x4 o;
        o.x = pk4_fp8(v[0][j] * scale, v[1][j] * scale, v[2][j] * scale, v[3][j] * scale); o.y = pk4_fp8(v[4][j] * scale, v[5][j] * scale, v[6][j] * scale, v[7][j] * scale);
        o.z = pk4_fp8(v[8][j] * scale, v[9][j] * scale, v[10][j] * scale, v[11][j] * scale); o.w = pk4_fp8(v[12][j] * scale, v[13][j] * scale, v[14][j] * scale, v[15][j] * scale);
        d[j] = o; }
}
DI void cvt_item(const Params& p, int item, int lane) {
    const float* src; bf16_t* dst; int K, N, ldd, nb, kb, map = 0, a = 0;
    if (item < CV_INE) { src = p.in[10]; dst = wsp<bf16_t>(p, WS_WINE); K = 2048; N = 1856; ldd = 2048; nb = item % 29; kb = item / 29; map = 1; }
    else if ((item -= CV_INE) < CV_UQ) { src = p.in[13]; dst = wsp<bf16_t>(p, WS_W2); K = 512; N = 1536; ldd = 1792; nb = item % 24; kb = item / 24; }
    else if ((item -= CV_UQ) < CV_UKV) { src = p.in[14]; dst = wsp<bf16_t>(p, WS_W2); K = 256; N = 2048; ldd = 1792; nb = item % 32; kb = item / 32; map = 2; }
    else if ((item -= CV_UKV) < CV_POOL) { const int g = item >> 4, r = item & 15; src = p.in[15] + (size_t)g * 65536; dst = wsp<bf16_t>(p, WS_W2); K = 256; N = 256; ldd = 1792; nb = r & 3; kb = r >> 2; a = 3584 + g * 256; }
    else if ((item -= CV_POOL) < CV_OUT) { if (OUT_F8) { cvt_f8_item(p.in[17], 2048, wsp<unsigned char>(p, WS_WOUTE), 2048, item, lane, OUT_WSCALE, -1); return; } src = p.in[17]; dst = wsp<bf16_t>(p, WS_WOUTE); K = 2048; N = 2048; ldd = 2048; nb = item & 31; kb = item >> 5; }
    else if ((item -= CV_OUT) < CV_INO) { src = p.in[18]; dst = wsp<bf16_t>(p, WS_WINO); K = 2048; N = 2560; ldd = 2048; nb = item % 40; kb = item / 40; }
    else if ((item -= CV_INO) < CV_OUT) { if (OUT_F8) { cvt_f8_item(p.in[20], 2048, wsp<unsigned char>(p, WS_WOUTO), 2048, item, lane, OUT_WSCALE, -1); return; } src = p.in[20]; dst = wsp<bf16_t>(p, WS_WOUTO); K = 2048; N = 2048; ldd = 2048; nb = item & 31; kb = item >> 5; }
    else { item -= CV_OUT; const int mat = item >> 10, w = item & 1023, le = mat / 3, kind = mat % 3; K = 2048; N = 2048; ldd = 2048; nb = w & 31; kb = w >> 5;
        src = p.in[24 + kind] + (size_t)le * 2048 * 2048;
        if (MOE_F8) { if (kind == 2) cvt_f8_item(src, 2048, wsp<unsigned char>(p, WS_WDN) + (size_t)le * 2048 * 2048, 2048, w, lane, DN_WSCALE, -1);
            else cvt_f8_item(src, 2048, wsp<unsigned char>(p, WS_WGU) + (size_t)le * 4096 * 2048, 4096, w, lane, GU_WSCALE, kind); return; }
        if (kind == 2) dst = wsp<bf16_t>(p, WS_WDN) + (size_t)le * 2048 * 2048; else { dst = wsp<bf16_t>(p, WS_WGU) + (size_t)le * 4096 * 2048; map = 3; a = kind * 128; } }
    const int n = nb * 64 + lane;
    const float* s = src + (size_t)(kb * 64) * N + n;
    float v[64];
#pragma unroll
    for (int k = 0; k < 64; ++k) v[k] = __builtin_nontemporal_load(s + (size_t)k * N);
    int drow;
    if (map == 0) drow = n + a;
    else if (map == 1) drow = n < 768 ? n : (n < 832 ? 1792 + (n - 768) : 768 + (n - 832));
    else if (map == 2) { const int h = n >> 8, j = n & 255; drow = j < 128 ? 1536 + h * 128 + j : 2560 + h * 128 + (j - 128); }
    else drow = (n >> 7) * 256 + (n & 127) + a;
    u32x4* d = (u32x4*)(dst + (size_t)drow * ldd + kb * 64);
#pragma unroll
    for (int c8 = 0; c8 < 8; ++c8) { u32x4 o; o.x = pk2(v[8 * c8], v[8 * c8 + 1]); o.y = pk2(v[8 * c8 + 2], v[8 * c8 + 3]); o.z = pk2(v[8 * c8 + 4], v[8 * c8 + 5]); o.w = pk2(v[8 * c8 + 6], v[8 * c8 + 7]); d[c8] = o; }
}
DI void ph_convert(const Params& p, int wid_, int item_lo, int item_hi, int bid, int nblk, int nwv) {
    const int wv_ = wid_; if (wv_ >= nwv) return;
    const int lane = (wid_ * 64 + fresh_lane()) & 63, gw = bid * nwv + wv_, NGW = nblk * nwv;
    for (int it = item_lo + gw; it < item_hi; it += NGW) cvt_item(p, it, lane);
}

DI void moe_f8_addr(const Params& p, int item, int lane, const float*& s, u32x4*& d, float& scale) {
    const int mat = item >> 10, w = item & 1023, le = mat / 3, kind = mat % 3, nb8 = w & 7, kb16 = w >> 3, n4 = nb8 * 256 + 4 * lane;
    s = p.in[24 + kind] + (size_t)le * 2048 * 2048 + (size_t)(kb16 * 16) * 2048 + n4;
    const int nrows = kind == 2 ? 2048 : 4096, dr = kind == 2 ? n4 : (n4 >> 7) * 256 + (n4 & 127) + kind * 128;
    unsigned char* base = kind == 2 ? wsp<unsigned char>(p, WS_WDN) + (size_t)le * 2048 * 2048 : wsp<unsigned char>(p, WS_WGU) + (size_t)le * 4096 * 2048;
    d = (u32x4*)(base + ((size_t)kb16 * nrows + dr) * 16); scale = kind == 2 ? DN_WSCALE : GU_WSCALE;
}
DI void ph_convert_moe_bg(const Params& p, int wid_, int moe_lo, int moe_hi, int bid, int nblk, int nwv) {
    if (wid_ >= nwv) return;
    const int lane = fresh_lane(), NGW = nblk * nwv; int it = moe_lo + bid * nwv + wid_;
    if (it >= moe_hi) return;
    const float* s; u32x4* d; float sc; f32x4 v[16], vn[16];
    moe_f8_addr(p, it, lane, s, d, sc);
#pragma unroll
    for (int k = 0; k < 16; ++k) v[k] = __builtin_nontemporal_load((const f32x4*)(s + (size_t)k * 2048));
    for (;;) {
        const int itn = it + NGW; const bool more = itn < moe_hi; const float* sn = s; u32x4* dn = d; float scn = sc;
        if (more) { moe_f8_addr(p, itn, lane, sn, dn, scn);
#pragma unroll
            for (int k = 0; k < 16; ++k) vn[k] = __builtin_nontemporal_load((const f32x4*)(sn + (size_t)k * 2048)); }
#pragma unroll
        for (int j = 0; j < 4; ++j) { u32x4 o;
            o.x = pk4_fp8(v[0][j] * sc, v[1][j] * sc, v[2][j] * sc, v[3][j] * sc); o.y = pk4_fp8(v[4][j] * sc, v[5][j] * sc, v[6][j] * sc, v[7][j] * sc);
            o.z = pk4_fp8(v[8][j] * sc, v[9][j] * sc, v[10][j] * sc, v[11][j] * sc); o.w = pk4_fp8(v[12][j] * sc, v[13][j] * sc, v[14][j] * sc, v[15][j] * sc);
            d[j] = o; }
        if (!more) break;
        it = itn; d = dn; sc = scn; s = sn;
#pragma unroll
        for (int k = 0; k < 16; ++k) v[k] = vn[k];
    }
}

DI void ph_misc(const Params& p, int wid_) {
    const size_t gt = (size_t)blockIdx.x * NTHREADS + (wid_ * 64 + fresh_lane()), NGT = (size_t)gridDim.x * NTHREADS;
    float* cosT = ws_cos(p); float* sinT = ws_sin(p);
    for (size_t i = gt; i < 1024 * 32; i += NGT) { const int s = (int)(i >> 5), f = (int)(i & 31);
        const float inv = powf(10000.f, -(float)(f & 15) / 16.f); const float pos = f < 16 ? (float)(s >> 6) : (float)(s & 63); const float ang = pos * inv;
        cosT[i] = cosf(ang); sinT[i] = sinf(ang); }
    bf16_t* ACT2 = wsp<bf16_t>(p, WS_ACT2); bf16_t* KPE = wsp<bf16_t>(p, WS_KPE); bf16_t* KO = wsp<bf16_t>(p, WS_KO); bf16_t* VTO = wsp<bf16_t>(p, WS_VTO);
    const float* cckv = p.in[2]; const float* ckpe = p.in[3]; const float* csk = p.in[4]; const float* csv = p.in[5];
    for (size_t i = gt; i < (size_t)TC * 256 / 4; i += NGT) { const size_t e = i * 4; const int j = (int)(e >> 8), cc = (int)(e & 255); const f32x4 v = *(const f32x4*)(cckv + e);
        u32x2 o; o.x = pk2(v[0], v[1]); o.y = pk2(v[2], v[3]); *(u32x2*)(ACT2 + (size_t)(T + j) * 1792 + 512 + cc) = o;
        const f32x4 k = *(const f32x4*)(csk + e); u32x2 o2; o2.x = pk2(k[0], k[1]); o2.y = pk2(k[2], k[3]); *(u32x2*)(KO + (size_t)(T + j) * 256 + cc) = o2; }
    for (size_t i = gt; i < (size_t)TC * 64 / 4; i += NGT) { const size_t e = i * 4; const f32x4 v = *(const f32x4*)(ckpe + e); u32x2 o; o.x = pk2(v[0], v[1]); o.y = pk2(v[2], v[3]); *(u32x2*)(KPE + (size_t)T * 64 + e) = o; }
    for (size_t i = gt; i < (size_t)256 * (TC / 8); i += NGT) { const int f = (int)(i / (TC / 8)), j8 = (int)(i % (TC / 8)) * 8; float v[8];
#pragma unroll
        for (int q = 0; q < 8; ++q) v[q] = csv[(size_t)(j8 + q) * 256 + f];
        u32x4 o; o.x = pk2(v[0], v[1]); o.y = pk2(v[2], v[3]); o.z = pk2(v[4], v[5]); o.w = pk2(v[6], v[7]); *(u32x4*)(VTO + (size_t)f * TX + T + j8) = o; }
}

DI void ph_h0(const Params& p, int wid_, unsigned char* lds_raw) {
    const int tid = (wid_ * 64 + fresh_lane()), lane = tid & 63, wv = wid_;
    const int rpb = p.rpb, rb0 = blockIdx.x * rpb, rb1 = min(rb0 + rpb, T);
    if (rb0 >= T) return;
    LAS float* P = (LAS float*)lds_raw;
    const int c_lo = cond_of_row(rb0);
    for (int i = tid; i < 2 * 2 * 512; i += NTHREADS) { const int cc = i >> 10, j = (i >> 9) & 1, col = (i & 511) * 4; const int ci = min(c_lo + cc, 8);
        *(LAS f32x4*)(P + (cc * 2 + j) * 2048 + col) = mod_from_partials(p, 0, ci, j, col); }
    __syncthreads();
    bf16_t* H = wsp<bf16_t>(p, WS_H);
    f32x4 v[8], vn[8]; int r = rb0 + wv;
    if (r < rb1) { const float* x = xrow_in(p, r) + lane * 8;
#pragma unroll
        for (int j = 0; j < 4; ++j) { v[2 * j] = __builtin_nontemporal_load((const f32x4*)(x + 512 * j)); v[2 * j + 1] = __builtin_nontemporal_load((const f32x4*)(x + 512 * j + 4)); } }
    for (; r < rb1; r += NWAVES) {
        const int rn = r + NWAVES;
        if (rn < rb1) { const float* x = xrow_in(p, rn) + lane * 8;
#pragma unroll
            for (int j = 0; j < 4; ++j) { vn[2 * j] = __builtin_nontemporal_load((const f32x4*)(x + 512 * j)); vn[2 * j + 1] = __builtin_nontemporal_load((const f32x4*)(x + 512 * j + 4)); } }
        asm volatile("" ::: "memory");
        const LAS float* sh = P + (cond_of_row(r) - c_lo) * 4096; const LAS float* sc = sh + 2048;
#pragma unroll
        for (int j = 0; j < 4; ++j) { const int c0 = lane * 8 + 512 * j;
            const f32x4 h0 = v[2 * j] * (1.f + *(const LAS f32x4*)(sc + c0)) + *(const LAS f32x4*)(sh + c0), h1 = v[2 * j + 1] * (1.f + *(const LAS f32x4*)(sc + c0 + 4)) + *(const LAS f32x4*)(sh + c0 + 4);
            u32x4 o; o.x = pk2(h0[0], h0[1]); o.y = pk2(h0[2], h0[3]); o.z = pk2(h1[0], h1[1]); o.w = pk2(h1[2], h1[3]); *(u32x4*)(H + (size_t)r * D + c0) = o; }
#pragma unroll
        for (int j = 0; j < 8; ++j) v[j] = vn[j];
    }
}

DI void ph_gb(const Params& p, int wid_) {
    float* GB = wsp<float>(p, WS_GB);
    for (int i = blockIdx.x * NTHREADS + (wid_ * 64 + fresh_lane()); i < 2 * 9 * 512; i += gridDim.x * NTHREADS) { const int l = i / (9 * 512), ci = (i / 512) % 9, col = (i & 511) * 4;
        const f32x4 g = *(const f32x4*)(p.in[21] + l * D + col), b = *(const f32x4*)(p.in[22] + l * D + col), sh = *(const f32x4*)(modp(p, l, ci, 3) + col), sc = *(const f32x4*)(modp(p, l, ci, 4) + col);
        *(f32x4*)(GB + ((size_t)(l * 9 + ci) * 2 + 0) * D + col) = g * (1.f + sc); *(f32x4*)(GB + ((size_t)(l * 9 + ci) * 2 + 1) * D + col) = b * (1.f + sc) + sh; }
}
struct E1Row { f32x4 cq[2], ckv, u[4], ad[4], sb[4]; };
DI void e1_seq(int r, int& s, int& S, int& rb) { if (r < T_CTX) { s = r & 255; S = 256; } else { s = (r - T_CTX) & 1023; S = 1024; } rb = r - s; }
DI void e1_load(const float* PJ, int r, int lane, E1Row& L) {
    const float* pr = PJ + (size_t)r * 1792; int s, S, rb; e1_seq(r, s, S, rb);
    L.cq[0] = *(const f32x4*)(pr + lane * 4); L.cq[1] = *(const f32x4*)(pr + lane * 4 + 256); L.ckv = *(const f32x4*)(pr + 512 + lane * 4);
#pragma unroll
    for (int g = 0; g < 4; ++g) { const int half = 1 << g, c0 = 768 + g * 256 + lane * 4; const int ia = s + half - 1, ib = s - half - 1;
        L.u[g] = *(const f32x4*)(pr + c0);
        const float ma = ia < S ? 1.f : 0.f, mb = ib >= 0 ? 1.f : 0.f;
        L.ad[g] = *(const f32x4*)(PJ + (size_t)(rb + min(ia, S - 1)) * 1792 + c0) * ma; L.sb[g] = *(const f32x4*)(PJ + (size_t)(rb + max(ib, 0)) * 1792 + c0) * mb; }
}
DI void e1_window_before(const float* PJ, int r, int lane, f32x4 (&wsum)[4]) {
    int s, S, rb; e1_seq(r, s, S, rb);
#pragma unroll
    for (int g = 0; g < 4; ++g) { const int half = 1 << g, c0 = 768 + g * 256 + lane * 4; const int lo = max(s - 1 - half, 0), hi = min(s - 1 + half, S);
        f32x4 sum = {0.f, 0.f, 0.f, 0.f};
        for (int t = lo; t < hi; ++t) sum += *(const f32x4*)(PJ + (size_t)(rb + t) * 1792 + c0);
        wsum[g] = sum; }
}
DI void ph_e1(const Params& p, int wid_) {
    ph_gb(p, wid_);
    const int lane = fresh_lane();
    const int rpw = (p.rpb + NWAVES - 1) / NWAVES, rb0 = blockIdx.x * p.rpb, ra = rb0 + wid_ * rpw, rz = min(min(ra + rpw, rb0 + p.rpb), T);
    if (ra >= rz) return;
    const float* PJ = wsp<float>(p, WS_PJ); bf16_t* ACT2 = wsp<bf16_t>(p, WS_ACT2);
    const float* qn = p.in[11]; const float* kvn = p.in[12];
    const f32x4 gq0 = *(const f32x4*)(qn + lane * 4), gq1 = *(const f32x4*)(qn + lane * 4 + 256), gkv = *(const f32x4*)(kvn + lane * 4);
    f32x4 wsum[4]; E1Row A, B;
    e1_load(PJ, ra, lane, A);
    e1_window_before(PJ, ra, lane, wsum);
    for (int r = ra; r < rz; ++r) {
        if (r + 1 < rz) e1_load(PJ, r + 1, lane, B);
        bf16_t* ar = ACT2 + (size_t)r * 1792; int s, S, rb; e1_seq(r, s, S, rb);
        if (s == 0 && r != ra) e1_window_before(PJ, r, lane, wsum);
        {
            const float ss = ((A.cq[0][0] * A.cq[0][0] + A.cq[0][1] * A.cq[0][1]) + (A.cq[0][2] * A.cq[0][2] + A.cq[0][3] * A.cq[0][3])) + ((A.cq[1][0] * A.cq[1][0] + A.cq[1][1] * A.cq[1][1]) + (A.cq[1][2] * A.cq[1][2] + A.cq[1][3] * A.cq[1][3]));
            const float rs = rsqrtf(wave_sum(ss) * (1.f / 512.f) + 1e-6f);
            const f32x4 y0 = A.cq[0] * rs * gq0, y1 = A.cq[1] * rs * gq1;
            u32x2 o; o.x = pk2(y0[0], y0[1]); o.y = pk2(y0[2], y0[3]); *(u32x2*)(ar + lane * 4) = o; o.x = pk2(y1[0], y1[1]); o.y = pk2(y1[2], y1[3]); *(u32x2*)(ar + lane * 4 + 256) = o;
        }
        {
            const int c0 = lane * 4; const f32x4 v = A.ckv; const float ss = (v[0] * v[0] + v[1] * v[1]) + (v[2] * v[2] + v[3] * v[3]);
            const float rs = rsqrtf(wave_sum(ss) * (1.f / 256.f) + 1e-6f); const f32x4 y = v * rs * gkv;
            u32x2 o; o.x = pk2(y[0], y[1]); o.y = pk2(y[2], y[3]); *(u32x2*)(ar + 512 + c0) = o;
            if (r < T_CTX) *(f32x4*)(p.out + O_CKV + (size_t)r * 256 + c0) = y;
        }
#pragma unroll
        for (int g = 0; g < 4; ++g) {
            const int half = 1 << g; const int lo = max(s - half, 0), hi = min(s + half, S); const int c0 = 768 + g * 256 + lane * 4;
            wsum[g] = wsum[g] + A.ad[g] - A.sb[g];
            const f32x4 y = wsum[g] * __builtin_amdgcn_rcpf((float)(hi - lo)) - A.u[g];
            u32x2 o; o.x = pk2(y[0], y[1]); o.y = pk2(y[2], y[3]); *(u32x2*)(ar + c0) = o; }
        A = B;
    }
}

DI void ph_ln1(const Params& p, int wid_, int l, unsigned char* lds_raw) {
    constexpr int HGS = 2052;
    const int lane = fresh_lane(), tid = wid_ * 64 + lane;
    const int rb0 = blockIdx.x * p.rpb, rb1 = min(rb0 + p.rpb, T);
    if (rb0 >= T) return;
    LAS float* HG = (LAS float*)lds_raw;
    LAS float* red = HG + 16 * HGS;
    const float* wr = p.in[23] + (size_t)l * 2048 * 16;
    float bk[64];
#pragma unroll
    for (int s = 0; s < 64; ++s) bk[s] = wr[(size_t)(wid_ * 256 + 4 * s + (lane >> 4)) * 16 + (lane & 15)];
    const float* Y = wsp<float>(p, WS_Y); float* STAT = wsp<float>(p, WS_STAT); bf16_t* H = wsp<bf16_t>(p, WS_H); float* AFF = wsp<float>(p, WS_AFF); float* AFFT = wsp<float>(p, WS_AFFT);
    unsigned char* H8 = wsp<unsigned char>(p, WS_H8);
    f32x4 v[8], vn[8], gg[8], gb[8];
#define LN1_ROW(i) (rb0 + 16 * ((i) >> 1) + wid_ + 8 * ((i) & 1))
#define LN1_LOAD(dst, rr) do { if ((rr) < rb1) { _Pragma("unroll") for (int j = 0; j < 4; ++j) { const float* y = Y + (size_t)(rr) * D + lane * 8 + 512 * j; dst[2 * j] = *(const f32x4*)y; dst[2 * j + 1] = *(const f32x4*)(y + 4); } } } while (0)
    const int ngrp = (rb1 - rb0 + 15) >> 4;
    LN1_LOAD(v, LN1_ROW(0));
    for (int g = 0; g < ngrp; ++g) {
#pragma unroll
        for (int h2 = 0; h2 < 2; ++h2) { const int i = 2 * g + h2, r = LN1_ROW(i), rl = wid_ + 8 * h2;
            LN1_LOAD(vn, LN1_ROW(i + 1));
            if (r < rb1) {
                const int ci = cond_of_row(r); const float* gv = wsp<float>(p, WS_GB) + (size_t)(l * 9 + ci) * 2 * D; const float* bv = gv + D;
#pragma unroll
                for (int j = 0; j < 8; ++j) { const int cc = lane * 8 + 512 * (j >> 1) + 4 * (j & 1); gg[j] = *(const f32x4*)(gv + cc); gb[j] = *(const f32x4*)(bv + cc); }
                float s = 0.f;
#pragma unroll
                for (int j = 0; j < 8; ++j) s += (v[j][0] + v[j][1]) + (v[j][2] + v[j][3]);
                const float mean = wave_sum(s) * (1.f / D); float s2 = 0.f;
#pragma unroll
                for (int j = 0; j < 8; ++j) { v[j] = v[j] - mean; s2 += (v[j][0] * v[j][0] + v[j][1] * v[j][1]) + (v[j][2] * v[j][2] + v[j][3] * v[j][3]); }
                const float rstd = rsqrtf(wave_sum(s2) * (1.f / D) + 1e-5f);
#pragma unroll
                for (int j = 0; j < 4; ++j) { const int c0 = lane * 8 + 512 * j;
                    const f32x4 a = v[2 * j] * rstd * gg[2 * j] + gb[2 * j], b = v[2 * j + 1] * rstd * gg[2 * j + 1] + gb[2 * j + 1];
                    *(LAS f32x4*)(HG + rl * HGS + c0) = a; *(LAS f32x4*)(HG + rl * HGS + c0 + 4) = b;
                    if (!MOE_F8) { u32x4 o; o.x = pk2(a[0], a[1]); o.y = pk2(a[2], a[3]); o.z = pk2(b[0], b[1]); o.w = pk2(b[2], b[3]); *(u32x4*)(H + (size_t)r * D + c0) = o; }
                    u32x2 o8; o8.x = pk4_fp8(a[0], a[1], a[2], a[3]); o8.y = pk4_fp8(b[0], b[1], b[2], b[3]); *(u32x2*)(H8 + (size_t)r * D + c0) = o8; }
                if (lane == 0) *(f32x2*)(STAT + 2 * (size_t)r) = (f32x2){mean, rstd};
            } else {
#pragma unroll
                for (int j = 0; j < 4; ++j) { const int c0 = lane * 8 + 512 * j; *(LAS f32x4*)(HG + rl * HGS + c0) = (f32x4){0.f, 0.f, 0.f, 0.f}; *(LAS f32x4*)(HG + rl * HGS + c0 + 4) = (f32x4){0.f, 0.f, 0.f, 0.f}; } }
#pragma unroll
            for (int j = 0; j < 8; ++j) v[j] = vn[j];
        }
        __syncthreads();
        {
            f32x4 acc = {0.f, 0.f, 0.f, 0.f};
            const LAS float* ap = HG + (lane & 15) * HGS + wid_ * 256 + (lane >> 4);
#pragma unroll
            for (int s = 0; s < 64; ++s) acc = __builtin_amdgcn_mfma_f32_16x16x4f32(ap[4 * s], bk[s], acc, 0, 0, 0);
#pragma unroll
            for (int rg = 0; rg < 4; ++rg) red[wid_ * 256 + ((lane >> 4) * 4 + rg) * 16 + (lane & 15)] = acc[rg];
        }
        __syncthreads();
        if (tid < 256) { const int row = tid >> 4, e = tid & 15, r = rb0 + 16 * g + row;
            float lg = 0.f;
#pragma unroll
            for (int w = 0; w < NWAVES; ++w) lg += red[w * 256 + tid];
            float m = lg;
#pragma unroll
            for (int o = 1; o < 16; o <<= 1) m = fmaxf(m, __shfl_xor(m, o));
            const float ex = expf(lg - m); float den = ex;
#pragma unroll
            for (int o = 1; o < 16; o <<= 1) den += __shfl_xor(den, o);
            if (r < rb1) { const float af = ex / den; AFF[(size_t)r * 16 + e] = af; AFFT[(size_t)e * T + r] = af; } }
        __syncthreads();
    }
#undef LN1_LOAD
#undef LN1_ROW
}

DI int wave_incl_scan(int v, int lane) {
#pragma unroll
    for (int o = 1; o < 64; o <<= 1) { const int u = __shfl_up(v, o); v += lane >= o ? u : 0; }
    return v;
}
DI int block_excl_scan2(int a0, int a1, int tid, int lane, int wave, int* wsum) {
    const int s = a0 + a1, incl = wave_incl_scan(s, lane);
    if (lane == 63) wsum[wave] = incl;
    __syncthreads();
    int base = 0;
#pragma unroll
    for (int w = 0; w < NWAVES; ++w) base += w < wave ? wsum[w] : 0;
    __syncthreads();
    return base + incl - s;
}
DI void ph_topk(const Params& p, int wid_, unsigned char* lds_raw) {
    const int tid = (wid_ * 64 + fresh_lane()), lane = tid & 63, wave = wid_;
    unsigned* vb = (unsigned*)lds_raw;
    int* hist = (int*)(vb + 1024);
    int* wsum = hist + 256;
    int* ctl = wsum + 16;
    int* selrow = ctl + 4;
    int* selslot = selrow + 128;
    int* nsel = selslot + 128;
    const float* AFFT = wsp<float>(p, WS_AFFT); int* INV = wsp<int>(p, WS_INV); const bf16_t* H = wsp<bf16_t>(p, WS_H); const unsigned char* H8 = wsp<unsigned char>(p, WS_H8); bf16_t* XS = wsp<bf16_t>(p, WS_XS);
    for (int it = blockIdx.x; it < 384; it += gridDim.x) {
        int n, cap, r0, e, sb;
        if (it < 128) { const int b = it >> 4; e = it & 15; n = 1024; cap = 128; r0 = T_CTX + b * 1024; sb = 512 + b * 128; }
        else { const int li = it - 128, b = li >> 4; e = li & 15; n = 256; cap = 32; r0 = b * 256; sb = b * 32; }
        const int i0 = 2 * tid, i1 = 2 * tid + 1;
        unsigned b0 = 0u, b1 = 0u;
        if (i0 < n) { const f32x2 a = *(const f32x2*)(AFFT + (size_t)e * T + r0 + i0); b0 = __float_as_uint(a[0]); b1 = __float_as_uint(a[1]); vb[i0] = b0; vb[i1] = b1; }
        if (tid == 0) *nsel = 0;
        unsigned prefix = 0u; int need = cap;
#pragma unroll
        for (int pass = 0; pass < 4; ++pass) { const int shift = 24 - 8 * pass;
            if (tid < 256) hist[tid] = 0;
            __syncthreads();
            if (i0 < n) { const bool m0 = pass == 0 || (b0 >> (shift + 8)) == prefix, m1 = pass == 0 || (b1 >> (shift + 8)) == prefix;
                if (m0) atomicAdd(&hist[(b0 >> shift) & 255u], 1); if (m1) atomicAdd(&hist[(b1 >> shift) & 255u], 1); }
            __syncthreads();
            if (wave == 0) { int h4[4], s = 0;
#pragma unroll
                for (int j = 0; j < 4; ++j) { h4[j] = hist[255 - (4 * lane + j)]; s += h4[j]; }
                const int incl = wave_incl_scan(s, lane), excl = incl - s;
                if (excl < need && need <= incl) { int cum = excl, bin = 0, nn = need; bool done = false;
#pragma unroll
                    for (int j = 0; j < 4; ++j) { if (!done) { if (cum + h4[j] >= need) { bin = 255 - (4 * lane + j); nn = need - cum; done = true; } else cum += h4[j]; } }
                    ctl[0] = bin; ctl[1] = nn; } }
            __syncthreads();
            prefix = (prefix << 8) | (unsigned)ctl[0]; need = ctl[1];
        }
        const int g0 = (i0 < n && b0 > prefix) ? 1 : 0, g1 = (i0 < n && b1 > prefix) ? 1 : 0, q0 = (i0 < n && b0 == prefix) ? 1 : 0, q1 = (i0 < n && b1 == prefix) ? 1 : 0;
        const int eqb = block_excl_scan2(q0, q1, tid, lane, wave, wsum);
        const int s0 = g0 | (q0 & (eqb < need ? 1 : 0)), s1 = g1 | (q1 & (eqb + q0 < need ? 1 : 0));
        const int slb = block_excl_scan2(s0, s1, tid, lane, wave, wsum);
        if (i0 < n) {
            INV[(size_t)(r0 + i0) * 16 + e] = s0 ? sb + slb : -1; INV[(size_t)(r0 + i1) * 16 + e] = s1 ? sb + slb + s0 : -1;
            if (s0) { const int pos = atomicAdd(nsel, 1); selrow[pos] = i0; selslot[pos] = slb; }
            if (s1) { const int pos = atomicAdd(nsel, 1); selrow[pos] = i1; selslot[pos] = slb + s0; } }
        __syncthreads();
        const int ns = *nsel;
        for (int k0 = wave; k0 < ns; k0 += 4 * NWAVES) {
            if (MOE_F8) { u32x4 bufr[4][2];
#pragma unroll
                for (int b = 0; b < 4; ++b) { const int k = k0 + NWAVES * b; if (k < ns) { const u32x4* src = (const u32x4*)(H8 + (size_t)(r0 + selrow[k]) * D); bufr[b][0] = src[lane]; bufr[b][1] = src[lane + 64]; } }
#pragma unroll
                for (int b = 0; b < 4; ++b) { const int k = k0 + NWAVES * b; if (k < ns) { u32x4* dst = (u32x4*)((unsigned char*)XS + (size_t)(e * NSLOT + sb + selslot[k]) * D); dst[lane] = bufr[b][0]; dst[lane + 64] = bufr[b][1]; } } }
            else {
#pragma unroll
                for (int b = 0; b < 4; ++b) { const int k = k0 + NWAVES * b; if (k < ns) { const u32x4* src = (const u32x4*)(H + (size_t)(r0 + selrow[k]) * D); u32x4* dst = (u32x4*)(XS + (size_t)(e * NSLOT + sb + selslot[k]) * D);
#pragma unroll
                    for (int j = 0; j < 4; ++j) dst[lane + 64 * j] = src[lane + 64 * j]; } } } }
        __syncthreads();
    }
}

DI void ph_ln2(const Params& p, int wid_, int l, unsigned char* lds_raw) {
    const int tid = (wid_ * 64 + fresh_lane()), lane = tid & 63, wv = wid_;
    const int rpb = p.rpb, rb0 = blockIdx.x * rpb, rb1 = min(rb0 + rpb, T);
    if (rb0 >= T) return;
    LAS float* PV = (LAS float*)lds_raw;
    LAS float* PC = PV + 4 * 2048;
    const int c_lo = cond_of_row(rb0);
    for (int i = tid; i < 4 * 512; i += NTHREADS) { const int w = i >> 9, col = (i & 511) * 4; const float* src = w == 0 ? p.in[21] + l * D : w == 1 ? p.in[22] + l * D : w == 2 ? p.in[27] + l * D : p.in[28] + l * D;
        *(LAS f32x4*)(PV + w * 2048 + col) = *(const f32x4*)(src + col); }
    for (int i = tid; i < 2 * 3 * 512; i += NTHREADS) { const int cc = i / 1536, w = (i / 512) % 3, col = (i & 511) * 4; const int ci = min(c_lo + cc, 8);
        const float* src = w == 0 ? modp(p, l, ci, 5) : modp(p, 1, ci, w == 1 ? 0 : 1);
        *(LAS f32x4*)(PC + (cc * 3 + w) * 2048 + col) = *(const f32x4*)(src + col); }
    __syncthreads();
    const float* Y = wsp<float>(p, WS_Y); const float* STAT = wsp<float>(p, WS_STAT);
    const float* AFF = wsp<float>(p, WS_AFF); const int* INV = wsp<int>(p, WS_INV); const bf16_t* YE = wsp<bf16_t>(p, WS_YE);
    float* XL = wsp<float>(p, WS_XL); bf16_t* H = wsp<bf16_t>(p, WS_H);
    f32x4 x[8], xn[8]; int sl = -1, sln = -1; float af = 0.f, afn = 0.f; f32x2 st = {0.f, 1.f}, stn = {0.f, 1.f};
    int r = rb0 + wv;
#define LN2_LOAD(dx, ds, da, dt, rr) do { if ((rr) < rb1) { _Pragma("unroll") for (int j = 0; j < 4; ++j) { const float* y = Y + (size_t)(rr) * D + lane * 8 + 512 * j; dx[2 * j] = *(const f32x4*)y; dx[2 * j + 1] = *(const f32x4*)(y + 4); } \
        if (lane < 16) { ds = INV[(size_t)(rr) * 16 + lane]; da = AFF[(size_t)(rr) * 16 + lane]; } dt = *(const f32x2*)(STAT + 2 * (size_t)(rr)); } } while (0)
    LN2_LOAD(x, sl, af, st, r);
    for (; r < rb1; r += NWAVES) {
        asm volatile("" ::: "memory");
        LN2_LOAD(xn, sln, afn, stn, r + NWAVES);
        const LAS float* pc = PC + (cond_of_row(r) - c_lo) * 3 * 2048;
        f32x4 f[8];
#pragma unroll
        for (int j = 0; j < 8; ++j) f[j] = (f32x4){0.f, 0.f, 0.f, 0.f};
        {
            unsigned long long mk = __ballot(sl >= 0) & 0xffffull;
            while (mk) {
                const int e0 = __builtin_ctzll(mk); mk &= mk - 1; const bool two = mk != 0ull; const int e1 = two ? __builtin_ctzll(mk) : e0; if (two) mk &= mk - 1;
                const int s0 = __shfl(sl, e0), s1 = __shfl(sl, e1); const float w0 = __shfl(af, e0), w1 = two ? __shfl(af, e1) : 0.f;
                const bf16_t* y0 = YE + (size_t)(e0 * NSLOT + s0) * D + lane * 8; const bf16_t* y1 = YE + (size_t)(e1 * NSLOT + s1) * D + lane * 8;
                u32x4 q0[4], q1[4];
#pragma unroll
                for (int j = 0; j < 4; ++j) { q0[j] = *(const u32x4*)(y0 + 512 * j); q1[j] = *(const u32x4*)(y1 + 512 * j); }
#pragma unroll
                for (int j = 0; j < 4; ++j) {
                    f[2 * j][0] += w0 * bflo(q0[j].x) + w1 * bflo(q1[j].x); f[2 * j][1] += w0 * bfhi(q0[j].x) + w1 * bfhi(q1[j].x); f[2 * j][2] += w0 * bflo(q0[j].y) + w1 * bflo(q1[j].y); f[2 * j][3] += w0 * bfhi(q0[j].y) + w1 * bfhi(q1[j].y);
                    f[2 * j + 1][0] += w0 * bflo(q0[j].z) + w1 * bflo(q1[j].z); f[2 * j + 1][1] += w0 * bfhi(q0[j].z) + w1 * bfhi(q1[j].z); f[2 * j + 1][2] += w0 * bflo(q0[j].w) + w1 * bflo(q1[j].w); f[2 * j + 1][3] += w0 * bfhi(q0[j].w) + w1 * bfhi(q1[j].w); }
            }
        }
        float s = 0.f;
#pragma unroll
        for (int j = 0; j < 8; ++j) { const int c0 = lane * 8 + 512 * (j >> 1) + 4 * (j & 1); const f32x4 x1 = (x[j] - st[0]) * st[1] * *(const LAS f32x4*)(PV + c0) + *(const LAS f32x4*)(PV + 2048 + c0);
            f[j] = DN_ALPHA * x1 + *(const LAS f32x4*)(pc + c0) * f[j]; s += (f[j][0] + f[j][1]) + (f[j][2] + f[j][3]); }
        const float mean = wave_sum(s) * (1.f / D); float s2 = 0.f;
#pragma unroll
        for (int j = 0; j < 8; ++j) { f[j] = f[j] - mean; s2 += (f[j][0] * f[j][0] + f[j][1] * f[j][1]) + (f[j][2] * f[j][2] + f[j][3] * f[j][3]); }
        const float rstd = rsqrtf(wave_sum(s2) * (1.f / D) + 1e-5f);
#pragma unroll
        for (int j = 0; j < 4; ++j) { const int c0 = lane * 8 + 512 * j; f32x4 o[2];
#pragma unroll
            for (int q = 0; q < 2; ++q) { const int cc = c0 + 4 * q; o[q] = f[2 * j + q] * rstd * *(const LAS f32x4*)(PV + 2 * 2048 + cc) + *(const LAS f32x4*)(PV + 3 * 2048 + cc);
                if (l == 0) { *(f32x4*)(XL + (size_t)r * D + cc) = o[q]; o[q] = o[q] * (1.f + *(const LAS f32x4*)(pc + 2 * 2048 + cc)) + *(const LAS f32x4*)(pc + 2048 + cc); }
                else *(f32x4*)(p.out + O_Y + (size_t)r * D + cc) = o[q]; }
            if (l == 0) { u32x4 w; w.x = pk2(o[0][0], o[0][1]); w.y = pk2(o[0][2], o[0][3]); w.z = pk2(o[1][0], o[1][1]); w.w = pk2(o[1][2], o[1][3]); *(u32x4*)(H + (size_t)r * D + c0) = w; } }
#pragma unroll
        for (int j = 0; j < 8; ++j) x[j] = xn[j];
        sl = sln; af = afn; st = stn;
    }
#undef LN2_LOAD
}
template <int PAT> DI void ph_readonly(const Params& p, int wid_) {
    const int lane = (wid_ * 64 + fresh_lane()) & 63, gw = blockIdx.x * NWAVES + wid_, NGW = gridDim.x * NWAVES;
    float accum = 0.f;
    for (int it = gw; it < 98304; it += NGW) {
        const int mat = it >> 10, w = it & 1023, le = mat / 3, kind = mat % 3;
        const float* base = p.in[24 + kind] + (size_t)le * 2048 * 2048;
        if (PAT == 0) { const int nb = w & 31, kb = w >> 5; const float* s = base + (size_t)(kb * 64) * 2048 + nb * 64 + lane; float v[64];
#pragma unroll
            for (int k = 0; k < 64; ++k) v[k] = __builtin_nontemporal_load(s + (size_t)k * 2048);
#pragma unroll
            for (int k = 0; k < 64; ++k) accum += v[k]; }
        else if (PAT == 1) { const int nb8 = w & 7, kb16 = w >> 3; const float* s = base + (size_t)(kb16 * 16) * 2048 + nb8 * 256 + 4 * lane; f32x4 v[16];
#pragma unroll
            for (int k = 0; k < 16; ++k) v[k] = __builtin_nontemporal_load((const f32x4*)(s + (size_t)k * 2048));
#pragma unroll
            for (int k = 0; k < 16; ++k) accum += (v[k][0] + v[k][1]) + (v[k][2] + v[k][3]); }
        else { const float* s = base + (size_t)w * 4096 + 4 * lane; f32x4 v[16];
#pragma unroll
            for (int k = 0; k < 16; ++k) v[k] = __builtin_nontemporal_load((const f32x4*)(s + (size_t)k * 256));
#pragma unroll
            for (int k = 0; k < 16; ++k) accum += (v[k][0] + v[k][1]) + (v[k][2] + v[k][3]); }
    }
    if (lane == 0) wsp<float>(p, WS_DBG)[gw] = accum + wave_sum(accum);
}

struct Unit { const char* A; const char* B; unsigned lda, ldb; int nt; int pm, pn; int mode; int aux; };
DI int vcu_of(int bx, int G) { return (G % 8 == 0) ? (bx % 8) * (G / 8) + bx / 8 : bx; }

DI void rope8(const Params& p, int s, int pi0, float* v) {
    const f32x4 c = *(const f32x4*)(ws_cos(p) + s * 32 + pi0), sn = *(const f32x4*)(ws_sin(p) + s * 32 + pi0);
#pragma unroll
    for (int i = 0; i < 4; ++i) { const float x1 = v[2 * i], x2 = v[2 * i + 1]; v[2 * i] = x1 * c[i] - x2 * sn[i]; v[2 * i + 1] = x1 * sn[i] + x2 * c[i]; }
}
DI void st_bf16x8(bf16_t* dst, const float* v) { u32x4 w; w.x = pk2(v[0], v[1]); w.y = pk2(v[2], v[3]); w.z = pk2(v[4], v[5]); w.w = pk2(v[6], v[7]); *(u32x4*)dst = w; }
DI void st_f32x8(float* dst, const float* v) { *(f32x4*)dst = (f32x4){v[0], v[1], v[2], v[3]}; *(f32x4*)(dst + 4) = (f32x4){v[4], v[5], v[6], v[7]}; }

struct SchedInEven { static constexpr bool BK16 = false; const Params* p; int G, c;
    DI bool next(int i, Unit& u) const { const int L = i * G + c; if (L >= 48 * 8) return false; u.pm = L >> 3; u.pn = L & 7;
        u.A = (const char*)wsp<bf16_t>(*p, WS_H) + (size_t)u.pm * 256 * 4096; u.B = (const char*)wsp<bf16_t>(*p, WS_WINE) + (size_t)u.pn * 256 * 4096; u.lda = 4096; u.ldb = 4096; u.nt = 32; u.mode = 0; u.aux = 0; return true; } };
struct EpiInEven { static constexpr bool HAS_STATE = false; static constexpr bool PAIR = false, F8 = false; const Params* p;
    DI void store(const Unit& u, int row, int col, float* v) const {
        const int r = u.pm * 256 + row, gc = u.pn * 256 + col;
        if (gc < 1792) { st_f32x8(wsp<float>(*p, WS_PJ) + (size_t)r * 1792 + gc, v); return; }
        if (gc >= 1856) return;
        const int j0 = gc - 1792;
        if (r < T_CTX) st_f32x8(p->out + O_KPE + (size_t)r * 64 + j0, v); else rope8(*p, (r - T_CTX) & 1023, j0 >> 1, v);
        st_bf16x8(wsp<bf16_t>(*p, WS_KPE) + (size_t)r * 64 + j0, v);
    } };

constexpr int E2_Q = 48 * 6, E2_K = 64 * 4, E2_V = 4 * 64, E2_P = 48 * 4, E2_TOTAL = E2_Q + E2_K + E2_V + E2_P;
struct SchedE2 { static constexpr bool BK16 = false; const Params* p; int G, c;
    DI bool next(int i, Unit& u) const { int L;
        if (G == 256) { if (c < 32) { if (i > 2) return false; L = i == 0 ? c : (i == 1 ? 256 + c : E2_Q + c); } else { if (i > 3) return false; L = i == 0 ? c : E2_Q + 32 + (c - 32) * 3 + (i - 1); } }
        else { L = i * G + c; if (L >= E2_TOTAL) return false; }
        const char* ACT2 = (const char*)wsp<bf16_t>(*p, WS_ACT2); const char* W2 = (const char*)wsp<bf16_t>(*p, WS_W2); u.aux = 0;
        if (L < E2_Q) { u.mode = 0; u.pm = L / 6; u.pn = L % 6; u.A = ACT2 + (size_t)u.pm * 256 * 3584; u.lda = 3584; u.B = W2 + (size_t)u.pn * 256 * 3584; u.ldb = 3584; u.nt = 8; return true; }
        L -= E2_Q;
        if (L < E2_K) { u.mode = 1; u.pm = L >> 2; u.pn = L & 3; u.A = ACT2 + (size_t)u.pm * 256 * 3584 + 512 * 2; u.lda = 3584; u.B = W2 + (size_t)(1536 + u.pn * 256) * 3584; u.ldb = 3584; u.nt = 4; return true; }
        L -= E2_K;
        if (L < E2_V) { u.mode = 2; u.pm = L >> 6; u.pn = L & 63; u.A = W2 + (size_t)(2560 + u.pm * 256) * 3584; u.lda = 3584; u.B = ACT2 + (size_t)u.pn * 256 * 3584 + 512 * 2; u.ldb = 3584; u.nt = 4; return true; }
        L -= E2_V;
        u.mode = 3; u.pm = L >> 2; u.aux = L & 3; u.pn = 0; u.A = ACT2 + (size_t)u.pm * 256 * 3584 + (768 + u.aux * 256) * 2; u.lda = 3584; u.B = W2 + (size_t)(3584 + u.aux * 256) * 3584; u.ldb = 3584; u.nt = 4; return true; } };
struct EpiE2 { static constexpr bool HAS_STATE = false; static constexpr bool PAIR = false, F8 = false; const Params* p;
    DI void store(const Unit& u, int row, int col, float* v) const {
        const int r = u.pm * 256 + row, gc = u.pn * 256 + col;
        if (u.mode == 0) { const int dd = gc % 192; if (dd >= 128 && r >= T_CTX) rope8(*p, (r - T_CTX) & 1023, (dd - 128) >> 1, v);
#pragma unroll
            for (int i = 0; i < 8; ++i) v[i] *= QS_MLA;
            st_bf16x8(wsp<bf16_t>(*p, WS_Q) + (size_t)r * 1536 + gc, v); }
        else if (u.mode == 1) st_bf16x8(wsp<bf16_t>(*p, WS_KN) + (size_t)r * 1024 + gc, v);
        else if (u.mode == 2) st_bf16x8(wsp<bf16_t>(*p, WS_VT) + (size_t)r * TX + gc, v);
        else { const float* ps = p->in[16] + u.aux * 256 + col;
#pragma unroll
            for (int i = 0; i < 8; ++i) v[i] *= ps[i];
            if (OUT_F8) { u32x2 o; o.x = pk4_fp8(v[0], v[1], v[2], v[3]); o.y = pk4_fp8(v[4], v[5], v[6], v[7]); *(u32x2*)((unsigned char*)wsp<bf16_t>(*p, WS_MIX) + (size_t)r * 2048 + 1024 + u.aux * 256 + col) = o; }
            else st_bf16x8(wsp<bf16_t>(*p, WS_MIX) + (size_t)r * 2048 + 1024 + u.aux * 256 + col, v); }
    } };

struct SchedOut { static constexpr bool BK16 = OUT_F8 != 0; const Params* p; int G, c, l;
    DI bool next(int i, Unit& u) const { const int L = i * G + c; if (L >= 48 * 8) return false; u.pm = L >> 3; u.pn = L & 7;
        constexpr unsigned P = OUT_F8 ? 2048 : 4096;
        u.A = (const char*)wsp<bf16_t>(*p, WS_MIX) + (size_t)u.pm * 256 * P; u.B = (const char*)wsp<bf16_t>(*p, l == 0 ? WS_WOUTE : WS_WOUTO) + (OUT_F8 ? (size_t)u.pn * 256 * 16 : (size_t)u.pn * 256 * P); u.lda = P; u.ldb = OUT_F8 ? 2048 * 16 : P; u.nt = OUT_F8 ? 16 : 32; u.mode = 0; u.aux = 0; return true; } };
struct EpiOut { static constexpr bool HAS_STATE = false; static constexpr bool PAIR = false, F8 = OUT_F8 != 0; const Params* p; int l;
    DI void store(const Unit& u, int row, int col, float* v) const {
        const int r = u.pm * 256 + row, gc = u.pn * 256 + col;
        const float* x = (l == 0 ? xrow_in(*p, r) : wsp<float>(*p, WS_XL) + (size_t)r * D) + gc; const float* g1 = modp(*p, l, cond_of_row(r), 2) + gc;
        const f32x4 x0 = *(const f32x4*)x, x1 = *(const f32x4*)(x + 4), g0 = *(const f32x4*)g1, g4 = *(const f32x4*)(g1 + 4);
#pragma unroll
        for (int i = 0; i < 4; ++i) { const float w0 = OUT_F8 ? g0[i] * (1.f / OUT_WSCALE) : g0[i], w4 = OUT_F8 ? g4[i] * (1.f / OUT_WSCALE) : g4[i]; v[i] = DN_ALPHA * x0[i] + w0 * v[i]; v[4 + i] = DN_ALPHA * x1[i] + w4 * v[4 + i]; }
        st_f32x8(wsp<float>(*p, WS_Y) + (size_t)r * D + gc, v);
    } };

struct SchedGU { static constexpr bool BK16 = MOE_F8 != 0; const Params* p; int G, c, l;
    DI bool next(int i, Unit& u) const { const int L = i * G + c; if (L >= 16 * 96) return false; const int e = L / 96, rem = L % 96; u.pn = rem / 6; u.pm = e * 6 + rem % 6; u.aux = e;
        constexpr unsigned P = MOE_F8 ? 2048 : 4096;
        u.A = (const char*)wsp<bf16_t>(*p, WS_XS) + (size_t)u.pm * 256 * P; u.B = (const char*)wsp<bf16_t>(*p, WS_WGU) + (MOE_F8 ? (size_t)(l * 16 + e) * 4096 * 2048 + (size_t)u.pn * 256 * 16 : ((size_t)(l * 16 + e) * 4096 + (size_t)u.pn * 256) * P); u.lda = P; u.ldb = MOE_F8 ? 4096 * 16 : P; u.nt = MOE_F8 ? 16 : 32; u.mode = 0; return true; } };
struct EpiGU { static constexpr bool HAS_STATE = false; static constexpr bool PAIR = true, F8 = MOE_F8 != 0; const Params* p;
    DI void store2(const Unit& u, int row, int col, const float* g, const float* up) const {
        float h[8];
#pragma unroll
        for (int i = 0; i < 8; ++i) { const float gg = MOE_F8 ? g[i] * (1.f / GU_WSCALE) : g[i], uu = MOE_F8 ? up[i] * (1.f / GU_WSCALE) : up[i]; h[i] = gg * uu * __builtin_amdgcn_rcpf(1.f + __expf(-gg)); }
        if (MOE_F8) { u32x2 o; o.x = pk4_fp8(h[0], h[1], h[2], h[3]); o.y = pk4_fp8(h[4], h[5], h[6], h[7]); *(u32x2*)((unsigned char*)wsp<bf16_t>(*p, WS_HID) + (size_t)(u.pm * 256 + row) * D + u.pn * 128 + col) = o; }
        else st_bf16x8(wsp<bf16_t>(*p, WS_HID) + (size_t)(u.pm * 256 + row) * D + u.pn * 128 + col, h);
    } };

struct SchedDown { static constexpr bool BK16 = MOE_F8 != 0; const Params* p; int G, c, l;
    DI bool next(int i, Unit& u) const { const int L = i * G + c; if (L >= 16 * 48) return false; const int e = L / 48, rem = L % 48; u.pn = rem / 6; u.pm = e * 6 + rem % 6; u.aux = e;
        constexpr unsigned P = MOE_F8 ? 2048 : 4096;
        u.A = (const char*)wsp<bf16_t>(*p, WS_HID) + (size_t)u.pm * 256 * P; u.B = (const char*)wsp<bf16_t>(*p, WS_WDN) + (MOE_F8 ? (size_t)(l * 16 + e) * 2048 * 2048 + (size_t)u.pn * 256 * 16 : ((size_t)(l * 16 + e) * 2048 + (size_t)u.pn * 256) * P); u.lda = P; u.ldb = MOE_F8 ? 2048 * 16 : P; u.nt = MOE_F8 ? 16 : 32; u.mode = 0; return true; } };
struct EpiDown { static constexpr bool HAS_STATE = false; static constexpr bool PAIR = false, F8 = MOE_F8 != 0; const Params* p;
    DI void store(const Unit& u, int row, int col, float* v) const {
        if (MOE_F8) {
#pragma unroll
            for (int i = 0; i < 8; ++i) v[i] *= (1.f / DN_WSCALE); }
        st_bf16x8(wsp<bf16_t>(*p, WS_YE) + (size_t)(u.pm * 256 + row) * D + u.pn * 256 + col, v); } };

constexpr int IO_QK = 48 * 9, IO_V = 16, IO_VT = 48, IO_TOTAL = IO_QK + IO_V + IO_VT;
struct SchedInOdd { static constexpr bool BK16 = false; const Params* p; int G, c;
    DI bool next(int i, Unit& u) const { int L = i * G + c; if (L >= IO_TOTAL) return false;
        const char* Hb = (const char*)wsp<bf16_t>(*p, WS_H); const char* W = (const char*)wsp<bf16_t>(*p, WS_WINO); u.aux = 0; u.nt = 32; u.lda = 4096; u.ldb = 4096;
        if (L < IO_QK) { u.mode = 0; u.pm = L / 9; u.pn = L % 9; u.A = Hb + (size_t)u.pm * 256 * 4096; u.B = W + (size_t)u.pn * 256 * 4096; return true; }
        L -= IO_QK;
        if (L < IO_V) { u.mode = 1; u.pm = L; u.pn = 9; u.A = Hb + (size_t)u.pm * 256 * 4096; u.B = W + (size_t)9 * 256 * 4096; return true; }
        L -= IO_V;
        u.mode = 2; u.pm = 0; u.pn = L; u.A = W + (size_t)9 * 256 * 4096; u.B = Hb + (size_t)u.pn * 256 * 4096; return true; } };
struct EpiInOdd { static constexpr bool HAS_STATE = true; static constexpr bool PAIR = false, F8 = false; const Params* p;
    struct State { f32x4 c[4], s[4]; bool rot; };
    DI void begin(State& st, const Unit& u, int row0, int col0) const {
        st.rot = u.mode == 0 && u.pm * 256 >= T_CTX;
        if (st.rot) { const int pi0 = (col0 & 63) >> 1;
#pragma unroll
            for (int ri = 0; ri < 4; ++ri) { const int r = u.pm * 256 + ri * 16 + row0, sp = (r - T_CTX) & 1023;
                st.c[ri] = *(const f32x4*)(ws_cos(*p) + sp * 32 + pi0); st.s[ri] = *(const f32x4*)(ws_sin(*p) + sp * 32 + pi0); } }
    }
    DI void store_st(const State& st, int ri, const Unit& u, int row, int col, float* v) const {
        const int r = u.pm * 256 + row, gc = u.pn * 256 + col;
        if (u.mode == 0) {
            if (gc < 2048) {
                if (st.rot) {
#pragma unroll
                    for (int i = 0; i < 4; ++i) { const float x1 = v[2 * i], x2 = v[2 * i + 1]; v[2 * i] = x1 * st.c[ri][i] - x2 * st.s[ri][i]; v[2 * i + 1] = x1 * st.s[ri][i] + x2 * st.c[ri][i]; } }
#pragma unroll
                for (int i = 0; i < 8; ++i) v[i] *= QS_SWA;
                st_bf16x8(wsp<bf16_t>(*p, WS_Q) + (size_t)r * 2048 + gc, v); }
            else { const int kc = gc - 2048; if (r < T_CTX) st_f32x8(p->out + O_SK + (size_t)r * 256 + kc, v);
                if (st.rot) {
#pragma unroll
                    for (int i = 0; i < 4; ++i) { const float x1 = v[2 * i], x2 = v[2 * i + 1]; v[2 * i] = x1 * st.c[ri][i] - x2 * st.s[ri][i]; v[2 * i + 1] = x1 * st.s[ri][i] + x2 * st.c[ri][i]; } }
                st_bf16x8(wsp<bf16_t>(*p, WS_KO) + (size_t)r * 256 + kc, v); } }
        else if (u.mode == 1) st_f32x8(p->out + O_SV + (size_t)r * 256 + col, v);
        else st_bf16x8(wsp<bf16_t>(*p, WS_VTO) + (size_t)row * TX + gc, v);
    }
    DI void store(const Unit& u, int row, int col, float* v) const {
        const int r = u.pm * 256 + row, gc = u.pn * 256 + col;
        if (u.mode == 0) {
            if (gc < 2048) { if (r >= T_CTX) rope8(*p, (r - T_CTX) & 1023, (gc & 63) >> 1, v);
#pragma unroll
                for (int i = 0; i < 8; ++i) v[i] *= QS_SWA;
                st_bf16x8(wsp<bf16_t>(*p, WS_Q) + (size_t)r * 2048 + gc, v); }
            else { const int kc = gc - 2048; if (r < T_CTX) st_f32x8(p->out + O_SK + (size_t)r * 256 + kc, v); else rope8(*p, (r - T_CTX) & 1023, (kc & 63) >> 1, v);
                st_bf16x8(wsp<bf16_t>(*p, WS_KO) + (size_t)r * 256 + kc, v); } }
        else if (u.mode == 1) st_f32x8(p->out + O_SV + (size_t)r * 256 + col, v);
        else st_bf16x8(wsp<bf16_t>(*p, WS_VTO) + (size_t)row * TX + gc, v);
    } };

namespace pg8 {
typedef short bf16x8 __attribute__((ext_vector_type(8)));
typedef int i32x4 __attribute__((ext_vector_type(4)));
typedef int i32x8 __attribute__((ext_vector_type(8)));
DI i32x8 cat8(bf16x8 lo, bf16x8 hi) { return __builtin_shufflevector(__builtin_bit_cast(i32x4, lo), __builtin_bit_cast(i32x4, hi), 0, 1, 2, 3, 4, 5, 6, 7); }
constexpr int BM = 256, BK = 64, HALF = 128, HTB = HALF * BK * 2  , STAGE_BYTES = 8 * HTB;
DI int lds_byte(int r, int c) { const int st = (r >> 4) * 2 + (c >> 5), rr = r & 15, cc = c & 31, ob = rr * 64 + cc * 2; return st * 1024 + (ob ^ (((ob >> 9) & 1) << 5)); }
DI void stage_rc(int b, int& R, int& C) { const int st = b / 1024, sb = b % 1024, swz = sb ^ (((sb >> 9) & 1) << 5); R = (st >> 1) * 16 + swz / 64; C = (st & 1) * 32 + (swz % 64) / 2; }
DI int perm32(int rho) { const int n = rho >> 4, i = rho & 15; return 8 * (i >> 2) + 4 * n + (i & 3); }

template <bool F8> struct Frag;
template <> struct Frag<false> { bf16x8 k0, k1; DI void set(bf16x8 a, bf16x8 b) { k0 = a; k1 = b; } };
template <> struct Frag<true> { i32x8 w; DI void set(bf16x8 a, bf16x8 b) { w = cat8(a, b); } };
template <class Epi, class Sched, bool ALIGN_EPI = true>
DI void gemm_phase(LAS unsigned char* lds, const Sched& S, const Epi& E, int wid) {
    const int lane = fresh_lane(), tid = wid * 64 + lane, wr = wid >> 2, wc = wid & 3, fr = lane & 15, fq = lane >> 4;
    int RA[2], RB[2], CB[2];
#pragma unroll
    for (int i = 0; i < 2; ++i) { int R, C; stage_rc(tid * 16 + i * 8192, R, C); RA[i] = R; RB[i] = (R & ~31) + perm32(R & 31); CB[i] = C * 2; }
    constexpr size_t kstep = (size_t)(BK * 2);
    const unsigned ldsw = (unsigned)wid * 1024u;
    const int aoff = lds_byte(wr * 64 + fr, fq * 8), boff = lds_byte(wc * 32 + fr, fq * 8);
#define PG8_SA(b, h) (((b) * 2 + (h)) * HTB)
#define PG8_SB(b, h) ((4 + (b) * 2 + (h)) * HTB)
#define PG8_STAGE(bufoff, gbase, v0, v1) do { unsigned o0_ = (v0), o1_ = (v1); asm volatile("" : "+v"(o0_), "+v"(o1_)); \
        __builtin_amdgcn_global_load_lds((const unsigned*)((const char*)(gbase) + o0_), (LAS unsigned*)(lds + (bufoff) + ldsw), 16, 0, 0); \
        __builtin_amdgcn_global_load_lds((const unsigned*)((const char*)(gbase) + o1_), (LAS unsigned*)(lds + (bufoff) + ldsw + 8192), 16, 0, 0); } while (0)
#define PG8_LDA(dst, b, h) do { _Pragma("unroll") for (int m = 0; m < 4; ++m) { const bf16x8 f0_ = *(const LAS bf16x8*)(lds + PG8_SA(b, h) + aoff + m * 2048), f1_ = *(const LAS bf16x8*)(lds + PG8_SA(b, h) + aoff + m * 2048 + 1024); dst[m].set(f0_, f1_); } } while (0)
#define PG8_LDB(dst, b, h) do { _Pragma("unroll") for (int n = 0; n < 2; ++n) { const bf16x8 f0_ = *(const LAS bf16x8*)(lds + PG8_SB(b, h) + boff + n * 2048), f1_ = *(const LAS bf16x8*)(lds + PG8_SB(b, h) + boff + n * 2048 + 1024); dst[n].set(f0_, f1_); } } while (0)
#define PG8_MMA(ai, bj, At, Bt) do { __builtin_amdgcn_s_setprio(1); _Pragma("unroll") for (int m = 0; m < 4; ++m) _Pragma("unroll") for (int n = 0; n < 2; ++n) { \
        if constexpr (Epi::F8) acc[ai][bj][m][n] = __builtin_amdgcn_mfma_scale_f32_16x16x128_f8f6f4(Bt[n].w, At[m].w, acc[ai][bj][m][n], 0, 0, 0, 0x7f7f7f7f, 0, 0x7f7f7f7f); \
        else { acc[ai][bj][m][n] = __builtin_amdgcn_mfma_f32_16x16x32_bf16(Bt[n].k0, At[m].k0, acc[ai][bj][m][n], 0, 0, 0); acc[ai][bj][m][n] = __builtin_amdgcn_mfma_f32_16x16x32_bf16(Bt[n].k1, At[m].k1, acc[ai][bj][m][n], 0, 0, 0); } } \
        __builtin_amdgcn_s_setprio(0); } while (0)
#define PG8_WAIT_V(n) asm volatile("s_waitcnt vmcnt(" #n ")" ::: "memory")
#define PG8_WAIT_L(n) asm volatile("s_waitcnt lgkmcnt(" #n ")" ::: "memory")
#define PG8_BAR __builtin_amdgcn_s_barrier()
#define PG8_SCHED __builtin_amdgcn_sched_barrier(0)
    Unit cur, nxt; int ui = 0;
    if (!S.next(0, cur)) return;
    f32x4 acc[2][2][4][2];
#pragma unroll
    for (int a = 0; a < 2; ++a)
#pragma unroll
        for (int b = 0; b < 2; ++b)
#pragma unroll
            for (int m = 0; m < 4; ++m)
#pragma unroll
                for (int n = 0; n < 2; ++n) acc[a][b][m][n] = (f32x4){0.f, 0.f, 0.f, 0.f};
    Frag<Epi::F8> At[4], B0[2], B1[2];
    const char* cA = cur.A; const char* cB = cur.B;
    const unsigned ld = cur.lda;
    const unsigned plane = cur.ldb;
    const unsigned vA0 = RA[0] * ld + CB[0], vA1 = RA[1] * ld + CB[1];
    const unsigned vB0 = Sched::BK16 ? (unsigned)(CB[0] >> 4) * plane + RB[0] * 16 : RB[0] * ld + CB[0], vB1 = Sched::BK16 ? (unsigned)(CB[1] >> 4) * plane + RB[1] * 16 : RB[1] * ld + CB[1];
    const size_t hA = (size_t)HALF * ld, hB = Sched::BK16 ? (size_t)HALF * 16 : hA;
    const size_t kstepB = Sched::BK16 ? (size_t)8 * plane : kstep;
    PG8_STAGE(PG8_SB(0, 0), cB, vB0, vB1); PG8_STAGE(PG8_SB(0, 1), cB + hB, vB0, vB1); PG8_STAGE(PG8_SA(0, 0), cA, vA0, vA1); PG8_STAGE(PG8_SA(0, 1), cA + hA, vA0, vA1);
    if (wr == 1) PG8_BAR;
    PG8_WAIT_V(2); PG8_BAR;
    PG8_STAGE(PG8_SB(1, 0), cB + kstepB, vB0, vB1); PG8_STAGE(PG8_SA(1, 0), cA + kstep, vA0, vA1); PG8_STAGE(PG8_SB(1, 1), cB + hB + kstepB, vB0, vB1);
    PG8_WAIT_V(6); PG8_BAR;
    for (;;) {
        const bool has_next = S.next(ui + 1, nxt);
        const char* nA = has_next ? nxt.A : cA; const char* nB = has_next ? nxt.B : cB;
        const int nt = cur.nt;
        for (int t = 0; t < nt; t += 2) {
            const bool last = (t == nt - 2);
            const char* a1 = cA + (size_t)(t + 1) * kstep;
            const char* a2 = last ? nA : cA + (size_t)(t + 2) * kstep; const char* b2 = last ? nB : cB + (size_t)(t + 2) * kstepB;
            const char* a3 = a2 + kstep; const char* b3 = b2 + kstepB;
            PG8_LDB(B0, 0, 0); PG8_LDB(B1, 0, 1); PG8_SCHED; PG8_LDA(At, 0, 0); PG8_STAGE(PG8_SA(1, 1), a1 + hA, vA0, vA1);
            PG8_WAIT_V(8); PG8_WAIT_L(0); PG8_BAR; PG8_MMA(0, 0, At, B0); PG8_MMA(0, 1, At, B1); PG8_BAR; PG8_SCHED;
            PG8_LDA(At, 0, 1); PG8_STAGE(PG8_SB(0, 0), b2, vB0, vB1); PG8_STAGE(PG8_SB(0, 1), b2 + hB, vB0, vB1); PG8_STAGE(PG8_SA(0, 0), a2, vA0, vA1);
            PG8_WAIT_V(8); PG8_WAIT_L(0); PG8_BAR; PG8_MMA(1, 0, At, B0); PG8_MMA(1, 1, At, B1); PG8_BAR; PG8_SCHED;
            PG8_LDB(B0, 1, 0); PG8_LDB(B1, 1, 1); PG8_SCHED; PG8_LDA(At, 1, 0); PG8_STAGE(PG8_SA(0, 1), a2 + hA, vA0, vA1);
            PG8_WAIT_V(8); PG8_WAIT_L(0); PG8_BAR; PG8_MMA(0, 0, At, B0); PG8_MMA(0, 1, At, B1); PG8_BAR; PG8_SCHED;
            PG8_LDA(At, 1, 1); PG8_STAGE(PG8_SB(1, 0), b3, vB0, vB1); PG8_STAGE(PG8_SB(1, 1), b3 + hB, vB0, vB1); PG8_STAGE(PG8_SA(1, 0), a3, vA0, vA1);
            PG8_WAIT_V(8); PG8_WAIT_L(0); PG8_BAR; PG8_MMA(1, 0, At, B0); PG8_MMA(1, 1, At, B1); PG8_BAR; PG8_SCHED;
        }
        if constexpr (ALIGN_EPI) { if (wr == 0) PG8_BAR; }
        {
            const int el_ = fresh_lane(); const int fr_ = el_ & 15, fq_ = el_ >> 4;
            if constexpr (Epi::HAS_STATE) {
#pragma unroll
                for (int ai = 0; ai < 2; ++ai) { typename Epi::State st; E.begin(st, cur, ai * HALF + wr * 64 + fr_, wc * 32 + 8 * fq_);
#pragma unroll
                    for (int m = 0; m < 4; ++m) { const int row = ai * HALF + wr * 64 + m * 16 + fr_;
#pragma unroll
                        for (int bj = 0; bj < 2; ++bj) { float v[8];
#pragma unroll
                            for (int j = 0; j < 4; ++j) { v[j] = acc[ai][bj][m][0][j]; v[4 + j] = acc[ai][bj][m][1][j]; }
                            E.store_st(st, m, cur, row, bj * HALF + wc * 32 + 8 * fq_, v); } } }
            } else {
#pragma unroll
            for (int ai = 0; ai < 2; ++ai)
#pragma unroll
                for (int m = 0; m < 4; ++m) { const int row = ai * HALF + wr * 64 + m * 16 + fr_;
                    if constexpr (Epi::PAIR) { float g[8], up[8];
#pragma unroll
                        for (int j = 0; j < 4; ++j) { g[j] = acc[ai][0][m][0][j]; g[4 + j] = acc[ai][0][m][1][j]; up[j] = acc[ai][1][m][0][j]; up[4 + j] = acc[ai][1][m][1][j]; }
                        E.store2(cur, row, wc * 32 + 8 * fq_, g, up);
#ifdef PROBE_EPI2
                        asm volatile("" ::: "memory"); E.store2(cur, row, wc * 32 + 8 * fq_, g, up);
#endif
                        }
                    else {
#pragma unroll
                        for (int bj = 0; bj < 2; ++bj) { float v[8];
#pragma unroll
                            for (int j = 0; j < 4; ++j) { v[j] = acc[ai][bj][m][0][j]; v[4 + j] = acc[ai][bj][m][1][j]; }
                            E.store(cur, row, bj * HALF + wc * 32 + 8 * fq_, v); } } }
            }
        }
        if (!has_next) break;
#pragma unroll
        for (int a = 0; a < 2; ++a)
#pragma unroll
            for (int b = 0; b < 2; ++b)
#pragma unroll
                for (int m = 0; m < 4; ++m)
#pragma unroll
                    for (int n = 0; n < 2; ++n) acc[a][b][m][n] = (f32x4){0.f, 0.f, 0.f, 0.f};
        cur = nxt; cA = nA; cB = nB; ++ui;
        if constexpr (ALIGN_EPI) { if (wr == 1) PG8_BAR; }
    }
    PG8_WAIT_V(0);
    if constexpr (!ALIGN_EPI) { if (wr == 0) PG8_BAR; }
    PG8_BAR;
#undef PG8_SA
#undef PG8_SB
#undef PG8_STAGE
#undef PG8_LDA
#undef PG8_LDB
#undef PG8_MMA
#undef PG8_WAIT_V
#undef PG8_WAIT_L
#undef PG8_BAR
#undef PG8_SCHED
}
}

namespace att {
typedef short bf16x8 __attribute__((ext_vector_type(8)));
typedef short s16x4 __attribute__((ext_vector_type(4)));
typedef float f32x16 __attribute__((ext_vector_type(16)));
typedef float f32x2_t __attribute__((ext_vector_type(2)));
typedef __bf16 bf16x2_t __attribute__((ext_vector_type(2)));
DI unsigned cvtpk(float lo, float hi) { f32x2_t v = {lo, hi}; bf16x2_t b = __builtin_convertvector(v, bf16x2_t); return __builtin_bit_cast(unsigned, b); }
DI int crow(int r, int h) { return (r & 3) + 8 * (r >> 2) + 4 * h; }
DI float max3f(float a, float b, float c) { float r; asm("v_max3_f32 %0, %1, %2, %3" : "=v"(r) : "v"(a), "v"(b), "v"(c)); return r; }

template <bool SWA>
DI void attn_phase(const Params& p, int wid_, LAS unsigned char* lds, int G, int c) {
    constexpr int DK = SWA ? 64 : 192, DV = SWA ? 64 : 128, KSTR = DK * 2 + 16, VSTR = 136;
    constexpr int QB = SWA ? 2 : 1;
    constexpr int KB = 64 * KSTR, VB = DV * VSTR, STG = KB + VB;
    constexpr int CPR = DK / 8, NKC = (64 * CPR) / NTHREADS, NVC = (DV * 8) / NTHREADS, NQ = DK / 16, NDV = DV / 32;
    constexpr int LDQ = SWA ? 2048 : 1536, NUNITS = SWA ? 768 : 384;
    static_assert(2 * STG <= 131072, "attention LDS");
    const int tid = (wid_ * 64 + fresh_lane()), lane = tid & 63, wid = wid_, q = lane & 31, hh = lane >> 5;
    const bf16_t* Q = wsp<bf16_t>(p, WS_Q); const bf16_t* KN = wsp<bf16_t>(p, SWA ? WS_KO : WS_KN); const bf16_t* KPE = wsp<bf16_t>(p, WS_KPE);
    const bf16_t* VT = wsp<bf16_t>(p, SWA ? WS_VTO : WS_VT); bf16_t* MIX = wsp<bf16_t>(p, WS_MIX);
    for (int L = c; L < NUNITS; L += G) {
        int rowbase, hk, nt0, nt1, key0a, key0b = 0, kpos0 = 0, qpos0 = 0; bool masked = false;
        if (!SWA) {
            if (L < 256) { const int b = L >> 5, qt = L & 3; hk = (L >> 2) & 7; rowbase = T_CTX + b * 1024 + qt * 256; key0a = T_CTX + b * 1024; nt0 = 16; key0b = T + b * 512; nt1 = 8; }
            else { const int Lc = L - 256, b = Lc >> 3; hk = Lc & 7; rowbase = b * 256; key0a = b * 256; nt0 = 4; nt1 = 0; }
        } else {
            if (L < 512) { const int b = L >> 6, t0 = (L & 15) * 64; hk = (L >> 4) & 3; rowbase = T_CTX + b * 1024 + t0;
                const int lo = max(t0 - 128, 0) & ~63, hi = min((t0 + 192 + 63) & ~63, 1024);
                key0a = T_CTX + b * 1024 + lo; nt0 = (hi - lo) >> 6; kpos0 = lo; qpos0 = t0; masked = true; key0b = T + b * 512; nt1 = 8; }
            else { const int Lc = L - 512, b = Lc >> 4; hk = (Lc >> 2) & 3; rowbase = b * 256 + (Lc & 3) * 64; key0a = b * 256; nt0 = 4; nt1 = 0; }
        }
        const int total = nt0 + nt1;
        const int qrow0 = SWA ? rowbase + q : rowbase + wid * 32 + q;
        const int qhead = SWA ? hk * 8 + wid : hk;
        bf16x8 qf[QB][NQ];
#pragma unroll
        for (int qb = 0; qb < QB; ++qb)
#pragma unroll
            for (int s = 0; s < NQ; ++s) qf[qb][s] = *(const bf16x8*)(Q + (size_t)(qrow0 + 32 * qb) * LDQ + qhead * DK + 16 * s + 8 * hh);
        f32x16 o[QB][NDV];
#pragma unroll
        for (int qb = 0; qb < QB; ++qb)
#pragma unroll
            for (int d = 0; d < NDV; ++d)
#pragma unroll
                for (int r = 0; r < 16; ++r) o[qb][d][r] = 0.f;
        float m[QB], l[QB];
#pragma unroll
        for (int qb = 0; qb < QB; ++qb) { m[qb] = SWA ? p.in[19][qhead] * LOG2E : -1e30f; l[qb] = (SWA && hh == 0) ? 1.f : 0.f; }
        const int qpos = qpos0 + q;
        u32x4 kreg[NKC], vreg[NVC];
#define ATT_LOAD(t_) do { const int tt_ = (t_); const int kb_ = tt_ < nt0 ? key0a + tt_ * 64 : key0b + (tt_ - nt0) * 64; \
            _Pragma("unroll") for (int i = 0; i < NKC; ++i) { const int ch = tid + NTHREADS * i, j = ch / CPR, cc = ch % CPR; \
                const bf16_t* src = SWA ? KN + (size_t)(kb_ + j) * 256 + hk * 64 + cc * 8 : (cc < 16 ? KN + (size_t)(kb_ + j) * 1024 + hk * 128 + cc * 8 : KPE + (size_t)(kb_ + j) * 64 + (cc - 16) * 8); \
                kreg[i] = *(const u32x4*)src; } \
            _Pragma("unroll") for (int i = 0; i < NVC; ++i) { const int ch = tid + NTHREADS * i, dv = ch >> 3, cc = ch & 7; \
                vreg[i] = *(const u32x4*)(VT + (size_t)(hk * DV + dv) * TX + kb_ + cc * 8); } } while (0)
#define ATT_WRITE(buf_) do { LAS unsigned char* Kw = lds + (buf_) * STG; LAS unsigned char* Vw = Kw + KB; \
            _Pragma("unroll") for (int i = 0; i < NKC; ++i) { const int ch = tid + NTHREADS * i, j = ch / CPR, cc = ch % CPR; *(LAS u32x4*)(Kw + j * KSTR + cc * 16) = kreg[i]; } \
            _Pragma("unroll") for (int i = 0; i < NVC; ++i) { const int ch = tid + NTHREADS * i, dv = ch >> 3, cc = ch & 7; \
                *(LAS u32x2*)(Vw + dv * VSTR + cc * 16) = (u32x2){vreg[i].x, vreg[i].y}; *(LAS u32x2*)(Vw + dv * VSTR + cc * 16 + 8) = (u32x2){vreg[i].z, vreg[i].w}; } } while (0)
        ATT_LOAD(0); ATT_WRITE(0);
        __syncthreads();
        for (int t = 0; t < total; ++t) {
            const int buf = t & 1;
            if (t + 1 < total) ATT_LOAD(t + 1);
            const LAS unsigned char* Kl = lds + buf * STG; const LAS unsigned char* Vl = Kl + KB;
            f32x16 s0[QB], s1[QB];
#pragma unroll
            for (int qb = 0; qb < QB; ++qb)
#pragma unroll
                for (int r = 0; r < 16; ++r) { s0[qb][r] = 0.f; s1[qb][r] = 0.f; }
#pragma unroll
            for (int s = 0; s < NQ; ++s) {
                const bf16x8 a0 = *(const LAS bf16x8*)(Kl + q * KSTR + (16 * s + 8 * hh) * 2);
                const bf16x8 a1 = *(const LAS bf16x8*)(Kl + (32 + q) * KSTR + (16 * s + 8 * hh) * 2);
#pragma unroll
                for (int qb = 0; qb < QB; ++qb) { s0[qb] = __builtin_amdgcn_mfma_f32_32x32x16_bf16(a0, qf[qb][s], s0[qb], 0, 0, 0); s1[qb] = __builtin_amdgcn_mfma_f32_32x32x16_bf16(a1, qf[qb][s], s1[qb], 0, 0, 0); }
            }
            bf16x8 pb[QB][2][2];
#pragma unroll
            for (int qb = 0; qb < QB; ++qb) {
                if (SWA && masked && t < nt0) {
                    const int kp = kpos0 + t * 64 - (qpos + 32 * qb);
#pragma unroll
                    for (int r = 0; r < 16; ++r) { const int d0 = kp + crow(r, hh), d1 = d0 + 32;
                        s0[qb][r] = (d0 >= -128 && d0 <= 128) ? s0[qb][r] : -1e30f; s1[qb][r] = (d1 >= -128 && d1 <= 128) ? s1[qb][r] : -1e30f; }
                }
                float tm = fmaxf(s0[qb][0], s1[qb][0]);
#pragma unroll
                for (int r = 1; r < 16; ++r) tm = max3f(tm, s0[qb][r], s1[qb][r]);
                tm = fmaxf(tm, __shfl_xor(tm, 32));
                const float mn = fmaxf(m[qb], tm);
                if (!__all(mn == m[qb])) {
                    const float alpha = __builtin_amdgcn_exp2f(m[qb] - mn); m[qb] = mn; l[qb] *= alpha;
#pragma unroll
                    for (int d = 0; d < NDV; ++d)
#pragma unroll
                        for (int r = 0; r < 16; ++r) o[qb][d][r] *= alpha; }
                float ls = 0.f;
#pragma unroll
                for (int r = 0; r < 16; ++r) { s0[qb][r] = __builtin_amdgcn_exp2f(s0[qb][r] - m[qb]); s1[qb][r] = __builtin_amdgcn_exp2f(s1[qb][r] - m[qb]); ls += s0[qb][r] + s1[qb][r]; }
                l[qb] += ls;
#pragma unroll
                for (int s = 0; s < 2; ++s) {
                    u32x4 w0, w1;
                    w0.x = cvtpk(s0[qb][8 * s + 0], s0[qb][8 * s + 1]); w0.y = cvtpk(s0[qb][8 * s + 2], s0[qb][8 * s + 3]); w0.z = cvtpk(s0[qb][8 * s + 4], s0[qb][8 * s + 5]); w0.w = cvtpk(s0[qb][8 * s + 6], s0[qb][8 * s + 7]);
                    w1.x = cvtpk(s1[qb][8 * s + 0], s1[qb][8 * s + 1]); w1.y = cvtpk(s1[qb][8 * s + 2], s1[qb][8 * s + 3]); w1.z = cvtpk(s1[qb][8 * s + 4], s1[qb][8 * s + 5]); w1.w = cvtpk(s1[qb][8 * s + 6], s1[qb][8 * s + 7]);
                    pb[qb][0][s] = __builtin_bit_cast(bf16x8, w0); pb[qb][1][s] = __builtin_bit_cast(bf16x8, w1);
                }
            }
#pragma unroll
            for (int d = 0; d < NDV; ++d)
#pragma unroll
                for (int blk = 0; blk < 2; ++blk)
#pragma unroll
                    for (int s = 0; s < 2; ++s) {
                        const LAS unsigned char* vp = Vl + (d * 32 + q) * VSTR + (blk * 32 + 16 * s + 4 * hh) * 2;
                        const s16x4 lo = *(const LAS s16x4*)vp, hi = *(const LAS s16x4*)(vp + 16);
                        const bf16x8 a = {lo[0], lo[1], lo[2], lo[3], hi[0], hi[1], hi[2], hi[3]};
#pragma unroll
                        for (int qb = 0; qb < QB; ++qb) o[qb][d] = __builtin_amdgcn_mfma_f32_32x32x16_bf16(a, pb[qb][blk][s], o[qb][d], 0, 0, 0);
                    }
            if (t + 1 < total) ATT_WRITE(buf ^ 1);
            __syncthreads();
        }
#undef ATT_LOAD
#undef ATT_WRITE
#pragma unroll
        for (int qb = 0; qb < QB; ++qb) {
            const float inv = 1.f / (l[qb] + __shfl_xor(l[qb], 32));
            bf16_t* orow = MIX + (size_t)(qrow0 + 32 * qb) * 2048 + qhead * DV;
            unsigned char* orow8 = (unsigned char*)MIX + (size_t)(qrow0 + 32 * qb) * 2048 + qhead * DV;
#pragma unroll
            for (int d = 0; d < NDV; ++d)
#pragma unroll
                for (int g = 0; g < 4; ++g) {
                    if (OUT_F8) *(unsigned*)(orow8 + d * 32 + 8 * g + 4 * hh) = pk4_fp8(o[qb][d][4 * g] * inv, o[qb][d][4 * g + 1] * inv, o[qb][d][4 * g + 2] * inv, o[qb][d][4 * g + 3] * inv);
                    else { u32x2 w; w.x = cvtpk(o[qb][d][4 * g] * inv, o[qb][d][4 * g + 1] * inv); w.y = cvtpk(o[qb][d][4 * g + 2] * inv, o[qb][d][4 * g + 3] * inv); *(u32x2*)(orow + d * 32 + 8 * g + 4 * hh) = w; } }
        }
    }
}
}


#ifndef R_PRO
#define R_PRO 1
#endif
#ifndef R_MOE
#define R_MOE 1
#endif
#ifndef R_ATT
#define R_ATT 1
#endif
#ifndef R_ATTM
#define R_ATTM R_ATT
#endif
#ifndef R_ATTS
#define R_ATTS R_ATT
#endif
#ifndef R_GEMM
#define R_GEMM 1
#endif
#ifndef R_THIN
#define R_THIN 1
#endif
#ifndef R_LN1
#define R_LN1 1
#endif
#ifndef R_LN2
#define R_LN2 1
#endif
#ifndef R_TOPK
#define R_TOPK 1
#endif
#define REP(n) for (int _r = 0; _r < (n); ++_r)
#define REPS(n, ...) do { { __VA_ARGS__ } if ((n) > 1) { __VA_ARGS__ } } while (0)
constexpr int LDS_BYTES = 147456, MISC_OFF = 146432;
constexpr int NPH = 20;
#ifndef CVT_WAVES
#define CVT_WAVES 4
#endif
#ifndef BG_MODE
#define BG_MODE 0
#endif
#ifndef BG_SPLIT
#define BG_SPLIT 32768
#endif
#ifndef CVT_IDLE_WAVES
#define CVT_IDLE_WAVES 8
#endif
#ifndef CV_IDLE2
#define CV_IDLE2 10240
#endif
#ifndef CV_IDLE6
#define CV_IDLE6 10240
#endif
constexpr int CV_I2 = CV_IDLE2, CV_I6 = CV_IDLE6, CV_IALL = CV_I2 + 2 * CV_I6;
__global__ void __launch_bounds__(NTHREADS, 2) mega(Params p) {
    extern __shared__ __attribute__((aligned(16))) unsigned char lds[];
    const int G = gridDim.x, c = vcu_of(blockIdx.x, G), wid = __builtin_amdgcn_readfirstlane(threadIdx.x >> 6);
    volatile LAS unsigned* MISC = (volatile LAS unsigned*)((LAS unsigned char*)lds + MISC_OFF);
    if (threadIdx.x < 4) MISC[threadIdx.x] = 0u;
    __syncthreads();
    XcdBarrier bar = xcd_barrier_post((unsigned*)(p.ws + WS_CTL) + CW_BAR, MISC);
    const int lo = p.ph_lo, hi = p.ph_hi;
#define IN(k) (lo <= (k) && (k) < hi)
#ifdef STAMP_A
#define stamps_ (wsp<unsigned long long>(p, WS_DBG + 65536))
#define STAMP(k) do { if (blockIdx.x == 0 && wid == 0 && fresh_lane() == 0) stamps_[k] = __builtin_amdgcn_s_memrealtime(); } while (0)
#else
#define STAMP(k) do { } while (0)
#endif
    STAMP(0); STAMP(23);
#ifndef R_BAR
#define R_BAR 1
#endif
#define SEAM(k) do { if (IN(k) && IN((k) + 1)) { xcd_barrier(bar); if (R_BAR > 1) xcd_barrier(bar); } STAMP((k) + 1); } while (0)
    if (IN(0)) REP(R_PRO) { ph_mod(p, wid, lds); STAMP(21); ph_misc(p, wid); STAMP(22); ph_convert(p, wid, 0, G == 256 ? (BG_MODE ? CV_TOTAL - CV_MOE / 2 : CV_TOTAL - CV_IALL) : CV_TOTAL, blockIdx.x, G, CVT_WAVES);
#ifdef RD_PAT
        ph_readonly<RD_PAT>(p, wid);
#endif
    } SEAM(0);
    if (IN(1)) REP(R_THIN) { ph_modreduce(p, wid); ph_h0(p, wid, lds); } SEAM(1);
    if (IN(2)) { REPS(R_GEMM, SchedInEven S{&p, G, c}; EpiInEven E{&p}; pg8::gemm_phase((LAS unsigned char*)lds, S, E, wid);); if (!BG_MODE && G == 256 && c >= 128) ph_convert(p, wid, CV_TOTAL - CV_IALL, CV_TOTAL - 2 * CV_I6, c - 128, 128, CVT_IDLE_WAVES); } SEAM(2);
    if (IN(3)) REP(R_THIN) { ph_e1(p, wid); } SEAM(3);
    #ifndef E2_ALIGN
#define E2_ALIGN true
#endif
    if (IN(4)) REPS(R_GEMM, SchedE2 S{&p, G, c}; EpiE2 E{&p}; pg8::gemm_phase<EpiE2, SchedE2, E2_ALIGN>((LAS unsigned char*)lds, S, E, wid);); SEAM(4);
    if (IN(5)) REP(R_ATTM) { att::attn_phase<false>(p, wid, (LAS unsigned char*)lds, G, c); } SEAM(5);
    if (IN(6)) { REPS(R_GEMM, SchedOut S{&p, G, c, 0}; EpiOut E{&p, 0}; pg8::gemm_phase((LAS unsigned char*)lds, S, E, wid);); if (!BG_MODE && G == 256 && c >= 128) ph_convert(p, wid, CV_TOTAL - 2 * CV_I6, CV_TOTAL - CV_I6, c - 128, 128, CVT_IDLE_WAVES); } SEAM(6);
    if (IN(7)) REP(R_LN1) { ph_ln1(p, wid, 0, lds); } SEAM(7);
    if (IN(8)) REP(R_TOPK) { ph_topk(p, wid, lds); } SEAM(8);
    {
        const bool bgm = BG_MODE && G == 256, isbg = bgm && (c & 31) >= 24;
        const int fG = bgm ? 192 : G, fc = bgm ? (c >> 5) * 24 + (c & 31) : c, bgi = (c >> 5) * 8 + (c & 31) - 24;
        if (IN(9)) { if (isbg) ph_convert_moe_bg(p, wid, CV_MOE / 2, CV_MOE / 2 + BG_SPLIT, bgi, 64, 8); else REPS(R_MOE, SchedGU S{&p, fG, fc, 0}; EpiGU E{&p}; pg8::gemm_phase((LAS unsigned char*)lds, S, E, wid);); } SEAM(9);
        if (IN(10)) { if (isbg) ph_convert_moe_bg(p, wid, CV_MOE / 2 + BG_SPLIT, CV_MOE, bgi, 64, 8); else REPS(R_MOE, SchedDown S{&p, fG, fc, 0}; EpiDown E{&p}; pg8::gemm_phase((LAS unsigned char*)lds, S, E, wid);); } SEAM(10);
    }
    if (IN(11)) REP(R_LN2) { ph_ln2(p, wid, 0, lds); } SEAM(11);
    if (IN(12)) REPS(R_GEMM, SchedInOdd S{&p, G, c}; EpiInOdd E{&p}; pg8::gemm_phase((LAS unsigned char*)lds, S, E, wid);); SEAM(12);
    if (IN(13)) REP(R_ATTS) { att::attn_phase<true>(p, wid, (LAS unsigned char*)lds, G, c); } SEAM(13);
    if (IN(14)) { REPS(R_GEMM, SchedOut S{&p, G, c, 1}; EpiOut E{&p, 1}; pg8::gemm_phase((LAS unsigned char*)lds, S, E, wid);); if (!BG_MODE && G == 256 && c >= 128) ph_convert(p, wid, CV_TOTAL - CV_I6, CV_TOTAL, c - 128, 128, CVT_IDLE_WAVES); } SEAM(14);
    if (IN(15)) REP(R_LN1) { ph_ln1(p, wid, 1, lds); } SEAM(15);
    if (IN(16)) REP(R_TOPK) { ph_topk(p, wid, lds); } SEAM(16);
    if (IN(17)) REPS(R_MOE, SchedGU S{&p, G, c, 1}; EpiGU E{&p}; pg8::gemm_phase((LAS unsigned char*)lds, S, E, wid);); SEAM(17);
    if (IN(18)) REPS(R_MOE, SchedDown S{&p, G, c, 1}; EpiDown E{&p}; pg8::gemm_phase((LAS unsigned char*)lds, S, E, wid);); SEAM(18);
    if (IN(19)) REP(R_LN2) { ph_ln2(p, wid, 1, lds); }
#ifdef STAMP_A
    STAMP(20);
    if (blockIdx.x == 0 && wid == 0 && fresh_lane() == 0) {
        asm volatile("s_waitcnt vmcnt(0)" ::: "memory");
        const unsigned long long d = (__hip_atomic_load(&stamps_[STAMP_B], __ATOMIC_RELAXED, __HIP_MEMORY_SCOPE_AGENT) - __hip_atomic_load(&stamps_[STAMP_A], __ATOMIC_RELAXED, __HIP_MEMORY_SCOPE_AGENT)) * 4ull;
        const unsigned long long t0 = __builtin_amdgcn_s_memrealtime();
        while (__builtin_amdgcn_s_memrealtime() - t0 < d) __builtin_amdgcn_s_sleep(8);
    }
#endif
#undef IN
#undef SEAM
}

extern "C" void kernel_launch(void* const* d_in, const int* in_sizes, int n_in, void* d_out, int out_size, void* d_ws, size_t ws_size, hipStream_t stream) {
    static int grid = 0;
    if (grid == 0) {
        if (n_in != 29 || out_size != (int)O_END || ws_size < WS_END) { fprintf(stderr, "kernel_launch: unexpected shapes (n_in %d out %d ws %zu need %zu)\n", n_in, out_size, ws_size, (size_t)WS_END); grid = -1; return; }
        int dev = 0, cus = 0, per_cu = 0;
        if (hipGetDevice(&dev) != hipSuccess || hipDeviceGetAttribute(&cus, hipDeviceAttributeMultiprocessorCount, dev) != hipSuccess) { grid = -1; return; }
        if (hipFuncSetAttribute((const void*)mega, hipFuncAttributeMaxDynamicSharedMemorySize, LDS_BYTES) != hipSuccess) { fprintf(stderr, "hipFuncSetAttribute failed\n"); grid = -1; return; }
        if (hipOccupancyMaxActiveBlocksPerMultiprocessor(&per_cu, (const void*)mega, NTHREADS, LDS_BYTES) != hipSuccess || per_cu < 1) fprintf(stderr, "occupancy query: %d\n", per_cu);
        (void)hipGetLastError();
        grid = cus > 0 ? cus : 256;
    }
    if (grid < 0) return;
    Params p{};
    for (int i = 0; i < 29; ++i) p.in[i] = (const float*)d_in[i];
    p.out = (float*)d_out; p.ws = (unsigned char*)d_ws; p.ph_lo = 0; p.ph_hi = NPH; p.rpb = (T + grid - 1) / grid; p.pad = 0;
    (void)hipMemsetAsync((char*)d_ws + WS_CTL, 0, 32768, stream);
    hipLaunchKernelGGL(mega, dim3(grid), dim3(NTHREADS), LDS_BYTES, stream, p);
}
```

```cpp
#include <hip/hip_runtime.h>
#include <cstdio>
#include <cstdint>

constexpr int D = 2048, T_CTX = 4096, T = 12288, TC = 4096, TX = 16384;
constexpr int MODW = 12288, NCOND = 9;
constexpr int NSLOT = 1536, NXS = 16 * NSLOT;
constexpr float DN_ALPHA = 1.41421356237309515f;
constexpr float LOG2E = 1.44269504088896341f;
constexpr float QS_MLA = 0.07216878364870322f * LOG2E;
constexpr float QS_SWA = 0.125f * LOG2E;
constexpr int NTHREADS = 512, NWAVES = 8;
#ifndef MOE_F8
#define MOE_F8 1
#endif
#ifndef OUT_F8
#define OUT_F8 1
#endif
constexpr float GU_WSCALE = 32.f, DN_WSCALE = 64.f, OUT_WSCALE = 64.f;

constexpr size_t O_Y = 0, O_CKV = 25165824, O_KPE = 26214400, O_SK = 26476544, O_SV = 27525120, O_END = 28573696;

constexpr size_t al256(size_t x) { return (x + 255) & ~(size_t)255; }
constexpr size_t WS_CTL = 0, CTL_BYTES = 1u << 20;
constexpr size_t WS_MOD = WS_CTL + CTL_BYTES;
constexpr size_t WS_ROPE = WS_MOD + al256((size_t)2 * 9 * 12288 * 4);
constexpr size_t WS_WINE = WS_ROPE + al256((size_t)2 * 1024 * 32 * 4);
constexpr size_t WS_W2 = WS_WINE + (size_t)2048 * 2048 * 2;
constexpr size_t WS_WOUTE = WS_W2 + (size_t)4608 * 1792 * 2;
constexpr size_t WS_WINO = WS_WOUTE + (size_t)2048 * 2048 * 2;
constexpr size_t WS_WOUTO = WS_WINO + (size_t)2560 * 2048 * 2;
constexpr size_t WS_WGU = WS_WOUTO + (size_t)2048 * 2048 * 2;
constexpr size_t WS_WDN = WS_WGU + (size_t)32 * 4096 * 2048 * 2;
constexpr size_t WS_H = WS_WDN + (size_t)32 * 2048 * 2048 * 2;
constexpr size_t WS_PJ = WS_H + (size_t)T * 2048 * 2;
constexpr size_t WS_ACT2 = WS_PJ + (size_t)T * 1792 * 4;
constexpr size_t WS_KPE = WS_ACT2 + (size_t)TX * 1792 * 2;
constexpr size_t WS_Q = WS_KPE + (size_t)TX * 64 * 2;
constexpr size_t WS_KN = WS_Q + (size_t)T * 2048 * 2;
constexpr size_t WS_VT = WS_KN + (size_t)TX * 1024 * 2;
constexpr size_t WS_VTO = WS_VT + (size_t)1024 * TX * 2;
constexpr size_t WS_KO = WS_VTO + (size_t)256 * TX * 2;
constexpr size_t WS_MIX = WS_KO + (size_t)TX * 256 * 2;
constexpr size_t WS_Y = WS_MIX + (size_t)T * 2048 * 2;
constexpr size_t WS_X1 = WS_Y + (size_t)T * 2048 * 4;
constexpr size_t WS_XL = WS_X1 + (size_t)T * 2048 * 4;
constexpr size_t WS_AFF = WS_XL + (size_t)T * 2048 * 4;
constexpr size_t WS_INV = WS_AFF + (size_t)T * 16 * 4;
constexpr size_t WS_XS = WS_INV + (size_t)T * 16 * 4;
constexpr size_t WS_HID = WS_XS + (size_t)NXS * 2048 * 2;
constexpr size_t WS_YE = WS_HID + (size_t)NXS * 2048 * 2;
constexpr size_t WS_AFFT = WS_YE + (size_t)NXS * 2048 * 2;
constexpr size_t WS_H8 = WS_AFFT + (size_t)T * 16 * 4;
constexpr size_t WS_STAT = WS_H8 + (size_t)T * 2048;
constexpr size_t WS_MODP = WS_STAT + (size_t)T * 8;
constexpr size_t WS_GB = WS_MODP + (size_t)4 * 2 * 9 * 12288 * 4;
constexpr size_t WS_DBG = WS_GB + (size_t)2 * 9 * 2 * 2048 * 4;
constexpr size_t WS_END = WS_DBG + (1u << 20);

typedef unsigned short bf16_t;
typedef float f32x4 __attribute__((ext_vector_type(4)));
typedef unsigned u32x4 __attribute__((ext_vector_type(4)));
typedef unsigned u32x2 __attribute__((ext_vector_type(2)));
typedef float f32x2 __attribute__((ext_vector_type(2)));
#define LAS __attribute__((address_space(3)))
#define DI __device__ __forceinline__

struct Params {
    const float* in[29];
    float* out;
    unsigned char* ws;
    int ph_lo, ph_hi;
    int rpb, pad;
};

DI unsigned f2bf(float f) { unsigned u = __float_as_uint(f); return (u + 0x7fffu + ((u >> 16) & 1u)) >> 16; }
typedef __bf16 bf16x2_hw __attribute__((ext_vector_type(2)));
DI unsigned pk2(float lo, float hi) { f32x2 v = {lo, hi}; bf16x2_hw b = __builtin_convertvector(v, bf16x2_hw); return __builtin_bit_cast(unsigned, b); }
DI unsigned pk4_fp8(float a, float b, float c, float d) { unsigned w = 0; w = __builtin_amdgcn_cvt_pk_fp8_f32(a, b, w, false); w = __builtin_amdgcn_cvt_pk_fp8_f32(c, d, w, true); return w; }
DI float bf2f(unsigned b) { return __uint_as_float(b << 16); }
DI float bflo(unsigned w) { return __uint_as_float(w << 16); }
DI float bfhi(unsigned w) { return __uint_as_float(w & 0xffff0000u); }
DI float wave_sum(float v) {
#pragma unroll
    for (int o = 1; o < 64; o <<= 1) v += __shfl_xor(v, o);
    return v;
}
DI float wave_max(float v) {
#pragma unroll
    for (int o = 1; o < 64; o <<= 1) v = fmaxf(v, __shfl_xor(v, o));
    return v;
}
DI int fresh_lane() { int l = (int)__builtin_amdgcn_mbcnt_hi(~0u, __builtin_amdgcn_mbcnt_lo(~0u, 0u)); asm volatile("" : "+v"(l)); return l; }
DI int cond_of_row(int r) { return r < T_CTX ? 0 : 1 + ((r - T_CTX) >> 10); }
DI const float* xrow_in(const Params& p, int r) { return r < T_CTX ? p.in[0] + (size_t)r * D : p.in[1] + (size_t)(r - T_CTX) * D; }

DI float* ws_mod(const Params& p) { return (float*)(p.ws + WS_MOD); }
DI float* ws_cos(const Params& p) { return (float*)(p.ws + WS_ROPE); }
DI float* ws_sin(const Params& p) { return (float*)(p.ws + WS_ROPE) + 1024 * 32; }
template <class X> DI X* wsp(const Params& p, size_t off) { return (X*)(p.ws + off); }
DI const float* modp(const Params& p, int l, int ci, int j) { return ws_mod(p) + ((size_t)(l * 9 + ci) * MODW + (size_t)j * D); }

#define XB_TMO      128
#define XB_XCNT(j)  (256  + 64 * (j))
#define XB_XSUB(j)  (1280 + 64 * (j))
#define XB_XGEN(j)  (2304 + 64 * (j))
#define XB_TOP      3328
#define XB_TOPGEN   3392
#define XCD_BAR_WORDS 3456
#define XB_SPIN_CAP (1u << 18)

__device__ __forceinline__ unsigned xb_ld(unsigned* p)              { return __hip_atomic_load(p, __ATOMIC_RELAXED, __HIP_MEMORY_SCOPE_AGENT); }
__device__ __forceinline__ unsigned xb_add(unsigned* p, unsigned v) { return __hip_atomic_fetch_add(p, v, __ATOMIC_RELAXED, __HIP_MEMORY_SCOPE_AGENT); }
__device__ __forceinline__ unsigned xb_xcc_id() { return (unsigned)__builtin_amdgcn_s_getreg((3 << 11) | 20) & 0xFu; }
#define XB_SPIN(cond, bar) do { unsigned _sp = 0; while (cond) { __builtin_amdgcn_s_sleep(1); \
    if ((++_sp & 255u) == 0u) { if (xb_ld(&(bar)[XB_TMO])) break; if (_sp > XB_SPIN_CAP) { atomicAdd(&(bar)[XB_TMO], 1u); break; } } } } while (0)

struct XcdBarrier {
    unsigned* bar; unsigned x;
    volatile LAS unsigned* st;
};

__device__ __forceinline__ XcdBarrier xcd_barrier_post(unsigned* bar, volatile LAS unsigned* st) {
    XcdBarrier b; b.bar = bar; b.x = xb_xcc_id(); b.st = st;
    if (threadIdx.x == 0) (void)xb_add(&bar[XB_XCNT(b.x)], 1u);
    return b;
}
__device__ __forceinline__ void xcd_barrier_complete(unsigned* bar, unsigned x, unsigned& nloc, unsigned& nx) {
    const unsigned G = gridDim.x * gridDim.y * gridDim.z;
    unsigned sum, cnt, mine, sp = 0u;
    for (;;) {
        sum = 0u; cnt = 0u; mine = 0u;
#pragma unroll
        for (unsigned j = 0; j < 16; ++j) { const unsigned c = xb_ld(&bar[XB_XCNT(j)]); sum += c; cnt += (c > 0u) ? 1u : 0u; mine = (j == x) ? c : mine; }
        if (sum == G) break;
        __builtin_amdgcn_s_sleep(1);
        if ((++sp & 255u) == 0u) { if (xb_ld(&bar[XB_TMO])) break; if (sp > XB_SPIN_CAP) { atomicAdd(&bar[XB_TMO], 1u); break; } }
    }
    nloc = mine > 0u ? mine : 1u; nx = cnt > 0u ? cnt : 1u;
}

__device__ __forceinline__ void xcd_barrier(const XcdBarrier& b) {
    asm volatile("s_waitcnt vmcnt(0)" ::: "memory");
    __syncthreads();
    if (threadIdx.x == 0) {
        unsigned* bar = b.bar;
        __builtin_amdgcn_s_waitcnt(0);
        unsigned nloc = b.st[0], nx = b.st[1];
        if (nloc == 0u) { xcd_barrier_complete(bar, b.x, nloc, nx); b.st[0] = nloc; b.st[1] = nx; }
        const unsigned old = xb_add(&bar[XB_XSUB(b.x)], 1u);
        const unsigned gen = old / nloc;
        if (old + 1u == (gen + 1u) * nloc) {
            __builtin_amdgcn_fence(__ATOMIC_RELEASE, "agent");
            asm volatile("s_waitcnt vmcnt(0)" ::: "memory");
            const unsigned og = xb_add(&bar[XB_TOP], 1u);
            const unsigned tg = og / nx;
            if (og + 1u == (tg + 1u) * nx) xb_add(&bar[XB_TOPGEN], 1u);
            else XB_SPIN(xb_ld(&bar[XB_TOPGEN]) == tg, bar);
            __builtin_amdgcn_fence(__ATOMIC_ACQUIRE, "agent");
            xb_add(&bar[XB_XGEN(b.x)], 1u);
            asm volatile("s_waitcnt vmcnt(0)" ::: "memory");
        } else {
            XB_SPIN(xb_ld(&bar[XB_XGEN(b.x)]) == gen, bar);
            __builtin_amdgcn_fence(__ATOMIC_ACQUIRE, "agent");
            asm volatile("s_waitcnt vmcnt(0)" ::: "memory");
        }
    }
    __syncthreads();
}
constexpr int CW_BAR = 4096;


DI void ph_mod(const Params& p, int wid_, unsigned char* lds_raw) {
    float* s_q = (float*)lds_raw;
    float* red = s_q + 9 * 512;
    const int tid = (wid_ * 64 + fresh_lane()), lane = tid & 63, wave = wid_;
    const float* c = p.in[6]; const float* c_ctx = p.in[7]; const float* w_ada = p.in[8];
    float* MODP = wsp<float>(p, WS_MODP);
    for (int it = blockIdx.x; it < 384; it += gridDim.x) {
        const int l = it / 192, rem = it % 192, cg = rem >> 2, kq4 = rem & 3;
        for (int i = tid; i < 9 * 512; i += NTHREADS) { const int ci = i >> 9, k = kq4 * 512 + (i & 511); const float v = ci == 0 ? c_ctx[k] : c[(ci - 1) * 2048 + k]; s_q[i] = v / (1.f + expf(-v)); }
        __syncthreads();
        const float* w = w_ada + ((size_t)l * 2048 + kq4 * 512 + wave * 64) * MODW + cg * 256 + 4 * lane;
        float acc[9][4];
#pragma unroll
        for (int ci = 0; ci < 9; ++ci)
#pragma unroll
            for (int j = 0; j < 4; ++j) acc[ci][j] = 0.f;
#pragma unroll 8
        for (int kk = 0; kk < 64; ++kk) {
            const f32x4 wv = __builtin_nontemporal_load((const f32x4*)(w + (size_t)kk * MODW));
#pragma unroll
            for (int ci = 0; ci < 9; ++ci) { const float s = s_q[ci * 512 + wave * 64 + kk];
#pragma unroll
                for (int j = 0; j < 4; ++j) acc[ci][j] += s * wv[j]; }
        }
#pragma unroll
        for (int ci = 0; ci < 9; ++ci) *(f32x4*)(red + (wave * 9 + ci) * 256 + 4 * lane) = (f32x4){acc[ci][0], acc[ci][1], acc[ci][2], acc[ci][3]};
        __syncthreads();
        for (int o = tid; o < 9 * 256; o += NTHREADS) { const int ci = o >> 8, cc = o & 255; float s = 0.f;
#pragma unroll
            for (int w8 = 0; w8 < 8; ++w8) s += red[(w8 * 9 + ci) * 256 + cc];
            MODP[((size_t)(kq4 * 2 + l) * 9 + ci) * MODW + cg * 256 + cc] = s; }
        __syncthreads();
    }
}
DI void ph_modreduce(const Params& p, int wid_) {
    const float* MODP = wsp<float>(p, WS_MODP); float* MOD = ws_mod(p); const float* b_ada = p.in[9];
    const int n4 = 2 * 9 * MODW / 4;
    for (int i = blockIdx.x * NTHREADS + (wid_ * 64 + fresh_lane()); i < n4; i += gridDim.x * NTHREADS) { const int e = i * 4, l = e / (9 * MODW), col = e % MODW;
        f32x4 s = *(const f32x4*)(b_ada + l * MODW + col);
#pragma unroll
        for (int q = 0; q < 4; ++q) s += *(const f32x4*)(MODP + (size_t)q * 2 * 9 * MODW + e);
        *(f32x4*)(MOD + e) = s; }
}
DI f32x4 mod_from_partials(const Params& p, int l, int ci, int j, int col) {
    const float* MODP = wsp<float>(p, WS_MODP); const size_t e = (size_t)(l * 9 + ci) * MODW + (size_t)j * D + col;
    f32x4 s = *(const f32x4*)(p.in[9] + l * MODW + j * D + col);
#pragma unroll
    for (int q = 0; q < 4; ++q) s += *(const f32x4*)(MODP + (size_t)q * 2 * 9 * MODW + e);
    return s;
}

constexpr int CV_INE = 928, CV_UQ = 192, CV_UKV = 128, CV_POOL = 64, CV_OUT = 1024, CV_INO = 1280, CV_MOE = 98304;
constexpr int CV_TOTAL = CV_INE + CV_UQ + CV_UKV + CV_POOL + CV_OUT + CV_INO + CV_OUT + CV_MOE;
DI void cvt_f8_item(const float* src, int N, unsigned char* dst, int nrows, int w, int lane, float scale, int gu_kind) {
    const int nb8 = w & 7, kb16 = w >> 3, n4 = nb8 * 256 + 4 * lane;
    const float* s = src + (size_t)(kb16 * 16) * N + n4;
    f32x4 v[16];
#pragma unroll
    for (int k = 0; k < 16; ++k) v[k] = __builtin_nontemporal_load((const f32x4*)(s + (size_t)k * N));
    const int dr = gu_kind < 0 ? n4 : (n4 >> 7) * 256 + (n4 & 127) + gu_kind * 128;
    u32x4* d = (u32x4*)(dst + ((size_t)kb16 * nrows + dr) * 16);
#pragma unroll
    for (int j = 0; j < 4; ++j) { u32x4 o;
        o.x = pk4_fp8(v[0][j] * scale, v[1][j] * scale, v[2][j] * scale, v[3][j] * scale); o.y = pk4_fp8(v[4][j] * scale, v[5][j] * scale, v[6][j] * scale, v[7][j] * scale);
        o.z = pk4_fp8(v[8][j] * scale, v[9][j] * scale, v[10][j] * scale, v[11][j] * scale); o.w = pk4_fp8(v[12][j] * scale, v[13][j] * scale, v[14][j] * scale, v[15][j] * scale);
        d[j] = o; }
}
DI void cvt_item(const Params& p, int item, int lane) {
    const float* src; bf16_t* dst; int K, N, ldd, nb, kb, map = 0, a = 0;
    if (item < CV_INE) { src = p.in[10]; dst = wsp<bf16_t>(p, WS_WINE); K = 2048; N = 1856; ldd = 2048; nb = item % 29; kb = item / 29; map = 1; }
    else if ((item -= CV_INE) < CV_UQ) { src = p.in[13]; dst = wsp<bf16_t>(p, WS_W2); K = 512; N = 1536; ldd = 1792; nb = item % 24; kb = item / 24; }
    else if ((item -= CV_UQ) < CV_UKV) { src = p.in[14]; dst = wsp<bf16_t>(p, WS_W2); K = 256; N = 2048; ldd = 1792; nb = item % 32; kb = item / 32; map = 2; }
    else if ((item -= CV_UKV) < CV_POOL) { const int g = item >> 4, r = item & 15; src = p.in[15] + (size_t)g * 65536; dst = wsp<bf16_t>(p, WS_W2); K = 256; N = 256; ldd = 1792; nb = r & 3; kb = r >> 2; a = 3584 + g * 256; }
    else if ((item -= CV_POOL) < CV_OUT) { if (OUT_F8) { cvt_f8_item(p.in[17], 2048, wsp<unsigned char>(p, WS_WOUTE), 2048, item, lane, OUT_WSCALE, -1); return; } src = p.in[17]; dst = wsp<bf16_t>(p, WS_WOUTE); K = 2048; N = 2048; ldd = 2048; nb = item & 31; kb = item >> 5; }
    else if ((item -= CV_OUT) < CV_INO) { src = p.in[18]; dst = wsp<bf16_t>(p, WS_WINO); K = 2048; N = 2560; ldd = 2048; nb = item % 40; kb = item / 40; }
    else if ((item -= CV_INO) < CV_OUT) { if (OUT_F8) { cvt_f8_item(p.in[20], 2048, wsp<unsigned char>(p, WS_WOUTO), 2048, item, lane, OUT_WSCALE, -1); return; } src = p.in[20]; dst = wsp<bf16_t>(p, WS_WOUTO); K = 2048; N = 2048; ldd = 2048; nb = item & 31; kb = item >> 5; }
    else { item -= CV_OUT; const int mat = item >> 10, w = item & 1023, le = mat / 3, kind = mat % 3; K = 2048; N = 2048; ldd = 2048; nb = w & 31; kb = w >> 5;
        src = p.in[24 + kind] + (size_t)le * 2048 * 2048;
        if (MOE_F8) { if (kind == 2) cvt_f8_item(src, 2048, wsp<unsigned char>(p, WS_WDN) + (size_t)le * 2048 * 2048, 2048, w, lane, DN_WSCALE, -1);
            else cvt_f8_item(src, 2048, wsp<unsigned char>(p, WS_WGU) + (size_t)le * 4096 * 2048, 4096, w, lane, GU_WSCALE, kind); return; }
        if (kind == 2) dst = wsp<bf16_t>(p, WS_WDN) + (size_t)le * 2048 * 2048; else { dst = wsp<bf16_t>(p, WS_WGU) + (size_t)le * 4096 * 2048; map = 3; a = kind * 128; } }
    const int n = nb * 64 + lane;
    const float* s = src + (size_t)(kb * 64) * N + n;
    float v[64];
#pragma unroll
    for (int k = 0; k < 64; ++k) v[k] = __builtin_nontemporal_load(s + (size_t)k * N);
    int drow;
    if (map == 0) drow = n + a;
    else if (map == 1) drow = n < 768 ? n : (n < 832 ? 1792 + (n - 768) : 768 + (n - 832));
    else if (map == 2) { const int h = n >> 8, j = n & 255; drow = j < 128 ? 1536 + h * 128 + j : 2560 + h * 128 + (j - 128); }
    else drow = (n >> 7) * 256 + (n & 127) + a;
    u32x4* d = (u32x4*)(dst + (size_t)drow * ldd + kb * 64);
#pragma unroll
    for (int c8 = 0; c8 < 8; ++c8) { u32x4 o; o.x = pk2(v[8 * c8], v[8 * c8 + 1]); o.y = pk2(v[8 * c8 + 2], v[8 * c8 + 3]); o.z = pk2(v[8 * c8 + 4], v[8 * c8 + 5]); o.w = pk2(v[8 * c8 + 6], v[8 * c8 + 7]); d[c8] = o; }
}
DI void ph_convert(const Params& p, int wid_, int item_lo, int item_hi, int bid, int nblk, int nwv) {
    const int wv_ = wid_; if (wv_ >= nwv) return;
    const int lane = (wid_ * 64 + fresh_lane()) & 63, gw = bid * nwv + wv_, NGW = nblk * nwv;
    for (int it = item_lo + gw; it < item_hi; it += NGW) cvt_item(p, it, lane);
}

DI void moe_f8_addr(const Params& p, int item, int lane, const float*& s, u32x4*& d, float& scale) {
    const int mat = item >> 10, w = item & 1023, le = mat / 3, kind = mat % 3, nb8 = w & 7, kb16 = w >> 3, n4 = nb8 * 256 + 4 * lane;
    s = p.in[24 + kind] + (size_t)le * 2048 * 2048 + (size_t)(kb16 * 16) * 2048 + n4;
    const int nrows = kind == 2 ? 2048 : 4096, dr = kind == 2 ? n4 : (n4 >> 7) * 256 + (n4 & 127) + kind * 128;
    unsigned char* base = kind == 2 ? wsp<unsigned char>(p, WS_WDN) + (size_t)le * 2048 * 2048 : wsp<unsigned char>(p, WS_WGU) + (size_t)le * 4096 * 2048;
    d = (u32x4*)(base + ((size_t)kb16 * nrows + dr) * 16); scale = kind == 2 ? DN_WSCALE : GU_WSCALE;
}
DI void ph_convert_moe_bg(const Params& p, int wid_, int moe_lo, int moe_hi, int bid, int nblk, int nwv) {
    if (wid_ >= nwv) return;
    const int lane = fresh_lane(), NGW = nblk * nwv; int it = moe_lo + bid * nwv + wid_;
    if (it >= moe_hi) return;
    const float* s; u32x4* d; float sc; f32x4 v[16], vn[16];
    moe_f8_addr(p, it, lane, s, d, sc);
#pragma unroll
    for (int k = 0; k < 16; ++k) v[k] = __builtin_nontemporal_load((const f32x4*)(s + (size_t)k * 2048));
    for (;;) {
        const int itn = it + NGW; const bool more = itn < moe_hi; const float* sn = s; u32x4* dn = d; float scn = sc;
        if (more) { moe_f8_addr(p, itn, lane, sn, dn, scn);
#pragma unroll
            for (int k = 0; k < 16; ++k) vn[k] = __builtin_nontemporal_load((const f32x4*)(sn + (size_t)k * 2048)); }
#pragma unroll
        for (int j = 0; j < 4; ++j) { u32x4 o;
            o.x = pk4_fp8(v[0][j] * sc, v[1][j] * sc, v[2][j] * sc, v[3][j] * sc); o.y = pk4_fp8(v[4][j] * sc, v[5][j] * sc, v[6][j] * sc, v[7][j] * sc);
            o.z = pk4_fp8(v[8][j] * sc, v[9][j] * sc, v[10][j] * sc, v[11][j] * sc); o.w = pk4_fp8(v[12][j] * sc, v[13][j] * sc, v[14][j] * sc, v[15][j] * sc);
            d[j] = o; }
        if (!more) break;
        it = itn; d = dn; sc = scn; s = sn;
#pragma unroll
        for (int k = 0; k < 16; ++k) v[k] = vn[k];
    }
}

DI void ph_misc(const Params& p, int wid_) {
    const size_t gt = (size_t)blockIdx.x * NTHREADS + (wid_ * 64 + fresh_lane()), NGT = (size_t)gridDim.x * NTHREADS;
    float* cosT = ws_cos(p); float* sinT = ws_sin(p);
    for (size_t i = gt; i < 1024 * 32; i += NGT) { const int s = (int)(i >> 5), f = (int)(i & 31);
        const float inv = powf(10000.f, -(float)(f & 15) / 16.f); const float pos = f < 16 ? (float)(s >> 6) : (float)(s & 63); const float ang = pos * inv;
        cosT[i] = cosf(ang); sinT[i] = sinf(ang); }
    bf16_t* ACT2 = wsp<bf16_t>(p, WS_ACT2); bf16_t* KPE = wsp<bf16_t>(p, WS_KPE); bf16_t* KO = wsp<bf16_t>(p, WS_KO); bf16_t* VTO = wsp<bf16_t>(p, WS_VTO);
    const float* cckv = p.in[2]; const float* ckpe = p.in[3]; const float* csk = p.in[4]; const float* csv = p.in[5];
    for (size_t i = gt; i < (size_t)TC * 256 / 4; i += NGT) { const size_t e = i * 4; const int j = (int)(e >> 8), cc = (int)(e & 255); const f32x4 v = *(const f32x4*)(cckv + e);
        u32x2 o; o.x = pk2(v[0], v[1]); o.y = pk2(v[2], v[3]); *(u32x2*)(ACT2 + (size_t)(T + j) * 1792 + 512 + cc) = o;
        const f32x4 k = *(const f32x4*)(csk + e); u32x2 o2; o2.x = pk2(k[0], k[1]); o2.y = pk2(k[2], k[3]); *(u32x2*)(KO + (size_t)(T + j) * 256 + cc) = o2; }
    for (size_t i = gt; i < (size_t)TC * 64 / 4; i += NGT) { const size_t e = i * 4; const f32x4 v = *(const f32x4*)(ckpe + e); u32x2 o; o.x = pk2(v[0], v[1]); o.y = pk2(v[2], v[3]); *(u32x2*)(KPE + (size_t)T * 64 + e) = o; }
    for (size_t i = gt; i < (size_t)256 * (TC / 8); i += NGT) { const int f = (int)(i / (TC / 8)), j8 = (int)(i % (TC / 8)) * 8; float v[8];
#pragma unroll
        for (int q = 0; q < 8; ++q) v[q] = csv[(size_t)(j8 + q) * 256 + f];
        u32x4 o; o.x = pk2(v[0], v[1]); o.y = pk2(v[2], v[3]); o.z = pk2(v[4], v[5]); o.w = pk2(v[6], v[7]); *(u32x4*)(VTO + (size_t)f * TX + T + j8) = o; }
}

DI void ph_h0(const Params& p, int wid_, unsigned char* lds_raw) {
    const int tid = (wid_ * 64 + fresh_lane()), lane = tid & 63, wv = wid_;
    const int rpb = p.rpb, rb0 = blockIdx.x * rpb, rb1 = min(rb0 + rpb, T);
    if (rb0 >= T) return;
    LAS float* P = (LAS float*)lds_raw;
    const int c_lo = cond_of_row(rb0);
    for (int i = tid; i < 2 * 2 * 512; i += NTHREADS) { const int cc = i >> 10, j = (i >> 9) & 1, col = (i & 511) * 4; const int ci = min(c_lo + cc, 8);
        *(LAS f32x4*)(P + (cc * 2 + j) * 2048 + col) = mod_from_partials(p, 0, ci, j, col); }
    __syncthreads();
    bf16_t* H = wsp<bf16_t>(p, WS_H);
    f32x4 v[8], vn[8]; int r = rb0 + wv;
    if (r < rb1) { const float* x = xrow_in(p, r) + lane * 8;
#pragma unroll
        for (int j = 0; j < 4; ++j) { v[2 * j] = __builtin_nontemporal_load((const f32x4*)(x + 512 * j)); v[2 * j + 1] = __builtin_nontemporal_load((const f32x4*)(x + 512 * j + 4)); } }
    for (; r < rb1; r += NWAVES) {
        const int rn = r + NWAVES;
        if (rn < rb1) { const float* x = xrow_in(p, rn) + lane * 8;
#pragma unroll
            for (int j = 0; j < 4; ++j) { vn[2 * j] = __builtin_nontemporal_load((const f32x4*)(x + 512 * j)); vn[2 * j + 1] = __builtin_nontemporal_load((const f32x4*)(x + 512 * j + 4)); } }
        asm volatile("" ::: "memory");
        const LAS float* sh = P + (cond_of_row(r) - c_lo) * 4096; const LAS float* sc = sh + 2048;
#pragma unroll
        for (int j = 0; j < 4; ++j) { const int c0 = lane * 8 + 512 * j;
            const f32x4 h0 = v[2 * j] * (1.f + *(const LAS f32x4*)(sc + c0)) + *(const LAS f32x4*)(sh + c0), h1 = v[2 * j + 1] * (1.f + *(const LAS f32x4*)(sc + c0 + 4)) + *(const LAS f32x4*)(sh + c0 + 4);
            u32x4 o; o.x = pk2(h0[0], h0[1]); o.y = pk2(h0[2], h0[3]); o.z = pk2(h1[0], h1[1]); o.w = pk2(h1[2], h1[3]); *(u32x4*)(H + (size_t)r * D + c0) = o; }
#pragma unroll
        for (int j = 0; j < 8; ++j) v[j] = vn[j];
    }
}

DI void ph_gb(const Params& p, int wid_) {
    float* GB = wsp<float>(p, WS_GB);
    for (int i = blockIdx.x * NTHREADS + (wid_ * 64 + fresh_lane()); i < 2 * 9 * 512; i += gridDim.x * NTHREADS) { const int l = i / (9 * 512), ci = (i / 512) % 9, col = (i & 511) * 4;
        const f32x4 g = *(const f32x4*)(p.in[21] + l * D + col), b = *(const f32x4*)(p.in[22] + l * D + col), sh = *(const f32x4*)(modp(p, l, ci, 3) + col), sc = *(const f32x4*)(modp(p, l, ci, 4) + col);
        *(f32x4*)(GB + ((size_t)(l * 9 + ci) * 2 + 0) * D + col) = g * (1.f + sc); *(f32x4*)(GB + ((size_t)(l * 9 + ci) * 2 + 1) * D + col) = b * (1.f + sc) + sh; }
}
struct E1Row { f32x4 cq[2], ckv, u[4], ad[4], sb[4]; };
DI void e1_seq(int r, int& s, int& S, int& rb) { if (r < T_CTX) { s = r & 255; S = 256; } else { s = (r - T_CTX) & 1023; S = 1024; } rb = r - s; }
DI void e1_load(const float* PJ, int r, int lane, E1Row& L) {
    const float* pr = PJ + (size_t)r * 1792; int s, S, rb; e1_seq(r, s, S, rb);
    L.cq[0] = *(const f32x4*)(pr + lane * 4); L.cq[1] = *(const f32x4*)(pr + lane * 4 + 256); L.ckv = *(const f32x4*)(pr + 512 + lane * 4);
#pragma unroll
    for (int g = 0; g < 4; ++g) { const int half = 1 << g, c0 = 768 + g * 256 + lane * 4; const int ia = s + half - 1, ib = s - half - 1;
        L.u[g] = *(const f32x4*)(pr + c0);
        const float ma = ia < S ? 1.f : 0.f, mb = ib >= 0 ? 1.f : 0.f;
        L.ad[g] = *(const f32x4*)(PJ + (size_t)(rb + min(ia, S - 1)) * 1792 + c0) * ma; L.sb[g] = *(const f32x4*)(PJ + (size_t)(rb + max(ib, 0)) * 1792 + c0) * mb; }
}
DI void e1_window_before(const float* PJ, int r, int lane, f32x4 (&wsum)[4]) {
    int s, S, rb; e1_seq(r, s, S, rb);
#pragma unroll
    for (int g = 0; g < 4; ++g) { const int half = 1 << g, c0 = 768 + g * 256 + lane * 4; const int lo = max(s - 1 - half, 0), hi = min(s - 1 + half, S);
        f32x4 sum = {0.f, 0.f, 0.f, 0.f};
        for (int t = lo; t < hi; ++t) sum += *(const f32x4*)(PJ + (size_t)(rb + t) * 1792 + c0);
        wsum[g] = sum; }
}
DI void ph_e1(const Params& p, int wid_) {
    ph_gb(p, wid_);
    const int lane = fresh_lane();
    const int rpw = (p.rpb + NWAVES - 1) / NWAVES, rb0 = blockIdx.x * p.rpb, ra = rb0 + wid_ * rpw, rz = min(min(ra + rpw, rb0 + p.rpb), T);
    if (ra >= rz) return;
    const float* PJ = wsp<float>(p, WS_PJ); bf16_t* ACT2 = wsp<bf16_t>(p, WS_ACT2);
    const float* qn = p.in[11]; const float* kvn = p.in[12];
    const f32x4 gq0 = *(const f32x4*)(qn + lane * 4), gq1 = *(const f32x4*)(qn + lane * 4 + 256), gkv = *(const f32x4*)(kvn + lane * 4);
    f32x4 wsum[4]; E1Row A, B;
    e1_load(PJ, ra, lane, A);
    e1_window_before(PJ, ra, lane, wsum);
    for (int r = ra; r < rz; ++r) {
        if (r + 1 < rz) e1_load(PJ, r + 1, lane, B);
        bf16_t* ar = ACT2 + (size_t)r * 1792; int s, S, rb; e1_seq(r, s, S, rb);
        if (s == 0 && r != ra) e1_window_before(PJ, r, lane, wsum);
        {
            const float ss = ((A.cq[0][0] * A.cq[0][0] + A.cq[0][1] * A.cq[0][1]) + (A.cq[0][2] * A.cq[0][2] + A.cq[0][3] * A.cq[0][3])) + ((A.cq[1][0] * A.cq[1][0] + A.cq[1][1] * A.cq[1][1]) + (A.cq[1][2] * A.cq[1][2] + A.cq[1][3] * A.cq[1][3]));
            const float rs = rsqrtf(wave_sum(ss) * (1.f / 512.f) + 1e-6f);
            const f32x4 y0 = A.cq[0] * rs * gq0, y1 = A.cq[1] * rs * gq1;
            u32x2 o; o.x = pk2(y0[0], y0[1]); o.y = pk2(y0[2], y0[3]); *(u32x2*)(ar + lane * 4) = o; o.x = pk2(y1[0], y1[1]); o.y = pk2(y1[2], y1[3]); *(u32x2*)(ar + lane * 4 + 256) = o;
        }
        {
            const int c0 = lane * 4; const f32x4 v = A.ckv; const float ss = (v[0] * v[0] + v[1] * v[1]) + (v[2] * v[2] + v[3] * v[3]);
            const float rs = rsqrtf(wave_sum(ss) * (1.f / 256.f) + 1e-6f); const f32x4 y = v * rs * gkv;
            u32x2 o; o.x = pk2(y[0], y[1]); o.y = pk2(y[2], y[3]); *(u32x2*)(ar + 512 + c0) = o;
            if (r < T_CTX) *(f32x4*)(p.out + O_CKV + (size_t)r * 256 + c0) = y;
        }
#pragma unroll
        for (int g = 0; g < 4; ++g) {
            const int half = 1 << g; const int lo = max(s - half, 0), hi = min(s + half, S); const int c0 = 768 + g * 256 + lane * 4;
            wsum[g] = wsum[g] + A.ad[g] - A.sb[g];
            const f32x4 y = wsum[g] * __builtin_amdgcn_rcpf((float)(hi - lo)) - A.u[g];
            u32x2 o; o.x = pk2(y[0], y[1]); o.y = pk2(y[2], y[3]); *(u32x2*)(ar + c0) = o; }
        A = B;
    }
}

DI void ph_ln1(const Params& p, int wid_, int l, unsigned char* lds_raw) {
    constexpr int HGS = 2052;
    const int lane = fresh_lane(), tid = wid_ * 64 + lane;
    const int rb0 = blockIdx.x * p.rpb, rb1 = min(rb0 + p.rpb, T);
    if (rb0 >= T) return;
    LAS float* HG = (LAS float*)lds_raw;
    LAS float* red = HG + 16 * HGS;
    const float* wr = p.in[23] + (size_t)l * 2048 * 16;
    float bk[64];
#pragma unroll
    for (int s = 0; s < 64; ++s) bk[s] = wr[(size_t)(wid_ * 256 + 4 * s + (lane >> 4)) * 16 + (lane & 15)];
    const float* Y = wsp<float>(p, WS_Y); float* STAT = wsp<float>(p, WS_STAT); bf16_t* H = wsp<bf16_t>(p, WS_H); float* AFF = wsp<float>(p, WS_AFF); float* AFFT = wsp<float>(p, WS_AFFT);
    unsigned char* H8 = wsp<unsigned char>(p, WS_H8);
    f32x4 v[8], vn[8], gg[8], gb[8];
#define LN1_ROW(i) (rb0 + 16 * ((i) >> 1) + wid_ + 8 * ((i) & 1))
#define LN1_LOAD(dst, rr) do { if ((rr) < rb1) { _Pragma("unroll") for (int j = 0; j < 4; ++j) { const float* y = Y + (size_t)(rr) * D + lane * 8 + 512 * j; dst[2 * j] = *(const f32x4*)y; dst[2 * j + 1] = *(const f32x4*)(y + 4); } } } while (0)
    const int ngrp = (rb1 - rb0 + 15) >> 4;
    LN1_LOAD(v, LN1_ROW(0));
    for (int g = 0; g < ngrp; ++g) {
#pragma unroll
        for (int h2 = 0; h2 < 2; ++h2) { const int i = 2 * g + h2, r = LN1_ROW(i), rl = wid_ + 8 * h2;
            LN1_LOAD(vn, LN1_ROW(i + 1));
            if (r < rb1) {
                const int ci = cond_of_row(r); const float* gv = wsp<float>(p, WS_GB) + (size_t)(l * 9 + ci) * 2 * D; const float* bv = gv + D;
#pragma unroll
                for (int j = 0; j < 8; ++j) { const int cc = lane * 8 + 512 * (j >> 1) + 4 * (j & 1); gg[j] = *(const f32x4*)(gv + cc); gb[j] = *(const f32x4*)(bv + cc); }
                float s = 0.f;
#pragma unroll
                for (int j = 0; j < 8; ++j) s += (v[j][0] + v[j][1]) + (v[j][2] + v[j][3]);
                const float mean = wave_sum(s) * (1.f / D); float s2 = 0.f;
#pragma unroll
                for (int j = 0; j < 8; ++j) { v[j] = v[j] - mean; s2 += (v[j][0] * v[j][0] + v[j][1] * v[j][1]) + (v[j][2] * v[j][2] + v[j][3] * v[j][3]); }
                const float rstd = rsqrtf(wave_sum(s2) * (1.f / D) + 1e-5f);
#pragma unroll
                for (int j = 0; j < 4; ++j) { const int c0 = lane * 8 + 512 * j;
                    const f32x4 a = v[2 * j] * rstd * gg[2 * j] + gb[2 * j], b = v[2 * j + 1] * rstd * gg[2 * j + 1] + gb[2 * j + 1];
                    *(LAS f32x4*)(HG + rl * HGS + c0) = a; *(LAS f32x4*)(HG + rl * HGS + c0 + 4) = b;
                    if (!MOE_F8) { u32x4 o; o.x = pk2(a[0], a[1]); o.y = pk2(a[2], a[3]); o.z = pk2(b[0], b[1]); o.w = pk2(b[2], b[3]); *(u32x4*)(H + (size_t)r * D + c0) = o; }
                    u32x2 o8; o8.x = pk4_fp8(a[0], a[1], a[2], a[3]); o8.y = pk4_fp8(b[0], b[1], b[2], b[3]); *(u32x2*)(H8 + (size_t)r * D + c0) = o8; }
                if (lane == 0) *(f32x2*)(STAT + 2 * (size_t)r) = (f32x2){mean, rstd};
            } else {
#pragma unroll
                for (int j = 0; j < 4; ++j) { const int c0 = lane * 8 + 512 * j; *(LAS f32x4*)(HG + rl * HGS + c0) = (f32x4){0.f, 0.f, 0.f, 0.f}; *(LAS f32x4*)(HG + rl * HGS + c0 + 4) = (f32x4){0.f, 0.f, 0.f, 0.f}; } }
#pragma unroll
            for (int j = 0; j < 8; ++j) v[j] = vn[j];
        }
        __syncthreads();
        {
            f32x4 acc = {0.f, 0.f, 0.f, 0.f};
            const LAS float* ap = HG + (lane & 15) * HGS + wid_ * 256 + (lane >> 4);
#pragma unroll
            for (int s = 0; s < 64; ++s) acc = __builtin_amdgcn_mfma_f32_16x16x4f32(ap[4 * s], bk[s], acc, 0, 0, 0);
#pragma unroll
            for (int rg = 0; rg < 4; ++rg) red[wid_ * 256 + ((lane >> 4) * 4 + rg) * 16 + (lane & 15)] = acc[rg];
        }
        __syncthreads();
        if (tid < 256) { const int row = tid >> 4, e = tid & 15, r = rb0 + 16 * g + row;
            float lg = 0.f;
#pragma unroll
            for (int w = 0; w < NWAVES; ++w) lg += red[w * 256 + tid];
            float m = lg;
#pragma unroll
            for (int o = 1; o < 16; o <<= 1) m = fmaxf(m, __shfl_xor(m, o));
            const float ex = expf(lg - m); float den = ex;
#pragma unroll
            for (int o = 1; o < 16; o <<= 1) den += __shfl_xor(den, o);
            if (r < rb1) { const float af = ex / den; AFF[(size_t)r * 16 + e] = af; AFFT[(size_t)e * T + r] = af; } }
        __syncthreads();
    }
#undef LN1_LOAD
#undef LN1_ROW
}

DI int wave_incl_scan(int v, int lane) {
#pragma unroll
    for (int o = 1; o < 64; o <<= 1) { const int u = __shfl_up(v, o); v += lane >= o ? u : 0; }
    return v;
}
DI int block_excl_scan2(int a0, int a1, int tid, int lane, int wave, int* wsum) {
    const int s = a0 + a1, incl = wave_incl_scan(s, lane);
    if (lane == 63) wsum[wave] = incl;
    __syncthreads();
    int base = 0;
#pragma unroll
    for (int w = 0; w < NWAVES; ++w) base += w < wave ? wsum[w] : 0;
    __syncthreads();
    return base + incl - s;
}
DI void ph_topk(const Params& p, int wid_, unsigned char* lds_raw) {
    const int tid = (wid_ * 64 + fresh_lane()), lane = tid & 63, wave = wid_;
    unsigned* vb = (unsigned*)lds_raw;
    int* hist = (int*)(vb + 1024);
    int* wsum = hist + 256;
    int* ctl = wsum + 16;
    int* selrow = ctl + 4;
    int* selslot = selrow + 128;
    int* nsel = selslot + 128;
    const float* AFFT = wsp<float>(p, WS_AFFT); int* INV = wsp<int>(p, WS_INV); const bf16_t* H = wsp<bf16_t>(p, WS_H); const unsigned char* H8 = wsp<unsigned char>(p, WS_H8); bf16_t* XS = wsp<bf16_t>(p, WS_XS);
    for (int it = blockIdx.x; it < 384; it += gridDim.x) {
        int n, cap, r0, e, sb;
        if (it < 128) { const int b = it >> 4; e = it & 15; n = 1024; cap = 128; r0 = T_CTX + b * 1024; sb = 512 + b * 128; }
        else { const int li = it - 128, b = li >> 4; e = li & 15; n = 256; cap = 32; r0 = b * 256; sb = b * 32; }
        const int i0 = 2 * tid, i1 = 2 * tid + 1;
        unsigned b0 = 0u, b1 = 0u;
        if (i0 < n) { const f32x2 a = *(const f32x2*)(AFFT + (size_t)e * T + r0 + i0); b0 = __float_as_uint(a[0]); b1 = __float_as_uint(a[1]); vb[i0] = b0; vb[i1] = b1; }
        if (tid == 0) *nsel = 0;
        unsigned prefix = 0u; int need = cap;
#pragma unroll
        for (int pass = 0; pass < 4; ++pass) { const int shift = 24 - 8 * pass;
            if (tid < 256) hist[tid] = 0;
            __syncthreads();
            if (i0 < n) { const bool m0 = pass == 0 || (b0 >> (shift + 8)) == prefix, m1 = pass == 0 || (b1 >> (shift + 8)) == prefix;
                if (m0) atomicAdd(&hist[(b0 >> shift) & 255u], 1); if (m1) atomicAdd(&hist[(b1 >> shift) & 255u], 1); }
            __syncthreads();
            if (wave == 0) { int h4[4], s = 0;
#pragma unroll
                for (int j = 0; j < 4; ++j) { h4[j] = hist[255 - (4 * lane + j)]; s += h4[j]; }
                const int incl = wave_incl_scan(s, lane), excl = incl - s;
                if (excl < need && need <= incl) { int cum = excl, bin = 0, nn = need; bool done = false;
#pragma unroll
                    for (int j = 0; j < 4; ++j) { if (!done) { if (cum + h4[j] >= need) { bin = 255 - (4 * lane + j); nn = need - cum; done = true; } else cum += h4[j]; } }
                    ctl[0] = bin; ctl[1] = nn; } }
            __syncthreads();
            prefix = (prefix << 8) | (unsigned)ctl[0]; need = ctl[1];
        }
        const int g0 = (i0 < n && b0 > prefix) ? 1 : 0, g1 = (i0 < n && b1 > prefix) ? 1 : 0, q0 = (i0 < n && b0 == prefix) ? 1 : 0, q1 = (i0 < n && b1 == prefix) ? 1 : 0;
        const int eqb = block_excl_scan2(q0, q1, tid, lane, wave, wsum);
        const int s0 = g0 | (q0 & (eqb < need ? 1 : 0)), s1 = g1 | (q1 & (eqb + q0 < need ? 1 : 0));
        const int slb = block_excl_scan2(s0, s1, tid, lane, wave, wsum);
        if (i0 < n) {
            INV[(size_t)(r0 + i0) * 16 + e] = s0 ? sb + slb : -1; INV[(size_t)(r0 + i1) * 16 + e] = s1 ? sb + slb + s0 : -1;
            if (s0) { const int pos = atomicAdd(nsel, 1); selrow[pos] = i0; selslot[pos] = slb; }
            if (s1) { const int pos = atomicAdd(nsel, 1); selrow[pos] = i1; selslot[pos] = slb + s0; } }
        __syncthreads();
        const int ns = *nsel;
        for (int k0 = wave; k0 < ns; k0 += 4 * NWAVES) {
            if (MOE_F8) { u32x4 bufr[4][2];
#pragma unroll
                for (int b = 0; b < 4; ++b) { const int k = k0 + NWAVES * b; if (k < ns) { const u32x4* src = (const u32x4*)(H8 + (size_t)(r0 + selrow[k]) * D); bufr[b][0] = src[lane]; bufr[b][1] = src[lane + 64]; } }
#pragma unroll
                for (int b = 0; b < 4; ++b) { const int k = k0 + NWAVES * b; if (k < ns) { u32x4* dst = (u32x4*)((unsigned char*)XS + (size_t)(e * NSLOT + sb + selslot[k]) * D); dst[lane] = bufr[b][0]; dst[lane + 64] = bufr[b][1]; } } }
            else {
#pragma unroll
                for (int b = 0; b < 4; ++b) { const int k = k0 + NWAVES * b; if (k < ns) { const u32x4* src = (const u32x4*)(H + (size_t)(r0 + selrow[k]) * D); u32x4* dst = (u32x4*)(XS + (size_t)(e * NSLOT + sb + selslot[k]) * D);
#pragma unroll
                    for (int j = 0; j < 4; ++j) dst[lane + 64 * j] = src[lane + 64 * j]; } } } }
        __syncthreads();
    }
}

DI void ph_ln2(const Params& p, int wid_, int l, unsigned char* lds_raw) {
    const int tid = (wid_ * 64 + fresh_lane()), lane = tid & 63, wv = wid_;
    const int rpb = p.rpb, rb0 = blockIdx.x * rpb, rb1 = min(rb0 + rpb, T);
    if (rb0 >= T) return;
    LAS float* PV = (LAS float*)lds_raw;
    LAS float* PC = PV + 4 * 2048;
    const int c_lo = cond_of_row(rb0);
    for (int i = tid; i < 4 * 512; i += NTHREADS) { const int w = i >> 9, col = (i & 511) * 4; const float* src = w == 0 ? p.in[21] + l * D : w == 1 ? p.in[22] + l * D : w == 2 ? p.in[27] + l * D : p.in[28] + l * D;
        *(LAS f32x4*)(PV + w * 2048 + col) = *(const f32x4*)(src + col); }
    for (int i = tid; i < 2 * 3 * 512; i += NTHREADS) { const int cc = i / 1536, w = (i / 512) % 3, col = (i & 511) * 4; const int ci = min(c_lo + cc, 8);
        const float* src = w == 0 ? modp(p, l, ci, 5) : modp(p, 1, ci, w == 1 ? 0 : 1);
        *(LAS f32x4*)(PC + (cc * 3 + w) * 2048 + col) = *(const f32x4*)(src + col); }
    __syncthreads();
    const float* Y = wsp<float>(p, WS_Y); const float* STAT = wsp<float>(p, WS_STAT);
    const float* AFF = wsp<float>(p, WS_AFF); const int* INV = wsp<int>(p, WS_INV); const bf16_t* YE = wsp<bf16_t>(p, WS_YE);
    float* XL = wsp<float>(p, WS_XL); bf16_t* H = wsp<bf16_t>(p, WS_H);
    f32x4 x[8], xn[8]; int sl = -1, sln = -1; float af = 0.f, afn = 0.f; f32x2 st = {0.f, 1.f}, stn = {0.f, 1.f};
    int r = rb0 + wv;
#define LN2_LOAD(dx, ds, da, dt, rr) do { if ((rr) < rb1) { _Pragma("unroll") for (int j = 0; j < 4; ++j) { const float* y = Y + (size_t)(rr) * D + lane * 8 + 512 * j; dx[2 * j] = __builtin_nontemporal_load((const f32x4*)y); dx[2 * j + 1] = __builtin_nontemporal_load((const f32x4*)(y + 4)); } \
        if (lane < 16) { ds = INV[(size_t)(rr) * 16 + lane]; da = AFF[(size_t)(rr) * 16 + lane]; } dt = *(const f32x2*)(STAT + 2 * (size_t)(rr)); } } while (0)
    LN2_LOAD(x, sl, af, st, r);
    for (; r < rb1; r += NWAVES) {
        asm volatile("" ::: "memory");
        LN2_LOAD(xn, sln, afn, stn, r + NWAVES);
        const LAS float* pc = PC + (cond_of_row(r) - c_lo) * 3 * 2048;
        f32x4 f[8];
#pragma unroll
        for (int j = 0; j < 8; ++j) f[j] = (f32x4){0.f, 0.f, 0.f, 0.f};
        {
            unsigned long long mk = __ballot(sl >= 0) & 0xffffull;
            while (mk) {
                const int e0 = __builtin_ctzll(mk); mk &= mk - 1; const bool two = mk != 0ull; const int e1 = two ? __builtin_ctzll(mk) : e0; if (two) mk &= mk - 1;
                const int s0 = __shfl(sl, e0), s1 = __shfl(sl, e1); const float w0 = __shfl(af, e0), w1 = two ? __shfl(af, e1) : 0.f;
                const bf16_t* y0 = YE + (size_t)(e0 * NSLOT + s0) * D + lane * 8; const bf16_t* y1 = YE + (size_t)(e1 * NSLOT + s1) * D + lane * 8;
                u32x4 q0[4], q1[4];
#pragma unroll
                for (int j = 0; j < 4; ++j) { q0[j] = __builtin_nontemporal_load((const u32x4*)(y0 + 512 * j)); q1[j] = __builtin_nontemporal_load((const u32x4*)(y1 + 512 * j)); }
#pragma unroll
                for (int j = 0; j < 4; ++j) {
                    f[2 * j][0] += w0 * bflo(q0[j].x) + w1 * bflo(q1[j].x); f[2 * j][1] += w0 * bfhi(q0[j].x) + w1 * bfhi(q1[j].x); f[2 * j][2] += w0 * bflo(q0[j].y) + w1 * bflo(q1[j].y); f[2 * j][3] += w0 * bfhi(q0[j].y) + w1 * bfhi(q1[j].y);
                    f[2 * j + 1][0] += w0 * bflo(q0[j].z) + w1 * bflo(q1[j].z); f[2 * j + 1][1] += w0 * bfhi(q0[j].z) + w1 * bfhi(q1[j].z); f[2 * j + 1][2] += w0 * bflo(q0[j].w) + w1 * bflo(q1[j].w); f[2 * j + 1][3] += w0 * bfhi(q0[j].w) + w1 * bfhi(q1[j].w); }
            }
        }
        float s = 0.f;
#pragma unroll
        for (int j = 0; j < 8; ++j) { const int c0 = lane * 8 + 512 * (j >> 1) + 4 * (j & 1); const f32x4 x1 = (x[j] - st[0]) * st[1] * *(const LAS f32x4*)(PV + c0) + *(const LAS f32x4*)(PV + 2048 + c0);
            f[j] = DN_ALPHA * x1 + *(const LAS f32x4*)(pc + c0) * f[j]; s += (f[j][0] + f[j][1]) + (f[j][2] + f[j][3]); }
        const float mean = wave_sum(s) * (1.f / D); float s2 = 0.f;
#pragma unroll
        for (int j = 0; j < 8; ++j) { f[j] = f[j] - mean; s2 += (f[j][0] * f[j][0] + f[j][1] * f[j][1]) + (f[j][2] * f[j][2] + f[j][3] * f[j][3]); }
        const float rstd = rsqrtf(wave_sum(s2) * (1.f / D) + 1e-5f);
#pragma unroll
        for (int j = 0; j < 4; ++j) { const int c0 = lane * 8 + 512 * j; f32x4 o[2];
#pragma unroll
            for (int q = 0; q < 2; ++q) { const int cc = c0 + 4 * q; o[q] = f[2 * j + q] * rstd * *(const LAS f32x4*)(PV + 2 * 2048 + cc) + *(const LAS f32x4*)(PV + 3 * 2048 + cc);
                if (l == 0) { *(f32x4*)(XL + (size_t)r * D + cc) = o[q]; o[q] = o[q] * (1.f + *(const LAS f32x4*)(pc + 2 * 2048 + cc)) + *(const LAS f32x4*)(pc + 2048 + cc); }
                else *(f32x4*)(p.out + O_Y + (size_t)r * D + cc) = o[q]; }
            if (l == 0) { u32x4 w; w.x = pk2(o[0][0], o[0][1]); w.y = pk2(o[0][2], o[0][3]); w.z = pk2(o[1][0], o[1][1]); w.w = pk2(o[1][2], o[1][3]); *(u32x4*)(H + (size_t)r * D + c0) = w; } }
#pragma unroll
        for (int j = 0; j < 8; ++j) x[j] = xn[j];
        sl = sln; af = afn; st = stn;
    }
#undef LN2_LOAD
}
template <int PAT> DI void ph_readonly(const Params& p, int wid_) {
    const int lane = (wid_ * 64 + fresh_lane()) & 63, gw = blockIdx.x * NWAVES + wid_, NGW = gridDim.x * NWAVES;
    float accum = 0.f;
    for (int it = gw; it < 98304; it += NGW) {
        const int mat = it >> 10, w = it & 1023, le = mat / 3, kind = mat % 3;
        const float* base = p.in[24 + kind] + (size_t)le * 2048 * 2048;
        if (PAT == 0) { const int nb = w & 31, kb = w >> 5; const float* s = base + (size_t)(kb * 64) * 2048 + nb * 64 + lane; float v[64];
#pragma unroll
            for (int k = 0; k < 64; ++k) v[k] = __builtin_nontemporal_load(s + (size_t)k * 2048);
#pragma unroll
            for (int k = 0; k < 64; ++k) accum += v[k]; }
        else if (PAT == 1) { const int nb8 = w & 7, kb16 = w >> 3; const float* s = base + (size_t)(kb16 * 16) * 2048 + nb8 * 256 + 4 * lane; f32x4 v[16];
#pragma unroll
            for (int k = 0; k < 16; ++k) v[k] = __builtin_nontemporal_load((const f32x4*)(s + (size_t)k * 2048));
#pragma unroll
            for (int k = 0; k < 16; ++k) accum += (v[k][0] + v[k][1]) + (v[k][2] + v[k][3]); }
        else { const float* s = base + (size_t)w * 4096 + 4 * lane; f32x4 v[16];
#pragma unroll
            for (int k = 0; k < 16; ++k) v[k] = __builtin_nontemporal_load((const f32x4*)(s + (size_t)k * 256));
#pragma unroll
            for (int k = 0; k < 16; ++k) accum += (v[k][0] + v[k][1]) + (v[k][2] + v[k][3]); }
    }
    if (lane == 0) wsp<float>(p, WS_DBG)[gw] = accum + wave_sum(accum);
}

struct Unit { const char* A; const char* B; unsigned lda, ldb; int nt; int pm, pn; int mode; int aux; };
DI int vcu_of(int bx, int G) { return (G % 8 == 0) ? (bx % 8) * (G / 8) + bx / 8 : bx; }

DI void rope8(const Params& p, int s, int pi0, float* v) {
    const f32x4 c = *(const f32x4*)(ws_cos(p) + s * 32 + pi0), sn = *(const f32x4*)(ws_sin(p) + s * 32 + pi0);
#pragma unroll
    for (int i = 0; i < 4; ++i) { const float x1 = v[2 * i], x2 = v[2 * i + 1]; v[2 * i] = x1 * c[i] - x2 * sn[i]; v[2 * i + 1] = x1 * sn[i] + x2 * c[i]; }
}
DI void st_bf16x8(bf16_t* dst, const float* v) { u32x4 w; w.x = pk2(v[0], v[1]); w.y = pk2(v[2], v[3]); w.z = pk2(v[4], v[5]); w.w = pk2(v[6], v[7]); *(u32x4*)dst = w; }
DI void st_f32x8(float* dst, const float* v) { *(f32x4*)dst = (f32x4){v[0], v[1], v[2], v[3]}; *(f32x4*)(dst + 4) = (f32x4){v[4], v[5], v[6], v[7]}; }

struct SchedInEven { static constexpr bool BK16 = false; const Params* p; int G, c;
    DI bool next(int i, Unit& u) const { const int L = i * G + c; if (L >= 48 * 8) return false; u.pm = L >> 3; u.pn = L & 7;
        u.A = (const char*)wsp<bf16_t>(*p, WS_H) + (size_t)u.pm * 256 * 4096; u.B = (const char*)wsp<bf16_t>(*p, WS_WINE) + (size_t)u.pn * 256 * 4096; u.lda = 4096; u.ldb = 4096; u.nt = 32; u.mode = 0; u.aux = 0; return true; } };
struct EpiInEven { static constexpr bool HAS_STATE = false; static constexpr bool PAIR = false, F8 = false; const Params* p;
    DI void store(const Unit& u, int row, int col, float* v) const {
        const int r = u.pm * 256 + row, gc = u.pn * 256 + col;
        if (gc < 1792) { st_f32x8(wsp<float>(*p, WS_PJ) + (size_t)r * 1792 + gc, v); return; }
        if (gc >= 1856) return;
        const int j0 = gc - 1792;
        if (r < T_CTX) st_f32x8(p->out + O_KPE + (size_t)r * 64 + j0, v); else rope8(*p, (r - T_CTX) & 1023, j0 >> 1, v);
        st_bf16x8(wsp<bf16_t>(*p, WS_KPE) + (size_t)r * 64 + j0, v);
    } };

constexpr int E2_Q = 48 * 6, E2_K = 64 * 4, E2_V = 4 * 64, E2_P = 48 * 4, E2_TOTAL = E2_Q + E2_K + E2_V + E2_P;
struct SchedE2 { static constexpr bool BK16 = false; const Params* p; int G, c;
    DI bool next(int i, Unit& u) const { int L;
        if (G == 256) { if (c < 32) { if (i > 2) return false; L = i == 0 ? c : (i == 1 ? 256 + c : E2_Q + c); } else { if (i > 3) return false; L = i == 0 ? c : E2_Q + 32 + (c - 32) * 3 + (i - 1); } }
        else { L = i * G + c; if (L >= E2_TOTAL) return false; }
        const char* ACT2 = (const char*)wsp<bf16_t>(*p, WS_ACT2); const char* W2 = (const char*)wsp<bf16_t>(*p, WS_W2); u.aux = 0;
        if (L < E2_Q) { u.mode = 0; u.pm = L / 6; u.pn = L % 6; u.A = ACT2 + (size_t)u.pm * 256 * 3584; u.lda = 3584; u.B = W2 + (size_t)u.pn * 256 * 3584; u.ldb = 3584; u.nt = 8; return true; }
        L -= E2_Q;
        if (L < E2_K) { u.mode = 1; u.pm = L >> 2; u.pn = L & 3; u.A = ACT2 + (size_t)u.pm * 256 * 3584 + 512 * 2; u.lda = 3584; u.B = W2 + (size_t)(1536 + u.pn * 256) * 3584; u.ldb = 3584; u.nt = 4; return true; }
        L -= E2_K;
        if (L < E2_V) { u.mode = 2; u.pm = L >> 6; u.pn = L & 63; u.A = W2 + (size_t)(2560 + u.pm * 256) * 3584; u.lda = 3584; u.B = ACT2 + (size_t)u.pn * 256 * 3584 + 512 * 2; u.ldb = 3584; u.nt = 4; return true; }
        L -= E2_V;
        u.mode = 3; u.pm = L >> 2; u.aux = L & 3; u.pn = 0; u.A = ACT2 + (size_t)u.pm * 256 * 3584 + (768 + u.aux * 256) * 2; u.lda = 3584; u.B = W2 + (size_t)(3584 + u.aux * 256) * 3584; u.ldb = 3584; u.nt = 4; return true; } };
struct EpiE2 { static constexpr bool HAS_STATE = false; static constexpr bool PAIR = false, F8 = false; const Params* p;
    DI void store(const Unit& u, int row, int col, float* v) const {
        const int r = u.pm * 256 + row, gc = u.pn * 256 + col;
        if (u.mode == 0) { const int dd = gc % 192; if (dd >= 128 && r >= T_CTX) rope8(*p, (r - T_CTX) & 1023, (dd - 128) >> 1, v);
#pragma unroll
            for (int i = 0; i < 8; ++i) v[i] *= QS_MLA;
            st_bf16x8(wsp<bf16_t>(*p, WS_Q) + (size_t)r * 1536 + gc, v); }
        else if (u.mode == 1) st_bf16x8(wsp<bf16_t>(*p, WS_KN) + (size_t)r * 1024 + gc, v);
        else if (u.mode == 2) st_bf16x8(wsp<bf16_t>(*p, WS_VT) + (size_t)r * TX + gc, v);
        else { const float* ps = p->in[16] + u.aux * 256 + col;
#pragma unroll
            for (int i = 0; i < 8; ++i) v[i] *= ps[i];
            if (OUT_F8) { u32x2 o; o.x = pk4_fp8(v[0], v[1], v[2], v[3]); o.y = pk4_fp8(v[4], v[5], v[6], v[7]); *(u32x2*)((unsigned char*)wsp<bf16_t>(*p, WS_MIX) + (size_t)r * 2048 + 1024 + u.aux * 256 + col) = o; }
            else st_bf16x8(wsp<bf16_t>(*p, WS_MIX) + (size_t)r * 2048 + 1024 + u.aux * 256 + col, v); }
    } };

struct SchedOut { static constexpr bool BK16 = OUT_F8 != 0; const Params* p; int G, c, l;
    DI bool next(int i, Unit& u) const { const int L = i * G + c; if (L >= 48 * 8) return false; u.pm = L >> 3; u.pn = L & 7;
        constexpr unsigned P = OUT_F8 ? 2048 : 4096;
        u.A = (const char*)wsp<bf16_t>(*p, WS_MIX) + (size_t)u.pm * 256 * P; u.B = (const char*)wsp<bf16_t>(*p, l == 0 ? WS_WOUTE : WS_WOUTO) + (OUT_F8 ? (size_t)u.pn * 256 * 16 : (size_t)u.pn * 256 * P); u.lda = P; u.ldb = OUT_F8 ? 2048 * 16 : P; u.nt = OUT_F8 ? 16 : 32; u.mode = 0; u.aux = 0; return true; } };
struct EpiOut { static constexpr bool HAS_STATE = false; static constexpr bool PAIR = false, F8 = OUT_F8 != 0; const Params* p; int l;
    DI void store(const Unit& u, int row, int col, float* v) const {
        const int r = u.pm * 256 + row, gc = u.pn * 256 + col;
        const float* x = (l == 0 ? xrow_in(*p, r) : wsp<float>(*p, WS_XL) + (size_t)r * D) + gc; const float* g1 = modp(*p, l, cond_of_row(r), 2) + gc;
        const f32x4 x0 = *(const f32x4*)x, x1 = *(const f32x4*)(x + 4), g0 = *(const f32x4*)g1, g4 = *(const f32x4*)(g1 + 4);
#pragma unroll
        for (int i = 0; i < 4; ++i) { const float w0 = OUT_F8 ? g0[i] * (1.f / OUT_WSCALE) : g0[i], w4 = OUT_F8 ? g4[i] * (1.f / OUT_WSCALE) : g4[i]; v[i] = DN_ALPHA * x0[i] + w0 * v[i]; v[4 + i] = DN_ALPHA * x1[i] + w4 * v[4 + i]; }
        st_f32x8(wsp<float>(*p, WS_Y) + (size_t)r * D + gc, v);
    } };

struct SchedGU { static constexpr bool BK16 = MOE_F8 != 0; const Params* p; int G, c, l;
    DI bool next(int i, Unit& u) const { const int L = i * G + c; if (L >= 16 * 96) return false; const int e = L / 96, rem = L % 96; u.pn = rem / 6; u.pm = e * 6 + rem % 6; u.aux = e;
        constexpr unsigned P = MOE_F8 ? 2048 : 4096;
        u.A = (const char*)wsp<bf16_t>(*p, WS_XS) + (size_t)u.pm * 256 * P; u.B = (const char*)wsp<bf16_t>(*p, WS_WGU) + (MOE_F8 ? (size_t)(l * 16 + e) * 4096 * 2048 + (size_t)u.pn * 256 * 16 : ((size_t)(l * 16 + e) * 4096 + (size_t)u.pn * 256) * P); u.lda = P; u.ldb = MOE_F8 ? 4096 * 16 : P; u.nt = MOE_F8 ? 16 : 32; u.mode = 0; return true; } };
struct EpiGU { static constexpr bool HAS_STATE = false; static constexpr bool PAIR = true, F8 = MOE_F8 != 0; const Params* p;
    DI void store2(const Unit& u, int row, int col, const float* g, const float* up) const {
        float h[8];
#pragma unroll
        for (int i = 0; i < 8; ++i) { const float gg = MOE_F8 ? g[i] * (1.f / GU_WSCALE) : g[i], uu = MOE_F8 ? up[i] * (1.f / GU_WSCALE) : up[i]; h[i] = gg * uu * __builtin_amdgcn_rcpf(1.f + __expf(-gg)); }
        if (MOE_F8) { u32x2 o; o.x = pk4_fp8(h[0], h[1], h[2], h[3]); o.y = pk4_fp8(h[4], h[5], h[6], h[7]); *(u32x2*)((unsigned char*)wsp<bf16_t>(*p, WS_HID) + (size_t)(u.pm * 256 + row) * D + u.pn * 128 + col) = o; }
        else st_bf16x8(wsp<bf16_t>(*p, WS_HID) + (size_t)(u.pm * 256 + row) * D + u.pn * 128 + col, h);
    } };

struct SchedDown { static constexpr bool BK16 = MOE_F8 != 0; const Params* p; int G, c, l;
    DI bool next(int i, Unit& u) const { const int L = i * G + c; if (L >= 16 * 48) return false; const int e = L / 48, rem = L % 48; u.pn = rem / 6; u.pm = e * 6 + rem % 6; u.aux = e;
        constexpr unsigned P = MOE_F8 ? 2048 : 4096;
        u.A = (const char*)wsp<bf16_t>(*p, WS_HID) + (size_t)u.pm * 256 * P; u.B = (const char*)wsp<bf16_t>(*p, WS_WDN) + (MOE_F8 ? (size_t)(l * 16 + e) * 2048 * 2048 + (size_t)u.pn * 256 * 16 : ((size_t)(l * 16 + e) * 2048 + (size_t)u.pn * 256) * P); u.lda = P; u.ldb = MOE_F8 ? 2048 * 16 : P; u.nt = MOE_F8 ? 16 : 32; u.mode = 0; return true; } };
struct EpiDown { static constexpr bool HAS_STATE = false; static constexpr bool PAIR = false, F8 = MOE_F8 != 0; const Params* p;
    DI void store(const Unit& u, int row, int col, float* v) const {
        if (MOE_F8) {
#pragma unroll
            for (int i = 0; i < 8; ++i) v[i] *= (1.f / DN_WSCALE); }
        st_bf16x8(wsp<bf16_t>(*p, WS_YE) + (size_t)(u.pm * 256 + row) * D + u.pn * 256 + col, v); } };

constexpr int IO_QK = 48 * 9, IO_V = 16, IO_VT = 48, IO_TOTAL = IO_QK + IO_V + IO_VT;
struct SchedInOdd { static constexpr bool BK16 = false; const Params* p; int G, c;
    DI bool next(int i, Unit& u) const { int L = i * G + c; if (L >= IO_TOTAL) return false;
        const char* Hb = (const char*)wsp<bf16_t>(*p, WS_H); const char* W = (const char*)wsp<bf16_t>(*p, WS_WINO); u.aux = 0; u.nt = 32; u.lda = 4096; u.ldb = 4096;
        if (L < IO_QK) { u.mode = 0; u.pm = L / 9; u.pn = L % 9; u.A = Hb + (size_t)u.pm * 256 * 4096; u.B = W + (size_t)u.pn * 256 * 4096; return true; }
        L -= IO_QK;
        if (L < IO_V) { u.mode = 1; u.pm = L; u.pn = 9; u.A = Hb + (size_t)u.pm * 256 * 4096; u.B = W + (size_t)9 * 256 * 4096; return true; }
        L -= IO_V;
        u.mode = 2; u.pm = 0; u.pn = L; u.A = W + (size_t)9 * 256 * 4096; u.B = Hb + (size_t)u.pn * 256 * 4096; return true; } };
struct EpiInOdd { static constexpr bool HAS_STATE = true; static constexpr bool PAIR = false, F8 = false; const Params* p;
    struct State { f32x4 c[4], s[4]; bool rot; };
    DI void begin(State& st, const Unit& u, int row0, int col0) const {
        st.rot = u.mode == 0 && u.pm * 256 >= T_CTX;
        if (st.rot) { const int pi0 = (col0 & 63) >> 1;
#pragma unroll
            for (int ri = 0; ri < 4; ++ri) { const int r = u.pm * 256 + ri * 16 + row0, sp = (r - T_CTX) & 1023;
                st.c[ri] = *(const f32x4*)(ws_cos(*p) + sp * 32 + pi0); st.s[ri] = *(const f32x4*)(ws_sin(*p) + sp * 32 + pi0); } }
    }
    DI void store_st(const State& st, int ri, const Unit& u, int row, int col, float* v) const {
        const int r = u.pm * 256 + row, gc = u.pn * 256 + col;
        if (u.mode == 0) {
            if (gc < 2048) {
                if (st.rot) {
#pragma unroll
                    for (int i = 0; i < 4; ++i) { const float x1 = v[2 * i], x2 = v[2 * i + 1]; v[2 * i] = x1 * st.c[ri][i] - x2 * st.s[ri][i]; v[2 * i + 1] = x1 * st.s[ri][i] + x2 * st.c[ri][i]; } }
#pragma unroll
                for (int i = 0; i < 8; ++i) v[i] *= QS_SWA;
                st_bf16x8(wsp<bf16_t>(*p, WS_Q) + (size_t)r * 2048 + gc, v); }
            else { const int kc = gc - 2048; if (r < T_CTX) st_f32x8(p->out + O_SK + (size_t)r * 256 + kc, v);
                if (st.rot) {
#pragma unroll
                    for (int i = 0; i < 4; ++i) { const float x1 = v[2 * i], x2 = v[2 * i + 1]; v[2 * i] = x1 * st.c[ri][i] - x2 * st.s[ri][i]; v[2 * i + 1] = x1 * st.s[ri][i] + x2 * st.c[ri][i]; } }
                st_bf16x8(wsp<bf16_t>(*p, WS_KO) + (size_t)r * 256 + kc, v); } }
        else if (u.mode == 1) st_f32x8(p->out + O_SV + (size_t)r * 256 + col, v);
        else st_bf16x8(wsp<bf16_t>(*p, WS_VTO) + (size_t)row * TX + gc, v);
    }
    DI void store(const Unit& u, int row, int col, float* v) const {
        const int r = u.pm * 256 + row, gc = u.pn * 256 + col;
        if (u.mode == 0) {
            if (gc < 2048) { if (r >= T_CTX) rope8(*p, (r - T_CTX) & 1023, (gc & 63) >> 1, v);
#pragma unroll
                for (int i = 0; i < 8; ++i) v[i] *= QS_SWA;
                st_bf16x8(wsp<bf16_t>(*p, WS_Q) + (size_t)r * 2048 + gc, v); }
            else { const int kc = gc - 2048; if (r < T_CTX) st_f32x8(p->out + O_SK + (size_t)r * 256 + kc, v); else rope8(*p, (r - T_CTX) & 1023, (kc & 63) >> 1, v);
                st_bf16x8(wsp<bf16_t>(*p, WS_KO) + (size_t)r * 256 + kc, v); } }
        else if (u.mode == 1) st_f32x8(p->out + O_SV + (size_t)r * 256 + col, v);
        else st_bf16x8(wsp<bf16_t>(*p, WS_VTO) + (size_t)row * TX + gc, v);
    } };

namespace pg8 {
typedef short bf16x8 __attribute__((ext_vector_type(8)));
typedef int i32x4 __attribute__((ext_vector_type(4)));
typedef int i32x8 __attribute__((ext_vector_type(8)));
DI i32x8 cat8(bf16x8 lo, bf16x8 hi) { return __builtin_shufflevector(__builtin_bit_cast(i32x4, lo), __builtin_bit_cast(i32x4, hi), 0, 1, 2, 3, 4, 5, 6, 7); }
constexpr int BM = 256, BK = 64, HALF = 128, HTB = HALF * BK * 2  , STAGE_BYTES = 8 * HTB;
DI int lds_byte(int r, int c) { const int st = (r >> 4) * 2 + (c >> 5), rr = r & 15, cc = c & 31, ob = rr * 64 + cc * 2; return st * 1024 + (ob ^ (((ob >> 9) & 1) << 5)); }
DI void stage_rc(int b, int& R, int& C) { const int st = b / 1024, sb = b % 1024, swz = sb ^ (((sb >> 9) & 1) << 5); R = (st >> 1) * 16 + swz / 64; C = (st & 1) * 32 + (swz % 64) / 2; }
DI int perm32(int rho) { const int n = rho >> 4, i = rho & 15; return 8 * (i >> 2) + 4 * n + (i & 3); }

template <bool F8> struct Frag;
template <> struct Frag<false> { bf16x8 k0, k1; DI void set(bf16x8 a, bf16x8 b) { k0 = a; k1 = b; } };
template <> struct Frag<true> { i32x8 w; DI void set(bf16x8 a, bf16x8 b) { w = cat8(a, b); } };
template <class Epi, class Sched, bool ALIGN_EPI = true>
DI void gemm_phase(LAS unsigned char* lds, const Sched& S, const Epi& E, int wid) {
    const int lane = fresh_lane(), tid = wid * 64 + lane, wr = wid >> 2, wc = wid & 3, fr = lane & 15, fq = lane >> 4;
    int RA[2], RB[2], CB[2];
#pragma unroll
    for (int i = 0; i < 2; ++i) { int R, C; stage_rc(tid * 16 + i * 8192, R, C); RA[i] = R; RB[i] = (R & ~31) + perm32(R & 31); CB[i] = C * 2; }
    constexpr size_t kstep = (size_t)(BK * 2);
    const unsigned ldsw = (unsigned)wid * 1024u;
    const int aoff = lds_byte(wr * 64 + fr, fq * 8), boff = lds_byte(wc * 32 + fr, fq * 8);
#define PG8_SA(b, h) (((b) * 2 + (h)) * HTB)
#define PG8_SB(b, h) ((4 + (b) * 2 + (h)) * HTB)
#define PG8_STAGE(bufoff, gbase, v0, v1) do { unsigned o0_ = (v0), o1_ = (v1); asm volatile("" : "+v"(o0_), "+v"(o1_)); \
        __builtin_amdgcn_global_load_lds((const unsigned*)((const char*)(gbase) + o0_), (LAS unsigned*)(lds + (bufoff) + ldsw), 16, 0, 0); \
        __builtin_amdgcn_global_load_lds((const unsigned*)((const char*)(gbase) + o1_), (LAS unsigned*)(lds + (bufoff) + ldsw + 8192), 16, 0, 0); } while (0)
#define PG8_LDA(dst, b, h) do { _Pragma("unroll") for (int m = 0; m < 4; ++m) { const bf16x8 f0_ = *(const LAS bf16x8*)(lds + PG8_SA(b, h) + aoff + m * 2048), f1_ = *(const LAS bf16x8*)(lds + PG8_SA(b, h) + aoff + m * 2048 + 1024); dst[m].set(f0_, f1_); } } while (0)
#define PG8_LDB(dst, b, h) do { _Pragma("unroll") for (int n = 0; n < 2; ++n) { const bf16x8 f0_ = *(const LAS bf16x8*)(lds + PG8_SB(b, h) + boff + n * 2048), f1_ = *(const LAS bf16x8*)(lds + PG8_SB(b, h) + boff + n * 2048 + 1024); dst[n].set(f0_, f1_); } } while (0)
#define PG8_MMA(ai, bj, At, Bt) do { __builtin_amdgcn_s_setprio(1); _Pragma("unroll") for (int m = 0; m < 4; ++m) _Pragma("unroll") for (int n = 0; n < 2; ++n) { \
        if constexpr (Epi::F8) acc[ai][bj][m][n] = __builtin_amdgcn_mfma_scale_f32_16x16x128_f8f6f4(Bt[n].w, At[m].w, acc[ai][bj][m][n], 0, 0, 0, 0x7f7f7f7f, 0, 0x7f7f7f7f); \
        else { acc[ai][bj][m][n] = __builtin_amdgcn_mfma_f32_16x16x32_bf16(Bt[n].k0, At[m].k0, acc[ai][bj][m][n], 0, 0, 0); acc[ai][bj][m][n] = __builtin_amdgcn_mfma_f32_16x16x32_bf16(Bt[n].k1, At[m].k1, acc[ai][bj][m][n], 0, 0, 0); } } \
        __builtin_amdgcn_s_setprio(0); } while (0)
#define PG8_WAIT_V(n) asm volatile("s_waitcnt vmcnt(" #n ")" ::: "memory")
#define PG8_WAIT_L(n) asm volatile("s_waitcnt lgkmcnt(" #n ")" ::: "memory")
#define PG8_BAR __builtin_amdgcn_s_barrier()
#define PG8_SCHED __builtin_amdgcn_sched_barrier(0)
    Unit cur, nxt; int ui = 0;
    if (!S.next(0, cur)) return;
    f32x4 acc[2][2][4][2];
#pragma unroll
    for (int a = 0; a < 2; ++a)
#pragma unroll
        for (int b = 0; b < 2; ++b)
#pragma unroll
            for (int m = 0; m < 4; ++m)
#pragma unroll
                for (int n = 0; n < 2; ++n) acc[a][b][m][n] = (f32x4){0.f, 0.f, 0.f, 0.f};
    Frag<Epi::F8> At[4], B0[2], B1[2];
    const char* cA = cur.A; const char* cB = cur.B;
    const unsigned ld = cur.lda;
    const unsigned plane = cur.ldb;
    const unsigned vA0 = RA[0] * ld + CB[0], vA1 = RA[1] * ld + CB[1];
    const unsigned vB0 = Sched::BK16 ? (unsigned)(CB[0] >> 4) * plane + RB[0] * 16 : RB[0] * ld + CB[0], vB1 = Sched::BK16 ? (unsigned)(CB[1] >> 4) * plane + RB[1] * 16 : RB[1] * ld + CB[1];
    const size_t hA = (size_t)HALF * ld, hB = Sched::BK16 ? (size_t)HALF * 16 : hA;
    const size_t kstepB = Sched::BK16 ? (size_t)8 * plane : kstep;
    PG8_STAGE(PG8_SB(0, 0), cB, vB0, vB1); PG8_STAGE(PG8_SB(0, 1), cB + hB, vB0, vB1); PG8_STAGE(PG8_SA(0, 0), cA, vA0, vA1); PG8_STAGE(PG8_SA(0, 1), cA + hA, vA0, vA1);
    if (wr == 1) PG8_BAR;
    PG8_WAIT_V(2); PG8_BAR;
    PG8_STAGE(PG8_SB(1, 0), cB + kstepB, vB0, vB1); PG8_STAGE(PG8_SA(1, 0), cA + kstep, vA0, vA1); PG8_STAGE(PG8_SB(1, 1), cB + hB + kstepB, vB0, vB1);
    PG8_WAIT_V(6); PG8_BAR;
    for (;;) {
        const bool has_next = S.next(ui + 1, nxt);
        const char* nA = has_next ? nxt.A : cA; const char* nB = has_next ? nxt.B : cB;
        const int nt = cur.nt;
        for (int t = 0; t < nt; t += 2) {
            const bool last = (t == nt - 2);
            const char* a1 = cA + (size_t)(t + 1) * kstep;
            const char* a2 = last ? nA : cA + (size_t)(t + 2) * kstep; const char* b2 = last ? nB : cB + (size_t)(t + 2) * kstepB;
            const char* a3 = a2 + kstep; const char* b3 = b2 + kstepB;
            PG8_LDB(B0, 0, 0); PG8_LDB(B1, 0, 1); PG8_SCHED; PG8_LDA(At, 0, 0); PG8_STAGE(PG8_SA(1, 1), a1 + hA, vA0, vA1);
            PG8_WAIT_V(8); PG8_WAIT_L(0); PG8_BAR; PG8_MMA(0, 0, At, B0); PG8_MMA(0, 1, At, B1); PG8_BAR; PG8_SCHED;
            PG8_LDA(At, 0, 1); PG8_STAGE(PG8_SB(0, 0), b2, vB0, vB1); PG8_STAGE(PG8_SB(0, 1), b2 + hB, vB0, vB1); PG8_STAGE(PG8_SA(0, 0), a2, vA0, vA1);
            PG8_WAIT_V(8); PG8_WAIT_L(0); PG8_BAR; PG8_MMA(1, 0, At, B0); PG8_MMA(1, 1, At, B1); PG8_BAR; PG8_SCHED;
            PG8_LDB(B0, 1, 0); PG8_LDB(B1, 1, 1); PG8_SCHED; PG8_LDA(At, 1, 0); PG8_STAGE(PG8_SA(0, 1), a2 + hA, vA0, vA1);
            PG8_WAIT_V(8); PG8_WAIT_L(0); PG8_BAR; PG8_MMA(0, 0, At, B0); PG8_MMA(0, 1, At, B1); PG8_BAR; PG8_SCHED;
            PG8_LDA(At, 1, 1); PG8_STAGE(PG8_SB(1, 0), b3, vB0, vB1); PG8_STAGE(PG8_SB(1, 1), b3 + hB, vB0, vB1); PG8_STAGE(PG8_SA(1, 0), a3, vA0, vA1);
            PG8_WAIT_V(8); PG8_WAIT_L(0); PG8_BAR; PG8_MMA(1, 0, At, B0); PG8_MMA(1, 1, At, B1); PG8_BAR; PG8_SCHED;
        }
        if constexpr (ALIGN_EPI) { if (wr == 0) PG8_BAR; }
        {
            const int el_ = fresh_lane(); const int fr_ = el_ & 15, fq_ = el_ >> 4;
            if constexpr (Epi::HAS_STATE) {
#pragma unroll
                for (int ai = 0; ai < 2; ++ai) { typename Epi::State st; E.begin(st, cur, ai * HALF + wr * 64 + fr_, wc * 32 + 8 * fq_);
#pragma unroll
                    for (int m = 0; m < 4; ++m) { const int row = ai * HALF + wr * 64 + m * 16 + fr_;
#pragma unroll
                        for (int bj = 0; bj < 2; ++bj) { float v[8];
#pragma unroll
                            for (int j = 0; j < 4; ++j) { v[j] = acc[ai][bj][m][0][j]; v[4 + j] = acc[ai][bj][m][1][j]; }
                            E.store_st(st, m, cur, row, bj * HALF + wc * 32 + 8 * fq_, v); } } }
            } else {
#pragma unroll
            for (int ai = 0; ai < 2; ++ai)
#pragma unroll
                for (int m = 0; m < 4; ++m) { const int row = ai * HALF + wr * 64 + m * 16 + fr_;
                    if constexpr (Epi::PAIR) { float g[8], up[8];
#pragma unroll
                        for (int j = 0; j < 4; ++j) { g[j] = acc[ai][0][m][0][j]; g[4 + j] = acc[ai][0][m][1][j]; up[j] = acc[ai][1][m][0][j]; up[4 + j] = acc[ai][1][m][1][j]; }
                        E.store2(cur, row, wc * 32 + 8 * fq_, g, up);
#ifdef PROBE_EPI2
                        asm volatile("" ::: "memory"); E.store2(cur, row, wc * 32 + 8 * fq_, g, up);
#endif
                        }
                    else {
#pragma unroll
                        for (int bj = 0; bj < 2; ++bj) { float v[8];
#pragma unroll
                            for (int j = 0; j < 4; ++j) { v[j] = acc[ai][bj][m][0][j]; v[4 + j] = acc[ai][bj][m][1][j]; }
                            E.store(cur, row, bj * HALF + wc * 32 + 8 * fq_, v); } } }
            }
        }
        if (!has_next) break;
#pragma unroll
        for (int a = 0; a < 2; ++a)
#pragma unroll
            for (int b = 0; b < 2; ++b)
#pragma unroll
                for (int m = 0; m < 4; ++m)
#pragma unroll
                    for (int n = 0; n < 2; ++n) acc[a][b][m][n] = (f32x4){0.f, 0.f, 0.f, 0.f};
        cur = nxt; cA = nA; cB = nB; ++ui;
        if constexpr (ALIGN_EPI) { if (wr == 1) PG8_BAR; }
    }
    PG8_WAIT_V(0);
    if constexpr (!ALIGN_EPI) { if (wr == 0) PG8_BAR; }
    PG8_BAR;
#undef PG8_SA
#undef PG8_SB
#undef PG8_STAGE
#undef PG8_LDA
#undef PG8_LDB
#undef PG8_MMA
#undef PG8_WAIT_V
#undef PG8_WAIT_L
#undef PG8_BAR
#undef PG8_SCHED
}
}

namespace att {
typedef short bf16x8 __attribute__((ext_vector_type(8)));
typedef short s16x4 __attribute__((ext_vector_type(4)));
typedef float f32x16 __attribute__((ext_vector_type(16)));
typedef float f32x2_t __attribute__((ext_vector_type(2)));
typedef __bf16 bf16x2_t __attribute__((ext_vector_type(2)));
DI unsigned cvtpk(float lo, float hi) { f32x2_t v = {lo, hi}; bf16x2_t b = __builtin_convertvector(v, bf16x2_t); return __builtin_bit_cast(unsigned, b); }
DI int crow(int r, int h) { return (r & 3) + 8 * (r >> 2) + 4 * h; }
DI float max3f(float a, float b, float c) { float r; asm("v_max3_f32 %0, %1, %2, %3" : "=v"(r) : "v"(a), "v"(b), "v"(c)); return r; }

template <bool SWA>
DI void attn_phase(const Params& p, int wid_, LAS unsigned char* lds, int G, int c) {
    constexpr int DK = SWA ? 64 : 192, DV = SWA ? 64 : 128, KSTR = DK * 2 + 16, VSTR = 136;
    constexpr int QB = SWA ? 2 : 1;
    constexpr int KB = 64 * KSTR, VB = DV * VSTR, STG = KB + VB;
    constexpr int CPR = DK / 8, NKC = (64 * CPR) / NTHREADS, NVC = (DV * 8) / NTHREADS, NQ = DK / 16, NDV = DV / 32;
    constexpr int LDQ = SWA ? 2048 : 1536, NUNITS = SWA ? 768 : 384;
    static_assert(2 * STG <= 131072, "attention LDS");
    const int tid = (wid_ * 64 + fresh_lane()), lane = tid & 63, wid = wid_, q = lane & 31, hh = lane >> 5;
    const bf16_t* Q = wsp<bf16_t>(p, WS_Q); const bf16_t* KN = wsp<bf16_t>(p, SWA ? WS_KO : WS_KN); const bf16_t* KPE = wsp<bf16_t>(p, WS_KPE);
    const bf16_t* VT = wsp<bf16_t>(p, SWA ? WS_VTO : WS_VT); bf16_t* MIX = wsp<bf16_t>(p, WS_MIX);
    for (int L = c; L < NUNITS; L += G) {
        int rowbase, hk, nt0, nt1, key0a, key0b = 0, kpos0 = 0, qpos0 = 0; bool masked = false;
        if (!SWA) {
            if (L < 256) { const int b = L >> 5, qt = L & 3; hk = (L >> 2) & 7; rowbase = T_CTX + b * 1024 + qt * 256; key0a = T_CTX + b * 1024; nt0 = 16; key0b = T + b * 512; nt1 = 8; }
            else { const int Lc = L - 256, b = Lc >> 3; hk = Lc & 7; rowbase = b * 256; key0a = b * 256; nt0 = 4; nt1 = 0; }
        } else {
            if (L < 512) { const int b = L >> 6, t0 = (L & 15) * 64; hk = (L >> 4) & 3; rowbase = T_CTX + b * 1024 + t0;
                const int lo = max(t0 - 128, 0) & ~63, hi = min((t0 + 192 + 63) & ~63, 1024);
                key0a = T_CTX + b * 1024 + lo; nt0 = (hi - lo) >> 6; kpos0 = lo; qpos0 = t0; masked = true; key0b = T + b * 512; nt1 = 8; }
            else { const int Lc = L - 512, b = Lc >> 4; hk = (Lc >> 2) & 3; rowbase = b * 256 + (Lc & 3) * 64; key0a = b * 256; nt0 = 4; nt1 = 0; }
        }
        const int total = nt0 + nt1;
        const int qrow0 = SWA ? rowbase + q : rowbase + wid * 32 + q;
        const int qhead = SWA ? hk * 8 + wid : hk;
        bf16x8 qf[QB][NQ];
#pragma unroll
        for (int qb = 0; qb < QB; ++qb)
#pragma unroll
            for (int s = 0; s < NQ; ++s) qf[qb][s] = *(const bf16x8*)(Q + (size_t)(qrow0 + 32 * qb) * LDQ + qhead * DK + 16 * s + 8 * hh);
        f32x16 o[QB][NDV];
#pragma unroll
        for (int qb = 0; qb < QB; ++qb)
#pragma unroll
            for (int d = 0; d < NDV; ++d)
#pragma unroll
                for (int r = 0; r < 16; ++r) o[qb][d][r] = 0.f;
        float m[QB], l[QB];
#pragma unroll
        for (int qb = 0; qb < QB; ++qb) { m[qb] = SWA ? p.in[19][qhead] * LOG2E : -1e30f; l[qb] = (SWA && hh == 0) ? 1.f : 0.f; }
        const int qpos = qpos0 + q;
        u32x4 kreg[NKC], vreg[NVC];
#define ATT_LOAD(t_) do { const int tt_ = (t_); const int kb_ = tt_ < nt0 ? key0a + tt_ * 64 : key0b + (tt_ - nt0) * 64; \
            _Pragma("unroll") for (int i = 0; i < NKC; ++i) { const int ch = tid + NTHREADS * i, j = ch / CPR, cc = ch % CPR; \
                const bf16_t* src = SWA ? KN + (size_t)(kb_ + j) * 256 + hk * 64 + cc * 8 : (cc < 16 ? KN + (size_t)(kb_ + j) * 1024 + hk * 128 + cc * 8 : KPE + (size_t)(kb_ + j) * 64 + (cc - 16) * 8); \
                kreg[i] = *(const u32x4*)src; } \
            _Pragma("unroll") for (int i = 0; i < NVC; ++i) { const int ch = tid + NTHREADS * i, dv = ch >> 3, cc = ch & 7; \
                vreg[i] = *(const u32x4*)(VT + (size_t)(hk * DV + dv) * TX + kb_ + cc * 8); } } while (0)
#define ATT_WRITE(buf_) do { LAS unsigned char* Kw = lds + (buf_) * STG; LAS unsigned char* Vw = Kw + KB; \
            _Pragma("unroll") for (int i = 0; i < NKC; ++i) { const int ch = tid + NTHREADS * i, j = ch / CPR, cc = ch % CPR; *(LAS u32x4*)(Kw + j * KSTR + cc * 16) = kreg[i]; } \
            _Pragma("unroll") for (int i = 0; i < NVC; ++i) { const int ch = tid + NTHREADS * i, dv = ch >> 3, cc = ch & 7; \
                *(LAS u32x2*)(Vw + dv * VSTR + cc * 16) = (u32x2){vreg[i].x, vreg[i].y}; *(LAS u32x2*)(Vw + dv * VSTR + cc * 16 + 8) = (u32x2){vreg[i].z, vreg[i].w}; } } while (0)
        ATT_LOAD(0); ATT_WRITE(0);
        __syncthreads();
        for (int t = 0; t < total; ++t) {
            const int buf = t & 1;
            if (t + 1 < total) ATT_LOAD(t + 1);
            const LAS unsigned char* Kl = lds + buf * STG; const LAS unsigned char* Vl = Kl + KB;
            f32x16 s0[QB], s1[QB];
#pragma unroll
            for (int qb = 0; qb < QB; ++qb)
#pragma unroll
                for (int r = 0; r < 16; ++r) { s0[qb][r] = 0.f; s1[qb][r] = 0.f; }
#pragma unroll
            for (int s = 0; s < NQ; ++s) {
                const bf16x8 a0 = *(const LAS bf16x8*)(Kl + q * KSTR + (16 * s + 8 * hh) * 2);
                const bf16x8 a1 = *(const LAS bf16x8*)(Kl + (32 + q) * KSTR + (16 * s + 8 * hh) * 2);
#pragma unroll
                for (int qb = 0; qb < QB; ++qb) { s0[qb] = __builtin_amdgcn_mfma_f32_32x32x16_bf16(a0, qf[qb][s], s0[qb], 0, 0, 0); s1[qb] = __builtin_amdgcn_mfma_f32_32x32x16_bf16(a1, qf[qb][s], s1[qb], 0, 0, 0); }
            }
            bf16x8 pb[QB][2][2];
#pragma unroll
            for (int qb = 0; qb < QB; ++qb) {
                if (SWA && masked && t < nt0) {
                    const int kp = kpos0 + t * 64 - (qpos + 32 * qb);
#pragma unroll
                    for (int r = 0; r < 16; ++r) { const int d0 = kp + crow(r, hh), d1 = d0 + 32;
                        s0[qb][r] = (d0 >= -128 && d0 <= 128) ? s0[qb][r] : -1e30f; s1[qb][r] = (d1 >= -128 && d1 <= 128) ? s1[qb][r] : -1e30f; }
                }
                float tm = fmaxf(s0[qb][0], s1[qb][0]);
#pragma unroll
                for (int r = 1; r < 16; ++r) tm = max3f(tm, s0[qb][r], s1[qb][r]);
                tm = fmaxf(tm, __shfl_xor(tm, 32));
                const float mn = fmaxf(m[qb], tm);
                if (!__all(mn == m[qb])) {
                    const float alpha = __builtin_amdgcn_exp2f(m[qb] - mn); m[qb] = mn; l[qb] *= alpha;
#pragma unroll
                    for (int d = 0; d < NDV; ++d)
#pragma unroll
                        for (int r = 0; r < 16; ++r) o[qb][d][r] *= alpha; }
                float ls = 0.f;
#pragma unroll
                for (int r = 0; r < 16; ++r) { s0[qb][r] = __builtin_amdgcn_exp2f(s0[qb][r] - m[qb]); s1[qb][r] = __builtin_amdgcn_exp2f(s1[qb][r] - m[qb]); ls += s0[qb][r] + s1[qb][r]; }
                l[qb] += ls;
#pragma unroll
                for (int s = 0; s < 2; ++s) {
                    u32x4 w0, w1;
                    w0.x = cvtpk(s0[qb][8 * s + 0], s0[qb][8 * s + 1]); w0.y = cvtpk(s0[qb][8 * s + 2], s0[qb][8 * s + 3]); w0.z = cvtpk(s0[qb][8 * s + 4], s0[qb][8 * s + 5]); w0.w = cvtpk(s0[qb][8 * s + 6], s0[qb][8 * s + 7]);
                    w1.x = cvtpk(s1[qb][8 * s + 0], s1[qb][8 * s + 1]); w1.y = cvtpk(s1[qb][8 * s + 2], s1[qb][8 * s + 3]); w1.z = cvtpk(s1[qb][8 * s + 4], s1[qb][8 * s + 5]); w1.w = cvtpk(s1[qb][8 * s + 6], s1[qb][8 * s + 7]);
                    pb[qb][0][s] = __builtin_bit_cast(bf16x8, w0); pb[qb][1][s] = __builtin_bit_cast(bf16x8, w1);
                }
            }
#pragma unroll
            for (int d = 0; d < NDV; ++d)
#pragma unroll
                for (int blk = 0; blk < 2; ++blk)
#pragma unroll
                    for (int s = 0; s < 2; ++s) {
                        const LAS unsigned char* vp = Vl + (d * 32 + q) * VSTR + (blk * 32 + 16 * s + 4 * hh) * 2;
                        const s16x4 lo = *(const LAS s16x4*)vp, hi = *(const LAS s16x4*)(vp + 16);
                        const bf16x8 a = {lo[0], lo[1], lo[2], lo[3], hi[0], hi[1], hi[2], hi[3]};
#pragma unroll
                        for (int qb = 0; qb < QB; ++qb) o[qb][d] = __builtin_amdgcn_mfma_f32_32x32x16_bf16(a, pb[qb][blk][s], o[qb][d], 0, 0, 0);
                    }
            if (t + 1 < total) ATT_WRITE(buf ^ 1);
            __syncthreads();
        }
#undef ATT_LOAD
#undef ATT_WRITE
#pragma unroll
        for (int qb = 0; qb < QB; ++qb) {
            const float inv = 1.f / (l[qb] + __shfl_xor(l[qb], 32));
            bf16_t* orow = MIX + (size_t)(qrow0 + 32 * qb) * 2048 + qhead * DV;
            unsigned char* orow8 = (unsigned char*)MIX + (size_t)(qrow0 + 32 * qb) * 2048 + qhead * DV;
#pragma unroll
            for (int d = 0; d < NDV; ++d)
#pragma unroll
                for (int g = 0; g < 4; ++g) {
                    if (OUT_F8) *(unsigned*)(orow8 + d * 32 + 8 * g + 4 * hh) = pk4_fp8(o[qb][d][4 * g] * inv, o[qb][d][4 * g + 1] * inv, o[qb][d][4 * g + 2] * inv, o[qb][d][4 * g + 3] * inv);
                    else { u32x2 w; w.x = cvtpk(o[qb][d][4 * g] * inv, o[qb][d][4 * g + 1] * inv); w.y = cvtpk(o[qb][d][4 * g + 2] * inv, o[qb][d][4 * g + 3] * inv); *(u32x2*)(orow + d * 32 + 8 * g + 4 * hh) = w; } }
        }
    }
}
}


#ifndef R_PRO
#define R_PRO 1
#endif
#ifndef R_MOE
#define R_MOE 1
#endif
#ifndef R_ATT
#define R_ATT 1
#endif
#ifndef R_ATTM
#define R_ATTM R_ATT
#endif
#ifndef R_ATTS
#define R_ATTS R_ATT
#endif
#ifndef R_GEMM
#define R_GEMM 1
#endif
#ifndef R_THIN
#define R_THIN 1
#endif
#ifndef R_LN1
#define R_LN1 1
#endif
#ifndef R_LN2
#define R_LN2 1
#endif
#ifndef R_TOPK
#define R_TOPK 1
#endif
#define REP(n) for (int _r = 0; _r < (n); ++_r)
#define REPS(n, ...) do { { __VA_ARGS__ } if ((n) > 1) { __VA_ARGS__ } } while (0)
constexpr int LDS_BYTES = 147456, MISC_OFF = 146432;
constexpr int NPH = 20;
#ifndef CVT_WAVES
#define CVT_WAVES 4
#endif
#ifndef ATT_SPLIT
#define ATT_SPLIT 1
#endif
#ifndef AS_I2
#define AS_I2 10240
#endif
#ifndef AS_I6
#define AS_I6 6144
#endif
#ifndef AS_I14
#define AS_I14 4096
#endif
#ifndef BG_MODE
#define BG_MODE 0
#endif
#ifndef BG_SPLIT
#define BG_SPLIT 32768
#endif
#ifndef CVT_IDLE_WAVES
#define CVT_IDLE_WAVES 8
#endif
#ifndef CV_IDLE2
#define CV_IDLE2 10240
#endif
#ifndef CV_IDLE6
#define CV_IDLE6 10240
#endif
constexpr int CV_I2 = CV_IDLE2, CV_I6 = CV_IDLE6, CV_IALL = CV_I2 + 2 * CV_I6;
__global__ void __launch_bounds__(NTHREADS, 2) mega(Params p) {
    extern __shared__ __attribute__((aligned(16))) unsigned char lds[];
    const int G = gridDim.x, c = vcu_of(blockIdx.x, G), wid = __builtin_amdgcn_readfirstlane(threadIdx.x >> 6);
    volatile LAS unsigned* MISC = (volatile LAS unsigned*)((LAS unsigned char*)lds + MISC_OFF);
    if (threadIdx.x < 4) MISC[threadIdx.x] = 0u;
    __syncthreads();
    XcdBarrier bar = xcd_barrier_post((unsigned*)(p.ws + WS_CTL) + CW_BAR, MISC);
    const int lo = p.ph_lo, hi = p.ph_hi;
#define IN(k) (lo <= (k) && (k) < hi)
#ifdef STAMP_A
#define stamps_ (wsp<unsigned long long>(p, WS_DBG + 65536))
#define STAMP(k) do { if (blockIdx.x == 0 && wid == 0 && fresh_lane() == 0) stamps_[k] = __builtin_amdgcn_s_memrealtime(); } while (0)
#else
#define STAMP(k) do { } while (0)
#endif
    STAMP(0); STAMP(23);
#ifndef R_BAR
#define R_BAR 1
#endif
#define SEAM(k) do { if (IN(k) && IN((k) + 1)) { xcd_barrier(bar); if (R_BAR > 1) xcd_barrier(bar); } STAMP((k) + 1); } while (0)
    if (IN(0)) REP(R_PRO) { ph_mod(p, wid, lds); STAMP(21); ph_misc(p, wid); STAMP(22); ph_convert(p, wid, 0, G == 256 ? (ATT_SPLIT ? CV_TOTAL - CV_MOE : CV_TOTAL - CV_IALL) : CV_TOTAL, blockIdx.x, G, CVT_WAVES);
#ifdef RD_PAT
        ph_readonly<RD_PAT>(p, wid);
#endif
    } SEAM(0);
    if (IN(1)) REP(R_THIN) { ph_modreduce(p, wid); ph_h0(p, wid, lds); } SEAM(1);
    if (IN(2)) { REPS(R_GEMM, SchedInEven S{&p, G, c}; EpiInEven E{&p}; pg8::gemm_phase((LAS unsigned char*)lds, S, E, wid);); if (G == 256 && c >= 128) { if (ATT_SPLIT) ph_convert(p, wid, CV_TOTAL - CV_MOE, CV_TOTAL - CV_MOE + AS_I2, c - 128, 128, CVT_IDLE_WAVES); else ph_convert(p, wid, CV_TOTAL - CV_IALL, CV_TOTAL - 2 * CV_I6, c - 128, 128, CVT_IDLE_WAVES); } } SEAM(2);
    if (IN(3)) REP(R_THIN) { ph_e1(p, wid); } SEAM(3);
    #ifndef E2_ALIGN
#define E2_ALIGN true
#endif
    if (IN(4)) REPS(R_GEMM, SchedE2 S{&p, G, c}; EpiE2 E{&p}; pg8::gemm_phase<EpiE2, SchedE2, E2_ALIGN>((LAS unsigned char*)lds, S, E, wid);); SEAM(4);
    const bool asp = ATT_SPLIT && G == 256, ascv = asp && (c & 31) >= 16;
    const int aG = asp ? 128 : G, ac = asp ? (c >> 5) * 16 + (c & 15) : c, ccv = (c >> 5) * 16 + (c & 15);
    if (IN(5)) { if (ascv) ph_convert(p, wid, CV_TOTAL - CV_MOE + AS_I2, CV_TOTAL - CV_MOE / 2, ccv, 128, 8); else REP(R_ATTM) { att::attn_phase<false>(p, wid, (LAS unsigned char*)lds, aG, ac); } } SEAM(5);
    if (IN(6)) { REPS(R_GEMM, SchedOut S{&p, G, c, 0}; EpiOut E{&p, 0}; pg8::gemm_phase((LAS unsigned char*)lds, S, E, wid);); if (G == 256 && c >= 128) { if (ATT_SPLIT) ph_convert(p, wid, CV_TOTAL - CV_MOE / 2, CV_TOTAL - CV_MOE / 2 + AS_I6, c - 128, 128, CVT_IDLE_WAVES); else ph_convert(p, wid, CV_TOTAL - 2 * CV_I6, CV_TOTAL - CV_I6, c - 128, 128, CVT_IDLE_WAVES); } } SEAM(6);
    if (IN(7)) REP(R_LN1) { ph_ln1(p, wid, 0, lds); } SEAM(7);
    if (IN(8)) REP(R_TOPK) { ph_topk(p, wid, lds); } SEAM(8);
    {
        const bool bgm = BG_MODE && G == 256, isbg = bgm && (c & 31) >= 24;
        const int fG = bgm ? 192 : G, fc = bgm ? (c >> 5) * 24 + (c & 31) : c, bgi = (c >> 5) * 8 + (c & 31) - 24;
        if (IN(9)) { if (isbg) ph_convert_moe_bg(p, wid, CV_MOE / 2, CV_MOE / 2 + BG_SPLIT, bgi, 64, 8); else REPS(R_MOE, SchedGU S{&p, fG, fc, 0}; EpiGU E{&p}; pg8::gemm_phase((LAS unsigned char*)lds, S, E, wid);); } SEAM(9);
        if (IN(10)) { if (isbg) ph_convert_moe_bg(p, wid, CV_MOE / 2 + BG_SPLIT, CV_MOE, bgi, 64, 8); else REPS(R_MOE, SchedDown S{&p, fG, fc, 0}; EpiDown E{&p}; pg8::gemm_phase((LAS unsigned char*)lds, S, E, wid);); } SEAM(10);
    }
    if (IN(11)) REP(R_LN2) { ph_ln2(p, wid, 0, lds); } SEAM(11);
    if (IN(12)) REPS(R_GEMM, SchedInOdd S{&p, G, c}; EpiInOdd E{&p}; pg8::gemm_phase((LAS unsigned char*)lds, S, E, wid);); SEAM(12);
    if (IN(13)) { if (ascv) ph_convert(p, wid, CV_TOTAL - CV_MOE / 2 + AS_I6, CV_TOTAL - AS_I14, ccv, 128, 8); else REP(R_ATTS) { att::attn_phase<true>(p, wid, (LAS unsigned char*)lds, aG, ac); } } SEAM(13);
    if (IN(14)) { REPS(R_GEMM, SchedOut S{&p, G, c, 1}; EpiOut E{&p, 1}; pg8::gemm_phase((LAS unsigned char*)lds, S, E, wid);); if (G == 256 && c >= 128) { if (ATT_SPLIT) ph_convert(p, wid, CV_TOTAL - AS_I14, CV_TOTAL, c - 128, 128, CVT_IDLE_WAVES); else ph_convert(p, wid, CV_TOTAL - CV_I6, CV_TOTAL, c - 128, 128, CVT_IDLE_WAVES); } } SEAM(14);
    if (IN(15)) REP(R_LN1) { ph_ln1(p, wid, 1, lds); } SEAM(15);
    if (IN(16)) REP(R_TOPK) { ph_topk(p, wid, lds); } SEAM(16);
    if (IN(17)) REPS(R_MOE, SchedGU S{&p, G, c, 1}; EpiGU E{&p}; pg8::gemm_phase((LAS unsigned char*)lds, S, E, wid);); SEAM(17);
    if (IN(18)) REPS(R_MOE, SchedDown S{&p, G, c, 1}; EpiDown E{&p}; pg8::gemm_phase((LAS unsigned char*)lds, S, E, wid);); SEAM(18);
    if (IN(19)) REP(R_LN2) { ph_ln2(p, wid, 1, lds); }
#ifdef STAMP_A
    STAMP(20);
    if (blockIdx.x == 0 && wid == 0 && fresh_lane() == 0) {
        asm volatile("s_waitcnt vmcnt(0)" ::: "memory");
        const unsigned long long d = (__hip_atomic_load(&stamps_[STAMP_B], __ATOMIC_RELAXED, __HIP_MEMORY_SCOPE_AGENT) - __hip_atomic_load(&stamps_[STAMP_A], __ATOMIC_RELAXED, __HIP_MEMORY_SCOPE_AGENT)) * 4ull;
        const unsigned long long t0 = __builtin_amdgcn_s_memrealtime();
        while (__builtin_amdgcn_s_memrealtime() - t0 < d) __builtin_amdgcn_s_sleep(8);
    }
#endif
#undef IN
#undef SEAM
}

extern "C" void kernel_launch(void* const* d_in, const int* in_sizes, int n_in, void* d_out, int out_size, void* d_ws, size_t ws_size, hipStream_t stream) {
    static int grid = 0;
    if (grid == 0) {
        if (n_in != 29 || out_size != (int)O_END || ws_size < WS_END) { fprintf(stderr, "kernel_launch: unexpected shapes (n_in %d out %d ws %zu need %zu)\n", n_in, out_size, ws_size, (size_t)WS_END); grid = -1; return; }
        int dev = 0, cus = 0, per_cu = 0;
        if (hipGetDevice(&dev) != hipSuccess || hipDeviceGetAttribute(&cus, hipDeviceAttributeMultiprocessorCount, dev) != hipSuccess) { grid = -1; return; }
        if (hipFuncSetAttribute((const void*)mega, hipFuncAttributeMaxDynamicSharedMemorySize, LDS_BYTES) != hipSuccess) { fprintf(stderr, "hipFuncSetAttribute failed\n"); grid = -1; return; }
        if (hipOccupancyMaxActiveBlocksPerMultiprocessor(&per_cu, (const void*)mega, NTHREADS, LDS_BYTES) != hipSuccess || per_cu < 1) fprintf(stderr, "occupancy query: %d\n", per_cu);
        (void)hipGetLastError();
        grid = cus > 0 ? cus : 256;
    }
    if (grid < 0) return;
    Params p{};
    for (int i = 0; i < 29; ++i) p.in[i] = (const float*)d_in[i];
    p.out = (float*)d_out; p.ws = (unsigned char*)d_ws; p.ph_lo = 0; p.ph_hi = NPH; p.rpb = (T + grid - 1) / grid; p.pad = 0;
    (void)hipMemsetAsync((char*)d_ws + WS_CTL, 0, 32768, stream);
    hipLaunchKernelGGL(mega, dim3(grid), dim3(NTHREADS), LDS_BYTES, stream, p);
}
```

```cpp
#include <hip/hip_runtime.h>
#include <cstdio>
#include <cstdint>

constexpr int D = 2048, T_CTX = 4096, T = 12288, TC = 4096, TX = 16384;
constexpr int MODW = 12288, NCOND = 9;
constexpr int NSLOT = 1536, NXS = 16 * NSLOT;
constexpr float DN_ALPHA = 1.41421356237309515f;
constexpr float LOG2E = 1.44269504088896341f;
constexpr float QS_MLA = 0.07216878364870322f * LOG2E;
constexpr float QS_SWA = 0.125f * LOG2E;
constexpr int NTHREADS = 512, NWAVES = 8;
#ifndef MOE_F8
#define MOE_F8 1
#endif
#ifndef OUT_F8
#define OUT_F8 1
#endif
constexpr float GU_WSCALE = 32.f, DN_WSCALE = 64.f, OUT_WSCALE = 64.f;
#ifndef YE_F8
#define YE_F8 1
#endif
constexpr float YE_SCALE = 8.f;

constexpr size_t O_Y = 0, O_CKV = 25165824, O_KPE = 26214400, O_SK = 26476544, O_SV = 27525120, O_END = 28573696;

constexpr size_t al256(size_t x) { return (x + 255) & ~(size_t)255; }
constexpr size_t WS_CTL = 0, CTL_BYTES = 1u << 20;
constexpr size_t WS_MOD = WS_CTL + CTL_BYTES;
constexpr size_t WS_ROPE = WS_MOD + al256((size_t)2 * 9 * 12288 * 4);
constexpr size_t WS_WINE = WS_ROPE + al256((size_t)2 * 1024 * 32 * 4);
constexpr size_t WS_W2 = WS_WINE + (size_t)2048 * 2048 * 2;
constexpr size_t WS_WOUTE = WS_W2 + (size_t)4608 * 1792 * 2;
constexpr size_t WS_WINO = WS_WOUTE + (size_t)2048 * 2048 * 2;
constexpr size_t WS_WOUTO = WS_WINO + (size_t)2560 * 2048 * 2;
constexpr size_t WS_WGU = WS_WOUTO + (size_t)2048 * 2048 * 2;
constexpr size_t WS_WDN = WS_WGU + (size_t)32 * 4096 * 2048 * 2;
constexpr size_t WS_H = WS_WDN + (size_t)32 * 2048 * 2048 * 2;
constexpr size_t WS_PJ = WS_H + (size_t)T * 2048 * 2;
constexpr size_t WS_PJB = WS_PJ + (size_t)T * 256 * 4;
constexpr size_t WS_ACT2 = WS_PJ + (size_t)T * 1792 * 4;
constexpr size_t WS_KPE = WS_ACT2 + (size_t)TX * 1792 * 2;
constexpr size_t WS_Q = WS_KPE + (size_t)TX * 64 * 2;
constexpr size_t WS_KN = WS_Q + (size_t)T * 2048 * 2;
constexpr size_t WS_VT = WS_KN + (size_t)TX * 1024 * 2;
constexpr size_t WS_VTO = WS_VT + (size_t)1024 * TX * 2;
constexpr size_t WS_KO = WS_VTO + (size_t)256 * TX * 2;
constexpr size_t WS_MIX = WS_KO + (size_t)TX * 256 * 2;
constexpr size_t WS_Y = WS_MIX + (size_t)T * 2048 * 2;
constexpr size_t WS_X1 = WS_Y + (size_t)T * 2048 * 4;
constexpr size_t WS_XL = WS_X1 + (size_t)T * 2048 * 4;
constexpr size_t WS_AFF = WS_XL + (size_t)T * 2048 * 4;
constexpr size_t WS_INV = WS_AFF + (size_t)T * 16 * 4;
constexpr size_t WS_XS = WS_INV + (size_t)T * 16 * 4;
constexpr size_t WS_HID = WS_XS + (size_t)NXS * 2048 * 2;
constexpr size_t WS_YE = WS_HID + (size_t)NXS * 2048 * 2;
constexpr size_t WS_AFFT = WS_YE + (size_t)NXS * 2048 * 2;
constexpr size_t WS_H8 = WS_AFFT + (size_t)T * 16 * 4;
constexpr size_t WS_STAT = WS_H8 + (size_t)T * 2048;
constexpr size_t WS_MODP = WS_STAT + (size_t)T * 8;
constexpr size_t WS_GB = WS_MODP + (size_t)4 * 2 * 9 * 12288 * 4;
constexpr size_t WS_DBG = WS_GB + (size_t)2 * 9 * 2 * 2048 * 4;
constexpr size_t WS_END = WS_DBG + (1u << 20);

typedef unsigned short bf16_t;
typedef float f32x4 __attribute__((ext_vector_type(4)));
typedef unsigned u32x4 __attribute__((ext_vector_type(4)));
typedef unsigned u32x2 __attribute__((ext_vector_type(2)));
typedef float f32x2 __attribute__((ext_vector_type(2)));
#define LAS __attribute__((address_space(3)))
#define DI __device__ __forceinline__

struct Params {
    const float* in[29];
    float* out;
    unsigned char* ws;
    int ph_lo, ph_hi;
    int rpb, pad;
};

DI unsigned f2bf(float f) { unsigned u = __float_as_uint(f); return (u + 0x7fffu + ((u >> 16) & 1u)) >> 16; }
typedef __bf16 bf16x2_hw __attribute__((ext_vector_type(2)));
DI unsigned pk2(float lo, float hi) { f32x2 v = {lo, hi}; bf16x2_hw b = __builtin_convertvector(v, bf16x2_hw); return __builtin_bit_cast(unsigned, b); }
DI unsigned pk4_fp8(float a, float b, float c, float d) { unsigned w = 0; w = __builtin_amdgcn_cvt_pk_fp8_f32(a, b, w, false); w = __builtin_amdgcn_cvt_pk_fp8_f32(c, d, w, true); return w; }
DI float bf2f(unsigned b) { return __uint_as_float(b << 16); }
DI float bflo(unsigned w) { return __uint_as_float(w << 16); }
DI float bfhi(unsigned w) { return __uint_as_float(w & 0xffff0000u); }
DI float wave_sum(float v) {
#pragma unroll
    for (int o = 1; o < 64; o <<= 1) v += __shfl_xor(v, o);
    return v;
}
DI float wave_max(float v) {
#pragma unroll
    for (int o = 1; o < 64; o <<= 1) v = fmaxf(v, __shfl_xor(v, o));
    return v;
}
DI int fresh_lane() { int l = (int)__builtin_amdgcn_mbcnt_hi(~0u, __builtin_amdgcn_mbcnt_lo(~0u, 0u)); asm volatile("" : "+v"(l)); return l; }
DI int cond_of_row(int r) { return r < T_CTX ? 0 : 1 + ((r - T_CTX) >> 10); }
DI const float* xrow_in(const Params& p, int r) { return r < T_CTX ? p.in[0] + (size_t)r * D : p.in[1] + (size_t)(r - T_CTX) * D; }

DI float* ws_mod(const Params& p) { return (float*)(p.ws + WS_MOD); }
DI float* ws_cos(const Params& p) { return (float*)(p.ws + WS_ROPE); }
DI float* ws_sin(const Params& p) { return (float*)(p.ws + WS_ROPE) + 1024 * 32; }
template <class X> DI X* wsp(const Params& p, size_t off) { return (X*)(p.ws + off); }
DI const float* modp(const Params& p, int l, int ci, int j) { return ws_mod(p) + ((size_t)(l * 9 + ci) * MODW + (size_t)j * D); }

#define XB_TMO      128
#define XB_XCNT(j)  (256  + 64 * (j))
#define XB_XSUB(j)  (1280 + 64 * (j))
#define XB_XGEN(j)  (2304 + 64 * (j))
#define XB_TOP      3328
#define XB_TOPGEN   3392
#define XCD_BAR_WORDS 3456
#define XB_SPIN_CAP (1u << 18)

__device__ __forceinline__ unsigned xb_ld(unsigned* p)              { return __hip_atomic_load(p, __ATOMIC_RELAXED, __HIP_MEMORY_SCOPE_AGENT); }
__device__ __forceinline__ unsigned xb_add(unsigned* p, unsigned v) { return __hip_atomic_fetch_add(p, v, __ATOMIC_RELAXED, __HIP_MEMORY_SCOPE_AGENT); }
__device__ __forceinline__ unsigned xb_xcc_id() { return (unsigned)__builtin_amdgcn_s_getreg((3 << 11) | 20) & 0xFu; }
#define XB_SPIN(cond, bar) do { unsigned _sp = 0; while (cond) { __builtin_amdgcn_s_sleep(1); \
    if ((++_sp & 255u) == 0u) { if (xb_ld(&(bar)[XB_TMO])) break; if (_sp > XB_SPIN_CAP) { atomicAdd(&(bar)[XB_TMO], 1u); break; } } } } while (0)

struct XcdBarrier {
    unsigned* bar; unsigned x;
    volatile LAS unsigned* st;
};

__device__ __forceinline__ XcdBarrier xcd_barrier_post(unsigned* bar, volatile LAS unsigned* st) {
    XcdBarrier b; b.bar = bar; b.x = xb_xcc_id(); b.st = st;
    if (threadIdx.x == 0) (void)xb_add(&bar[XB_XCNT(b.x)], 1u);
    return b;
}
__device__ __forceinline__ void xcd_barrier_complete(unsigned* bar, unsigned x, unsigned& nloc, unsigned& nx) {
    const unsigned G = gridDim.x * gridDim.y * gridDim.z;
    unsigned sum, cnt, mine, sp = 0u;
    for (;;) {
        sum = 0u; cnt = 0u; mine = 0u;
#pragma unroll
        for (unsigned j = 0; j < 16; ++j) { const unsigned c = xb_ld(&bar[XB_XCNT(j)]); sum += c; cnt += (c > 0u) ? 1u : 0u; mine = (j == x) ? c : mine; }
        if (sum == G) break;
        __builtin_amdgcn_s_sleep(1);
        if ((++sp & 255u) == 0u) { if (xb_ld(&bar[XB_TMO])) break; if (sp > XB_SPIN_CAP) { atomicAdd(&bar[XB_TMO], 1u); break; } }
    }
    nloc = mine > 0u ? mine : 1u; nx = cnt > 0u ? cnt : 1u;
}

__device__ __forceinline__ void xcd_barrier(const XcdBarrier& b) {
    asm volatile("s_waitcnt vmcnt(0)" ::: "memory");
    __syncthreads();
    if (threadIdx.x == 0) {
        unsigned* bar = b.bar;
        __builtin_amdgcn_s_waitcnt(0);
        unsigned nloc = b.st[0], nx = b.st[1];
        if (nloc == 0u) { xcd_barrier_complete(bar, b.x, nloc, nx); b.st[0] = nloc; b.st[1] = nx; }
        const unsigned old = xb_add(&bar[XB_XSUB(b.x)], 1u);
        const unsigned gen = old / nloc;
        if (old + 1u == (gen + 1u) * nloc) {
            __builtin_amdgcn_fence(__ATOMIC_RELEASE, "agent");
            asm volatile("s_waitcnt vmcnt(0)" ::: "memory");
            const unsigned og = xb_add(&bar[XB_TOP], 1u);
            const unsigned tg = og / nx;
            if (og + 1u == (tg + 1u) * nx) xb_add(&bar[XB_TOPGEN], 1u);
            else XB_SPIN(xb_ld(&bar[XB_TOPGEN]) == tg, bar);
            __builtin_amdgcn_fence(__ATOMIC_ACQUIRE, "agent");
            xb_add(&bar[XB_XGEN(b.x)], 1u);
            asm volatile("s_waitcnt vmcnt(0)" ::: "memory");
        } else {
            XB_SPIN(xb_ld(&bar[XB_XGEN(b.x)]) == gen, bar);
            __builtin_amdgcn_fence(__ATOMIC_ACQUIRE, "agent");
            asm volatile("s_waitcnt vmcnt(0)" ::: "memory");
        }
    }
    __syncthreads();
}
constexpr int CW_BAR = 4096;


DI void ph_mod(const Params& p, int wid_, unsigned char* lds_raw) {
    float* s_q = (float*)lds_raw;
    float* red = s_q + 9 * 512;
    const int tid = (wid_ * 64 + fresh_lane()), lane = tid & 63, wave = wid_;
    const float* c = p.in[6]; const float* c_ctx = p.in[7]; const float* w_ada = p.in[8];
    float* MODP = wsp<float>(p, WS_MODP);
    for (int it = blockIdx.x; it < 384; it += gridDim.x) {
        const int l = it / 192, rem = it % 192, cg = rem >> 2, kq4 = rem & 3;
        for (int i = tid; i < 9 * 512; i += NTHREADS) { const int ci = i >> 9, k = kq4 * 512 + (i & 511); const float v = ci == 0 ? c_ctx[k] : c[(ci - 1) * 2048 + k]; s_q[i] = v / (1.f + expf(-v)); }
        __syncthreads();
        const float* w = w_ada + ((size_t)l * 2048 + kq4 * 512 + wave * 64) * MODW + cg * 256 + 4 * lane;
        float acc[9][4];
#pragma unroll
        for (int ci = 0; ci < 9; ++ci)
#pragma unroll
            for (int j = 0; j < 4; ++j) acc[ci][j] = 0.f;
#pragma unroll 8
        for (int kk = 0; kk < 64; ++kk) {
            const f32x4 wv = __builtin_nontemporal_load((const f32x4*)(w + (size_t)kk * MODW));
#pragma unroll
            for (int ci = 0; ci < 9; ++ci) { const float s = s_q[ci * 512 + wave * 64 + kk];
#pragma unroll
                for (int j = 0; j < 4; ++j) acc[ci][j] += s * wv[j]; }
        }
#pragma unroll
        for (int ci = 0; ci < 9; ++ci) *(f32x4*)(red + (wave * 9 + ci) * 256 + 4 * lane) = (f32x4){acc[ci][0], acc[ci][1], acc[ci][2], acc[ci][3]};
        __syncthreads();
        for (int o = tid; o < 9 * 256; o += NTHREADS) { const int ci = o >> 8, cc = o & 255; float s = 0.f;
#pragma unroll
            for (int w8 = 0; w8 < 8; ++w8) s += red[(w8 * 9 + ci) * 256 + cc];
            MODP[((size_t)(kq4 * 2 + l) * 9 + ci) * MODW + cg * 256 + cc] = s; }
        __syncthreads();
    }
}
DI void ph_modreduce(const Params& p, int wid_) {
    const float* MODP = wsp<float>(p, WS_MODP); float* MOD = ws_mod(p); const float* b_ada = p.in[9];
    const int n4 = 2 * 9 * MODW / 4;
    for (int i = blockIdx.x * NTHREADS + (wid_ * 64 + fresh_lane()); i < n4; i += gridDim.x * NTHREADS) { const int e = i * 4, l = e / (9 * MODW), col = e % MODW;
        f32x4 s = *(const f32x4*)(b_ada + l * MODW + col);
#pragma unroll
        for (int q = 0; q < 4; ++q) s += *(const f32x4*)(MODP + (size_t)q * 2 * 9 * MODW + e);
        *(f32x4*)(MOD + e) = s; }
}
DI f32x4 mod_from_partials(const Params& p, int l, int ci, int j, int col) {
    const float* MODP = wsp<float>(p, WS_MODP); const size_t e = (size_t)(l * 9 + ci) * MODW + (size_t)j * D + col;
    f32x4 s = *(const f32x4*)(p.in[9] + l * MODW + j * D + col);
#pragma unroll
    for (int q = 0; q < 4; ++q) s += *(const f32x4*)(MODP + (size_t)q * 2 * 9 * MODW + e);
    return s;
}

constexpr int CV_INE = 928, CV_UQ = 192, CV_UKV = 128, CV_POOL = 64, CV_OUT = 1024, CV_INO = 1280, CV_MOE = 98304;
constexpr int CV_TOTAL = CV_INE + CV_UQ + CV_UKV + CV_POOL + CV_OUT + CV_INO + CV_OUT + CV_MOE;
DI void cvt_f8_item(const float* src, int N, unsigned char* dst, int nrows, int w, int lane, float scale, int gu_kind) {
    const int nb8 = w & 7, kb16 = w >> 3, n4 = nb8 * 256 + 4 * lane;
    const float* s = src + (size_t)(kb16 * 16) * N + n4;
    f32x4 v[16];
#pragma unroll
    for (int k = 0; k < 16; ++k) v[k] = __builtin_nontemporal_load((const f32x4*)(s + (size_t)k * N));
    const int dr = gu_kind < 0 ? n4 : (n4 >> 7) * 256 + (n4 & 127) + gu_kind * 128;
    u32x4* d = (u32x4*)(dst + ((size_t)kb16 * nrows + dr) * 16);
#pragma unroll
    for (int j = 0; j < 4; ++j) { u32x4 o;
        o.x = pk4_fp8(v[0][j] * scale, v[1][j] * scale, v[2][j] * scale, v[3][j] * scale); o.y = pk4_fp8(v[4][j] * scale, v[5][j] * scale, v[6][j] * scale, v[7][j] * scale);
        o.z = pk4_fp8(v[8][j] * scale, v[9][j] * scale, v[10][j] * scale, v[11][j] * scale); o.w = pk4_fp8(v[12][j] * scale, v[13][j] * scale, v[14][j] * scale, v[15][j] * scale);
        d[j] = o; }
}
DI void cvt_item(const Params& p, int item, int lane) {
    const float* src; bf16_t* dst; int K, N, ldd, nb, kb, map = 0, a = 0;
    if (item < CV_INE) { src = p.in[10]; dst = wsp<bf16_t>(p, WS_WINE); K = 2048; N = 1856; ldd = 2048; nb = item % 29; kb = item / 29; map = 1; }
    else if ((item -= CV_INE) < CV_UQ) { src = p.in[13]; dst = wsp<bf16_t>(p, WS_W2); K = 512; N = 1536; ldd = 1792; nb = item % 24; kb = item / 24; }
    else if ((item -= CV_UQ) < CV_UKV) { src = p.in[14]; dst = wsp<bf16_t>(p, WS_W2); K = 256; N = 2048; ldd = 1792; nb = item % 32; kb = item / 32; map = 2; }
    else if ((item -= CV_UKV) < CV_POOL) { const int g = item >> 4, r = item & 15; src = p.in[15] + (size_t)g * 65536; dst = wsp<bf16_t>(p, WS_W2); K = 256; N = 256; ldd = 1792; nb = r & 3; kb = r >> 2; a = 3584 + g * 256; }
    else if ((item -= CV_POOL) < CV_OUT) { if (OUT_F8) { cvt_f8_item(p.in[17], 2048, wsp<unsigned char>(p, WS_WOUTE), 2048, item, lane, OUT_WSCALE, -1); return; } src = p.in[17]; dst = wsp<bf16_t>(p, WS_WOUTE); K = 2048; N = 2048; ldd = 2048; nb = item & 31; kb = item >> 5; }
    else if ((item -= CV_OUT) < CV_INO) { src = p.in[18]; dst = wsp<bf16_t>(p, WS_WINO); K = 2048; N = 2560; ldd = 2048; nb = item % 40; kb = item / 40; }
    else if ((item -= CV_INO) < CV_OUT) { if (OUT_F8) { cvt_f8_item(p.in[20], 2048, wsp<unsigned char>(p, WS_WOUTO), 2048, item, lane, OUT_WSCALE, -1); return; } src = p.in[20]; dst = wsp<bf16_t>(p, WS_WOUTO); K = 2048; N = 2048; ldd = 2048; nb = item & 31; kb = item >> 5; }
    else { item -= CV_OUT; const int mat = item >> 10, w = item & 1023, le = mat / 3, kind = mat % 3; K = 2048; N = 2048; ldd = 2048; nb = w & 31; kb = w >> 5;
        src = p.in[24 + kind] + (size_t)le * 2048 * 2048;
        if (MOE_F8) { if (kind == 2) cvt_f8_item(src, 2048, wsp<unsigned char>(p, WS_WDN) + (size_t)le * 2048 * 2048, 2048, w, lane, DN_WSCALE, -1);
            else cvt_f8_item(src, 2048, wsp<unsigned char>(p, WS_WGU) + (size_t)le * 4096 * 2048, 4096, w, lane, GU_WSCALE, kind); return; }
        if (kind == 2) dst = wsp<bf16_t>(p, WS_WDN) + (size_t)le * 2048 * 2048; else { dst = wsp<bf16_t>(p, WS_WGU) + (size_t)le * 4096 * 2048; map = 3; a = kind * 128; } }
    const int n = nb * 64 + lane;
    const float* s = src + (size_t)(kb * 64) * N + n;
    float v[64];
#pragma unroll
    for (int k = 0; k < 64; ++k) v[k] = __builtin_nontemporal_load(s + (size_t)k * N);
    int drow;
    if (map == 0) drow = n + a;
    else if (map == 1) drow = n < 768 ? n : (n < 832 ? 1792 + (n - 768) : 768 + (n - 832));
    else if (map == 2) { const int h = n >> 8, j = n & 255; drow = j < 128 ? 1536 + h * 128 + j : 2560 + h * 128 + (j - 128); }
    else drow = (n >> 7) * 256 + (n & 127) + a;
    u32x4* d = (u32x4*)(dst + (size_t)drow * ldd + kb * 64);
#pragma unroll
    for (int c8 = 0; c8 < 8; ++c8) { u32x4 o; o.x = pk2(v[8 * c8], v[8 * c8 + 1]); o.y = pk2(v[8 * c8 + 2], v[8 * c8 + 3]); o.z = pk2(v[8 * c8 + 4], v[8 * c8 + 5]); o.w = pk2(v[8 * c8 + 6], v[8 * c8 + 7]); d[c8] = o; }
}
DI void ph_convert(const Params& p, int wid_, int item_lo, int item_hi, int bid, int nblk, int nwv) {
    const int wv_ = wid_; if (wv_ >= nwv) return;
    const int lane = (wid_ * 64 + fresh_lane()) & 63, gw = bid * nwv + wv_, NGW = nblk * nwv;
    for (int it = item_lo + gw; it < item_hi; it += NGW) cvt_item(p, it, lane);
}

#ifndef DYN_CH
#define DYN_CH 4
#endif
DI void ph_convert_dyn(const Params& p, int wid_, int item_lo, int item_hi, unsigned* ctr, int nwv) {
    if (wid_ >= nwv) return;
    const int lane = fresh_lane();
    unsigned nxt = 0u; if (lane == 0) nxt = __hip_atomic_fetch_add(ctr, (unsigned)DYN_CH, __ATOMIC_RELAXED, __HIP_MEMORY_SCOPE_AGENT); nxt = __builtin_amdgcn_readfirstlane(nxt);
    for (;;) {
        const int i0 = item_lo + (int)nxt; if (i0 >= item_hi) break;
        nxt = 0u; if (lane == 0) nxt = __hip_atomic_fetch_add(ctr, (unsigned)DYN_CH, __ATOMIC_RELAXED, __HIP_MEMORY_SCOPE_AGENT);
        const int i1 = min(i0 + DYN_CH, item_hi);
        for (int it = i0; it < i1; ++it) cvt_item(p, it, lane);
        nxt = __builtin_amdgcn_readfirstlane(nxt);
    }
}

DI void moe_f8_addr(const Params& p, int item, int lane, const float*& s, u32x4*& d, float& scale) {
    const int mat = item >> 10, w = item & 1023, le = mat / 3, kind = mat % 3, nb8 = w & 7, kb16 = w >> 3, n4 = nb8 * 256 + 4 * lane;
    s = p.in[24 + kind] + (size_t)le * 2048 * 2048 + (size_t)(kb16 * 16) * 2048 + n4;
    const int nrows = kind == 2 ? 2048 : 4096, dr = kind == 2 ? n4 : (n4 >> 7) * 256 + (n4 & 127) + kind * 128;
    unsigned char* base = kind == 2 ? wsp<unsigned char>(p, WS_WDN) + (size_t)le * 2048 * 2048 : wsp<unsigned char>(p, WS_WGU) + (size_t)le * 4096 * 2048;
    d = (u32x4*)(base + ((size_t)kb16 * nrows + dr) * 16); scale = kind == 2 ? DN_WSCALE : GU_WSCALE;
}
DI void ph_convert_moe_bg(const Params& p, int wid_, int moe_lo, int moe_hi, int bid, int nblk, int nwv) {
    if (wid_ >= nwv) return;
    const int lane = fresh_lane(), NGW = nblk * nwv; int it = moe_lo + bid * nwv + wid_;
    if (it >= moe_hi) return;
    const float* s; u32x4* d; float sc; f32x4 v[16], vn[16];
    moe_f8_addr(p, it, lane, s, d, sc);
#pragma unroll
    for (int k = 0; k < 16; ++k) v[k] = __builtin_nontemporal_load((const f32x4*)(s + (size_t)k * 2048));
    for (;;) {
        const int itn = it + NGW; const bool more = itn < moe_hi; const float* sn = s; u32x4* dn = d; float scn = sc;
        if (more) { moe_f8_addr(p, itn, lane, sn, dn, scn);
#pragma unroll
            for (int k = 0; k < 16; ++k) vn[k] = __builtin_nontemporal_load((const f32x4*)(sn + (size_t)k * 2048)); }
#pragma unroll
        for (int j = 0; j < 4; ++j) { u32x4 o;
            o.x = pk4_fp8(v[0][j] * sc, v[1][j] * sc, v[2][j] * sc, v[3][j] * sc); o.y = pk4_fp8(v[4][j] * sc, v[5][j] * sc, v[6][j] * sc, v[7][j] * sc);
            o.z = pk4_fp8(v[8][j] * sc, v[9][j] * sc, v[10][j] * sc, v[11][j] * sc); o.w = pk4_fp8(v[12][j] * sc, v[13][j] * sc, v[14][j] * sc, v[15][j] * sc);
            d[j] = o; }
        if (!more) break;
        it = itn; d = dn; sc = scn; s = sn;
#pragma unroll
        for (int k = 0; k < 16; ++k) v[k] = vn[k];
    }
}

DI void ph_misc(const Params& p, int wid_) {
    const size_t gt = (size_t)blockIdx.x * NTHREADS + (wid_ * 64 + fresh_lane()), NGT = (size_t)gridDim.x * NTHREADS;
    float* cosT = ws_cos(p); float* sinT = ws_sin(p);
    for (size_t i = gt; i < 1024 * 32; i += NGT) { const int s = (int)(i >> 5), f = (int)(i & 31);
        const float inv = powf(10000.f, -(float)(f & 15) / 16.f); const float pos = f < 16 ? (float)(s >> 6) : (float)(s & 63); const float ang = pos * inv;
        cosT[i] = cosf(ang); sinT[i] = sinf(ang); }
    bf16_t* ACT2 = wsp<bf16_t>(p, WS_ACT2); bf16_t* KPE = wsp<bf16_t>(p, WS_KPE); bf16_t* KO = wsp<bf16_t>(p, WS_KO); bf16_t* VTO = wsp<bf16_t>(p, WS_VTO);
    const float* cckv = p.in[2]; const float* ckpe = p.in[3]; const float* csk = p.in[4]; const float* csv = p.in[5];
    for (size_t i = gt; i < (size_t)TC * 256 / 4; i += NGT) { const size_t e = i * 4; const int j = (int)(e >> 8), cc = (int)(e & 255); const f32x4 v = *(const f32x4*)(cckv + e);
        u32x2 o; o.x = pk2(v[0], v[1]); o.y = pk2(v[2], v[3]); *(u32x2*)(ACT2 + (size_t)(T + j) * 1792 + 512 + cc) = o;
        const f32x4 k = *(const f32x4*)(csk + e); u32x2 o2; o2.x = pk2(k[0], k[1]); o2.y = pk2(k[2], k[3]); *(u32x2*)(KO + (size_t)(T + j) * 256 + cc) = o2; }
    for (size_t i = gt; i < (size_t)TC * 64 / 4; i += NGT) { const size_t e = i * 4; const f32x4 v = *(const f32x4*)(ckpe + e); u32x2 o; o.x = pk2(v[0], v[1]); o.y = pk2(v[2], v[3]); *(u32x2*)(KPE + (size_t)T * 64 + e) = o; }
    for (size_t i = gt; i < (size_t)256 * (TC / 8); i += NGT) { const int f = (int)(i / (TC / 8)), j8 = (int)(i % (TC / 8)) * 8; float v[8];
#pragma unroll
        for (int q = 0; q < 8; ++q) v[q] = csv[(size_t)(j8 + q) * 256 + f];
        u32x4 o; o.x = pk2(v[0], v[1]); o.y = pk2(v[2], v[3]); o.z = pk2(v[4], v[5]); o.w = pk2(v[6], v[7]); *(u32x4*)(VTO + (size_t)f * TX + T + j8) = o; }
}

DI void ph_h0(const Params& p, int wid_, unsigned char* lds_raw) {
    const int tid = (wid_ * 64 + fresh_lane()), lane = tid & 63, wv = wid_;
    const int rpb = p.rpb, rb0 = blockIdx.x * rpb, rb1 = min(rb0 + rpb, T);
    if (rb0 >= T) return;
    LAS float* P = (LAS float*)lds_raw;
    const int c_lo = cond_of_row(rb0);
    for (int i = tid; i < 2 * 2 * 512; i += NTHREADS) { const int cc = i >> 10, j = (i >> 9) & 1, col = (i & 511) * 4; const int ci = min(c_lo + cc, 8);
        *(LAS f32x4*)(P + (cc * 2 + j) * 2048 + col) = mod_from_partials(p, 0, ci, j, col); }
    __syncthreads();
    bf16_t* H = wsp<bf16_t>(p, WS_H);
    f32x4 v[8], vn[8]; int r = rb0 + wv;
    if (r < rb1) { const float* x = xrow_in(p, r) + lane * 8;
#pragma unroll
        for (int j = 0; j < 4; ++j) { v[2 * j] = __builtin_nontemporal_load((const f32x4*)(x + 512 * j)); v[2 * j + 1] = __builtin_nontemporal_load((const f32x4*)(x + 512 * j + 4)); } }
    for (; r < rb1; r += NWAVES) {
        const int rn = r + NWAVES;
        if (rn < rb1) { const float* x = xrow_in(p, rn) + lane * 8;
#pragma unroll
            for (int j = 0; j < 4; ++j) { vn[2 * j] = __builtin_nontemporal_load((const f32x4*)(x + 512 * j)); vn[2 * j + 1] = __builtin_nontemporal_load((const f32x4*)(x + 512 * j + 4)); } }
        asm volatile("" ::: "memory");
        const LAS float* sh = P + (cond_of_row(r) - c_lo) * 4096; const LAS float* sc = sh + 2048;
#pragma unroll
        for (int j = 0; j < 4; ++j) { const int c0 = lane * 8 + 512 * j;
            const f32x4 h0 = v[2 * j] * (1.f + *(const LAS f32x4*)(sc + c0)) + *(const LAS f32x4*)(sh + c0), h1 = v[2 * j + 1] * (1.f + *(const LAS f32x4*)(sc + c0 + 4)) + *(const LAS f32x4*)(sh + c0 + 4);
            u32x4 o; o.x = pk2(h0[0], h0[1]); o.y = pk2(h0[2], h0[3]); o.z = pk2(h1[0], h1[1]); o.w = pk2(h1[2], h1[3]); *(u32x4*)(H + (size_t)r * D + c0) = o; }
#pragma unroll
        for (int j = 0; j < 8; ++j) v[j] = vn[j];
    }
}

DI void ph_gb(const Params& p, int wid_) {
    float* GB = wsp<float>(p, WS_GB);
    for (int i = blockIdx.x * NTHREADS + (wid_ * 64 + fresh_lane()); i < 2 * 9 * 512; i += gridDim.x * NTHREADS) { const int l = i / (9 * 512), ci = (i / 512) % 9, col = (i & 511) * 4;
        const f32x4 g = *(const f32x4*)(p.in[21] + l * D + col), b = *(const f32x4*)(p.in[22] + l * D + col), sh = *(const f32x4*)(modp(p, l, ci, 3) + col), sc = *(const f32x4*)(modp(p, l, ci, 4) + col);
        *(f32x4*)(GB + ((size_t)(l * 9 + ci) * 2 + 0) * D + col) = g * (1.f + sc); *(f32x4*)(GB + ((size_t)(l * 9 + ci) * 2 + 1) * D + col) = b * (1.f + sc) + sh; }
}
struct E1Row { f32x4 cq[2], ckv, u[4], ad[4], sb[4]; };
DI f32x4 ldbf4(const bf16_t* q) { const u32x2 w = *(const u32x2*)q; return (f32x4){bflo(w.x), bfhi(w.x), bflo(w.y), bfhi(w.y)}; }
DI void e1_seq(int r, int& s, int& S, int& rb) { if (r < T_CTX) { s = r & 255; S = 256; } else { s = (r - T_CTX) & 1023; S = 1024; } rb = r - s; }
DI void e1_load(const float* PJ32, const bf16_t* PJB, int r, int lane, E1Row& L) {
    const bf16_t* pr = PJB + (size_t)r * 1536; int s, S, rb; e1_seq(r, s, S, rb);
    L.cq[0] = ldbf4(pr + lane * 4); L.cq[1] = ldbf4(pr + lane * 4 + 256); L.ckv = *(const f32x4*)(PJ32 + (size_t)r * 256 + lane * 4);
#pragma unroll
    for (int g = 0; g < 4; ++g) { const int half = 1 << g, c0 = 512 + g * 256 + lane * 4; const int ia = s + half - 1, ib = s - half - 1;
        L.u[g] = ldbf4(pr + c0);
        const float ma = ia < S ? 1.f : 0.f, mb = ib >= 0 ? 1.f : 0.f;
        L.ad[g] = ldbf4(PJB + (size_t)(rb + min(ia, S - 1)) * 1536 + c0) * ma; L.sb[g] = ldbf4(PJB + (size_t)(rb + max(ib, 0)) * 1536 + c0) * mb; }
}
DI void e1_window_before(const bf16_t* PJB, int r, int lane, f32x4 (&wsum)[4]) {
    int s, S, rb; e1_seq(r, s, S, rb);
#pragma unroll
    for (int g = 0; g < 4; ++g) { const int half = 1 << g, c0 = 512 + g * 256 + lane * 4; const int lo = max(s - 1 - half, 0), hi = min(s - 1 + half, S);
        f32x4 sum = {0.f, 0.f, 0.f, 0.f};
        for (int t = lo; t < hi; ++t) sum += ldbf4(PJB + (size_t)(rb + t) * 1536 + c0);
        wsum[g] = sum; }
}
DI void ph_e1(const Params& p, int wid_) {
    ph_gb(p, wid_);
    const int lane = fresh_lane();
    const int rpw = (p.rpb + NWAVES - 1) / NWAVES, rb0 = blockIdx.x * p.rpb, ra = rb0 + wid_ * rpw, rz = min(min(ra + rpw, rb0 + p.rpb), T);
    if (ra >= rz) return;
    const float* PJ32 = wsp<float>(p, WS_PJ); const bf16_t* PJB = wsp<bf16_t>(p, WS_PJB); bf16_t* ACT2 = wsp<bf16_t>(p, WS_ACT2);
    const float* qn = p.in[11]; const float* kvn = p.in[12];
    const f32x4 gq0 = *(const f32x4*)(qn + lane * 4), gq1 = *(const f32x4*)(qn + lane * 4 + 256), gkv = *(const f32x4*)(kvn + lane * 4);
    f32x4 wsum[4]; E1Row A, B;
    e1_load(PJ32, PJB, ra, lane, A);
    e1_window_before(PJB, ra, lane, wsum);
    for (int r = ra; r < rz; ++r) {
        if (r + 1 < rz) e1_load(PJ32, PJB, r + 1, lane, B);
        bf16_t* ar = ACT2 + (size_t)r * 1792; int s, S, rb; e1_seq(r, s, S, rb);
        if (s == 0 && r != ra) e1_window_before(PJB, r, lane, wsum);
        {
            const float ss = ((A.cq[0][0] * A.cq[0][0] + A.cq[0][1] * A.cq[0][1]) + (A.cq[0][2] * A.cq[0][2] + A.cq[0][3] * A.cq[0][3])) + ((A.cq[1][0] * A.cq[1][0] + A.cq[1][1] * A.cq[1][1]) + (A.cq[1][2] * A.cq[1][2] + A.cq[1][3] * A.cq[1][3]));
            const float rs = rsqrtf(wave_sum(ss) * (1.f / 512.f) + 1e-6f);
            const f32x4 y0 = A.cq[0] * rs * gq0, y1 = A.cq[1] * rs * gq1;
            u32x2 o; o.x = pk2(y0[0], y0[1]); o.y = pk2(y0[2], y0[3]); *(u32x2*)(ar + lane * 4) = o; o.x = pk2(y1[0], y1[1]); o.y = pk2(y1[2], y1[3]); *(u32x2*)(ar + lane * 4 + 256) = o;
        }
        {
            const int c0 = lane * 4; const f32x4 v = A.ckv; const float ss = (v[0] * v[0] + v[1] * v[1]) + (v[2] * v[2] + v[3] * v[3]);
            const float rs = rsqrtf(wave_sum(ss) * (1.f / 256.f) + 1e-6f); const f32x4 y = v * rs * gkv;
            u32x2 o; o.x = pk2(y[0], y[1]); o.y = pk2(y[2], y[3]); *(u32x2*)(ar + 512 + c0) = o;
            if (r < T_CTX) *(f32x4*)(p.out + O_CKV + (size_t)r * 256 + c0) = y;
        }
#pragma unroll
        for (int g = 0; g < 4; ++g) {
            const int half = 1 << g; const int lo = max(s - half, 0), hi = min(s + half, S); const int c0 = 768 + g * 256 + lane * 4;
            wsum[g] = wsum[g] + A.ad[g] - A.sb[g];
            const f32x4 y = wsum[g] * __builtin_amdgcn_rcpf((float)(hi - lo)) - A.u[g];
            u32x2 o; o.x = pk2(y[0], y[1]); o.y = pk2(y[2], y[3]); *(u32x2*)(ar + c0) = o; }
        A = B;
    }
}

DI void ph_ln1(const Params& p, int wid_, int l, unsigned char* lds_raw) {
    constexpr int HGS = 2052;
    const int lane = fresh_lane(), tid = wid_ * 64 + lane;
    const int rb0 = blockIdx.x * p.rpb, rb1 = min(rb0 + p.rpb, T);
    if (rb0 >= T) return;
    LAS float* HG = (LAS float*)lds_raw;
    LAS float* red = HG + 16 * HGS;
    const float* wr = p.in[23] + (size_t)l * 2048 * 16;
    float bk[64];
#pragma unroll
    for (int s = 0; s < 64; ++s) bk[s] = wr[(size_t)(wid_ * 256 + 4 * s + (lane >> 4)) * 16 + (lane & 15)];
    const bf16_t* Y = wsp<bf16_t>(p, WS_Y); float* STAT = wsp<float>(p, WS_STAT); bf16_t* H = wsp<bf16_t>(p, WS_H); float* AFF = wsp<float>(p, WS_AFF); float* AFFT = wsp<float>(p, WS_AFFT);
    unsigned char* H8 = wsp<unsigned char>(p, WS_H8);
    f32x4 v[8], gg[8], gb[8]; u32x4 rw[4], rwn[4];
#define LN1_ROW(i) (rb0 + 16 * ((i) >> 1) + wid_ + 8 * ((i) & 1))
#define LN1_LOAD(dst, rr) do { if ((rr) < rb1) { _Pragma("unroll") for (int j = 0; j < 4; ++j) dst[j] = *(const u32x4*)(Y + (size_t)(rr) * D + lane * 8 + 512 * j); } } while (0)
    const int ngrp = (rb1 - rb0 + 15) >> 4;
    LN1_LOAD(rw, LN1_ROW(0));
    for (int g = 0; g < ngrp; ++g) {
#pragma unroll
        for (int h2 = 0; h2 < 2; ++h2) { const int i = 2 * g + h2, r = LN1_ROW(i), rl = wid_ + 8 * h2;
            LN1_LOAD(rwn, LN1_ROW(i + 1));
            if (r < rb1) {
#pragma unroll
                for (int j = 0; j < 4; ++j) { v[2 * j] = (f32x4){bflo(rw[j].x), bfhi(rw[j].x), bflo(rw[j].y), bfhi(rw[j].y)}; v[2 * j + 1] = (f32x4){bflo(rw[j].z), bfhi(rw[j].z), bflo(rw[j].w), bfhi(rw[j].w)}; }
                const int ci = cond_of_row(r); const float* gv = wsp<float>(p, WS_GB) + (size_t)(l * 9 + ci) * 2 * D; const float* bv = gv + D;
#pragma unroll
                for (int j = 0; j < 8; ++j) { const int cc = lane * 8 + 512 * (j >> 1) + 4 * (j & 1); gg[j] = *(const f32x4*)(gv + cc); gb[j] = *(const f32x4*)(bv + cc); }
                float s = 0.f;
#pragma unroll
                for (int j = 0; j < 8; ++j) s += (v[j][0] + v[j][1]) + (v[j][2] + v[j][3]);
                const float mean = wave_sum(s) * (1.f / D); float s2 = 0.f;
#pragma unroll
                for (int j = 0; j < 8; ++j) { v[j] = v[j] - mean; s2 += (v[j][0] * v[j][0] + v[j][1] * v[j][1]) + (v[j][2] * v[j][2] + v[j][3] * v[j][3]); }
                const float rstd = rsqrtf(wave_sum(s2) * (1.f / D) + 1e-5f);
#pragma unroll
                for (int j = 0; j < 4; ++j) { const int c0 = lane * 8 + 512 * j;
                    const f32x4 a = v[2 * j] * rstd * gg[2 * j] + gb[2 * j], b = v[2 * j + 1] * rstd * gg[2 * j + 1] + gb[2 * j + 1];
                    *(LAS f32x4*)(HG + rl * HGS + c0) = a; *(LAS f32x4*)(HG + rl * HGS + c0 + 4) = b;
                    if (!MOE_F8) { u32x4 o; o.x = pk2(a[0], a[1]); o.y = pk2(a[2], a[3]); o.z = pk2(b[0], b[1]); o.w = pk2(b[2], b[3]); *(u32x4*)(H + (size_t)r * D + c0) = o; }
                    u32x2 o8; o8.x = pk4_fp8(a[0], a[1], a[2], a[3]); o8.y = pk4_fp8(b[0], b[1], b[2], b[3]); *(u32x2*)(H8 + (size_t)r * D + c0) = o8; }
                if (lane == 0) *(f32x2*)(STAT + 2 * (size_t)r) = (f32x2){mean, rstd};
            } else {
#pragma unroll
                for (int j = 0; j < 4; ++j) { const int c0 = lane * 8 + 512 * j; *(LAS f32x4*)(HG + rl * HGS + c0) = (f32x4){0.f, 0.f, 0.f, 0.f}; *(LAS f32x4*)(HG + rl * HGS + c0 + 4) = (f32x4){0.f, 0.f, 0.f, 0.f}; } }
#pragma unroll
            for (int j = 0; j < 4; ++j) rw[j] = rwn[j];
        }
        __syncthreads();
        {
            f32x4 acc = {0.f, 0.f, 0.f, 0.f};
            const LAS float* ap = HG + (lane & 15) * HGS + wid_ * 256 + (lane >> 4);
#pragma unroll
            for (int s = 0; s < 64; ++s) acc = __builtin_amdgcn_mfma_f32_16x16x4f32(ap[4 * s], bk[s], acc, 0, 0, 0);
#pragma unroll
            for (int rg = 0; rg < 4; ++rg) red[wid_ * 256 + ((lane >> 4) * 4 + rg) * 16 + (lane & 15)] = acc[rg];
        }
        __syncthreads();
        if (tid < 256) { const int row = tid >> 4, e = tid & 15, r = rb0 + 16 * g + row;
            float lg = 0.f;
#pragma unroll
            for (int w = 0; w < NWAVES; ++w) lg += red[w * 256 + tid];
            float m = lg;
#pragma unroll
            for (int o = 1; o < 16; o <<= 1) m = fmaxf(m, __shfl_xor(m, o));
            const float ex = expf(lg - m); float den = ex;
#pragma unroll
            for (int o = 1; o < 16; o <<= 1) den += __shfl_xor(den, o);
            if (r < rb1) { const float af = ex / den; AFF[(size_t)r * 16 + e] = af; AFFT[(size_t)e * T + r] = af; } }
        __syncthreads();
    }
#undef LN1_LOAD
#undef LN1_ROW
}

DI int wave_incl_scan(int v, int lane) {
#pragma unroll
    for (int o = 1; o < 64; o <<= 1) { const int u = __shfl_up(v, o); v += lane >= o ? u : 0; }
    return v;
}
DI int block_excl_scan2(int a0, int a1, int tid, int lane, int wave, int* wsum) {
    const int s = a0 + a1, incl = wave_incl_scan(s, lane);
    if (lane == 63) wsum[wave] = incl;
    __syncthreads();
    int base = 0;
#pragma unroll
    for (int w = 0; w < NWAVES; ++w) base += w < wave ? wsum[w] : 0;
    __syncthreads();
    return base + incl - s;
}
DI void ph_topk(const Params& p, int wid_, unsigned char* lds_raw) {
    const int tid = (wid_ * 64 + fresh_lane()), lane = tid & 63, wave = wid_;
    unsigned* vb = (unsigned*)lds_raw;
    int* hist = (int*)(vb + 1024);
    int* wsum = hist + 256;
    int* ctl = wsum + 16;
    int* selrow = ctl + 4;
    int* selslot = selrow + 128;
    int* nsel = selslot + 128;
    const float* AFFT = wsp<float>(p, WS_AFFT); int* INV = wsp<int>(p, WS_INV); const bf16_t* H = wsp<bf16_t>(p, WS_H); const unsigned char* H8 = wsp<unsigned char>(p, WS_H8); bf16_t* XS = wsp<bf16_t>(p, WS_XS);
    const int it_step = gridDim.x == 256 ? (blockIdx.x < 128 ? 384 : 128) : (int)gridDim.x;
    for (int it = blockIdx.x; it < 384; it += it_step) {
        int n, cap, r0, e, sb;
        if (it < 128) { const int b = it >> 4; e = it & 15; n = 1024; cap = 128; r0 = T_CTX + b * 1024; sb = 512 + b * 128; }
        else { const int li = it - 128, b = li >> 4; e = li & 15; n = 256; cap = 32; r0 = b * 256; sb = b * 32; }
        const int i0 = 2 * tid, i1 = 2 * tid + 1;
        unsigned b0 = 0u, b1 = 0u;
        if (i0 < n) { const f32x2 a = *(const f32x2*)(AFFT + (size_t)e * T + r0 + i0); b0 = __float_as_uint(a[0]); b1 = __float_as_uint(a[1]); vb[i0] = b0; vb[i1] = b1; }
        if (tid == 0) *nsel = 0;
        unsigned prefix = 0u; int need = cap;
#pragma unroll
        for (int pass = 0; pass < 4; ++pass) { const int shift = 24 - 8 * pass;
            if (tid < 256) hist[tid] = 0;
            __syncthreads();
            if (i0 < n) { const bool m0 = pass == 0 || (b0 >> (shift + 8)) == prefix, m1 = pass == 0 || (b1 >> (shift + 8)) == prefix;
                if (m0) atomicAdd(&hist[(b0 >> shift) & 255u], 1); if (m1) atomicAdd(&hist[(b1 >> shift) & 255u], 1); }
            __syncthreads();
            if (wave == 0) { int h4[4], s = 0;
#pragma unroll
                for (int j = 0; j < 4; ++j) { h4[j] = hist[255 - (4 * lane + j)]; s += h4[j]; }
                const int incl = wave_incl_scan(s, lane), excl = incl - s;
                if (excl < need && need <= incl) { int cum = excl, bin = 0, nn = need; bool done = false;
#pragma unroll
                    for (int j = 0; j < 4; ++j) { if (!done) { if (cum + h4[j] >= need) { bin = 255 - (4 * lane + j); nn = need - cum; done = true; } else cum += h4[j]; } }
                    ctl[0] = bin; ctl[1] = nn; } }
            __syncthreads();
            prefix = (prefix << 8) | (unsigned)ctl[0]; need = ctl[1];
        }
        const int g0 = (i0 < n && b0 > prefix) ? 1 : 0, g1 = (i0 < n && b1 > prefix) ? 1 : 0, q0 = (i0 < n && b0 == prefix) ? 1 : 0, q1 = (i0 < n && b1 == prefix) ? 1 : 0;
        const int eqb = block_excl_scan2(q0, q1, tid, lane, wave, wsum);
        const int s0 = g0 | (q0 & (eqb < need ? 1 : 0)), s1 = g1 | (q1 & (eqb + q0 < need ? 1 : 0));
        const int slb = block_excl_scan2(s0, s1, tid, lane, wave, wsum);
        if (i0 < n) {
            INV[(size_t)(r0 + i0) * 16 + e] = s0 ? sb + slb : -1; INV[(size_t)(r0 + i1) * 16 + e] = s1 ? sb + slb + s0 : -1;
            if (s0) { const int pos = atomicAdd(nsel, 1); selrow[pos] = i0; selslot[pos] = slb; }
            if (s1) { const int pos = atomicAdd(nsel, 1); selrow[pos] = i1; selslot[pos] = slb + s0; } }
        __syncthreads();
        const int ns = *nsel;
        for (int k0 = wave; k0 < ns; k0 += 4 * NWAVES) {
            if (MOE_F8) { u32x4 bufr[4][2];
#pragma unroll
                for (int b = 0; b < 4; ++b) { const int k = k0 + NWAVES * b; if (k < ns) { const u32x4* src = (const u32x4*)(H8 + (size_t)(r0 + selrow[k]) * D); bufr[b][0] = src[lane]; bufr[b][1] = src[lane + 64]; } }
#pragma unroll
                for (int b = 0; b < 4; ++b) { const int k = k0 + NWAVES * b; if (k < ns) { u32x4* dst = (u32x4*)((unsigned char*)XS + (size_t)(e * NSLOT + sb + selslot[k]) * D); dst[lane] = bufr[b][0]; dst[lane + 64] = bufr[b][1]; } } }
            else {
#pragma unroll
                for (int b = 0; b < 4; ++b) { const int k = k0 + NWAVES * b; if (k < ns) { const u32x4* src = (const u32x4*)(H + (size_t)(r0 + selrow[k]) * D); u32x4* dst = (u32x4*)(XS + (size_t)(e * NSLOT + sb + selslot[k]) * D);
#pragma unroll
                    for (int j = 0; j < 4; ++j) dst[lane + 64 * j] = src[lane + 64 * j]; } } } }
        __syncthreads();
    }
}

DI void ph_ln2(const Params& p, int wid_, int l, unsigned char* lds_raw) {
    const int tid = (wid_ * 64 + fresh_lane()), lane = tid & 63, wv = wid_;
    const int rpb = p.rpb, rb0 = blockIdx.x * rpb, rb1 = min(rb0 + rpb, T);
    if (rb0 >= T) return;
    LAS float* PV = (LAS float*)lds_raw;
    LAS float* PC = PV + 4 * 2048;
    const int c_lo = cond_of_row(rb0);
    for (int i = tid; i < 4 * 512; i += NTHREADS) { const int w = i >> 9, col = (i & 511) * 4; const float* src = w == 0 ? p.in[21] + l * D : w == 1 ? p.in[22] + l * D : w == 2 ? p.in[27] + l * D : p.in[28] + l * D;
        *(LAS f32x4*)(PV + w * 2048 + col) = *(const f32x4*)(src + col); }
    for (int i = tid; i < 2 * 3 * 512; i += NTHREADS) { const int cc = i / 1536, w = (i / 512) % 3, col = (i & 511) * 4; const int ci = min(c_lo + cc, 8);
        const float* src = w == 0 ? modp(p, l, ci, 5) : modp(p, 1, ci, w == 1 ? 0 : 1);
        *(LAS f32x4*)(PC + (cc * 3 + w) * 2048 + col) = *(const f32x4*)(src + col); }
    __syncthreads();
    const bf16_t* Y = wsp<bf16_t>(p, WS_Y); const float* STAT = wsp<float>(p, WS_STAT);
    const float* AFF = wsp<float>(p, WS_AFF); const int* INV = wsp<int>(p, WS_INV); const bf16_t* YE = wsp<bf16_t>(p, WS_YE);
    bf16_t* XL = wsp<bf16_t>(p, WS_XL); bf16_t* H = wsp<bf16_t>(p, WS_H);
    u32x4 x[4], xn[4]; int sl = -1, sln = -1; float af = 0.f, afn = 0.f; f32x2 st = {0.f, 1.f}, stn = {0.f, 1.f};
    int r = rb0 + wv;
#define LN2_LOAD(dx, ds, da, dt, rr) do { if ((rr) < rb1) { _Pragma("unroll") for (int j = 0; j < 4; ++j) dx[j] = __builtin_nontemporal_load((const u32x4*)(Y + (size_t)(rr) * D + lane * 8 + 512 * j)); \
        if (lane < 16) { ds = INV[(size_t)(rr) * 16 + lane]; da = AFF[(size_t)(rr) * 16 + lane]; } dt = *(const f32x2*)(STAT + 2 * (size_t)(rr)); } } while (0)
    LN2_LOAD(x, sl, af, st, r);
    for (; r < rb1; r += NWAVES) {
        asm volatile("" ::: "memory");
        LN2_LOAD(xn, sln, afn, stn, r + NWAVES);
        const LAS float* pc = PC + (cond_of_row(r) - c_lo) * 3 * 2048;
        f32x4 f[8];
#pragma unroll
        for (int j = 0; j < 8; ++j) f[j] = (f32x4){0.f, 0.f, 0.f, 0.f};
        {
            unsigned long long mk = __ballot(sl >= 0) & 0xffffull;
            while (mk) {
                const int e0 = __builtin_ctzll(mk); mk &= mk - 1; const bool two = mk != 0ull; const int e1 = two ? __builtin_ctzll(mk) : e0; if (two) mk &= mk - 1;
                const int s0 = __shfl(sl, e0), s1 = __shfl(sl, e1); const float w0 = __shfl(af, e0) * (MOE_F8 && YE_F8 ? 1.f / YE_SCALE : 1.f), w1 = two ? __shfl(af, e1) * (MOE_F8 && YE_F8 ? 1.f / YE_SCALE : 1.f) : 0.f;
                if (MOE_F8 && YE_F8) {
                    const unsigned char* y0 = (const unsigned char*)YE + (size_t)(e0 * NSLOT + s0) * D + lane * 8; const unsigned char* y1 = (const unsigned char*)YE + (size_t)(e1 * NSLOT + s1) * D + lane * 8;
                    u32x2 q0[4], q1[4];
#pragma unroll
                    for (int j = 0; j < 4; ++j) { q0[j] = *(const u32x2*)(y0 + 512 * j); q1[j] = *(const u32x2*)(y1 + 512 * j); }
#pragma unroll
                    for (int j = 0; j < 4; ++j) {
                        const f32x2 a0 = __builtin_amdgcn_cvt_pk_f32_fp8(q0[j].x, false), a1 = __builtin_amdgcn_cvt_pk_f32_fp8(q0[j].x, true), a2 = __builtin_amdgcn_cvt_pk_f32_fp8(q0[j].y, false), a3 = __builtin_amdgcn_cvt_pk_f32_fp8(q0[j].y, true);
                        const f32x2 b0 = __builtin_amdgcn_cvt_pk_f32_fp8(q1[j].x, false), b1 = __builtin_amdgcn_cvt_pk_f32_fp8(q1[j].x, true), b2 = __builtin_amdgcn_cvt_pk_f32_fp8(q1[j].y, false), b3 = __builtin_amdgcn_cvt_pk_f32_fp8(q1[j].y, true);
                        f[2 * j][0] += w0 * a0[0] + w1 * b0[0]; f[2 * j][1] += w0 * a0[1] + w1 * b0[1]; f[2 * j][2] += w0 * a1[0] + w1 * b1[0]; f[2 * j][3] += w0 * a1[1] + w1 * b1[1];
                        f[2 * j + 1][0] += w0 * a2[0] + w1 * b2[0]; f[2 * j + 1][1] += w0 * a2[1] + w1 * b2[1]; f[2 * j + 1][2] += w0 * a3[0] + w1 * b3[0]; f[2 * j + 1][3] += w0 * a3[1] + w1 * b3[1]; }
                } else {
                const bf16_t* y0 = YE + (size_t)(e0 * NSLOT + s0) * D + lane * 8; const bf16_t* y1 = YE + (size_t)(e1 * NSLOT + s1) * D + lane * 8;
                u32x4 q0[4], q1[4];
#pragma unroll
                for (int j = 0; j < 4; ++j) { q0[j] = *(const u32x4*)(y0 + 512 * j); q1[j] = *(const u32x4*)(y1 + 512 * j); }
#pragma unroll
                for (int j = 0; j < 4; ++j) {
                    f[2 * j][0] += w0 * bflo(q0[j].x) + w1 * bflo(q1[j].x); f[2 * j][1] += w0 * bfhi(q0[j].x) + w1 * bfhi(q1[j].x); f[2 * j][2] += w0 * bflo(q0[j].y) + w1 * bflo(q1[j].y); f[2 * j][3] += w0 * bfhi(q0[j].y) + w1 * bfhi(q1[j].y);
                    f[2 * j + 1][0] += w0 * bflo(q0[j].z) + w1 * bflo(q1[j].z); f[2 * j + 1][1] += w0 * bfhi(q0[j].z) + w1 * bfhi(q1[j].z); f[2 * j + 1][2] += w0 * bflo(q0[j].w) + w1 * bflo(q1[j].w); f[2 * j + 1][3] += w0 * bfhi(q0[j].w) + w1 * bfhi(q1[j].w); }
                }
            }
        }
        float s = 0.f;
#pragma unroll
        for (int j = 0; j < 8; ++j) { const int c0 = lane * 8 + 512 * (j >> 1) + 4 * (j & 1); const unsigned xa = (j & 1) ? x[j >> 1].z : x[j >> 1].x, xb = (j & 1) ? x[j >> 1].w : x[j >> 1].y; const f32x4 xw = {bflo(xa), bfhi(xa), bflo(xb), bfhi(xb)};
            const f32x4 x1 = (xw - st[0]) * st[1] * *(const LAS f32x4*)(PV + c0) + *(const LAS f32x4*)(PV + 2048 + c0);
            f[j] = DN_ALPHA * x1 + *(const LAS f32x4*)(pc + c0) * f[j]; s += (f[j][0] + f[j][1]) + (f[j][2] + f[j][3]); }
        const float mean = wave_sum(s) * (1.f / D); float s2 = 0.f;
#pragma unroll
        for (int j = 0; j < 8; ++j) { f[j] = f[j] - mean; s2 += (f[j][0] * f[j][0] + f[j][1] * f[j][1]) + (f[j][2] * f[j][2] + f[j][3] * f[j][3]); }
        const float rstd = rsqrtf(wave_sum(s2) * (1.f / D) + 1e-5f);
#pragma unroll
        for (int j = 0; j < 4; ++j) { const int c0 = lane * 8 + 512 * j; f32x4 o[2];
#pragma unroll
            for (int q = 0; q < 2; ++q) { const int cc = c0 + 4 * q; o[q] = f[2 * j + q] * rstd * *(const LAS f32x4*)(PV + 2 * 2048 + cc) + *(const LAS f32x4*)(PV + 3 * 2048 + cc);
                if (l == 0) { u32x2 w; w.x = pk2(o[q][0], o[q][1]); w.y = pk2(o[q][2], o[q][3]); *(u32x2*)(XL + (size_t)r * D + cc) = w; o[q] = o[q] * (1.f + *(const LAS f32x4*)(pc + 2 * 2048 + cc)) + *(const LAS f32x4*)(pc + 2048 + cc); }
                else *(f32x4*)(p.out + O_Y + (size_t)r * D + cc) = o[q]; }
            if (l == 0) { u32x4 w; w.x = pk2(o[0][0], o[0][1]); w.y = pk2(o[0][2], o[0][3]); w.z = pk2(o[1][0], o[1][1]); w.w = pk2(o[1][2], o[1][3]); *(u32x4*)(H + (size_t)r * D + c0) = w; } }
#pragma unroll
        for (int j = 0; j < 4; ++j) x[j] = xn[j];
        sl = sln; af = afn; st = stn;
    }
#undef LN2_LOAD
}
template <int PAT> DI void ph_readonly(const Params& p, int wid_) {
    const int lane = (wid_ * 64 + fresh_lane()) & 63, gw = blockIdx.x * NWAVES + wid_, NGW = gridDim.x * NWAVES;
    float accum = 0.f;
    for (int it = gw; it < 98304; it += NGW) {
        const int mat = it >> 10, w = it & 1023, le = mat / 3, kind = mat % 3;
        const float* base = p.in[24 + kind] + (size_t)le * 2048 * 2048;
        if (PAT == 0) { const int nb = w & 31, kb = w >> 5; const float* s = base + (size_t)(kb * 64) * 2048 + nb * 64 + lane; float v[64];
#pragma unroll
            for (int k = 0; k < 64; ++k) v[k] = __builtin_nontemporal_load(s + (size_t)k * 2048);
#pragma unroll
            for (int k = 0; k < 64; ++k) accum += v[k]; }
        else if (PAT == 1) { const int nb8 = w & 7, kb16 = w >> 3; const float* s = base + (size_t)(kb16 * 16) * 2048 + nb8 * 256 + 4 * lane; f32x4 v[16];
#pragma unroll
            for (int k = 0; k < 16; ++k) v[k] = __builtin_nontemporal_load((const f32x4*)(s + (size_t)k * 2048));
#pragma unroll
            for (int k = 0; k < 16; ++k) accum += (v[k][0] + v[k][1]) + (v[k][2] + v[k][3]); }
        else { const float* s = base + (size_t)w * 4096 + 4 * lane; f32x4 v[16];
#pragma unroll
            for (int k = 0; k < 16; ++k) v[k] = __builtin_nontemporal_load((const f32x4*)(s + (size_t)k * 256));
#pragma unroll
            for (int k = 0; k < 16; ++k) accum += (v[k][0] + v[k][1]) + (v[k][2] + v[k][3]); }
    }
    if (lane == 0) wsp<float>(p, WS_DBG)[gw] = accum + wave_sum(accum);
}

struct Unit { const char* A; const char* B; unsigned lda, ldb; int nt; int pm, pn; int mode; int aux; };
DI int vcu_of(int bx, int G) { return (G % 8 == 0) ? (bx % 8) * (G / 8) + bx / 8 : bx; }

DI void rope8(const Params& p, int s, int pi0, float* v) {
    const f32x4 c = *(const f32x4*)(ws_cos(p) + s * 32 + pi0), sn = *(const f32x4*)(ws_sin(p) + s * 32 + pi0);
#pragma unroll
    for (int i = 0; i < 4; ++i) { const float x1 = v[2 * i], x2 = v[2 * i + 1]; v[2 * i] = x1 * c[i] - x2 * sn[i]; v[2 * i + 1] = x1 * sn[i] + x2 * c[i]; }
}
DI void st_bf16x8(bf16_t* dst, const float* v) { u32x4 w; w.x = pk2(v[0], v[1]); w.y = pk2(v[2], v[3]); w.z = pk2(v[4], v[5]); w.w = pk2(v[6], v[7]); *(u32x4*)dst = w; }
DI void st_f32x8(float* dst, const float* v) { *(f32x4*)dst = (f32x4){v[0], v[1], v[2], v[3]}; *(f32x4*)(dst + 4) = (f32x4){v[4], v[5], v[6], v[7]}; }

struct SchedInEven { static constexpr bool BK16 = false; const Params* p; int G, c;
    DI bool next(int i, Unit& u) const { const int L = i * G + c; if (L >= 48 * 8) return false; u.pm = L >> 3; u.pn = L & 7;
        u.A = (const char*)wsp<bf16_t>(*p, WS_H) + (size_t)u.pm * 256 * 4096; u.B = (const char*)wsp<bf16_t>(*p, WS_WINE) + (size_t)u.pn * 256 * 4096; u.lda = 4096; u.ldb = 4096; u.nt = 32; u.mode = 0; u.aux = 0; return true; } };
struct EpiInEven { static constexpr bool HAS_STATE = false; static constexpr bool PAIR = false, F8 = false; const Params* p;
    DI void store(const Unit& u, int row, int col, float* v) const {
        const int r = u.pm * 256 + row, gc = u.pn * 256 + col;
        if (gc < 512) { st_bf16x8(wsp<bf16_t>(*p, WS_PJB) + (size_t)r * 1536 + gc, v); return; }
        if (gc < 768) { st_f32x8(wsp<float>(*p, WS_PJ) + (size_t)r * 256 + (gc - 512), v); return; }
        if (gc < 1792) { st_bf16x8(wsp<bf16_t>(*p, WS_PJB) + (size_t)r * 1536 + (gc - 256), v); return; }
        if (gc >= 1856) return;
        const int j0 = gc - 1792;
        if (r < T_CTX) st_f32x8(p->out + O_KPE + (size_t)r * 64 + j0, v); else rope8(*p, (r - T_CTX) & 1023, j0 >> 1, v);
        st_bf16x8(wsp<bf16_t>(*p, WS_KPE) + (size_t)r * 64 + j0, v);
    } };

constexpr int E2_Q = 48 * 6, E2_K = 64 * 4, E2_V = 4 * 64, E2_P = 48 * 4, E2_TOTAL = E2_Q + E2_K + E2_V + E2_P;
struct SchedE2 { static constexpr bool BK16 = false; const Params* p; int G, c;
    DI bool next(int i, Unit& u) const { int L;
        if (G == 256) { if (c < 32) { if (i > 2) return false; L = i == 0 ? c : (i == 1 ? 256 + c : E2_Q + c); } else { if (i > 3) return false; L = i == 0 ? c : E2_Q + 32 + (c - 32) * 3 + (i - 1); } }
        else { L = i * G + c; if (L >= E2_TOTAL) return false; }
        const char* ACT2 = (const char*)wsp<bf16_t>(*p, WS_ACT2); const char* W2 = (const char*)wsp<bf16_t>(*p, WS_W2); u.aux = 0;
        if (L < E2_Q) { u.mode = 0; u.pm = L / 6; u.pn = L % 6; u.A = ACT2 + (size_t)u.pm * 256 * 3584; u.lda = 3584; u.B = W2 + (size_t)u.pn * 256 * 3584; u.ldb = 3584; u.nt = 8; return true; }
        L -= E2_Q;
        if (L < E2_K) { u.mode = 1; u.pm = L >> 2; u.pn = L & 3; u.A = ACT2 + (size_t)u.pm * 256 * 3584 + 512 * 2; u.lda = 3584; u.B = W2 + (size_t)(1536 + u.pn * 256) * 3584; u.ldb = 3584; u.nt = 4; return true; }
        L -= E2_K;
        if (L < E2_V) { u.mode = 2; u.pm = L >> 6; u.pn = L & 63; u.A = W2 + (size_t)(2560 + u.pm * 256) * 3584; u.lda = 3584; u.B = ACT2 + (size_t)u.pn * 256 * 3584 + 512 * 2; u.ldb = 3584; u.nt = 4; return true; }
        L -= E2_V;
        u.mode = 3; u.pm = L >> 2; u.aux = L & 3; u.pn = 0; u.A = ACT2 + (size_t)u.pm * 256 * 3584 + (768 + u.aux * 256) * 2; u.lda = 3584; u.B = W2 + (size_t)(3584 + u.aux * 256) * 3584; u.ldb = 3584; u.nt = 4; return true; } };
struct EpiE2 { static constexpr bool HAS_STATE = false; static constexpr bool PAIR = false, F8 = false; const Params* p;
    DI void store(const Unit& u, int row, int col, float* v) const {
        const int r = u.pm * 256 + row, gc = u.pn * 256 + col;
        if (u.mode == 0) { const int dd = gc % 192; if (dd >= 128 && r >= T_CTX) rope8(*p, (r - T_CTX) & 1023, (dd - 128) >> 1, v);
#pragma unroll
            for (int i = 0; i < 8; ++i) v[i] *= QS_MLA;
            st_bf16x8(wsp<bf16_t>(*p, WS_Q) + (size_t)r * 1536 + gc, v); }
        else if (u.mode == 1) st_bf16x8(wsp<bf16_t>(*p, WS_KN) + (size_t)r * 1024 + gc, v);
        else if (u.mode == 2) st_bf16x8(wsp<bf16_t>(*p, WS_VT) + (size_t)r * TX + gc, v);
        else { const float* ps = p->in[16] + u.aux * 256 + col;
#pragma unroll
            for (int i = 0; i < 8; ++i) v[i] *= ps[i];
            if (OUT_F8) { u32x2 o; o.x = pk4_fp8(v[0], v[1], v[2], v[3]); o.y = pk4_fp8(v[4], v[5], v[6], v[7]); *(u32x2*)((unsigned char*)wsp<bf16_t>(*p, WS_MIX) + (size_t)r * 2048 + 1024 + u.aux * 256 + col) = o; }
            else st_bf16x8(wsp<bf16_t>(*p, WS_MIX) + (size_t)r * 2048 + 1024 + u.aux * 256 + col, v); }
    } };

struct SchedOut { static constexpr bool BK16 = OUT_F8 != 0; const Params* p; int G, c, l;
    DI bool next(int i, Unit& u) const { const int L = i * G + c; if (L >= 48 * 8) return false; u.pm = L >> 3; u.pn = L & 7;
        constexpr unsigned P = OUT_F8 ? 2048 : 4096;
        u.A = (const char*)wsp<bf16_t>(*p, WS_MIX) + (size_t)u.pm * 256 * P; u.B = (const char*)wsp<bf16_t>(*p, l == 0 ? WS_WOUTE : WS_WOUTO) + (OUT_F8 ? (size_t)u.pn * 256 * 16 : (size_t)u.pn * 256 * P); u.lda = P; u.ldb = OUT_F8 ? 2048 * 16 : P; u.nt = OUT_F8 ? 16 : 32; u.mode = 0; u.aux = 0; return true; } };
struct EpiOut { static constexpr bool HAS_STATE = false; static constexpr bool PAIR = false, F8 = OUT_F8 != 0; const Params* p; int l;
    DI void store(const Unit& u, int row, int col, float* v) const {
        const int r = u.pm * 256 + row, gc = u.pn * 256 + col;
        const float* g1 = modp(*p, l, cond_of_row(r), 2) + gc; f32x4 x0, x1;
        if (l == 0) { const float* x = xrow_in(*p, r) + gc; x0 = *(const f32x4*)x; x1 = *(const f32x4*)(x + 4); }
        else { const u32x4 w = *(const u32x4*)(wsp<bf16_t>(*p, WS_XL) + (size_t)r * D + gc); x0 = (f32x4){bflo(w.x), bfhi(w.x), bflo(w.y), bfhi(w.y)}; x1 = (f32x4){bflo(w.z), bfhi(w.z), bflo(w.w), bfhi(w.w)}; }
        const f32x4 g0 = *(const f32x4*)g1, g4 = *(const f32x4*)(g1 + 4);
#pragma unroll
        for (int i = 0; i < 4; ++i) { const float w0 = OUT_F8 ? g0[i] * (1.f / OUT_WSCALE) : g0[i], w4 = OUT_F8 ? g4[i] * (1.f / OUT_WSCALE) : g4[i]; v[i] = DN_ALPHA * x0[i] + w0 * v[i]; v[4 + i] = DN_ALPHA * x1[i] + w4 * v[4 + i]; }
        st_bf16x8(wsp<bf16_t>(*p, WS_Y) + (size_t)r * D + gc, v);
    } };

struct SchedGU { static constexpr bool BK16 = MOE_F8 != 0; const Params* p; int G, c, l;
    DI bool next(int i, Unit& u) const { int L = i * G + c; if (L >= 16 * 96) return false;
#ifdef MOE_XCD_ORDER
        if (G == 256) { const int x = c >> 5, j = i * 32 + (c & 31); L = x * 192 + j; }
#endif
        const int e = L / 96, rem = L % 96; u.pn = rem / 6; u.pm = e * 6 + rem % 6; u.aux = e;
        constexpr unsigned P = MOE_F8 ? 2048 : 4096;
        u.A = (const char*)wsp<bf16_t>(*p, WS_XS) + (size_t)u.pm * 256 * P; u.B = (const char*)wsp<bf16_t>(*p, WS_WGU) + (MOE_F8 ? (size_t)(l * 16 + e) * 4096 * 2048 + (size_t)u.pn * 256 * 16 : ((size_t)(l * 16 + e) * 4096 + (size_t)u.pn * 256) * P); u.lda = P; u.ldb = MOE_F8 ? 4096 * 16 : P; u.nt = MOE_F8 ? 16 : 32; u.mode = 0; return true; } };
struct EpiGU { static constexpr bool HAS_STATE = false; static constexpr bool PAIR = true, F8 = MOE_F8 != 0; const Params* p;
    DI void store2(const Unit& u, int row, int col, const float* g, const float* up) const {
        float h[8];
#pragma unroll
        for (int i = 0; i < 8; ++i) { const float gg = MOE_F8 ? g[i] * (1.f / GU_WSCALE) : g[i], uu = MOE_F8 ? up[i] * (1.f / GU_WSCALE) : up[i]; h[i] = gg * uu * __builtin_amdgcn_rcpf(1.f + __expf(-gg)); }
        if (MOE_F8) { u32x2 o; o.x = pk4_fp8(h[0], h[1], h[2], h[3]); o.y = pk4_fp8(h[4], h[5], h[6], h[7]); *(u32x2*)((unsigned char*)wsp<bf16_t>(*p, WS_HID) + (size_t)(u.pm * 256 + row) * D + u.pn * 128 + col) = o; }
        else st_bf16x8(wsp<bf16_t>(*p, WS_HID) + (size_t)(u.pm * 256 + row) * D + u.pn * 128 + col, h);
    } };

struct SchedDown { static constexpr bool BK16 = MOE_F8 != 0; const Params* p; int G, c, l;
    DI bool next(int i, Unit& u) const { int L = i * G + c; if (L >= 16 * 48) return false;
#ifdef MOE_XCD_ORDER
        if (G == 256) { const int x = c >> 5, j = i * 32 + (c & 31); L = x * 96 + j; }
#endif
        const int e = L / 48, rem = L % 48; u.pn = rem / 6; u.pm = e * 6 + rem % 6; u.aux = e;
        constexpr unsigned P = MOE_F8 ? 2048 : 4096;
        u.A = (const char*)wsp<bf16_t>(*p, WS_HID) + (size_t)u.pm * 256 * P; u.B = (const char*)wsp<bf16_t>(*p, WS_WDN) + (MOE_F8 ? (size_t)(l * 16 + e) * 2048 * 2048 + (size_t)u.pn * 256 * 16 : ((size_t)(l * 16 + e) * 2048 + (size_t)u.pn * 256) * P); u.lda = P; u.ldb = MOE_F8 ? 2048 * 16 : P; u.nt = MOE_F8 ? 16 : 32; u.mode = 0; return true; } };
struct EpiDown { static constexpr bool HAS_STATE = false; static constexpr bool PAIR = false, F8 = MOE_F8 != 0; const Params* p;
    DI void store(const Unit& u, int row, int col, float* v) const {
        if (MOE_F8) {
#pragma unroll
            for (int i = 0; i < 8; ++i) v[i] *= (YE_F8 ? YE_SCALE / DN_WSCALE : 1.f / DN_WSCALE); }
        if (MOE_F8 && YE_F8) { u32x2 o; o.x = pk4_fp8(v[0], v[1], v[2], v[3]); o.y = pk4_fp8(v[4], v[5], v[6], v[7]); *(u32x2*)((unsigned char*)wsp<bf16_t>(*p, WS_YE) + (size_t)(u.pm * 256 + row) * D + u.pn * 256 + col) = o; }
        else st_bf16x8(wsp<bf16_t>(*p, WS_YE) + (size_t)(u.pm * 256 + row) * D + u.pn * 256 + col, v); } };

constexpr int IO_QK = 48 * 9, IO_V = 16, IO_VT = 48, IO_TOTAL = IO_QK + IO_V + IO_VT;
struct SchedInOdd { static constexpr bool BK16 = false; const Params* p; int G, c;
    DI bool next(int i, Unit& u) const { int L = i * G + c; if (L >= IO_TOTAL) return false;
        const char* Hb = (const char*)wsp<bf16_t>(*p, WS_H); const char* W = (const char*)wsp<bf16_t>(*p, WS_WINO); u.aux = 0; u.nt = 32; u.lda = 4096; u.ldb = 4096;
        if (L < IO_QK) { u.mode = 0; u.pm = L / 9; u.pn = L % 9; u.A = Hb + (size_t)u.pm * 256 * 4096; u.B = W + (size_t)u.pn * 256 * 4096; return true; }
        L -= IO_QK;
        if (L < IO_V) { u.mode = 1; u.pm = L; u.pn = 9; u.A = Hb + (size_t)u.pm * 256 * 4096; u.B = W + (size_t)9 * 256 * 4096; return true; }
        L -= IO_V;
        u.mode = 2; u.pm = 0; u.pn = L; u.A = W + (size_t)9 * 256 * 4096; u.B = Hb + (size_t)u.pn * 256 * 4096; return true; } };
struct EpiInOdd { static constexpr bool HAS_STATE = true; static constexpr bool PAIR = false, F8 = false; const Params* p;
    struct State { f32x4 c[4], s[4]; bool rot; };
    DI void begin(State& st, const Unit& u, int row0, int col0) const {
        st.rot = u.mode == 0 && u.pm * 256 >= T_CTX;
        if (st.rot) { const int pi0 = (col0 & 63) >> 1;
#pragma unroll
            for (int ri = 0; ri < 4; ++ri) { const int r = u.pm * 256 + ri * 16 + row0, sp = (r - T_CTX) & 1023;
                st.c[ri] = *(const f32x4*)(ws_cos(*p) + sp * 32 + pi0); st.s[ri] = *(const f32x4*)(ws_sin(*p) + sp * 32 + pi0); } }
    }
    DI void store_st(const State& st, int ri, const Unit& u, int row, int col, float* v) const {
        const int r = u.pm * 256 + row, gc = u.pn * 256 + col;
        if (u.mode == 0) {
            if (gc < 2048) {
                if (st.rot) {
#pragma unroll
                    for (int i = 0; i < 4; ++i) { const float x1 = v[2 * i], x2 = v[2 * i + 1]; v[2 * i] = x1 * st.c[ri][i] - x2 * st.s[ri][i]; v[2 * i + 1] = x1 * st.s[ri][i] + x2 * st.c[ri][i]; } }
#pragma unroll
                for (int i = 0; i < 8; ++i) v[i] *= QS_SWA;
                st_bf16x8(wsp<bf16_t>(*p, WS_Q) + (size_t)r * 2048 + gc, v); }
            else { const int kc = gc - 2048; if (r < T_CTX) st_f32x8(p->out + O_SK + (size_t)r * 256 + kc, v);
                if (st.rot) {
#pragma unroll
                    for (int i = 0; i < 4; ++i) { const float x1 = v[2 * i], x2 = v[2 * i + 1]; v[2 * i] = x1 * st.c[ri][i] - x2 * st.s[ri][i]; v[2 * i + 1] = x1 * st.s[ri][i] + x2 * st.c[ri][i]; } }
                st_bf16x8(wsp<bf16_t>(*p, WS_KO) + (size_t)r * 256 + kc, v); } }
        else if (u.mode == 1) st_f32x8(p->out + O_SV + (size_t)r * 256 + col, v);
        else st_bf16x8(wsp<bf16_t>(*p, WS_VTO) + (size_t)row * TX + gc, v);
    }
    DI void store(const Unit& u, int row, int col, float* v) const {
        const int r = u.pm * 256 + row, gc = u.pn * 256 + col;
        if (u.mode == 0) {
            if (gc < 2048) { if (r >= T_CTX) rope8(*p, (r - T_CTX) & 1023, (gc & 63) >> 1, v);
#pragma unroll
                for (int i = 0; i < 8; ++i) v[i] *= QS_SWA;
                st_bf16x8(wsp<bf16_t>(*p, WS_Q) + (size_t)r * 2048 + gc, v); }
            else { const int kc = gc - 2048; if (r < T_CTX) st_f32x8(p->out + O_SK + (size_t)r * 256 + kc, v); else rope8(*p, (r - T_CTX) & 1023, (kc & 63) >> 1, v);
                st_bf16x8(wsp<bf16_t>(*p, WS_KO) + (size_t)r * 256 + kc, v); } }
        else if (u.mode == 1) st_f32x8(p->out + O_SV + (size_t)r * 256 + col, v);
        else st_bf16x8(wsp<bf16_t>(*p, WS_VTO) + (size_t)row * TX + gc, v);
    } };

namespace pg8 {
typedef short bf16x8 __attribute__((ext_vector_type(8)));
typedef int i32x4 __attribute__((ext_vector_type(4)));
typedef int i32x8 __attribute__((ext_vector_type(8)));
DI i32x8 cat8(bf16x8 lo, bf16x8 hi) { return __builtin_shufflevector(__builtin_bit_cast(i32x4, lo), __builtin_bit_cast(i32x4, hi), 0, 1, 2, 3, 4, 5, 6, 7); }
constexpr int BM = 256, BK = 64, HALF = 128, HTB = HALF * BK * 2  , STAGE_BYTES = 8 * HTB;
DI int lds_byte(int r, int c) { const int st = (r >> 4) * 2 + (c >> 5), rr = r & 15, cc = c & 31, ob = rr * 64 + cc * 2; return st * 1024 + (ob ^ (((ob >> 9) & 1) << 5)); }
DI void stage_rc(int b, int& R, int& C) { const int st = b / 1024, sb = b % 1024, swz = sb ^ (((sb >> 9) & 1) << 5); R = (st >> 1) * 16 + swz / 64; C = (st & 1) * 32 + (swz % 64) / 2; }
DI int perm32(int rho) { const int n = rho >> 4, i = rho & 15; return 8 * (i >> 2) + 4 * n + (i & 3); }

template <bool F8> struct Frag;
template <> struct Frag<false> { bf16x8 k0, k1; DI void set(bf16x8 a, bf16x8 b) { k0 = a; k1 = b; } };
template <> struct Frag<true> { i32x8 w; DI void set(bf16x8 a, bf16x8 b) { w = cat8(a, b); } };
template <class Epi, class Sched, bool ALIGN_EPI = true>
DI void gemm_phase(LAS unsigned char* lds, const Sched& S, const Epi& E, int wid) {
    const int lane = fresh_lane(), tid = wid * 64 + lane, wr = wid >> 2, wc = wid & 3, fr = lane & 15, fq = lane >> 4;
    int RA[2], RB[2], CB[2];
#pragma unroll
    for (int i = 0; i < 2; ++i) { int R, C; stage_rc(tid * 16 + i * 8192, R, C); RA[i] = R; RB[i] = (R & ~31) + perm32(R & 31); CB[i] = C * 2; }
    constexpr size_t kstep = (size_t)(BK * 2);
    const unsigned ldsw = (unsigned)wid * 1024u;
    const int aoff = lds_byte(wr * 64 + fr, fq * 8), boff = lds_byte(wc * 32 + fr, fq * 8);
#define PG8_SA(b, h) (((b) * 2 + (h)) * HTB)
#define PG8_SB(b, h) ((4 + (b) * 2 + (h)) * HTB)
#define PG8_STAGE(bufoff, gbase, v0, v1) do { unsigned o0_ = (v0), o1_ = (v1); asm volatile("" : "+v"(o0_), "+v"(o1_)); \
        __builtin_amdgcn_global_load_lds((const unsigned*)((const char*)(gbase) + o0_), (LAS unsigned*)(lds + (bufoff) + ldsw), 16, 0, 0); \
        __builtin_amdgcn_global_load_lds((const unsigned*)((const char*)(gbase) + o1_), (LAS unsigned*)(lds + (bufoff) + ldsw + 8192), 16, 0, 0); } while (0)
#define PG8_LDA(dst, b, h) do { _Pragma("unroll") for (int m = 0; m < 4; ++m) { const bf16x8 f0_ = *(const LAS bf16x8*)(lds + PG8_SA(b, h) + aoff + m * 2048), f1_ = *(const LAS bf16x8*)(lds + PG8_SA(b, h) + aoff + m * 2048 + 1024); dst[m].set(f0_, f1_); } } while (0)
#define PG8_LDB(dst, b, h) do { _Pragma("unroll") for (int n = 0; n < 2; ++n) { const bf16x8 f0_ = *(const LAS bf16x8*)(lds + PG8_SB(b, h) + boff + n * 2048), f1_ = *(const LAS bf16x8*)(lds + PG8_SB(b, h) + boff + n * 2048 + 1024); dst[n].set(f0_, f1_); } } while (0)
#define PG8_MMA(ai, bj, At, Bt) do { __builtin_amdgcn_s_setprio(1); _Pragma("unroll") for (int m = 0; m < 4; ++m) _Pragma("unroll") for (int n = 0; n < 2; ++n) { \
        if constexpr (Epi::F8) acc[ai][bj][m][n] = __builtin_amdgcn_mfma_scale_f32_16x16x128_f8f6f4(Bt[n].w, At[m].w, acc[ai][bj][m][n], 0, 0, 0, 0x7f7f7f7f, 0, 0x7f7f7f7f); \
        else { acc[ai][bj][m][n] = __builtin_amdgcn_mfma_f32_16x16x32_bf16(Bt[n].k0, At[m].k0, acc[ai][bj][m][n], 0, 0, 0); acc[ai][bj][m][n] = __builtin_amdgcn_mfma_f32_16x16x32_bf16(Bt[n].k1, At[m].k1, acc[ai][bj][m][n], 0, 0, 0); } } \
        __builtin_amdgcn_s_setprio(0); } while (0)
#define PG8_WAIT_V(n) asm volatile("s_waitcnt vmcnt(" #n ")" ::: "memory")
#define PG8_WAIT_L(n) asm volatile("s_waitcnt lgkmcnt(" #n ")" ::: "memory")
#define PG8_BAR __builtin_amdgcn_s_barrier()
#define PG8_SCHED __builtin_amdgcn_sched_barrier(0)
    Unit cur, nxt; int ui = 0;
    if (!S.next(0, cur)) return;
    f32x4 acc[2][2][4][2];
#pragma unroll
    for (int a = 0; a < 2; ++a)
#pragma unroll
        for (int b = 0; b < 2; ++b)
#pragma unroll
            for (int m = 0; m < 4; ++m)
#pragma unroll
                for (int n = 0; n < 2; ++n) acc[a][b][m][n] = (f32x4){0.f, 0.f, 0.f, 0.f};
    Frag<Epi::F8> At[4], B0[2], B1[2];
    const char* cA = cur.A; const char* cB = cur.B;
    const unsigned ld = cur.lda;
    const unsigned plane = cur.ldb;
    const unsigned vA0 = RA[0] * ld + CB[0], vA1 = RA[1] * ld + CB[1];
    const unsigned vB0 = Sched::BK16 ? (unsigned)(CB[0] >> 4) * plane + RB[0] * 16 : RB[0] * ld + CB[0], vB1 = Sched::BK16 ? (unsigned)(CB[1] >> 4) * plane + RB[1] * 16 : RB[1] * ld + CB[1];
    const size_t hA = (size_t)HALF * ld, hB = Sched::BK16 ? (size_t)HALF * 16 : hA;
    const size_t kstepB = Sched::BK16 ? (size_t)8 * plane : kstep;
    PG8_STAGE(PG8_SB(0, 0), cB, vB0, vB1); PG8_STAGE(PG8_SB(0, 1), cB + hB, vB0, vB1); PG8_STAGE(PG8_SA(0, 0), cA, vA0, vA1); PG8_STAGE(PG8_SA(0, 1), cA + hA, vA0, vA1);
    if (wr == 1) PG8_BAR;
    PG8_WAIT_V(2); PG8_BAR;
    PG8_STAGE(PG8_SB(1, 0), cB + kstepB, vB0, vB1); PG8_STAGE(PG8_SA(1, 0), cA + kstep, vA0, vA1); PG8_STAGE(PG8_SB(1, 1), cB + hB + kstepB, vB0, vB1);
    PG8_WAIT_V(6); PG8_BAR;
    for (;;) {
        const bool has_next = S.next(ui + 1, nxt);
        const char* nA = has_next ? nxt.A : cA; const char* nB = has_next ? nxt.B : cB;
        const int nt = cur.nt;
        for (int t = 0; t < nt; t += 2) {
            const bool last = (t == nt - 2);
            const char* a1 = cA + (size_t)(t + 1) * kstep;
            const char* a2 = last ? nA : cA + (size_t)(t + 2) * kstep; const char* b2 = last ? nB : cB + (size_t)(t + 2) * kstepB;
            const char* a3 = a2 + kstep; const char* b3 = b2 + kstepB;
            PG8_LDB(B0, 0, 0); PG8_LDB(B1, 0, 1); PG8_SCHED; PG8_LDA(At, 0, 0); PG8_STAGE(PG8_SA(1, 1), a1 + hA, vA0, vA1);
            PG8_WAIT_V(8); PG8_WAIT_L(0); PG8_BAR; PG8_MMA(0, 0, At, B0); PG8_MMA(0, 1, At, B1); PG8_BAR; PG8_SCHED;
            PG8_LDA(At, 0, 1); PG8_STAGE(PG8_SB(0, 0), b2, vB0, vB1); PG8_STAGE(PG8_SB(0, 1), b2 + hB, vB0, vB1); PG8_STAGE(PG8_SA(0, 0), a2, vA0, vA1);
            PG8_WAIT_V(8); PG8_WAIT_L(0); PG8_BAR; PG8_MMA(1, 0, At, B0); PG8_MMA(1, 1, At, B1); PG8_BAR; PG8_SCHED;
            PG8_LDB(B0, 1, 0); PG8_LDB(B1, 1, 1); PG8_SCHED; PG8_LDA(At, 1, 0); PG8_STAGE(PG8_SA(0, 1), a2 + hA, vA0, vA1);
            PG8_WAIT_V(8); PG8_WAIT_L(0); PG8_BAR; PG8_MMA(0, 0, At, B0); PG8_MMA(0, 1, At, B1); PG8_BAR; PG8_SCHED;
            PG8_LDA(At, 1, 1); PG8_STAGE(PG8_SB(1, 0), b3, vB0, vB1); PG8_STAGE(PG8_SB(1, 1), b3 + hB, vB0, vB1); PG8_STAGE(PG8_SA(1, 0), a3, vA0, vA1);
            PG8_WAIT_V(8); PG8_WAIT_L(0); PG8_BAR; PG8_MMA(1, 0, At, B0); PG8_MMA(1, 1, At, B1); PG8_BAR; PG8_SCHED;
        }
        if constexpr (ALIGN_EPI) { if (wr == 0) PG8_BAR; }
        {
            const int el_ = fresh_lane(); const int fr_ = el_ & 15, fq_ = el_ >> 4;
            if constexpr (Epi::HAS_STATE) {
#pragma unroll
                for (int ai = 0; ai < 2; ++ai) { typename Epi::State st; E.begin(st, cur, ai * HALF + wr * 64 + fr_, wc * 32 + 8 * fq_);
#pragma unroll
                    for (int m = 0; m < 4; ++m) { const int row = ai * HALF + wr * 64 + m * 16 + fr_;
#pragma unroll
                        for (int bj = 0; bj < 2; ++bj) { float v[8];
#pragma unroll
                            for (int j = 0; j < 4; ++j) { v[j] = acc[ai][bj][m][0][j]; v[4 + j] = acc[ai][bj][m][1][j]; }
                            E.store_st(st, m, cur, row, bj * HALF + wc * 32 + 8 * fq_, v); } } }
            } else {
#pragma unroll
            for (int ai = 0; ai < 2; ++ai)
#pragma unroll
                for (int m = 0; m < 4; ++m) { const int row = ai * HALF + wr * 64 + m * 16 + fr_;
                    if constexpr (Epi::PAIR) { float g[8], up[8];
#pragma unroll
                        for (int j = 0; j < 4; ++j) { g[j] = acc[ai][0][m][0][j]; g[4 + j] = acc[ai][0][m][1][j]; up[j] = acc[ai][1][m][0][j]; up[4 + j] = acc[ai][1][m][1][j]; }
                        E.store2(cur, row, wc * 32 + 8 * fq_, g, up);
#ifdef PROBE_EPI2
                        asm volatile("" ::: "memory"); E.store2(cur, row, wc * 32 + 8 * fq_, g, up);
#endif
                        }
                    else {
#pragma unroll
                        for (int bj = 0; bj < 2; ++bj) { float v[8];
#pragma unroll
                            for (int j = 0; j < 4; ++j) { v[j] = acc[ai][bj][m][0][j]; v[4 + j] = acc[ai][bj][m][1][j]; }
                            E.store(cur, row, bj * HALF + wc * 32 + 8 * fq_, v); } } }
            }
        }
        if (!has_next) break;
#pragma unroll
        for (int a = 0; a < 2; ++a)
#pragma unroll
            for (int b = 0; b < 2; ++b)
#pragma unroll
                for (int m = 0; m < 4; ++m)
#pragma unroll
                    for (int n = 0; n < 2; ++n) acc[a][b][m][n] = (f32x4){0.f, 0.f, 0.f, 0.f};
        cur = nxt; cA = nA; cB = nB; ++ui;
        if constexpr (ALIGN_EPI) { if (wr == 1) PG8_BAR; }
    }
    PG8_WAIT_V(0);
    if constexpr (!ALIGN_EPI) { if (wr == 0) PG8_BAR; }
    PG8_BAR;
#undef PG8_SA
#undef PG8_SB
#undef PG8_STAGE
#undef PG8_LDA
#undef PG8_LDB
#undef PG8_MMA
#undef PG8_WAIT_V
#undef PG8_WAIT_L
#undef PG8_BAR
#undef PG8_SCHED
}
}

namespace att {
typedef short bf16x8 __attribute__((ext_vector_type(8)));
typedef short s16x4 __attribute__((ext_vector_type(4)));
typedef float f32x16 __attribute__((ext_vector_type(16)));
typedef float f32x2_t __attribute__((ext_vector_type(2)));
typedef __bf16 bf16x2_t __attribute__((ext_vector_type(2)));
DI unsigned cvtpk(float lo, float hi) { f32x2_t v = {lo, hi}; bf16x2_t b = __builtin_convertvector(v, bf16x2_t); return __builtin_bit_cast(unsigned, b); }
DI int crow(int r, int h) { return (r & 3) + 8 * (r >> 2) + 4 * h; }
DI float max3f(float a, float b, float c) { float r; asm("v_max3_f32 %0, %1, %2, %3" : "=v"(r) : "v"(a), "v"(b), "v"(c)); return r; }

DI void cvt_moe_one(const Params& p, int item, int lane) {
    const float* s; u32x4* d; float sc; f32x4 v[16];
    moe_f8_addr(p, item, lane, s, d, sc);
#pragma unroll
    for (int k = 0; k < 16; ++k) v[k] = __builtin_nontemporal_load((const f32x4*)(s + (size_t)k * 2048));
#pragma unroll
    for (int j = 0; j < 4; ++j) { u32x4 o;
        o.x = pk4_fp8(v[0][j] * sc, v[1][j] * sc, v[2][j] * sc, v[3][j] * sc); o.y = pk4_fp8(v[4][j] * sc, v[5][j] * sc, v[6][j] * sc, v[7][j] * sc);
        o.z = pk4_fp8(v[8][j] * sc, v[9][j] * sc, v[10][j] * sc, v[11][j] * sc); o.w = pk4_fp8(v[12][j] * sc, v[13][j] * sc, v[14][j] * sc, v[15][j] * sc);
        d[j] = o; }
}
template <bool SWA, int AW>
DI void attn_phase(const Params& p, int wid_, LAS unsigned char* lds, int G, int c, int cv_lo, int cv_hi) {
    constexpr int AT = NTHREADS;
    const bool isatt = AW == 8 || wid_ < AW;
    int cvi = cv_lo + c * (8 - AW) + (wid_ - AW); const int cvs = G * (8 - AW);
    constexpr int DK = SWA ? 64 : 192, DV = SWA ? 64 : 128, KSTR = DK * 2 + 16, VSTR = 136;
    constexpr int QB = SWA ? 2 : 1;
    constexpr int KB = 64 * KSTR, VB = DV * VSTR, STG = KB + VB;
    constexpr int CPR = DK / 8, NKC = (64 * CPR) / AT, NVC = (DV * 8) / AT, NQ = DK / 16, NDV = DV / 32;
    constexpr int LDQ = SWA ? 2048 : 1536, NUNITS = (SWA ? 768 : 384) * (8 / AW);
    static_assert(2 * STG <= 131072, "attention LDS");
    const int tid = (wid_ * 64 + fresh_lane()), lane = tid & 63, wid = wid_, q = lane & 31, hh = lane >> 5;
    const bf16_t* Q = wsp<bf16_t>(p, WS_Q); const bf16_t* KN = wsp<bf16_t>(p, SWA ? WS_KO : WS_KN); const bf16_t* KPE = wsp<bf16_t>(p, WS_KPE);
    const bf16_t* VT = wsp<bf16_t>(p, SWA ? WS_VTO : WS_VT); bf16_t* MIX = wsp<bf16_t>(p, WS_MIX);
#define ATT_DECODE(L) \
        int rowbase, hk, nt0, nt1, key0a, key0b = 0, kpos0 = 0, qpos0 = 0, hsel = 0; bool masked = false; \
        if (!SWA && AW == 4) { \
            if (L < 512) { const int b = L >> 6, qt = L & 7; hk = (L >> 3) & 7; rowbase = T_CTX + b * 1024 + qt * 128; key0a = T_CTX + b * 1024; nt0 = 16; key0b = T + b * 512; nt1 = 8; } \
            else { const int Lc = L - 512, b = Lc >> 4; hk = (Lc >> 1) & 7; rowbase = b * 256 + (Lc & 1) * 128; key0a = b * 256; nt0 = 4; nt1 = 0; } \
        } else if (SWA && AW == 4) { \
            hsel = L & 1; const int L2 = L >> 1; \
            if (L2 < 512) { const int b = L2 >> 6, t0 = (L2 & 15) * 64; hk = (L2 >> 4) & 3; rowbase = T_CTX + b * 1024 + t0; \
                const int lo = max(t0 - 128, 0) & ~63, hi = min((t0 + 192 + 63) & ~63, 1024); \
                key0a = T_CTX + b * 1024 + lo; nt0 = (hi - lo) >> 6; kpos0 = lo; qpos0 = t0; masked = true; key0b = T + b * 512; nt1 = 8; } \
            else { const int Lc = L2 - 512, b = Lc >> 4; hk = (Lc >> 2) & 3; rowbase = b * 256 + (Lc & 3) * 64; key0a = b * 256; nt0 = 4; nt1 = 0; } \
        } else if (!SWA) { \
            if (L < 256) { const int b = L >> 5, qt = L & 3; hk = (L >> 2) & 7; rowbase = T_CTX + b * 1024 + qt * 256; key0a = T_CTX + b * 1024; nt0 = 16; key0b = T + b * 512; nt1 = 8; } \
            else { const int Lc = L - 256, b = Lc >> 3; hk = Lc & 7; rowbase = b * 256; key0a = b * 256; nt0 = 4; nt1 = 0; } \
        } else { \
            if (L < 512) { const int b = L >> 6, t0 = (L & 15) * 64; hk = (L >> 4) & 3; rowbase = T_CTX + b * 1024 + t0; \
                const int lo = max(t0 - 128, 0) & ~63, hi = min((t0 + 192 + 63) & ~63, 1024); \
                key0a = T_CTX + b * 1024 + lo; nt0 = (hi - lo) >> 6; kpos0 = lo; qpos0 = t0; masked = true; key0b = T + b * 512; nt1 = 8; } \
            else { const int Lc = L - 512, b = Lc >> 4; hk = (Lc >> 2) & 3; rowbase = b * 256 + (Lc & 3) * 64; key0a = b * 256; nt0 = 4; nt1 = 0; } \
        }
#define ATT_LOAD(t_) do { const int tt_ = (t_); const int kb_ = tt_ < nt0 ? key0a + tt_ * 64 : key0b + (tt_ - nt0) * 64; \
            _Pragma("unroll") for (int i = 0; i < NKC; ++i) { const int ch = tid + AT * i, j = ch / CPR, cc = ch % CPR; \
                const bf16_t* src = SWA ? KN + (size_t)(kb_ + j) * 256 + hk * 64 + cc * 8 : (cc < 16 ? KN + (size_t)(kb_ + j) * 1024 + hk * 128 + cc * 8 : KPE + (size_t)(kb_ + j) * 64 + (cc - 16) * 8); \
                kreg[i] = *(const u32x4*)src; } \
            _Pragma("unroll") for (int i = 0; i < NVC; ++i) { const int ch = tid + AT * i, dv = ch >> 3, cc = ch & 7; \
                vreg[i] = *(const u32x4*)(VT + (size_t)(hk * DV + dv) * TX + kb_ + cc * 8); } } while (0)
#define ATT_WRITE(buf_) do { LAS unsigned char* Kw = lds + (buf_) * STG; LAS unsigned char* Vw = Kw + KB; \
            _Pragma("unroll") for (int i = 0; i < NKC; ++i) { const int ch = tid + AT * i, j = ch / CPR, cc = ch % CPR; *(LAS u32x4*)(Kw + j * KSTR + cc * 16) = kreg[i]; } \
            _Pragma("unroll") for (int i = 0; i < NVC; ++i) { const int ch = tid + AT * i, dv = ch >> 3, cc = ch & 7; \
                *(LAS u32x2*)(Vw + dv * VSTR + cc * 16) = (u32x2){vreg[i].x, vreg[i].y}; *(LAS u32x2*)(Vw + dv * VSTR + cc * 16 + 8) = (u32x2){vreg[i].z, vreg[i].w}; } } while (0)
    if (!isatt) {
        u32x4 kreg[NKC], vreg[NVC];
        for (int L = c; L < NUNITS; L += G) {
            ATT_DECODE(L);
            const int total = nt0 + nt1; (void)rowbase; (void)kpos0; (void)qpos0; (void)hsel; (void)masked;
            ATT_LOAD(0); ATT_WRITE(0);
            __syncthreads();
            for (int t = 0; t < total; ++t) { const int buf = t & 1;
                if (t + 1 < total) ATT_LOAD(t + 1);
                if (cvi < cv_hi) { cvt_moe_one(p, cvi, lane); cvi += cvs; }
                if (t + 1 < total) ATT_WRITE(buf ^ 1);
                __syncthreads(); }
        }
        for (; cvi < cv_hi; cvi += cvs) cvt_moe_one(p, cvi, lane);
        return;
    }
    for (int L = c; L < NUNITS; L += G) {
        ATT_DECODE(L);
        const int total = nt0 + nt1;
        const int qrow0 = SWA ? rowbase + q : rowbase + wid * 32 + q;
        const int qhead = SWA ? hk * 8 + hsel * (8 - AW) + (isatt ? wid : 0) : hk;
        bf16x8 qf[QB][NQ];
        if (isatt) {
#pragma unroll
        for (int qb = 0; qb < QB; ++qb)
#pragma unroll
            for (int s = 0; s < NQ; ++s) qf[qb][s] = *(const bf16x8*)(Q + (size_t)(qrow0 + 32 * qb) * LDQ + qhead * DK + 16 * s + 8 * hh);
        }
        f32x16 o[QB][NDV];
#pragma unroll
        for (int qb = 0; qb < QB; ++qb)
#pragma unroll
            for (int d = 0; d < NDV; ++d)
#pragma unroll
                for (int r = 0; r < 16; ++r) o[qb][d][r] = 0.f;
        float m[QB], l[QB];
#pragma unroll
        for (int qb = 0; qb < QB; ++qb) { m[qb] = SWA ? p.in[19][qhead] * LOG2E : -1e30f; l[qb] = (SWA && hh == 0) ? 1.f : 0.f; }
        const int qpos = qpos0 + q;
        u32x4 kreg[NKC], vreg[NVC];
        ATT_LOAD(0); ATT_WRITE(0);
        __syncthreads();
        for (int t = 0; t < total; ++t) {
            const int buf = t & 1;
            {
            if (t + 1 < total) ATT_LOAD(t + 1);
            const LAS unsigned char* Kl = lds + buf * STG; const LAS unsigned char* Vl = Kl + KB;
            f32x16 s0[QB], s1[QB];
#pragma unroll
            for (int qb = 0; qb < QB; ++qb)
#pragma unroll
                for (int r = 0; r < 16; ++r) { s0[qb][r] = 0.f; s1[qb][r] = 0.f; }
#pragma unroll
            for (int s = 0; s < NQ; ++s) {
                const bf16x8 a0 = *(const LAS bf16x8*)(Kl + q * KSTR + (16 * s + 8 * hh) * 2);
                const bf16x8 a1 = *(const LAS bf16x8*)(Kl + (32 + q) * KSTR + (16 * s + 8 * hh) * 2);
#pragma unroll
                for (int qb = 0; qb < QB; ++qb) { s0[qb] = __builtin_amdgcn_mfma_f32_32x32x16_bf16(a0, qf[qb][s], s0[qb], 0, 0, 0); s1[qb] = __builtin_amdgcn_mfma_f32_32x32x16_bf16(a1, qf[qb][s], s1[qb], 0, 0, 0); }
            }
            bf16x8 pb[QB][2][2];
#pragma unroll
            for (int qb = 0; qb < QB; ++qb) {
                const int rel = kpos0 + t * 64 - qpos0 - 32 * qb;
                if (SWA && masked && t < nt0 && (rel - 31 < -128 || rel + 63 > 128)) {
                    const int kp = kpos0 + t * 64 - (qpos + 32 * qb);
#pragma unroll
                    for (int r = 0; r < 16; ++r) { const int d0 = kp + crow(r, hh), d1 = d0 + 32;
                        s0[qb][r] = (d0 >= -128 && d0 <= 128) ? s0[qb][r] : -1e30f; s1[qb][r] = (d1 >= -128 && d1 <= 128) ? s1[qb][r] : -1e30f; }
                }
                float tm = fmaxf(s0[qb][0], s1[qb][0]);
#pragma unroll
                for (int r = 1; r < 16; ++r) tm = max3f(tm, s0[qb][r], s1[qb][r]);
                tm = fmaxf(tm, __shfl_xor(tm, 32));
                const float mn = fmaxf(m[qb], tm);
                if (!__all(mn == m[qb])) {
                    const float alpha = __builtin_amdgcn_exp2f(m[qb] - mn); m[qb] = mn; l[qb] *= alpha;
#pragma unroll
                    for (int d = 0; d < NDV; ++d)
#pragma unroll
                        for (int r = 0; r < 16; ++r) o[qb][d][r] *= alpha; }
                float ls = 0.f;
#pragma unroll
                for (int r = 0; r < 16; ++r) { s0[qb][r] = __builtin_amdgcn_exp2f(s0[qb][r] - m[qb]); s1[qb][r] = __builtin_amdgcn_exp2f(s1[qb][r] - m[qb]); ls += s0[qb][r] + s1[qb][r]; }
                l[qb] += ls;
#pragma unroll
                for (int s = 0; s < 2; ++s) {
                    u32x4 w0, w1;
                    w0.x = cvtpk(s0[qb][8 * s + 0], s0[qb][8 * s + 1]); w0.y = cvtpk(s0[qb][8 * s + 2], s0[qb][8 * s + 3]); w0.z = cvtpk(s0[qb][8 * s + 4], s0[qb][8 * s + 5]); w0.w = cvtpk(s0[qb][8 * s + 6], s0[qb][8 * s + 7]);
                    w1.x = cvtpk(s1[qb][8 * s + 0], s1[qb][8 * s + 1]); w1.y = cvtpk(s1[qb][8 * s + 2], s1[qb][8 * s + 3]); w1.z = cvtpk(s1[qb][8 * s + 4], s1[qb][8 * s + 5]); w1.w = cvtpk(s1[qb][8 * s + 6], s1[qb][8 * s + 7]);
                    pb[qb][0][s] = __builtin_bit_cast(bf16x8, w0); pb[qb][1][s] = __builtin_bit_cast(bf16x8, w1);
                }
            }
#pragma unroll
            for (int d = 0; d < NDV; ++d)
#pragma unroll
                for (int blk = 0; blk < 2; ++blk)
#pragma unroll
                    for (int s = 0; s < 2; ++s) {
                        const LAS unsigned char* vp = Vl + (d * 32 + q) * VSTR + (blk * 32 + 16 * s + 4 * hh) * 2;
                        const s16x4 lo = *(const LAS s16x4*)vp, hi = *(const LAS s16x4*)(vp + 16);
                        const bf16x8 a = {lo[0], lo[1], lo[2], lo[3], hi[0], hi[1], hi[2], hi[3]};
#pragma unroll
                        for (int qb = 0; qb < QB; ++qb) o[qb][d] = __builtin_amdgcn_mfma_f32_32x32x16_bf16(a, pb[qb][blk][s], o[qb][d], 0, 0, 0);
                    }
            if (t + 1 < total) ATT_WRITE(buf ^ 1);
            }
            __syncthreads();
        }
        if (isatt) {
#pragma unroll
        for (int qb = 0; qb < QB; ++qb) {
            const float inv = 1.f / (l[qb] + __shfl_xor(l[qb], 32));
            bf16_t* orow = MIX + (size_t)(qrow0 + 32 * qb) * 2048 + qhead * DV;
            unsigned char* orow8 = (unsigned char*)MIX + (size_t)(qrow0 + 32 * qb) * 2048 + qhead * DV;
#pragma unroll
            for (int d = 0; d < NDV; ++d)
#pragma unroll
                for (int g = 0; g < 4; ++g) {
                    if (OUT_F8) *(unsigned*)(orow8 + d * 32 + 8 * g + 4 * hh) = pk4_fp8(o[qb][d][4 * g] * inv, o[qb][d][4 * g + 1] * inv, o[qb][d][4 * g + 2] * inv, o[qb][d][4 * g + 3] * inv);
                    else { u32x2 w; w.x = cvtpk(o[qb][d][4 * g] * inv, o[qb][d][4 * g + 1] * inv); w.y = cvtpk(o[qb][d][4 * g + 2] * inv, o[qb][d][4 * g + 3] * inv); *(u32x2*)(orow + d * 32 + 8 * g + 4 * hh) = w; } }
        }
        }
    }
}
#undef ATT_LOAD
#undef ATT_WRITE
#undef ATT_DECODE
}


#ifndef R_PRO
#define R_PRO 1
#endif
#ifndef R_MOE
#define R_MOE 1
#endif
#ifndef R_ATT
#define R_ATT 1
#endif
#ifndef R_ATTM
#define R_ATTM R_ATT
#endif
#ifndef R_ATTS
#define R_ATTS R_ATT
#endif
#ifndef R_GEMM
#define R_GEMM 1
#endif
#ifndef R_THIN
#define R_THIN 1
#endif
#ifndef R_LN1
#define R_LN1 1
#endif
#ifndef R_LN2
#define R_LN2 1
#endif
#ifndef R_TOPK
#define R_TOPK 1
#endif
#define REP(n) for (int _r = 0; _r < (n); ++_r)
#define REPS(n, ...) do { { __VA_ARGS__ } if ((n) > 1) { __VA_ARGS__ } } while (0)
constexpr int LDS_BYTES = 147456, MISC_OFF = 146432;
constexpr int NPH = 20;
#ifndef CVT_WAVES
#define CVT_WAVES 4
#endif
#ifndef ATT_SPLIT
#define ATT_SPLIT 1
#endif
#ifndef AS_PIPE
#define AS_PIPE 0
#endif
#ifndef AS_WAVES
#define AS_WAVES 4
#endif
#ifndef AS_CO
#define AS_CO 1
#endif
#ifndef AS_DYN
#define AS_DYN 1
#endif
#ifndef AS_I2
#define AS_I2 10240
#endif
#ifndef AS_I6
#define AS_I6 6144
#endif
#ifndef AS_I14
#define AS_I14 4096
#endif
#ifndef BG_MODE
#define BG_MODE 0
#endif
#ifndef BG_SPLIT
#define BG_SPLIT 32768
#endif
#ifndef CVT_IDLE_WAVES
#define CVT_IDLE_WAVES 4
#endif
#ifndef CV_IDLE2
#define CV_IDLE2 10240
#endif
#ifndef CV_IDLE6
#define CV_IDLE6 10240
#endif
constexpr int CV_I2 = CV_IDLE2, CV_I6 = CV_IDLE6, CV_IALL = CV_I2 + 2 * CV_I6;
__global__ void __launch_bounds__(NTHREADS, 2) mega(Params p) {
    extern __shared__ __attribute__((aligned(16))) unsigned char lds[];
    const int G = gridDim.x, c = vcu_of(blockIdx.x, G), wid = __builtin_amdgcn_readfirstlane(threadIdx.x >> 6);
    volatile LAS unsigned* MISC = (volatile LAS unsigned*)((LAS unsigned char*)lds + MISC_OFF);
    if (threadIdx.x < 4) MISC[threadIdx.x] = 0u;
    __syncthreads();
    XcdBarrier bar = xcd_barrier_post((unsigned*)(p.ws + WS_CTL) + CW_BAR, MISC);
    const int lo = p.ph_lo, hi = p.ph_hi;
#define IN(k) (lo <= (k) && (k) < hi)
#ifdef STAMP_A
#define stamps_ (wsp<unsigned long long>(p, WS_DBG + 65536))
#define STAMP(k) do { if (blockIdx.x == 0 && wid == 0 && fresh_lane() == 0) stamps_[k] = __builtin_amdgcn_s_memrealtime(); } while (0)
#else
#define STAMP(k) do { } while (0)
#endif
    STAMP(0); STAMP(23);
#ifndef R_BAR
#define R_BAR 1
#endif
#define SEAM(k) do { if (IN(k) && IN((k) + 1)) { xcd_barrier(bar); if (R_BAR > 1) xcd_barrier(bar); } STAMP((k) + 1); } while (0)
    if (IN(0)) REP(R_PRO) { ph_mod(p, wid, lds); STAMP(21); ph_misc(p, wid); STAMP(22); ph_convert(p, wid, 0, G == 256 ? (ATT_SPLIT ? CV_TOTAL - CV_MOE : CV_TOTAL - CV_IALL) : CV_TOTAL, blockIdx.x, G, CVT_WAVES);
#ifdef RD_PAT
        ph_readonly<RD_PAT>(p, wid);
#endif
    } SEAM(0);
    if (IN(1)) REP(R_THIN) { ph_modreduce(p, wid); ph_h0(p, wid, lds); } SEAM(1);
    if (IN(2)) { REPS(R_GEMM, SchedInEven S{&p, G, c}; EpiInEven E{&p}; pg8::gemm_phase((LAS unsigned char*)lds, S, E, wid);); if (G == 256 && c >= 128) { if (ATT_SPLIT) ph_convert(p, wid, CV_TOTAL - CV_MOE, CV_TOTAL - CV_MOE + AS_I2, c - 128, 128, CVT_IDLE_WAVES); else ph_convert(p, wid, CV_TOTAL - CV_IALL, CV_TOTAL - 2 * CV_I6, c - 128, 128, CVT_IDLE_WAVES); } } SEAM(2);
    if (IN(3)) REP(R_THIN) { ph_e1(p, wid); } SEAM(3);
    #ifndef MOE_ALIGN
#define MOE_ALIGN true
#endif
#ifndef E2_ALIGN
#define E2_ALIGN true
#endif
    if (IN(4)) REPS(R_GEMM, SchedE2 S{&p, G, c}; EpiE2 E{&p}; pg8::gemm_phase<EpiE2, SchedE2, E2_ALIGN>((LAS unsigned char*)lds, S, E, wid);); SEAM(4);
    const bool asp = ATT_SPLIT && G == 256, ascv = asp && (c & 31) >= 16;
    const int aG = asp ? 128 : G, ac = asp ? (c >> 5) * 16 + (c & 15) : c, ccv = (c >> 5) * 16 + (c & 15);
#if AS_DYN
#if AS_CO
    if (IN(5)) { if (asp) att::attn_phase<false, 4>(p, wid, (LAS unsigned char*)lds, G, c, AS_I2, CV_MOE / 2); else att::attn_phase<false, 8>(p, wid, (LAS unsigned char*)lds, G, c, 0, 0); } SEAM(5);
#else
    if (IN(5)) { if (!ascv) REP(R_ATTM) { att::attn_phase<false, 8>(p, wid, (LAS unsigned char*)lds, aG, ac, 0, 0); } if (asp) ph_convert_dyn(p, wid, CV_TOTAL - CV_MOE + AS_I2, CV_TOTAL - CV_MOE / 2, (unsigned*)(p.ws + WS_CTL) + 64, AS_WAVES); } SEAM(5);
#endif
#else
    if (IN(5)) { if (ascv) { if (AS_PIPE) ph_convert_moe_bg(p, wid, AS_I2, CV_MOE / 2, ccv, 128, AS_WAVES); else ph_convert(p, wid, CV_TOTAL - CV_MOE + AS_I2, CV_TOTAL - CV_MOE / 2, ccv, 128, AS_WAVES); } else REP(R_ATTM) { att::attn_phase<false, 8>(p, wid, (LAS unsigned char*)lds, aG, ac, 0, 0); } } SEAM(5);
#endif
    if (IN(6)) { REPS(R_GEMM, SchedOut S{&p, G, c, 0}; EpiOut E{&p, 0}; pg8::gemm_phase((LAS unsigned char*)lds, S, E, wid);); if (G == 256 && c >= 128) { if (ATT_SPLIT) ph_convert(p, wid, CV_TOTAL - CV_MOE / 2, CV_TOTAL - CV_MOE / 2 + AS_I6, c - 128, 128, CVT_IDLE_WAVES); else ph_convert(p, wid, CV_TOTAL - 2 * CV_I6, CV_TOTAL - CV_I6, c - 128, 128, CVT_IDLE_WAVES); } } SEAM(6);
    if (IN(7)) REP(R_LN1) { ph_ln1(p, wid, 0, lds); } SEAM(7);
    if (IN(8)) REP(R_TOPK) { ph_topk(p, wid, lds); } SEAM(8);
    {
        const bool bgm = BG_MODE && G == 256, isbg = bgm && (c & 31) >= 24;
        const int fG = bgm ? 192 : G, fc = bgm ? (c >> 5) * 24 + (c & 31) : c, bgi = (c >> 5) * 8 + (c & 31) - 24;
        if (IN(9)) { if (isbg) ph_convert_moe_bg(p, wid, CV_MOE / 2, CV_MOE / 2 + BG_SPLIT, bgi, 64, 8); else REPS(R_MOE, SchedGU S{&p, fG, fc, 0}; EpiGU E{&p}; pg8::gemm_phase<EpiGU, SchedGU, MOE_ALIGN>((LAS unsigned char*)lds, S, E, wid);); } SEAM(9);
        if (IN(10)) { if (isbg) ph_convert_moe_bg(p, wid, CV_MOE / 2 + BG_SPLIT, CV_MOE, bgi, 64, 8); else REPS(R_MOE, SchedDown S{&p, fG, fc, 0}; EpiDown E{&p}; pg8::gemm_phase<EpiDown, SchedDown, MOE_ALIGN>((LAS unsigned char*)lds, S, E, wid);); } SEAM(10);
    }
    if (IN(11)) REP(R_LN2) { ph_ln2(p, wid, 0, lds); } SEAM(11);
    if (IN(12)) REPS(R_GEMM, SchedInOdd S{&p, G, c}; EpiInOdd E{&p}; pg8::gemm_phase((LAS unsigned char*)lds, S, E, wid);); SEAM(12);
#if AS_DYN
#if AS_CO
    if (IN(13)) { if (asp) att::attn_phase<true, 4>(p, wid, (LAS unsigned char*)lds, G, c, CV_MOE / 2 + AS_I6, CV_MOE - AS_I14); else att::attn_phase<true, 8>(p, wid, (LAS unsigned char*)lds, G, c, 0, 0); } SEAM(13);
#else
    if (IN(13)) { if (!ascv) REP(R_ATTS) { att::attn_phase<true, 8>(p, wid, (LAS unsigned char*)lds, aG, ac, 0, 0); } if (asp) ph_convert_dyn(p, wid, CV_TOTAL - CV_MOE / 2 + AS_I6, CV_TOTAL - AS_I14, (unsigned*)(p.ws + WS_CTL) + 128, AS_WAVES); } SEAM(13);
#endif
#else
    if (IN(13)) { if (ascv) { if (AS_PIPE) ph_convert_moe_bg(p, wid, CV_MOE / 2 + AS_I6, CV_MOE - AS_I14, ccv, 128, AS_WAVES); else ph_convert(p, wid, CV_TOTAL - CV_MOE / 2 + AS_I6, CV_TOTAL - AS_I14, ccv, 128, AS_WAVES); } else REP(R_ATTS) { att::attn_phase<true, 8>(p, wid, (LAS unsigned char*)lds, aG, ac, 0, 0); } } SEAM(13);
#endif
    if (IN(14)) { REPS(R_GEMM, SchedOut S{&p, G, c, 1}; EpiOut E{&p, 1}; pg8::gemm_phase((LAS unsigned char*)lds, S, E, wid);); if (G == 256 && c >= 128) { if (ATT_SPLIT) ph_convert(p, wid, CV_TOTAL - AS_I14, CV_TOTAL, c - 128, 128, CVT_IDLE_WAVES); else ph_convert(p, wid, CV_TOTAL - CV_I6, CV_TOTAL, c - 128, 128, CVT_IDLE_WAVES); } } SEAM(14);
    if (IN(15)) REP(R_LN1) { ph_ln1(p, wid, 1, lds); } SEAM(15);
    if (IN(16)) REP(R_TOPK) { ph_topk(p, wid, lds); } SEAM(16);
    if (IN(17)) REPS(R_MOE, SchedGU S{&p, G, c, 1}; EpiGU E{&p}; pg8::gemm_phase<EpiGU, SchedGU, MOE_ALIGN>((LAS unsigned char*)lds, S, E, wid);); SEAM(17);
    if (IN(18)) REPS(R_MOE, SchedDown S{&p, G, c, 1}; EpiDown E{&p}; pg8::gemm_phase<EpiDown, SchedDown, MOE_ALIGN>((LAS unsigned char*)lds, S, E, wid);); SEAM(18);
    if (IN(19)) REP(R_LN2) { ph_ln2(p, wid, 1, lds); }
#ifdef STAMP_A
    STAMP(20);
    if (blockIdx.x == 0 && wid == 0 && fresh_lane() == 0) {
        asm volatile("s_waitcnt vmcnt(0)" ::: "memory");
        const unsigned long long d = (__hip_atomic_load(&stamps_[STAMP_B], __ATOMIC_RELAXED, __HIP_MEMORY_SCOPE_AGENT) - __hip_atomic_load(&stamps_[STAMP_A], __ATOMIC_RELAXED, __HIP_MEMORY_SCOPE_AGENT)) * 4ull;
        const unsigned long long t0 = __builtin_amdgcn_s_memrealtime();
        while (__builtin_amdgcn_s_memrealtime() - t0 < d) __builtin_amdgcn_s_sleep(8);
    }
#endif
#undef IN
#undef SEAM
}

extern "C" void kernel_launch(void* const* d_in, const int* in_sizes, int n_in, void* d_out, int out_size, void* d_ws, size_t ws_size, hipStream_t stream) {
    static int grid = 0;
    if (grid == 0) {
        if (n_in != 29 || out_size != (int)O_END || ws_size < WS_END) { fprintf(stderr, "kernel_launch: unexpected shapes (n_in %d out %d ws %zu need %zu)\n", n_in, out_size, ws_size, (size_t)WS_END); grid = -1; return; }
        int dev = 0, cus = 0, per_cu = 0;
        if (hipGetDevice(&dev) != hipSuccess || hipDeviceGetAttribute(&cus, hipDeviceAttributeMultiprocessorCount, dev) != hipSuccess) { grid = -1; return; }
        if (hipFuncSetAttribute((const void*)mega, hipFuncAttributeMaxDynamicSharedMemorySize, LDS_BYTES) != hipSuccess) { fprintf(stderr, "hipFuncSetAttribute failed\n"); grid = -1; return; }
        if (hipOccupancyMaxActiveBlocksPerMultiprocessor(&per_cu, (const void*)mega, NTHREADS, LDS_BYTES) != hipSuccess || per_cu < 1) fprintf(stderr, "occupancy query: %d\n", per_cu);
        (void)hipGetLastError();
        grid = cus > 0 ? cus : 256;
    }
    if (grid < 0) return;
    Params p{};
    for (int i = 0; i < 29; ++i) p.in[i] = (const float*)d_in[i];
    p.out = (float*)d_out; p.ws = (unsigned char*)d_ws; p.ph_lo = 0; p.ph_hi = NPH; p.rpb = (T + grid - 1) / grid; p.pad = 0;
    (void)hipMemsetAsync((char*)d_ws + WS_CTL, 0, 32768, stream);
    hipLaunchKernelGGL(mega, dim3(grid), dim3(NTHREADS), LDS_BYTES, stream, p);
}
```
